# Optimizing an MI355X kernel written in HIP

```python
import math
import jax
import jax.numpy as jnp
from jax import lax
import numpy as np

D_MODEL = 2048
BATCH = 1
SEQ = 16384
DEPTH = 2

CTX_LEN = 256
GRID_W = 64
HEAD_DIM = 128
BRANCH_WIDTH = 1024
N_BRANCH = 3
N_MOD = 6
RMS_EPS = 1e-6
NEG_INF = -1e30

HY_WIDTH = BRANCH_WIDTH
HY_GROUPS = HY_WIDTH // HEAD_DIM
HY_ORDER = 2
HY_DIRS = 2
HY_SHORT_WIDTH = 3
HY_BANDS = 16
HY_EMB = 1 + 2 * HY_BANDS
HY_FILTER_HIDDEN = 64
HY_DECAY_TARGET = 1e-2
HY_DECAY_SHORT_PCT = 0.3
HY_DECAY_LONG_PCT = 1.5
HY_DECAY_SHIFT = 0.05

WA_HEADS = BRANCH_WIDTH // HEAD_DIM
WA_KV_HEADS = 2
WA_WINDOW = 128
WA_BLOCK = 128

NA_HEADS = BRANCH_WIDTH // HEAD_DIM
NA_WIN_ROWS = 8
NA_WIN_COLS = 16

ROPE_BASE = 10000.0

N_EXPERTS = 16
EC_CAPACITY_FACTOR = 2
D_EXPERT = 1024

OFF_HY = 0
OFF_WA_Q = OFF_HY + 3 * HY_WIDTH
OFF_WA_KV = OFF_WA_Q + WA_HEADS * HEAD_DIM
OFF_NA_Q = OFF_WA_KV + 2 * WA_KV_HEADS * HEAD_DIM
OFF_NA_KV = OFF_NA_Q + NA_HEADS * HEAD_DIM
OFF_GATE = OFF_NA_KV + 2 * NA_HEADS * HEAD_DIM
N_IN = OFF_GATE + N_BRANCH * D_MODEL

kernel_name = 'hybrid_hyena_window_natten_ec_moe_dit'


def rms_norm(x, g):
    xf = x.astype(jnp.float32)
    y = xf * lax.rsqrt(jnp.mean(xf * xf, axis=-1, keepdims=True) + RMS_EPS)
    return (y * g.astype(jnp.float32)).astype(x.dtype)


def modulate(h, shift, scale):
    return h * (1 + scale) + shift


def split_heads(z, n_heads):
    return z.reshape(z.shape[:-1] + (n_heads, HEAD_DIM))


def keys_values(z, n_heads, k_gain):
    k, v = jnp.split(z, 2, axis=-1)
    return rms_norm(split_heads(k, n_heads), k_gain), split_heads(v, n_heads)


def axial_rope_tables(L):
    t = jnp.arange(L, dtype=jnp.int32)
    row = (t // GRID_W).astype(jnp.float32)
    col = (t % GRID_W).astype(jnp.float32)
    nf = HEAD_DIM // 4
    inv = ROPE_BASE ** (-jnp.arange(nf, dtype=jnp.float32) / nf)
    ang = jnp.stack([row[:, None] * inv, col[:, None] * inv], axis=1)
    return jnp.cos(ang), jnp.sin(ang)


def apply_axial_rope(x, cos, sin):
    nf = HEAD_DIM // 4
    xr = x.reshape(x.shape[:-1] + (2, 2, nf))
    x1, x2 = xr[..., 0, :], xr[..., 1, :]
    c = cos[None, :, None].astype(x.dtype)
    s = sin[None, :, None].astype(x.dtype)
    out = jnp.stack([x1 * c - x2 * s, x2 * c + x1 * s], axis=-2)
    return out.reshape(x.shape)


def short_conv3(z, w, b):
    L = z.shape[1]
    zp = jnp.pad(z, ((0, 0), (1, 1), (0, 0)))
    return zp[:, :L] * w[0] + zp[:, 1:L + 1] * w[1] + zp[:, 2:] * w[2] + b


def hyena_filter_spectra(L, fw1, fb1, fw2, fb2, fw3, freq, decay):
    f32 = jnp.float32
    t = jnp.linspace(0.0, 1.0, L, dtype=f32)[:, None]
    pos = jnp.arange(L, dtype=f32)[:, None]
    bands = jnp.linspace(1e-4, HY_BANDS - 1, HY_BANDS, dtype=f32)[None, :]
    ang = (2.0 * math.pi / L) * bands * pos
    feats = jnp.concatenate([t, jnp.cos(ang), -jnp.sin(ang)], axis=-1)
    fr = freq.astype(f32)
    h = jnp.sin(fr[0] * (feats @ fw1.astype(f32) + fb1.astype(f32)))
    h = jnp.sin(fr[1] * (h @ fw2.astype(f32) + fb2.astype(f32)))
    h = (h @ fw3.astype(f32)).reshape(L, HY_DIRS, HY_ORDER, HY_WIDTH)
    rate = jnp.abs(decay.astype(f32)).reshape(HY_DIRS, HY_ORDER, HY_WIDTH)
    h = h * (jnp.exp(-t[:, :, None, None] * rate) + HY_DECAY_SHIFT)
    hf, hb = h[:, 0], h[:, 1]
    k = jnp.concatenate([hf[:1] + hb[:1], hf[1:], jnp.zeros_like(hf[:1]), hb[1:][::-1]], axis=0)
    k = k / jnp.sum(jnp.abs(k), axis=0, keepdims=True)
    return jnp.fft.rfft(k, axis=0)


def bidir_long_conv(u, k_spec, d_skip):
    L = u.shape[1]
    uf = jnp.fft.rfft(u.astype(jnp.float32), n=2 * L, axis=1)
    y = jnp.fft.irfft(uf * k_spec[None], n=2 * L, axis=1)[:, :L]
    return (y + u.astype(jnp.float32) * d_skip.astype(jnp.float32)).astype(u.dtype)


def hyena_branch(z, p):
    L = z.shape[1]
    z = short_conv3(z, p['hy_conv_w'], p['hy_conv_b'])
    v, x1, x2 = jnp.split(z, 3, axis=-1)
    k_spec = hyena_filter_spectra(L, p['hy_fw1'], p['hy_fb1'], p['hy_fw2'], p['hy_fb2'],
                                  p['hy_fw3'], p['hy_freq'], p['hy_decay'])
    y = x1 * bidir_long_conv(v, k_spec[:, 0], p['hy_d'][0])
    return x2 * bidir_long_conv(y, k_spec[:, 1], p['hy_d'][1])


def windowed_gqa_latent(q, k, v, kc, vc, sink):
    B, L, H, Dh = q.shape
    kvh = k.shape[2]
    g = H // kvh
    nb = L // WA_BLOCK
    qb = q.reshape(B, nb, WA_BLOCK, kvh, g, Dh)

    def band(t):
        tp = jnp.pad(t, ((0, 0), (WA_BLOCK, WA_BLOCK), (0, 0), (0, 0)))
        tp = tp.reshape(B, nb + 2, WA_BLOCK, kvh, Dh)
        return jnp.concatenate([tp[:, :-2], tp[:, 1:-1], tp[:, 2:]], axis=2)

    kb, vb = band(k), band(v)
    scale = HEAD_DIM ** -0.5
    blk = jnp.arange(nb)[:, None] * WA_BLOCK
    qpos = (blk + jnp.arange(WA_BLOCK)[None])[:, :, None]
    kpos = (blk - WA_BLOCK + jnp.arange(3 * WA_BLOCK)[None])[:, None, :]
    valid = (kpos >= 0) & (kpos < L) & (jnp.abs(qpos - kpos) <= WA_WINDOW)
    s_loc = jnp.einsum('bnqkgd,bnskd->bnkgqs', qb, kb).astype(jnp.float32) * scale
    s_loc = jnp.where(valid[None, :, None, None], s_loc, NEG_INF)
    s_ctx = jnp.einsum('bnqkgd,bckd->bnkgqc', qb, kc).astype(jnp.float32) * scale
    s_sink = jnp.broadcast_to(sink.astype(jnp.float32).reshape(1, 1, kvh, g, 1, 1), s_loc.shape[:-1] + (1,))
    p = jax.nn.softmax(jnp.concatenate([s_loc, s_ctx, s_sink], axis=-1), axis=-1).astype(v.dtype)
    nl = 3 * WA_BLOCK
    nc = kc.shape[1]
    o = (jnp.einsum('bnkgqs,bnskd->bnqkgd', p[..., :nl], vb)
         + jnp.einsum('bnkgqc,bckd->bnqkgd', p[..., nl:nl + nc], vc))
    return o.reshape(B, L, H * Dh)


def neighbourhood_attention_latent(q, k, v, kc, vc, rpb):
    B, L, H, Dh = q.shape
    rows = L // GRID_W
    wr = min(NA_WIN_ROWS, rows)
    qg = q.reshape(B, rows, GRID_W, H, Dh)
    kg = k.reshape(B, rows, GRID_W, H, Dh)
    vg = v.reshape(B, rows, GRID_W, H, Dh)
    col = jnp.arange(GRID_W)
    cstart = jnp.clip(col - NA_WIN_COLS // 2, 0, GRID_W - NA_WIN_COLS)
    col_in = (col[None, :] >= cstart[:, None]) & (col[None, :] < cstart[:, None] + NA_WIN_COLS)
    dc_idx = jnp.clip(col[None, :] - col[:, None] + NA_WIN_COLS - 1, 0, 2 * NA_WIN_COLS - 2)
    scale = HEAD_DIM ** -0.5
    n_loc = wr * GRID_W

    def row_block(r):
        r0 = jnp.clip(r - NA_WIN_ROWS // 2, 0, rows - wr)
        q_r = lax.dynamic_index_in_dim(qg, r, axis=1, keepdims=False)
        k_r = lax.dynamic_slice_in_dim(kg, r0, wr, axis=1)
        v_r = lax.dynamic_slice_in_dim(vg, r0, wr, axis=1).reshape(B, n_loc, H, Dh)
        dr_idx = r0 + jnp.arange(wr) - r + NA_WIN_ROWS - 1
        bias = rpb[:, dr_idx[None, :, None], dc_idx[:, None, :]].astype(jnp.float32)
        s_loc = jnp.einsum('bqhd,bwkhd->bhqwk', q_r, k_r).astype(jnp.float32) * scale + bias
        s_loc = jnp.where(col_in[:, None, :], s_loc, NEG_INF).reshape(B, H, GRID_W, n_loc)
        s_ctx = jnp.einsum('bqhd,bchd->bhqc', q_r, kc).astype(jnp.float32) * scale
        p = jax.nn.softmax(jnp.concatenate([s_loc, s_ctx], axis=-1), axis=-1).astype(v.dtype)
        return (jnp.einsum('bhqs,bshd->bqhd', p[..., :n_loc], v_r)
                + jnp.einsum('bhqc,bchd->bqhd', p[..., n_loc:], vc))

    out = lax.map(row_block, jnp.arange(rows))
    return jnp.moveaxis(out, 0, 1).reshape(B, L, H * Dh)


def context_attention(q, k, v, sink):
    B, Lc, H, Dh = q.shape
    kvh = k.shape[2]
    g = H // kvh
    qg = q.reshape(B, Lc, kvh, g, Dh)
    s = jnp.einsum('bqkgd,bckd->bkgqc', qg, k).astype(jnp.float32) * (HEAD_DIM ** -0.5)
    if sink is not None:
        s_sink = jnp.broadcast_to(sink.astype(jnp.float32).reshape(1, kvh, g, 1, 1), s.shape[:-1] + (1,))
        s = jnp.concatenate([s, s_sink], axis=-1)
    p = jax.nn.softmax(s, axis=-1)[..., :Lc].astype(v.dtype)
    return jnp.einsum('bkgqc,bckd->bqkgd', p, v).reshape(B, Lc, H * Dh)


def merge_branches(y_hy, y_wa, y_na, z_gate, w_branch, w_out):
    g = jax.nn.sigmoid(z_gate.astype(jnp.float32)).astype(z_gate.dtype)
    g_hy, g_wa, g_na = jnp.split(g, N_BRANCH, axis=-1)
    m = g_hy * (y_hy @ w_branch[0]) + g_wa * (y_wa @ w_branch[1]) + g_na * (y_na @ w_branch[2])
    return m @ w_out


def expert_choice_ffn(h, w_router, w_gate, w_up, w_down):
    B, N, D = h.shape
    cap = EC_CAPACITY_FACTOR * N // N_EXPERTS

    def one_set(hs):
        aff = jax.nn.softmax((hs @ w_router).astype(jnp.float32), axis=-1)
        gsel, idx = lax.top_k(aff.T, cap)
        xe = hs[idx]
        a = jnp.einsum('ecd,edf->ecf', xe, w_gate)
        u = jnp.einsum('ecd,edf->ecf', xe, w_up)
        ye = jnp.einsum('ecf,efd->ecd', jax.nn.silu(a) * u, w_down) * gsel[..., None].astype(hs.dtype)
        return jnp.zeros_like(hs).at[idx.reshape(-1)].add(ye.reshape(-1, D))

    return jax.vmap(one_set)(h)


def trunk_layer(x, ctx, c, c_ctx, p, update_ctx):
    L = x.shape[1]
    mx = jnp.split((jax.nn.silu(c) @ p['w_mod'] + p['b_mod'])[:, None, :], N_MOD, axis=-1)
    mc = jnp.split(jax.nn.silu(c_ctx) @ p['w_mod'] + p['b_mod'], N_MOD, axis=-1)
    w_in = p['w_in']
    hx = modulate(rms_norm(x, p['norm1_g']), mx[0], mx[1])
    hc = modulate(rms_norm(ctx, p['norm1_g']), mc[0], mc[1])

    if update_ctx:
        zc = hc @ w_in
        zc_wa_kv = zc[..., OFF_WA_KV:OFF_NA_Q]
        zc_na_kv = zc[..., OFF_NA_KV:OFF_GATE]
    else:
        zc_wa_kv = hc @ w_in[:, OFF_WA_KV:OFF_NA_Q]
        zc_na_kv = hc @ w_in[:, OFF_NA_KV:OFF_GATE]
    kc_wa, vc_wa = keys_values(zc_wa_kv, WA_KV_HEADS, p['wa_k_norm'])
    kc_na, vc_na = keys_values(zc_na_kv, NA_HEADS, p['na_k_norm'])

    zx = hx @ w_in
    cos, sin = axial_rope_tables(L)
    y_hy = hyena_branch(zx[..., OFF_HY:OFF_WA_Q], p)
    q_wa = apply_axial_rope(rms_norm(split_heads(zx[..., OFF_WA_Q:OFF_WA_KV], WA_HEADS), p['wa_q_norm']), cos, sin)
    k_wa, v_wa = keys_values(zx[..., OFF_WA_KV:OFF_NA_Q], WA_KV_HEADS, p['wa_k_norm'])
    k_wa = apply_axial_rope(k_wa, cos, sin)
    y_wa = windowed_gqa_latent(q_wa, k_wa, v_wa, kc_wa, vc_wa, p['wa_sink'])
    q_na = rms_norm(split_heads(zx[..., OFF_NA_Q:OFF_NA_KV], NA_HEADS), p['na_q_norm'])
    k_na, v_na = keys_values(zx[..., OFF_NA_KV:OFF_GATE], NA_HEADS, p['na_k_norm'])
    y_na = neighbourhood_attention_latent(q_na, k_na, v_na, kc_na, vc_na, p['na_rpb'])
    x = x + mx[2] * merge_branches(y_hy, y_wa, y_na, zx[..., OFF_GATE:], p['w_branch'], p['w_out'])
    h2 = modulate(rms_norm(x, p['norm2_g']), mx[3], mx[4])
    x = x + mx[5] * expert_choice_ffn(h2, p['w_router'], p['w_gate'], p['w_up'], p['w_down'])

    if update_ctx:
        yc_hy = hyena_branch(zc[..., OFF_HY:OFF_WA_Q], p)
        qc_wa = rms_norm(split_heads(zc[..., OFF_WA_Q:OFF_WA_KV], WA_HEADS), p['wa_q_norm'])
        yc_wa = context_attention(qc_wa, kc_wa, vc_wa, p['wa_sink'])
        qc_na = rms_norm(split_heads(zc[..., OFF_NA_Q:OFF_NA_KV], NA_HEADS), p['na_q_norm'])
        yc_na = context_attention(qc_na, kc_na, vc_na, None)
        ctx = ctx + mc[2] * merge_branches(yc_hy, yc_wa, yc_na, zc[..., OFF_GATE:], p['w_branch'], p['w_out'])
        hc2 = modulate(rms_norm(ctx, p['norm2_g']), mc[3], mc[4])
        ctx = ctx + mc[5] * expert_choice_ffn(hc2, p['w_router'], p['w_gate'], p['w_up'], p['w_down'])
    return x, ctx


def setup_inputs(seed: int = 0) -> dict:
    key = jax.random.key(seed)
    ks = iter(jax.random.split(key, 40))

    def nrm(shape, scale):
        return jax.random.normal(next(ks), shape, jnp.float32) * scale

    n_filt = HY_DIRS * HY_ORDER * HY_WIDTH
    base_decay = jnp.linspace(math.log(HY_DECAY_TARGET) / HY_DECAY_SHORT_PCT,
                              math.log(HY_DECAY_TARGET) / HY_DECAY_LONG_PCT, HY_WIDTH, dtype=jnp.float32)
    base_decay = jnp.broadcast_to(base_decay, (DEPTH, HY_DIRS, HY_ORDER, HY_WIDTH)).reshape(DEPTH, n_filt)
    return {
        'x': nrm((BATCH, SEQ, D_MODEL), 1.0),
        'c': nrm((BATCH, D_MODEL), 1.0),
        'ctx': nrm((BATCH, CTX_LEN, D_MODEL), 1.0),
        'c_ctx': nrm((D_MODEL,), 1.0),
        'w_mod': nrm((DEPTH, D_MODEL, N_MOD * D_MODEL), D_MODEL ** -0.5),
        'b_mod': nrm((DEPTH, N_MOD * D_MODEL), 0.02),
        'norm1_g': 1.0 + nrm((DEPTH, D_MODEL), 0.02),
        'w_in': nrm((DEPTH, D_MODEL, N_IN), D_MODEL ** -0.5),
        'hy_conv_w': nrm((DEPTH, HY_SHORT_WIDTH, 3 * HY_WIDTH), 0.5),
        'hy_conv_b': nrm((DEPTH, 3 * HY_WIDTH), 0.02),
        'hy_fw1': nrm((DEPTH, HY_EMB, HY_FILTER_HIDDEN), HY_EMB ** -0.5),
        'hy_fb1': nrm((DEPTH, HY_FILTER_HIDDEN), 0.1),
        'hy_fw2': nrm((DEPTH, HY_FILTER_HIDDEN, HY_FILTER_HIDDEN), HY_FILTER_HIDDEN ** -0.5),
        'hy_fb2': nrm((DEPTH, HY_FILTER_HIDDEN), 0.1),
        'hy_fw3': nrm((DEPTH, HY_FILTER_HIDDEN, n_filt), HY_FILTER_HIDDEN ** -0.5),
        'hy_freq': 1.0 + nrm((DEPTH, 2, HY_FILTER_HIDDEN), 0.1),
        'hy_decay': base_decay * (1.0 + nrm((DEPTH, n_filt), 0.05)),
        'hy_d': nrm((DEPTH, HY_ORDER, HY_WIDTH), 0.5),
        'wa_q_norm': 1.0 + nrm((DEPTH, HEAD_DIM), 0.02),
        'wa_k_norm': 1.0 + nrm((DEPTH, HEAD_DIM), 0.02),
        'wa_sink': nrm((DEPTH, WA_HEADS), 0.5),
        'na_q_norm': 1.0 + nrm((DEPTH, HEAD_DIM), 0.02),
        'na_k_norm': 1.0 + nrm((DEPTH, HEAD_DIM), 0.02),
        'na_rpb': nrm((DEPTH, NA_HEADS, 2 * NA_WIN_ROWS - 1, 2 * NA_WIN_COLS - 1), 0.2),
        'w_branch': nrm((DEPTH, N_BRANCH, BRANCH_WIDTH, D_MODEL), BRANCH_WIDTH ** -0.5),
        'w_out': nrm((DEPTH, D_MODEL, D_MODEL), D_MODEL ** -0.5),
        'norm2_g': 1.0 + nrm((DEPTH, D_MODEL), 0.02),
        'w_router': nrm((DEPTH, D_MODEL, N_EXPERTS), D_MODEL ** -0.5),
        'w_gate': nrm((DEPTH, N_EXPERTS, D_MODEL, D_EXPERT), D_MODEL ** -0.5),
        'w_up': nrm((DEPTH, N_EXPERTS, D_MODEL, D_EXPERT), D_MODEL ** -0.5),
        'w_down': nrm((DEPTH, N_EXPERTS, D_EXPERT, D_MODEL), D_EXPERT ** -0.5),
    }


def reference(x, c, ctx, c_ctx, w_mod, b_mod, norm1_g, w_in, hy_conv_w, hy_conv_b, hy_fw1, hy_fb1,
              hy_fw2, hy_fb2, hy_fw3, hy_freq, hy_decay, hy_d, wa_q_norm, wa_k_norm, wa_sink,
              na_q_norm, na_k_norm, na_rpb, w_branch, w_out, norm2_g, w_router, w_gate, w_up, w_down):
    for l in range(DEPTH):
        p = {
            'w_mod': w_mod[l], 'b_mod': b_mod[l], 'norm1_g': norm1_g[l], 'w_in': w_in[l],
            'hy_conv_w': hy_conv_w[l], 'hy_conv_b': hy_conv_b[l], 'hy_fw1': hy_fw1[l], 'hy_fb1': hy_fb1[l],
            'hy_fw2': hy_fw2[l], 'hy_fb2': hy_fb2[l], 'hy_fw3': hy_fw3[l], 'hy_freq': hy_freq[l],
            'hy_decay': hy_decay[l], 'hy_d': hy_d[l], 'wa_q_norm': wa_q_norm[l], 'wa_k_norm': wa_k_norm[l],
            'wa_sink': wa_sink[l], 'na_q_norm': na_q_norm[l], 'na_k_norm': na_k_norm[l], 'na_rpb': na_rpb[l],
            'w_branch': w_branch[l], 'w_out': w_out[l], 'norm2_g': norm2_g[l], 'w_router': w_router[l],
            'w_gate': w_gate[l], 'w_up': w_up[l], 'w_down': w_down[l],
        }
        x, ctx = trunk_layer(x, ctx, c, c_ctx, p, l < DEPTH - 1)
    return x
```

```cpp
#include <hip/hip_runtime.h>
#include <stdint.h>
#include <stdio.h>

#ifndef ONE_LAUNCH
#define ONE_LAUNCH 1
#endif

typedef unsigned short bf16_t;
#define LAS __attribute__((address_space(3)))

constexpr int L = 16384, LC = 256, MR = L + LC, D = 2048, NIN = 13824;
constexpr int HD = 128, GRIDW = 64;
constexpr int OFF_HY = 0, OFF_WAQ = 3072, OFF_WAKV = 4096, OFF_NAQ = 4608, OFF_NAKV = 5632, OFF_GATE = 7680;
constexpr int NE = 16, CAP = 2048, CAPC = 32, SLOTS = 2304, DF = 1024;
constexpr int NMOD = 6 * D;
constexpr float RMS_EPS = 1e-6f;
constexpr float QK_SCALE = 0.08838834764831845f;

constexpr size_t al256(size_t x) { return (x + 255) & ~(size_t)255; }
constexpr size_t WS_CTL = 0, CTL_BYTES = 1u << 20;
constexpr size_t WS_MOD = WS_CTL + CTL_BYTES;
constexpr size_t WS_H2F = WS_MOD + al256((size_t)2 * 2 * NMOD * 4);
constexpr size_t WS_AFF = WS_H2F + al256((size_t)2 * MR * 64 * 4);
constexpr size_t WS_IDX = WS_AFF + al256((size_t)MR * 16 * 4);
constexpr size_t WS_GSEL = WS_IDX + al256((size_t)NE * SLOTS * 4);
constexpr size_t WS_SLOT = WS_GSEL + al256((size_t)NE * SLOTS * 4);
constexpr size_t WS_KFC = WS_SLOT + al256((size_t)NE * MR * 4);
constexpr size_t WS_ZHYC = WS_KFC + al256((size_t)4096 * LC * 2);
constexpr size_t WS_XA = WS_ZHYC + al256((size_t)3072 * LC * 2);
constexpr size_t WS_XB = WS_XA + al256((size_t)MR * D * 4);
constexpr size_t WS_W = WS_XB + al256((size_t)MR * D * 4);
constexpr size_t W_BYTES = (size_t)2 * ((size_t)NIN * D + 3 * (size_t)D * 1024 + (size_t)D * D + (size_t)NE * 2048 * D + (size_t)NE * D * DF);
constexpr size_t WS_R3 = WS_W + al256(W_BYTES);
constexpr size_t R3_BYTES = (size_t)MR * D * 4 + (size_t)MR * D * 2;
constexpr size_t WS_KF = WS_R3;
constexpr size_t WS_MPART = WS_R3;
constexpr size_t WS_MB = WS_R3 + (size_t)MR * D * 4;
constexpr size_t WS_TMP = WS_R3;
constexpr size_t WS_YE = WS_R3;
constexpr size_t WS_R4 = WS_R3 + al256(R3_BYTES);
constexpr size_t R4_BYTES = (size_t)MR * 6144 * 2;
constexpr size_t WS_GATE = WS_R4;
constexpr size_t WS_H2 = WS_R4;
constexpr size_t WS_ACT = WS_R4 + al256((size_t)MR * D * 2);
constexpr size_t WS_R5 = WS_R4 + al256(R4_BYTES);
constexpr size_t WS_HX = WS_R5;
constexpr size_t WS_YHYT = WS_R5;
constexpr size_t WS_YHY = WS_R5 + al256((size_t)1024 * L * 2);
constexpr size_t WS_ZHYT = WS_R5 + al256((size_t)MR * D * 2);
constexpr size_t WS_QWA = WS_ZHYT + al256((size_t)3072 * L * 2);
constexpr size_t WS_KVWA = WS_QWA + al256((size_t)MR * 1024 * 2);
constexpr size_t WS_QNA = WS_KVWA + al256((size_t)MR * 512 * 2);
constexpr size_t WS_KVNA = WS_QNA + al256((size_t)MR * 1024 * 2);
constexpr size_t WS_YWA = WS_KVNA + al256((size_t)MR * 2048 * 2);
constexpr size_t WS_YNA = WS_YWA + al256((size_t)MR * 1024 * 2);
constexpr size_t WS_END = WS_YNA + al256((size_t)MR * 1024 * 2);
static_assert((size_t)1024 * L * 2 + (size_t)MR * 1024 * 2 <= (size_t)MR * D * 2 + 512, "YHYT+YHY overlay HX");
static_assert((size_t)4096 * L * 2 <= R3_BYTES && (size_t)NE * SLOTS * D * 2 <= R3_BYTES && (size_t)NE * SLOTS * DF * 4 <= R3_BYTES, "R3");
static_assert((size_t)MR * D * 2 + 256 + (size_t)NE * SLOTS * DF * 2 <= R4_BYTES, "R4");

constexpr int LDS_BYTES = 160 * 1024;
constexpr int NTHREADS = 512;
constexpr int PH_PER_LAYER = 12, NPH = 1 + 2 * PH_PER_LAYER;

__device__ __forceinline__ float bf2f(bf16_t b) { return __uint_as_float(((unsigned)b) << 16); }
__device__ __forceinline__ bf16_t f2bf(float f) { unsigned u = __float_as_uint(f); u += 0x7fffu + ((u >> 16) & 1u); return (bf16_t)(u >> 16); }
__device__ __forceinline__ unsigned pk2(float lo, float hi) { return (unsigned)f2bf(lo) | ((unsigned)f2bf(hi) << 16); }
__device__ __forceinline__ float wave_sum(float v) {
#pragma unroll
    for (int o = 1; o < 64; o <<= 1) v += __shfl_xor(v, o);
    return v;
}
__device__ __forceinline__ float wave_max(float v) {
#pragma unroll
    for (int o = 1; o < 64; o <<= 1) v = fmaxf(v, __shfl_xor(v, o));
    return v;
}
__device__ __forceinline__ float silu_f(float x) { return x / (1.f + __expf(-x)); }
__device__ __forceinline__ float sigmoid_f(float x) { return 1.f / (1.f + __expf(-x)); }
#define LDS_FENCE() asm volatile("s_waitcnt lgkmcnt(0)" ::: "memory")

#define XB_TMO      128
#define XB_XCNT(j)  (256  + 64 * (j))
#define XB_XSUB(j)  (1280 + 64 * (j))
#define XB_XGEN(j)  (2304 + 64 * (j))
#define XB_TOP      3328
#define XB_TOPGEN   3392
#define XCD_BAR_WORDS 3456
#define XB_SPIN_CAP (1u << 22)

__device__ __forceinline__ unsigned xb_ld(unsigned* p)              { return __hip_atomic_load(p, __ATOMIC_RELAXED, __HIP_MEMORY_SCOPE_AGENT); }
__device__ __forceinline__ unsigned xb_add(unsigned* p, unsigned v) { return __hip_atomic_fetch_add(p, v, __ATOMIC_RELAXED, __HIP_MEMORY_SCOPE_AGENT); }
__device__ __forceinline__ unsigned xb_xcc_id() { return (unsigned)__builtin_amdgcn_s_getreg((3 << 11) | 20) & 0xFu; }
#define XB_SPIN(cond, bar) do { unsigned _sp = 0; while (cond) { __builtin_amdgcn_s_sleep(1); \
    if ((++_sp & 255u) == 0u) { if (xb_ld(&(bar)[XB_TMO])) break; if (_sp > XB_SPIN_CAP) { atomicAdd(&(bar)[XB_TMO], 1u); break; } } } } while (0)

struct XcdBarrier { unsigned* bar; unsigned x; volatile LAS unsigned* st; };

__device__ __forceinline__ XcdBarrier xcd_barrier_post(unsigned* bar, volatile LAS unsigned* st) {
    XcdBarrier b; b.bar = bar; b.x = xb_xcc_id(); b.st = st;
    if (threadIdx.x == 0) (void)xb_add(&bar[XB_XCNT(b.x)], 1u);
    return b;
}
__device__ __forceinline__ void xcd_barrier_complete(unsigned* bar, unsigned x, unsigned& nloc, unsigned& nx) {
    const unsigned G = gridDim.x * gridDim.y * gridDim.z;
    unsigned sum, cnt, mine, sp = 0u;
    for (;;) {
        sum = 0u; cnt = 0u; mine = 0u;
#pragma unroll
        for (unsigned j = 0; j < 16; ++j) { const unsigned c = xb_ld(&bar[XB_XCNT(j)]); sum += c; cnt += (c > 0u) ? 1u : 0u; mine = (j == x) ? c : mine; }
        if (sum == G) break;
        __builtin_amdgcn_s_sleep(1);
        if ((++sp & 255u) == 0u) { if (xb_ld(&bar[XB_TMO])) break; if (sp > XB_SPIN_CAP) { atomicAdd(&bar[XB_TMO], 1u); break; } }
    }
    nloc = mine > 0u ? mine : 1u; nx = cnt > 0u ? cnt : 1u;
}
__device__ __forceinline__ void xcd_barrier(const XcdBarrier& b) {
    asm volatile("s_waitcnt vmcnt(0)" ::: "memory");
    __syncthreads();
    if (threadIdx.x == 0) {
        unsigned* bar = b.bar;
        __builtin_amdgcn_s_waitcnt(0);
        unsigned nloc = b.st[0], nx = b.st[1];
        if (nloc == 0u) { xcd_barrier_complete(bar, b.x, nloc, nx); b.st[0] = nloc; b.st[1] = nx; }
        const unsigned old = xb_add(&bar[XB_XSUB(b.x)], 1u);
        const unsigned gen = old / nloc;
        if (old + 1u == (gen + 1u) * nloc) {
            __builtin_amdgcn_fence(__ATOMIC_RELEASE, "agent");
            asm volatile("s_waitcnt vmcnt(0)" ::: "memory");
            const unsigned og = xb_add(&bar[XB_TOP], 1u);
            const unsigned tg = og / nx;
            if (og + 1u == (tg + 1u) * nx) xb_add(&bar[XB_TOPGEN], 1u);
            else XB_SPIN(xb_ld(&bar[XB_TOPGEN]) == tg, bar);
            __builtin_amdgcn_fence(__ATOMIC_ACQUIRE, "agent");
            xb_add(&bar[XB_XGEN(b.x)], 1u);
            asm volatile("s_waitcnt vmcnt(0)" ::: "memory");
        } else {
            XB_SPIN(xb_ld(&bar[XB_XGEN(b.x)]) == gen, bar);
            __builtin_amdgcn_fence(__ATOMIC_ACQUIRE, "agent");
            asm volatile("s_waitcnt vmcnt(0)" ::: "memory");
        }
    }
    __syncthreads();
}

struct KArgs { const float* in[31]; float* out; unsigned char* ws; int ph_lo, ph_hi; };

struct Ctx {
    const float* const* in; float* out; unsigned char* ws;
    int bid, nb, tid, lane, wave;
    unsigned char* smem;
    template <class T> __device__ __forceinline__ T* wsp(size_t off) const { return (T*)(ws + off); }
    __device__ __forceinline__ const float* mod(int layer, int src, int chunk) const { return wsp<float>(WS_MOD) + ((size_t)(layer * 2 + src) * NMOD) + chunk * D; }
    __device__ __forceinline__ const float* xrow(int layer, int r) const {
        if (layer == 0) return r < L ? in[0] + (size_t)r * D : in[2] + (size_t)(r - L) * D;
        return wsp<float>(WS_XB) + (size_t)r * D;
    }
};

template <class RowPtr, class Epi>
__device__ __forceinline__ void sgemm_unit(const RowPtr& rp, const float* __restrict__ W, int ldw, int K, int m0, int n0, const Epi& ep, float* lds, int tid) {
    float* As = lds;
    float* Bs = lds + 16 * 132;
    const int ty = tid >> 4, tx = tid & 15;
    const int am = tid >> 2, kq = (tid & 3) * 4;
    const int bk = tid >> 5, n4 = (tid & 31) * 4;
    float acc[4][8];
#pragma unroll
    for (int i = 0; i < 4; ++i)
#pragma unroll
        for (int j = 0; j < 8; ++j) acc[i][j] = 0.f;
    const bf16_t* arow = rp(m0 + am);
    const float* wp = W + (size_t)bk * ldw + n0 + n4;
    for (int k0 = 0; k0 < K; k0 += 16) {
        const uint2 a4 = *(const uint2*)(arow + k0 + kq);
        const float4 b4 = *(const float4*)(wp + (size_t)k0 * ldw);
        __syncthreads();
        As[(kq + 0) * 132 + am] = __uint_as_float(a4.x << 16);
        As[(kq + 1) * 132 + am] = __uint_as_float(a4.x & 0xffff0000u);
        As[(kq + 2) * 132 + am] = __uint_as_float(a4.y << 16);
        As[(kq + 3) * 132 + am] = __uint_as_float(a4.y & 0xffff0000u);
        *(float4*)&Bs[bk * 128 + n4] = b4;
        __syncthreads();
#pragma unroll
        for (int kk = 0; kk < 16; ++kk) {
            const float4 a = *(const float4*)&As[kk * 132 + ty * 4];
            const float4 b0 = *(const float4*)&Bs[kk * 128 + tx * 8];
            const float4 b1 = *(const float4*)&Bs[kk * 128 + tx * 8 + 4];
            const float av[4] = {a.x, a.y, a.z, a.w};
            const float bv[8] = {b0.x, b0.y, b0.z, b0.w, b1.x, b1.y, b1.z, b1.w};
#pragma unroll
            for (int i = 0; i < 4; ++i)
#pragma unroll
                for (int j = 0; j < 8; ++j) acc[i][j] = fmaf(av[i], bv[j], acc[i][j]);
        }
    }
#pragma unroll
    for (int i = 0; i < 4; ++i) ep(m0 + ty * 4 + i, n0 + tx * 8, acc[i]);
}

struct RowLin { const bf16_t* base; int ld; __device__ __forceinline__ const bf16_t* operator()(int m) const { return base + (size_t)m * ld; } };
struct RowGather { const bf16_t* base; int ld; const int* idx; __device__ __forceinline__ const bf16_t* operator()(int m) const { return base + (size_t)idx[m] * ld; } };

__device__ __forceinline__ void ph_g0(const Ctx& c) {
    float* lds = (float*)c.smem;
    for (int u = c.bid; u < 2 * 256; u += c.nb) {
        const int layer = u >> 8, n0 = (u & 255) * 48;
        __syncthreads();
        for (int k = c.tid; k < D; k += NTHREADS) { lds[k] = silu_f(c.in[1][k]); lds[D + k] = silu_f(c.in[3][k]); }
        __syncthreads();
        const int col = c.tid % 48, kg = c.tid / 48;
        float a0 = 0.f, a1 = 0.f;
        if (kg < 10) {
            const float* w = c.in[4] + (size_t)layer * D * NMOD + n0 + col;
            for (int k = kg; k < D; k += 10) { const float wv = w[(size_t)k * NMOD]; a0 = fmaf(lds[k], wv, a0); a1 = fmaf(lds[D + k], wv, a1); }
        }
        float* red = lds + 2 * D;
        if (kg < 10) { red[(kg * 48 + col) * 2] = a0; red[(kg * 48 + col) * 2 + 1] = a1; }
        __syncthreads();
        if (c.tid < 96) {
            const int cc = c.tid >> 1, s = c.tid & 1; float t = 0.f;
            for (int g = 0; g < 10; ++g) t += red[(g * 48 + cc) * 2 + s];
            t += c.in[5][(size_t)layer * NMOD + n0 + cc];
            c.wsp<float>(WS_MOD)[(size_t)(layer * 2 + s) * NMOD + n0 + cc] = t;
        }
    }
    const int gw = c.bid * 8 + c.wave, ngw = c.nb * 8;
    for (int task = gw; task < 2 * MR; task += ngw) {
        const int layer = task / MR, pos = task % MR;
        const bool isc = pos >= L; const int i = isc ? pos - L : pos; const int Lx = isc ? LC : L;
        const float tt = (float)i * (1.0f / (float)(Lx - 1));
        const float c0 = (float)(2.0 * 3.14159265358979323846 / (double)Lx);
        const int j = c.lane;
        float feat = 0.f;
        if (j == 0) feat = tt;
        else if (j < 33) { const int b = (j - 1) & 15; const float band = 1e-4f + (float)b * ((15.0f - 1e-4f) / 15.0f); const float ang = (c0 * band) * (float)i; feat = (j <= 16) ? cosf(ang) : -sinf(ang); }
        const float* fw1 = c.in[10] + (size_t)layer * 33 * 64; const float* fb1 = c.in[11] + layer * 64;
        const float* fw2 = c.in[12] + (size_t)layer * 64 * 64; const float* fb2 = c.in[13] + layer * 64;
        const float* fr = c.in[15] + layer * 128;
        float s = fb1[j];
        for (int f = 0; f < 33; ++f) s = fmaf(__shfl(feat, f), fw1[f * 64 + j], s);
        const float h1 = sinf(fr[j] * s);
        float s2 = fb2[j];
        for (int m = 0; m < 64; ++m) s2 = fmaf(__shfl(h1, m), fw2[m * 64 + j], s2);
        const float h2 = sinf(fr[64 + j] * s2);
        c.wsp<float>(WS_H2F)[((size_t)layer * MR + pos) * 64 + j] = h2;
    }
}

__device__ __forceinline__ void ph_a(const Ctx& c, int layer) {
    const int gw = c.bid * 8 + c.wave, ngw = c.nb * 8;
    const float* g = c.in[6] + (size_t)layer * D;
    for (int r = gw; r < MR; r += ngw) {
        const float* x = c.xrow(layer, r);
        const int src = r < L ? 0 : 1;
        const float* sh = c.mod(layer, src, 0); const float* sc = c.mod(layer, src, 1);
        float4 v[8]; float ss = 0.f;
#pragma unroll
        for (int j = 0; j < 8; ++j) { v[j] = *(const float4*)(x + 4 * c.lane + 256 * j); ss += v[j].x * v[j].x + v[j].y * v[j].y + v[j].z * v[j].z + v[j].w * v[j].w; }
        ss = wave_sum(ss);
        const float inv = rsqrtf(ss * (1.0f / D) + RMS_EPS);
        bf16_t* o = c.wsp<bf16_t>(WS_HX) + (size_t)r * D;
#pragma unroll
        for (int j = 0; j < 8; ++j) {
            const int col = 4 * c.lane + 256 * j;
            const float4 gg = *(const float4*)(g + col), s4 = *(const float4*)(sh + col), c4 = *(const float4*)(sc + col);
            const float y0 = v[j].x * inv * gg.x * (1.f + c4.x) + s4.x, y1 = v[j].y * inv * gg.y * (1.f + c4.y) + s4.y;
            const float y2 = v[j].z * inv * gg.z * (1.f + c4.z) + s4.z, y3 = v[j].w * inv * gg.w * (1.f + c4.w) + s4.w;
            uint2 w; w.x = pk2(y0, y1); w.y = pk2(y2, y3);
            *(uint2*)(o + col) = w;
        }
    }
    float* hs = (float*)c.smem;
    const float* fw3 = c.in[14] + (size_t)layer * 64 * 4096;
    const float* dec = c.in[16] + (size_t)layer * 4096;
    for (int u = c.bid; u < 260; u += c.nb) {
        const bool isc = u >= 256; const int p0 = isc ? (u - 256) * 64 : u * 64; const int Lx = isc ? LC : L;
        __syncthreads();
        const float* h2f = c.wsp<float>(WS_H2F) + ((size_t)layer * MR + (isc ? L : 0) + p0) * 64;
        for (int e = c.tid; e < 64 * 64; e += NTHREADS) hs[e] = h2f[e];
        __syncthreads();
        for (int cb = 0; cb < 8; ++cb) {
            const int col = cb * 512 + c.tid;
            float w[64];
#pragma unroll
            for (int j = 0; j < 64; ++j) w[j] = fw3[j * 4096 + col];
            const float rate = fabsf(dec[col]);
            bf16_t* dst = isc ? c.wsp<bf16_t>(WS_KFC) + (size_t)col * LC + p0 : c.wsp<bf16_t>(WS_KF) + (size_t)col * L + p0;
#pragma unroll 1
            for (int p = 0; p < 64; p += 2) {
                float s0 = 0.f, s1 = 0.f;
#pragma unroll
                for (int j = 0; j < 64; j += 4) {
                    const float4 h4 = *(const float4*)&hs[p * 64 + j]; const float4 g4 = *(const float4*)&hs[(p + 1) * 64 + j];
                    s0 = fmaf(h4.x, w[j], s0); s0 = fmaf(h4.y, w[j + 1], s0); s0 = fmaf(h4.z, w[j + 2], s0); s0 = fmaf(h4.w, w[j + 3], s0);
                    s1 = fmaf(g4.x, w[j], s1); s1 = fmaf(g4.y, w[j + 1], s1); s1 = fmaf(g4.z, w[j + 2], s1); s1 = fmaf(g4.w, w[j + 3], s1);
                }
                const float t0 = (float)(p0 + p) * (1.0f / (float)(Lx - 1)), t1 = (float)(p0 + p + 1) * (1.0f / (float)(Lx - 1));
                *(unsigned*)(dst + p) = pk2(s0 * (__expf(-t0 * rate) + 0.05f), s1 * (__expf(-t1 * rate) + 0.05f));
            }
        }
    }
}

struct EpiIn {
    unsigned char* ws;
    __device__ __forceinline__ void operator()(int row, int col, const float (&v)[8]) const {
        if (col < OFF_WAQ) {
            if (row < L) { bf16_t* d = (bf16_t*)(ws + WS_ZHYT);
#pragma unroll
                for (int j = 0; j < 8; ++j) d[(size_t)(col + j) * L + row] = f2bf(v[j]); }
            else { bf16_t* d = (bf16_t*)(ws + WS_ZHYC);
#pragma unroll
                for (int j = 0; j < 8; ++j) d[(size_t)(col + j) * LC + (row - L)] = f2bf(v[j]); }
            return;
        }
        bf16_t* dst; float t[8];
#pragma unroll
        for (int j = 0; j < 8; ++j) t[j] = v[j];
        if (col < OFF_WAKV) dst = (bf16_t*)(ws + WS_QWA) + (size_t)row * 1024 + (col - OFF_WAQ);
        else if (col < OFF_NAQ) dst = (bf16_t*)(ws + WS_KVWA) + (size_t)row * 512 + (col - OFF_WAKV);
        else if (col < OFF_NAKV) dst = (bf16_t*)(ws + WS_QNA) + (size_t)row * 1024 + (col - OFF_NAQ);
        else if (col < OFF_GATE) dst = (bf16_t*)(ws + WS_KVNA) + (size_t)row * 2048 + (col - OFF_NAKV);
        else { dst = (bf16_t*)(ws + WS_GATE) + (size_t)row * 6144 + (col - OFF_GATE);
#pragma unroll
            for (int j = 0; j < 8; ++j) t[j] = sigmoid_f(t[j]); }
        uint4 o; o.x = pk2(t[0], t[1]); o.y = pk2(t[2], t[3]); o.z = pk2(t[4], t[5]); o.w = pk2(t[6], t[7]);
        *(uint4*)dst = o;
    }
};
__device__ __forceinline__ void ph_b(const Ctx& c, int layer) {
    const RowLin rp{c.wsp<bf16_t>(WS_HX), D};
    const EpiIn ep{c.ws};
    const float* W = c.in[7] + (size_t)layer * D * NIN;
    const int nM = MR / 128, nN = NIN / 128;
    for (int u = c.bid; u < nM * nN; u += c.nb) {
        const int pm = u % nM, pn = u / nM;
        sgemm_unit(rp, W, NIN, D, pm * 128, pn * 128, ep, (float*)c.smem, c.tid);
    }
}

__device__ __forceinline__ void ph_b2(const Ctx& c, int layer) {
    const int gw = c.bid * 8 + c.wave, ngw = c.nb * 8;
    const int lane = c.lane;
    const int dlo = lane < 32 ? lane : lane + 32, dhi = dlo + 32;
    const int f = lane & 31, ax = lane >> 5;
    const float invf = powf(10000.0f, -(float)f / 32.0f);
    for (int task = gw; task < MR * 26; task += ngw) {
        const int r = task / 26, s = task % 26;
        bf16_t* p; const float* gain; bool rope;
        if (s < 8) { p = c.wsp<bf16_t>(WS_QWA) + (size_t)r * 1024 + s * 128; gain = c.in[18] + layer * 128; rope = true; }
        else if (s < 10) { p = c.wsp<bf16_t>(WS_KVWA) + (size_t)r * 512 + (s - 8) * 128; gain = c.in[19] + layer * 128; rope = true; }
        else if (s < 18) { p = c.wsp<bf16_t>(WS_QNA) + (size_t)r * 1024 + (s - 10) * 128; gain = c.in[21] + layer * 128; rope = false; }
        else { p = c.wsp<bf16_t>(WS_KVNA) + (size_t)r * 2048 + (s - 18) * 128; gain = c.in[22] + layer * 128; rope = false; }
        float a = bf2f(p[dlo]), b = bf2f(p[dhi]);
        const float ss = wave_sum(a * a + b * b);
        const float inv = rsqrtf(ss * (1.0f / 128.0f) + RMS_EPS);
        a = a * inv * gain[dlo]; b = b * inv * gain[dhi];
        if (rope && r < L) {
            const float pos = ax == 0 ? (float)(r / GRIDW) : (float)(r % GRIDW);
            const float ang = pos * invf; const float cs = cosf(ang), sn = sinf(ang);
            const float na = a * cs - b * sn, nb2 = b * cs + a * sn; a = na; b = nb2;
        }
        p[dlo] = f2bf(a); p[dhi] = f2bf(b);
    }
}

__device__ __forceinline__ float shortconv_at(const bf16_t* z, int t, int Lx, float w0, float w1, float w2, float b) {
    const float zm = t > 0 ? bf2f(z[t - 1]) : 0.f, z0 = bf2f(z[t]), zp = t + 1 < Lx ? bf2f(z[t + 1]) : 0.f;
    return zm * w0 + z0 * w1 + zp * w2 + b;
}
__device__ __forceinline__ float block_sum(float v, float* red, int tid) {
    v = wave_sum(v);
    __syncthreads();
    if ((tid & 63) == 0) red[tid >> 6] = v;
    __syncthreads();
    float t = 0.f;
#pragma unroll
    for (int w = 0; w < 8; ++w) t += red[w];
    return t;
}
__device__ __forceinline__ void hyena_direct_unit(const Ctx& c, int layer, int ch) {
    bf16_t* kc = (bf16_t*)c.smem;
    float* cv = (float*)c.smem;
    float* us = (float*)(c.smem + 4 * L);
    float* red = us + L;
    const int tid = c.tid;
    const float* cw = c.in[8] + (size_t)layer * 3 * 3072; const float* cb = c.in[9] + (size_t)layer * 3072;
    const bf16_t* zv = c.wsp<bf16_t>(WS_ZHYT) + (size_t)ch * L;
    const bf16_t* z1 = c.wsp<bf16_t>(WS_ZHYT) + (size_t)(1024 + ch) * L;
    const bf16_t* z2 = c.wsp<bf16_t>(WS_ZHYT) + (size_t)(2048 + ch) * L;
    const bf16_t* KF = c.wsp<bf16_t>(WS_KF);
    __syncthreads();
    { const float w0 = cw[ch], w1 = cw[3072 + ch], w2 = cw[6144 + ch], b = cb[ch];
#pragma unroll 2
      for (int t = tid; t < L; t += NTHREADS) us[t] = shortconv_at(zv, t, L, w0, w1, w2, b); }
    for (int o = 0; o < 2; ++o) {
        const bf16_t* hf = KF + (size_t)(o * 1024 + ch) * L;
        const bf16_t* hb = KF + (size_t)(2048 + o * 1024 + ch) * L;
        float sabs = 0.f;
#pragma unroll 2
        for (int t = tid; t < L; t += NTHREADS) {
            bf16_t kf = hf[t], kb = hb[t];
            if (t == 0) { kf = f2bf(bf2f(kf) + bf2f(kb)); kb = 0; }
            kc[L + t] = kf; kc[L - t] = (t == 0) ? kf : kb;
            sabs += fabsf(bf2f(kf)) + fabsf(bf2f(kb));
        }
        if (tid == 0) kc[0] = 0;
        const float S = block_sum(sabs, red, tid);
        {
            float acc[32];
#pragma unroll
            for (int j = 0; j < 32; ++j) acc[j] = 0.f;
#pragma unroll 2
            for (int s = 0; s < L; ++s) {
                const float uv = us[s];
                const bf16_t* kp = kc + (L + tid - s);
#pragma unroll
                for (int j = 0; j < 32; ++j) acc[j] = fmaf(uv, bf2f(kp[512 * j]), acc[j]);
            }
            __syncthreads();
#pragma unroll
            for (int j = 0; j < 32; ++j) cv[tid + 512 * j] = acc[j];
        }
        LDS_FENCE();
        const float invS = 1.0f / S;
        const float dsk = c.in[17][(size_t)layer * 2048 + o * 1024 + ch];
        const int co = o == 0 ? 1024 : 2048;
        const bf16_t* zz = o == 0 ? z1 : z2;
        const float w0 = cw[co + ch], w1 = cw[3072 + co + ch], w2 = cw[6144 + co + ch], b = cb[co + ch];
        bf16_t* dst = c.wsp<bf16_t>(WS_YHYT) + (size_t)ch * L;
#pragma unroll 2
        for (int t = tid; t < L; t += NTHREADS) {
            const float r = shortconv_at(zz, t, L, w0, w1, w2, b) * (cv[t] * invS + us[t] * dsk);
            if (o == 0) us[t] = r; else dst[t] = f2bf(r);
        }
        __syncthreads();
    }
}
__device__ __forceinline__ void hyena_ctx_unit(const Ctx& c, int layer, int ch) {
    float* kc = (float*)c.smem;
    float* us = kc + 512;
    float* red = us + 256;
    const int tid = c.tid;
    const float* cw = c.in[8] + (size_t)layer * 3 * 3072; const float* cb = c.in[9] + (size_t)layer * 3072;
    const bf16_t* zv = c.wsp<bf16_t>(WS_ZHYC) + (size_t)ch * LC;
    const bf16_t* z1 = c.wsp<bf16_t>(WS_ZHYC) + (size_t)(1024 + ch) * LC;
    const bf16_t* z2 = c.wsp<bf16_t>(WS_ZHYC) + (size_t)(2048 + ch) * LC;
    const bf16_t* KF = c.wsp<bf16_t>(WS_KFC);
    __syncthreads();
    if (tid < LC) us[tid] = shortconv_at(zv, tid, LC, cw[ch], cw[3072 + ch], cw[6144 + ch], cb[ch]);
    for (int o = 0; o < 2; ++o) {
        const bf16_t* hf = KF + (size_t)(o * 1024 + ch) * LC;
        const bf16_t* hb = KF + (size_t)(2048 + o * 1024 + ch) * LC;
        float sabs = 0.f;
        {
            const int lag = tid - 256; float k;
            if (lag == 0) k = bf2f(hf[0]) + bf2f(hb[0]); else if (lag > 0) k = bf2f(hf[lag]); else if (lag > -256) k = bf2f(hb[-lag]); else k = 0.f;
            kc[tid] = k; sabs = fabsf(k);
        }
        const float S = block_sum(sabs, red, tid);
        float acc = 0.f;
        if (tid < LC) for (int s = 0; s < LC; ++s) acc = fmaf(us[s], kc[256 + tid - s], acc);
        const float dsk = c.in[17][(size_t)layer * 2048 + o * 1024 + ch];
        float res = 0.f;
        if (tid < LC) {
            const bf16_t* zz = o == 0 ? z1 : z2; const int co = o == 0 ? 1024 : 2048;
            res = shortconv_at(zz, tid, LC, cw[co + ch], cw[3072 + co + ch], cw[6144 + co + ch], cb[co + ch]) * (acc / S + us[tid] * dsk);
        }
        __syncthreads();
        if (tid < LC) { if (o == 0) us[tid] = res; else c.wsp<bf16_t>(WS_YHY)[(size_t)(L + tid) * 1024 + ch] = f2bf(res); }
        __syncthreads();
    }
}

template <class KeyFn>
__device__ __forceinline__ void wave_attn(const bf16_t* q, int nkeys, const KeyFn& key, bool has_sink, float sink, bf16_t* out, float* wl, int lane) {
    float* qf = wl;
    float* sc = wl + 128;
    qf[2 * lane] = bf2f(q[2 * lane]); qf[2 * lane + 1] = bf2f(q[2 * lane + 1]);
    LDS_FENCE();
    float mx = -3.0e38f;
    for (int j = lane; j < nkeys; j += 64) {
        const bf16_t* kp; const bf16_t* vp; float bias;
        float s = -1e30f;
        if (key(j, kp, vp, bias)) {
            float d = 0.f;
#pragma unroll
            for (int e = 0; e < 128; e += 8) {
                const uint4 kk = *(const uint4*)(kp + e);
                d = fmaf(qf[e + 0], __uint_as_float(kk.x << 16), d); d = fmaf(qf[e + 1], __uint_as_float(kk.x & 0xffff0000u), d);
                d = fmaf(qf[e + 2], __uint_as_float(kk.y << 16), d); d = fmaf(qf[e + 3], __uint_as_float(kk.y & 0xffff0000u), d);
                d = fmaf(qf[e + 4], __uint_as_float(kk.z << 16), d); d = fmaf(qf[e + 5], __uint_as_float(kk.z & 0xffff0000u), d);
                d = fmaf(qf[e + 6], __uint_as_float(kk.w << 16), d); d = fmaf(qf[e + 7], __uint_as_float(kk.w & 0xffff0000u), d);
            }
            s = d * QK_SCALE + bias;
        }
        sc[j] = s; mx = fmaxf(mx, s);
    }
    if (has_sink) mx = fmaxf(mx, sink);
    mx = wave_max(mx);
    float sum = 0.f;
    for (int j = lane; j < nkeys; j += 64) { const float p = __expf(sc[j] - mx); sc[j] = p; sum += p; }
    sum = wave_sum(sum);
    if (has_sink) sum += __expf(sink - mx);
    LDS_FENCE();
    float o0 = 0.f, o1 = 0.f;
    for (int j = 0; j < nkeys; ++j) {
        const float p = sc[j];
        if (p != 0.f) {
            const bf16_t* kp; const bf16_t* vp; float bias;
            key(j, kp, vp, bias);
            const unsigned vv = *(const unsigned*)(vp + 2 * lane);
            o0 = fmaf(p, __uint_as_float(vv << 16), o0); o1 = fmaf(p, __uint_as_float(vv & 0xffff0000u), o1);
        }
    }
    const float inv = 1.0f / sum;
    *(unsigned*)(out + 2 * lane) = pk2(o0 * inv, o1 * inv);
    LDS_FENCE();
}

struct KeyWA {
    const bf16_t* kv; int t, kvh;
    __device__ __forceinline__ bool operator()(int j, const bf16_t*& kp, const bf16_t*& vp, float& bias) const {
        bias = 0.f;
        int row; bool ok = true;
        if (j < 257) { const int kpos = t - 128 + j; ok = kpos >= 0 && kpos < L; row = ok ? kpos : 0; } else row = L + (j - 257);
        kp = kv + (size_t)row * 512 + kvh * 128; vp = kp + 256; return ok;
    }
};
struct KeyCtxWA { const bf16_t* kv; int kvh;
    __device__ __forceinline__ bool operator()(int j, const bf16_t*& kp, const bf16_t*& vp, float& bias) const { bias = 0.f; kp = kv + (size_t)(L + j) * 512 + kvh * 128; vp = kp + 256; return true; } };
struct KeyNA {
    const bf16_t* kv; const float* rpb; int r, qc, r0, cs, h;
    __device__ __forceinline__ bool operator()(int j, const bf16_t*& kp, const bf16_t*& vp, float& bias) const {
        int row;
        if (j < 128) { const int w = j >> 4, kc = cs + (j & 15); row = (r0 + w) * GRIDW + kc;
            const int dr = r0 + w - r + 7; int dc = kc - qc + 15; dc = dc < 0 ? 0 : (dc > 30 ? 30 : dc);
            bias = rpb[(h * 15 + dr) * 31 + dc]; }
        else { row = L + (j - 128); bias = 0.f; }
        kp = kv + (size_t)row * 2048 + h * 128; vp = kp + 1024; return true;
    }
};
struct KeyCtxNA { const bf16_t* kv; int h;
    __device__ __forceinline__ bool operator()(int j, const bf16_t*& kp, const bf16_t*& vp, float& bias) const { bias = 0.f; kp = kv + (size_t)(L + j) * 2048 + h * 128; vp = kp + 1024; return true; } };

__device__ __forceinline__ void ph_c(const Ctx& c, int layer) {
#ifndef NO_HY
    for (int u = c.bid; u < 1024; u += c.nb) hyena_direct_unit(c, layer, u);
#endif
#ifndef NO_HYC
    if (layer == 0) for (int u = c.bid; u < 1024; u += c.nb) hyena_ctx_unit(c, layer, u);
#endif
    __syncthreads();
#ifndef NO_ATT
    const int gw = c.bid * 8 + c.wave, ngw = c.nb * 8;
    float* wl = (float*)c.smem + c.wave * 768;
    const int nrows = layer == 0 ? MR : L;
    const float* sinkp = c.in[20] + layer * 8;
    const float* rpb = c.in[23] + (size_t)layer * 8 * 15 * 31;
    const bf16_t* kvwa = c.wsp<bf16_t>(WS_KVWA); const bf16_t* kvna = c.wsp<bf16_t>(WS_KVNA);
    for (int task = gw; task < nrows * 16; task += ngw) {
        const int r = task >> 4, hh = task & 15;
        if (hh < 8) {
            const int h = hh; const bf16_t* q = c.wsp<bf16_t>(WS_QWA) + (size_t)r * 1024 + h * 128; bf16_t* o = c.wsp<bf16_t>(WS_YWA) + (size_t)r * 1024 + h * 128;
            if (r < L) { const KeyWA k{kvwa, r, h >> 2}; wave_attn(q, 513, k, true, sinkp[h], o, wl, c.lane); }
            else { const KeyCtxWA k{kvwa, h >> 2}; wave_attn(q, 256, k, true, sinkp[h], o, wl, c.lane); }
        } else {
            const int h = hh - 8; const bf16_t* q = c.wsp<bf16_t>(WS_QNA) + (size_t)r * 1024 + h * 128; bf16_t* o = c.wsp<bf16_t>(WS_YNA) + (size_t)r * 1024 + h * 128;
            if (r < L) { const int gr = r / GRIDW, qc = r % GRIDW; int r0 = gr - 4; r0 = r0 < 0 ? 0 : (r0 > 248 ? 248 : r0); int cs = qc - 8; cs = cs < 0 ? 0 : (cs > 48 ? 48 : cs);
                const KeyNA k{kvna, rpb, gr, qc, r0, cs, h}; wave_attn(q, 384, k, false, 0.f, o, wl, c.lane); }
            else { const KeyCtxNA k{kvna, h}; wave_attn(q, 256, k, false, 0.f, o, wl, c.lane); }
        }
    }
#endif
}

__device__ __forceinline__ void ph_c2(const Ctx& c) {
    bf16_t* tile = (bf16_t*)c.smem;
    const bf16_t* src = c.wsp<bf16_t>(WS_YHYT); bf16_t* dst = c.wsp<bf16_t>(WS_YHY);
    for (int u = c.bid; u < (1024 / 64) * (L / 64); u += c.nb) {
        const int c0 = (u % 16) * 64, t0 = (u / 16) * 64;
        __syncthreads();
        for (int e = c.tid; e < 4096; e += NTHREADS) { const int cc = e >> 6, tt = e & 63; tile[cc * 66 + tt] = src[(size_t)(c0 + cc) * L + t0 + tt]; }
        __syncthreads();
        for (int e = c.tid; e < 4096; e += NTHREADS) { const int tt = e >> 6, cc = e & 63; dst[(size_t)(t0 + tt) * 1024 + c0 + cc] = tile[cc * 66 + tt]; }
    }
}

struct EpiMerge { unsigned char* ws; int b;
    __device__ __forceinline__ void operator()(int row, int col, const float (&v)[8]) const {
        const bf16_t* g = (const bf16_t*)(ws + WS_GATE) + (size_t)row * 6144 + b * 2048 + col;
        float* mp = (float*)(ws + WS_MPART) + (size_t)row * D + col;
        const uint4 gg = *(const uint4*)g;
        const float gv[8] = {__uint_as_float(gg.x << 16), __uint_as_float(gg.x & 0xffff0000u), __uint_as_float(gg.y << 16), __uint_as_float(gg.y & 0xffff0000u),
                             __uint_as_float(gg.z << 16), __uint_as_float(gg.z & 0xffff0000u), __uint_as_float(gg.w << 16), __uint_as_float(gg.w & 0xffff0000u)};
        float t[8];
        if (b == 0) {
#pragma unroll
            for (int j = 0; j < 8; ++j) t[j] = gv[j] * v[j];
        } else {
            const float4 p0 = *(const float4*)mp, p1 = *(const float4*)(mp + 4);
            const float pv[8] = {p0.x, p0.y, p0.z, p0.w, p1.x, p1.y, p1.z, p1.w};
#pragma unroll
            for (int j = 0; j < 8; ++j) t[j] = fmaf(gv[j], v[j], pv[j]);
        }
        if (b < 2) { *(float4*)mp = make_float4(t[0], t[1], t[2], t[3]); *(float4*)(mp + 4) = make_float4(t[4], t[5], t[6], t[7]); }
        else { uint4 o; o.x = pk2(t[0], t[1]); o.y = pk2(t[2], t[3]); o.z = pk2(t[4], t[5]); o.w = pk2(t[6], t[7]); *(uint4*)((bf16_t*)(ws + WS_MB) + (size_t)row * D + col) = o; }
    }
};
__device__ __forceinline__ void ph_d(const Ctx& c, int layer) {
    const int nM = MR / 128, nN = D / 128;
    for (int b = 0; b < 3; ++b) {
        const bf16_t* A = b == 0 ? c.wsp<bf16_t>(WS_YHY) : (b == 1 ? c.wsp<bf16_t>(WS_YWA) : c.wsp<bf16_t>(WS_YNA));
        const RowLin rp{A, 1024}; const EpiMerge ep{c.ws, b};
        const float* W = c.in[24] + ((size_t)layer * 3 + b) * 1024 * D;
        for (int u = c.bid; u < nM * nN; u += c.nb) sgemm_unit(rp, W, D, 1024, (u % nM) * 128, (u / nM) * 128, ep, (float*)c.smem, c.tid);
    }
}
struct EpiOut { const Ctx* c; int layer;
    __device__ __forceinline__ void operator()(int row, int col, const float (&v)[8]) const {
        const float* xin = c->xrow(layer, row) + col; const float* g = c->mod(layer, row < L ? 0 : 1, 2) + col;
        float* o = (float*)(c->ws + WS_XA) + (size_t)row * D + col;
        const float4 x0 = *(const float4*)xin, x1 = *(const float4*)(xin + 4), g0 = *(const float4*)g, g1 = *(const float4*)(g + 4);
        *(float4*)o = make_float4(x0.x + g0.x * v[0], x0.y + g0.y * v[1], x0.z + g0.z * v[2], x0.w + g0.w * v[3]);
        *(float4*)(o + 4) = make_float4(x1.x + g1.x * v[4], x1.y + g1.y * v[5], x1.z + g1.z * v[6], x1.w + g1.w * v[7]);
    }
};
__device__ __forceinline__ void ph_e(const Ctx& c, int layer) {
    const int nM = MR / 128, nN = D / 128;
    const RowLin rp{c.wsp<bf16_t>(WS_MB), D}; const EpiOut ep{&c, layer};
    const float* W = c.in[25] + (size_t)layer * D * D;
    for (int u = c.bid; u < nM * nN; u += c.nb) sgemm_unit(rp, W, D, D, (u % nM) * 128, (u / nM) * 128, ep, (float*)c.smem, c.tid);
}

__device__ __forceinline__ void ph_f(const Ctx& c, int layer) {
    const int gw = c.bid * 8 + c.wave, ngw = c.nb * 8;
    const float* g = c.in[26] + (size_t)layer * D;
    const float* wr = c.in[27] + (size_t)layer * D * NE;
    for (int r = gw; r < MR; r += ngw) {
        const float* x = c.wsp<float>(WS_XA) + (size_t)r * D;
        const int src = r < L ? 0 : 1;
        const float* sh = c.mod(layer, src, 3); const float* sc = c.mod(layer, src, 4);
        float4 v[8]; float ss = 0.f;
#pragma unroll
        for (int j = 0; j < 8; ++j) { v[j] = *(const float4*)(x + 4 * c.lane + 256 * j); ss += v[j].x * v[j].x + v[j].y * v[j].y + v[j].z * v[j].z + v[j].w * v[j].w; }
        ss = wave_sum(ss);
        const float inv = rsqrtf(ss * (1.0f / D) + RMS_EPS);
        bf16_t* o = c.wsp<bf16_t>(WS_H2) + (size_t)r * D;
        float lg[NE];
#pragma unroll
        for (int e = 0; e < NE; ++e) lg[e] = 0.f;
#pragma unroll
        for (int j = 0; j < 8; ++j) {
            const int col = 4 * c.lane + 256 * j;
            const float4 gg = *(const float4*)(g + col), s4 = *(const float4*)(sh + col), c4 = *(const float4*)(sc + col);
            const float y[4] = {v[j].x * inv * gg.x * (1.f + c4.x) + s4.x, v[j].y * inv * gg.y * (1.f + c4.y) + s4.y,
                                v[j].z * inv * gg.z * (1.f + c4.z) + s4.z, v[j].w * inv * gg.w * (1.f + c4.w) + s4.w};
            uint2 w; w.x = pk2(y[0], y[1]); w.y = pk2(y[2], y[3]);
            *(uint2*)(o + col) = w;
#pragma unroll
            for (int q = 0; q < 4; ++q) {
                const float4* wp = (const float4*)(wr + (size_t)(col + q) * NE);
#pragma unroll
                for (int e4 = 0; e4 < 4; ++e4) { const float4 w4 = wp[e4]; lg[e4 * 4 + 0] = fmaf(y[q], w4.x, lg[e4 * 4 + 0]); lg[e4 * 4 + 1] = fmaf(y[q], w4.y, lg[e4 * 4 + 1]); lg[e4 * 4 + 2] = fmaf(y[q], w4.z, lg[e4 * 4 + 2]); lg[e4 * 4 + 3] = fmaf(y[q], w4.w, lg[e4 * 4 + 3]); }
            }
        }
        float mx = -3e38f;
#pragma unroll
        for (int e = 0; e < NE; ++e) { lg[e] = wave_sum(lg[e]); mx = fmaxf(mx, lg[e]); }
        float sum = 0.f;
#pragma unroll
        for (int e = 0; e < NE; ++e) { lg[e] = expf(lg[e] - mx); sum += lg[e]; }
        float mine = 0.f;
#pragma unroll
        for (int e = 0; e < NE; ++e) mine = (c.lane == e) ? lg[e] / sum : mine;
        if (c.lane < NE) c.wsp<float>(WS_AFF)[(size_t)r * NE + c.lane] = mine;
    }
}

__device__ __forceinline__ void topk_unit(const Ctx& c, int e, int row0, int n, int K, int slot0) {
    unsigned* hist = (unsigned*)c.smem;
    unsigned* sh = hist + 256;
    const int tid = c.tid, lane = c.lane, wave = c.wave;
    const float* aff = c.wsp<float>(WS_AFF);
    unsigned key[32];
#pragma unroll
    for (int j = 0; j < 32; ++j) { const int t = tid + 512 * j; key[j] = t < n ? __float_as_uint(aff[(size_t)(row0 + t) * NE + e]) : 0u; }
    unsigned prefix = 0u, mask = 0u, need = (unsigned)K;
    for (int pass = 0; pass < 4; ++pass) {
        const int shift = 24 - 8 * pass;
        __syncthreads();
        if (tid < 256) hist[tid] = 0u;
        __syncthreads();
#pragma unroll
        for (int j = 0; j < 32; ++j) { const int t = tid + 512 * j; if (t < n && (key[j] & mask) == prefix) atomicAdd(&hist[(key[j] >> shift) & 255u], 1u); }
        __syncthreads();
        if (tid == 0) {
            unsigned cum = 0u; int b = 255;
            for (; b > 0; --b) { if (cum + hist[b] >= need) break; cum += hist[b]; }
            sh[0] = prefix | ((unsigned)b << shift); sh[1] = need - cum;
        }
        __syncthreads();
        prefix = sh[0]; need = sh[1]; mask |= 255u << shift;
    }
    const unsigned T = prefix; const unsigned cnt_gt = (unsigned)K - need;
    int* IDX = c.wsp<int>(WS_IDX) + (size_t)e * SLOTS; float* GS = c.wsp<float>(WS_GSEL) + (size_t)e * SLOTS; int* SL = c.wsp<int>(WS_SLOT) + (size_t)e * MR;
    unsigned base_gt = 0u, base_eq = 0u;
    for (int j = 0; j < 32; ++j) {
        const int t = tid + 512 * j;
        unsigned kj = 0u;
#pragma unroll
        for (int q = 0; q < 32; ++q) kj = (q == j) ? key[q] : kj;
        const bool valid = t < n; const bool gt = valid && kj > T, eq = valid && kj == T;
        const unsigned long long mg = __ballot(gt), me = __ballot(eq);
        const unsigned long long lower = (lane == 0) ? 0ull : (~0ull >> (64 - lane));
        const unsigned rg = (unsigned)__popcll(mg & lower), re = (unsigned)__popcll(me & lower);
        __syncthreads();
        if (lane == 0) { sh[8 + wave] = (unsigned)__popcll(mg); sh[16 + wave] = (unsigned)__popcll(me); }
        __syncthreads();
        unsigned og = 0u, oe = 0u, tg = 0u, te = 0u;
#pragma unroll
        for (int w = 0; w < 8; ++w) { const unsigned a = sh[8 + w], b2 = sh[16 + w]; if (w < wave) { og += a; oe += b2; } tg += a; te += b2; }
        int slot = -1;
        if (gt) slot = (int)(base_gt + og + rg);
        else if (eq) { const unsigned rk = base_eq + oe + re; if (rk < need) slot = (int)(cnt_gt + rk); }
        if (valid) { SL[row0 + t] = slot >= 0 ? slot0 + slot : -1; if (slot >= 0) { IDX[slot0 + slot] = row0 + t; GS[slot0 + slot] = __uint_as_float(kj); } }
        base_gt += tg; base_eq += te;
    }
}
__device__ __forceinline__ void ph_g(const Ctx& c) {
    for (int u = c.bid; u < 32; u += c.nb) {
        if (u < 16) topk_unit(c, u, 0, L, CAP, 0);
        else { const int e = u - 16; topk_unit(c, e, L, LC, CAPC, CAP);
            for (int s = CAP + CAPC + c.tid; s < SLOTS; s += NTHREADS) { c.wsp<int>(WS_IDX)[(size_t)e * SLOTS + s] = 0; c.wsp<float>(WS_GSEL)[(size_t)e * SLOTS + s] = 0.f; } }
    }
}

struct EpiGate { float* tmp; __device__ __forceinline__ void operator()(int row, int col, const float (&v)[8]) const {
    float* p = tmp + (size_t)row * DF + col; *(float4*)p = make_float4(v[0], v[1], v[2], v[3]); *(float4*)(p + 4) = make_float4(v[4], v[5], v[6], v[7]); } };
struct EpiUp { const float* tmp; bf16_t* act; __device__ __forceinline__ void operator()(int row, int col, const float (&v)[8]) const {
    const float* p = tmp + (size_t)row * DF + col; const float4 a0 = *(const float4*)p, a1 = *(const float4*)(p + 4);
    const float a[8] = {a0.x, a0.y, a0.z, a0.w, a1.x, a1.y, a1.z, a1.w}; float t[8];
#pragma unroll
    for (int j = 0; j < 8; ++j) t[j] = silu_f(a[j]) * v[j];
    uint4 o; o.x = pk2(t[0], t[1]); o.y = pk2(t[2], t[3]); o.z = pk2(t[4], t[5]); o.w = pk2(t[6], t[7]);
    *(uint4*)(act + (size_t)row * DF + col) = o; } };
struct EpiDown { bf16_t* ye; __device__ __forceinline__ void operator()(int row, int col, const float (&v)[8]) const {
    uint4 o; o.x = pk2(v[0], v[1]); o.y = pk2(v[2], v[3]); o.z = pk2(v[4], v[5]); o.w = pk2(v[6], v[7]);
    *(uint4*)(ye + (size_t)row * D + col) = o; } };
__device__ __forceinline__ void ph_h(const Ctx& c, int layer) {
    const int nM = SLOTS / 128, nN = DF / 128;
    for (int which = 0; which < 2; ++which)
        for (int u = c.bid; u < NE * nM * nN; u += c.nb) {
            const int e = u / (nM * nN), r = u % (nM * nN), pm = r % nM, pn = r / nM;
            const RowGather rp{c.wsp<bf16_t>(WS_H2), D, c.wsp<int>(WS_IDX) + (size_t)e * SLOTS};
            float* tmp = c.wsp<float>(WS_TMP) + (size_t)e * SLOTS * DF;
            const float* W = c.in[which == 0 ? 28 : 29] + ((size_t)layer * NE + e) * D * DF;
            if (which == 0) { const EpiGate ep{tmp}; sgemm_unit(rp, W, DF, D, pm * 128, pn * 128, ep, (float*)c.smem, c.tid); }
            else { const EpiUp ep{tmp, c.wsp<bf16_t>(WS_ACT) + (size_t)e * SLOTS * DF}; sgemm_unit(rp, W, DF, D, pm * 128, pn * 128, ep, (float*)c.smem, c.tid); }
        }
}
__device__ __forceinline__ void ph_i(const Ctx& c, int layer) {
    const int nM = SLOTS / 128, nN = D / 128;
    for (int u = c.bid; u < NE * nM * nN; u += c.nb) {
        const int e = u / (nM * nN), r = u % (nM * nN), pm = r % nM, pn = r / nM;
        const RowLin rp{c.wsp<bf16_t>(WS_ACT) + (size_t)e * SLOTS * DF, DF};
        const EpiDown ep{c.wsp<bf16_t>(WS_YE) + (size_t)e * SLOTS * D};
        const float* W = c.in[30] + ((size_t)layer * NE + e) * DF * D;
        sgemm_unit(rp, W, D, DF, pm * 128, pn * 128, ep, (float*)c.smem, c.tid);
    }
}

__device__ __forceinline__ void ph_j(const Ctx& c, int layer) {
    const int gw = c.bid * 8 + c.wave, ngw = c.nb * 8;
    const int nrows = layer == 0 ? MR : L;
    for (int r = gw; r < nrows; r += ngw) {
        const float* x1 = c.wsp<float>(WS_XA) + (size_t)r * D;
        const float* g5 = c.mod(layer, r < L ? 0 : 1, 5);
        float* o = layer == 0 ? c.wsp<float>(WS_XB) + (size_t)r * D : c.out + (size_t)r * D;
        float acc[32];
#pragma unroll
        for (int j = 0; j < 32; ++j) acc[j] = 0.f;
        for (int e = 0; e < NE; ++e) {
            const int s = c.wsp<int>(WS_SLOT)[(size_t)e * MR + r];
            if (s >= 0) {
                const float gs = c.wsp<float>(WS_GSEL)[(size_t)e * SLOTS + s];
                const bf16_t* y = c.wsp<bf16_t>(WS_YE) + ((size_t)e * SLOTS + s) * D;
#pragma unroll
                for (int j = 0; j < 8; ++j) { const uint2 w = *(const uint2*)(y + 4 * c.lane + 256 * j);
                    acc[4 * j + 0] = fmaf(gs, __uint_as_float(w.x << 16), acc[4 * j + 0]); acc[4 * j + 1] = fmaf(gs, __uint_as_float(w.x & 0xffff0000u), acc[4 * j + 1]);
                    acc[4 * j + 2] = fmaf(gs, __uint_as_float(w.y << 16), acc[4 * j + 2]); acc[4 * j + 3] = fmaf(gs, __uint_as_float(w.y & 0xffff0000u), acc[4 * j + 3]); }
            }
        }
#pragma unroll
        for (int j = 0; j < 8; ++j) { const int col = 4 * c.lane + 256 * j; const float4 xv = *(const float4*)(x1 + col), gv = *(const float4*)(g5 + col);
            *(float4*)(o + col) = make_float4(xv.x + gv.x * acc[4 * j], xv.y + gv.y * acc[4 * j + 1], xv.z + gv.z * acc[4 * j + 2], xv.w + gv.w * acc[4 * j + 3]); }
    }
}

__global__ void __launch_bounds__(NTHREADS, 2) mega(KArgs a) {
    extern __shared__ __attribute__((aligned(16))) unsigned char smem[];
    Ctx c; c.in = a.in; c.out = a.out; c.ws = a.ws; c.bid = blockIdx.x; c.nb = gridDim.x; c.tid = threadIdx.x; c.lane = c.tid & 63;
    c.wave = __builtin_amdgcn_readfirstlane(c.tid >> 6); c.smem = smem;
    volatile LAS unsigned* st = (volatile LAS unsigned*)(LAS unsigned char*)(smem + LDS_BYTES - 16);
    if (c.tid == 0) { st[0] = 0u; st[1] = 0u; st[2] = 0u; st[3] = 0u; }
    __syncthreads();
    const int lo = a.ph_lo, hi = a.ph_hi;
    XcdBarrier bar; bar.bar = (unsigned*)(a.ws + WS_CTL); bar.x = 0; bar.st = st;
    if (hi - lo > 1) bar = xcd_barrier_post((unsigned*)(a.ws + WS_CTL), st);
#ifndef ONLY_PH
#define ONLY_PH -1
#endif
#define PSEL(j) (ONLY_PH < 0 || ONLY_PH == (j))
#define IN(k) (lo <= (k) && (k) < hi)
#define LAUNDER(cc) Ctx cc = c; asm volatile("" : "+v"(cc.tid), "+v"(cc.lane)); asm volatile("" : "+s"(cc.bid), "+s"(cc.nb), "+s"(cc.wave), "+s"(cc.ws), "+s"(cc.out))
#define SEAM(k) do { if (IN(k) && IN((k) + 1)) xcd_barrier(bar); } while (0)
    if (PSEL(0) && IN(0)) { LAUNDER(cc); ph_g0(cc); } SEAM(0);
    for (int layer = 0; layer < 2; ++layer) {
        const int b = 1 + layer * PH_PER_LAYER;
        if (PSEL(1) && IN(b + 0)) { LAUNDER(cc); int ly = layer; asm volatile("" : "+s"(ly)); ph_a(cc, ly); } SEAM(b + 0);
        if (PSEL(2) && IN(b + 1)) { LAUNDER(cc); int ly = layer; asm volatile("" : "+s"(ly)); ph_b(cc, ly); } SEAM(b + 1);
        if (PSEL(3) && IN(b + 2)) { LAUNDER(cc); int ly = layer; asm volatile("" : "+s"(ly)); ph_b2(cc, ly); } SEAM(b + 2);
        if (PSEL(4) && IN(b + 3)) { LAUNDER(cc); int ly = layer; asm volatile("" : "+s"(ly)); ph_c(cc, ly); } SEAM(b + 3);
        if (PSEL(5) && IN(b + 4)) { LAUNDER(cc); int ly = layer; asm volatile("" : "+s"(ly)); ph_c2(cc); } SEAM(b + 4);
        if (PSEL(6) && IN(b + 5)) { LAUNDER(cc); int ly = layer; asm volatile("" : "+s"(ly)); ph_d(cc, ly); } SEAM(b + 5);
        if (PSEL(7) && IN(b + 6)) { LAUNDER(cc); int ly = layer; asm volatile("" : "+s"(ly)); ph_e(cc, ly); } SEAM(b + 6);
        if (PSEL(8) && IN(b + 7)) { LAUNDER(cc); int ly = layer; asm volatile("" : "+s"(ly)); ph_f(cc, ly); } SEAM(b + 7);
        if (PSEL(9) && IN(b + 8)) { LAUNDER(cc); int ly = layer; asm volatile("" : "+s"(ly)); ph_g(cc); } SEAM(b + 8);
        if (PSEL(10) && IN(b + 9)) { LAUNDER(cc); int ly = layer; asm volatile("" : "+s"(ly)); ph_h(cc, ly); } SEAM(b + 9);
        if (PSEL(11) && IN(b + 10)) { LAUNDER(cc); int ly = layer; asm volatile("" : "+s"(ly)); ph_i(cc, ly); } SEAM(b + 10);
        if (PSEL(12) && IN(b + 11)) { LAUNDER(cc); int ly = layer; asm volatile("" : "+s"(ly)); ph_j(cc, ly); } SEAM(b + 11);
    }
#undef IN
#undef SEAM
}

extern "C" void kernel_launch(void* const* d_in, const int* in_sizes, int n_in, void* d_out, int out_size, void* d_ws, size_t ws_size, hipStream_t stream) {
    static int grid = 0;
    if (grid == 0) {
        if (n_in != 31 || out_size != L * D || ws_size < WS_END) { fprintf(stderr, "kernel_launch: unexpected shapes: n_in %d out %d ws %zu (need %zu)\n", n_in, out_size, ws_size, (size_t)WS_END); grid = -1; return; }
        int dev = 0, cus = 0, per_cu = 0;
        if (hipGetDevice(&dev) != hipSuccess || hipDeviceGetAttribute(&cus, hipDeviceAttributeMultiprocessorCount, dev) != hipSuccess) { grid = -1; return; }
        if (hipFuncSetAttribute((const void*)mega, hipFuncAttributeMaxDynamicSharedMemorySize, LDS_BYTES) != hipSuccess) { fprintf(stderr, "kernel_launch: hipFuncSetAttribute failed\n"); grid = -1; return; }
        if (hipOccupancyMaxActiveBlocksPerMultiprocessor(&per_cu, (const void*)mega, NTHREADS, LDS_BYTES) != hipSuccess || per_cu < 1) fprintf(stderr, "kernel_launch: occupancy query says %d\n", per_cu);
        (void)hipGetLastError();
        grid = cus;
    }
    if (grid < 0) return;
    if (hipMemsetAsync((char*)d_ws + WS_CTL, 0, CTL_BYTES, stream) != hipSuccess) return;
    KArgs a{};
    for (int i = 0; i < 31; ++i) a.in[i] = (const float*)d_in[i];
    a.out = (float*)d_out; a.ws = (unsigned char*)d_ws;
#if ONE_LAUNCH
    a.ph_lo = 0; a.ph_hi = NPH;
    hipLaunchKernelGGL(mega, dim3(grid), dim3(NTHREADS), LDS_BYTES, stream, a);
#else
    for (int p = 0; p < NPH; ++p) { a.ph_lo = p; a.ph_hi = p + 1; hipLaunchKernelGGL(mega, dim3(grid), dim3(NTHREADS), LDS_BYTES, stream, a); }
#endif
    const hipError_t le = hipPeekAtLastError();
    if (le != hipSuccess) fprintf(stderr, "kernel_launch: launch failed: %s\n", hipGetErrorName(le));
}
```

```cpp
#include <hip/hip_runtime.h>
#include <stdint.h>
#include <stdio.h>

#ifndef ONE_LAUNCH
#define ONE_LAUNCH 1
#endif

typedef unsigned short bf16_t;
#define LAS __attribute__((address_space(3)))

constexpr int L = 16384, LC = 256, MR = L + LC, D = 2048, NIN = 13824;
constexpr int HD = 128, GRIDW = 64;
constexpr int OFF_HY = 0, OFF_WAQ = 3072, OFF_WAKV = 4096, OFF_NAQ = 4608, OFF_NAKV = 5632, OFF_GATE = 7680;
constexpr int NE = 16, CAP = 2048, CAPC = 32, SLOTS = 2304, DF = 1024;
constexpr int NMOD = 6 * D;
constexpr float RMS_EPS = 1e-6f;
constexpr float QK_SCALE = 0.08838834764831845f;

constexpr size_t al256(size_t x) { return (x + 255) & ~(size_t)255; }
constexpr size_t WS_CTL = 0, CTL_BYTES = 1u << 20;
constexpr size_t WS_MOD = WS_CTL + CTL_BYTES;
constexpr size_t WS_H2F = WS_MOD + al256((size_t)2 * 2 * NMOD * 4);
constexpr size_t WS_AFF = WS_H2F + al256((size_t)2 * MR * 64 * 4);
constexpr size_t WS_IDX = WS_AFF + al256((size_t)MR * 16 * 4);
constexpr size_t WS_GSEL = WS_IDX + al256((size_t)NE * SLOTS * 4);
constexpr size_t WS_SLOT = WS_GSEL + al256((size_t)NE * SLOTS * 4);
constexpr size_t WS_KFC = WS_SLOT + al256((size_t)NE * MR * 4);
constexpr size_t WS_ZHYC = WS_KFC + al256((size_t)4096 * LC * 2);
constexpr size_t WS_XA = WS_ZHYC + al256((size_t)3072 * LC * 2);
constexpr size_t WS_XB = WS_XA + al256((size_t)MR * D * 4);
constexpr size_t WS_W = WS_XB + al256((size_t)MR * D * 4);
constexpr size_t W_BYTES = (size_t)2 * ((size_t)NIN * D + 3 * (size_t)D * 1024 + (size_t)D * D + (size_t)NE * 2048 * D + (size_t)NE * D * DF);
constexpr size_t WS_WIN = WS_W;
constexpr size_t WS_WBR = WS_WIN + (size_t)NIN * D * 2;
constexpr size_t WS_WOUT = WS_WBR + (size_t)3 * D * 1024 * 2;
constexpr size_t WS_WGU = WS_WOUT + (size_t)D * D * 2;
constexpr size_t WS_WDN = WS_WGU + (size_t)NE * 2048 * D * 2;
constexpr size_t WS_R3 = WS_W + al256(W_BYTES);
constexpr size_t R3_BYTES = (size_t)MR * D * 4 + (size_t)MR * D * 2;
constexpr size_t WS_KF = WS_R3;
constexpr size_t WS_MPART = WS_R3;
constexpr size_t WS_MB = WS_R3 + (size_t)MR * D * 4;
constexpr size_t WS_TMP = WS_R3;
constexpr size_t WS_YE = WS_R3;
constexpr size_t WS_R4 = WS_R3 + al256(R3_BYTES);
constexpr size_t R4_BYTES = (size_t)MR * 6144 * 2;
constexpr size_t WS_GATE = WS_R4;
constexpr size_t WS_H2 = WS_R4;
constexpr size_t WS_ACT = WS_R4 + al256((size_t)MR * D * 2);
constexpr size_t WS_R5 = WS_R4 + al256(R4_BYTES);
constexpr size_t WS_HX = WS_R5;
constexpr size_t WS_YHYT = WS_R5;
constexpr size_t WS_YHY = WS_R5 + al256((size_t)1024 * L * 2);
constexpr size_t WS_ZHYT = WS_R5 + al256((size_t)MR * D * 2);
constexpr size_t WS_QWA = WS_ZHYT + al256((size_t)3072 * MR * 2);
constexpr size_t WS_KVWA = WS_QWA + al256((size_t)MR * 1024 * 2);
constexpr size_t WS_QNA = WS_KVWA + al256((size_t)MR * 512 * 2);
constexpr size_t WS_KVNA = WS_QNA + al256((size_t)MR * 1024 * 2);
constexpr size_t WS_YWA = WS_KVNA + al256((size_t)MR * 2048 * 2);
constexpr size_t WS_YNA = WS_YWA + al256((size_t)MR * 1024 * 2);
constexpr size_t WS_END = WS_YNA + al256((size_t)MR * 1024 * 2);
static_assert((size_t)1024 * L * 2 + (size_t)MR * 1024 * 2 <= (size_t)MR * D * 2 + 512, "YHYT+YHY overlay HX");
static_assert((size_t)4096 * L * 2 <= R3_BYTES && (size_t)NE * SLOTS * D * 2 <= R3_BYTES && (size_t)NE * SLOTS * DF * 4 <= R3_BYTES, "R3");
static_assert((size_t)MR * D * 2 + 256 + (size_t)NE * SLOTS * DF * 2 <= R4_BYTES, "R4");

constexpr int LDS_BYTES = 160 * 1024;
constexpr int NTHREADS = 512;
constexpr int PH_PER_LAYER = 12, NPH = 1 + 2 * PH_PER_LAYER;

__device__ __forceinline__ float bf2f(bf16_t b) { return __uint_as_float(((unsigned)b) << 16); }
__device__ __forceinline__ bf16_t f2bf(float f) { unsigned u = __float_as_uint(f); u += 0x7fffu + ((u >> 16) & 1u); return (bf16_t)(u >> 16); }
__device__ __forceinline__ unsigned pk2(float lo, float hi) { return (unsigned)f2bf(lo) | ((unsigned)f2bf(hi) << 16); }
__device__ __forceinline__ float wave_sum(float v) {
#pragma unroll
    for (int o = 1; o < 64; o <<= 1) v += __shfl_xor(v, o);
    return v;
}
__device__ __forceinline__ float wave_max(float v) {
#pragma unroll
    for (int o = 1; o < 64; o <<= 1) v = fmaxf(v, __shfl_xor(v, o));
    return v;
}
__device__ __forceinline__ float silu_f(float x) { return x / (1.f + __expf(-x)); }
__device__ __forceinline__ float sigmoid_f(float x) { return 1.f / (1.f + __expf(-x)); }
#define LDS_FENCE() asm volatile("s_waitcnt lgkmcnt(0)" ::: "memory")

#define XB_TMO      128
#define XB_XCNT(j)  (256  + 64 * (j))
#define XB_XSUB(j)  (1280 + 64 * (j))
#define XB_XGEN(j)  (2304 + 64 * (j))
#define XB_TOP      3328
#define XB_TOPGEN   3392
#define XCD_BAR_WORDS 3456
#define XB_SPIN_CAP (1u << 22)

__device__ __forceinline__ unsigned xb_ld(unsigned* p)              { return __hip_atomic_load(p, __ATOMIC_RELAXED, __HIP_MEMORY_SCOPE_AGENT); }
__device__ __forceinline__ unsigned xb_add(unsigned* p, unsigned v) { return __hip_atomic_fetch_add(p, v, __ATOMIC_RELAXED, __HIP_MEMORY_SCOPE_AGENT); }
__device__ __forceinline__ unsigned xb_xcc_id() { return (unsigned)__builtin_amdgcn_s_getreg((3 << 11) | 20) & 0xFu; }
#define XB_SPIN(cond, bar) do { unsigned _sp = 0; while (cond) { __builtin_amdgcn_s_sleep(1); \
    if ((++_sp & 255u) == 0u) { if (xb_ld(&(bar)[XB_TMO])) break; if (_sp > XB_SPIN_CAP) { atomicAdd(&(bar)[XB_TMO], 1u); break; } } } } while (0)

struct XcdBarrier { unsigned* bar; unsigned x; volatile LAS unsigned* st; };

__device__ __forceinline__ XcdBarrier xcd_barrier_post(unsigned* bar, volatile LAS unsigned* st) {
    XcdBarrier b; b.bar = bar; b.x = xb_xcc_id(); b.st = st;
    if (threadIdx.x == 0) (void)xb_add(&bar[XB_XCNT(b.x)], 1u);
    return b;
}
__device__ __forceinline__ void xcd_barrier_complete(unsigned* bar, unsigned x, unsigned& nloc, unsigned& nx) {
    const unsigned G = gridDim.x * gridDim.y * gridDim.z;
    unsigned sum, cnt, mine, sp = 0u;
    for (;;) {
        sum = 0u; cnt = 0u; mine = 0u;
#pragma unroll
        for (unsigned j = 0; j < 16; ++j) { const unsigned c = xb_ld(&bar[XB_XCNT(j)]); sum += c; cnt += (c > 0u) ? 1u : 0u; mine = (j == x) ? c : mine; }
        if (sum == G) break;
        __builtin_amdgcn_s_sleep(1);
        if ((++sp & 255u) == 0u) { if (xb_ld(&bar[XB_TMO])) break; if (sp > XB_SPIN_CAP) { atomicAdd(&bar[XB_TMO], 1u); break; } }
    }
    nloc = mine > 0u ? mine : 1u; nx = cnt > 0u ? cnt : 1u;
}
__device__ __forceinline__ void xcd_barrier(const XcdBarrier& b) {
    asm volatile("s_waitcnt vmcnt(0)" ::: "memory");
    __syncthreads();
    if (threadIdx.x == 0) {
        unsigned* bar = b.bar;
        __builtin_amdgcn_s_waitcnt(0);
        unsigned nloc = b.st[0], nx = b.st[1];
        if (nloc == 0u) { xcd_barrier_complete(bar, b.x, nloc, nx); b.st[0] = nloc; b.st[1] = nx; }
        const unsigned old = xb_add(&bar[XB_XSUB(b.x)], 1u);
        const unsigned gen = old / nloc;
        if (old + 1u == (gen + 1u) * nloc) {
            __builtin_amdgcn_fence(__ATOMIC_RELEASE, "agent");
            asm volatile("s_waitcnt vmcnt(0)" ::: "memory");
            const unsigned og = xb_add(&bar[XB_TOP], 1u);
            const unsigned tg = og / nx;
            if (og + 1u == (tg + 1u) * nx) xb_add(&bar[XB_TOPGEN], 1u);
            else XB_SPIN(xb_ld(&bar[XB_TOPGEN]) == tg, bar);
            __builtin_amdgcn_fence(__ATOMIC_ACQUIRE, "agent");
            xb_add(&bar[XB_XGEN(b.x)], 1u);
            asm volatile("s_waitcnt vmcnt(0)" ::: "memory");
        } else {
            XB_SPIN(xb_ld(&bar[XB_XGEN(b.x)]) == gen, bar);
            __builtin_amdgcn_fence(__ATOMIC_ACQUIRE, "agent");
            asm volatile("s_waitcnt vmcnt(0)" ::: "memory");
        }
    }
    __syncthreads();
}

struct KArgs { const float* in[31]; float* out; unsigned char* ws; int ph_lo, ph_hi; };

struct Ctx {
    const float* const* in; float* out; unsigned char* ws;
    int bid, nb, tid, lane, wave;
    unsigned char* smem;
    template <class T> __device__ __forceinline__ T* wsp(size_t off) const { return (T*)(ws + off); }
    __device__ __forceinline__ const float* mod(int layer, int src, int chunk) const { return wsp<float>(WS_MOD) + ((size_t)(layer * 2 + src) * NMOD) + chunk * D; }
    __device__ __forceinline__ const float* xrow(int layer, int r) const {
        if (layer == 0) return r < L ? in[0] + (size_t)r * D : in[2] + (size_t)(r - L) * D;
        return wsp<float>(WS_XB) + (size_t)r * D;
    }
};

template <class RowPtr, class Epi>
__device__ __forceinline__ void sgemm_unit(const RowPtr& rp, const float* __restrict__ W, int ldw, int K, int m0, int n0, const Epi& ep, float* lds, int tid) {
    float* As = lds;
    float* Bs = lds + 16 * 132;
    const int ty = tid >> 4, tx = tid & 15;
    const int am = tid >> 2, kq = (tid & 3) * 4;
    const int bk = tid >> 5, n4 = (tid & 31) * 4;
    float acc[4][8];
#pragma unroll
    for (int i = 0; i < 4; ++i)
#pragma unroll
        for (int j = 0; j < 8; ++j) acc[i][j] = 0.f;
    const bf16_t* arow = rp(m0 + am);
    const float* wp = W + (size_t)bk * ldw + n0 + n4;
    for (int k0 = 0; k0 < K; k0 += 16) {
        const uint2 a4 = *(const uint2*)(arow + k0 + kq);
        const float4 b4 = *(const float4*)(wp + (size_t)k0 * ldw);
        __syncthreads();
        As[(kq + 0) * 132 + am] = __uint_as_float(a4.x << 16);
        As[(kq + 1) * 132 + am] = __uint_as_float(a4.x & 0xffff0000u);
        As[(kq + 2) * 132 + am] = __uint_as_float(a4.y << 16);
        As[(kq + 3) * 132 + am] = __uint_as_float(a4.y & 0xffff0000u);
        *(float4*)&Bs[bk * 128 + n4] = b4;
        __syncthreads();
#pragma unroll
        for (int kk = 0; kk < 16; ++kk) {
            const float4 a = *(const float4*)&As[kk * 132 + ty * 4];
            const float4 b0 = *(const float4*)&Bs[kk * 128 + tx * 8];
            const float4 b1 = *(const float4*)&Bs[kk * 128 + tx * 8 + 4];
            const float av[4] = {a.x, a.y, a.z, a.w};
            const float bv[8] = {b0.x, b0.y, b0.z, b0.w, b1.x, b1.y, b1.z, b1.w};
#pragma unroll
            for (int i = 0; i < 4; ++i)
#pragma unroll
                for (int j = 0; j < 8; ++j) acc[i][j] = fmaf(av[i], bv[j], acc[i][j]);
        }
    }
#pragma unroll
    for (int i = 0; i < 4; ++i) ep(m0 + ty * 4 + i, n0 + tx * 8, acc[i]);
}

struct RowLin { const bf16_t* base; int ld; __device__ __forceinline__ const bf16_t* operator()(int m) const { return base + (size_t)m * ld; } };
struct RowGather { const bf16_t* base; int ld; const int* idx; __device__ __forceinline__ const bf16_t* operator()(int m) const { return base + (size_t)idx[m] * ld; } };


namespace pg8 {
typedef short bf16x8 __attribute__((ext_vector_type(8)));
typedef float f32x4 __attribute__((ext_vector_type(4)));
typedef unsigned u32x4 __attribute__((ext_vector_type(4)));
typedef unsigned u32x2 __attribute__((ext_vector_type(2)));
constexpr int BM = 256, BK = 64, HALF = 128, HTB = HALF * BK * 2, STAGE_BYTES = 8 * HTB, NXCD = 8, WGM = 8;
__host__ __device__ __forceinline__ int lds_byte(int r, int c) { const int st = (r >> 4) * 2 + (c >> 5), rr = r & 15, cc = c & 31, ob = rr * 64 + cc * 2; return st * 1024 + (ob ^ (((ob >> 9) & 1) << 5)); }
__host__ __device__ __forceinline__ void stage_rc(int b, int& R, int& C) { const int st = b / 1024, sb = b % 1024, swz = sb ^ (((sb >> 9) & 1) << 5); R = (st >> 1) * 16 + swz / 64; C = (st & 1) * 32 + (swz % 64) / 2; }
__host__ __device__ __forceinline__ int perm32(int rho) { const int n = rho >> 4, i = rho & 15; return 8 * (i >> 2) + 4 * n + (i & 3); }
struct Unit { int pm, pn; };
struct StaticOrder {
    int nM, nN, nwg, G, c;
    __host__ __device__ void init(int nM_, int nN_, int G_, int c_) { nM = nM_; nN = nN_; nwg = nM * nN; G = G_; c = c_; }
    __host__ __device__ bool next(int i, Unit& u) const {
        const long Lq = (long)i * G + c; if (Lq >= nwg) return false;
        int wgid = (int)Lq; { const int q = nwg / NXCD, r = nwg % NXCD, xcd = wgid % NXCD, off = wgid / NXCD; wgid = (xcd < r ? xcd * (q + 1) : r * (q + 1) + (xcd - r) * q) + off; }
        const int nig = WGM * nN, gid = wgid / nig, fm = gid * WGM, gsz = (nM - fm) < WGM ? (nM - fm) : WGM;
        u.pm = fm + ((wgid % nig) % gsz); u.pn = (wgid % nig) / gsz; return true;
    }
};
__device__ __forceinline__ unsigned cvt_pk_bf16(float lo, float hi) { unsigned r; asm volatile("v_cvt_pk_bf16_f32 %0, %1, %2" : "=v"(r) : "v"(lo), "v"(hi)); return r; }

struct GeomLin {
    static constexpr bool GATHER = false;
    const char* A; const char* B; int K, lda, ldb; const int* idx;
    __device__ __forceinline__ const char* a_base(const Unit& u) const { return A + (size_t)u.pm * 256 * lda * 2; }
    __device__ __forceinline__ const char* b_base(const Unit& u) const { return B + (size_t)u.pn * 256 * ldb * 2; }
    __device__ __forceinline__ int row0(const Unit& u) const { return u.pm * 256; }
};
template <bool GATHER_> struct GeomExpert {
    static constexpr bool GATHER = GATHER_;
    const char* A; const char* B; int K, lda, ldb; const int* idx; int tpe, nb;
    __device__ __forceinline__ int row0(const Unit& u) const { const int e = u.pm / tpe, t = u.pm - e * tpe; return e * SLOTS + t * 256; }
    __device__ __forceinline__ const char* a_base(const Unit& u) const { return GATHER_ ? A : A + (size_t)row0(u) * lda * 2; }
    __device__ __forceinline__ const char* b_base(const Unit& u) const { const int e = u.pm / tpe; return B + ((size_t)e * nb + (size_t)u.pn * 256) * ldb * 2; }
};

template <class Epi, class Geom, class Sched>
__device__ __forceinline__ void gemm_phase(LAS unsigned char* lds, const Geom& G, const Sched& S, const Epi& E) {
    const int tid = threadIdx.x, wid = __builtin_amdgcn_readfirstlane(tid >> 6), lane = tid & 63, wr = wid >> 2, wc = wid & 3, fr = lane & 15, fq = lane >> 4;
    const int K = G.K, nt = K / BK;
    int Rs[2], Cs[2]; unsigned vB0[2], vA0[2], vAc[2][2], vAn[2][2];
#pragma unroll
    for (int i = 0; i < 2; ++i) { int R, C; stage_rc(tid * 16 + i * 8192, R, C); Rs[i] = R; Cs[i] = C; const int Rb = Epi::PERM ? ((R & ~31) + perm32(R & 31)) : R;
        vB0[i] = (unsigned)(Rb * G.ldb + C) * 2u; vA0[i] = (unsigned)(R * G.lda + C) * 2u;
#pragma unroll
        for (int h = 0; h < 2; ++h) { vAc[h][i] = 0u; vAn[h][i] = 0u; } }
    const size_t hstepA = (size_t)HALF * G.lda * 2, hstepB = (size_t)HALF * G.ldb * 2;
#define PG8_VOFF(dst, u) do { if constexpr (Geom::GATHER) { const int _r0 = G.row0(u); _Pragma("unroll") for (int _h = 0; _h < 2; ++_h) _Pragma("unroll") for (int _i = 0; _i < 2; ++_i) \
        dst[_h][_i] = ((unsigned)G.idx[_r0 + _h * HALF + Rs[_i]] * (unsigned)G.lda + (unsigned)Cs[_i]) * 2u; } } while (0)
    const size_t kstep = (size_t)(BK * 2);
    const unsigned ldsw = (unsigned)wid * 1024u;
    const int aoff = lds_byte(wr * 64 + fr, fq * 8), boff = lds_byte(wc * 32 + fr, fq * 8);
#define PG8_SA(b, h) (((b) * 2 + (h)) * HTB)
#define PG8_SB(b, h) ((4 + (b) * 2 + (h)) * HTB)
#define PG8_STAGE(bufoff, gbase, v) do { \
        __builtin_amdgcn_global_load_lds((const unsigned*)((const char*)(gbase) + (v)[0]), (LAS unsigned*)(lds + (bufoff) + ldsw), 16, 0, 0); \
        __builtin_amdgcn_global_load_lds((const unsigned*)((const char*)(gbase) + (v)[1]), (LAS unsigned*)(lds + (bufoff) + ldsw + 8192), 16, 0, 0); } while (0)
#define PG8_STA(bufoff, gbase, h, VX) do { if constexpr (Geom::GATHER) { PG8_STAGE(bufoff, gbase, VX[h]); } else { PG8_STAGE(bufoff, (gbase) + (h) * hstepA, vA0); } } while (0)
#define PG8_STB(bufoff, gbase, h) PG8_STAGE(bufoff, (gbase) + (h) * hstepB, vB0)
#define PG8_LDA(dst, b, h) do { _Pragma("unroll") for (int m = 0; m < 4; ++m) _Pragma("unroll") for (int k = 0; k < 2; ++k) dst[m][k] = *(const LAS bf16x8*)(lds + PG8_SA(b, h) + aoff + m * 2048 + k * 1024); } while (0)
#define PG8_LDB(dst, b, h) do { _Pragma("unroll") for (int n = 0; n < 2; ++n) _Pragma("unroll") for (int k = 0; k < 2; ++k) dst[n][k] = *(const LAS bf16x8*)(lds + PG8_SB(b, h) + boff + n * 2048 + k * 1024); } while (0)
#define PG8_MMA(ai, bj, At, Bt) do { __builtin_amdgcn_s_setprio(1); _Pragma("unroll") for (int m = 0; m < 4; ++m) _Pragma("unroll") for (int n = 0; n < 2; ++n) _Pragma("unroll") for (int k = 0; k < 2; ++k) \
        acc[ai][bj][m][n] = __builtin_amdgcn_mfma_f32_16x16x32_bf16(Bt[n][k], At[m][k], acc[ai][bj][m][n], 0, 0, 0); __builtin_amdgcn_s_setprio(0); } while (0)
#define PG8_WAIT_V(n) asm volatile("s_waitcnt vmcnt(" #n ")" ::: "memory")
#define PG8_WAIT_L(n) asm volatile("s_waitcnt lgkmcnt(" #n ")" ::: "memory")
#define PG8_BAR __builtin_amdgcn_s_barrier()
#define PG8_SCHED __builtin_amdgcn_sched_barrier(0)
    Unit cur, nxt; int ui = 0;
    if (!S.next(0, cur)) return;
    f32x4 acc[2][2][4][2];
#pragma unroll
    for (int a = 0; a < 2; ++a)
#pragma unroll
        for (int b = 0; b < 2; ++b)
#pragma unroll
            for (int m = 0; m < 4; ++m)
#pragma unroll
                for (int n = 0; n < 2; ++n) acc[a][b][m][n] = (f32x4){0.f, 0.f, 0.f, 0.f};
    bf16x8 At[4][2], B0[2][2], B1[2][2];
    const char* cA = G.a_base(cur); const char* cB = G.b_base(cur);
    PG8_VOFF(vAc, cur);
    PG8_STB(PG8_SB(0, 0), cB, 0); PG8_STA(PG8_SA(0, 0), cA, 0, vAc); PG8_STB(PG8_SB(0, 1), cB, 1); PG8_STA(PG8_SA(0, 1), cA, 1, vAc);
    if (wr == 1) PG8_BAR;
    PG8_WAIT_V(4); PG8_BAR;
    PG8_STB(PG8_SB(1, 0), cB + kstep, 0); PG8_STA(PG8_SA(1, 0), cA + kstep, 0, vAc); PG8_STB(PG8_SB(1, 1), cB + kstep, 1);
    PG8_WAIT_V(6); PG8_BAR;
    for (;;) {
        const bool has_next = S.next(ui + 1, nxt);
        const char* nA = has_next ? G.a_base(nxt) : cA; const char* nB = has_next ? G.b_base(nxt) : cB;
        if constexpr (Geom::GATHER) { if (has_next) PG8_VOFF(vAn, nxt); else {
#pragma unroll
            for (int h = 0; h < 2; ++h) { vAn[h][0] = vAc[h][0]; vAn[h][1] = vAc[h][1]; } } }
        for (int t = 0; t < nt; t += 2) {
            const bool last = (t == nt - 2);
            const char* a1 = cA + (size_t)(t + 1) * kstep;
            const char* a2 = last ? nA : cA + (size_t)(t + 2) * kstep; const char* b2 = last ? nB : cB + (size_t)(t + 2) * kstep;
            const char* a3 = a2 + kstep; const char* b3 = b2 + kstep;
            unsigned v2[2][2];
#pragma unroll
            for (int h = 0; h < 2; ++h) { v2[h][0] = (Geom::GATHER && last) ? vAn[h][0] : vAc[h][0]; v2[h][1] = (Geom::GATHER && last) ? vAn[h][1] : vAc[h][1]; }
            PG8_LDB(B0, 0, 0); PG8_SCHED; PG8_LDA(At, 0, 0); PG8_STA(PG8_SA(1, 1), a1, 1, vAc);
            PG8_WAIT_L(8); PG8_BAR; PG8_WAIT_L(0); PG8_MMA(0, 0, At, B0); PG8_BAR; PG8_SCHED;
            PG8_LDB(B1, 0, 1); PG8_STB(PG8_SB(0, 0), b2, 0);
            PG8_BAR; PG8_WAIT_L(0); PG8_MMA(0, 1, At, B1); PG8_BAR;
            PG8_LDA(At, 0, 1); PG8_STA(PG8_SA(0, 0), a2, 0, v2);
            PG8_BAR; PG8_WAIT_L(0); PG8_MMA(1, 0, At, B0); PG8_BAR; PG8_SCHED;
            PG8_STB(PG8_SB(0, 1), b2, 1);
            PG8_WAIT_V(6); PG8_BAR; PG8_MMA(1, 1, At, B1); PG8_BAR;
            PG8_LDB(B0, 1, 0); PG8_SCHED; PG8_LDA(At, 1, 0); PG8_STA(PG8_SA(0, 1), a2, 1, v2);
            PG8_WAIT_L(8); PG8_BAR; PG8_WAIT_L(0); PG8_MMA(0, 0, At, B0); PG8_BAR; PG8_SCHED;
            PG8_LDB(B1, 1, 1); PG8_STB(PG8_SB(1, 0), b3, 0);
            PG8_BAR; PG8_WAIT_L(0); PG8_MMA(0, 1, At, B1); PG8_BAR;
            PG8_LDA(At, 1, 1); PG8_STA(PG8_SA(1, 0), a3, 0, v2);
            PG8_BAR; PG8_WAIT_L(0); PG8_MMA(1, 0, At, B0); PG8_BAR; PG8_SCHED;
            PG8_STB(PG8_SB(1, 1), b3, 1);
            PG8_WAIT_V(6); PG8_BAR; PG8_MMA(1, 1, At, B1); PG8_BAR;
        }
        E(acc, cur, G.row0(cur), wr, wc, fr, fq);
        if (!has_next) break;
#pragma unroll
        for (int a = 0; a < 2; ++a)
#pragma unroll
            for (int b = 0; b < 2; ++b)
#pragma unroll
                for (int m = 0; m < 4; ++m)
#pragma unroll
                    for (int n = 0; n < 2; ++n) acc[a][b][m][n] = (f32x4){0.f, 0.f, 0.f, 0.f};
        cur = nxt; cA = nA; cB = nB; ++ui;
#pragma unroll
        for (int h = 0; h < 2; ++h) { vAc[h][0] = vAn[h][0]; vAc[h][1] = vAn[h][1]; }
    }
    PG8_WAIT_V(0);
    if (wr == 0) PG8_BAR;
    PG8_BAR;
#undef PG8_VOFF
#undef PG8_SA
#undef PG8_SB
#undef PG8_STAGE
#undef PG8_STA
#undef PG8_STB
#undef PG8_LDA
#undef PG8_LDB
#undef PG8_MMA
#undef PG8_WAIT_V
#undef PG8_WAIT_L
#undef PG8_BAR
#undef PG8_SCHED
}

struct EpiBf16Plain {
    static constexpr bool PERM = true;
    bf16_t* O; int ldc; int coloff;
    __device__ __forceinline__ void operator()(const f32x4 (&acc)[2][2][4][2], const Unit& u, int row0, int wr, int wc, int fr, int fq) const {
        const int r0 = row0 + wr * 64 + fr, col0 = coloff + u.pn * BM + wc * 32 + 8 * fq;
#pragma unroll
        for (int ai = 0; ai < 2; ++ai)
#pragma unroll
            for (int m = 0; m < 4; ++m) { bf16_t* rowp = O + (size_t)(r0 + ai * HALF + m * 16) * ldc + col0;
#pragma unroll
                for (int bj = 0; bj < 2; ++bj) { const f32x4 v0 = acc[ai][bj][m][0], v1 = acc[ai][bj][m][1];
                    u32x4 w; w.x = cvt_pk_bf16(v0[0], v0[1]); w.y = cvt_pk_bf16(v0[2], v0[3]); w.z = cvt_pk_bf16(v1[0], v1[1]); w.w = cvt_pk_bf16(v1[2], v1[3]);
                    *(u32x4*)(rowp + bj * HALF) = w; } }
    }
};
struct EpiInRest {
    static constexpr bool PERM = true;
    unsigned char* ws;
    __device__ __forceinline__ void operator()(const f32x4 (&acc)[2][2][4][2], const Unit& u, int row0, int wr, int wc, int fr, int fq) const {
        const int gcol = OFF_WAQ + u.pn * BM;
        bf16_t* base; int ldc, c0; bool sg = false;
        if (gcol < OFF_WAKV) { base = (bf16_t*)(ws + WS_QWA); ldc = 1024; c0 = gcol - OFF_WAQ; }
        else if (gcol < OFF_NAQ) { base = (bf16_t*)(ws + WS_KVWA); ldc = 512; c0 = gcol - OFF_WAKV; }
        else if (gcol < OFF_NAKV) { base = (bf16_t*)(ws + WS_QNA); ldc = 1024; c0 = gcol - OFF_NAQ; }
        else if (gcol < OFF_GATE) { base = (bf16_t*)(ws + WS_KVNA); ldc = 2048; c0 = gcol - OFF_NAKV; }
        else { base = (bf16_t*)(ws + WS_GATE); ldc = 6144; c0 = gcol - OFF_GATE; sg = true; }
        const int r0 = row0 + wr * 64 + fr, col0 = c0 + wc * 32 + 8 * fq;
#pragma unroll
        for (int ai = 0; ai < 2; ++ai)
#pragma unroll
            for (int m = 0; m < 4; ++m) { bf16_t* rowp = base + (size_t)(r0 + ai * HALF + m * 16) * ldc + col0;
#pragma unroll
                for (int bj = 0; bj < 2; ++bj) { f32x4 v0 = acc[ai][bj][m][0], v1 = acc[ai][bj][m][1];
                    if (sg) {
#pragma unroll
                        for (int j = 0; j < 4; ++j) { v0[j] = sigmoid_f(v0[j]); v1[j] = sigmoid_f(v1[j]); } }
                    u32x4 w; w.x = cvt_pk_bf16(v0[0], v0[1]); w.y = cvt_pk_bf16(v0[2], v0[3]); w.z = cvt_pk_bf16(v1[0], v1[1]); w.w = cvt_pk_bf16(v1[2], v1[3]);
                    *(u32x4*)(rowp + bj * HALF) = w; } }
    }
};
template <int BR> struct EpiMergeF {
    static constexpr bool PERM = false;
    unsigned char* ws;
    __device__ __forceinline__ void operator()(const f32x4 (&acc)[2][2][4][2], const Unit& u, int row0, int wr, int wc, int fr, int fq) const {
        const int r0 = row0 + wr * 64 + fr, col0 = u.pn * BM + wc * 32 + 4 * fq;
#pragma unroll
        for (int ai = 0; ai < 2; ++ai)
#pragma unroll
            for (int m = 0; m < 4; ++m) { const size_t row = (size_t)(r0 + ai * HALF + m * 16);
                const bf16_t* gp = (const bf16_t*)(ws + WS_GATE) + row * 6144 + BR * 2048 + col0;
                float* mp = (float*)(ws + WS_MPART) + row * D + col0; bf16_t* ob = (bf16_t*)(ws + WS_MB) + row * D + col0;
#pragma unroll
                for (int bj = 0; bj < 2; ++bj)
#pragma unroll
                    for (int n = 0; n < 2; ++n) { const int co = bj * HALF + n * 16;
                        const u32x2 gg = *(const u32x2*)(gp + co);
                        const f32x4 g = {__uint_as_float(gg.x << 16), __uint_as_float(gg.x & 0xffff0000u), __uint_as_float(gg.y << 16), __uint_as_float(gg.y & 0xffff0000u)};
                        f32x4 t = g * acc[ai][bj][m][n];
                        if (BR > 0) t += *(const f32x4*)(mp + co);
                        if (BR < 2) *(f32x4*)(mp + co) = t;
                        else { u32x2 w; w.x = cvt_pk_bf16(t[0], t[1]); w.y = cvt_pk_bf16(t[2], t[3]); *(u32x2*)(ob + co) = w; } } }
    }
};
struct EpiOutF {
    static constexpr bool PERM = false;
    const Ctx* c; int layer;
    __device__ __forceinline__ void operator()(const f32x4 (&acc)[2][2][4][2], const Unit& u, int row0, int wr, int wc, int fr, int fq) const {
        const int r0 = row0 + wr * 64 + fr, col0 = u.pn * BM + wc * 32 + 4 * fq;
#pragma unroll
        for (int ai = 0; ai < 2; ++ai)
#pragma unroll
            for (int m = 0; m < 4; ++m) { const int row = r0 + ai * HALF + m * 16;
                const float* xin = c->xrow(layer, row) + col0; const float* g = c->mod(layer, row < L ? 0 : 1, 2) + col0;
                float* o = (float*)(c->ws + WS_XA) + (size_t)row * D + col0;
#pragma unroll
                for (int bj = 0; bj < 2; ++bj)
#pragma unroll
                    for (int n = 0; n < 2; ++n) { const int co = bj * HALF + n * 16;
                        *(f32x4*)(o + co) = *(const f32x4*)(xin + co) + *(const f32x4*)(g + co) * acc[ai][bj][m][n]; } }
    }
};
struct EpiGU {
    static constexpr bool PERM = false;
    bf16_t* act;
    __device__ __forceinline__ void operator()(const f32x4 (&acc)[2][2][4][2], const Unit& u, int row0, int wr, int wc, int fr, int fq) const {
        const int r0 = row0 + wr * 64 + fr, f0 = u.pn * 128 + wc * 16 + 4 * fq;
#pragma unroll
        for (int ai = 0; ai < 2; ++ai)
#pragma unroll
            for (int m = 0; m < 4; ++m) { bf16_t* rowp = act + (size_t)(r0 + ai * HALF + m * 16) * DF + f0;
#pragma unroll
                for (int bj = 0; bj < 2; ++bj) { const f32x4 a = acc[ai][bj][m][0], uu = acc[ai][bj][m][1]; f32x4 t;
#pragma unroll
                    for (int j = 0; j < 4; ++j) t[j] = silu_f(a[j]) * uu[j];
                    u32x2 w; w.x = cvt_pk_bf16(t[0], t[1]); w.y = cvt_pk_bf16(t[2], t[3]); *(u32x2*)(rowp + bj * 64) = w; } }
    }
};
}

template <class RowMap>
__device__ __forceinline__ void transpose_item(const float* __restrict__ W, int K, int N, bf16_t* WT, const RowMap& rm, float* scr, int item, int lane) {
    const int nblk = N / 32, kb = item / nblk, nb = item % nblk, k0 = 64 * kb, n0 = 32 * nb;
#pragma unroll 8
    for (int i = 0; i < 32; ++i) { const int kk = 2 * i + (lane >> 5); scr[kk * 33 + (lane & 31)] = W[(size_t)(k0 + kk) * N + n0 + (lane & 31)]; }
    LDS_FENCE();
    const int cq = lane & 7;
#pragma unroll
    for (int j = 0; j < 4; ++j) { const int n = (lane >> 3) + 8 * j; const float* sp = scr + (8 * cq) * 33 + n;
        uint4 o; o.x = pk2(sp[0 * 33], sp[1 * 33]); o.y = pk2(sp[2 * 33], sp[3 * 33]); o.z = pk2(sp[4 * 33], sp[5 * 33]); o.w = pk2(sp[6 * 33], sp[7 * 33]);
        *(uint4*)(WT + (size_t)rm(n0 + n) * K + k0 + 8 * cq) = o; }
    LDS_FENCE();
}
struct RmPlain { int off; __device__ __forceinline__ int operator()(int n) const { return off + n; } };
struct RmGU { int off; __device__ __forceinline__ int operator()(int f) const { return off + 32 * (f >> 4) + (f & 15); } };
__device__ __forceinline__ void ph_conv(const Ctx& c, int layer) {
    __syncthreads();
    float* scr = (float*)c.smem + c.wave * (64 * 33);
    const int gw = c.bid * 8 + c.wave, ngw = c.nb * 8;
    constexpr int I_IN = (D / 64) * (NIN / 32), I_BR = (1024 / 64) * (D / 32), I_OUT = (D / 64) * (D / 32), I_G = (D / 64) * (DF / 32), I_DN = (DF / 64) * (D / 32);
    constexpr int NITEMS = I_IN + 3 * I_BR + I_OUT + NE * (2 * I_G + I_DN);
    for (int it = gw; it < NITEMS; it += ngw) {
        int r = it;
        if (r < I_IN) { transpose_item(c.in[7] + (size_t)layer * D * NIN, D, NIN, c.wsp<bf16_t>(WS_WIN), RmPlain{0}, scr, r, c.lane); continue; } r -= I_IN;
        if (r < 3 * I_BR) { const int b = r / I_BR; transpose_item(c.in[24] + ((size_t)layer * 3 + b) * 1024 * D, 1024, D, c.wsp<bf16_t>(WS_WBR) + (size_t)b * D * 1024, RmPlain{0}, scr, r % I_BR, c.lane); continue; } r -= 3 * I_BR;
        if (r < I_OUT) { transpose_item(c.in[25] + (size_t)layer * D * D, D, D, c.wsp<bf16_t>(WS_WOUT), RmPlain{0}, scr, r, c.lane); continue; } r -= I_OUT;
        const int e = r / (2 * I_G + I_DN); r -= e * (2 * I_G + I_DN);
        if (r < I_G) { transpose_item(c.in[28] + ((size_t)layer * NE + e) * D * DF, D, DF, c.wsp<bf16_t>(WS_WGU), RmGU{e * 2048}, scr, r, c.lane); continue; } r -= I_G;
        if (r < I_G) { transpose_item(c.in[29] + ((size_t)layer * NE + e) * D * DF, D, DF, c.wsp<bf16_t>(WS_WGU), RmGU{e * 2048 + 16}, scr, r, c.lane); continue; } r -= I_G;
        transpose_item(c.in[30] + ((size_t)layer * NE + e) * DF * D, DF, D, c.wsp<bf16_t>(WS_WDN) + (size_t)e * D * DF, RmPlain{0}, scr, r, c.lane);
    }
}

__device__ __forceinline__ void ph_g0(const Ctx& c) {
    float* lds = (float*)c.smem;
    for (int u = c.bid; u < 2 * 256; u += c.nb) {
        const int layer = u >> 8, n0 = (u & 255) * 48;
        __syncthreads();
        for (int k = c.tid; k < D; k += NTHREADS) { lds[k] = silu_f(c.in[1][k]); lds[D + k] = silu_f(c.in[3][k]); }
        __syncthreads();
        const int col = c.tid % 48, kg = c.tid / 48;
        float a0 = 0.f, a1 = 0.f;
        if (kg < 10) {
            const float* w = c.in[4] + (size_t)layer * D * NMOD + n0 + col;
            for (int k = kg; k < D; k += 10) { const float wv = w[(size_t)k * NMOD]; a0 = fmaf(lds[k], wv, a0); a1 = fmaf(lds[D + k], wv, a1); }
        }
        float* red = lds + 2 * D;
        if (kg < 10) { red[(kg * 48 + col) * 2] = a0; red[(kg * 48 + col) * 2 + 1] = a1; }
        __syncthreads();
        if (c.tid < 96) {
            const int cc = c.tid >> 1, s = c.tid & 1; float t = 0.f;
            for (int g = 0; g < 10; ++g) t += red[(g * 48 + cc) * 2 + s];
            t += c.in[5][(size_t)layer * NMOD + n0 + cc];
            c.wsp<float>(WS_MOD)[(size_t)(layer * 2 + s) * NMOD + n0 + cc] = t;
        }
    }
    const int gw = c.bid * 8 + c.wave, ngw = c.nb * 8;
    for (int task = gw; task < 2 * MR; task += ngw) {
        const int layer = task / MR, pos = task % MR;
        const bool isc = pos >= L; const int i = isc ? pos - L : pos; const int Lx = isc ? LC : L;
        const float tt = (float)i * (1.0f / (float)(Lx - 1));
        const float c0 = (float)(2.0 * 3.14159265358979323846 / (double)Lx);
        const int j = c.lane;
        float feat = 0.f;
        if (j == 0) feat = tt;
        else if (j < 33) { const int b = (j - 1) & 15; const float band = 1e-4f + (float)b * ((15.0f - 1e-4f) / 15.0f); const float ang = (c0 * band) * (float)i; feat = (j <= 16) ? cosf(ang) : -sinf(ang); }
        const float* fw1 = c.in[10] + (size_t)layer * 33 * 64; const float* fb1 = c.in[11] + layer * 64;
        const float* fw2 = c.in[12] + (size_t)layer * 64 * 64; const float* fb2 = c.in[13] + layer * 64;
        const float* fr = c.in[15] + layer * 128;
        float s = fb1[j];
        for (int f = 0; f < 33; ++f) s = fmaf(__shfl(feat, f), fw1[f * 64 + j], s);
        const float h1 = sinf(fr[j] * s);
        float s2 = fb2[j];
        for (int m = 0; m < 64; ++m) s2 = fmaf(__shfl(h1, m), fw2[m * 64 + j], s2);
        const float h2 = sinf(fr[64 + j] * s2);
        c.wsp<float>(WS_H2F)[((size_t)layer * MR + pos) * 64 + j] = h2;
    }
}

__device__ __forceinline__ void ph_a(const Ctx& c, int layer) {
    const int gw = c.bid * 8 + c.wave, ngw = c.nb * 8;
    const float* g = c.in[6] + (size_t)layer * D;
    for (int r = gw; r < MR; r += ngw) {
        const float* x = c.xrow(layer, r);
        const int src = r < L ? 0 : 1;
        const float* sh = c.mod(layer, src, 0); const float* sc = c.mod(layer, src, 1);
        float4 v[8]; float ss = 0.f;
#pragma unroll
        for (int j = 0; j < 8; ++j) { v[j] = *(const float4*)(x + 4 * c.lane + 256 * j); ss += v[j].x * v[j].x + v[j].y * v[j].y + v[j].z * v[j].z + v[j].w * v[j].w; }
        ss = wave_sum(ss);
        const float inv = rsqrtf(ss * (1.0f / D) + RMS_EPS);
        bf16_t* o = c.wsp<bf16_t>(WS_HX) + (size_t)r * D;
#pragma unroll
        for (int j = 0; j < 8; ++j) {
            const int col = 4 * c.lane + 256 * j;
            const float4 gg = *(const float4*)(g + col), s4 = *(const float4*)(sh + col), c4 = *(const float4*)(sc + col);
            const float y0 = v[j].x * inv * gg.x * (1.f + c4.x) + s4.x, y1 = v[j].y * inv * gg.y * (1.f + c4.y) + s4.y;
            const float y2 = v[j].z * inv * gg.z * (1.f + c4.z) + s4.z, y3 = v[j].w * inv * gg.w * (1.f + c4.w) + s4.w;
            uint2 w; w.x = pk2(y0, y1); w.y = pk2(y2, y3);
            *(uint2*)(o + col) = w;
        }
    }
    float* hs = (float*)c.smem;
    const float* fw3 = c.in[14] + (size_t)layer * 64 * 4096;
    const float* dec = c.in[16] + (size_t)layer * 4096;
    for (int u = c.bid; u < 260; u += c.nb) {
        const bool isc = u >= 256; const int p0 = isc ? (u - 256) * 64 : u * 64; const int Lx = isc ? LC : L;
        __syncthreads();
        const float* h2f = c.wsp<float>(WS_H2F) + ((size_t)layer * MR + (isc ? L : 0) + p0) * 64;
        for (int e = c.tid; e < 64 * 64; e += NTHREADS) hs[e] = h2f[e];
        __syncthreads();
        for (int cb = 0; cb < 8; ++cb) {
            const int col = cb * 512 + c.tid;
            float w[64];
#pragma unroll
            for (int j = 0; j < 64; ++j) w[j] = fw3[j * 4096 + col];
            const float rate = fabsf(dec[col]);
            bf16_t* dst = isc ? c.wsp<bf16_t>(WS_KFC) + (size_t)col * LC + p0 : c.wsp<bf16_t>(WS_KF) + (size_t)col * L + p0;
#pragma unroll 1
            for (int p = 0; p < 64; p += 2) {
                float s0 = 0.f, s1 = 0.f;
#pragma unroll
                for (int j = 0; j < 64; j += 4) {
                    const float4 h4 = *(const float4*)&hs[p * 64 + j]; const float4 g4 = *(const float4*)&hs[(p + 1) * 64 + j];
                    s0 = fmaf(h4.x, w[j], s0); s0 = fmaf(h4.y, w[j + 1], s0); s0 = fmaf(h4.z, w[j + 2], s0); s0 = fmaf(h4.w, w[j + 3], s0);
                    s1 = fmaf(g4.x, w[j], s1); s1 = fmaf(g4.y, w[j + 1], s1); s1 = fmaf(g4.z, w[j + 2], s1); s1 = fmaf(g4.w, w[j + 3], s1);
                }
                const float t0 = (float)(p0 + p) * (1.0f / (float)(Lx - 1)), t1 = (float)(p0 + p + 1) * (1.0f / (float)(Lx - 1));
                *(unsigned*)(dst + p) = pk2(s0 * (__expf(-t0 * rate) + 0.05f), s1 * (__expf(-t1 * rate) + 0.05f));
            }
        }
    }
}

struct EpiIn {
    unsigned char* ws;
    __device__ __forceinline__ void operator()(int row, int col, const float (&v)[8]) const {
        if (col < OFF_WAQ) {
            bf16_t* d = (bf16_t*)(ws + WS_ZHYT);
#pragma unroll
            for (int j = 0; j < 8; ++j) d[(size_t)(col + j) * MR + row] = f2bf(v[j]);
            return;
        }
        bf16_t* dst; float t[8];
#pragma unroll
        for (int j = 0; j < 8; ++j) t[j] = v[j];
        if (col < OFF_WAKV) dst = (bf16_t*)(ws + WS_QWA) + (size_t)row * 1024 + (col - OFF_WAQ);
        else if (col < OFF_NAQ) dst = (bf16_t*)(ws + WS_KVWA) + (size_t)row * 512 + (col - OFF_WAKV);
        else if (col < OFF_NAKV) dst = (bf16_t*)(ws + WS_QNA) + (size_t)row * 1024 + (col - OFF_NAQ);
        else if (col < OFF_GATE) dst = (bf16_t*)(ws + WS_KVNA) + (size_t)row * 2048 + (col - OFF_NAKV);
        else { dst = (bf16_t*)(ws + WS_GATE) + (size_t)row * 6144 + (col - OFF_GATE);
#pragma unroll
            for (int j = 0; j < 8; ++j) t[j] = sigmoid_f(t[j]); }
        uint4 o; o.x = pk2(t[0], t[1]); o.y = pk2(t[2], t[3]); o.z = pk2(t[4], t[5]); o.w = pk2(t[6], t[7]);
        *(uint4*)dst = o;
    }
};
__device__ __forceinline__ void ph_b(const Ctx& c, int layer) {
    const RowLin rp{c.wsp<bf16_t>(WS_HX), D};
    const EpiIn ep{c.ws};
    const float* W = c.in[7] + (size_t)layer * D * NIN;
    const int nM = MR / 128, nN = NIN / 128;
    for (int u = c.bid; u < nM * nN; u += c.nb) {
        const int pm = u % nM, pn = u / nM;
        sgemm_unit(rp, W, NIN, D, pm * 128, pn * 128, ep, (float*)c.smem, c.tid);
    }
}

__device__ __forceinline__ void ph_b2(const Ctx& c, int layer) {
    const int gw = c.bid * 8 + c.wave, ngw = c.nb * 8;
    const int lane = c.lane;
    const int dlo = lane < 32 ? lane : lane + 32, dhi = dlo + 32;
    const int f = lane & 31, ax = lane >> 5;
    const float invf = powf(10000.0f, -(float)f / 32.0f);
    for (int task = gw; task < MR * 26; task += ngw) {
        const int r = task / 26, s = task % 26;
        bf16_t* p; const float* gain; bool rope;
        if (s < 8) { p = c.wsp<bf16_t>(WS_QWA) + (size_t)r * 1024 + s * 128; gain = c.in[18] + layer * 128; rope = true; }
        else if (s < 10) { p = c.wsp<bf16_t>(WS_KVWA) + (size_t)r * 512 + (s - 8) * 128; gain = c.in[19] + layer * 128; rope = true; }
        else if (s < 18) { p = c.wsp<bf16_t>(WS_QNA) + (size_t)r * 1024 + (s - 10) * 128; gain = c.in[21] + layer * 128; rope = false; }
        else { p = c.wsp<bf16_t>(WS_KVNA) + (size_t)r * 2048 + (s - 18) * 128; gain = c.in[22] + layer * 128; rope = false; }
        float a = bf2f(p[dlo]), b = bf2f(p[dhi]);
        const float ss = wave_sum(a * a + b * b);
        const float inv = rsqrtf(ss * (1.0f / 128.0f) + RMS_EPS);
        a = a * inv * gain[dlo]; b = b * inv * gain[dhi];
        if (rope && r < L) {
            const float pos = ax == 0 ? (float)(r / GRIDW) : (float)(r % GRIDW);
            const float ang = pos * invf; const float cs = cosf(ang), sn = sinf(ang);
            const float na = a * cs - b * sn, nb2 = b * cs + a * sn; a = na; b = nb2;
        }
        p[dlo] = f2bf(a); p[dhi] = f2bf(b);
    }
}

__device__ __forceinline__ float shortconv_at(const bf16_t* z, int t, int Lx, float w0, float w1, float w2, float b) {
    const float zm = t > 0 ? bf2f(z[t - 1]) : 0.f, z0 = bf2f(z[t]), zp = t + 1 < Lx ? bf2f(z[t + 1]) : 0.f;
    return zm * w0 + z0 * w1 + zp * w2 + b;
}
__device__ __forceinline__ float block_sum(float v, float* red, int tid) {
    v = wave_sum(v);
    __syncthreads();
    if ((tid & 63) == 0) red[tid >> 6] = v;
    __syncthreads();
    float t = 0.f;
#pragma unroll
    for (int w = 0; w < 8; ++w) t += red[w];
    return t;
}
__device__ __forceinline__ void hyena_direct_unit(const Ctx& c, int layer, int ch) {
    bf16_t* kc = (bf16_t*)c.smem;
    float* cv = (float*)c.smem;
    float* us = (float*)(c.smem + 4 * L);
    float* red = us + L;
    const int tid = c.tid;
    const float* cw = c.in[8] + (size_t)layer * 3 * 3072; const float* cb = c.in[9] + (size_t)layer * 3072;
    const bf16_t* zv = c.wsp<bf16_t>(WS_ZHYT) + (size_t)ch * MR;
    const bf16_t* z1 = c.wsp<bf16_t>(WS_ZHYT) + (size_t)(1024 + ch) * MR;
    const bf16_t* z2 = c.wsp<bf16_t>(WS_ZHYT) + (size_t)(2048 + ch) * MR;
    const bf16_t* KF = c.wsp<bf16_t>(WS_KF);
    __syncthreads();
    { const float w0 = cw[ch], w1 = cw[3072 + ch], w2 = cw[6144 + ch], b = cb[ch];
#pragma unroll 2
      for (int t = tid; t < L; t += NTHREADS) us[t] = shortconv_at(zv, t, L, w0, w1, w2, b); }
    for (int o = 0; o < 2; ++o) {
        const bf16_t* hf = KF + (size_t)(o * 1024 + ch) * L;
        const bf16_t* hb = KF + (size_t)(2048 + o * 1024 + ch) * L;
        float sabs = 0.f;
#pragma unroll 2
        for (int t = tid; t < L; t += NTHREADS) {
            bf16_t kf = hf[t], kb = hb[t];
            if (t == 0) { kf = f2bf(bf2f(kf) + bf2f(kb)); kb = 0; }
            kc[L + t] = kf; kc[L - t] = (t == 0) ? kf : kb;
            sabs += fabsf(bf2f(kf)) + fabsf(bf2f(kb));
        }
        if (tid == 0) kc[0] = 0;
        const float S = block_sum(sabs, red, tid);
        {
            float acc[32];
#pragma unroll
            for (int j = 0; j < 32; ++j) acc[j] = 0.f;
#pragma unroll 2
            for (int s = 0; s < L; ++s) {
                const float uv = us[s];
                const bf16_t* kp = kc + (L + tid - s);
#pragma unroll
                for (int j = 0; j < 32; ++j) acc[j] = fmaf(uv, bf2f(kp[512 * j]), acc[j]);
            }
            __syncthreads();
#pragma unroll
            for (int j = 0; j < 32; ++j) cv[tid + 512 * j] = acc[j];
        }
        LDS_FENCE();
        const float invS = 1.0f / S;
        const float dsk = c.in[17][(size_t)layer * 2048 + o * 1024 + ch];
        const int co = o == 0 ? 1024 : 2048;
        const bf16_t* zz = o == 0 ? z1 : z2;
        const float w0 = cw[co + ch], w1 = cw[3072 + co + ch], w2 = cw[6144 + co + ch], b = cb[co + ch];
        bf16_t* dst = c.wsp<bf16_t>(WS_YHYT) + (size_t)ch * L;
#pragma unroll 2
        for (int t = tid; t < L; t += NTHREADS) {
            const float r = shortconv_at(zz, t, L, w0, w1, w2, b) * (cv[t] * invS + us[t] * dsk);
            if (o == 0) us[t] = r; else dst[t] = f2bf(r);
        }
        __syncthreads();
    }
}
__device__ __forceinline__ void hyena_ctx_unit(const Ctx& c, int layer, int ch) {
    float* kc = (float*)c.smem;
    float* us = kc + 512;
    float* red = us + 256;
    const int tid = c.tid;
    const float* cw = c.in[8] + (size_t)layer * 3 * 3072; const float* cb = c.in[9] + (size_t)layer * 3072;
    const bf16_t* zv = c.wsp<bf16_t>(WS_ZHYT) + (size_t)ch * MR + L;
    const bf16_t* z1 = c.wsp<bf16_t>(WS_ZHYT) + (size_t)(1024 + ch) * MR + L;
    const bf16_t* z2 = c.wsp<bf16_t>(WS_ZHYT) + (size_t)(2048 + ch) * MR + L;
    const bf16_t* KF = c.wsp<bf16_t>(WS_KFC);
    __syncthreads();
    if (tid < LC) us[tid] = shortconv_at(zv, tid, LC, cw[ch], cw[3072 + ch], cw[6144 + ch], cb[ch]);
    for (int o = 0; o < 2; ++o) {
        const bf16_t* hf = KF + (size_t)(o * 1024 + ch) * LC;
        const bf16_t* hb = KF + (size_t)(2048 + o * 1024 + ch) * LC;
        float sabs = 0.f;
        {
            const int lag = tid - 256; float k;
            if (lag == 0) k = bf2f(hf[0]) + bf2f(hb[0]); else if (lag > 0) k = bf2f(hf[lag]); else if (lag > -256) k = bf2f(hb[-lag]); else k = 0.f;
            kc[tid] = k; sabs = fabsf(k);
        }
        const float S = block_sum(sabs, red, tid);
        float acc = 0.f;
        if (tid < LC) for (int s = 0; s < LC; ++s) acc = fmaf(us[s], kc[256 + tid - s], acc);
        const float dsk = c.in[17][(size_t)layer * 2048 + o * 1024 + ch];
        float res = 0.f;
        if (tid < LC) {
            const bf16_t* zz = o == 0 ? z1 : z2; const int co = o == 0 ? 1024 : 2048;
            res = shortconv_at(zz, tid, LC, cw[co + ch], cw[3072 + co + ch], cw[6144 + co + ch], cb[co + ch]) * (acc / S + us[tid] * dsk);
        }
        __syncthreads();
        if (tid < LC) { if (o == 0) us[tid] = res; else c.wsp<bf16_t>(WS_YHY)[(size_t)(L + tid) * 1024 + ch] = f2bf(res); }
        __syncthreads();
    }
}

template <class KeyFn>
__device__ __forceinline__ void wave_attn(const bf16_t* q, int nkeys, const KeyFn& key, bool has_sink, float sink, bf16_t* out, float* wl, int lane) {
    float* qf = wl;
    float* sc = wl + 128;
    qf[2 * lane] = bf2f(q[2 * lane]); qf[2 * lane + 1] = bf2f(q[2 * lane + 1]);
    LDS_FENCE();
    float mx = -3.0e38f;
    for (int j = lane; j < nkeys; j += 64) {
        const bf16_t* kp; const bf16_t* vp; float bias;
        float s = -1e30f;
        if (key(j, kp, vp, bias)) {
            float d = 0.f;
#pragma unroll
            for (int e = 0; e < 128; e += 8) {
                const uint4 kk = *(const uint4*)(kp + e);
                d = fmaf(qf[e + 0], __uint_as_float(kk.x << 16), d); d = fmaf(qf[e + 1], __uint_as_float(kk.x & 0xffff0000u), d);
                d = fmaf(qf[e + 2], __uint_as_float(kk.y << 16), d); d = fmaf(qf[e + 3], __uint_as_float(kk.y & 0xffff0000u), d);
                d = fmaf(qf[e + 4], __uint_as_float(kk.z << 16), d); d = fmaf(qf[e + 5], __uint_as_float(kk.z & 0xffff0000u), d);
                d = fmaf(qf[e + 6], __uint_as_float(kk.w << 16), d); d = fmaf(qf[e + 7], __uint_as_float(kk.w & 0xffff0000u), d);
            }
            s = d * QK_SCALE + bias;
        }
        sc[j] = s; mx = fmaxf(mx, s);
    }
    if (has_sink) mx = fmaxf(mx, sink);
    mx = wave_max(mx);
    float sum = 0.f;
    for (int j = lane; j < nkeys; j += 64) { const float p = __expf(sc[j] - mx); sc[j] = p; sum += p; }
    sum = wave_sum(sum);
    if (has_sink) sum += __expf(sink - mx);
    LDS_FENCE();
    float o0 = 0.f, o1 = 0.f;
    for (int j = 0; j < nkeys; ++j) {
        const float p = sc[j];
        if (p != 0.f) {
            const bf16_t* kp; const bf16_t* vp; float bias;
            key(j, kp, vp, bias);
            const unsigned vv = *(const unsigned*)(vp + 2 * lane);
            o0 = fmaf(p, __uint_as_float(vv << 16), o0); o1 = fmaf(p, __uint_as_float(vv & 0xffff0000u), o1);
        }
    }
    const float inv = 1.0f / sum;
    *(unsigned*)(out + 2 * lane) = pk2(o0 * inv, o1 * inv);
    LDS_FENCE();
}

struct KeyWA {
    const bf16_t* kv; int t, kvh;
    __device__ __forceinline__ bool operator()(int j, const bf16_t*& kp, const bf16_t*& vp, float& bias) const {
        bias = 0.f;
        int row; bool ok = true;
        if (j < 257) { const int kpos = t - 128 + j; ok = kpos >= 0 && kpos < L; row = ok ? kpos : 0; } else row = L + (j - 257);
        kp = kv + (size_t)row * 512 + kvh * 128; vp = kp + 256; return ok;
    }
};
struct KeyCtxWA { const bf16_t* kv; int kvh;
    __device__ __forceinline__ bool operator()(int j, const bf16_t*& kp, const bf16_t*& vp, float& bias) const { bias = 0.f; kp = kv + (size_t)(L + j) * 512 + kvh * 128; vp = kp + 256; return true; } };
struct KeyNA {
    const bf16_t* kv; const float* rpb; int r, qc, r0, cs, h;
    __device__ __forceinline__ bool operator()(int j, const bf16_t*& kp, const bf16_t*& vp, float& bias) const {
        int row;
        if (j < 128) { const int w = j >> 4, kc = cs + (j & 15); row = (r0 + w) * GRIDW + kc;
            const int dr = r0 + w - r + 7; int dc = kc - qc + 15; dc = dc < 0 ? 0 : (dc > 30 ? 30 : dc);
            bias = rpb[(h * 15 + dr) * 31 + dc]; }
        else { row = L + (j - 128); bias = 0.f; }
        kp = kv + (size_t)row * 2048 + h * 128; vp = kp + 1024; return true;
    }
};
struct KeyCtxNA { const bf16_t* kv; int h;
    __device__ __forceinline__ bool operator()(int j, const bf16_t*& kp, const bf16_t*& vp, float& bias) const { bias = 0.f; kp = kv + (size_t)(L + j) * 2048 + h * 128; vp = kp + 1024; return true; } };

__device__ __forceinline__ void ph_c(const Ctx& c, int layer) {
#ifndef NO_HY
    for (int u = c.bid; u < 1024; u += c.nb) hyena_direct_unit(c, layer, u);
#endif
#ifndef NO_HYC
    if (layer == 0) for (int u = c.bid; u < 1024; u += c.nb) hyena_ctx_unit(c, layer, u);
#endif
    __syncthreads();
#ifndef NO_ATT
    const int gw = c.bid * 8 + c.wave, ngw = c.nb * 8;
    float* wl = (float*)c.smem + c.wave * 768;
    const int nrows = layer == 0 ? MR : L;
    const float* sinkp = c.in[20] + layer * 8;
    const float* rpb = c.in[23] + (size_t)layer * 8 * 15 * 31;
    const bf16_t* kvwa = c.wsp<bf16_t>(WS_KVWA); const bf16_t* kvna = c.wsp<bf16_t>(WS_KVNA);
    for (int task = gw; task < nrows * 16; task += ngw) {
        const int r = task >> 4, hh = task & 15;
        if (hh < 8) {
            const int h = hh; const bf16_t* q = c.wsp<bf16_t>(WS_QWA) + (size_t)r * 1024 + h * 128; bf16_t* o = c.wsp<bf16_t>(WS_YWA) + (size_t)r * 1024 + h * 128;
            if (r < L) { const KeyWA k{kvwa, r, h >> 2}; wave_attn(q, 513, k, true, sinkp[h], o, wl, c.lane); }
            else { const KeyCtxWA k{kvwa, h >> 2}; wave_attn(q, 256, k, true, sinkp[h], o, wl, c.lane); }
        } else {
            const int h = hh - 8; const bf16_t* q = c.wsp<bf16_t>(WS_QNA) + (size_t)r * 1024 + h * 128; bf16_t* o = c.wsp<bf16_t>(WS_YNA) + (size_t)r * 1024 + h * 128;
            if (r < L) { const int gr = r / GRIDW, qc = r % GRIDW; int r0 = gr - 4; r0 = r0 < 0 ? 0 : (r0 > 248 ? 248 : r0); int cs = qc - 8; cs = cs < 0 ? 0 : (cs > 48 ? 48 : cs);
                const KeyNA k{kvna, rpb, gr, qc, r0, cs, h}; wave_attn(q, 384, k, false, 0.f, o, wl, c.lane); }
            else { const KeyCtxNA k{kvna, h}; wave_attn(q, 256, k, false, 0.f, o, wl, c.lane); }
        }
    }
#endif
}

__device__ __forceinline__ void ph_c2(const Ctx& c) {
    bf16_t* tile = (bf16_t*)c.smem;
    const bf16_t* src = c.wsp<bf16_t>(WS_YHYT); bf16_t* dst = c.wsp<bf16_t>(WS_YHY);
    for (int u = c.bid; u < (1024 / 64) * (L / 64); u += c.nb) {
        const int c0 = (u % 16) * 64, t0 = (u / 16) * 64;
        __syncthreads();
        for (int e = c.tid; e < 4096; e += NTHREADS) { const int cc = e >> 6, tt = e & 63; tile[cc * 66 + tt] = src[(size_t)(c0 + cc) * L + t0 + tt]; }
        __syncthreads();
        for (int e = c.tid; e < 4096; e += NTHREADS) { const int tt = e >> 6, cc = e & 63; dst[(size_t)(t0 + tt) * 1024 + c0 + cc] = tile[cc * 66 + tt]; }
    }
}

struct EpiMerge { unsigned char* ws; int b;
    __device__ __forceinline__ void operator()(int row, int col, const float (&v)[8]) const {
        const bf16_t* g = (const bf16_t*)(ws + WS_GATE) + (size_t)row * 6144 + b * 2048 + col;
        float* mp = (float*)(ws + WS_MPART) + (size_t)row * D + col;
        const uint4 gg = *(const uint4*)g;
        const float gv[8] = {__uint_as_float(gg.x << 16), __uint_as_float(gg.x & 0xffff0000u), __uint_as_float(gg.y << 16), __uint_as_float(gg.y & 0xffff0000u),
                             __uint_as_float(gg.z << 16), __uint_as_float(gg.z & 0xffff0000u), __uint_as_float(gg.w << 16), __uint_as_float(gg.w & 0xffff0000u)};
        float t[8];
        if (b == 0) {
#pragma unroll
            for (int j = 0; j < 8; ++j) t[j] = gv[j] * v[j];
        } else {
            const float4 p0 = *(const float4*)mp, p1 = *(const float4*)(mp + 4);
            const float pv[8] = {p0.x, p0.y, p0.z, p0.w, p1.x, p1.y, p1.z, p1.w};
#pragma unroll
            for (int j = 0; j < 8; ++j) t[j] = fmaf(gv[j], v[j], pv[j]);
        }
        if (b < 2) { *(float4*)mp = make_float4(t[0], t[1], t[2], t[3]); *(float4*)(mp + 4) = make_float4(t[4], t[5], t[6], t[7]); }
        else { uint4 o; o.x = pk2(t[0], t[1]); o.y = pk2(t[2], t[3]); o.z = pk2(t[4], t[5]); o.w = pk2(t[6], t[7]); *(uint4*)((bf16_t*)(ws + WS_MB) + (size_t)row * D + col) = o; }
    }
};
__device__ __forceinline__ void ph_d(const Ctx& c, int layer) {
    const int nM = MR / 128, nN = D / 128;
    for (int b = 0; b < 3; ++b) {
        const bf16_t* A = b == 0 ? c.wsp<bf16_t>(WS_YHY) : (b == 1 ? c.wsp<bf16_t>(WS_YWA) : c.wsp<bf16_t>(WS_YNA));
        const RowLin rp{A, 1024}; const EpiMerge ep{c.ws, b};
        const float* W = c.in[24] + ((size_t)layer * 3 + b) * 1024 * D;
        for (int u = c.bid; u < nM * nN; u += c.nb) sgemm_unit(rp, W, D, 1024, (u % nM) * 128, (u / nM) * 128, ep, (float*)c.smem, c.tid);
    }
}
struct EpiOut { const Ctx* c; int layer;
    __device__ __forceinline__ void operator()(int row, int col, const float (&v)[8]) const {
        const float* xin = c->xrow(layer, row) + col; const float* g = c->mod(layer, row < L ? 0 : 1, 2) + col;
        float* o = (float*)(c->ws + WS_XA) + (size_t)row * D + col;
        const float4 x0 = *(const float4*)xin, x1 = *(const float4*)(xin + 4), g0 = *(const float4*)g, g1 = *(const float4*)(g + 4);
        *(float4*)o = make_float4(x0.x + g0.x * v[0], x0.y + g0.y * v[1], x0.z + g0.z * v[2], x0.w + g0.w * v[3]);
        *(float4*)(o + 4) = make_float4(x1.x + g1.x * v[4], x1.y + g1.y * v[5], x1.z + g1.z * v[6], x1.w + g1.w * v[7]);
    }
};
__device__ __forceinline__ void ph_e(const Ctx& c, int layer) {
    const int nM = MR / 128, nN = D / 128;
    const RowLin rp{c.wsp<bf16_t>(WS_MB), D}; const EpiOut ep{&c, layer};
    const float* W = c.in[25] + (size_t)layer * D * D;
    for (int u = c.bid; u < nM * nN; u += c.nb) sgemm_unit(rp, W, D, D, (u % nM) * 128, (u / nM) * 128, ep, (float*)c.smem, c.tid);
}

__device__ __forceinline__ void ph_f(const Ctx& c, int layer) {
    const int gw = c.bid * 8 + c.wave, ngw = c.nb * 8;
    const float* g = c.in[26] + (size_t)layer * D;
    const float* wr = c.in[27] + (size_t)layer * D * NE;
    for (int r = gw; r < MR; r += ngw) {
        const float* x = c.wsp<float>(WS_XA) + (size_t)r * D;
        const int src = r < L ? 0 : 1;
        const float* sh = c.mod(layer, src, 3); const float* sc = c.mod(layer, src, 4);
        float4 v[8]; float ss = 0.f;
#pragma unroll
        for (int j = 0; j < 8; ++j) { v[j] = *(const float4*)(x + 4 * c.lane + 256 * j); ss += v[j].x * v[j].x + v[j].y * v[j].y + v[j].z * v[j].z + v[j].w * v[j].w; }
        ss = wave_sum(ss);
        const float inv = rsqrtf(ss * (1.0f / D) + RMS_EPS);
        bf16_t* o = c.wsp<bf16_t>(WS_H2) + (size_t)r * D;
        float lg[NE];
#pragma unroll
        for (int e = 0; e < NE; ++e) lg[e] = 0.f;
#pragma unroll
        for (int j = 0; j < 8; ++j) {
            const int col = 4 * c.lane + 256 * j;
            const float4 gg = *(const float4*)(g + col), s4 = *(const float4*)(sh + col), c4 = *(const float4*)(sc + col);
            const float y[4] = {v[j].x * inv * gg.x * (1.f + c4.x) + s4.x, v[j].y * inv * gg.y * (1.f + c4.y) + s4.y,
                                v[j].z * inv * gg.z * (1.f + c4.z) + s4.z, v[j].w * inv * gg.w * (1.f + c4.w) + s4.w};
            uint2 w; w.x = pk2(y[0], y[1]); w.y = pk2(y[2], y[3]);
            *(uint2*)(o + col) = w;
#pragma unroll
            for (int q = 0; q < 4; ++q) {
                const float4* wp = (const float4*)(wr + (size_t)(col + q) * NE);
#pragma unroll
                for (int e4 = 0; e4 < 4; ++e4) { const float4 w4 = wp[e4]; lg[e4 * 4 + 0] = fmaf(y[q], w4.x, lg[e4 * 4 + 0]); lg[e4 * 4 + 1] = fmaf(y[q], w4.y, lg[e4 * 4 + 1]); lg[e4 * 4 + 2] = fmaf(y[q], w4.z, lg[e4 * 4 + 2]); lg[e4 * 4 + 3] = fmaf(y[q], w4.w, lg[e4 * 4 + 3]); }
            }
        }
        float mx = -3e38f;
#pragma unroll
        for (int e = 0; e < NE; ++e) { lg[e] = wave_sum(lg[e]); mx = fmaxf(mx, lg[e]); }
        float sum = 0.f;
#pragma unroll
        for (int e = 0; e < NE; ++e) { lg[e] = expf(lg[e] - mx); sum += lg[e]; }
        float mine = 0.f;
#pragma unroll
        for (int e = 0; e < NE; ++e) mine = (c.lane == e) ? lg[e] / sum : mine;
        if (c.lane < NE) c.wsp<float>(WS_AFF)[(size_t)r * NE + c.lane] = mine;
    }
}

__device__ __forceinline__ void topk_unit(const Ctx& c, int e, int row0, int n, int K, int slot0) {
    unsigned* keys = (unsigned*)c.smem;
    unsigned* hist = keys + L;
    unsigned* sh = hist + 256;
    const int tid = c.tid, lane = c.lane, wave = c.wave;
    const float* aff = c.wsp<float>(WS_AFF);
    __syncthreads();
#pragma unroll 4
    for (int t = tid; t < n; t += NTHREADS) keys[t] = __float_as_uint(aff[(size_t)(row0 + t) * NE + e]);
    unsigned prefix = 0u, mask = 0u, need = (unsigned)K;
#pragma unroll 1
    for (int pass = 0; pass < 4; ++pass) {
        const int shift = 24 - 8 * pass;
        __syncthreads();
        if (tid < 256) hist[tid] = 0u;
        __syncthreads();
#pragma unroll 4
        for (int t = tid; t < n; t += NTHREADS) { const unsigned k = keys[t]; if ((k & mask) == prefix) atomicAdd(&hist[(k >> shift) & 255u], 1u); }
        __syncthreads();
        if (tid == 0) {
            unsigned cum = 0u; int b = 255;
            for (; b > 0; --b) { if (cum + hist[b] >= need) break; cum += hist[b]; }
            sh[0] = prefix | ((unsigned)b << shift); sh[1] = need - cum;
        }
        __syncthreads();
        prefix = sh[0]; need = sh[1]; mask |= 255u << shift;
    }
    const unsigned T = prefix; const unsigned cnt_gt = (unsigned)K - need;
    int* IDX = c.wsp<int>(WS_IDX) + (size_t)e * SLOTS; float* GS = c.wsp<float>(WS_GSEL) + (size_t)e * SLOTS; int* SL = c.wsp<int>(WS_SLOT) + (size_t)e * MR;
    unsigned base_gt = 0u, base_eq = 0u;
    const int rounds = (n + NTHREADS - 1) / NTHREADS;
#pragma unroll 1
    for (int j = 0; j < rounds; ++j) {
        const int t = tid + NTHREADS * j;
        const bool valid = t < n; const unsigned kj = valid ? keys[t] : 0u;
        const bool gt = valid && kj > T, eq = valid && kj == T;
        const unsigned long long mg = __ballot(gt), me = __ballot(eq);
        const unsigned long long lower = (lane == 0) ? 0ull : (~0ull >> (64 - lane));
        const unsigned rg = (unsigned)__popcll(mg & lower), re = (unsigned)__popcll(me & lower);
        __syncthreads();
        if (lane == 0) { sh[8 + wave] = (unsigned)__popcll(mg); sh[16 + wave] = (unsigned)__popcll(me); }
        __syncthreads();
        unsigned og = 0u, oe = 0u, tg = 0u, te = 0u;
#pragma unroll
        for (int w = 0; w < 8; ++w) { const unsigned a = sh[8 + w], b2 = sh[16 + w]; if (w < wave) { og += a; oe += b2; } tg += a; te += b2; }
        int slot = -1;
        if (gt) slot = (int)(base_gt + og + rg);
        else if (eq) { const unsigned rk = base_eq + oe + re; if (rk < need) slot = (int)(cnt_gt + rk); }
        if (valid) { SL[row0 + t] = slot >= 0 ? slot0 + slot : -1; if (slot >= 0) { IDX[slot0 + slot] = row0 + t; GS[slot0 + slot] = __uint_as_float(kj); } }
        base_gt += tg; base_eq += te;
    }
}
__device__ __forceinline__ void ph_g(const Ctx& c) {
    for (int u = c.bid; u < 32; u += c.nb) {
        if (u < 16) topk_unit(c, u, 0, L, CAP, 0);
        else { const int e = u - 16; topk_unit(c, e, L, LC, CAPC, CAP);
            for (int s = CAP + CAPC + c.tid; s < SLOTS; s += NTHREADS) { c.wsp<int>(WS_IDX)[(size_t)e * SLOTS + s] = 0; c.wsp<float>(WS_GSEL)[(size_t)e * SLOTS + s] = 0.f; } }
    }
}

struct EpiGate { float* tmp; __device__ __forceinline__ void operator()(int row, int col, const float (&v)[8]) const {
    float* p = tmp + (size_t)row * DF + col; *(float4*)p = make_float4(v[0], v[1], v[2], v[3]); *(float4*)(p + 4) = make_float4(v[4], v[5], v[6], v[7]); } };
struct EpiUp { const float* tmp; bf16_t* act; __device__ __forceinline__ void operator()(int row, int col, const float (&v)[8]) const {
    const float* p = tmp + (size_t)row * DF + col; const float4 a0 = *(const float4*)p, a1 = *(const float4*)(p + 4);
    const float a[8] = {a0.x, a0.y, a0.z, a0.w, a1.x, a1.y, a1.z, a1.w}; float t[8];
#pragma unroll
    for (int j = 0; j < 8; ++j) t[j] = silu_f(a[j]) * v[j];
    uint4 o; o.x = pk2(t[0], t[1]); o.y = pk2(t[2], t[3]); o.z = pk2(t[4], t[5]); o.w = pk2(t[6], t[7]);
    *(uint4*)(act + (size_t)row * DF + col) = o; } };
struct EpiDown { bf16_t* ye; __device__ __forceinline__ void operator()(int row, int col, const float (&v)[8]) const {
    uint4 o; o.x = pk2(v[0], v[1]); o.y = pk2(v[2], v[3]); o.z = pk2(v[4], v[5]); o.w = pk2(v[6], v[7]);
    *(uint4*)(ye + (size_t)row * D + col) = o; } };
__device__ __forceinline__ void ph_h(const Ctx& c, int layer) {
    const int nM = SLOTS / 128, nN = DF / 128;
    for (int which = 0; which < 2; ++which)
        for (int u = c.bid; u < NE * nM * nN; u += c.nb) {
            const int e = u / (nM * nN), r = u % (nM * nN), pm = r % nM, pn = r / nM;
            const RowGather rp{c.wsp<bf16_t>(WS_H2), D, c.wsp<int>(WS_IDX) + (size_t)e * SLOTS};
            float* tmp = c.wsp<float>(WS_TMP) + (size_t)e * SLOTS * DF;
            const float* W = c.in[which == 0 ? 28 : 29] + ((size_t)layer * NE + e) * D * DF;
            if (which == 0) { const EpiGate ep{tmp}; sgemm_unit(rp, W, DF, D, pm * 128, pn * 128, ep, (float*)c.smem, c.tid); }
            else { const EpiUp ep{tmp, c.wsp<bf16_t>(WS_ACT) + (size_t)e * SLOTS * DF}; sgemm_unit(rp, W, DF, D, pm * 128, pn * 128, ep, (float*)c.smem, c.tid); }
        }
}
__device__ __forceinline__ void ph_i(const Ctx& c, int layer) {
    const int nM = SLOTS / 128, nN = D / 128;
    for (int u = c.bid; u < NE * nM * nN; u += c.nb) {
        const int e = u / (nM * nN), r = u % (nM * nN), pm = r % nM, pn = r / nM;
        const RowLin rp{c.wsp<bf16_t>(WS_ACT) + (size_t)e * SLOTS * DF, DF};
        const EpiDown ep{c.wsp<bf16_t>(WS_YE) + (size_t)e * SLOTS * D};
        const float* W = c.in[30] + ((size_t)layer * NE + e) * DF * D;
        sgemm_unit(rp, W, D, DF, pm * 128, pn * 128, ep, (float*)c.smem, c.tid);
    }
}

__device__ __forceinline__ void ph_j(const Ctx& c, int layer) {
    const int gw = c.bid * 8 + c.wave, ngw = c.nb * 8;
    const int nrows = layer == 0 ? MR : L;
    for (int r = gw; r < nrows; r += ngw) {
        const float* x1 = c.wsp<float>(WS_XA) + (size_t)r * D;
        const float* g5 = c.mod(layer, r < L ? 0 : 1, 5);
        float* o = layer == 0 ? c.wsp<float>(WS_XB) + (size_t)r * D : c.out + (size_t)r * D;
        float acc[32];
#pragma unroll
        for (int j = 0; j < 32; ++j) acc[j] = 0.f;
        for (int e = 0; e < NE; ++e) {
            const int s = c.wsp<int>(WS_SLOT)[(size_t)e * MR + r];
            if (s >= 0) {
                const float gs = c.wsp<float>(WS_GSEL)[(size_t)e * SLOTS + s];
                const bf16_t* y = c.wsp<bf16_t>(WS_YE) + ((size_t)e * SLOTS + s) * D;
#pragma unroll
                for (int j = 0; j < 8; ++j) { const uint2 w = *(const uint2*)(y + 4 * c.lane + 256 * j);
                    acc[4 * j + 0] = fmaf(gs, __uint_as_float(w.x << 16), acc[4 * j + 0]); acc[4 * j + 1] = fmaf(gs, __uint_as_float(w.x & 0xffff0000u), acc[4 * j + 1]);
                    acc[4 * j + 2] = fmaf(gs, __uint_as_float(w.y << 16), acc[4 * j + 2]); acc[4 * j + 3] = fmaf(gs, __uint_as_float(w.y & 0xffff0000u), acc[4 * j + 3]); }
            }
        }
#pragma unroll
        for (int j = 0; j < 8; ++j) { const int col = 4 * c.lane + 256 * j; const float4 xv = *(const float4*)(x1 + col), gv = *(const float4*)(g5 + col);
            *(float4*)(o + col) = make_float4(xv.x + gv.x * acc[4 * j], xv.y + gv.y * acc[4 * j + 1], xv.z + gv.z * acc[4 * j + 2], xv.w + gv.w * acc[4 * j + 3]); }
    }
}


#ifndef FAST_B
#define FAST_B 1
#endif
#ifndef FAST_DE
#define FAST_DE 1
#endif
#ifndef FAST_HI
#define FAST_HI 1
#endif
__device__ __forceinline__ void ph_b_fast(const Ctx& c, int layer) {
    LAS unsigned char* lds = (LAS unsigned char*)c.smem;
    const char* WIN = (const char*)(c.ws + WS_WIN); const char* HX = (const char*)(c.ws + WS_HX);
    __syncthreads();
    {
        const pg8::GeomLin G{WIN, HX, D, D, D, nullptr}; pg8::StaticOrder S; S.init(3072 / 256, MR / 256, c.nb, c.bid);
        const pg8::EpiBf16Plain E{c.wsp<bf16_t>(WS_ZHYT), MR, 0};
        pg8::gemm_phase(lds, G, S, E);
    }
    {
        const pg8::GeomLin G{HX, WIN + (size_t)OFF_WAQ * D * 2, D, D, D, nullptr}; pg8::StaticOrder S; S.init(MR / 256, (NIN - OFF_WAQ) / 256, c.nb, c.bid);
        const pg8::EpiInRest E{c.ws};
        pg8::gemm_phase(lds, G, S, E);
    }
}
__device__ __forceinline__ void ph_d_fast(const Ctx& c, int layer) {
    LAS unsigned char* lds = (LAS unsigned char*)c.smem;
    const int nM = layer == 0 ? MR / 256 : L / 256;
    pg8::StaticOrder S; S.init(nM, D / 256, c.nb, c.bid);
    __syncthreads();
    { const pg8::GeomLin G{(const char*)(c.ws + WS_YHY), (const char*)(c.ws + WS_WBR), 1024, 1024, 1024, nullptr}; const pg8::EpiMergeF<0> E{c.ws}; pg8::gemm_phase(lds, G, S, E); }
    { const pg8::GeomLin G{(const char*)(c.ws + WS_YWA), (const char*)(c.ws + WS_WBR) + (size_t)D * 1024 * 2, 1024, 1024, 1024, nullptr}; const pg8::EpiMergeF<1> E{c.ws}; pg8::gemm_phase(lds, G, S, E); }
    { const pg8::GeomLin G{(const char*)(c.ws + WS_YNA), (const char*)(c.ws + WS_WBR) + (size_t)2 * D * 1024 * 2, 1024, 1024, 1024, nullptr}; const pg8::EpiMergeF<2> E{c.ws}; pg8::gemm_phase(lds, G, S, E); }
}
__device__ __forceinline__ void ph_e_fast(const Ctx& c, int layer) {
    LAS unsigned char* lds = (LAS unsigned char*)c.smem;
    const int nM = layer == 0 ? MR / 256 : L / 256;
    pg8::StaticOrder S; S.init(nM, D / 256, c.nb, c.bid);
    __syncthreads();
    const pg8::GeomLin G{(const char*)(c.ws + WS_MB), (const char*)(c.ws + WS_WOUT), D, D, D, nullptr}; const pg8::EpiOutF E{&c, layer};
    pg8::gemm_phase(lds, G, S, E);
}
__device__ __forceinline__ void ph_h_fast(const Ctx& c, int layer) {
    LAS unsigned char* lds = (LAS unsigned char*)c.smem;
    const int tpe = layer == 0 ? 9 : 8;
    pg8::StaticOrder S; S.init(NE * tpe, 2048 / 256, c.nb, c.bid);
    __syncthreads();
    const pg8::GeomExpert<true> G{(const char*)(c.ws + WS_H2), (const char*)(c.ws + WS_WGU), D, D, D, c.wsp<int>(WS_IDX), tpe, 2048};
    const pg8::EpiGU E{c.wsp<bf16_t>(WS_ACT)};
    pg8::gemm_phase(lds, G, S, E);
}
__device__ __forceinline__ void ph_i_fast(const Ctx& c, int layer) {
    LAS unsigned char* lds = (LAS unsigned char*)c.smem;
    const int tpe = layer == 0 ? 9 : 8;
    pg8::StaticOrder S; S.init(NE * tpe, D / 256, c.nb, c.bid);
    __syncthreads();
    const pg8::GeomExpert<false> G{(const char*)(c.ws + WS_ACT), (const char*)(c.ws + WS_WDN), DF, DF, DF, nullptr, tpe, D};
    const pg8::EpiBf16Plain E{c.wsp<bf16_t>(WS_YE), D, 0};
    pg8::gemm_phase(lds, G, S, E);
}

__global__ void __launch_bounds__(NTHREADS, 2) mega(KArgs a) {
    extern __shared__ __attribute__((aligned(16))) unsigned char smem[];
    Ctx c; c.in = a.in; c.out = a.out; c.ws = a.ws; c.bid = blockIdx.x; c.nb = gridDim.x; c.tid = threadIdx.x; c.lane = c.tid & 63;
    c.wave = __builtin_amdgcn_readfirstlane(c.tid >> 6); c.smem = smem;
    volatile LAS unsigned* st = (volatile LAS unsigned*)(LAS unsigned char*)(smem + LDS_BYTES - 16);
    if (c.tid == 0) { st[0] = 0u; st[1] = 0u; st[2] = 0u; st[3] = 0u; }
    __syncthreads();
    const int lo = a.ph_lo, hi = a.ph_hi;
    XcdBarrier bar; bar.bar = (unsigned*)(a.ws + WS_CTL); bar.x = 0; bar.st = st;
    if (hi - lo > 1) bar = xcd_barrier_post((unsigned*)(a.ws + WS_CTL), st);
#ifndef ONLY_PH
#define ONLY_PH -1
#endif
#define PSEL(j) (ONLY_PH < 0 || ONLY_PH == (j))
#define IN(k) (lo <= (k) && (k) < hi)
#define LAUNDER(cc) Ctx cc = c; asm volatile("" : "+v"(cc.tid), "+v"(cc.lane)); asm volatile("" : "+s"(cc.bid), "+s"(cc.nb), "+s"(cc.wave), "+s"(cc.ws), "+s"(cc.out))
#define SEAM(k) do { if (IN(k) && IN((k) + 1)) xcd_barrier(bar); } while (0)
    if (PSEL(0) && IN(0)) { LAUNDER(cc); ph_g0(cc); } SEAM(0);
#define LAYER_PROGRAM(layer) do { const int b = 1 + (layer) * PH_PER_LAYER; \
        if (PSEL(1) && IN(b + 0)) { LAUNDER(cc); constexpr int ly = (layer); ph_a(cc, ly); if (FAST_B || FAST_DE || FAST_HI) ph_conv(cc, ly); } SEAM(b + 0); \
        if (PSEL(2) && IN(b + 1)) { LAUNDER(cc); constexpr int ly = (layer); if (FAST_B) ph_b_fast(cc, ly); else ph_b(cc, ly); } SEAM(b + 1); \
        if (PSEL(3) && IN(b + 2)) { LAUNDER(cc); constexpr int ly = (layer); ph_b2(cc, ly); } SEAM(b + 2); \
        if (PSEL(4) && IN(b + 3)) { LAUNDER(cc); constexpr int ly = (layer); ph_c(cc, ly); } SEAM(b + 3); \
        if (PSEL(5) && IN(b + 4)) { LAUNDER(cc); constexpr int ly = (layer); ph_c2(cc); } SEAM(b + 4); \
        if (PSEL(6) && IN(b + 5)) { LAUNDER(cc); constexpr int ly = (layer); if (FAST_DE) ph_d_fast(cc, ly); else ph_d(cc, ly); } SEAM(b + 5); \
        if (PSEL(7) && IN(b + 6)) { LAUNDER(cc); constexpr int ly = (layer); if (FAST_DE) ph_e_fast(cc, ly); else ph_e(cc, ly); } SEAM(b + 6); \
        if (PSEL(8) && IN(b + 7)) { LAUNDER(cc); constexpr int ly = (layer); ph_f(cc, ly); } SEAM(b + 7); \
        if (PSEL(9) && IN(b + 8)) { LAUNDER(cc); constexpr int ly = (layer); ph_g(cc); } SEAM(b + 8); \
        if (PSEL(10) && IN(b + 9)) { LAUNDER(cc); constexpr int ly = (layer); if (FAST_HI) ph_h_fast(cc, ly); else ph_h(cc, ly); } SEAM(b + 9); \
        if (PSEL(11) && IN(b + 10)) { LAUNDER(cc); constexpr int ly = (layer); if (FAST_HI) ph_i_fast(cc, ly); else ph_i(cc, ly); } SEAM(b + 10); \
        if (PSEL(12) && IN(b + 11)) { LAUNDER(cc); constexpr int ly = (layer); ph_j(cc, ly); } SEAM(b + 11); \
    } while (0)
    LAYER_PROGRAM(0);
    LAYER_PROGRAM(1);
#undef LAYER_PROGRAM
#undef IN
#undef SEAM
}

extern "C" void kernel_launch(void* const* d_in, const int* in_sizes, int n_in, void* d_out, int out_size, void* d_ws, size_t ws_size, hipStream_t stream) {
    static int grid = 0;
    if (grid == 0) {
        if (n_in != 31 || out_size != L * D || ws_size < WS_END) { fprintf(stderr, "kernel_launch: unexpected shapes: n_in %d out %d ws %zu (need %zu)\n", n_in, out_size, ws_size, (size_t)WS_END); grid = -1; return; }
        int dev = 0, cus = 0, per_cu = 0;
        if (hipGetDevice(&dev) != hipSuccess || hipDeviceGetAttribute(&cus, hipDeviceAttributeMultiprocessorCount, dev) != hipSuccess) { grid = -1; return; }
        if (hipFuncSetAttribute((const void*)mega, hipFuncAttributeMaxDynamicSharedMemorySize, LDS_BYTES) != hipSuccess) { fprintf(stderr, "kernel_launch: hipFuncSetAttribute failed\n"); grid = -1; return; }
        if (hipOccupancyMaxActiveBlocksPerMultiprocessor(&per_cu, (const void*)mega, NTHREADS, LDS_BYTES) != hipSuccess || per_cu < 1) fprintf(stderr, "kernel_launch: occupancy query says %d\n", per_cu);
        (void)hipGetLastError();
        grid = cus;
    }
    if (grid < 0) return;
    if (hipMemsetAsync((char*)d_ws + WS_CTL, 0, CTL_BYTES, stream) != hipSuccess) return;
    KArgs a{};
    for (int i = 0; i < 31; ++i) a.in[i] = (const float*)d_in[i];
    a.out = (float*)d_out; a.ws = (unsigned char*)d_ws;
#if ONE_LAUNCH
    a.ph_lo = 0; a.ph_hi = NPH;
    hipLaunchKernelGGL(mega, dim3(grid), dim3(NTHREADS), LDS_BYTES, stream, a);
#else
    for (int p = 0; p < NPH; ++p) { a.ph_lo = p; a.ph_hi = p + 1; hipLaunchKernelGGL(mega, dim3(grid), dim3(NTHREADS), LDS_BYTES, stream, a); }
#endif
    const hipError_t le = hipPeekAtLastError();
    if (le != hipSuccess) fprintf(stderr, "kernel_launch: launch failed: %s\n", hipGetErrorName(le));
}
```

```cpp
#include <hip/hip_runtime.h>
#include <stdint.h>
#include <stdio.h>

#ifndef ONE_LAUNCH
#define ONE_LAUNCH 1
#endif

typedef unsigned short bf16_t;
#define LAS __attribute__((address_space(3)))

constexpr int L = 16384, LC = 256, MR = L + LC, D = 2048, NIN = 13824;
constexpr int HD = 128, GRIDW = 64;
constexpr int OFF_HY = 0, OFF_WAQ = 3072, OFF_WAKV = 4096, OFF_NAQ = 4608, OFF_NAKV = 5632, OFF_GATE = 7680;
constexpr int NE = 16, CAP = 2048, CAPC = 32, SLOTS = 2304, DF = 1024;
constexpr int NMOD = 6 * D;
constexpr float RMS_EPS = 1e-6f;
constexpr float QK_SCALE = 0.08838834764831845f;

constexpr size_t al256(size_t x) { return (x + 255) & ~(size_t)255; }
constexpr size_t WS_CTL = 0, CTL_BYTES = 1u << 20;
constexpr size_t WS_MOD = WS_CTL + CTL_BYTES;
constexpr size_t WS_H2F = WS_MOD + al256((size_t)2 * 2 * NMOD * 4);
constexpr size_t WS_AFF = WS_H2F + al256((size_t)2 * MR * 64 * 4);
constexpr size_t WS_IDX = WS_AFF + al256((size_t)MR * 16 * 4);
constexpr size_t WS_GSEL = WS_IDX + al256((size_t)NE * SLOTS * 4);
constexpr size_t WS_SLOT = WS_GSEL + al256((size_t)NE * SLOTS * 4);
constexpr size_t WS_KFC = WS_SLOT + al256((size_t)NE * MR * 4);
constexpr size_t WS_ZHYC = WS_KFC + al256((size_t)4096 * LC * 2);
constexpr size_t WS_XA = WS_ZHYC + al256((size_t)3072 * LC * 2);
constexpr size_t WS_XB = WS_XA + al256((size_t)MR * D * 4);
constexpr size_t WS_W = WS_XB + al256((size_t)MR * D * 4);
constexpr size_t W_BYTES = (size_t)2 * ((size_t)NIN * D + 3 * (size_t)D * 1024 + (size_t)D * D + (size_t)NE * 2048 * D + (size_t)NE * D * DF);
constexpr size_t WS_WIN = WS_W;
constexpr size_t WS_WBR = WS_WIN + (size_t)NIN * D * 2;
constexpr size_t WS_WOUT = WS_WBR + (size_t)3 * D * 1024 * 2;
constexpr size_t WS_WGU = WS_WOUT + (size_t)D * D * 2;
constexpr size_t WS_WDN = WS_WGU + (size_t)NE * 2048 * D * 2;
constexpr size_t WS_R3 = WS_W + al256(W_BYTES);
constexpr size_t R3_BYTES = (size_t)MR * D * 4 + (size_t)MR * D * 2;
constexpr size_t WS_KF = WS_R3;
constexpr size_t WS_KS = WS_R3 + al256((size_t)4096 * L * 2);
constexpr size_t WS_MPART = WS_R3;
constexpr size_t WS_MB = WS_R3 + (size_t)MR * D * 4;
constexpr size_t WS_TMP = WS_R3;
constexpr size_t WS_YE = WS_R3;
constexpr size_t WS_R4 = WS_R3 + al256(R3_BYTES);
constexpr size_t R4_BYTES = (size_t)MR * 6144 * 2;
constexpr size_t WS_GATE = WS_R4;
constexpr size_t WS_H2 = WS_R4;
constexpr size_t WS_ACT = WS_R4 + al256((size_t)MR * D * 2);
constexpr size_t WS_R5 = WS_R4 + al256(R4_BYTES);
constexpr size_t WS_HX = WS_R5;
constexpr size_t WS_YHYT = WS_R5;
constexpr size_t WS_YHY = WS_R5 + al256((size_t)1024 * L * 2);
constexpr size_t WS_ZHYT = WS_R5 + al256((size_t)MR * D * 2);
constexpr size_t WS_QWA = WS_ZHYT + al256((size_t)3072 * MR * 2);
constexpr size_t WS_KVWA = WS_QWA + al256((size_t)MR * 1024 * 2);
constexpr size_t WS_QNA = WS_KVWA + al256((size_t)MR * 512 * 2);
constexpr size_t WS_KVNA = WS_QNA + al256((size_t)MR * 1024 * 2);
constexpr size_t WS_YWA = WS_KVNA + al256((size_t)MR * 2048 * 2);
constexpr size_t WS_YNA = WS_YWA + al256((size_t)MR * 1024 * 2);
constexpr size_t WS_END = WS_YNA + al256((size_t)MR * 1024 * 2);
static_assert((size_t)1024 * L * 2 + (size_t)MR * 1024 * 2 <= (size_t)MR * D * 2 + 512, "YHYT+YHY overlay HX");
static_assert((size_t)4096 * L * 2 + 256 + (size_t)256 * 2 * 16384 * 8 <= R3_BYTES && (size_t)NE * SLOTS * D * 2 <= R3_BYTES && (size_t)NE * SLOTS * DF * 4 <= R3_BYTES, "R3");
static_assert((size_t)MR * D * 2 + 256 + (size_t)NE * SLOTS * DF * 2 <= R4_BYTES, "R4");

constexpr int LDS_BYTES = 160 * 1024;
constexpr int NTHREADS = 512;
constexpr int PH_PER_LAYER = 12, NPH = 1 + 2 * PH_PER_LAYER;

__device__ __forceinline__ float bf2f(bf16_t b) { return __uint_as_float(((unsigned)b) << 16); }
__device__ __forceinline__ bf16_t f2bf(float f) { unsigned u = __float_as_uint(f); u += 0x7fffu + ((u >> 16) & 1u); return (bf16_t)(u >> 16); }
__device__ __forceinline__ unsigned pk2(float lo, float hi) { return (unsigned)f2bf(lo) | ((unsigned)f2bf(hi) << 16); }
__device__ __forceinline__ float wave_sum(float v) {
#pragma unroll
    for (int o = 1; o < 64; o <<= 1) v += __shfl_xor(v, o);
    return v;
}
__device__ __forceinline__ float wave_max(float v) {
#pragma unroll
    for (int o = 1; o < 64; o <<= 1) v = fmaxf(v, __shfl_xor(v, o));
    return v;
}
__device__ __forceinline__ float silu_f(float x) { return x / (1.f + __expf(-x)); }
__device__ __forceinline__ float sigmoid_f(float x) { return 1.f / (1.f + __expf(-x)); }
#define LDS_FENCE() asm volatile("s_waitcnt lgkmcnt(0)" ::: "memory")

#define XB_TMO      128
#define XB_XCNT(j)  (256  + 64 * (j))
#define XB_XSUB(j)  (1280 + 64 * (j))
#define XB_XGEN(j)  (2304 + 64 * (j))
#define XB_TOP      3328
#define XB_TOPGEN   3392
#define XCD_BAR_WORDS 3456
#define XB_SPIN_CAP (1u << 22)

__device__ __forceinline__ unsigned xb_ld(unsigned* p)              { return __hip_atomic_load(p, __ATOMIC_RELAXED, __HIP_MEMORY_SCOPE_AGENT); }
__device__ __forceinline__ unsigned xb_add(unsigned* p, unsigned v) { return __hip_atomic_fetch_add(p, v, __ATOMIC_RELAXED, __HIP_MEMORY_SCOPE_AGENT); }
__device__ __forceinline__ unsigned xb_xcc_id() { return (unsigned)__builtin_amdgcn_s_getreg((3 << 11) | 20) & 0xFu; }
#define XB_SPIN(cond, bar) do { unsigned _sp = 0; while (cond) { __builtin_amdgcn_s_sleep(1); \
    if ((++_sp & 255u) == 0u) { if (xb_ld(&(bar)[XB_TMO])) break; if (_sp > XB_SPIN_CAP) { atomicAdd(&(bar)[XB_TMO], 1u); break; } } } } while (0)

struct XcdBarrier { unsigned* bar; unsigned x; volatile LAS unsigned* st; };

__device__ __forceinline__ XcdBarrier xcd_barrier_post(unsigned* bar, volatile LAS unsigned* st) {
    XcdBarrier b; b.bar = bar; b.x = xb_xcc_id(); b.st = st;
    if (threadIdx.x == 0) (void)xb_add(&bar[XB_XCNT(b.x)], 1u);
    return b;
}
__device__ __forceinline__ void xcd_barrier_complete(unsigned* bar, unsigned x, unsigned& nloc, unsigned& nx) {
    const unsigned G = gridDim.x * gridDim.y * gridDim.z;
    unsigned sum, cnt, mine, sp = 0u;
    for (;;) {
        sum = 0u; cnt = 0u; mine = 0u;
#pragma unroll
        for (unsigned j = 0; j < 16; ++j) { const unsigned c = xb_ld(&bar[XB_XCNT(j)]); sum += c; cnt += (c > 0u) ? 1u : 0u; mine = (j == x) ? c : mine; }
        if (sum == G) break;
        __builtin_amdgcn_s_sleep(1);
        if ((++sp & 255u) == 0u) { if (xb_ld(&bar[XB_TMO])) break; if (sp > XB_SPIN_CAP) { atomicAdd(&bar[XB_TMO], 1u); break; } }
    }
    nloc = mine > 0u ? mine : 1u; nx = cnt > 0u ? cnt : 1u;
}
__device__ __forceinline__ void xcd_barrier(const XcdBarrier& b) {
    asm volatile("s_waitcnt vmcnt(0)" ::: "memory");
    __syncthreads();
    if (threadIdx.x == 0) {
        unsigned* bar = b.bar;
        __builtin_amdgcn_s_waitcnt(0);
        unsigned nloc = b.st[0], nx = b.st[1];
        if (nloc == 0u) { xcd_barrier_complete(bar, b.x, nloc, nx); b.st[0] = nloc; b.st[1] = nx; }
        const unsigned old = xb_add(&bar[XB_XSUB(b.x)], 1u);
        const unsigned gen = old / nloc;
        if (old + 1u == (gen + 1u) * nloc) {
            __builtin_amdgcn_fence(__ATOMIC_RELEASE, "agent");
            asm volatile("s_waitcnt vmcnt(0)" ::: "memory");
            const unsigned og = xb_add(&bar[XB_TOP], 1u);
            const unsigned tg = og / nx;
            if (og + 1u == (tg + 1u) * nx) xb_add(&bar[XB_TOPGEN], 1u);
            else XB_SPIN(xb_ld(&bar[XB_TOPGEN]) == tg, bar);
            __builtin_amdgcn_fence(__ATOMIC_ACQUIRE, "agent");
            xb_add(&bar[XB_XGEN(b.x)], 1u);
            asm volatile("s_waitcnt vmcnt(0)" ::: "memory");
        } else {
            XB_SPIN(xb_ld(&bar[XB_XGEN(b.x)]) == gen, bar);
            __builtin_amdgcn_fence(__ATOMIC_ACQUIRE, "agent");
            asm volatile("s_waitcnt vmcnt(0)" ::: "memory");
        }
    }
    __syncthreads();
}

struct KArgs { const float* in[31]; float* out; unsigned char* ws; int ph_lo, ph_hi; };

struct Ctx {
    const float* const* in; float* out; unsigned char* ws;
    int bid, nb, tid, lane, wave;
    unsigned char* smem;
    template <class T> __device__ __forceinline__ T* wsp(size_t off) const { return (T*)(ws + off); }
    __device__ __forceinline__ const float* mod(int layer, int src, int chunk) const { return wsp<float>(WS_MOD) + ((size_t)(layer * 2 + src) * NMOD) + chunk * D; }
    __device__ __forceinline__ const float* xrow(int layer, int r) const {
        if (layer == 0) return r < L ? in[0] + (size_t)r * D : in[2] + (size_t)(r - L) * D;
        return wsp<float>(WS_XB) + (size_t)r * D;
    }
};

template <class RowPtr, class Epi>
__device__ __forceinline__ void sgemm_unit(const RowPtr& rp, const float* __restrict__ W, int ldw, int K, int m0, int n0, const Epi& ep, float* lds, int tid) {
    float* As = lds;
    float* Bs = lds + 16 * 132;
    const int ty = tid >> 4, tx = tid & 15;
    const int am = tid >> 2, kq = (tid & 3) * 4;
    const int bk = tid >> 5, n4 = (tid & 31) * 4;
    float acc[4][8];
#pragma unroll
    for (int i = 0; i < 4; ++i)
#pragma unroll
        for (int j = 0; j < 8; ++j) acc[i][j] = 0.f;
    const bf16_t* arow = rp(m0 + am);
    const float* wp = W + (size_t)bk * ldw + n0 + n4;
    for (int k0 = 0; k0 < K; k0 += 16) {
        const uint2 a4 = *(const uint2*)(arow + k0 + kq);
        const float4 b4 = *(const float4*)(wp + (size_t)k0 * ldw);
        __syncthreads();
        As[(kq + 0) * 132 + am] = __uint_as_float(a4.x << 16);
        As[(kq + 1) * 132 + am] = __uint_as_float(a4.x & 0xffff0000u);
        As[(kq + 2) * 132 + am] = __uint_as_float(a4.y << 16);
        As[(kq + 3) * 132 + am] = __uint_as_float(a4.y & 0xffff0000u);
        *(float4*)&Bs[bk * 128 + n4] = b4;
        __syncthreads();
#pragma unroll
        for (int kk = 0; kk < 16; ++kk) {
            const float4 a = *(const float4*)&As[kk * 132 + ty * 4];
            const float4 b0 = *(const float4*)&Bs[kk * 128 + tx * 8];
            const float4 b1 = *(const float4*)&Bs[kk * 128 + tx * 8 + 4];
            const float av[4] = {a.x, a.y, a.z, a.w};
            const float bv[8] = {b0.x, b0.y, b0.z, b0.w, b1.x, b1.y, b1.z, b1.w};
#pragma unroll
            for (int i = 0; i < 4; ++i)
#pragma unroll
                for (int j = 0; j < 8; ++j) acc[i][j] = fmaf(av[i], bv[j], acc[i][j]);
        }
    }
#pragma unroll
    for (int i = 0; i < 4; ++i) ep(m0 + ty * 4 + i, n0 + tx * 8, acc[i]);
}

struct RowLin { const bf16_t* base; int ld; __device__ __forceinline__ const bf16_t* operator()(int m) const { return base + (size_t)m * ld; } };
struct RowGather { const bf16_t* base; int ld; const int* idx; __device__ __forceinline__ const bf16_t* operator()(int m) const { return base + (size_t)idx[m] * ld; } };


namespace pg8 {
typedef short bf16x8 __attribute__((ext_vector_type(8)));
typedef float f32x4 __attribute__((ext_vector_type(4)));
typedef unsigned u32x4 __attribute__((ext_vector_type(4)));
typedef unsigned u32x2 __attribute__((ext_vector_type(2)));
constexpr int BM = 256, BK = 64, HALF = 128, HTB = HALF * BK * 2, STAGE_BYTES = 8 * HTB, NXCD = 8, WGM = 8;
__host__ __device__ __forceinline__ int lds_byte(int r, int c) { const int st = (r >> 4) * 2 + (c >> 5), rr = r & 15, cc = c & 31, ob = rr * 64 + cc * 2; return st * 1024 + (ob ^ (((ob >> 9) & 1) << 5)); }
__host__ __device__ __forceinline__ void stage_rc(int b, int& R, int& C) { const int st = b / 1024, sb = b % 1024, swz = sb ^ (((sb >> 9) & 1) << 5); R = (st >> 1) * 16 + swz / 64; C = (st & 1) * 32 + (swz % 64) / 2; }
__host__ __device__ __forceinline__ int perm32(int rho) { const int n = rho >> 4, i = rho & 15; return 8 * (i >> 2) + 4 * n + (i & 3); }
struct Unit { int pm, pn; };
struct StaticOrder {
    int nM, nN, nwg, G, c;
    __host__ __device__ void init(int nM_, int nN_, int G_, int c_) { nM = nM_; nN = nN_; nwg = nM * nN; G = G_; c = c_; }
    __host__ __device__ bool next(int i, Unit& u) const {
        const long Lq = (long)i * G + c; if (Lq >= nwg) return false;
        int wgid = (int)Lq; { const int q = nwg / NXCD, r = nwg % NXCD, xcd = wgid % NXCD, off = wgid / NXCD; wgid = (xcd < r ? xcd * (q + 1) : r * (q + 1) + (xcd - r) * q) + off; }
        const int nig = WGM * nN, gid = wgid / nig, fm = gid * WGM, gsz = (nM - fm) < WGM ? (nM - fm) : WGM;
        u.pm = fm + ((wgid % nig) % gsz); u.pn = (wgid % nig) / gsz; return true;
    }
};
__device__ __forceinline__ unsigned cvt_pk_bf16(float lo, float hi) { unsigned r; asm volatile("v_cvt_pk_bf16_f32 %0, %1, %2" : "=v"(r) : "v"(lo), "v"(hi)); return r; }

struct GeomLin {
    static constexpr bool GATHER = false;
    const char* A; const char* B; int K, lda, ldb; const int* idx;
    __device__ __forceinline__ const char* a_base(const Unit& u) const { return A + (size_t)u.pm * 256 * lda * 2; }
    __device__ __forceinline__ const char* b_base(const Unit& u) const { return B + (size_t)u.pn * 256 * ldb * 2; }
    __device__ __forceinline__ int row0(const Unit& u) const { return u.pm * 256; }
};
template <bool GATHER_> struct GeomExpert {
    static constexpr bool GATHER = GATHER_;
    const char* A; const char* B; int K, lda, ldb; const int* idx; int tpe, nb;
    __device__ __forceinline__ int row0(const Unit& u) const { const int e = u.pm / tpe, t = u.pm - e * tpe; return e * SLOTS + t * 256; }
    __device__ __forceinline__ const char* a_base(const Unit& u) const { return GATHER_ ? A : A + (size_t)row0(u) * lda * 2; }
    __device__ __forceinline__ const char* b_base(const Unit& u) const { const int e = u.pm / tpe; return B + ((size_t)e * nb + (size_t)u.pn * 256) * ldb * 2; }
};

template <class Epi, class Geom, class Sched>
__device__ __forceinline__ void gemm_phase(LAS unsigned char* lds, const Geom& G, const Sched& S, const Epi& E) {
    const int tid = threadIdx.x, wid = __builtin_amdgcn_readfirstlane(tid >> 6), lane = tid & 63, wr = wid >> 2, wc = wid & 3, fr = lane & 15, fq = lane >> 4;
    const int K = G.K, nt = K / BK;
    int Rs[2], Cs[2]; unsigned vB0[2], vA0[2], vAc[2][2], vAn[2][2];
#pragma unroll
    for (int i = 0; i < 2; ++i) { int R, C; stage_rc(tid * 16 + i * 8192, R, C); Rs[i] = R; Cs[i] = C; const int Rb = Epi::PERM ? ((R & ~31) + perm32(R & 31)) : R;
        vB0[i] = (unsigned)(Rb * G.ldb + C) * 2u; vA0[i] = (unsigned)(R * G.lda + C) * 2u;
#pragma unroll
        for (int h = 0; h < 2; ++h) { vAc[h][i] = 0u; vAn[h][i] = 0u; } }
    const size_t hstepA = (size_t)HALF * G.lda * 2, hstepB = (size_t)HALF * G.ldb * 2;
#define PG8_VOFF(dst, u) do { if constexpr (Geom::GATHER) { const int _r0 = G.row0(u); _Pragma("unroll") for (int _h = 0; _h < 2; ++_h) _Pragma("unroll") for (int _i = 0; _i < 2; ++_i) \
        dst[_h][_i] = ((unsigned)G.idx[_r0 + _h * HALF + Rs[_i]] * (unsigned)G.lda + (unsigned)Cs[_i]) * 2u; } } while (0)
    const size_t kstep = (size_t)(BK * 2);
    const unsigned ldsw = (unsigned)wid * 1024u;
    const int aoff = lds_byte(wr * 64 + fr, fq * 8), boff = lds_byte(wc * 32 + fr, fq * 8);
#define PG8_SA(b, h) (((b) * 2 + (h)) * HTB)
#define PG8_SB(b, h) ((4 + (b) * 2 + (h)) * HTB)
#define PG8_STAGE(bufoff, gbase, v) do { \
        __builtin_amdgcn_global_load_lds((const unsigned*)((const char*)(gbase) + (v)[0]), (LAS unsigned*)(lds + (bufoff) + ldsw), 16, 0, 0); \
        __builtin_amdgcn_global_load_lds((const unsigned*)((const char*)(gbase) + (v)[1]), (LAS unsigned*)(lds + (bufoff) + ldsw + 8192), 16, 0, 0); } while (0)
#define PG8_STA(bufoff, gbase, h, VX) do { if constexpr (Geom::GATHER) { PG8_STAGE(bufoff, gbase, VX[h]); } else { PG8_STAGE(bufoff, (gbase) + (h) * hstepA, vA0); } } while (0)
#define PG8_STB(bufoff, gbase, h) PG8_STAGE(bufoff, (gbase) + (h) * hstepB, vB0)
#define PG8_LDA(dst, b, h) do { _Pragma("unroll") for (int m = 0; m < 4; ++m) _Pragma("unroll") for (int k = 0; k < 2; ++k) dst[m][k] = *(const LAS bf16x8*)(lds + PG8_SA(b, h) + aoff + m * 2048 + k * 1024); } while (0)
#define PG8_LDB(dst, b, h) do { _Pragma("unroll") for (int n = 0; n < 2; ++n) _Pragma("unroll") for (int k = 0; k < 2; ++k) dst[n][k] = *(const LAS bf16x8*)(lds + PG8_SB(b, h) + boff + n * 2048 + k * 1024); } while (0)
#define PG8_MMA(ai, bj, At, Bt) do { __builtin_amdgcn_s_setprio(1); _Pragma("unroll") for (int m = 0; m < 4; ++m) _Pragma("unroll") for (int n = 0; n < 2; ++n) _Pragma("unroll") for (int k = 0; k < 2; ++k) \
        acc[ai][bj][m][n] = __builtin_amdgcn_mfma_f32_16x16x32_bf16(Bt[n][k], At[m][k], acc[ai][bj][m][n], 0, 0, 0); __builtin_amdgcn_s_setprio(0); } while (0)
#define PG8_WAIT_V(n) asm volatile("s_waitcnt vmcnt(" #n ")" ::: "memory")
#define PG8_WAIT_L(n) asm volatile("s_waitcnt lgkmcnt(" #n ")" ::: "memory")
#define PG8_BAR __builtin_amdgcn_s_barrier()
#define PG8_SCHED __builtin_amdgcn_sched_barrier(0)
    Unit cur, nxt; int ui = 0;
    if (!S.next(0, cur)) return;
    f32x4 acc[2][2][4][2];
#pragma unroll
    for (int a = 0; a < 2; ++a)
#pragma unroll
        for (int b = 0; b < 2; ++b)
#pragma unroll
            for (int m = 0; m < 4; ++m)
#pragma unroll
                for (int n = 0; n < 2; ++n) acc[a][b][m][n] = (f32x4){0.f, 0.f, 0.f, 0.f};
    bf16x8 At[4][2], B0[2][2], B1[2][2];
    const char* cA = G.a_base(cur); const char* cB = G.b_base(cur);
    PG8_VOFF(vAc, cur);
    PG8_STB(PG8_SB(0, 0), cB, 0); PG8_STA(PG8_SA(0, 0), cA, 0, vAc); PG8_STB(PG8_SB(0, 1), cB, 1); PG8_STA(PG8_SA(0, 1), cA, 1, vAc);
    if (wr == 1) PG8_BAR;
    PG8_WAIT_V(4); PG8_BAR;
    PG8_STB(PG8_SB(1, 0), cB + kstep, 0); PG8_STA(PG8_SA(1, 0), cA + kstep, 0, vAc); PG8_STB(PG8_SB(1, 1), cB + kstep, 1);
    PG8_WAIT_V(6); PG8_BAR;
    for (;;) {
        const bool has_next = S.next(ui + 1, nxt);
        const char* nA = has_next ? G.a_base(nxt) : cA; const char* nB = has_next ? G.b_base(nxt) : cB;
        if constexpr (Geom::GATHER) { if (has_next) PG8_VOFF(vAn, nxt); else {
#pragma unroll
            for (int h = 0; h < 2; ++h) { vAn[h][0] = vAc[h][0]; vAn[h][1] = vAc[h][1]; } } }
        for (int t = 0; t < nt; t += 2) {
            const bool last = (t == nt - 2);
            const char* a1 = cA + (size_t)(t + 1) * kstep;
            const char* a2 = last ? nA : cA + (size_t)(t + 2) * kstep; const char* b2 = last ? nB : cB + (size_t)(t + 2) * kstep;
            const char* a3 = a2 + kstep; const char* b3 = b2 + kstep;
            unsigned v2[2][2];
#pragma unroll
            for (int h = 0; h < 2; ++h) { v2[h][0] = (Geom::GATHER && last) ? vAn[h][0] : vAc[h][0]; v2[h][1] = (Geom::GATHER && last) ? vAn[h][1] : vAc[h][1]; }
            PG8_LDB(B0, 0, 0); PG8_SCHED; PG8_LDA(At, 0, 0); PG8_STA(PG8_SA(1, 1), a1, 1, vAc);
            PG8_WAIT_L(8); PG8_BAR; PG8_WAIT_L(0); PG8_MMA(0, 0, At, B0); PG8_BAR; PG8_SCHED;
            PG8_LDB(B1, 0, 1); PG8_STB(PG8_SB(0, 0), b2, 0);
            PG8_BAR; PG8_WAIT_L(0); PG8_MMA(0, 1, At, B1); PG8_BAR;
            PG8_LDA(At, 0, 1); PG8_STA(PG8_SA(0, 0), a2, 0, v2);
            PG8_BAR; PG8_WAIT_L(0); PG8_MMA(1, 0, At, B0); PG8_BAR; PG8_SCHED;
            PG8_STB(PG8_SB(0, 1), b2, 1);
            PG8_WAIT_V(6); PG8_BAR; PG8_MMA(1, 1, At, B1); PG8_BAR;
            PG8_LDB(B0, 1, 0); PG8_SCHED; PG8_LDA(At, 1, 0); PG8_STA(PG8_SA(0, 1), a2, 1, v2);
            PG8_WAIT_L(8); PG8_BAR; PG8_WAIT_L(0); PG8_MMA(0, 0, At, B0); PG8_BAR; PG8_SCHED;
            PG8_LDB(B1, 1, 1); PG8_STB(PG8_SB(1, 0), b3, 0);
            PG8_BAR; PG8_WAIT_L(0); PG8_MMA(0, 1, At, B1); PG8_BAR;
            PG8_LDA(At, 1, 1); PG8_STA(PG8_SA(1, 0), a3, 0, v2);
            PG8_BAR; PG8_WAIT_L(0); PG8_MMA(1, 0, At, B0); PG8_BAR; PG8_SCHED;
            PG8_STB(PG8_SB(1, 1), b3, 1);
            PG8_WAIT_V(6); PG8_BAR; PG8_MMA(1, 1, At, B1); PG8_BAR;
        }
        E(acc, cur, G.row0(cur), wr, wc, fr, fq);
        if (!has_next) break;
#pragma unroll
        for (int a = 0; a < 2; ++a)
#pragma unroll
            for (int b = 0; b < 2; ++b)
#pragma unroll
                for (int m = 0; m < 4; ++m)
#pragma unroll
                    for (int n = 0; n < 2; ++n) acc[a][b][m][n] = (f32x4){0.f, 0.f, 0.f, 0.f};
        cur = nxt; cA = nA; cB = nB; ++ui;
#pragma unroll
        for (int h = 0; h < 2; ++h) { vAc[h][0] = vAn[h][0]; vAc[h][1] = vAn[h][1]; }
    }
    PG8_WAIT_V(0);
    if (wr == 0) PG8_BAR;
    PG8_BAR;
#undef PG8_VOFF
#undef PG8_SA
#undef PG8_SB
#undef PG8_STAGE
#undef PG8_STA
#undef PG8_STB
#undef PG8_LDA
#undef PG8_LDB
#undef PG8_MMA
#undef PG8_WAIT_V
#undef PG8_WAIT_L
#undef PG8_BAR
#undef PG8_SCHED
}

struct EpiBf16Plain {
    static constexpr bool PERM = true;
    bf16_t* O; int ldc; int coloff;
    __device__ __forceinline__ void operator()(const f32x4 (&acc)[2][2][4][2], const Unit& u, int row0, int wr, int wc, int fr, int fq) const {
        const int r0 = row0 + wr * 64 + fr, col0 = coloff + u.pn * BM + wc * 32 + 8 * fq;
#pragma unroll
        for (int ai = 0; ai < 2; ++ai)
#pragma unroll
            for (int m = 0; m < 4; ++m) { bf16_t* rowp = O + (size_t)(r0 + ai * HALF + m * 16) * ldc + col0;
#pragma unroll
                for (int bj = 0; bj < 2; ++bj) { const f32x4 v0 = acc[ai][bj][m][0], v1 = acc[ai][bj][m][1];
                    u32x4 w; w.x = cvt_pk_bf16(v0[0], v0[1]); w.y = cvt_pk_bf16(v0[2], v0[3]); w.z = cvt_pk_bf16(v1[0], v1[1]); w.w = cvt_pk_bf16(v1[2], v1[3]);
                    *(u32x4*)(rowp + bj * HALF) = w; } }
    }
};
struct EpiInRest {
    static constexpr bool PERM = true;
    unsigned char* ws;
    __device__ __forceinline__ void operator()(const f32x4 (&acc)[2][2][4][2], const Unit& u, int row0, int wr, int wc, int fr, int fq) const {
        const int gcol = OFF_WAQ + u.pn * BM;
        bf16_t* base; int ldc, c0; bool sg = false;
        if (gcol < OFF_WAKV) { base = (bf16_t*)(ws + WS_QWA); ldc = 1024; c0 = gcol - OFF_WAQ; }
        else if (gcol < OFF_NAQ) { base = (bf16_t*)(ws + WS_KVWA); ldc = 512; c0 = gcol - OFF_WAKV; }
        else if (gcol < OFF_NAKV) { base = (bf16_t*)(ws + WS_QNA); ldc = 1024; c0 = gcol - OFF_NAQ; }
        else if (gcol < OFF_GATE) { base = (bf16_t*)(ws + WS_KVNA); ldc = 2048; c0 = gcol - OFF_NAKV; }
        else { base = (bf16_t*)(ws + WS_GATE); ldc = 6144; c0 = gcol - OFF_GATE; sg = true; }
        const int r0 = row0 + wr * 64 + fr, col0 = c0 + wc * 32 + 8 * fq;
#pragma unroll
        for (int ai = 0; ai < 2; ++ai)
#pragma unroll
            for (int m = 0; m < 4; ++m) { bf16_t* rowp = base + (size_t)(r0 + ai * HALF + m * 16) * ldc + col0;
#pragma unroll
                for (int bj = 0; bj < 2; ++bj) { f32x4 v0 = acc[ai][bj][m][0], v1 = acc[ai][bj][m][1];
                    if (sg) {
#pragma unroll
                        for (int j = 0; j < 4; ++j) { v0[j] = sigmoid_f(v0[j]); v1[j] = sigmoid_f(v1[j]); } }
                    u32x4 w; w.x = cvt_pk_bf16(v0[0], v0[1]); w.y = cvt_pk_bf16(v0[2], v0[3]); w.z = cvt_pk_bf16(v1[0], v1[1]); w.w = cvt_pk_bf16(v1[2], v1[3]);
                    *(u32x4*)(rowp + bj * HALF) = w; } }
    }
};
template <int BR> struct EpiMergeF {
    static constexpr bool PERM = false;
    unsigned char* ws;
    __device__ __forceinline__ void operator()(const f32x4 (&acc)[2][2][4][2], const Unit& u, int row0, int wr, int wc, int fr, int fq) const {
        const int r0 = row0 + wr * 64 + fr, col0 = u.pn * BM + wc * 32 + 4 * fq;
#pragma unroll
        for (int ai = 0; ai < 2; ++ai)
#pragma unroll
            for (int m = 0; m < 4; ++m) { const size_t row = (size_t)(r0 + ai * HALF + m * 16);
                const bf16_t* gp = (const bf16_t*)(ws + WS_GATE) + row * 6144 + BR * 2048 + col0;
                float* mp = (float*)(ws + WS_MPART) + row * D + col0; bf16_t* ob = (bf16_t*)(ws + WS_MB) + row * D + col0;
#pragma unroll
                for (int bj = 0; bj < 2; ++bj)
#pragma unroll
                    for (int n = 0; n < 2; ++n) { const int co = bj * HALF + n * 16;
                        const u32x2 gg = *(const u32x2*)(gp + co);
                        const f32x4 g = {__uint_as_float(gg.x << 16), __uint_as_float(gg.x & 0xffff0000u), __uint_as_float(gg.y << 16), __uint_as_float(gg.y & 0xffff0000u)};
                        f32x4 t = g * acc[ai][bj][m][n];
                        if (BR > 0) t += *(const f32x4*)(mp + co);
                        if (BR < 2) *(f32x4*)(mp + co) = t;
                        else { u32x2 w; w.x = cvt_pk_bf16(t[0], t[1]); w.y = cvt_pk_bf16(t[2], t[3]); *(u32x2*)(ob + co) = w; } } }
    }
};
struct EpiOutF {
    static constexpr bool PERM = false;
    const Ctx* c; int layer;
    __device__ __forceinline__ void operator()(const f32x4 (&acc)[2][2][4][2], const Unit& u, int row0, int wr, int wc, int fr, int fq) const {
        const int r0 = row0 + wr * 64 + fr, col0 = u.pn * BM + wc * 32 + 4 * fq;
#pragma unroll
        for (int ai = 0; ai < 2; ++ai)
#pragma unroll
            for (int m = 0; m < 4; ++m) { const int row = r0 + ai * HALF + m * 16;
                const float* xin = c->xrow(layer, row) + col0; const float* g = c->mod(layer, row < L ? 0 : 1, 2) + col0;
                float* o = (float*)(c->ws + WS_XA) + (size_t)row * D + col0;
#pragma unroll
                for (int bj = 0; bj < 2; ++bj)
#pragma unroll
                    for (int n = 0; n < 2; ++n) { const int co = bj * HALF + n * 16;
                        *(f32x4*)(o + co) = *(const f32x4*)(xin + co) + *(const f32x4*)(g + co) * acc[ai][bj][m][n]; } }
    }
};
struct EpiGU {
    static constexpr bool PERM = false;
    bf16_t* act;
    __device__ __forceinline__ void operator()(const f32x4 (&acc)[2][2][4][2], const Unit& u, int row0, int wr, int wc, int fr, int fq) const {
        const int r0 = row0 + wr * 64 + fr, f0 = u.pn * 128 + wc * 16 + 4 * fq;
#pragma unroll
        for (int ai = 0; ai < 2; ++ai)
#pragma unroll
            for (int m = 0; m < 4; ++m) { bf16_t* rowp = act + (size_t)(r0 + ai * HALF + m * 16) * DF + f0;
#pragma unroll
                for (int bj = 0; bj < 2; ++bj) { const f32x4 a = acc[ai][bj][m][0], uu = acc[ai][bj][m][1]; f32x4 t;
#pragma unroll
                    for (int j = 0; j < 4; ++j) t[j] = silu_f(a[j]) * uu[j];
                    u32x2 w; w.x = cvt_pk_bf16(t[0], t[1]); w.y = cvt_pk_bf16(t[2], t[3]); *(u32x2*)(rowp + bj * 64) = w; } }
    }
};
}

template <class RowMap>
__device__ __forceinline__ void transpose_item(const float* __restrict__ W, int K, int N, bf16_t* WT, const RowMap& rm, float* scr, int item, int lane) {
    const int nblk = N / 32, kb = item / nblk, nb = item % nblk, k0 = 64 * kb, n0 = 32 * nb;
#pragma unroll 8
    for (int i = 0; i < 32; ++i) { const int kk = 2 * i + (lane >> 5); scr[kk * 33 + (lane & 31)] = W[(size_t)(k0 + kk) * N + n0 + (lane & 31)]; }
    LDS_FENCE();
    const int cq = lane & 7;
#pragma unroll
    for (int j = 0; j < 4; ++j) { const int n = (lane >> 3) + 8 * j; const float* sp = scr + (8 * cq) * 33 + n;
        uint4 o; o.x = pk2(sp[0 * 33], sp[1 * 33]); o.y = pk2(sp[2 * 33], sp[3 * 33]); o.z = pk2(sp[4 * 33], sp[5 * 33]); o.w = pk2(sp[6 * 33], sp[7 * 33]);
        *(uint4*)(WT + (size_t)rm(n0 + n) * K + k0 + 8 * cq) = o; }
    LDS_FENCE();
}
struct RmPlain { int off; __device__ __forceinline__ int operator()(int n) const { return off + n; } };
struct RmGU { int off; __device__ __forceinline__ int operator()(int f) const { return off + 32 * (f >> 4) + (f & 15); } };
__device__ __forceinline__ void ph_conv(const Ctx& c, int layer) {
    __syncthreads();
    float* scr = (float*)c.smem + c.wave * (64 * 33);
    const int gw = c.bid * 8 + c.wave, ngw = c.nb * 8;
    constexpr int I_IN = (D / 64) * (NIN / 32), I_BR = (1024 / 64) * (D / 32), I_OUT = (D / 64) * (D / 32), I_G = (D / 64) * (DF / 32), I_DN = (DF / 64) * (D / 32);
    constexpr int NITEMS = I_IN + 3 * I_BR + I_OUT + NE * (2 * I_G + I_DN);
    for (int it = gw; it < NITEMS; it += ngw) {
        int r = it;
        if (r < I_IN) { transpose_item(c.in[7] + (size_t)layer * D * NIN, D, NIN, c.wsp<bf16_t>(WS_WIN), RmPlain{0}, scr, r, c.lane); continue; } r -= I_IN;
        if (r < 3 * I_BR) { const int b = r / I_BR; transpose_item(c.in[24] + ((size_t)layer * 3 + b) * 1024 * D, 1024, D, c.wsp<bf16_t>(WS_WBR) + (size_t)b * D * 1024, RmPlain{0}, scr, r % I_BR, c.lane); continue; } r -= 3 * I_BR;
        if (r < I_OUT) { transpose_item(c.in[25] + (size_t)layer * D * D, D, D, c.wsp<bf16_t>(WS_WOUT), RmPlain{0}, scr, r, c.lane); continue; } r -= I_OUT;
        const int e = r / (2 * I_G + I_DN); r -= e * (2 * I_G + I_DN);
        if (r < I_G) { transpose_item(c.in[28] + ((size_t)layer * NE + e) * D * DF, D, DF, c.wsp<bf16_t>(WS_WGU), RmGU{e * 2048}, scr, r, c.lane); continue; } r -= I_G;
        if (r < I_G) { transpose_item(c.in[29] + ((size_t)layer * NE + e) * D * DF, D, DF, c.wsp<bf16_t>(WS_WGU), RmGU{e * 2048 + 16}, scr, r, c.lane); continue; } r -= I_G;
        transpose_item(c.in[30] + ((size_t)layer * NE + e) * DF * D, DF, D, c.wsp<bf16_t>(WS_WDN) + (size_t)e * D * DF, RmPlain{0}, scr, r, c.lane);
    }
}

__device__ __forceinline__ void ph_g0(const Ctx& c) {
    float* lds = (float*)c.smem;
    for (int u = c.bid; u < 2 * 256; u += c.nb) {
        const int layer = u >> 8, n0 = (u & 255) * 48;
        __syncthreads();
        for (int k = c.tid; k < D; k += NTHREADS) { lds[k] = silu_f(c.in[1][k]); lds[D + k] = silu_f(c.in[3][k]); }
        __syncthreads();
        const int col = c.tid % 48, kg = c.tid / 48;
        float a0 = 0.f, a1 = 0.f;
        if (kg < 10) {
            const float* w = c.in[4] + (size_t)layer * D * NMOD + n0 + col;
            for (int k = kg; k < D; k += 10) { const float wv = w[(size_t)k * NMOD]; a0 = fmaf(lds[k], wv, a0); a1 = fmaf(lds[D + k], wv, a1); }
        }
        float* red = lds + 2 * D;
        if (kg < 10) { red[(kg * 48 + col) * 2] = a0; red[(kg * 48 + col) * 2 + 1] = a1; }
        __syncthreads();
        if (c.tid < 96) {
            const int cc = c.tid >> 1, s = c.tid & 1; float t = 0.f;
            for (int g = 0; g < 10; ++g) t += red[(g * 48 + cc) * 2 + s];
            t += c.in[5][(size_t)layer * NMOD + n0 + cc];
            c.wsp<float>(WS_MOD)[(size_t)(layer * 2 + s) * NMOD + n0 + cc] = t;
        }
    }
    const int gw = c.bid * 8 + c.wave, ngw = c.nb * 8;
    for (int task = gw; task < 2 * MR; task += ngw) {
        const int layer = task / MR, pos = task % MR;
        const bool isc = pos >= L; const int i = isc ? pos - L : pos; const int Lx = isc ? LC : L;
        const float tt = (float)i * (1.0f / (float)(Lx - 1));
        const float c0 = (float)(2.0 * 3.14159265358979323846 / (double)Lx);
        const int j = c.lane;
        float feat = 0.f;
        if (j == 0) feat = tt;
        else if (j < 33) { const int b = (j - 1) & 15; const float band = 1e-4f + (float)b * ((15.0f - 1e-4f) / 15.0f); const float ang = (c0 * band) * (float)i; feat = (j <= 16) ? cosf(ang) : -sinf(ang); }
        const float* fw1 = c.in[10] + (size_t)layer * 33 * 64; const float* fb1 = c.in[11] + layer * 64;
        const float* fw2 = c.in[12] + (size_t)layer * 64 * 64; const float* fb2 = c.in[13] + layer * 64;
        const float* fr = c.in[15] + layer * 128;
        float s = fb1[j];
        for (int f = 0; f < 33; ++f) s = fmaf(__shfl(feat, f), fw1[f * 64 + j], s);
        const float h1 = sinf(fr[j] * s);
        float s2 = fb2[j];
        for (int m = 0; m < 64; ++m) s2 = fmaf(__shfl(h1, m), fw2[m * 64 + j], s2);
        const float h2 = sinf(fr[64 + j] * s2);
        c.wsp<float>(WS_H2F)[((size_t)layer * MR + pos) * 64 + j] = h2;
    }
}

__device__ __forceinline__ void ph_a(const Ctx& c, int layer) {
    const int gw = c.bid * 8 + c.wave, ngw = c.nb * 8;
    const float* g = c.in[6] + (size_t)layer * D;
    for (int r = gw; r < MR; r += ngw) {
        const float* x = c.xrow(layer, r);
        const int src = r < L ? 0 : 1;
        const float* sh = c.mod(layer, src, 0); const float* sc = c.mod(layer, src, 1);
        float4 v[8]; float ss = 0.f;
#pragma unroll
        for (int j = 0; j < 8; ++j) { v[j] = *(const float4*)(x + 4 * c.lane + 256 * j); ss += v[j].x * v[j].x + v[j].y * v[j].y + v[j].z * v[j].z + v[j].w * v[j].w; }
        ss = wave_sum(ss);
        const float inv = rsqrtf(ss * (1.0f / D) + RMS_EPS);
        bf16_t* o = c.wsp<bf16_t>(WS_HX) + (size_t)r * D;
#pragma unroll
        for (int j = 0; j < 8; ++j) {
            const int col = 4 * c.lane + 256 * j;
            const float4 gg = *(const float4*)(g + col), s4 = *(const float4*)(sh + col), c4 = *(const float4*)(sc + col);
            const float y0 = v[j].x * inv * gg.x * (1.f + c4.x) + s4.x, y1 = v[j].y * inv * gg.y * (1.f + c4.y) + s4.y;
            const float y2 = v[j].z * inv * gg.z * (1.f + c4.z) + s4.z, y3 = v[j].w * inv * gg.w * (1.f + c4.w) + s4.w;
            uint2 w; w.x = pk2(y0, y1); w.y = pk2(y2, y3);
            *(uint2*)(o + col) = w;
        }
    }
    float* hs = (float*)c.smem;
    const float* fw3 = c.in[14] + (size_t)layer * 64 * 4096;
    const float* dec = c.in[16] + (size_t)layer * 4096;
    for (int u = c.bid; u < 260; u += c.nb) {
        const bool isc = u >= 256; const int p0 = isc ? (u - 256) * 64 : u * 64; const int Lx = isc ? LC : L;
        __syncthreads();
        const float* h2f = c.wsp<float>(WS_H2F) + ((size_t)layer * MR + (isc ? L : 0) + p0) * 64;
        for (int e = c.tid; e < 64 * 64; e += NTHREADS) hs[e] = h2f[e];
        __syncthreads();
        for (int cb = 0; cb < 8; ++cb) {
            const int col = cb * 512 + c.tid;
            float w[64];
#pragma unroll
            for (int j = 0; j < 64; ++j) w[j] = fw3[j * 4096 + col];
            const float rate = fabsf(dec[col]);
            bf16_t* dst = isc ? c.wsp<bf16_t>(WS_KFC) + (size_t)col * LC + p0 : c.wsp<bf16_t>(WS_KF) + (size_t)col * L + p0;
#pragma unroll 1
            for (int p = 0; p < 64; p += 2) {
                float s0 = 0.f, s1 = 0.f;
#pragma unroll
                for (int j = 0; j < 64; j += 4) {
                    const float4 h4 = *(const float4*)&hs[p * 64 + j]; const float4 g4 = *(const float4*)&hs[(p + 1) * 64 + j];
                    s0 = fmaf(h4.x, w[j], s0); s0 = fmaf(h4.y, w[j + 1], s0); s0 = fmaf(h4.z, w[j + 2], s0); s0 = fmaf(h4.w, w[j + 3], s0);
                    s1 = fmaf(g4.x, w[j], s1); s1 = fmaf(g4.y, w[j + 1], s1); s1 = fmaf(g4.z, w[j + 2], s1); s1 = fmaf(g4.w, w[j + 3], s1);
                }
                const float t0 = (float)(p0 + p) * (1.0f / (float)(Lx - 1)), t1 = (float)(p0 + p + 1) * (1.0f / (float)(Lx - 1));
                *(unsigned*)(dst + p) = pk2(s0 * (__expf(-t0 * rate) + 0.05f), s1 * (__expf(-t1 * rate) + 0.05f));
            }
        }
    }
}

struct EpiIn {
    unsigned char* ws;
    __device__ __forceinline__ void operator()(int row, int col, const float (&v)[8]) const {
        if (col < OFF_WAQ) {
            bf16_t* d = (bf16_t*)(ws + WS_ZHYT);
#pragma unroll
            for (int j = 0; j < 8; ++j) d[(size_t)(col + j) * MR + row] = f2bf(v[j]);
            return;
        }
        bf16_t* dst; float t[8];
#pragma unroll
        for (int j = 0; j < 8; ++j) t[j] = v[j];
        if (col < OFF_WAKV) dst = (bf16_t*)(ws + WS_QWA) + (size_t)row * 1024 + (col - OFF_WAQ);
        else if (col < OFF_NAQ) dst = (bf16_t*)(ws + WS_KVWA) + (size_t)row * 512 + (col - OFF_WAKV);
        else if (col < OFF_NAKV) dst = (bf16_t*)(ws + WS_QNA) + (size_t)row * 1024 + (col - OFF_NAQ);
        else if (col < OFF_GATE) dst = (bf16_t*)(ws + WS_KVNA) + (size_t)row * 2048 + (col - OFF_NAKV);
        else { dst = (bf16_t*)(ws + WS_GATE) + (size_t)row * 6144 + (col - OFF_GATE);
#pragma unroll
            for (int j = 0; j < 8; ++j) t[j] = sigmoid_f(t[j]); }
        uint4 o; o.x = pk2(t[0], t[1]); o.y = pk2(t[2], t[3]); o.z = pk2(t[4], t[5]); o.w = pk2(t[6], t[7]);
        *(uint4*)dst = o;
    }
};
__device__ __forceinline__ void ph_b(const Ctx& c, int layer) {
    const RowLin rp{c.wsp<bf16_t>(WS_HX), D};
    const EpiIn ep{c.ws};
    const float* W = c.in[7] + (size_t)layer * D * NIN;
    const int nM = MR / 128, nN = NIN / 128;
    for (int u = c.bid; u < nM * nN; u += c.nb) {
        const int pm = u % nM, pn = u / nM;
        sgemm_unit(rp, W, NIN, D, pm * 128, pn * 128, ep, (float*)c.smem, c.tid);
    }
}

__device__ __forceinline__ void ph_b2(const Ctx& c, int layer) {
    const int gw = c.bid * 8 + c.wave, ngw = c.nb * 8;
    const int lane = c.lane;
    const int dlo = lane < 32 ? lane : lane + 32, dhi = dlo + 32;
    const int f = lane & 31, ax = lane >> 5;
    const float invf = powf(10000.0f, -(float)f / 32.0f);
    for (int task = gw; task < MR * 26; task += ngw) {
        const int r = task / 26, s = task % 26;
        bf16_t* p; const float* gain; bool rope;
        if (s < 8) { p = c.wsp<bf16_t>(WS_QWA) + (size_t)r * 1024 + s * 128; gain = c.in[18] + layer * 128; rope = true; }
        else if (s < 10) { p = c.wsp<bf16_t>(WS_KVWA) + (size_t)r * 512 + (s - 8) * 128; gain = c.in[19] + layer * 128; rope = true; }
        else if (s < 18) { p = c.wsp<bf16_t>(WS_QNA) + (size_t)r * 1024 + (s - 10) * 128; gain = c.in[21] + layer * 128; rope = false; }
        else { p = c.wsp<bf16_t>(WS_KVNA) + (size_t)r * 2048 + (s - 18) * 128; gain = c.in[22] + layer * 128; rope = false; }
        float a = bf2f(p[dlo]), b = bf2f(p[dhi]);
        const float ss = wave_sum(a * a + b * b);
        const float inv = rsqrtf(ss * (1.0f / 128.0f) + RMS_EPS);
        a = a * inv * gain[dlo]; b = b * inv * gain[dhi];
        if (rope && r < L) {
            const float pos = ax == 0 ? (float)(r / GRIDW) : (float)(r % GRIDW);
            const float ang = pos * invf; const float cs = cosf(ang), sn = sinf(ang);
            const float na = a * cs - b * sn, nb2 = b * cs + a * sn; a = na; b = nb2;
        }
        p[dlo] = f2bf(a); p[dhi] = f2bf(b);
    }
}

__device__ __forceinline__ float shortconv_at(const bf16_t* z, int t, int Lx, float w0, float w1, float w2, float b) {
    const float zm = t > 0 ? bf2f(z[t - 1]) : 0.f, z0 = bf2f(z[t]), zp = t + 1 < Lx ? bf2f(z[t + 1]) : 0.f;
    return zm * w0 + z0 * w1 + zp * w2 + b;
}
__device__ __forceinline__ float block_sum(float v, float* red, int tid) {
    v = wave_sum(v);
    __syncthreads();
    if ((tid & 63) == 0) red[tid >> 6] = v;
    __syncthreads();
    float t = 0.f;
#pragma unroll
    for (int w = 0; w < 8; ++w) t += red[w];
    return t;
}
__device__ __forceinline__ void hyena_direct_unit(const Ctx& c, int layer, int ch) {
    bf16_t* kc = (bf16_t*)c.smem;
    float* cv = (float*)c.smem;
    float* us = (float*)(c.smem + 4 * L);
    float* red = us + L;
    const int tid = c.tid;
    const float* cw = c.in[8] + (size_t)layer * 3 * 3072; const float* cb = c.in[9] + (size_t)layer * 3072;
    const bf16_t* zv = c.wsp<bf16_t>(WS_ZHYT) + (size_t)ch * MR;
    const bf16_t* z1 = c.wsp<bf16_t>(WS_ZHYT) + (size_t)(1024 + ch) * MR;
    const bf16_t* z2 = c.wsp<bf16_t>(WS_ZHYT) + (size_t)(2048 + ch) * MR;
    const bf16_t* KF = c.wsp<bf16_t>(WS_KF);
    __syncthreads();
    { const float w0 = cw[ch], w1 = cw[3072 + ch], w2 = cw[6144 + ch], b = cb[ch];
#pragma unroll 2
      for (int t = tid; t < L; t += NTHREADS) us[t] = shortconv_at(zv, t, L, w0, w1, w2, b); }
    for (int o = 0; o < 2; ++o) {
        const bf16_t* hf = KF + (size_t)(o * 1024 + ch) * L;
        const bf16_t* hb = KF + (size_t)(2048 + o * 1024 + ch) * L;
        float sabs = 0.f;
#pragma unroll 2
        for (int t = tid; t < L; t += NTHREADS) {
            bf16_t kf = hf[t], kb = hb[t];
            if (t == 0) { kf = f2bf(bf2f(kf) + bf2f(kb)); kb = 0; }
            kc[L + t] = kf; kc[L - t] = (t == 0) ? kf : kb;
            sabs += fabsf(bf2f(kf)) + fabsf(bf2f(kb));
        }
        if (tid == 0) kc[0] = 0;
        const float S = block_sum(sabs, red, tid);
        {
            float acc[32];
#pragma unroll
            for (int j = 0; j < 32; ++j) acc[j] = 0.f;
#pragma unroll 2
            for (int s = 0; s < L; ++s) {
                const float uv = us[s];
                const bf16_t* kp = kc + (L + tid - s);
#pragma unroll
                for (int j = 0; j < 32; ++j) acc[j] = fmaf(uv, bf2f(kp[512 * j]), acc[j]);
            }
            __syncthreads();
#pragma unroll
            for (int j = 0; j < 32; ++j) cv[tid + 512 * j] = acc[j];
        }
        LDS_FENCE();
        const float invS = 1.0f / S;
        const float dsk = c.in[17][(size_t)layer * 2048 + o * 1024 + ch];
        const int co = o == 0 ? 1024 : 2048;
        const bf16_t* zz = o == 0 ? z1 : z2;
        const float w0 = cw[co + ch], w1 = cw[3072 + co + ch], w2 = cw[6144 + co + ch], b = cb[co + ch];
        bf16_t* dst = c.wsp<bf16_t>(WS_YHYT) + (size_t)ch * L;
#pragma unroll 2
        for (int t = tid; t < L; t += NTHREADS) {
            const float r = shortconv_at(zz, t, L, w0, w1, w2, b) * (cv[t] * invS + us[t] * dsk);
            if (o == 0) us[t] = r; else dst[t] = f2bf(r);
        }
        __syncthreads();
    }
}
__device__ __forceinline__ void hyena_ctx_unit(const Ctx& c, int layer, int ch) {
    float* kc = (float*)c.smem;
    float* us = kc + 512;
    float* red = us + 256;
    const int tid = c.tid;
    const float* cw = c.in[8] + (size_t)layer * 3 * 3072; const float* cb = c.in[9] + (size_t)layer * 3072;
    const bf16_t* zv = c.wsp<bf16_t>(WS_ZHYT) + (size_t)ch * MR + L;
    const bf16_t* z1 = c.wsp<bf16_t>(WS_ZHYT) + (size_t)(1024 + ch) * MR + L;
    const bf16_t* z2 = c.wsp<bf16_t>(WS_ZHYT) + (size_t)(2048 + ch) * MR + L;
    const bf16_t* KF = c.wsp<bf16_t>(WS_KFC);
    __syncthreads();
    if (tid < LC) us[tid] = shortconv_at(zv, tid, LC, cw[ch], cw[3072 + ch], cw[6144 + ch], cb[ch]);
    for (int o = 0; o < 2; ++o) {
        const bf16_t* hf = KF + (size_t)(o * 1024 + ch) * LC;
        const bf16_t* hb = KF + (size_t)(2048 + o * 1024 + ch) * LC;
        float sabs = 0.f;
        {
            const int lag = tid - 256; float k;
            if (lag == 0) k = bf2f(hf[0]) + bf2f(hb[0]); else if (lag > 0) k = bf2f(hf[lag]); else if (lag > -256) k = bf2f(hb[-lag]); else k = 0.f;
            kc[tid] = k; sabs = fabsf(k);
        }
        const float S = block_sum(sabs, red, tid);
        float acc = 0.f;
        if (tid < LC) for (int s = 0; s < LC; ++s) acc = fmaf(us[s], kc[256 + tid - s], acc);
        const float dsk = c.in[17][(size_t)layer * 2048 + o * 1024 + ch];
        float res = 0.f;
        if (tid < LC) {
            const bf16_t* zz = o == 0 ? z1 : z2; const int co = o == 0 ? 1024 : 2048;
            res = shortconv_at(zz, tid, LC, cw[co + ch], cw[3072 + co + ch], cw[6144 + co + ch], cb[co + ch]) * (acc / S + us[tid] * dsk);
        }
        __syncthreads();
        if (tid < LC) { if (o == 0) us[tid] = res; else c.wsp<bf16_t>(WS_YHY)[(size_t)(L + tid) * 1024 + ch] = f2bf(res); }
        __syncthreads();
    }
}

template <class KeyFn>
__device__ __forceinline__ void wave_attn(const bf16_t* q, int nkeys, const KeyFn& key, bool has_sink, float sink, bf16_t* out, float* wl, int lane) {
    float* qf = wl;
    float* sc = wl + 128;
    qf[2 * lane] = bf2f(q[2 * lane]); qf[2 * lane + 1] = bf2f(q[2 * lane + 1]);
    LDS_FENCE();
    float mx = -3.0e38f;
    for (int j = lane; j < nkeys; j += 64) {
        const bf16_t* kp; const bf16_t* vp; float bias;
        float s = -1e30f;
        if (key(j, kp, vp, bias)) {
            float d = 0.f;
#pragma unroll
            for (int e = 0; e < 128; e += 8) {
                const uint4 kk = *(const uint4*)(kp + e);
                d = fmaf(qf[e + 0], __uint_as_float(kk.x << 16), d); d = fmaf(qf[e + 1], __uint_as_float(kk.x & 0xffff0000u), d);
                d = fmaf(qf[e + 2], __uint_as_float(kk.y << 16), d); d = fmaf(qf[e + 3], __uint_as_float(kk.y & 0xffff0000u), d);
                d = fmaf(qf[e + 4], __uint_as_float(kk.z << 16), d); d = fmaf(qf[e + 5], __uint_as_float(kk.z & 0xffff0000u), d);
                d = fmaf(qf[e + 6], __uint_as_float(kk.w << 16), d); d = fmaf(qf[e + 7], __uint_as_float(kk.w & 0xffff0000u), d);
            }
            s = d * QK_SCALE + bias;
        }
        sc[j] = s; mx = fmaxf(mx, s);
    }
    if (has_sink) mx = fmaxf(mx, sink);
    mx = wave_max(mx);
    float sum = 0.f;
    for (int j = lane; j < nkeys; j += 64) { const float p = __expf(sc[j] - mx); sc[j] = p; sum += p; }
    sum = wave_sum(sum);
    if (has_sink) sum += __expf(sink - mx);
    LDS_FENCE();
    float o0 = 0.f, o1 = 0.f;
    for (int j = 0; j < nkeys; ++j) {
        const float p = sc[j];
        if (p != 0.f) {
            const bf16_t* kp; const bf16_t* vp; float bias;
            key(j, kp, vp, bias);
            const unsigned vv = *(const unsigned*)(vp + 2 * lane);
            o0 = fmaf(p, __uint_as_float(vv << 16), o0); o1 = fmaf(p, __uint_as_float(vv & 0xffff0000u), o1);
        }
    }
    const float inv = 1.0f / sum;
    *(unsigned*)(out + 2 * lane) = pk2(o0 * inv, o1 * inv);
    LDS_FENCE();
}

struct KeyWA {
    const bf16_t* kv; int t, kvh;
    __device__ __forceinline__ bool operator()(int j, const bf16_t*& kp, const bf16_t*& vp, float& bias) const {
        bias = 0.f;
        int row; bool ok = true;
        if (j < 257) { const int kpos = t - 128 + j; ok = kpos >= 0 && kpos < L; row = ok ? kpos : 0; } else row = L + (j - 257);
        kp = kv + (size_t)row * 512 + kvh * 128; vp = kp + 256; return ok;
    }
};
struct KeyCtxWA { const bf16_t* kv; int kvh;
    __device__ __forceinline__ bool operator()(int j, const bf16_t*& kp, const bf16_t*& vp, float& bias) const { bias = 0.f; kp = kv + (size_t)(L + j) * 512 + kvh * 128; vp = kp + 256; return true; } };
struct KeyNA {
    const bf16_t* kv; const float* rpb; int r, qc, r0, cs, h;
    __device__ __forceinline__ bool operator()(int j, const bf16_t*& kp, const bf16_t*& vp, float& bias) const {
        int row;
        if (j < 128) { const int w = j >> 4, kc = cs + (j & 15); row = (r0 + w) * GRIDW + kc;
            const int dr = r0 + w - r + 7; int dc = kc - qc + 15; dc = dc < 0 ? 0 : (dc > 30 ? 30 : dc);
            bias = rpb[(h * 15 + dr) * 31 + dc]; }
        else { row = L + (j - 128); bias = 0.f; }
        kp = kv + (size_t)row * 2048 + h * 128; vp = kp + 1024; return true;
    }
};
struct KeyCtxNA { const bf16_t* kv; int h;
    __device__ __forceinline__ bool operator()(int j, const bf16_t*& kp, const bf16_t*& vp, float& bias) const { bias = 0.f; kp = kv + (size_t)(L + j) * 2048 + h * 128; vp = kp + 1024; return true; } };


#define HYF __device__ __forceinline__
#define HYF_OPAQUE(x) asm volatile("" : "+v"(x))
#define HYF_SB(i) do { if (((i) & 3) == 3) __builtin_amdgcn_sched_barrier(0); } while (0)
namespace hyf {
constexpr int FL = 16384;
constexpr int FPAD = FL + 32 * 16;
typedef float cpx __attribute__((ext_vector_type(2)));
HYF int phys(int p) { return ((p & ~15) | ((p & 15) ^ ((p >> 5) & 15))) + ((p >> 9) << 4); }

#define HYF_C32 {1.0f, 0.98078528040323043f, 0.92387953251128674f, 0.83146961230254524f, 0.70710678118654752f, 0.55557023301960218f, 0.38268343236508978f, 0.19509032201612825f, \
                 0.0f, -0.19509032201612825f, -0.38268343236508978f, -0.55557023301960218f, -0.70710678118654752f, -0.83146961230254524f, -0.92387953251128674f, -0.98078528040323043f}
#define HYF_S32 {0.0f, 0.19509032201612825f, 0.38268343236508978f, 0.55557023301960218f, 0.70710678118654752f, 0.83146961230254524f, 0.92387953251128674f, 0.98078528040323043f, \
                 1.0f, 0.98078528040323043f, 0.92387953251128674f, 0.83146961230254524f, 0.70710678118654752f, 0.55557023301960218f, 0.38268343236508978f, 0.19509032201612825f}

HYF int rev5(int x) { return (int)(__builtin_bitreverse32((unsigned)x) >> 27); }
HYF int rev4(int x) { return (int)(__builtin_bitreverse32((unsigned)x) >> 28); }
HYF cpx cmul(cpx a, cpx t) { return a.xx * t + (cpx){-a.y, a.y} * t.yx; }
HYF cpx cmulc(cpx a, cpx t) { return t.xx * a + t.yy * (cpx){a.y, -a.x}; }

template <int N, int SG, int BASE, int STRIDE32>
struct DifStage {
    static HYF void run(cpx (&v)[32], const float (&K)[9]) {
        constexpr int H = N / 2;
#pragma unroll
        for (int j = 0; j < H; ++j) {
            const cpx a = v[BASE + j], b = v[BASE + j + H];
            v[BASE + j] = a + b;
            const cpx d = a - b;
            const int tw = j * STRIDE32;
            if (tw == 0) v[BASE + j + H] = d;
            else if (tw == 8) v[BASE + j + H] = (SG < 0) ? (cpx){d.y, -d.x} : (cpx){-d.y, d.x};
            else {
                const float c = (tw < 8) ? K[tw] : -K[16 - tw];
                const float sa = (tw < 8) ? K[8 - tw] : K[tw - 8];
                const float s = (SG < 0) ? -sa : sa;
                v[BASE + j + H] = d * c + (cpx){-d.y, d.x} * s;
            }
        }
        if constexpr (N > 2) { DifStage<H, SG, BASE, STRIDE32 * 2>::run(v, K); DifStage<H, SG, BASE + H, STRIDE32 * 2>::run(v, K); }
    }
};
template <int SG> HYF void dft32(cpx (&v)[32], const float (&K0)[9]) { float K[9]; _Pragma("unroll") for (int m = 0; m < 9; ++m) { K[m] = K0[m]; HYF_OPAQUE(K[m]); } DifStage<32, SG, 0, 1>::run(v, K); }
template <int SG> HYF void dft16(cpx (&v)[32], const float (&K0)[9]) { float K[9]; _Pragma("unroll") for (int m = 0; m < 9; ++m) { K[m] = K0[m]; HYF_OPAQUE(K[m]); } DifStage<16, SG, 0, 2>::run(v, K); }

struct ThreadTw { cpx w1;
                  cpx w2;
                  cpx wo;
                  int b1;
                  int b2, n3;
                  int b3[2], sw;
                  float K[9]; };
HYF void tw_addr(int tid, ThreadTw& t) {
    t.b1 = (tid & ~15) | ((tid & 15) ^ ((tid >> 5) & 15));
    t.b2 = (tid >> 4) * 528; t.n3 = tid & 15; t.sw = (tid >> 1) & 15;
    for (int h = 0; h < 2; ++h) { const int g = tid + 512 * h; t.b3[h] = g * 16 + (g >> 5) * 16; }
    constexpr float KK[9] = {1.0f, 0.98078528040323043f, 0.92387953251128674f, 0.83146961230254524f, 0.70710678118654752f, 0.55557023301960218f, 0.38268343236508978f, 0.19509032201612825f, 0.0f};
    for (int m = 0; m < 9; ++m) { t.K[m] = KK[m]; HYF_OPAQUE(t.K[m]); }
}

HYF void fwd_p1(const ThreadTw& tw, cpx (&v)[32], cpx* lds) {
    int b1 = tw.b1; HYF_OPAQUE(b1);
    float wx = tw.w1.x, wy = tw.w1.y; HYF_OPAQUE(wx); HYF_OPAQUE(wy); const cpx w = {wx, wy};
    dft32<-1>(v, tw.K);
    cpx t = {1.f, 0.f};
#pragma unroll
    for (int k1 = 0; k1 < 32; ++k1) {
        lds[b1 + 528 * k1] = cmul(v[rev5(k1)], t);
        t = cmul(t, w);
        HYF_SB(k1);
    }
}
HYF void fwd_p2(const ThreadTw& tw, cpx* lds) {
    int b2 = tw.b2, n3 = tw.n3; HYF_OPAQUE(b2); HYF_OPAQUE(n3);
    float wx = tw.w2.x, wy = tw.w2.y; HYF_OPAQUE(wx); HYF_OPAQUE(wy); const cpx w = {wx, wy};
    cpx v[32];
#pragma unroll
    for (int n2 = 0; n2 < 32; ++n2) v[n2] = lds[b2 + 16 * n2 + (n3 ^ ((n2 >> 1) & 15))];
    dft32<-1>(v, tw.K);
    cpx t = {1.f, 0.f};
#pragma unroll
    for (int k2 = 0; k2 < 32; ++k2) {
        lds[b2 + 16 * k2 + (n3 ^ ((k2 >> 1) & 15))] = cmul(v[rev5(k2)], t);
        t = cmul(t, w);
        HYF_SB(k2);
    }
}
HYF void fwd_p3(int tid, const ThreadTw& tw, const cpx* lds, cpx* ks) {
    HYF_OPAQUE(tid);
#pragma unroll
    for (int h = 0; h < 2; ++h) {
        int b3 = tw.b3[h], sw = tw.sw; HYF_OPAQUE(b3); HYF_OPAQUE(sw);
        cpx v[32];
#pragma unroll
        for (int n3 = 0; n3 < 16; ++n3) v[n3] = lds[b3 + (n3 ^ sw)];
        dft16<-1>(v, tw.K);
#pragma unroll
        for (int k3 = 0; k3 < 16; ++k3) ks[(h * 16 + k3) * 512 + tid] = v[rev4(k3)];
    }
}
HYF void mid_p3(int tid, const ThreadTw& tw, cpx* lds, const cpx* ks) {
    HYF_OPAQUE(tid);
#pragma unroll
    for (int h = 0; h < 2; ++h) {
        int b3 = tw.b3[h], sw = tw.sw; HYF_OPAQUE(b3); HYF_OPAQUE(sw);
        cpx v[32], p[32];
#pragma unroll
        for (int n3 = 0; n3 < 16; ++n3) v[n3] = lds[b3 + (n3 ^ sw)];
        dft16<-1>(v, tw.K);
#pragma unroll
        for (int k3 = 0; k3 < 16; ++k3) p[k3] = cmul(v[rev4(k3)], ks[(h * 16 + k3) * 512 + tid]);
        dft16<1>(p, tw.K);
#pragma unroll
        for (int n3 = 0; n3 < 16; ++n3) lds[b3 + (n3 ^ sw)] = p[rev4(n3)];
    }
}
HYF void inv_p2(const ThreadTw& tw, cpx* lds) {
    int b2 = tw.b2, n3 = tw.n3; HYF_OPAQUE(b2); HYF_OPAQUE(n3);
    float wx = tw.w2.x, wy = tw.w2.y; HYF_OPAQUE(wx); HYF_OPAQUE(wy); const cpx w = {wx, wy};
    cpx v[32];
    cpx t = {1.f, 0.f};
#pragma unroll
    for (int k2 = 0; k2 < 32; ++k2) {
        v[k2] = cmulc(lds[b2 + 16 * k2 + (n3 ^ ((k2 >> 1) & 15))], t);
        t = cmul(t, w);
        HYF_SB(k2);
    }
    dft32<1>(v, tw.K);
#pragma unroll
    for (int n2 = 0; n2 < 32; ++n2) { lds[b2 + 16 * n2 + (n3 ^ ((n2 >> 1) & 15))] = v[rev5(n2)]; HYF_SB(n2); }
}
HYF void inv_p1(const ThreadTw& tw, const cpx* lds, cpx (&out)[32]) {
    int b1 = tw.b1; HYF_OPAQUE(b1);
    float wx = tw.w1.x, wy = tw.w1.y; HYF_OPAQUE(wx); HYF_OPAQUE(wy); const cpx w = {wx, wy};
    cpx v[32];
    cpx t = {1.f, 0.f};
#pragma unroll
    for (int k1 = 0; k1 < 32; ++k1) {
        v[k1] = cmulc(lds[b1 + 528 * k1], t);
        t = cmul(t, w);
        HYF_SB(k1);
    }
    dft32<1>(v, tw.K);
#pragma unroll
    for (int n1 = 0; n1 < 32; ++n1) out[n1] = v[rev5(n1)];
}
HYF cpx opaque_wo(const ThreadTw& tw) { float x = tw.wo.x, y = tw.wo.y; HYF_OPAQUE(x); HYF_OPAQUE(y); return (cpx){x, y}; }
HYF cpx modfac(cpx wo, int n1) {
    constexpr float C64[32] = {1.0f, 0.99518472667219693f, 0.98078528040323043f, 0.95694033573220882f, 0.92387953251128674f, 0.88192126434835505f, 0.83146961230254524f, 0.77301045336273699f,
        0.70710678118654752f, 0.63439328416364549f, 0.55557023301960218f, 0.47139673682599764f, 0.38268343236508978f, 0.29028467725446233f, 0.19509032201612825f, 0.098017140329560604f,
        0.0f, -0.098017140329560604f, -0.19509032201612825f, -0.29028467725446233f, -0.38268343236508978f, -0.47139673682599764f, -0.55557023301960218f, -0.63439328416364549f,
        -0.70710678118654752f, -0.77301045336273699f, -0.83146961230254524f, -0.88192126434835505f, -0.92387953251128674f, -0.95694033573220882f, -0.98078528040323043f, -0.99518472667219693f};
    constexpr float S64[32] = {0.0f, 0.098017140329560604f, 0.19509032201612825f, 0.29028467725446233f, 0.38268343236508978f, 0.47139673682599764f, 0.55557023301960218f, 0.63439328416364549f,
        0.70710678118654752f, 0.77301045336273699f, 0.83146961230254524f, 0.88192126434835505f, 0.92387953251128674f, 0.95694033573220882f, 0.98078528040323043f, 0.99518472667219693f,
        1.0f, 0.99518472667219693f, 0.98078528040323043f, 0.95694033573220882f, 0.92387953251128674f, 0.88192126434835505f, 0.83146961230254524f, 0.77301045336273699f,
        0.70710678118654752f, 0.63439328416364549f, 0.55557023301960218f, 0.47139673682599764f, 0.38268343236508978f, 0.29028467725446233f, 0.19509032201612825f, 0.098017140329560604f};
    return cmul(wo, (cpx){C64[n1], -S64[n1]});
}
}

#undef HYF
#ifndef FAST_HY
#define FAST_HY 1
#endif
__device__ __forceinline__ void hyena_fft_unit(const Ctx& c, int layer, int ch, const hyf::ThreadTw& tw) {
    using namespace hyf;
    cpx* lds = (cpx*)c.smem; float* red = (float*)(c.smem + (size_t)FPAD * 8);
    cpx* ks = c.wsp<cpx>(WS_KS) + (size_t)c.bid * (2 * FL);
    float* ub = (float*)(ks + FL); float* yb = ub + FL;
    const int tid = c.tid;
    const float* cw = c.in[8] + (size_t)layer * 3 * 3072; const float* cb = c.in[9] + (size_t)layer * 3072;
    const bf16_t* zv = c.wsp<bf16_t>(WS_ZHYT) + (size_t)ch * MR;
    const bf16_t* KF = c.wsp<bf16_t>(WS_KF);
    { const float w0 = cw[ch], w1 = cw[3072 + ch], w2 = cw[6144 + ch], b = cb[ch]; int tq = tid; HYF_OPAQUE(tq);
#pragma unroll 4
      for (int j = 0; j < 32; ++j) ub[tq + 512 * j] = shortconv_at(zv, tq + 512 * j, L, w0, w1, w2, b); }
#pragma unroll 1
    for (int o = 0; o < 2; ++o) {
        const bf16_t* hf = KF + (size_t)(o * 1024 + ch) * L;
        const bf16_t* hb = KF + (size_t)(2048 + o * 1024 + ch) * L;
        float S;
        {
            cpx v[32]; float sabs = 0.f; int tq = tid; HYF_OPAQUE(tq);
#pragma unroll
            for (int j = 0; j < 32; ++j) { const int n = tq + 512 * j; const float f = bf2f(hf[n]); const float bb = bf2f(hb[n == 0 ? 0 : L - n]);
                v[j] = (cpx){f + bb, 0.f}; sabs += (n == 0) ? fabsf(f + bb) : fabsf(f) + fabsf(bb); }
            S = block_sum(sabs, red, tid);
            fwd_p1(tw, v, lds); __syncthreads(); fwd_p2(tw, lds); __syncthreads(); fwd_p3(tid, tw, lds, ks); __syncthreads();
        }
        {
            cpx v[32]; int tq = tid; HYF_OPAQUE(tq);
#pragma unroll
            for (int j = 0; j < 32; ++j) v[j] = (cpx){ub[tq + 512 * j], 0.f};
            fwd_p1(tw, v, lds); __syncthreads(); fwd_p2(tw, lds); __syncthreads(); mid_p3(tid, tw, lds, ks); __syncthreads();
            inv_p2(tw, lds); __syncthreads();
            inv_p1(tw, lds, v); __syncthreads();
            HYF_OPAQUE(tq);
#pragma unroll
            for (int j = 0; j < 32; ++j) yb[tq + 512 * j] = v[j].x;
        }
        {
            cpx v[32]; const cpx wo = opaque_wo(tw); int tq = tid; HYF_OPAQUE(tq);
#pragma unroll
            for (int j = 0; j < 32; ++j) { const int n = tq + 512 * j; const float f = bf2f(hf[n]); const float bb = bf2f(hb[n == 0 ? 0 : L - n]);
                const float d = (n == 0) ? f + bb : f - bb; v[j] = modfac(wo, j) * d; }
            fwd_p1(tw, v, lds); __syncthreads(); fwd_p2(tw, lds); __syncthreads(); fwd_p3(tid, tw, lds, ks); __syncthreads();
        }
        {
            cpx v[32]; cpx wo = opaque_wo(tw); int tq = tid; HYF_OPAQUE(tq);
#pragma unroll
            for (int j = 0; j < 32; ++j) v[j] = modfac(wo, j) * ub[tq + 512 * j];
            fwd_p1(tw, v, lds); __syncthreads(); fwd_p2(tw, lds); __syncthreads(); mid_p3(tid, tw, lds, ks); __syncthreads();
            inv_p2(tw, lds); __syncthreads();
            inv_p1(tw, lds, v); __syncthreads();
            const float sc = (0.5f / (float)L) / S; wo = opaque_wo(tw); HYF_OPAQUE(tq);
            const float dsk = c.in[17][(size_t)layer * 2048 + o * 1024 + ch];
            const int co = o == 0 ? 1024 : 2048;
            const bf16_t* zz = c.wsp<bf16_t>(WS_ZHYT) + (size_t)(co + ch) * MR;
            const float w0 = cw[co + ch], w1 = cw[3072 + co + ch], w2 = cw[6144 + co + ch], b = cb[co + ch];
            bf16_t* dst = c.wsp<bf16_t>(WS_YHYT) + (size_t)ch * L;
#pragma unroll
            for (int j = 0; j < 32; ++j) { const int t = tq + 512 * j; const cpx m = modfac(wo, j);
                const float conv = (yb[t] + v[j].x * m.x + v[j].y * m.y) * sc;
                const float r = shortconv_at(zz, t, L, w0, w1, w2, b) * (conv + ub[t] * dsk);
                if (o == 0) ub[t] = r; else dst[t] = f2bf(r); }
        }
    }
}

__device__ __forceinline__ void ph_c(const Ctx& c, int layer) {
#ifndef NO_HY
    if (FAST_HY) {
        hyf::ThreadTw tw; hyf::tw_addr(c.tid, tw);
        { float s_, c_; sincospif(-2.0f * (float)c.tid / (float)hyf::FL, &s_, &c_); tw.w1 = (hyf::cpx){c_, s_};
          sincospif(-2.0f * (float)(c.tid & 15) / 512.0f, &s_, &c_); tw.w2 = (hyf::cpx){c_, s_};
          sincospif(-(float)c.tid / (float)hyf::FL, &s_, &c_); tw.wo = (hyf::cpx){c_, s_}; }
        for (int u = c.bid; u < 1024; u += c.nb) hyena_fft_unit(c, layer, u, tw);
    } else
    for (int u = c.bid; u < 1024; u += c.nb) hyena_direct_unit(c, layer, u);
#endif
#ifndef NO_HYC
    if (layer == 0) for (int u = c.bid; u < 1024; u += c.nb) hyena_ctx_unit(c, layer, u);
#endif
    __syncthreads();
#ifndef NO_ATT
    const int gw = c.bid * 8 + c.wave, ngw = c.nb * 8;
    float* wl = (float*)c.smem + c.wave * 768;
    const int nrows = layer == 0 ? MR : L;
    const float* sinkp = c.in[20] + layer * 8;
    const float* rpb = c.in[23] + (size_t)layer * 8 * 15 * 31;
    const bf16_t* kvwa = c.wsp<bf16_t>(WS_KVWA); const bf16_t* kvna = c.wsp<bf16_t>(WS_KVNA);
    for (int task = gw; task < nrows * 16; task += ngw) {
        const int r = task >> 4, hh = task & 15;
        if (hh < 8) {
            const int h = hh; const bf16_t* q = c.wsp<bf16_t>(WS_QWA) + (size_t)r * 1024 + h * 128; bf16_t* o = c.wsp<bf16_t>(WS_YWA) + (size_t)r * 1024 + h * 128;
            if (r < L) { const KeyWA k{kvwa, r, h >> 2}; wave_attn(q, 513, k, true, sinkp[h], o, wl, c.lane); }
            else { const KeyCtxWA k{kvwa, h >> 2}; wave_attn(q, 256, k, true, sinkp[h], o, wl, c.lane); }
        } else {
            const int h = hh - 8; const bf16_t* q = c.wsp<bf16_t>(WS_QNA) + (size_t)r * 1024 + h * 128; bf16_t* o = c.wsp<bf16_t>(WS_YNA) + (size_t)r * 1024 + h * 128;
            if (r < L) { const int gr = r / GRIDW, qc = r % GRIDW; int r0 = gr - 4; r0 = r0 < 0 ? 0 : (r0 > 248 ? 248 : r0); int cs = qc - 8; cs = cs < 0 ? 0 : (cs > 48 ? 48 : cs);
                const KeyNA k{kvna, rpb, gr, qc, r0, cs, h}; wave_attn(q, 384, k, false, 0.f, o, wl, c.lane); }
            else { const KeyCtxNA k{kvna, h}; wave_attn(q, 256, k, false, 0.f, o, wl, c.lane); }
        }
    }
#endif
}

__device__ __forceinline__ void ph_c2(const Ctx& c) {
    bf16_t* tile = (bf16_t*)c.smem;
    const bf16_t* src = c.wsp<bf16_t>(WS_YHYT); bf16_t* dst = c.wsp<bf16_t>(WS_YHY);
    for (int u = c.bid; u < (1024 / 64) * (L / 64); u += c.nb) {
        const int c0 = (u % 16) * 64, t0 = (u / 16) * 64;
        __syncthreads();
        for (int e = c.tid; e < 4096; e += NTHREADS) { const int cc = e >> 6, tt = e & 63; tile[cc * 66 + tt] = src[(size_t)(c0 + cc) * L + t0 + tt]; }
        __syncthreads();
        for (int e = c.tid; e < 4096; e += NTHREADS) { const int tt = e >> 6, cc = e & 63; dst[(size_t)(t0 + tt) * 1024 + c0 + cc] = tile[cc * 66 + tt]; }
    }
}

struct EpiMerge { unsigned char* ws; int b;
    __device__ __forceinline__ void operator()(int row, int col, const float (&v)[8]) const {
        const bf16_t* g = (const bf16_t*)(ws + WS_GATE) + (size_t)row * 6144 + b * 2048 + col;
        float* mp = (float*)(ws + WS_MPART) + (size_t)row * D + col;
        const uint4 gg = *(const uint4*)g;
        const float gv[8] = {__uint_as_float(gg.x << 16), __uint_as_float(gg.x & 0xffff0000u), __uint_as_float(gg.y << 16), __uint_as_float(gg.y & 0xffff0000u),
                             __uint_as_float(gg.z << 16), __uint_as_float(gg.z & 0xffff0000u), __uint_as_float(gg.w << 16), __uint_as_float(gg.w & 0xffff0000u)};
        float t[8];
        if (b == 0) {
#pragma unroll
            for (int j = 0; j < 8; ++j) t[j] = gv[j] * v[j];
        } else {
            const float4 p0 = *(const float4*)mp, p1 = *(const float4*)(mp + 4);
            const float pv[8] = {p0.x, p0.y, p0.z, p0.w, p1.x, p1.y, p1.z, p1.w};
#pragma unroll
            for (int j = 0; j < 8; ++j) t[j] = fmaf(gv[j], v[j], pv[j]);
        }
        if (b < 2) { *(float4*)mp = make_float4(t[0], t[1], t[2], t[3]); *(float4*)(mp + 4) = make_float4(t[4], t[5], t[6], t[7]); }
        else { uint4 o; o.x = pk2(t[0], t[1]); o.y = pk2(t[2], t[3]); o.z = pk2(t[4], t[5]); o.w = pk2(t[6], t[7]); *(uint4*)((bf16_t*)(ws + WS_MB) + (size_t)row * D + col) = o; }
    }
};
__device__ __forceinline__ void ph_d(const Ctx& c, int layer) {
    const int nM = MR / 128, nN = D / 128;
    for (int b = 0; b < 3; ++b) {
        const bf16_t* A = b == 0 ? c.wsp<bf16_t>(WS_YHY) : (b == 1 ? c.wsp<bf16_t>(WS_YWA) : c.wsp<bf16_t>(WS_YNA));
        const RowLin rp{A, 1024}; const EpiMerge ep{c.ws, b};
        const float* W = c.in[24] + ((size_t)layer * 3 + b) * 1024 * D;
        for (int u = c.bid; u < nM * nN; u += c.nb) sgemm_unit(rp, W, D, 1024, (u % nM) * 128, (u / nM) * 128, ep, (float*)c.smem, c.tid);
    }
}
struct EpiOut { const Ctx* c; int layer;
    __device__ __forceinline__ void operator()(int row, int col, const float (&v)[8]) const {
        const float* xin = c->xrow(layer, row) + col; const float* g = c->mod(layer, row < L ? 0 : 1, 2) + col;
        float* o = (float*)(c->ws + WS_XA) + (size_t)row * D + col;
        const float4 x0 = *(const float4*)xin, x1 = *(const float4*)(xin + 4), g0 = *(const float4*)g, g1 = *(const float4*)(g + 4);
        *(float4*)o = make_float4(x0.x + g0.x * v[0], x0.y + g0.y * v[1], x0.z + g0.z * v[2], x0.w + g0.w * v[3]);
        *(float4*)(o + 4) = make_float4(x1.x + g1.x * v[4], x1.y + g1.y * v[5], x1.z + g1.z * v[6], x1.w + g1.w * v[7]);
    }
};
__device__ __forceinline__ void ph_e(const Ctx& c, int layer) {
    const int nM = MR / 128, nN = D / 128;
    const RowLin rp{c.wsp<bf16_t>(WS_MB), D}; const EpiOut ep{&c, layer};
    const float* W = c.in[25] + (size_t)layer * D * D;
    for (int u = c.bid; u < nM * nN; u += c.nb) sgemm_unit(rp, W, D, D, (u % nM) * 128, (u / nM) * 128, ep, (float*)c.smem, c.tid);
}

__device__ __forceinline__ void ph_f(const Ctx& c, int layer) {
    const int gw = c.bid * 8 + c.wave, ngw = c.nb * 8;
    const float* g = c.in[26] + (size_t)layer * D;
    const float* wr = c.in[27] + (size_t)layer * D * NE;
    for (int r = gw; r < MR; r += ngw) {
        const float* x = c.wsp<float>(WS_XA) + (size_t)r * D;
        const int src = r < L ? 0 : 1;
        const float* sh = c.mod(layer, src, 3); const float* sc = c.mod(layer, src, 4);
        float4 v[8]; float ss = 0.f;
#pragma unroll
        for (int j = 0; j < 8; ++j) { v[j] = *(const float4*)(x + 4 * c.lane + 256 * j); ss += v[j].x * v[j].x + v[j].y * v[j].y + v[j].z * v[j].z + v[j].w * v[j].w; }
        ss = wave_sum(ss);
        const float inv = rsqrtf(ss * (1.0f / D) + RMS_EPS);
        bf16_t* o = c.wsp<bf16_t>(WS_H2) + (size_t)r * D;
        float lg[NE];
#pragma unroll
        for (int e = 0; e < NE; ++e) lg[e] = 0.f;
#pragma unroll
        for (int j = 0; j < 8; ++j) {
            const int col = 4 * c.lane + 256 * j;
            const float4 gg = *(const float4*)(g + col), s4 = *(const float4*)(sh + col), c4 = *(const float4*)(sc + col);
            const float y[4] = {v[j].x * inv * gg.x * (1.f + c4.x) + s4.x, v[j].y * inv * gg.y * (1.f + c4.y) + s4.y,
                                v[j].z * inv * gg.z * (1.f + c4.z) + s4.z, v[j].w * inv * gg.w * (1.f + c4.w) + s4.w};
            uint2 w; w.x = pk2(y[0], y[1]); w.y = pk2(y[2], y[3]);
            *(uint2*)(o + col) = w;
#pragma unroll
            for (int q = 0; q < 4; ++q) {
                const float4* wp = (const float4*)(wr + (size_t)(col + q) * NE);
#pragma unroll
                for (int e4 = 0; e4 < 4; ++e4) { const float4 w4 = wp[e4]; lg[e4 * 4 + 0] = fmaf(y[q], w4.x, lg[e4 * 4 + 0]); lg[e4 * 4 + 1] = fmaf(y[q], w4.y, lg[e4 * 4 + 1]); lg[e4 * 4 + 2] = fmaf(y[q], w4.z, lg[e4 * 4 + 2]); lg[e4 * 4 + 3] = fmaf(y[q], w4.w, lg[e4 * 4 + 3]); }
            }
        }
        float mx = -3e38f;
#pragma unroll
        for (int e = 0; e < NE; ++e) { lg[e] = wave_sum(lg[e]); mx = fmaxf(mx, lg[e]); }
        float sum = 0.f;
#pragma unroll
        for (int e = 0; e < NE; ++e) { lg[e] = expf(lg[e] - mx); sum += lg[e]; }
        float mine = 0.f;
#pragma unroll
        for (int e = 0; e < NE; ++e) mine = (c.lane == e) ? lg[e] / sum : mine;
        if (c.lane < NE) c.wsp<float>(WS_AFF)[(size_t)r * NE + c.lane] = mine;
    }
}

__device__ __forceinline__ void topk_unit(const Ctx& c, int e, int row0, int n, int K, int slot0) {
    unsigned* keys = (unsigned*)c.smem;
    unsigned* hist = keys + L;
    unsigned* sh = hist + 256;
    const int tid = c.tid, lane = c.lane, wave = c.wave;
    const float* aff = c.wsp<float>(WS_AFF);
    __syncthreads();
#pragma unroll 4
    for (int t = tid; t < n; t += NTHREADS) keys[t] = __float_as_uint(aff[(size_t)(row0 + t) * NE + e]);
    unsigned prefix = 0u, mask = 0u, need = (unsigned)K;
#pragma unroll 1
    for (int pass = 0; pass < 4; ++pass) {
        const int shift = 24 - 8 * pass;
        __syncthreads();
        if (tid < 256) hist[tid] = 0u;
        __syncthreads();
#pragma unroll 4
        for (int t = tid; t < n; t += NTHREADS) { const unsigned k = keys[t]; if ((k & mask) == prefix) atomicAdd(&hist[(k >> shift) & 255u], 1u); }
        __syncthreads();
        if (tid == 0) {
            unsigned cum = 0u; int b = 255;
            for (; b > 0; --b) { if (cum + hist[b] >= need) break; cum += hist[b]; }
            sh[0] = prefix | ((unsigned)b << shift); sh[1] = need - cum;
        }
        __syncthreads();
        prefix = sh[0]; need = sh[1]; mask |= 255u << shift;
    }
    const unsigned T = prefix; const unsigned cnt_gt = (unsigned)K - need;
    int* IDX = c.wsp<int>(WS_IDX) + (size_t)e * SLOTS; float* GS = c.wsp<float>(WS_GSEL) + (size_t)e * SLOTS; int* SL = c.wsp<int>(WS_SLOT) + (size_t)e * MR;
    unsigned base_gt = 0u, base_eq = 0u;
    const int rounds = (n + NTHREADS - 1) / NTHREADS;
#pragma unroll 1
    for (int j = 0; j < rounds; ++j) {
        const int t = tid + NTHREADS * j;
        const bool valid = t < n; const unsigned kj = valid ? keys[t] : 0u;
        const bool gt = valid && kj > T, eq = valid && kj == T;
        const unsigned long long mg = __ballot(gt), me = __ballot(eq);
        const unsigned long long lower = (lane == 0) ? 0ull : (~0ull >> (64 - lane));
        const unsigned rg = (unsigned)__popcll(mg & lower), re = (unsigned)__popcll(me & lower);
        __syncthreads();
        if (lane == 0) { sh[8 + wave] = (unsigned)__popcll(mg); sh[16 + wave] = (unsigned)__popcll(me); }
        __syncthreads();
        unsigned og = 0u, oe = 0u, tg = 0u, te = 0u;
#pragma unroll
        for (int w = 0; w < 8; ++w) { const unsigned a = sh[8 + w], b2 = sh[16 + w]; if (w < wave) { og += a; oe += b2; } tg += a; te += b2; }
        int slot = -1;
        if (gt) slot = (int)(base_gt + og + rg);
        else if (eq) { const unsigned rk = base_eq + oe + re; if (rk < need) slot = (int)(cnt_gt + rk); }
        if (valid) { SL[row0 + t] = slot >= 0 ? slot0 + slot : -1; if (slot >= 0) { IDX[slot0 + slot] = row0 + t; GS[slot0 + slot] = __uint_as_float(kj); } }
        base_gt += tg; base_eq += te;
    }
}
__device__ __forceinline__ void ph_g(const Ctx& c) {
    for (int u = c.bid; u < 32; u += c.nb) {
        if (u < 16) topk_unit(c, u, 0, L, CAP, 0);
        else { const int e = u - 16; topk_unit(c, e, L, LC, CAPC, CAP);
            for (int s = CAP + CAPC + c.tid; s < SLOTS; s += NTHREADS) { c.wsp<int>(WS_IDX)[(size_t)e * SLOTS + s] = 0; c.wsp<float>(WS_GSEL)[(size_t)e * SLOTS + s] = 0.f; } }
    }
}

struct EpiGate { float* tmp; __device__ __forceinline__ void operator()(int row, int col, const float (&v)[8]) const {
    float* p = tmp + (size_t)row * DF + col; *(float4*)p = make_float4(v[0], v[1], v[2], v[3]); *(float4*)(p + 4) = make_float4(v[4], v[5], v[6], v[7]); } };
struct EpiUp { const float* tmp; bf16_t* act; __device__ __forceinline__ void operator()(int row, int col, const float (&v)[8]) const {
    const float* p = tmp + (size_t)row * DF + col; const float4 a0 = *(const float4*)p, a1 = *(const float4*)(p + 4);
    const float a[8] = {a0.x, a0.y, a0.z, a0.w, a1.x, a1.y, a1.z, a1.w}; float t[8];
#pragma unroll
    for (int j = 0; j < 8; ++j) t[j] = silu_f(a[j]) * v[j];
    uint4 o; o.x = pk2(t[0], t[1]); o.y = pk2(t[2], t[3]); o.z = pk2(t[4], t[5]); o.w = pk2(t[6], t[7]);
    *(uint4*)(act + (size_t)row * DF + col) = o; } };
struct EpiDown { bf16_t* ye; __device__ __forceinline__ void operator()(int row, int col, const float (&v)[8]) const {
    uint4 o; o.x = pk2(v[0], v[1]); o.y = pk2(v[2], v[3]); o.z = pk2(v[4], v[5]); o.w = pk2(v[6], v[7]);
    *(uint4*)(ye + (size_t)row * D + col) = o; } };
__device__ __forceinline__ void ph_h(const Ctx& c, int layer) {
    const int nM = SLOTS / 128, nN = DF / 128;
    for (int which = 0; which < 2; ++which)
        for (int u = c.bid; u < NE * nM * nN; u += c.nb) {
            const int e = u / (nM * nN), r = u % (nM * nN), pm = r % nM, pn = r / nM;
            const RowGather rp{c.wsp<bf16_t>(WS_H2), D, c.wsp<int>(WS_IDX) + (size_t)e * SLOTS};
            float* tmp = c.wsp<float>(WS_TMP) + (size_t)e * SLOTS * DF;
            const float* W = c.in[which == 0 ? 28 : 29] + ((size_t)layer * NE + e) * D * DF;
            if (which == 0) { const EpiGate ep{tmp}; sgemm_unit(rp, W, DF, D, pm * 128, pn * 128, ep, (float*)c.smem, c.tid); }
            else { const EpiUp ep{tmp, c.wsp<bf16_t>(WS_ACT) + (size_t)e * SLOTS * DF}; sgemm_unit(rp, W, DF, D, pm * 128, pn * 128, ep, (float*)c.smem, c.tid); }
        }
}
__device__ __forceinline__ void ph_i(const Ctx& c, int layer) {
    const int nM = SLOTS / 128, nN = D / 128;
    for (int u = c.bid; u < NE * nM * nN; u += c.nb) {
        const int e = u / (nM * nN), r = u % (nM * nN), pm = r % nM, pn = r / nM;
        const RowLin rp{c.wsp<bf16_t>(WS_ACT) + (size_t)e * SLOTS * DF, DF};
        const EpiDown ep{c.wsp<bf16_t>(WS_YE) + (size_t)e * SLOTS * D};
        const float* W = c.in[30] + ((size_t)layer * NE + e) * DF * D;
        sgemm_unit(rp, W, D, DF, pm * 128, pn * 128, ep, (float*)c.smem, c.tid);
    }
}

__device__ __forceinline__ void ph_j(const Ctx& c, int layer) {
    const int gw = c.bid * 8 + c.wave, ngw = c.nb * 8;
    const int nrows = layer == 0 ? MR : L;
    for (int r = gw; r < nrows; r += ngw) {
        const float* x1 = c.wsp<float>(WS_XA) + (size_t)r * D;
        const float* g5 = c.mod(layer, r < L ? 0 : 1, 5);
        float* o = layer == 0 ? c.wsp<float>(WS_XB) + (size_t)r * D : c.out + (size_t)r * D;
        float acc[32];
#pragma unroll
        for (int j = 0; j < 32; ++j) acc[j] = 0.f;
        for (int e = 0; e < NE; ++e) {
            const int s = c.wsp<int>(WS_SLOT)[(size_t)e * MR + r];
            if (s >= 0) {
                const float gs = c.wsp<float>(WS_GSEL)[(size_t)e * SLOTS + s];
                const bf16_t* y = c.wsp<bf16_t>(WS_YE) + ((size_t)e * SLOTS + s) * D;
#pragma unroll
                for (int j = 0; j < 8; ++j) { const uint2 w = *(const uint2*)(y + 4 * c.lane + 256 * j);
                    acc[4 * j + 0] = fmaf(gs, __uint_as_float(w.x << 16), acc[4 * j + 0]); acc[4 * j + 1] = fmaf(gs, __uint_as_float(w.x & 0xffff0000u), acc[4 * j + 1]);
                    acc[4 * j + 2] = fmaf(gs, __uint_as_float(w.y << 16), acc[4 * j + 2]); acc[4 * j + 3] = fmaf(gs, __uint_as_float(w.y & 0xffff0000u), acc[4 * j + 3]); }
            }
        }
#pragma unroll
        for (int j = 0; j < 8; ++j) { const int col = 4 * c.lane + 256 * j; const float4 xv = *(const float4*)(x1 + col), gv = *(const float4*)(g5 + col);
            *(float4*)(o + col) = make_float4(xv.x + gv.x * acc[4 * j], xv.y + gv.y * acc[4 * j + 1], xv.z + gv.z * acc[4 * j + 2], xv.w + gv.w * acc[4 * j + 3]); }
    }
}


#ifndef FAST_B
#define FAST_B 1
#endif
#ifndef FAST_DE
#define FAST_DE 1
#endif
#ifndef FAST_HI
#define FAST_HI 1
#endif
__device__ __forceinline__ void ph_b_fast(const Ctx& c, int layer) {
    LAS unsigned char* lds = (LAS unsigned char*)c.smem;
    const char* WIN = (const char*)(c.ws + WS_WIN); const char* HX = (const char*)(c.ws + WS_HX);
    __syncthreads();
    {
        const pg8::GeomLin G{WIN, HX, D, D, D, nullptr}; pg8::StaticOrder S; S.init(3072 / 256, MR / 256, c.nb, c.bid);
        const pg8::EpiBf16Plain E{c.wsp<bf16_t>(WS_ZHYT), MR, 0};
        pg8::gemm_phase(lds, G, S, E);
    }
    {
        const pg8::GeomLin G{HX, WIN + (size_t)OFF_WAQ * D * 2, D, D, D, nullptr}; pg8::StaticOrder S; S.init(MR / 256, (NIN - OFF_WAQ) / 256, c.nb, c.bid);
        const pg8::EpiInRest E{c.ws};
        pg8::gemm_phase(lds, G, S, E);
    }
}
__device__ __forceinline__ void ph_d_fast(const Ctx& c, int layer) {
    LAS unsigned char* lds = (LAS unsigned char*)c.smem;
    const int nM = layer == 0 ? MR / 256 : L / 256;
    pg8::StaticOrder S; S.init(nM, D / 256, c.nb, c.bid);
    __syncthreads();
    { const pg8::GeomLin G{(const char*)(c.ws + WS_YHY), (const char*)(c.ws + WS_WBR), 1024, 1024, 1024, nullptr}; const pg8::EpiMergeF<0> E{c.ws}; pg8::gemm_phase(lds, G, S, E); }
    { const pg8::GeomLin G{(const char*)(c.ws + WS_YWA), (const char*)(c.ws + WS_WBR) + (size_t)D * 1024 * 2, 1024, 1024, 1024, nullptr}; const pg8::EpiMergeF<1> E{c.ws}; pg8::gemm_phase(lds, G, S, E); }
    { const pg8::GeomLin G{(const char*)(c.ws + WS_YNA), (const char*)(c.ws + WS_WBR) + (size_t)2 * D * 1024 * 2, 1024, 1024, 1024, nullptr}; const pg8::EpiMergeF<2> E{c.ws}; pg8::gemm_phase(lds, G, S, E); }
}
__device__ __forceinline__ void ph_e_fast(const Ctx& c, int layer) {
    LAS unsigned char* lds = (LAS unsigned char*)c.smem;
    const int nM = layer == 0 ? MR / 256 : L / 256;
    pg8::StaticOrder S; S.init(nM, D / 256, c.nb, c.bid);
    __syncthreads();
    const pg8::GeomLin G{(const char*)(c.ws + WS_MB), (const char*)(c.ws + WS_WOUT), D, D, D, nullptr}; const pg8::EpiOutF E{&c, layer};
    pg8::gemm_phase(lds, G, S, E);
}
__device__ __forceinline__ void ph_h_fast(const Ctx& c, int layer) {
    LAS unsigned char* lds = (LAS unsigned char*)c.smem;
    const int tpe = layer == 0 ? 9 : 8;
    pg8::StaticOrder S; S.init(NE * tpe, 2048 / 256, c.nb, c.bid);
    __syncthreads();
    const pg8::GeomExpert<true> G{(const char*)(c.ws + WS_H2), (const char*)(c.ws + WS_WGU), D, D, D, c.wsp<int>(WS_IDX), tpe, 2048};
    const pg8::EpiGU E{c.wsp<bf16_t>(WS_ACT)};
    pg8::gemm_phase(lds, G, S, E);
}
__device__ __forceinline__ void ph_i_fast(const Ctx& c, int layer) {
    LAS unsigned char* lds = (LAS unsigned char*)c.smem;
    const int tpe = layer == 0 ? 9 : 8;
    pg8::StaticOrder S; S.init(NE * tpe, D / 256, c.nb, c.bid);
    __syncthreads();
    const pg8::GeomExpert<false> G{(const char*)(c.ws + WS_ACT), (const char*)(c.ws + WS_WDN), DF, DF, DF, nullptr, tpe, D};
    const pg8::EpiBf16Plain E{c.wsp<bf16_t>(WS_YE), D, 0};
    pg8::gemm_phase(lds, G, S, E);
}

__global__ void __launch_bounds__(NTHREADS, 2) mega(KArgs a) {
    extern __shared__ __attribute__((aligned(16))) unsigned char smem[];
    Ctx c; c.in = a.in; c.out = a.out; c.ws = a.ws; c.bid = blockIdx.x; c.nb = gridDim.x; c.tid = threadIdx.x; c.lane = c.tid & 63;
    c.wave = __builtin_amdgcn_readfirstlane(c.tid >> 6); c.smem = smem;
    volatile LAS unsigned* st = (volatile LAS unsigned*)(LAS unsigned char*)(smem + LDS_BYTES - 16);
    if (c.tid == 0) { st[0] = 0u; st[1] = 0u; st[2] = 0u; st[3] = 0u; }
    __syncthreads();
    const int lo = a.ph_lo, hi = a.ph_hi;
    XcdBarrier bar; bar.bar = (unsigned*)(a.ws + WS_CTL); bar.x = 0; bar.st = st;
    if (hi - lo > 1) bar = xcd_barrier_post((unsigned*)(a.ws + WS_CTL), st);
#ifndef ONLY_PH
#define ONLY_PH -1
#endif
#define PSEL(j) (ONLY_PH < 0 || ONLY_PH == (j))
#define IN(k) (lo <= (k) && (k) < hi)
#define LAUNDER(cc) Ctx cc = c; asm volatile("" : "+v"(cc.tid), "+v"(cc.lane)); asm volatile("" : "+s"(cc.bid), "+s"(cc.nb), "+s"(cc.wave), "+s"(cc.ws), "+s"(cc.out))
#define SEAM(k) do { if (IN(k) && IN((k) + 1)) xcd_barrier(bar); } while (0)
    if (PSEL(0) && IN(0)) { LAUNDER(cc); ph_g0(cc); } SEAM(0);
#define LAYER_PROGRAM(layer) do { const int b = 1 + (layer) * PH_PER_LAYER; \
        if (PSEL(1) && IN(b + 0)) { LAUNDER(cc); constexpr int ly = (layer); ph_a(cc, ly); if (FAST_B || FAST_DE || FAST_HI) ph_conv(cc, ly); } SEAM(b + 0); \
        if (PSEL(2) && IN(b + 1)) { LAUNDER(cc); constexpr int ly = (layer); if (FAST_B) ph_b_fast(cc, ly); else ph_b(cc, ly); } SEAM(b + 1); \
        if (PSEL(3) && IN(b + 2)) { LAUNDER(cc); constexpr int ly = (layer); ph_b2(cc, ly); } SEAM(b + 2); \
        if (PSEL(4) && IN(b + 3)) { LAUNDER(cc); constexpr int ly = (layer); ph_c(cc, ly); } SEAM(b + 3); \
        if (PSEL(5) && IN(b + 4)) { LAUNDER(cc); constexpr int ly = (layer); ph_c2(cc); } SEAM(b + 4); \
        if (PSEL(6) && IN(b + 5)) { LAUNDER(cc); constexpr int ly = (layer); if (FAST_DE) ph_d_fast(cc, ly); else ph_d(cc, ly); } SEAM(b + 5); \
        if (PSEL(7) && IN(b + 6)) { LAUNDER(cc); constexpr int ly = (layer); if (FAST_DE) ph_e_fast(cc, ly); else ph_e(cc, ly); } SEAM(b + 6); \
        if (PSEL(8) && IN(b + 7)) { LAUNDER(cc); constexpr int ly = (layer); ph_f(cc, ly); } SEAM(b + 7); \
        if (PSEL(9) && IN(b + 8)) { LAUNDER(cc); constexpr int ly = (layer); ph_g(cc); } SEAM(b + 8); \
        if (PSEL(10) && IN(b + 9)) { LAUNDER(cc); constexpr int ly = (layer); if (FAST_HI) ph_h_fast(cc, ly); else ph_h(cc, ly); } SEAM(b + 9); \
        if (PSEL(11) && IN(b + 10)) { LAUNDER(cc); constexpr int ly = (layer); if (FAST_HI) ph_i_fast(cc, ly); else ph_i(cc, ly); } SEAM(b + 10); \
        if (PSEL(12) && IN(b + 11)) { LAUNDER(cc); constexpr int ly = (layer); ph_j(cc, ly); } SEAM(b + 11); \
    } while (0)
    LAYER_PROGRAM(0);
    LAYER_PROGRAM(1);
#undef LAYER_PROGRAM
#undef IN
#undef SEAM
}

extern "C" void kernel_launch(void* const* d_in, const int* in_sizes, int n_in, void* d_out, int out_size, void* d_ws, size_t ws_size, hipStream_t stream) {
    static int grid = 0;
    if (grid == 0) {
        if (n_in != 31 || out_size != L * D || ws_size < WS_END) { fprintf(stderr, "kernel_launch: unexpected shapes: n_in %d out %d ws %zu (need %zu)\n", n_in, out_size, ws_size, (size_t)WS_END); grid = -1; return; }
        int dev = 0, cus = 0, per_cu = 0;
        if (hipGetDevice(&dev) != hipSuccess || hipDeviceGetAttribute(&cus, hipDeviceAttributeMultiprocessorCount, dev) != hipSuccess) { grid = -1; return; }
        if (hipFuncSetAttribute((const void*)mega, hipFuncAttributeMaxDynamicSharedMemorySize, LDS_BYTES) != hipSuccess) { fprintf(stderr, "kernel_launch: hipFuncSetAttribute failed\n"); grid = -1; return; }
        if (hipOccupancyMaxActiveBlocksPerMultiprocessor(&per_cu, (const void*)mega, NTHREADS, LDS_BYTES) != hipSuccess || per_cu < 1) fprintf(stderr, "kernel_launch: occupancy query says %d\n", per_cu);
        (void)hipGetLastError();
        grid = cus;
    }
    if (grid < 0) return;
    if (hipMemsetAsync((char*)d_ws + WS_CTL, 0, CTL_BYTES, stream) != hipSuccess) return;
    KArgs a{};
    for (int i = 0; i < 31; ++i) a.in[i] = (const float*)d_in[i];
    a.out = (float*)d_out; a.ws = (unsigned char*)d_ws;
#if ONE_LAUNCH
    a.ph_lo = 0; a.ph_hi = NPH;
    hipLaunchKernelGGL(mega, dim3(grid), dim3(NTHREADS), LDS_BYTES, stream, a);
#else
    for (int p = 0; p < NPH; ++p) { a.ph_lo = p; a.ph_hi = p + 1; hipLaunchKernelGGL(mega, dim3(grid), dim3(NTHREADS), LDS_BYTES, stream, a); }
#endif
    const hipError_t le = hipPeekAtLastError();
    if (le != hipSuccess) fprintf(stderr, "kernel_launch: launch failed: %s\n", hipGetErrorName(le));
}
```

```cpp
#include <hip/hip_runtime.h>
#include <stdint.h>
#include <stdio.h>

#ifndef ONE_LAUNCH
#define ONE_LAUNCH 1
#endif

typedef unsigned short bf16_t;
#define LAS __attribute__((address_space(3)))

constexpr int L = 16384, LC = 256, MR = L + LC, D = 2048, NIN = 13824;
constexpr int HD = 128, GRIDW = 64;
constexpr int OFF_HY = 0, OFF_WAQ = 3072, OFF_WAKV = 4096, OFF_NAQ = 4608, OFF_NAKV = 5632, OFF_GATE = 7680;
constexpr int NE = 16, CAP = 2048, CAPC = 32, SLOTS = 2304, DF = 1024;
constexpr int NMOD = 6 * D;
constexpr float RMS_EPS = 1e-6f;
constexpr float QK_SCALE = 0.08838834764831845f;

constexpr size_t al256(size_t x) { return (x + 255) & ~(size_t)255; }
constexpr size_t WS_CTL = 0, CTL_BYTES = 1u << 20;
constexpr size_t WS_MOD = WS_CTL + CTL_BYTES;
constexpr size_t WS_H2F = WS_MOD + al256((size_t)2 * 2 * NMOD * 4);
constexpr size_t WS_AFF = WS_H2F + al256((size_t)2 * MR * 64 * 4);
constexpr size_t WS_IDX = WS_AFF + al256((size_t)MR * 16 * 4);
constexpr size_t WS_GSEL = WS_IDX + al256((size_t)NE * SLOTS * 4);
constexpr size_t WS_SLOT = WS_GSEL + al256((size_t)NE * SLOTS * 4);
constexpr size_t WS_KFC = WS_SLOT + al256((size_t)NE * MR * 4);
constexpr size_t WS_ZHYC = WS_KFC + al256((size_t)4096 * LC * 2);
constexpr size_t WS_XA = WS_ZHYC + al256((size_t)3072 * LC * 2);
constexpr size_t WS_XB = WS_XA + al256((size_t)MR * D * 4);
constexpr size_t WS_W = WS_XB + al256((size_t)MR * D * 4);
constexpr size_t W_BYTES = (size_t)2 * ((size_t)NIN * D + 3 * (size_t)D * 1024 + (size_t)D * D + (size_t)NE * 2048 * D + (size_t)NE * D * DF);
constexpr size_t WS_WIN = WS_W;
constexpr size_t WS_WBR = WS_WIN + (size_t)NIN * D * 2;
constexpr size_t WS_WOUT = WS_WBR + (size_t)3 * D * 1024 * 2;
constexpr size_t WS_WGU = WS_WOUT + (size_t)D * D * 2;
constexpr size_t WS_WDN = WS_WGU + (size_t)NE * 2048 * D * 2;
constexpr size_t WS_R3 = WS_W + al256(W_BYTES);
constexpr size_t R3_BYTES = (size_t)MR * D * 4 + (size_t)MR * D * 2;
constexpr size_t WS_KF = WS_R3;
constexpr size_t WS_KS = WS_R3 + al256((size_t)4096 * L * 2);
constexpr size_t WS_MPART = WS_R3;
constexpr size_t WS_MB = WS_R3 + (size_t)MR * D * 4;
constexpr size_t WS_TMP = WS_R3;
constexpr size_t WS_YE = WS_R3;
constexpr size_t WS_R4 = WS_R3 + al256(R3_BYTES);
constexpr size_t R4_BYTES = (size_t)MR * 6144 * 2;
constexpr size_t WS_GATE = WS_R4;
constexpr size_t WS_H2 = WS_R4;
constexpr size_t WS_ACT = WS_R4 + al256((size_t)MR * D * 2);
constexpr size_t WS_R5 = WS_R4 + al256(R4_BYTES);
constexpr size_t WS_HX = WS_R5;
constexpr size_t WS_YHYT = WS_R5;
constexpr size_t WS_YHY = WS_R5 + al256((size_t)1024 * L * 2);
constexpr size_t WS_ZHYT = WS_R5 + al256((size_t)MR * D * 2);
constexpr size_t WS_QWA = WS_ZHYT + al256((size_t)3072 * MR * 2);
constexpr size_t WS_KVWA = WS_QWA + al256((size_t)MR * 1024 * 2);
constexpr size_t WS_QNA = WS_KVWA + al256((size_t)MR * 512 * 2);
constexpr size_t WS_KVNA = WS_QNA + al256((size_t)MR * 1024 * 2);
constexpr size_t WS_YWA = WS_KVNA + al256((size_t)MR * 2048 * 2);
constexpr size_t WS_YNA = WS_YWA + al256((size_t)MR * 1024 * 2);
constexpr size_t WS_END = WS_YNA + al256((size_t)MR * 1024 * 2);
static_assert((size_t)1024 * L * 2 + (size_t)MR * 1024 * 2 <= (size_t)MR * D * 2 + 512, "YHYT+YHY overlay HX");
static_assert((size_t)4096 * L * 2 + 256 + (size_t)256 * 2 * 16384 * 8 <= R3_BYTES && (size_t)NE * SLOTS * D * 2 <= R3_BYTES && (size_t)NE * SLOTS * DF * 4 <= R3_BYTES, "R3");
static_assert((size_t)MR * D * 2 + 256 + (size_t)NE * SLOTS * DF * 2 <= R4_BYTES, "R4");

constexpr int LDS_BYTES = 160 * 1024;
constexpr int NTHREADS = 512;
constexpr int PH_PER_LAYER = 12, NPH = 1 + 2 * PH_PER_LAYER;

__device__ __forceinline__ float bf2f(bf16_t b) { return __uint_as_float(((unsigned)b) << 16); }
__device__ __forceinline__ bf16_t f2bf(float f) { unsigned u = __float_as_uint(f); u += 0x7fffu + ((u >> 16) & 1u); return (bf16_t)(u >> 16); }
__device__ __forceinline__ unsigned pk2(float lo, float hi) { return (unsigned)f2bf(lo) | ((unsigned)f2bf(hi) << 16); }
__device__ __forceinline__ float wave_sum(float v) {
#pragma unroll
    for (int o = 1; o < 64; o <<= 1) v += __shfl_xor(v, o);
    return v;
}
__device__ __forceinline__ float wave_max(float v) {
#pragma unroll
    for (int o = 1; o < 64; o <<= 1) v = fmaxf(v, __shfl_xor(v, o));
    return v;
}
__device__ __forceinline__ float silu_f(float x) { return x / (1.f + __expf(-x)); }
__device__ __forceinline__ float sigmoid_f(float x) { return 1.f / (1.f + __expf(-x)); }
#define LDS_FENCE() asm volatile("s_waitcnt lgkmcnt(0)" ::: "memory")

#define XB_TMO      128
#define XB_XCNT(j)  (256  + 64 * (j))
#define XB_XSUB(j)  (1280 + 64 * (j))
#define XB_XGEN(j)  (2304 + 64 * (j))
#define XB_TOP      3328
#define XB_TOPGEN   3392
#define XCD_BAR_WORDS 3456
#define XB_SPIN_CAP (1u << 22)

__device__ __forceinline__ unsigned xb_ld(unsigned* p)              { return __hip_atomic_load(p, __ATOMIC_RELAXED, __HIP_MEMORY_SCOPE_AGENT); }
__device__ __forceinline__ unsigned xb_add(unsigned* p, unsigned v) { return __hip_atomic_fetch_add(p, v, __ATOMIC_RELAXED, __HIP_MEMORY_SCOPE_AGENT); }
__device__ __forceinline__ unsigned xb_xcc_id() { return (unsigned)__builtin_amdgcn_s_getreg((3 << 11) | 20) & 0xFu; }
#define XB_SPIN(cond, bar) do { unsigned _sp = 0; while (cond) { __builtin_amdgcn_s_sleep(1); \
    if ((++_sp & 255u) == 0u) { if (xb_ld(&(bar)[XB_TMO])) break; if (_sp > XB_SPIN_CAP) { atomicAdd(&(bar)[XB_TMO], 1u); break; } } } } while (0)

struct XcdBarrier { unsigned* bar; unsigned x; volatile LAS unsigned* st; };

__device__ __forceinline__ XcdBarrier xcd_barrier_post(unsigned* bar, volatile LAS unsigned* st) {
    XcdBarrier b; b.bar = bar; b.x = xb_xcc_id(); b.st = st;
    if (threadIdx.x == 0) (void)xb_add(&bar[XB_XCNT(b.x)], 1u);
    return b;
}
__device__ __forceinline__ void xcd_barrier_complete(unsigned* bar, unsigned x, unsigned& nloc, unsigned& nx) {
    const unsigned G = gridDim.x * gridDim.y * gridDim.z;
    unsigned sum, cnt, mine, sp = 0u;
    for (;;) {
        sum = 0u; cnt = 0u; mine = 0u;
#pragma unroll
        for (unsigned j = 0; j < 16; ++j) { const unsigned c = xb_ld(&bar[XB_XCNT(j)]); sum += c; cnt += (c > 0u) ? 1u : 0u; mine = (j == x) ? c : mine; }
        if (sum == G) break;
        __builtin_amdgcn_s_sleep(1);
        if ((++sp & 255u) == 0u) { if (xb_ld(&bar[XB_TMO])) break; if (sp > XB_SPIN_CAP) { atomicAdd(&bar[XB_TMO], 1u); break; } }
    }
    nloc = mine > 0u ? mine : 1u; nx = cnt > 0u ? cnt : 1u;
}
__device__ __forceinline__ void xcd_barrier(const XcdBarrier& b) {
    asm volatile("s_waitcnt vmcnt(0)" ::: "memory");
    __syncthreads();
    if (threadIdx.x == 0) {
        unsigned* bar = b.bar;
        __builtin_amdgcn_s_waitcnt(0);
        unsigned nloc = b.st[0], nx = b.st[1];
        if (nloc == 0u) { xcd_barrier_complete(bar, b.x, nloc, nx); b.st[0] = nloc; b.st[1] = nx; }
        const unsigned old = xb_add(&bar[XB_XSUB(b.x)], 1u);
        const unsigned gen = old / nloc;
        if (old + 1u == (gen + 1u) * nloc) {
            __builtin_amdgcn_fence(__ATOMIC_RELEASE, "agent");
            asm volatile("s_waitcnt vmcnt(0)" ::: "memory");
            const unsigned og = xb_add(&bar[XB_TOP], 1u);
            const unsigned tg = og / nx;
            if (og + 1u == (tg + 1u) * nx) xb_add(&bar[XB_TOPGEN], 1u);
            else XB_SPIN(xb_ld(&bar[XB_TOPGEN]) == tg, bar);
            __builtin_amdgcn_fence(__ATOMIC_ACQUIRE, "agent");
            xb_add(&bar[XB_XGEN(b.x)], 1u);
            asm volatile("s_waitcnt vmcnt(0)" ::: "memory");
        } else {
            XB_SPIN(xb_ld(&bar[XB_XGEN(b.x)]) == gen, bar);
            __builtin_amdgcn_fence(__ATOMIC_ACQUIRE, "agent");
            asm volatile("s_waitcnt vmcnt(0)" ::: "memory");
        }
    }
    __syncthreads();
}

struct KArgs { const float* in[31]; float* out; unsigned char* ws; int ph_lo, ph_hi; };

struct Ctx {
    const float* const* in; float* out; unsigned char* ws;
    int bid, nb, tid, lane, wave;
    unsigned char* smem;
    template <class T> __device__ __forceinline__ T* wsp(size_t off) const { return (T*)(ws + off); }
    __device__ __forceinline__ const float* mod(int layer, int src, int chunk) const { return wsp<float>(WS_MOD) + ((size_t)(layer * 2 + src) * NMOD) + chunk * D; }
    __device__ __forceinline__ const float* xrow(int layer, int r) const {
        if (layer == 0) return r < L ? in[0] + (size_t)r * D : in[2] + (size_t)(r - L) * D;
        return wsp<float>(WS_XB) + (size_t)r * D;
    }
};

template <class RowPtr, class Epi>
__device__ __forceinline__ void sgemm_unit(const RowPtr& rp, const float* __restrict__ W, int ldw, int K, int m0, int n0, const Epi& ep, float* lds, int tid) {
    float* As = lds;
    float* Bs = lds + 16 * 132;
    const int ty = tid >> 4, tx = tid & 15;
    const int am = tid >> 2, kq = (tid & 3) * 4;
    const int bk = tid >> 5, n4 = (tid & 31) * 4;
    float acc[4][8];
#pragma unroll
    for (int i = 0; i < 4; ++i)
#pragma unroll
        for (int j = 0; j < 8; ++j) acc[i][j] = 0.f;
    const bf16_t* arow = rp(m0 + am);
    const float* wp = W + (size_t)bk * ldw + n0 + n4;
    for (int k0 = 0; k0 < K; k0 += 16) {
        const uint2 a4 = *(const uint2*)(arow + k0 + kq);
        const float4 b4 = *(const float4*)(wp + (size_t)k0 * ldw);
        __syncthreads();
        As[(kq + 0) * 132 + am] = __uint_as_float(a4.x << 16);
        As[(kq + 1) * 132 + am] = __uint_as_float(a4.x & 0xffff0000u);
        As[(kq + 2) * 132 + am] = __uint_as_float(a4.y << 16);
        As[(kq + 3) * 132 + am] = __uint_as_float(a4.y & 0xffff0000u);
        *(float4*)&Bs[bk * 128 + n4] = b4;
        __syncthreads();
#pragma unroll
        for (int kk = 0; kk < 16; ++kk) {
            const float4 a = *(const float4*)&As[kk * 132 + ty * 4];
            const float4 b0 = *(const float4*)&Bs[kk * 128 + tx * 8];
            const float4 b1 = *(const float4*)&Bs[kk * 128 + tx * 8 + 4];
            const float av[4] = {a.x, a.y, a.z, a.w};
            const float bv[8] = {b0.x, b0.y, b0.z, b0.w, b1.x, b1.y, b1.z, b1.w};
#pragma unroll
            for (int i = 0; i < 4; ++i)
#pragma unroll
                for (int j = 0; j < 8; ++j) acc[i][j] = fmaf(av[i], bv[j], acc[i][j]);
        }
    }
#pragma unroll
    for (int i = 0; i < 4; ++i) ep(m0 + ty * 4 + i, n0 + tx * 8, acc[i]);
}

struct RowLin { const bf16_t* base; int ld; __device__ __forceinline__ const bf16_t* operator()(int m) const { return base + (size_t)m * ld; } };
struct RowGather { const bf16_t* base; int ld; const int* idx; __device__ __forceinline__ const bf16_t* operator()(int m) const { return base + (size_t)idx[m] * ld; } };


namespace pg8 {
typedef short bf16x8 __attribute__((ext_vector_type(8)));
typedef float f32x4 __attribute__((ext_vector_type(4)));
typedef unsigned u32x4 __attribute__((ext_vector_type(4)));
typedef unsigned u32x2 __attribute__((ext_vector_type(2)));
constexpr int BM = 256, BK = 64, HALF = 128, HTB = HALF * BK * 2, STAGE_BYTES = 8 * HTB, NXCD = 8, WGM = 8;
__host__ __device__ __forceinline__ int lds_byte(int r, int c) { const int st = (r >> 4) * 2 + (c >> 5), rr = r & 15, cc = c & 31, ob = rr * 64 + cc * 2; return st * 1024 + (ob ^ (((ob >> 9) & 1) << 5)); }
__host__ __device__ __forceinline__ void stage_rc(int b, int& R, int& C) { const int st = b / 1024, sb = b % 1024, swz = sb ^ (((sb >> 9) & 1) << 5); R = (st >> 1) * 16 + swz / 64; C = (st & 1) * 32 + (swz % 64) / 2; }
__host__ __device__ __forceinline__ int perm32(int rho) { const int n = rho >> 4, i = rho & 15; return 8 * (i >> 2) + 4 * n + (i & 3); }
struct Unit { int pm, pn; };
struct StaticOrder {
    int nM, nN, nwg, G, c;
    __host__ __device__ void init(int nM_, int nN_, int G_, int c_) { nM = nM_; nN = nN_; nwg = nM * nN; G = G_; c = c_; }
    __host__ __device__ bool next(int i, Unit& u) const {
        const long Lq = (long)i * G + c; if (Lq >= nwg) return false;
        int wgid = (int)Lq; { const int q = nwg / NXCD, r = nwg % NXCD, xcd = wgid % NXCD, off = wgid / NXCD; wgid = (xcd < r ? xcd * (q + 1) : r * (q + 1) + (xcd - r) * q) + off; }
        const int nig = WGM * nN, gid = wgid / nig, fm = gid * WGM, gsz = (nM - fm) < WGM ? (nM - fm) : WGM;
        u.pm = fm + ((wgid % nig) % gsz); u.pn = (wgid % nig) / gsz; return true;
    }
};
__device__ __forceinline__ unsigned cvt_pk_bf16(float lo, float hi) { unsigned r; asm volatile("v_cvt_pk_bf16_f32 %0, %1, %2" : "=v"(r) : "v"(lo), "v"(hi)); return r; }

struct GeomLin {
    static constexpr bool GATHER = false;
    const char* A; const char* B; int K, lda, ldb; const int* idx;
    __device__ __forceinline__ const char* a_base(const Unit& u) const { return A + (size_t)u.pm * 256 * lda * 2; }
    __device__ __forceinline__ const char* b_base(const Unit& u) const { return B + (size_t)u.pn * 256 * ldb * 2; }
    __device__ __forceinline__ int row0(const Unit& u) const { return u.pm * 256; }
};
template <bool GATHER_> struct GeomExpert {
    static constexpr bool GATHER = GATHER_;
    const char* A; const char* B; int K, lda, ldb; const int* idx; int tpe, nb;
    __device__ __forceinline__ int row0(const Unit& u) const { const int e = u.pm / tpe, t = u.pm - e * tpe; return e * SLOTS + t * 256; }
    __device__ __forceinline__ const char* a_base(const Unit& u) const { return GATHER_ ? A : A + (size_t)row0(u) * lda * 2; }
    __device__ __forceinline__ const char* b_base(const Unit& u) const { const int e = u.pm / tpe; return B + ((size_t)e * nb + (size_t)u.pn * 256) * ldb * 2; }
};

template <class Epi, class Geom, class Sched>
__device__ __forceinline__ void gemm_phase(LAS unsigned char* lds, const Geom& G, const Sched& S, const Epi& E) {
    const int tid = threadIdx.x, wid = __builtin_amdgcn_readfirstlane(tid >> 6), lane = tid & 63, wr = wid >> 2, wc = wid & 3, fr = lane & 15, fq = lane >> 4;
    const int K = G.K, nt = K / BK;
    int Rs[2], Cs[2]; unsigned vB0[2], vA0[2], vAc[2][2], vAn[2][2];
#pragma unroll
    for (int i = 0; i < 2; ++i) { int R, C; stage_rc(tid * 16 + i * 8192, R, C); Rs[i] = R; Cs[i] = C; const int Rb = Epi::PERM ? ((R & ~31) + perm32(R & 31)) : R;
        vB0[i] = (unsigned)(Rb * G.ldb + C) * 2u; vA0[i] = (unsigned)(R * G.lda + C) * 2u;
#pragma unroll
        for (int h = 0; h < 2; ++h) { vAc[h][i] = 0u; vAn[h][i] = 0u; } }
    const size_t hstepA = (size_t)HALF * G.lda * 2, hstepB = (size_t)HALF * G.ldb * 2;
#define PG8_VOFF(dst, u) do { if constexpr (Geom::GATHER) { const int _r0 = G.row0(u); _Pragma("unroll") for (int _h = 0; _h < 2; ++_h) _Pragma("unroll") for (int _i = 0; _i < 2; ++_i) \
        dst[_h][_i] = ((unsigned)G.idx[_r0 + _h * HALF + Rs[_i]] * (unsigned)G.lda + (unsigned)Cs[_i]) * 2u; } } while (0)
    const size_t kstep = (size_t)(BK * 2);
    const unsigned ldsw = (unsigned)wid * 1024u;
    const int aoff = lds_byte(wr * 64 + fr, fq * 8), boff = lds_byte(wc * 32 + fr, fq * 8);
#define PG8_SA(b, h) (((b) * 2 + (h)) * HTB)
#define PG8_SB(b, h) ((4 + (b) * 2 + (h)) * HTB)
#define PG8_STAGE(bufoff, gbase, v) do { \
        __builtin_amdgcn_global_load_lds((const unsigned*)((const char*)(gbase) + (v)[0]), (LAS unsigned*)(lds + (bufoff) + ldsw), 16, 0, 0); \
        __builtin_amdgcn_global_load_lds((const unsigned*)((const char*)(gbase) + (v)[1]), (LAS unsigned*)(lds + (bufoff) + ldsw + 8192), 16, 0, 0); } while (0)
#define PG8_STA(bufoff, gbase, h, VX) do { if constexpr (Geom::GATHER) { PG8_STAGE(bufoff, gbase, VX[h]); } else { PG8_STAGE(bufoff, (gbase) + (h) * hstepA, vA0); } } while (0)
#define PG8_STB(bufoff, gbase, h) PG8_STAGE(bufoff, (gbase) + (h) * hstepB, vB0)
#define PG8_LDA(dst, b, h) do { _Pragma("unroll") for (int m = 0; m < 4; ++m) _Pragma("unroll") for (int k = 0; k < 2; ++k) dst[m][k] = *(const LAS bf16x8*)(lds + PG8_SA(b, h) + aoff + m * 2048 + k * 1024); } while (0)
#define PG8_LDB(dst, b, h) do { _Pragma("unroll") for (int n = 0; n < 2; ++n) _Pragma("unroll") for (int k = 0; k < 2; ++k) dst[n][k] = *(const LAS bf16x8*)(lds + PG8_SB(b, h) + boff + n * 2048 + k * 1024); } while (0)
#define PG8_MMA(ai, bj, At, Bt) do { __builtin_amdgcn_s_setprio(1); _Pragma("unroll") for (int m = 0; m < 4; ++m) _Pragma("unroll") for (int n = 0; n < 2; ++n) _Pragma("unroll") for (int k = 0; k < 2; ++k) \
        acc[ai][bj][m][n] = __builtin_amdgcn_mfma_f32_16x16x32_bf16(Bt[n][k], At[m][k], acc[ai][bj][m][n], 0, 0, 0); __builtin_amdgcn_s_setprio(0); } while (0)
#define PG8_WAIT_V(n) asm volatile("s_waitcnt vmcnt(" #n ")" ::: "memory")
#define PG8_WAIT_L(n) asm volatile("s_waitcnt lgkmcnt(" #n ")" ::: "memory")
#define PG8_BAR __builtin_amdgcn_s_barrier()
#define PG8_SCHED __builtin_amdgcn_sched_barrier(0)
    Unit cur, nxt; int ui = 0;
    if (!S.next(0, cur)) return;
    f32x4 acc[2][2][4][2];
#pragma unroll
    for (int a = 0; a < 2; ++a)
#pragma unroll
        for (int b = 0; b < 2; ++b)
#pragma unroll
            for (int m = 0; m < 4; ++m)
#pragma unroll
                for (int n = 0; n < 2; ++n) acc[a][b][m][n] = (f32x4){0.f, 0.f, 0.f, 0.f};
    bf16x8 At[4][2], B0[2][2], B1[2][2];
    const char* cA = G.a_base(cur); const char* cB = G.b_base(cur);
    PG8_VOFF(vAc, cur);
    PG8_STB(PG8_SB(0, 0), cB, 0); PG8_STA(PG8_SA(0, 0), cA, 0, vAc); PG8_STB(PG8_SB(0, 1), cB, 1); PG8_STA(PG8_SA(0, 1), cA, 1, vAc);
    if (wr == 1) PG8_BAR;
    PG8_WAIT_V(4); PG8_BAR;
    PG8_STB(PG8_SB(1, 0), cB + kstep, 0); PG8_STA(PG8_SA(1, 0), cA + kstep, 0, vAc); PG8_STB(PG8_SB(1, 1), cB + kstep, 1);
    PG8_WAIT_V(6); PG8_BAR;
    for (;;) {
        const bool has_next = S.next(ui + 1, nxt);
        const char* nA = has_next ? G.a_base(nxt) : cA; const char* nB = has_next ? G.b_base(nxt) : cB;
        if constexpr (Geom::GATHER) { if (has_next) PG8_VOFF(vAn, nxt); else {
#pragma unroll
            for (int h = 0; h < 2; ++h) { vAn[h][0] = vAc[h][0]; vAn[h][1] = vAc[h][1]; } } }
        for (int t = 0; t < nt; t += 2) {
            const bool last = (t == nt - 2);
            const char* a1 = cA + (size_t)(t + 1) * kstep;
            const char* a2 = last ? nA : cA + (size_t)(t + 2) * kstep; const char* b2 = last ? nB : cB + (size_t)(t + 2) * kstep;
            const char* a3 = a2 + kstep; const char* b3 = b2 + kstep;
            unsigned v2[2][2];
#pragma unroll
            for (int h = 0; h < 2; ++h) { v2[h][0] = (Geom::GATHER && last) ? vAn[h][0] : vAc[h][0]; v2[h][1] = (Geom::GATHER && last) ? vAn[h][1] : vAc[h][1]; }
            PG8_LDB(B0, 0, 0); PG8_SCHED; PG8_LDA(At, 0, 0); PG8_STA(PG8_SA(1, 1), a1, 1, vAc);
            PG8_WAIT_L(8); PG8_BAR; PG8_WAIT_L(0); PG8_MMA(0, 0, At, B0); PG8_BAR; PG8_SCHED;
            PG8_LDB(B1, 0, 1); PG8_STB(PG8_SB(0, 0), b2, 0);
            PG8_BAR; PG8_WAIT_L(0); PG8_MMA(0, 1, At, B1); PG8_BAR;
            PG8_LDA(At, 0, 1); PG8_STA(PG8_SA(0, 0), a2, 0, v2);
            PG8_BAR; PG8_WAIT_L(0); PG8_MMA(1, 0, At, B0); PG8_BAR; PG8_SCHED;
            PG8_STB(PG8_SB(0, 1), b2, 1);
            PG8_WAIT_V(6); PG8_BAR; PG8_MMA(1, 1, At, B1); PG8_BAR;
            PG8_LDB(B0, 1, 0); PG8_SCHED; PG8_LDA(At, 1, 0); PG8_STA(PG8_SA(0, 1), a2, 1, v2);
            PG8_WAIT_L(8); PG8_BAR; PG8_WAIT_L(0); PG8_MMA(0, 0, At, B0); PG8_BAR; PG8_SCHED;
            PG8_LDB(B1, 1, 1); PG8_STB(PG8_SB(1, 0), b3, 0);
            PG8_BAR; PG8_WAIT_L(0); PG8_MMA(0, 1, At, B1); PG8_BAR;
            PG8_LDA(At, 1, 1); PG8_STA(PG8_SA(1, 0), a3, 0, v2);
            PG8_BAR; PG8_WAIT_L(0); PG8_MMA(1, 0, At, B0); PG8_BAR; PG8_SCHED;
            PG8_STB(PG8_SB(1, 1), b3, 1);
            PG8_WAIT_V(6); PG8_BAR; PG8_MMA(1, 1, At, B1); PG8_BAR;
        }
        E(acc, cur, G.row0(cur), wr, wc, fr, fq);
        if (!has_next) break;
#pragma unroll
        for (int a = 0; a < 2; ++a)
#pragma unroll
            for (int b = 0; b < 2; ++b)
#pragma unroll
                for (int m = 0; m < 4; ++m)
#pragma unroll
                    for (int n = 0; n < 2; ++n) acc[a][b][m][n] = (f32x4){0.f, 0.f, 0.f, 0.f};
        cur = nxt; cA = nA; cB = nB; ++ui;
#pragma unroll
        for (int h = 0; h < 2; ++h) { vAc[h][0] = vAn[h][0]; vAc[h][1] = vAn[h][1]; }
    }
    PG8_WAIT_V(0);
    if (wr == 0) PG8_BAR;
    PG8_BAR;
#undef PG8_VOFF
#undef PG8_SA
#undef PG8_SB
#undef PG8_STAGE
#undef PG8_STA
#undef PG8_STB
#undef PG8_LDA
#undef PG8_LDB
#undef PG8_MMA
#undef PG8_WAIT_V
#undef PG8_WAIT_L
#undef PG8_BAR
#undef PG8_SCHED
}

struct EpiBf16Plain {
    static constexpr bool PERM = true;
    bf16_t* O; int ldc; int coloff;
    __device__ __forceinline__ void operator()(const f32x4 (&acc)[2][2][4][2], const Unit& u, int row0, int wr, int wc, int fr, int fq) const {
        const int r0 = row0 + wr * 64 + fr, col0 = coloff + u.pn * BM + wc * 32 + 8 * fq;
#pragma unroll
        for (int ai = 0; ai < 2; ++ai)
#pragma unroll
            for (int m = 0; m < 4; ++m) { bf16_t* rowp = O + (size_t)(r0 + ai * HALF + m * 16) * ldc + col0;
#pragma unroll
                for (int bj = 0; bj < 2; ++bj) { const f32x4 v0 = acc[ai][bj][m][0], v1 = acc[ai][bj][m][1];
                    u32x4 w; w.x = cvt_pk_bf16(v0[0], v0[1]); w.y = cvt_pk_bf16(v0[2], v0[3]); w.z = cvt_pk_bf16(v1[0], v1[1]); w.w = cvt_pk_bf16(v1[2], v1[3]);
                    *(u32x4*)(rowp + bj * HALF) = w; } }
    }
};
struct EpiInRest {
    static constexpr bool PERM = true;
    unsigned char* ws;
    __device__ __forceinline__ void operator()(const f32x4 (&acc)[2][2][4][2], const Unit& u, int row0, int wr, int wc, int fr, int fq) const {
        const int gcol = OFF_WAQ + u.pn * BM;
        bf16_t* base; int ldc, c0; bool sg = false;
        if (gcol < OFF_WAKV) { base = (bf16_t*)(ws + WS_QWA); ldc = 1024; c0 = gcol - OFF_WAQ; }
        else if (gcol < OFF_NAQ) { base = (bf16_t*)(ws + WS_KVWA); ldc = 512; c0 = gcol - OFF_WAKV; }
        else if (gcol < OFF_NAKV) { base = (bf16_t*)(ws + WS_QNA); ldc = 1024; c0 = gcol - OFF_NAQ; }
        else if (gcol < OFF_GATE) { base = (bf16_t*)(ws + WS_KVNA); ldc = 2048; c0 = gcol - OFF_NAKV; }
        else { base = (bf16_t*)(ws + WS_GATE); ldc = 6144; c0 = gcol - OFF_GATE; sg = true; }
        const int r0 = row0 + wr * 64 + fr, col0 = c0 + wc * 32 + 8 * fq;
#pragma unroll
        for (int ai = 0; ai < 2; ++ai)
#pragma unroll
            for (int m = 0; m < 4; ++m) { bf16_t* rowp = base + (size_t)(r0 + ai * HALF + m * 16) * ldc + col0;
#pragma unroll
                for (int bj = 0; bj < 2; ++bj) { f32x4 v0 = acc[ai][bj][m][0], v1 = acc[ai][bj][m][1];
                    if (sg) {
#pragma unroll
                        for (int j = 0; j < 4; ++j) { v0[j] = sigmoid_f(v0[j]); v1[j] = sigmoid_f(v1[j]); } }
                    u32x4 w; w.x = cvt_pk_bf16(v0[0], v0[1]); w.y = cvt_pk_bf16(v0[2], v0[3]); w.z = cvt_pk_bf16(v1[0], v1[1]); w.w = cvt_pk_bf16(v1[2], v1[3]);
                    *(u32x4*)(rowp + bj * HALF) = w; } }
    }
};
template <int BR> struct EpiMergeF {
    static constexpr bool PERM = false;
    unsigned char* ws;
    __device__ __forceinline__ void operator()(const f32x4 (&acc)[2][2][4][2], const Unit& u, int row0, int wr, int wc, int fr, int fq) const {
        const int r0 = row0 + wr * 64 + fr, col0 = u.pn * BM + wc * 32 + 4 * fq;
#pragma unroll
        for (int ai = 0; ai < 2; ++ai)
#pragma unroll
            for (int m = 0; m < 4; ++m) { const size_t row = (size_t)(r0 + ai * HALF + m * 16);
                const bf16_t* gp = (const bf16_t*)(ws + WS_GATE) + row * 6144 + BR * 2048 + col0;
                float* mp = (float*)(ws + WS_MPART) + row * D + col0; bf16_t* ob = (bf16_t*)(ws + WS_MB) + row * D + col0;
#pragma unroll
                for (int bj = 0; bj < 2; ++bj)
#pragma unroll
                    for (int n = 0; n < 2; ++n) { const int co = bj * HALF + n * 16;
                        const u32x2 gg = *(const u32x2*)(gp + co);
                        const f32x4 g = {__uint_as_float(gg.x << 16), __uint_as_float(gg.x & 0xffff0000u), __uint_as_float(gg.y << 16), __uint_as_float(gg.y & 0xffff0000u)};
                        f32x4 t = g * acc[ai][bj][m][n];
                        if (BR > 0) t += *(const f32x4*)(mp + co);
                        if (BR < 2) *(f32x4*)(mp + co) = t;
                        else { u32x2 w; w.x = cvt_pk_bf16(t[0], t[1]); w.y = cvt_pk_bf16(t[2], t[3]); *(u32x2*)(ob + co) = w; } } }
    }
};
struct EpiOutF {
    static constexpr bool PERM = false;
    const Ctx* c; int layer;
    __device__ __forceinline__ void operator()(const f32x4 (&acc)[2][2][4][2], const Unit& u, int row0, int wr, int wc, int fr, int fq) const {
        const int r0 = row0 + wr * 64 + fr, col0 = u.pn * BM + wc * 32 + 4 * fq;
#pragma unroll
        for (int ai = 0; ai < 2; ++ai)
#pragma unroll
            for (int m = 0; m < 4; ++m) { const int row = r0 + ai * HALF + m * 16;
                const float* xin = c->xrow(layer, row) + col0; const float* g = c->mod(layer, row < L ? 0 : 1, 2) + col0;
                float* o = (float*)(c->ws + WS_XA) + (size_t)row * D + col0;
#pragma unroll
                for (int bj = 0; bj < 2; ++bj)
#pragma unroll
                    for (int n = 0; n < 2; ++n) { const int co = bj * HALF + n * 16;
                        *(f32x4*)(o + co) = *(const f32x4*)(xin + co) + *(const f32x4*)(g + co) * acc[ai][bj][m][n]; } }
    }
};
struct EpiGU {
    static constexpr bool PERM = false;
    bf16_t* act;
    __device__ __forceinline__ void operator()(const f32x4 (&acc)[2][2][4][2], const Unit& u, int row0, int wr, int wc, int fr, int fq) const {
        const int r0 = row0 + wr * 64 + fr, f0 = u.pn * 128 + wc * 16 + 4 * fq;
#pragma unroll
        for (int ai = 0; ai < 2; ++ai)
#pragma unroll
            for (int m = 0; m < 4; ++m) { bf16_t* rowp = act + (size_t)(r0 + ai * HALF + m * 16) * DF + f0;
#pragma unroll
                for (int bj = 0; bj < 2; ++bj) { const f32x4 a = acc[ai][bj][m][0], uu = acc[ai][bj][m][1]; f32x4 t;
#pragma unroll
                    for (int j = 0; j < 4; ++j) t[j] = silu_f(a[j]) * uu[j];
                    u32x2 w; w.x = cvt_pk_bf16(t[0], t[1]); w.y = cvt_pk_bf16(t[2], t[3]); *(u32x2*)(rowp + bj * 64) = w; } }
    }
};
}

template <class RowMap>
__device__ __forceinline__ void transpose_item(const float* __restrict__ W, int K, int N, bf16_t* WT, const RowMap& rm, float* scr, int item, int lane) {
    const int nblk = N / 32, kb = item / nblk, nb = item % nblk, k0 = 64 * kb, n0 = 32 * nb;
#pragma unroll 8
    for (int i = 0; i < 32; ++i) { const int kk = 2 * i + (lane >> 5); scr[kk * 33 + (lane & 31)] = W[(size_t)(k0 + kk) * N + n0 + (lane & 31)]; }
    LDS_FENCE();
    const int cq = lane & 7;
#pragma unroll
    for (int j = 0; j < 4; ++j) { const int n = (lane >> 3) + 8 * j; const float* sp = scr + (8 * cq) * 33 + n;
        uint4 o; o.x = pk2(sp[0 * 33], sp[1 * 33]); o.y = pk2(sp[2 * 33], sp[3 * 33]); o.z = pk2(sp[4 * 33], sp[5 * 33]); o.w = pk2(sp[6 * 33], sp[7 * 33]);
        *(uint4*)(WT + (size_t)rm(n0 + n) * K + k0 + 8 * cq) = o; }
    LDS_FENCE();
}
struct RmPlain { int off; __device__ __forceinline__ int operator()(int n) const { return off + n; } };
struct RmGU { int off; __device__ __forceinline__ int operator()(int f) const { return off + 32 * (f >> 4) + (f & 15); } };
__device__ __forceinline__ void ph_conv(const Ctx& c, int layer) {
    __syncthreads();
    float* scr = (float*)c.smem + c.wave * (64 * 33);
    const int gw = c.bid * 8 + c.wave, ngw = c.nb * 8;
    constexpr int I_IN = (D / 64) * (NIN / 32), I_BR = (1024 / 64) * (D / 32), I_OUT = (D / 64) * (D / 32), I_G = (D / 64) * (DF / 32), I_DN = (DF / 64) * (D / 32);
    constexpr int NITEMS = I_IN + 3 * I_BR + I_OUT + NE * (2 * I_G + I_DN);
    for (int it = gw; it < NITEMS; it += ngw) {
        int r = it;
        if (r < I_IN) { transpose_item(c.in[7] + (size_t)layer * D * NIN, D, NIN, c.wsp<bf16_t>(WS_WIN), RmPlain{0}, scr, r, c.lane); continue; } r -= I_IN;
        if (r < 3 * I_BR) { const int b = r / I_BR; transpose_item(c.in[24] + ((size_t)layer * 3 + b) * 1024 * D, 1024, D, c.wsp<bf16_t>(WS_WBR) + (size_t)b * D * 1024, RmPlain{0}, scr, r % I_BR, c.lane); continue; } r -= 3 * I_BR;
        if (r < I_OUT) { transpose_item(c.in[25] + (size_t)layer * D * D, D, D, c.wsp<bf16_t>(WS_WOUT), RmPlain{0}, scr, r, c.lane); continue; } r -= I_OUT;
        const int e = r / (2 * I_G + I_DN); r -= e * (2 * I_G + I_DN);
        if (r < I_G) { transpose_item(c.in[28] + ((size_t)layer * NE + e) * D * DF, D, DF, c.wsp<bf16_t>(WS_WGU), RmGU{e * 2048}, scr, r, c.lane); continue; } r -= I_G;
        if (r < I_G) { transpose_item(c.in[29] + ((size_t)layer * NE + e) * D * DF, D, DF, c.wsp<bf16_t>(WS_WGU), RmGU{e * 2048 + 16}, scr, r, c.lane); continue; } r -= I_G;
        transpose_item(c.in[30] + ((size_t)layer * NE + e) * DF * D, DF, D, c.wsp<bf16_t>(WS_WDN) + (size_t)e * D * DF, RmPlain{0}, scr, r, c.lane);
    }
}

__device__ __forceinline__ void ph_g0(const Ctx& c) {
    float* lds = (float*)c.smem;
    for (int u = c.bid; u < 2 * 256; u += c.nb) {
        const int layer = u >> 8, n0 = (u & 255) * 48;
        __syncthreads();
        for (int k = c.tid; k < D; k += NTHREADS) { lds[k] = silu_f(c.in[1][k]); lds[D + k] = silu_f(c.in[3][k]); }
        __syncthreads();
        const int col = c.tid % 48, kg = c.tid / 48;
        float a0 = 0.f, a1 = 0.f;
        if (kg < 10) {
            const float* w = c.in[4] + (size_t)layer * D * NMOD + n0 + col;
            for (int k = kg; k < D; k += 10) { const float wv = w[(size_t)k * NMOD]; a0 = fmaf(lds[k], wv, a0); a1 = fmaf(lds[D + k], wv, a1); }
        }
        float* red = lds + 2 * D;
        if (kg < 10) { red[(kg * 48 + col) * 2] = a0; red[(kg * 48 + col) * 2 + 1] = a1; }
        __syncthreads();
        if (c.tid < 96) {
            const int cc = c.tid >> 1, s = c.tid & 1; float t = 0.f;
            for (int g = 0; g < 10; ++g) t += red[(g * 48 + cc) * 2 + s];
            t += c.in[5][(size_t)layer * NMOD + n0 + cc];
            c.wsp<float>(WS_MOD)[(size_t)(layer * 2 + s) * NMOD + n0 + cc] = t;
        }
    }
    const int gw = c.bid * 8 + c.wave, ngw = c.nb * 8;
    for (int task = gw; task < 2 * MR; task += ngw) {
        const int layer = task / MR, pos = task % MR;
        const bool isc = pos >= L; const int i = isc ? pos - L : pos; const int Lx = isc ? LC : L;
        const float tt = (float)i * (1.0f / (float)(Lx - 1));
        const float c0 = (float)(2.0 * 3.14159265358979323846 / (double)Lx);
        const int j = c.lane;
        float feat = 0.f;
        if (j == 0) feat = tt;
        else if (j < 33) { const int b = (j - 1) & 15; const float band = 1e-4f + (float)b * ((15.0f - 1e-4f) / 15.0f); const float ang = (c0 * band) * (float)i; feat = (j <= 16) ? cosf(ang) : -sinf(ang); }
        const float* fw1 = c.in[10] + (size_t)layer * 33 * 64; const float* fb1 = c.in[11] + layer * 64;
        const float* fw2 = c.in[12] + (size_t)layer * 64 * 64; const float* fb2 = c.in[13] + layer * 64;
        const float* fr = c.in[15] + layer * 128;
        float s = fb1[j];
        for (int f = 0; f < 33; ++f) s = fmaf(__shfl(feat, f), fw1[f * 64 + j], s);
        const float h1 = sinf(fr[j] * s);
        float s2 = fb2[j];
        for (int m = 0; m < 64; ++m) s2 = fmaf(__shfl(h1, m), fw2[m * 64 + j], s2);
        const float h2 = sinf(fr[64 + j] * s2);
        c.wsp<float>(WS_H2F)[((size_t)layer * MR + pos) * 64 + j] = h2;
    }
}

__device__ __forceinline__ void ph_a(const Ctx& c, int layer) {
    const int gw = c.bid * 8 + c.wave, ngw = c.nb * 8;
    const float* g = c.in[6] + (size_t)layer * D;
    for (int r = gw; r < MR; r += ngw) {
        const float* x = c.xrow(layer, r);
        const int src = r < L ? 0 : 1;
        const float* sh = c.mod(layer, src, 0); const float* sc = c.mod(layer, src, 1);
        float4 v[8]; float ss = 0.f;
#pragma unroll
        for (int j = 0; j < 8; ++j) { v[j] = *(const float4*)(x + 4 * c.lane + 256 * j); ss += v[j].x * v[j].x + v[j].y * v[j].y + v[j].z * v[j].z + v[j].w * v[j].w; }
        ss = wave_sum(ss);
        const float inv = rsqrtf(ss * (1.0f / D) + RMS_EPS);
        bf16_t* o = c.wsp<bf16_t>(WS_HX) + (size_t)r * D;
#pragma unroll
        for (int j = 0; j < 8; ++j) {
            const int col = 4 * c.lane + 256 * j;
            const float4 gg = *(const float4*)(g + col), s4 = *(const float4*)(sh + col), c4 = *(const float4*)(sc + col);
            const float y0 = v[j].x * inv * gg.x * (1.f + c4.x) + s4.x, y1 = v[j].y * inv * gg.y * (1.f + c4.y) + s4.y;
            const float y2 = v[j].z * inv * gg.z * (1.f + c4.z) + s4.z, y3 = v[j].w * inv * gg.w * (1.f + c4.w) + s4.w;
            uint2 w; w.x = pk2(y0, y1); w.y = pk2(y2, y3);
            *(uint2*)(o + col) = w;
        }
    }
    float* hs = (float*)c.smem;
    const float* fw3 = c.in[14] + (size_t)layer * 64 * 4096;
    const float* dec = c.in[16] + (size_t)layer * 4096;
    for (int u = c.bid; u < 260; u += c.nb) {
        const bool isc = u >= 256; const int p0 = isc ? (u - 256) * 64 : u * 64; const int Lx = isc ? LC : L;
        __syncthreads();
        const float* h2f = c.wsp<float>(WS_H2F) + ((size_t)layer * MR + (isc ? L : 0) + p0) * 64;
        for (int e = c.tid; e < 64 * 64; e += NTHREADS) hs[e] = h2f[e];
        __syncthreads();
        for (int cb = 0; cb < 8; ++cb) {
            const int col = cb * 512 + c.tid;
            float w[64];
#pragma unroll
            for (int j = 0; j < 64; ++j) w[j] = fw3[j * 4096 + col];
            const float rate = fabsf(dec[col]);
            bf16_t* dst = isc ? c.wsp<bf16_t>(WS_KFC) + (size_t)col * LC + p0 : c.wsp<bf16_t>(WS_KF) + (size_t)col * L + p0;
#pragma unroll 1
            for (int p = 0; p < 64; p += 2) {
                float s0 = 0.f, s1 = 0.f;
#pragma unroll
                for (int j = 0; j < 64; j += 4) {
                    const float4 h4 = *(const float4*)&hs[p * 64 + j]; const float4 g4 = *(const float4*)&hs[(p + 1) * 64 + j];
                    s0 = fmaf(h4.x, w[j], s0); s0 = fmaf(h4.y, w[j + 1], s0); s0 = fmaf(h4.z, w[j + 2], s0); s0 = fmaf(h4.w, w[j + 3], s0);
                    s1 = fmaf(g4.x, w[j], s1); s1 = fmaf(g4.y, w[j + 1], s1); s1 = fmaf(g4.z, w[j + 2], s1); s1 = fmaf(g4.w, w[j + 3], s1);
                }
                const float t0 = (float)(p0 + p) * (1.0f / (float)(Lx - 1)), t1 = (float)(p0 + p + 1) * (1.0f / (float)(Lx - 1));
                *(unsigned*)(dst + p) = pk2(s0 * (__expf(-t0 * rate) + 0.05f), s1 * (__expf(-t1 * rate) + 0.05f));
            }
        }
    }
}

struct EpiIn {
    unsigned char* ws;
    __device__ __forceinline__ void operator()(int row, int col, const float (&v)[8]) const {
        if (col < OFF_WAQ) {
            bf16_t* d = (bf16_t*)(ws + WS_ZHYT);
#pragma unroll
            for (int j = 0; j < 8; ++j) d[(size_t)(col + j) * MR + row] = f2bf(v[j]);
            return;
        }
        bf16_t* dst; float t[8];
#pragma unroll
        for (int j = 0; j < 8; ++j) t[j] = v[j];
        if (col < OFF_WAKV) dst = (bf16_t*)(ws + WS_QWA) + (size_t)row * 1024 + (col - OFF_WAQ);
        else if (col < OFF_NAQ) dst = (bf16_t*)(ws + WS_KVWA) + (size_t)row * 512 + (col - OFF_WAKV);
        else if (col < OFF_NAKV) dst = (bf16_t*)(ws + WS_QNA) + (size_t)row * 1024 + (col - OFF_NAQ);
        else if (col < OFF_GATE) dst = (bf16_t*)(ws + WS_KVNA) + (size_t)row * 2048 + (col - OFF_NAKV);
        else { dst = (bf16_t*)(ws + WS_GATE) + (size_t)row * 6144 + (col - OFF_GATE);
#pragma unroll
            for (int j = 0; j < 8; ++j) t[j] = sigmoid_f(t[j]); }
        uint4 o; o.x = pk2(t[0], t[1]); o.y = pk2(t[2], t[3]); o.z = pk2(t[4], t[5]); o.w = pk2(t[6], t[7]);
        *(uint4*)dst = o;
    }
};
__device__ __forceinline__ void ph_b(const Ctx& c, int layer) {
    const RowLin rp{c.wsp<bf16_t>(WS_HX), D};
    const EpiIn ep{c.ws};
    const float* W = c.in[7] + (size_t)layer * D * NIN;
    const int nM = MR / 128, nN = NIN / 128;
    for (int u = c.bid; u < nM * nN; u += c.nb) {
        const int pm = u % nM, pn = u / nM;
        sgemm_unit(rp, W, NIN, D, pm * 128, pn * 128, ep, (float*)c.smem, c.tid);
    }
}

__device__ __forceinline__ void ph_b2(const Ctx& c, int layer) {
    const int gw = c.bid * 8 + c.wave, ngw = c.nb * 8;
    const int lane = c.lane;
    const int dlo = lane < 32 ? lane : lane + 32, dhi = dlo + 32;
    const int f = lane & 31, ax = lane >> 5;
    const float invf = powf(10000.0f, -(float)f / 32.0f);
    for (int task = gw; task < MR * 26; task += ngw) {
        const int r = task / 26, s = task % 26;
        bf16_t* p; const float* gain; bool rope;
        if (s < 8) { p = c.wsp<bf16_t>(WS_QWA) + (size_t)r * 1024 + s * 128; gain = c.in[18] + layer * 128; rope = true; }
        else if (s < 10) { p = c.wsp<bf16_t>(WS_KVWA) + (size_t)r * 512 + (s - 8) * 128; gain = c.in[19] + layer * 128; rope = true; }
        else if (s < 18) { p = c.wsp<bf16_t>(WS_QNA) + (size_t)r * 1024 + (s - 10) * 128; gain = c.in[21] + layer * 128; rope = false; }
        else { p = c.wsp<bf16_t>(WS_KVNA) + (size_t)r * 2048 + (s - 18) * 128; gain = c.in[22] + layer * 128; rope = false; }
        float a = bf2f(p[dlo]), b = bf2f(p[dhi]);
        const float ss = wave_sum(a * a + b * b);
        const float inv = rsqrtf(ss * (1.0f / 128.0f) + RMS_EPS);
        a = a * inv * gain[dlo]; b = b * inv * gain[dhi];
        if (rope && r < L) {
            const float pos = ax == 0 ? (float)(r / GRIDW) : (float)(r % GRIDW);
            const float ang = pos * invf; const float cs = cosf(ang), sn = sinf(ang);
            const float na = a * cs - b * sn, nb2 = b * cs + a * sn; a = na; b = nb2;
        }
        p[dlo] = f2bf(a); p[dhi] = f2bf(b);
    }
}

__device__ __forceinline__ float shortconv_at(const bf16_t* z, int t, int Lx, float w0, float w1, float w2, float b) {
    const float zm = t > 0 ? bf2f(z[t - 1]) : 0.f, z0 = bf2f(z[t]), zp = t + 1 < Lx ? bf2f(z[t + 1]) : 0.f;
    return zm * w0 + z0 * w1 + zp * w2 + b;
}
__device__ __forceinline__ float block_sum(float v, float* red, int tid) {
    v = wave_sum(v);
    __syncthreads();
    if ((tid & 63) == 0) red[tid >> 6] = v;
    __syncthreads();
    float t = 0.f;
#pragma unroll
    for (int w = 0; w < 8; ++w) t += red[w];
    return t;
}
__device__ __forceinline__ void hyena_direct_unit(const Ctx& c, int layer, int ch) {
    bf16_t* kc = (bf16_t*)c.smem;
    float* cv = (float*)c.smem;
    float* us = (float*)(c.smem + 4 * L);
    float* red = us + L;
    const int tid = c.tid;
    const float* cw = c.in[8] + (size_t)layer * 3 * 3072; const float* cb = c.in[9] + (size_t)layer * 3072;
    const bf16_t* zv = c.wsp<bf16_t>(WS_ZHYT) + (size_t)ch * MR;
    const bf16_t* z1 = c.wsp<bf16_t>(WS_ZHYT) + (size_t)(1024 + ch) * MR;
    const bf16_t* z2 = c.wsp<bf16_t>(WS_ZHYT) + (size_t)(2048 + ch) * MR;
    const bf16_t* KF = c.wsp<bf16_t>(WS_KF);
    __syncthreads();
    { const float w0 = cw[ch], w1 = cw[3072 + ch], w2 = cw[6144 + ch], b = cb[ch];
#pragma unroll 2
      for (int t = tid; t < L; t += NTHREADS) us[t] = shortconv_at(zv, t, L, w0, w1, w2, b); }
    for (int o = 0; o < 2; ++o) {
        const bf16_t* hf = KF + (size_t)(o * 1024 + ch) * L;
        const bf16_t* hb = KF + (size_t)(2048 + o * 1024 + ch) * L;
        float sabs = 0.f;
#pragma unroll 2
        for (int t = tid; t < L; t += NTHREADS) {
            bf16_t kf = hf[t], kb = hb[t];
            if (t == 0) { kf = f2bf(bf2f(kf) + bf2f(kb)); kb = 0; }
            kc[L + t] = kf; kc[L - t] = (t == 0) ? kf : kb;
            sabs += fabsf(bf2f(kf)) + fabsf(bf2f(kb));
        }
        if (tid == 0) kc[0] = 0;
        const float S = block_sum(sabs, red, tid);
        {
            float acc[32];
#pragma unroll
            for (int j = 0; j < 32; ++j) acc[j] = 0.f;
#pragma unroll 2
            for (int s = 0; s < L; ++s) {
                const float uv = us[s];
                const bf16_t* kp = kc + (L + tid - s);
#pragma unroll
                for (int j = 0; j < 32; ++j) acc[j] = fmaf(uv, bf2f(kp[512 * j]), acc[j]);
            }
            __syncthreads();
#pragma unroll
            for (int j = 0; j < 32; ++j) cv[tid + 512 * j] = acc[j];
        }
        LDS_FENCE();
        const float invS = 1.0f / S;
        const float dsk = c.in[17][(size_t)layer * 2048 + o * 1024 + ch];
        const int co = o == 0 ? 1024 : 2048;
        const bf16_t* zz = o == 0 ? z1 : z2;
        const float w0 = cw[co + ch], w1 = cw[3072 + co + ch], w2 = cw[6144 + co + ch], b = cb[co + ch];
        bf16_t* dst = c.wsp<bf16_t>(WS_YHYT) + (size_t)ch * L;
#pragma unroll 2
        for (int t = tid; t < L; t += NTHREADS) {
            const float r = shortconv_at(zz, t, L, w0, w1, w2, b) * (cv[t] * invS + us[t] * dsk);
            if (o == 0) us[t] = r; else dst[t] = f2bf(r);
        }
        __syncthreads();
    }
}
__device__ __forceinline__ void hyena_ctx_unit(const Ctx& c, int layer, int ch) {
    float* kc = (float*)c.smem;
    float* us = kc + 512;
    float* red = us + 256;
    const int tid = c.tid;
    const float* cw = c.in[8] + (size_t)layer * 3 * 3072; const float* cb = c.in[9] + (size_t)layer * 3072;
    const bf16_t* zv = c.wsp<bf16_t>(WS_ZHYT) + (size_t)ch * MR + L;
    const bf16_t* z1 = c.wsp<bf16_t>(WS_ZHYT) + (size_t)(1024 + ch) * MR + L;
    const bf16_t* z2 = c.wsp<bf16_t>(WS_ZHYT) + (size_t)(2048 + ch) * MR + L;
    const bf16_t* KF = c.wsp<bf16_t>(WS_KFC);
    __syncthreads();
    if (tid < LC) us[tid] = shortconv_at(zv, tid, LC, cw[ch], cw[3072 + ch], cw[6144 + ch], cb[ch]);
    for (int o = 0; o < 2; ++o) {
        const bf16_t* hf = KF + (size_t)(o * 1024 + ch) * LC;
        const bf16_t* hb = KF + (size_t)(2048 + o * 1024 + ch) * LC;
        float sabs = 0.f;
        {
            const int lag = tid - 256; float k;
            if (lag == 0) k = bf2f(hf[0]) + bf2f(hb[0]); else if (lag > 0) k = bf2f(hf[lag]); else if (lag > -256) k = bf2f(hb[-lag]); else k = 0.f;
            kc[tid] = k; sabs = fabsf(k);
        }
        const float S = block_sum(sabs, red, tid);
        float acc = 0.f;
        if (tid < LC) for (int s = 0; s < LC; ++s) acc = fmaf(us[s], kc[256 + tid - s], acc);
        const float dsk = c.in[17][(size_t)layer * 2048 + o * 1024 + ch];
        float res = 0.f;
        if (tid < LC) {
            const bf16_t* zz = o == 0 ? z1 : z2; const int co = o == 0 ? 1024 : 2048;
            res = shortconv_at(zz, tid, LC, cw[co + ch], cw[3072 + co + ch], cw[6144 + co + ch], cb[co + ch]) * (acc / S + us[tid] * dsk);
        }
        __syncthreads();
        if (tid < LC) { if (o == 0) us[tid] = res; else c.wsp<bf16_t>(WS_YHY)[(size_t)(L + tid) * 1024 + ch] = f2bf(res); }
        __syncthreads();
    }
}

template <class KeyFn>
__device__ __forceinline__ void wave_attn(const bf16_t* q, int nkeys, const KeyFn& key, bool has_sink, float sink, bf16_t* out, float* wl, int lane) {
    float* qf = wl;
    float* sc = wl + 128;
    qf[2 * lane] = bf2f(q[2 * lane]); qf[2 * lane + 1] = bf2f(q[2 * lane + 1]);
    LDS_FENCE();
    float mx = -3.0e38f;
    for (int j = lane; j < nkeys; j += 64) {
        const bf16_t* kp; const bf16_t* vp; float bias;
        float s = -1e30f;
        if (key(j, kp, vp, bias)) {
            float d = 0.f;
#pragma unroll
            for (int e = 0; e < 128; e += 8) {
                const uint4 kk = *(const uint4*)(kp + e);
                d = fmaf(qf[e + 0], __uint_as_float(kk.x << 16), d); d = fmaf(qf[e + 1], __uint_as_float(kk.x & 0xffff0000u), d);
                d = fmaf(qf[e + 2], __uint_as_float(kk.y << 16), d); d = fmaf(qf[e + 3], __uint_as_float(kk.y & 0xffff0000u), d);
                d = fmaf(qf[e + 4], __uint_as_float(kk.z << 16), d); d = fmaf(qf[e + 5], __uint_as_float(kk.z & 0xffff0000u), d);
                d = fmaf(qf[e + 6], __uint_as_float(kk.w << 16), d); d = fmaf(qf[e + 7], __uint_as_float(kk.w & 0xffff0000u), d);
            }
            s = d * QK_SCALE + bias;
        }
        sc[j] = s; mx = fmaxf(mx, s);
    }
    if (has_sink) mx = fmaxf(mx, sink);
    mx = wave_max(mx);
    float sum = 0.f;
    for (int j = lane; j < nkeys; j += 64) { const float p = __expf(sc[j] - mx); sc[j] = p; sum += p; }
    sum = wave_sum(sum);
    if (has_sink) sum += __expf(sink - mx);
    LDS_FENCE();
    float o0 = 0.f, o1 = 0.f;
    for (int j = 0; j < nkeys; ++j) {
        const float p = sc[j];
        if (p != 0.f) {
            const bf16_t* kp; const bf16_t* vp; float bias;
            key(j, kp, vp, bias);
            const unsigned vv = *(const unsigned*)(vp + 2 * lane);
            o0 = fmaf(p, __uint_as_float(vv << 16), o0); o1 = fmaf(p, __uint_as_float(vv & 0xffff0000u), o1);
        }
    }
    const float inv = 1.0f / sum;
    *(unsigned*)(out + 2 * lane) = pk2(o0 * inv, o1 * inv);
    LDS_FENCE();
}

struct KeyWA {
    const bf16_t* kv; int t, kvh;
    __device__ __forceinline__ bool operator()(int j, const bf16_t*& kp, const bf16_t*& vp, float& bias) const {
        bias = 0.f;
        int row; bool ok = true;
        if (j < 257) { const int kpos = t - 128 + j; ok = kpos >= 0 && kpos < L; row = ok ? kpos : 0; } else row = L + (j - 257);
        kp = kv + (size_t)row * 512 + kvh * 128; vp = kp + 256; return ok;
    }
};
struct KeyCtxWA { const bf16_t* kv; int kvh;
    __device__ __forceinline__ bool operator()(int j, const bf16_t*& kp, const bf16_t*& vp, float& bias) const { bias = 0.f; kp = kv + (size_t)(L + j) * 512 + kvh * 128; vp = kp + 256; return true; } };
struct KeyNA {
    const bf16_t* kv; const float* rpb; int r, qc, r0, cs, h;
    __device__ __forceinline__ bool operator()(int j, const bf16_t*& kp, const bf16_t*& vp, float& bias) const {
        int row;
        if (j < 128) { const int w = j >> 4, kc = cs + (j & 15); row = (r0 + w) * GRIDW + kc;
            const int dr = r0 + w - r + 7; int dc = kc - qc + 15; dc = dc < 0 ? 0 : (dc > 30 ? 30 : dc);
            bias = rpb[(h * 15 + dr) * 31 + dc]; }
        else { row = L + (j - 128); bias = 0.f; }
        kp = kv + (size_t)row * 2048 + h * 128; vp = kp + 1024; return true;
    }
};
struct KeyCtxNA { const bf16_t* kv; int h;
    __device__ __forceinline__ bool operator()(int j, const bf16_t*& kp, const bf16_t*& vp, float& bias) const { bias = 0.f; kp = kv + (size_t)(L + j) * 2048 + h * 128; vp = kp + 1024; return true; } };


#define HYF __device__ __forceinline__
#define HYF_OPAQUE(x) asm volatile("" : "+v"(x))
#define HYF_SB(i) do { if (((i) & 3) == 3) __builtin_amdgcn_sched_barrier(0); } while (0)
namespace hyf {
constexpr int FL = 16384;
constexpr int FPAD = FL + 32 * 16;
typedef float cpx __attribute__((ext_vector_type(2)));
HYF int phys(int p) { return ((p & ~15) | ((p & 15) ^ ((p >> 5) & 15))) + ((p >> 9) << 4); }

#define HYF_C32 {1.0f, 0.98078528040323043f, 0.92387953251128674f, 0.83146961230254524f, 0.70710678118654752f, 0.55557023301960218f, 0.38268343236508978f, 0.19509032201612825f, \
                 0.0f, -0.19509032201612825f, -0.38268343236508978f, -0.55557023301960218f, -0.70710678118654752f, -0.83146961230254524f, -0.92387953251128674f, -0.98078528040323043f}
#define HYF_S32 {0.0f, 0.19509032201612825f, 0.38268343236508978f, 0.55557023301960218f, 0.70710678118654752f, 0.83146961230254524f, 0.92387953251128674f, 0.98078528040323043f, \
                 1.0f, 0.98078528040323043f, 0.92387953251128674f, 0.83146961230254524f, 0.70710678118654752f, 0.55557023301960218f, 0.38268343236508978f, 0.19509032201612825f}

HYF int rev5(int x) { return (int)(__builtin_bitreverse32((unsigned)x) >> 27); }
HYF int rev4(int x) { return (int)(__builtin_bitreverse32((unsigned)x) >> 28); }
HYF cpx cmul(cpx a, cpx t) { return a.xx * t + (cpx){-a.y, a.y} * t.yx; }
HYF cpx cmulc(cpx a, cpx t) { return t.xx * a + t.yy * (cpx){a.y, -a.x}; }

template <int N, int SG, int BASE, int STRIDE32>
struct DifStage {
    static HYF void run(cpx (&v)[32], const float (&K)[9]) {
        constexpr int H = N / 2;
#pragma unroll
        for (int j = 0; j < H; ++j) {
            const cpx a = v[BASE + j], b = v[BASE + j + H];
            v[BASE + j] = a + b;
            const cpx d = a - b;
            const int tw = j * STRIDE32;
            if (tw == 0) v[BASE + j + H] = d;
            else if (tw == 8) v[BASE + j + H] = (SG < 0) ? (cpx){d.y, -d.x} : (cpx){-d.y, d.x};
            else {
                const float c = (tw < 8) ? K[tw] : -K[16 - tw];
                const float sa = (tw < 8) ? K[8 - tw] : K[tw - 8];
                const float s = (SG < 0) ? -sa : sa;
                v[BASE + j + H] = d * c + (cpx){-d.y, d.x} * s;
            }
        }
        if constexpr (N > 2) { DifStage<H, SG, BASE, STRIDE32 * 2>::run(v, K); DifStage<H, SG, BASE + H, STRIDE32 * 2>::run(v, K); }
    }
};
template <int SG> HYF void dft32(cpx (&v)[32], const float (&K0)[9]) { float K[9]; _Pragma("unroll") for (int m = 0; m < 9; ++m) { K[m] = K0[m]; HYF_OPAQUE(K[m]); } DifStage<32, SG, 0, 1>::run(v, K); }
template <int SG> HYF void dft16(cpx (&v)[32], const float (&K0)[9]) { float K[9]; _Pragma("unroll") for (int m = 0; m < 9; ++m) { K[m] = K0[m]; HYF_OPAQUE(K[m]); } DifStage<16, SG, 0, 2>::run(v, K); }

struct ThreadTw { cpx w1;
                  cpx w2;
                  cpx wo;
                  int b1;
                  int b2, n3;
                  int b3[2], sw;
                  float K[9]; };
HYF void tw_addr(int tid, ThreadTw& t) {
    t.b1 = (tid & ~15) | ((tid & 15) ^ ((tid >> 5) & 15));
    t.b2 = (tid >> 4) * 528; t.n3 = tid & 15; t.sw = (tid >> 1) & 15;
    for (int h = 0; h < 2; ++h) { const int g = tid + 512 * h; t.b3[h] = g * 16 + (g >> 5) * 16; }
    constexpr float KK[9] = {1.0f, 0.98078528040323043f, 0.92387953251128674f, 0.83146961230254524f, 0.70710678118654752f, 0.55557023301960218f, 0.38268343236508978f, 0.19509032201612825f, 0.0f};
    for (int m = 0; m < 9; ++m) { t.K[m] = KK[m]; HYF_OPAQUE(t.K[m]); }
}

HYF void fwd_p1(const ThreadTw& tw, cpx (&v)[32], cpx* lds) {
    int b1 = tw.b1; HYF_OPAQUE(b1);
    float wx = tw.w1.x, wy = tw.w1.y; HYF_OPAQUE(wx); HYF_OPAQUE(wy); const cpx w = {wx, wy};
    dft32<-1>(v, tw.K);
    cpx t = {1.f, 0.f};
#pragma unroll
    for (int k1 = 0; k1 < 32; ++k1) {
        lds[b1 + 528 * k1] = cmul(v[rev5(k1)], t);
        t = cmul(t, w);
        HYF_SB(k1);
    }
}
HYF void fwd_p2(const ThreadTw& tw, cpx* lds) {
    int b2 = tw.b2, n3 = tw.n3; HYF_OPAQUE(b2); HYF_OPAQUE(n3);
    float wx = tw.w2.x, wy = tw.w2.y; HYF_OPAQUE(wx); HYF_OPAQUE(wy); const cpx w = {wx, wy};
    cpx v[32];
#pragma unroll
    for (int n2 = 0; n2 < 32; ++n2) v[n2] = lds[b2 + 16 * n2 + (n3 ^ ((n2 >> 1) & 15))];
    dft32<-1>(v, tw.K);
    cpx t = {1.f, 0.f};
#pragma unroll
    for (int k2 = 0; k2 < 32; ++k2) {
        lds[b2 + 16 * k2 + (n3 ^ ((k2 >> 1) & 15))] = cmul(v[rev5(k2)], t);
        t = cmul(t, w);
        HYF_SB(k2);
    }
}
HYF void fwd_p3(int tid, const ThreadTw& tw, const cpx* lds, cpx* ks) {
    HYF_OPAQUE(tid);
#pragma unroll
    for (int h = 0; h < 2; ++h) {
        int b3 = tw.b3[h], sw = tw.sw; HYF_OPAQUE(b3); HYF_OPAQUE(sw);
        cpx v[32];
#pragma unroll
        for (int n3 = 0; n3 < 16; ++n3) v[n3] = lds[b3 + (n3 ^ sw)];
        dft16<-1>(v, tw.K);
#pragma unroll
        for (int k3 = 0; k3 < 16; ++k3) ks[(h * 16 + k3) * 512 + tid] = v[rev4(k3)];
    }
}
HYF void mid_p3(int tid, const ThreadTw& tw, cpx* lds, const cpx* ks) {
    HYF_OPAQUE(tid);
#pragma unroll
    for (int h = 0; h < 2; ++h) {
        int b3 = tw.b3[h], sw = tw.sw; HYF_OPAQUE(b3); HYF_OPAQUE(sw);
        cpx v[32], p[32];
#pragma unroll
        for (int n3 = 0; n3 < 16; ++n3) v[n3] = lds[b3 + (n3 ^ sw)];
        dft16<-1>(v, tw.K);
#pragma unroll
        for (int k3 = 0; k3 < 16; ++k3) p[k3] = cmul(v[rev4(k3)], ks[(h * 16 + k3) * 512 + tid]);
        dft16<1>(p, tw.K);
#pragma unroll
        for (int n3 = 0; n3 < 16; ++n3) lds[b3 + (n3 ^ sw)] = p[rev4(n3)];
    }
}
HYF void inv_p2(const ThreadTw& tw, cpx* lds) {
    int b2 = tw.b2, n3 = tw.n3; HYF_OPAQUE(b2); HYF_OPAQUE(n3);
    float wx = tw.w2.x, wy = tw.w2.y; HYF_OPAQUE(wx); HYF_OPAQUE(wy); const cpx w = {wx, wy};
    cpx v[32];
    cpx t = {1.f, 0.f};
#pragma unroll
    for (int k2 = 0; k2 < 32; ++k2) {
        v[k2] = cmulc(lds[b2 + 16 * k2 + (n3 ^ ((k2 >> 1) & 15))], t);
        t = cmul(t, w);
        HYF_SB(k2);
    }
    dft32<1>(v, tw.K);
#pragma unroll
    for (int n2 = 0; n2 < 32; ++n2) { lds[b2 + 16 * n2 + (n3 ^ ((n2 >> 1) & 15))] = v[rev5(n2)]; HYF_SB(n2); }
}
HYF void inv_p1(const ThreadTw& tw, const cpx* lds, cpx (&out)[32]) {
    int b1 = tw.b1; HYF_OPAQUE(b1);
    float wx = tw.w1.x, wy = tw.w1.y; HYF_OPAQUE(wx); HYF_OPAQUE(wy); const cpx w = {wx, wy};
    cpx v[32];
    cpx t = {1.f, 0.f};
#pragma unroll
    for (int k1 = 0; k1 < 32; ++k1) {
        v[k1] = cmulc(lds[b1 + 528 * k1], t);
        t = cmul(t, w);
        HYF_SB(k1);
    }
    dft32<1>(v, tw.K);
#pragma unroll
    for (int n1 = 0; n1 < 32; ++n1) out[n1] = v[rev5(n1)];
}
HYF cpx opaque_wo(const ThreadTw& tw) { float x = tw.wo.x, y = tw.wo.y; HYF_OPAQUE(x); HYF_OPAQUE(y); return (cpx){x, y}; }
HYF cpx modfac(cpx wo, int n1) {
    constexpr float C64[32] = {1.0f, 0.99518472667219693f, 0.98078528040323043f, 0.95694033573220882f, 0.92387953251128674f, 0.88192126434835505f, 0.83146961230254524f, 0.77301045336273699f,
        0.70710678118654752f, 0.63439328416364549f, 0.55557023301960218f, 0.47139673682599764f, 0.38268343236508978f, 0.29028467725446233f, 0.19509032201612825f, 0.098017140329560604f,
        0.0f, -0.098017140329560604f, -0.19509032201612825f, -0.29028467725446233f, -0.38268343236508978f, -0.47139673682599764f, -0.55557023301960218f, -0.63439328416364549f,
        -0.70710678118654752f, -0.77301045336273699f, -0.83146961230254524f, -0.88192126434835505f, -0.92387953251128674f, -0.95694033573220882f, -0.98078528040323043f, -0.99518472667219693f};
    constexpr float S64[32] = {0.0f, 0.098017140329560604f, 0.19509032201612825f, 0.29028467725446233f, 0.38268343236508978f, 0.47139673682599764f, 0.55557023301960218f, 0.63439328416364549f,
        0.70710678118654752f, 0.77301045336273699f, 0.83146961230254524f, 0.88192126434835505f, 0.92387953251128674f, 0.95694033573220882f, 0.98078528040323043f, 0.99518472667219693f,
        1.0f, 0.99518472667219693f, 0.98078528040323043f, 0.95694033573220882f, 0.92387953251128674f, 0.88192126434835505f, 0.83146961230254524f, 0.77301045336273699f,
        0.70710678118654752f, 0.63439328416364549f, 0.55557023301960218f, 0.47139673682599764f, 0.38268343236508978f, 0.29028467725446233f, 0.19509032201612825f, 0.098017140329560604f};
    return cmul(wo, (cpx){C64[n1], -S64[n1]});
}
}

#undef HYF
#ifndef FAST_HY
#define FAST_HY 1
#endif
__device__ __forceinline__ void hyena_fft_unit(const Ctx& c, int layer, int ch, const hyf::ThreadTw& tw) {
    using namespace hyf;
    cpx* lds = (cpx*)c.smem; float* red = (float*)(c.smem + (size_t)FPAD * 8);
    cpx* ks = c.wsp<cpx>(WS_KS) + (size_t)c.bid * (2 * FL);
    float* ub = (float*)(ks + FL); float* yb = ub + FL;
    const int tid = c.tid;
    const float* cw = c.in[8] + (size_t)layer * 3 * 3072; const float* cb = c.in[9] + (size_t)layer * 3072;
    const bf16_t* zv = c.wsp<bf16_t>(WS_ZHYT) + (size_t)ch * MR;
    const bf16_t* KF = c.wsp<bf16_t>(WS_KF);
    { const float w0 = cw[ch], w1 = cw[3072 + ch], w2 = cw[6144 + ch], b = cb[ch]; int tq = tid; HYF_OPAQUE(tq);
#pragma unroll 4
      for (int j = 0; j < 32; ++j) ub[tq + 512 * j] = shortconv_at(zv, tq + 512 * j, L, w0, w1, w2, b); }
#pragma unroll 1
    for (int o = 0; o < 2; ++o) {
        const bf16_t* hf = KF + (size_t)(o * 1024 + ch) * L;
        const bf16_t* hb = KF + (size_t)(2048 + o * 1024 + ch) * L;
        float S;
        {
            cpx v[32]; float sabs = 0.f; int tq = tid; HYF_OPAQUE(tq);
#pragma unroll
            for (int j = 0; j < 32; ++j) { const int n = tq + 512 * j; const float f = bf2f(hf[n]); const float bb = bf2f(hb[n == 0 ? 0 : L - n]);
                v[j] = (cpx){f + bb, 0.f}; sabs += (n == 0) ? fabsf(f + bb) : fabsf(f) + fabsf(bb); }
            S = block_sum(sabs, red, tid);
            fwd_p1(tw, v, lds); __syncthreads(); fwd_p2(tw, lds); __syncthreads(); fwd_p3(tid, tw, lds, ks); __syncthreads();
        }
        {
            cpx v[32]; int tq = tid; HYF_OPAQUE(tq);
#pragma unroll
            for (int j = 0; j < 32; ++j) v[j] = (cpx){ub[tq + 512 * j], 0.f};
            fwd_p1(tw, v, lds); __syncthreads(); fwd_p2(tw, lds); __syncthreads(); mid_p3(tid, tw, lds, ks); __syncthreads();
            inv_p2(tw, lds); __syncthreads();
            inv_p1(tw, lds, v); __syncthreads();
            HYF_OPAQUE(tq);
#pragma unroll
            for (int j = 0; j < 32; ++j) yb[tq + 512 * j] = v[j].x;
        }
        {
            cpx v[32]; const cpx wo = opaque_wo(tw); int tq = tid; HYF_OPAQUE(tq);
#pragma unroll
            for (int j = 0; j < 32; ++j) { const int n = tq + 512 * j; const float f = bf2f(hf[n]); const float bb = bf2f(hb[n == 0 ? 0 : L - n]);
                const float d = (n == 0) ? f + bb : f - bb; v[j] = modfac(wo, j) * d; }
            fwd_p1(tw, v, lds); __syncthreads(); fwd_p2(tw, lds); __syncthreads(); fwd_p3(tid, tw, lds, ks); __syncthreads();
        }
        {
            cpx v[32]; cpx wo = opaque_wo(tw); int tq = tid; HYF_OPAQUE(tq);
#pragma unroll
            for (int j = 0; j < 32; ++j) v[j] = modfac(wo, j) * ub[tq + 512 * j];
            fwd_p1(tw, v, lds); __syncthreads(); fwd_p2(tw, lds); __syncthreads(); mid_p3(tid, tw, lds, ks); __syncthreads();
            inv_p2(tw, lds); __syncthreads();
            inv_p1(tw, lds, v); __syncthreads();
            const float sc = (0.5f / (float)L) / S; wo = opaque_wo(tw); HYF_OPAQUE(tq);
            const float dsk = c.in[17][(size_t)layer * 2048 + o * 1024 + ch];
            const int co = o == 0 ? 1024 : 2048;
            const bf16_t* zz = c.wsp<bf16_t>(WS_ZHYT) + (size_t)(co + ch) * MR;
            const float w0 = cw[co + ch], w1 = cw[3072 + co + ch], w2 = cw[6144 + co + ch], b = cb[co + ch];
            bf16_t* dst = c.wsp<bf16_t>(WS_YHYT) + (size_t)ch * L;
#pragma unroll
            for (int j = 0; j < 32; ++j) { const int t = tq + 512 * j; const cpx m = modfac(wo, j);
                const float conv = (yb[t] + v[j].x * m.x + v[j].y * m.y) * sc;
                const float r = shortconv_at(zz, t, L, w0, w1, w2, b) * (conv + ub[t] * dsk);
                if (o == 0) ub[t] = r; else dst[t] = f2bf(r); }
        }
    }
}


#ifndef FAST_ATT
#define FAST_ATT 1
#endif
namespace fa {
using bf16x8 = __attribute__((ext_vector_type(8))) short;
using s16x4  = __attribute__((ext_vector_type(4))) short;
using f32x16 = __attribute__((ext_vector_type(16))) float;
using u32x4  = __attribute__((ext_vector_type(4))) unsigned;
constexpr int AD = 128, NW = 8, QBLK = 32, KVBLK = 64;
constexpr float SCALE = 0.088388347648318440f;
constexpr float THR = 8.f;
constexpr size_t SHM_V = KVBLK * AD * 2, SHM_K = KVBLK * AD * 2, SHM_ATTN = 2 * SHM_V + 2 * SHM_K + NW * 64 * 4;
constexpr float NEG = -1e30f;
#define KSWZ(row, colB) ((row) * 256 + ((colB) ^ (((row) & 7) << 4)))
#define SBAR() __builtin_amdgcn_sched_barrier(0)
__device__ __forceinline__ int crow(int r, int hi) { return (r & 3) + 8 * (r >> 2) + 4 * hi; }
__device__ __forceinline__ unsigned cvtpk(float lo, float hi) { unsigned r; asm volatile("v_cvt_pk_bf16_f32 %0, %1, %2" : "=v"(r) : "v"(lo), "v"(hi)); return r; }
__device__ __forceinline__ void partialSM(f32x16& p0, f32x16& p1, float& m_reg, float& mn, float& alpha) {
  constexpr float C = SCALE * 1.4426950408889634f;
  float pmax = p0[0];
#pragma unroll
  for (int r = 1; r < 16; ++r) pmax = fmaxf(pmax, p0[r]);
#pragma unroll
  for (int r = 0; r < 16; ++r) pmax = fmaxf(pmax, p1[r]);
  { auto rr = __builtin_amdgcn_permlane32_swap(__float_as_uint(pmax), __float_as_uint(pmax), false, false);
    pmax = fmaxf(__uint_as_float(rr[0]), __uint_as_float(rr[1])); }
  if (__builtin_expect(__all(pmax - m_reg <= THR / SCALE), 1)) { mn = m_reg; alpha = 1.f; }
  else { mn = fmaxf(m_reg, pmax); alpha = __builtin_amdgcn_exp2f((m_reg - mn) * C); m_reg = mn; }
  const float mnC = -mn * C;
#pragma unroll
  for (int r = 0; r < 16; ++r) p0[r] = fmaf(p0[r], C, mnC);
#pragma unroll
  for (int r = 0; r < 16; ++r) p1[r] = fmaf(p1[r], C, mnC);
#pragma unroll
  for (int r = 0; r < 16; ++r) p0[r] = __builtin_amdgcn_exp2f(p0[r]);
}
__device__ __forceinline__ void finishSM(f32x16& p0, f32x16& p1, float alpha, float& l_reg, bf16x8& pa0, bf16x8& pa1, bf16x8& pa2, bf16x8& pa3) {
#pragma unroll
  for (int r = 0; r < 16; ++r) p1[r] = __builtin_amdgcn_exp2f(p1[r]);
  float ps = 0;
#pragma unroll
  for (int r = 0; r < 16; ++r) ps += p0[r];
#pragma unroll
  for (int r = 0; r < 16; ++r) ps += p1[r];
  { auto rr = __builtin_amdgcn_permlane32_swap(__float_as_uint(ps), __float_as_uint(ps), false, false);
    ps = __uint_as_float(rr[0]) + __uint_as_float(rr[1]); }
  l_reg = l_reg * alpha + ps;
#define PK4(P, BASE, OUT) do { unsigned a0 = cvtpk(P[BASE + 0], P[BASE + 1]), a1 = cvtpk(P[BASE + 2], P[BASE + 3]);   \
    unsigned b0 = cvtpk(P[BASE + 4], P[BASE + 5]), b1 = cvtpk(P[BASE + 6], P[BASE + 7]);                              \
    auto r0 = __builtin_amdgcn_permlane32_swap(a0, b0, false, false); auto r1 = __builtin_amdgcn_permlane32_swap(a1, b1, false, false); \
    u32x4 w = {r0[0], r1[0], r0[1], r1[1]}; OUT = *reinterpret_cast<bf16x8*>(&w); } while (0)
  PK4(p0, 0, pa0); PK4(p0, 8, pa1); PK4(p1, 0, pa2); PK4(p1, 8, pa3);
#undef PK4
}
__device__ __forceinline__ void qkt(f32x16& p0, f32x16& p1, const char* Ks, const bf16x8* qr, int r32, int hi) {
  p0 = f32x16{}; p1 = f32x16{};
#pragma unroll
  for (int d0 = 0; d0 < 8; ++d0) { const int cb = (d0 * 16 + hi * 8) * 2;
    const bf16x8 b0 = *reinterpret_cast<const bf16x8*>(Ks + KSWZ(r32, cb));
    const bf16x8 b1 = *reinterpret_cast<const bf16x8*>(Ks + KSWZ(32 + r32, cb));
    p0 = __builtin_amdgcn_mfma_f32_32x32x16_bf16(b0, qr[d0], p0, 0, 0, 0);
    p1 = __builtin_amdgcn_mfma_f32_32x32x16_bf16(b1, qr[d0], p1, 0, 0, 0); }
}
__device__ __forceinline__ int v_st(int k, int c) { const int kk = (k & ~0xC) | ((k & 4) << 1) | ((k & 8) >> 1); return ((kk >> 3) * 4 + (c >> 5)) * 512 + ((kk & 7) * 32 + (c & 31)) * 2; }
__device__ __forceinline__ int v_rd_base(int lane) { return ((lane & 3) << 3) | (((lane >> 2) & 3) << 6) | (((lane >> 4) & 1) << 5) | (((lane >> 5) & 1) << 8); }
constexpr int v_rd_off(int d0, int ks, int half) { return d0 * 512 + ks * 4096 + half * 2048; }
template <int OFF> __device__ __forceinline__ s16x4 tr_read(int vb) { s16x4 r; asm volatile("ds_read_b64_tr_b16 %0, %1 offset:%2" : "=&v"(r) : "v"(vb), "i"(OFF) : "memory"); return r; }
template <int D0> __device__ __forceinline__ void pv_one(f32x16& od, int vb, bf16x8 pa0, bf16x8 pa1, bf16x8 pa2, bf16x8 pa3) {
  const s16x4 l0 = tr_read<v_rd_off(D0, 0, 0)>(vb), h0 = tr_read<v_rd_off(D0, 0, 1)>(vb), l1 = tr_read<v_rd_off(D0, 1, 0)>(vb), h1 = tr_read<v_rd_off(D0, 1, 1)>(vb);
  const s16x4 l2 = tr_read<v_rd_off(D0, 2, 0)>(vb), h2 = tr_read<v_rd_off(D0, 2, 1)>(vb), l3 = tr_read<v_rd_off(D0, 3, 0)>(vb), h3 = tr_read<v_rd_off(D0, 3, 1)>(vb);
  asm volatile("s_waitcnt lgkmcnt(0)" ::: "memory"); SBAR();
#define PK(Lo, Hi) (bf16x8){Lo[0], Lo[1], Lo[2], Lo[3], Hi[0], Hi[1], Hi[2], Hi[3]}
  od = __builtin_amdgcn_mfma_f32_32x32x16_bf16(pa0, PK(l0, h0), od, 0, 0, 0);
  od = __builtin_amdgcn_mfma_f32_32x32x16_bf16(pa1, PK(l1, h1), od, 0, 0, 0);
  od = __builtin_amdgcn_mfma_f32_32x32x16_bf16(pa2, PK(l2, h2), od, 0, 0, 0);
  od = __builtin_amdgcn_mfma_f32_32x32x16_bf16(pa3, PK(l3, h3), od, 0, 0, 0);
#undef PK
}
__device__ __forceinline__ void pv_d0(f32x16* o, int vb, bf16x8 pa0, bf16x8 pa1, bf16x8 pa2, bf16x8 pa3) {
  pv_one<0>(o[0], vb, pa0, pa1, pa2, pa3); pv_one<1>(o[1], vb, pa0, pa1, pa2, pa3); pv_one<2>(o[2], vb, pa0, pa1, pa2, pa3); pv_one<3>(o[3], vb, pa0, pa1, pa2, pa3);
}

template <class Tiles>
__device__ __forceinline__ void attn_unit(const bf16_t* __restrict__ Qb, int ldq, const bf16_t* __restrict__ Kb, const bf16_t* __restrict__ Vb, int ldk,
                                          bf16_t* __restrict__ Ob, int ldo, const Tiles& T, int NT, bool has_sink, float sink, char* lds) {
  int tid = threadIdx.x; asm volatile("" : "+v"(tid));
  const int wid = __builtin_amdgcn_readfirstlane(tid >> 6), lane = tid & 63, r32 = lane & 31, hi = lane >> 5;
  char* V_lds = lds; char* K_lds = lds + 2 * SHM_V;
  float* ws = (float*)(lds + 2 * SHM_V + 2 * SHM_K) + wid * 64; float* li_l = ws; float* al_l = ws + 32;
  float m_reg = -1e30f, l_reg = 0; f32x16 o[4] = {}; bf16x8 qr[8];
  const bf16_t* Qw = Qb + (long)(wid * QBLK + r32) * ldq + hi * 8;
#pragma unroll
  for (int d0 = 0; d0 < 8; ++d0) qr[d0] = *reinterpret_cast<const bf16x8*>(Qw + d0 * 16);
  const int sr = tid >> 4, sc = (tid & 15) * 8, vst0 = v_st(sr, sc), vst1 = v_st(32 + sr, sc);
  const int vb0 = (int)(uintptr_t)V_lds + v_rd_base(lane);
  bf16x8 vs0, vs1, ks0, ks1;
#define SLOAD(j) do { const long _k0 = T.row(j); vs0 = *reinterpret_cast<const bf16x8*>(&Vb[(_k0 + sr) * ldk + sc]); vs1 = *reinterpret_cast<const bf16x8*>(&Vb[(_k0 + 32 + sr) * ldk + sc]); \
    ks0 = *reinterpret_cast<const bf16x8*>(&Kb[(_k0 + sr) * ldk + sc]); ks1 = *reinterpret_cast<const bf16x8*>(&Kb[(_k0 + 32 + sr) * ldk + sc]); } while (0)
#define SWRITE(b) do { *(bf16x8*)(V_lds + (b) * SHM_V + vst0) = vs0; *(bf16x8*)(V_lds + (b) * SHM_V + vst1) = vs1; const int kc = sc * 2; \
    *(bf16x8*)(K_lds + (b) * SHM_K + KSWZ(sr, kc)) = ks0; *(bf16x8*)(K_lds + (b) * SHM_K + KSWZ(32 + sr, kc)) = ks1; } while (0)
  __syncthreads();
  SLOAD(0); asm volatile("s_waitcnt vmcnt(0)" ::: "memory"); SWRITE(0);
  if (1 < NT) SLOAD(1);
#pragma unroll 1
  for (int j = 0; j < NT; ++j) {
    const int b = j & 1;
    __syncthreads();
    if (j + 1 < NT) { asm volatile("s_waitcnt vmcnt(0)" ::: "memory"); SWRITE(b ^ 1); if (j + 2 < NT) SLOAD(j + 2); }
    if (T.active(j, wid)) {
      f32x16 p0, p1; float mn, alpha; bf16x8 pa0, pa1, pa2, pa3;
      qkt(p0, p1, K_lds + b * SHM_K, qr, r32, hi); T.mask(p0, p1, j, wid, r32, hi);
      partialSM(p0, p1, m_reg, mn, alpha);
      if (__any(alpha < 1.f)) { if (hi == 0) al_l[r32] = alpha; asm volatile("s_waitcnt lgkmcnt(0)" ::: "memory");
#pragma unroll
        for (int d = 0; d < 4; ++d)
#pragma unroll
          for (int r = 0; r < 16; ++r) o[d][r] *= al_l[crow(r, hi)]; }
      finishSM(p0, p1, alpha, l_reg, pa0, pa1, pa2, pa3); SBAR();
      pv_d0(o, vb0 + b * (int)SHM_V, pa0, pa1, pa2, pa3);
    }
  }
  if (has_sink) { constexpr float C = SCALE * 1.4426950408889634f; l_reg += __builtin_amdgcn_exp2f(fmaf(sink, 1.4426950408889634f, -m_reg * C)); }
  if (hi == 0) li_l[r32] = l_reg; asm volatile("s_waitcnt lgkmcnt(0)" ::: "memory");
  float rli[16];
#pragma unroll
  for (int r = 0; r < 16; ++r) rli[r] = __builtin_amdgcn_rcpf(li_l[crow(r, hi)]);
  bf16_t* Ow = Ob + (long)(wid * QBLK) * ldo;
#pragma unroll
  for (int r = 0; r < 16; ++r) { const int orow = crow(r, hi);
#pragma unroll
    for (int d0 = 0; d0 < 4; ++d0) Ow[(long)orow * ldo + d0 * 32 + r32] = f2bf(o[d0][r] * rli[r]); }
#undef SLOAD
#undef SWRITE
}
#undef KSWZ
#undef SBAR

struct TilesGen {
  int mode, i0, lo, R, glo, nloc; const float* bias;
  __device__ __forceinline__ long row(int j) const {
    if (j < 4) return L + 64 * j;
    if (mode == 0) return lo + 64 * (j - 4);
    return (long)(glo + (j - 4)) * 64;
  }
  __device__ __forceinline__ bool active(int j, int wid) const {
    if (j < 4 || mode == 2) return true;
    if (mode == 0) { const int Tr = lo + 64 * (j - 4), q0 = i0 + 32 * wid; return Tr + 63 >= q0 - 128 && Tr <= q0 + 31 + 128; }
    const int kr = glo + (j - 4), qr = R + (wid >> 1);
    int r0 = qr - 4; r0 = r0 < 0 ? 0 : (r0 > 248 ? 248 : r0);
    return kr >= r0 && kr <= r0 + 7;
  }
  __device__ __forceinline__ void mask(f32x16& p0, f32x16& p1, int j, int wid, int r32, int hi) const {
    if (j < 4 || mode == 2) return;
    if (mode == 0) {
      const int Tr = lo + 64 * (j - 4), q0 = i0 + 32 * wid;
      if (q0 + 31 - Tr <= 128 && Tr + 63 - q0 <= 128) return;
      const int dq = q0 + r32 - Tr;
#pragma unroll
      for (int r = 0; r < 16; ++r) { const int kk = crow(r, hi); p0[r] = (kk >= dq - 128 && kk <= dq + 128) ? p0[r] : NEG; p1[r] = (kk + 32 >= dq - 128 && kk + 32 <= dq + 128) ? p1[r] : NEG; }
      return;
    }
    const int kr = glo + (j - 4), qr = R + (wid >> 1), qc = (wid & 1) * 32 + r32;
    int cs = qc - 8; cs = cs < 0 ? 0 : (cs > 48 ? 48 : cs);
    const float* bt = bias + (kr - qr + 7) * 32 + (15 - qc);
#pragma unroll
    for (int r = 0; r < 16; ++r) { const int k0 = crow(r, hi), k1 = k0 + 32;
      const bool v0 = (unsigned)(k0 - cs) < 16u, v1 = (unsigned)(k1 - cs) < 16u;
      p0[r] = v0 ? p0[r] + bt[v0 ? k0 : cs] : NEG; p1[r] = v1 ? p1[r] + bt[v1 ? k1 : cs] : NEG; }
  }
};
}

__device__ __forceinline__ void ph_attn_fast(const Ctx& c, int layer) {
  char* lds = (char*)c.smem;
  float* btab = (float*)(c.smem + fa::SHM_ATTN);
  const bf16_t* QWA = c.wsp<bf16_t>(WS_QWA); const bf16_t* KVWA = c.wsp<bf16_t>(WS_KVWA); bf16_t* YWA = c.wsp<bf16_t>(WS_YWA);
  const bf16_t* QNA = c.wsp<bf16_t>(WS_QNA); const bf16_t* KVNA = c.wsp<bf16_t>(WS_KVNA); bf16_t* YNA = c.wsp<bf16_t>(WS_YNA);
  const float* sinkp = c.in[20] + layer * 8; const float* rpb = c.in[23] + (size_t)layer * 8 * 15 * 31;
  const int nq = L / 256;
  const int nunits = 2 * 8 * nq + (layer == 0 ? 16 : 0);
#pragma unroll 1
  for (int u = c.bid; u < nunits; u += c.nb) {
    fa::TilesGen T; T.mode = 2; T.i0 = 0; T.lo = 0; T.R = 0; T.glo = 0; T.nloc = 0; T.bias = btab;
    int h, i0, NT; bool wa;
    if (u < 8 * nq) {
      wa = true; h = u / nq; i0 = (u % nq) * 256;
      const int lo = i0 - 128 < 0 ? 0 : i0 - 128, hiR = i0 + 384 > L ? L : i0 + 384;
      T.mode = 0; T.i0 = i0; T.lo = lo; NT = 4 + (hiR - lo) / 64;
    } else if (u < 16 * nq) {
      const int v = u - 8 * nq; wa = false; h = v / nq; const int qb = v % nq; i0 = qb * 256; const int R = qb * 4;
      int glo = R - 4; glo = glo < 0 ? 0 : (glo > 248 ? 248 : glo);
      int gh = R + 3 - 4; gh = gh < 0 ? 0 : (gh > 248 ? 248 : gh); gh += 7;
      T.mode = 1; T.R = R; T.glo = glo; T.nloc = gh - glo + 1; NT = 4 + T.nloc;
      __syncthreads();
      for (int e = c.tid; e < 15 * 32; e += NTHREADS) { const int dr = e >> 5, dc = e & 31; btab[e] = dc < 31 ? rpb[(h * 15 + dr) * 31 + dc] * (1.0f / fa::SCALE) : 0.f; }
    } else {
      const int v = u - 16 * nq; wa = v < 8; h = v & 7; i0 = L; NT = 4;
    }
    const bf16_t* Q = (wa ? QWA : QNA) + (size_t)i0 * 1024 + h * 128;
    const bf16_t* Kb = wa ? KVWA + (h >> 2) * 128 : KVNA + h * 128;
    const bf16_t* Vb = wa ? KVWA + 256 + (h >> 2) * 128 : KVNA + 1024 + h * 128;
    bf16_t* O = (wa ? YWA : YNA) + (size_t)i0 * 1024 + h * 128;
    fa::attn_unit(Q, 1024, Kb, Vb, wa ? 512 : 2048, O, 1024, T, NT, wa, wa ? sinkp[h] : 0.f, lds);
  }
}

__device__ __forceinline__ void ph_c(const Ctx& c, int layer) {
#ifndef NO_HY
    if (FAST_HY) {
        hyf::ThreadTw tw; hyf::tw_addr(c.tid, tw);
        { float s_, c_; sincospif(-2.0f * (float)c.tid / (float)hyf::FL, &s_, &c_); tw.w1 = (hyf::cpx){c_, s_};
          sincospif(-2.0f * (float)(c.tid & 15) / 512.0f, &s_, &c_); tw.w2 = (hyf::cpx){c_, s_};
          sincospif(-(float)c.tid / (float)hyf::FL, &s_, &c_); tw.wo = (hyf::cpx){c_, s_}; }
        for (int u = c.bid; u < 1024; u += c.nb) hyena_fft_unit(c, layer, u, tw);
    } else
    for (int u = c.bid; u < 1024; u += c.nb) hyena_direct_unit(c, layer, u);
#endif
#ifndef NO_HYC
    if (layer == 0) for (int u = c.bid; u < 1024; u += c.nb) hyena_ctx_unit(c, layer, u);
#endif
    __syncthreads();
#ifndef NO_ATT
    if (FAST_ATT) { ph_attn_fast(c, layer); return; }
    const int gw = c.bid * 8 + c.wave, ngw = c.nb * 8;
    float* wl = (float*)c.smem + c.wave * 768;
    const int nrows = layer == 0 ? MR : L;
    const float* sinkp = c.in[20] + layer * 8;
    const float* rpb = c.in[23] + (size_t)layer * 8 * 15 * 31;
    const bf16_t* kvwa = c.wsp<bf16_t>(WS_KVWA); const bf16_t* kvna = c.wsp<bf16_t>(WS_KVNA);
    for (int task = gw; task < nrows * 16; task += ngw) {
        const int r = task >> 4, hh = task & 15;
        if (hh < 8) {
            const int h = hh; const bf16_t* q = c.wsp<bf16_t>(WS_QWA) + (size_t)r * 1024 + h * 128; bf16_t* o = c.wsp<bf16_t>(WS_YWA) + (size_t)r * 1024 + h * 128;
            if (r < L) { const KeyWA k{kvwa, r, h >> 2}; wave_attn(q, 513, k, true, sinkp[h], o, wl, c.lane); }
            else { const KeyCtxWA k{kvwa, h >> 2}; wave_attn(q, 256, k, true, sinkp[h], o, wl, c.lane); }
        } else {
            const int h = hh - 8; const bf16_t* q = c.wsp<bf16_t>(WS_QNA) + (size_t)r * 1024 + h * 128; bf16_t* o = c.wsp<bf16_t>(WS_YNA) + (size_t)r * 1024 + h * 128;
            if (r < L) { const int gr = r / GRIDW, qc = r % GRIDW; int r0 = gr - 4; r0 = r0 < 0 ? 0 : (r0 > 248 ? 248 : r0); int cs = qc - 8; cs = cs < 0 ? 0 : (cs > 48 ? 48 : cs);
                const KeyNA k{kvna, rpb, gr, qc, r0, cs, h}; wave_attn(q, 384, k, false, 0.f, o, wl, c.lane); }
            else { const KeyCtxNA k{kvna, h}; wave_attn(q, 256, k, false, 0.f, o, wl, c.lane); }
        }
    }
#endif
}

__device__ __forceinline__ void ph_c2(const Ctx& c) {
    bf16_t* tile = (bf16_t*)c.smem;
    const bf16_t* src = c.wsp<bf16_t>(WS_YHYT); bf16_t* dst = c.wsp<bf16_t>(WS_YHY);
    for (int u = c.bid; u < (1024 / 64) * (L / 64); u += c.nb) {
        const int c0 = (u % 16) * 64, t0 = (u / 16) * 64;
        __syncthreads();
        for (int e = c.tid; e < 4096; e += NTHREADS) { const int cc = e >> 6, tt = e & 63; tile[cc * 66 + tt] = src[(size_t)(c0 + cc) * L + t0 + tt]; }
        __syncthreads();
        for (int e = c.tid; e < 4096; e += NTHREADS) { const int tt = e >> 6, cc = e & 63; dst[(size_t)(t0 + tt) * 1024 + c0 + cc] = tile[cc * 66 + tt]; }
    }
}

struct EpiMerge { unsigned char* ws; int b;
    __device__ __forceinline__ void operator()(int row, int col, const float (&v)[8]) const {
        const bf16_t* g = (const bf16_t*)(ws + WS_GATE) + (size_t)row * 6144 + b * 2048 + col;
        float* mp = (float*)(ws + WS_MPART) + (size_t)row * D + col;
        const uint4 gg = *(const uint4*)g;
        const float gv[8] = {__uint_as_float(gg.x << 16), __uint_as_float(gg.x & 0xffff0000u), __uint_as_float(gg.y << 16), __uint_as_float(gg.y & 0xffff0000u),
                             __uint_as_float(gg.z << 16), __uint_as_float(gg.z & 0xffff0000u), __uint_as_float(gg.w << 16), __uint_as_float(gg.w & 0xffff0000u)};
        float t[8];
        if (b == 0) {
#pragma unroll
            for (int j = 0; j < 8; ++j) t[j] = gv[j] * v[j];
        } else {
            const float4 p0 = *(const float4*)mp, p1 = *(const float4*)(mp + 4);
            const float pv[8] = {p0.x, p0.y, p0.z, p0.w, p1.x, p1.y, p1.z, p1.w};
#pragma unroll
            for (int j = 0; j < 8; ++j) t[j] = fmaf(gv[j], v[j], pv[j]);
        }
        if (b < 2) { *(float4*)mp = make_float4(t[0], t[1], t[2], t[3]); *(float4*)(mp + 4) = make_float4(t[4], t[5], t[6], t[7]); }
        else { uint4 o; o.x = pk2(t[0], t[1]); o.y = pk2(t[2], t[3]); o.z = pk2(t[4], t[5]); o.w = pk2(t[6], t[7]); *(uint4*)((bf16_t*)(ws + WS_MB) + (size_t)row * D + col) = o; }
    }
};
__device__ __forceinline__ void ph_d(const Ctx& c, int layer) {
    const int nM = MR / 128, nN = D / 128;
    for (int b = 0; b < 3; ++b) {
        const bf16_t* A = b == 0 ? c.wsp<bf16_t>(WS_YHY) : (b == 1 ? c.wsp<bf16_t>(WS_YWA) : c.wsp<bf16_t>(WS_YNA));
        const RowLin rp{A, 1024}; const EpiMerge ep{c.ws, b};
        const float* W = c.in[24] + ((size_t)layer * 3 + b) * 1024 * D;
        for (int u = c.bid; u < nM * nN; u += c.nb) sgemm_unit(rp, W, D, 1024, (u % nM) * 128, (u / nM) * 128, ep, (float*)c.smem, c.tid);
    }
}
struct EpiOut { const Ctx* c; int layer;
    __device__ __forceinline__ void operator()(int row, int col, const float (&v)[8]) const {
        const float* xin = c->xrow(layer, row) + col; const float* g = c->mod(layer, row < L ? 0 : 1, 2) + col;
        float* o = (float*)(c->ws + WS_XA) + (size_t)row * D + col;
        const float4 x0 = *(const float4*)xin, x1 = *(const float4*)(xin + 4), g0 = *(const float4*)g, g1 = *(const float4*)(g + 4);
        *(float4*)o = make_float4(x0.x + g0.x * v[0], x0.y + g0.y * v[1], x0.z + g0.z * v[2], x0.w + g0.w * v[3]);
        *(float4*)(o + 4) = make_float4(x1.x + g1.x * v[4], x1.y + g1.y * v[5], x1.z + g1.z * v[6], x1.w + g1.w * v[7]);
    }
};
__device__ __forceinline__ void ph_e(const Ctx& c, int layer) {
    const int nM = MR / 128, nN = D / 128;
    const RowLin rp{c.wsp<bf16_t>(WS_MB), D}; const EpiOut ep{&c, layer};
    const float* W = c.in[25] + (size_t)layer * D * D;
    for (int u = c.bid; u < nM * nN; u += c.nb) sgemm_unit(rp, W, D, D, (u % nM) * 128, (u / nM) * 128, ep, (float*)c.smem, c.tid);
}

__device__ __forceinline__ void ph_f(const Ctx& c, int layer) {
    const int gw = c.bid * 8 + c.wave, ngw = c.nb * 8;
    const float* g = c.in[26] + (size_t)layer * D;
    const float* wr = c.in[27] + (size_t)layer * D * NE;
    for (int r = gw; r < MR; r += ngw) {
        const float* x = c.wsp<float>(WS_XA) + (size_t)r * D;
        const int src = r < L ? 0 : 1;
        const float* sh = c.mod(layer, src, 3); const float* sc = c.mod(layer, src, 4);
        float4 v[8]; float ss = 0.f;
#pragma unroll
        for (int j = 0; j < 8; ++j) { v[j] = *(const float4*)(x + 4 * c.lane + 256 * j); ss += v[j].x * v[j].x + v[j].y * v[j].y + v[j].z * v[j].z + v[j].w * v[j].w; }
        ss = wave_sum(ss);
        const float inv = rsqrtf(ss * (1.0f / D) + RMS_EPS);
        bf16_t* o = c.wsp<bf16_t>(WS_H2) + (size_t)r * D;
        float lg[NE];
#pragma unroll
        for (int e = 0; e < NE; ++e) lg[e] = 0.f;
#pragma unroll
        for (int j = 0; j < 8; ++j) {
            const int col = 4 * c.lane + 256 * j;
            const float4 gg = *(const float4*)(g + col), s4 = *(const float4*)(sh + col), c4 = *(const float4*)(sc + col);
            const float y[4] = {v[j].x * inv * gg.x * (1.f + c4.x) + s4.x, v[j].y * inv * gg.y * (1.f + c4.y) + s4.y,
                                v[j].z * inv * gg.z * (1.f + c4.z) + s4.z, v[j].w * inv * gg.w * (1.f + c4.w) + s4.w};
            uint2 w; w.x = pk2(y[0], y[1]); w.y = pk2(y[2], y[3]);
            *(uint2*)(o + col) = w;
#pragma unroll
            for (int q = 0; q < 4; ++q) {
                const float4* wp = (const float4*)(wr + (size_t)(col + q) * NE);
#pragma unroll
                for (int e4 = 0; e4 < 4; ++e4) { const float4 w4 = wp[e4]; lg[e4 * 4 + 0] = fmaf(y[q], w4.x, lg[e4 * 4 + 0]); lg[e4 * 4 + 1] = fmaf(y[q], w4.y, lg[e4 * 4 + 1]); lg[e4 * 4 + 2] = fmaf(y[q], w4.z, lg[e4 * 4 + 2]); lg[e4 * 4 + 3] = fmaf(y[q], w4.w, lg[e4 * 4 + 3]); }
            }
        }
        float mx = -3e38f;
#pragma unroll
        for (int e = 0; e < NE; ++e) { lg[e] = wave_sum(lg[e]); mx = fmaxf(mx, lg[e]); }
        float sum = 0.f;
#pragma unroll
        for (int e = 0; e < NE; ++e) { lg[e] = expf(lg[e] - mx); sum += lg[e]; }
        float mine = 0.f;
#pragma unroll
        for (int e = 0; e < NE; ++e) mine = (c.lane == e) ? lg[e] / sum : mine;
        if (c.lane < NE) c.wsp<float>(WS_AFF)[(size_t)r * NE + c.lane] = mine;
    }
}

__device__ __forceinline__ void topk_unit(const Ctx& c, int e, int row0, int n, int K, int slot0) {
    unsigned* keys = (unsigned*)c.smem;
    unsigned* hist = keys + L;
    unsigned* sh = hist + 256;
    const int tid = c.tid, lane = c.lane, wave = c.wave;
    const float* aff = c.wsp<float>(WS_AFF);
    __syncthreads();
#pragma unroll 4
    for (int t = tid; t < n; t += NTHREADS) keys[t] = __float_as_uint(aff[(size_t)(row0 + t) * NE + e]);
    unsigned prefix = 0u, mask = 0u, need = (unsigned)K;
#pragma unroll 1
    for (int pass = 0; pass < 4; ++pass) {
        const int shift = 24 - 8 * pass;
        __syncthreads();
        if (tid < 256) hist[tid] = 0u;
        __syncthreads();
#pragma unroll 4
        for (int t = tid; t < n; t += NTHREADS) { const unsigned k = keys[t]; if ((k & mask) == prefix) atomicAdd(&hist[(k >> shift) & 255u], 1u); }
        __syncthreads();
        if (tid == 0) {
            unsigned cum = 0u; int b = 255;
            for (; b > 0; --b) { if (cum + hist[b] >= need) break; cum += hist[b]; }
            sh[0] = prefix | ((unsigned)b << shift); sh[1] = need - cum;
        }
        __syncthreads();
        prefix = sh[0]; need = sh[1]; mask |= 255u << shift;
    }
    const unsigned T = prefix; const unsigned cnt_gt = (unsigned)K - need;
    int* IDX = c.wsp<int>(WS_IDX) + (size_t)e * SLOTS; float* GS = c.wsp<float>(WS_GSEL) + (size_t)e * SLOTS; int* SL = c.wsp<int>(WS_SLOT) + (size_t)e * MR;
    unsigned base_gt = 0u, base_eq = 0u;
    const int rounds = (n + NTHREADS - 1) / NTHREADS;
#pragma unroll 1
    for (int j = 0; j < rounds; ++j) {
        const int t = tid + NTHREADS * j;
        const bool valid = t < n; const unsigned kj = valid ? keys[t] : 0u;
        const bool gt = valid && kj > T, eq = valid && kj == T;
        const unsigned long long mg = __ballot(gt), me = __ballot(eq);
        const unsigned long long lower = (lane == 0) ? 0ull : (~0ull >> (64 - lane));
        const unsigned rg = (unsigned)__popcll(mg & lower), re = (unsigned)__popcll(me & lower);
        __syncthreads();
        if (lane == 0) { sh[8 + wave] = (unsigned)__popcll(mg); sh[16 + wave] = (unsigned)__popcll(me); }
        __syncthreads();
        unsigned og = 0u, oe = 0u, tg = 0u, te = 0u;
#pragma unroll
        for (int w = 0; w < 8; ++w) { const unsigned a = sh[8 + w], b2 = sh[16 + w]; if (w < wave) { og += a; oe += b2; } tg += a; te += b2; }
        int slot = -1;
        if (gt) slot = (int)(base_gt + og + rg);
        else if (eq) { const unsigned rk = base_eq + oe + re; if (rk < need) slot = (int)(cnt_gt + rk); }
        if (valid) { SL[row0 + t] = slot >= 0 ? slot0 + slot : -1; if (slot >= 0) { IDX[slot0 + slot] = row0 + t; GS[slot0 + slot] = __uint_as_float(kj); } }
        base_gt += tg; base_eq += te;
    }
}
__device__ __forceinline__ void ph_g(const Ctx& c) {
    for (int u = c.bid; u < 32; u += c.nb) {
        if (u < 16) topk_unit(c, u, 0, L, CAP, 0);
        else { const int e = u - 16; topk_unit(c, e, L, LC, CAPC, CAP);
            for (int s = CAP + CAPC + c.tid; s < SLOTS; s += NTHREADS) { c.wsp<int>(WS_IDX)[(size_t)e * SLOTS + s] = 0; c.wsp<float>(WS_GSEL)[(size_t)e * SLOTS + s] = 0.f; } }
    }
}

struct EpiGate { float* tmp; __device__ __forceinline__ void operator()(int row, int col, const float (&v)[8]) const {
    float* p = tmp + (size_t)row * DF + col; *(float4*)p = make_float4(v[0], v[1], v[2], v[3]); *(float4*)(p + 4) = make_float4(v[4], v[5], v[6], v[7]); } };
struct EpiUp { const float* tmp; bf16_t* act; __device__ __forceinline__ void operator()(int row, int col, const float (&v)[8]) const {
    const float* p = tmp + (size_t)row * DF + col; const float4 a0 = *(const float4*)p, a1 = *(const float4*)(p + 4);
    const float a[8] = {a0.x, a0.y, a0.z, a0.w, a1.x, a1.y, a1.z, a1.w}; float t[8];
#pragma unroll
    for (int j = 0; j < 8; ++j) t[j] = silu_f(a[j]) * v[j];
    uint4 o; o.x = pk2(t[0], t[1]); o.y = pk2(t[2], t[3]); o.z = pk2(t[4], t[5]); o.w = pk2(t[6], t[7]);
    *(uint4*)(act + (size_t)row * DF + col) = o; } };
struct EpiDown { bf16_t* ye; __device__ __forceinline__ void operator()(int row, int col, const float (&v)[8]) const {
    uint4 o; o.x = pk2(v[0], v[1]); o.y = pk2(v[2], v[3]); o.z = pk2(v[4], v[5]); o.w = pk2(v[6], v[7]);
    *(uint4*)(ye + (size_t)row * D + col) = o; } };
__device__ __forceinline__ void ph_h(const Ctx& c, int layer) {
    const int nM = SLOTS / 128, nN = DF / 128;
    for (int which = 0; which < 2; ++which)
        for (int u = c.bid; u < NE * nM * nN; u += c.nb) {
            const int e = u / (nM * nN), r = u % (nM * nN), pm = r % nM, pn = r / nM;
            const RowGather rp{c.wsp<bf16_t>(WS_H2), D, c.wsp<int>(WS_IDX) + (size_t)e * SLOTS};
            float* tmp = c.wsp<float>(WS_TMP) + (size_t)e * SLOTS * DF;
            const float* W = c.in[which == 0 ? 28 : 29] + ((size_t)layer * NE + e) * D * DF;
            if (which == 0) { const EpiGate ep{tmp}; sgemm_unit(rp, W, DF, D, pm * 128, pn * 128, ep, (float*)c.smem, c.tid); }
            else { const EpiUp ep{tmp, c.wsp<bf16_t>(WS_ACT) + (size_t)e * SLOTS * DF}; sgemm_unit(rp, W, DF, D, pm * 128, pn * 128, ep, (float*)c.smem, c.tid); }
        }
}
__device__ __forceinline__ void ph_i(const Ctx& c, int layer) {
    const int nM = SLOTS / 128, nN = D / 128;
    for (int u = c.bid; u < NE * nM * nN; u += c.nb) {
        const int e = u / (nM * nN), r = u % (nM * nN), pm = r % nM, pn = r / nM;
        const RowLin rp{c.wsp<bf16_t>(WS_ACT) + (size_t)e * SLOTS * DF, DF};
        const EpiDown ep{c.wsp<bf16_t>(WS_YE) + (size_t)e * SLOTS * D};
        const float* W = c.in[30] + ((size_t)layer * NE + e) * DF * D;
        sgemm_unit(rp, W, D, DF, pm * 128, pn * 128, ep, (float*)c.smem, c.tid);
    }
}

__device__ __forceinline__ void ph_j(const Ctx& c, int layer) {
    const int gw = c.bid * 8 + c.wave, ngw = c.nb * 8;
    const int nrows = layer == 0 ? MR : L;
    for (int r = gw; r < nrows; r += ngw) {
        const float* x1 = c.wsp<float>(WS_XA) + (size_t)r * D;
        const float* g5 = c.mod(layer, r < L ? 0 : 1, 5);
        float* o = layer == 0 ? c.wsp<float>(WS_XB) + (size_t)r * D : c.out + (size_t)r * D;
        float acc[32];
#pragma unroll
        for (int j = 0; j < 32; ++j) acc[j] = 0.f;
        for (int e = 0; e < NE; ++e) {
            const int s = c.wsp<int>(WS_SLOT)[(size_t)e * MR + r];
            if (s >= 0) {
                const float gs = c.wsp<float>(WS_GSEL)[(size_t)e * SLOTS + s];
                const bf16_t* y = c.wsp<bf16_t>(WS_YE) + ((size_t)e * SLOTS + s) * D;
#pragma unroll
                for (int j = 0; j < 8; ++j) { const uint2 w = *(const uint2*)(y + 4 * c.lane + 256 * j);
                    acc[4 * j + 0] = fmaf(gs, __uint_as_float(w.x << 16), acc[4 * j + 0]); acc[4 * j + 1] = fmaf(gs, __uint_as_float(w.x & 0xffff0000u), acc[4 * j + 1]);
                    acc[4 * j + 2] = fmaf(gs, __uint_as_float(w.y << 16), acc[4 * j + 2]); acc[4 * j + 3] = fmaf(gs, __uint_as_float(w.y & 0xffff0000u), acc[4 * j + 3]); }
            }
        }
#pragma unroll
        for (int j = 0; j < 8; ++j) { const int col = 4 * c.lane + 256 * j; const float4 xv = *(const float4*)(x1 + col), gv = *(const float4*)(g5 + col);
            *(float4*)(o + col) = make_float4(xv.x + gv.x * acc[4 * j], xv.y + gv.y * acc[4 * j + 1], xv.z + gv.z * acc[4 * j + 2], xv.w + gv.w * acc[4 * j + 3]); }
    }
}


#ifndef FAST_B
#define FAST_B 1
#endif
#ifndef FAST_DE
#define FAST_DE 1
#endif
#ifndef FAST_HI
#define FAST_HI 1
#endif
__device__ __forceinline__ void ph_b_fast(const Ctx& c, int layer) {
    LAS unsigned char* lds = (LAS unsigned char*)c.smem;
    const char* WIN = (const char*)(c.ws + WS_WIN); const char* HX = (const char*)(c.ws + WS_HX);
    __syncthreads();
    {
        const pg8::GeomLin G{WIN, HX, D, D, D, nullptr}; pg8::StaticOrder S; S.init(3072 / 256, MR / 256, c.nb, c.bid);
        const pg8::EpiBf16Plain E{c.wsp<bf16_t>(WS_ZHYT), MR, 0};
        pg8::gemm_phase(lds, G, S, E);
    }
    {
        const pg8::GeomLin G{HX, WIN + (size_t)OFF_WAQ * D * 2, D, D, D, nullptr}; pg8::StaticOrder S; S.init(MR / 256, (NIN - OFF_WAQ) / 256, c.nb, c.bid);
        const pg8::EpiInRest E{c.ws};
        pg8::gemm_phase(lds, G, S, E);
    }
}
__device__ __forceinline__ void ph_d_fast(const Ctx& c, int layer) {
    LAS unsigned char* lds = (LAS unsigned char*)c.smem;
    const int nM = layer == 0 ? MR / 256 : L / 256;
    pg8::StaticOrder S; S.init(nM, D / 256, c.nb, c.bid);
    __syncthreads();
    { const pg8::GeomLin G{(const char*)(c.ws + WS_YHY), (const char*)(c.ws + WS_WBR), 1024, 1024, 1024, nullptr}; const pg8::EpiMergeF<0> E{c.ws}; pg8::gemm_phase(lds, G, S, E); }
    { const pg8::GeomLin G{(const char*)(c.ws + WS_YWA), (const char*)(c.ws + WS_WBR) + (size_t)D * 1024 * 2, 1024, 1024, 1024, nullptr}; const pg8::EpiMergeF<1> E{c.ws}; pg8::gemm_phase(lds, G, S, E); }
    { const pg8::GeomLin G{(const char*)(c.ws + WS_YNA), (const char*)(c.ws + WS_WBR) + (size_t)2 * D * 1024 * 2, 1024, 1024, 1024, nullptr}; const pg8::EpiMergeF<2> E{c.ws}; pg8::gemm_phase(lds, G, S, E); }
}
__device__ __forceinline__ void ph_e_fast(const Ctx& c, int layer) {
    LAS unsigned char* lds = (LAS unsigned char*)c.smem;
    const int nM = layer == 0 ? MR / 256 : L / 256;
    pg8::StaticOrder S; S.init(nM, D / 256, c.nb, c.bid);
    __syncthreads();
    const pg8::GeomLin G{(const char*)(c.ws + WS_MB), (const char*)(c.ws + WS_WOUT), D, D, D, nullptr}; const pg8::EpiOutF E{&c, layer};
    pg8::gemm_phase(lds, G, S, E);
}
__device__ __forceinline__ void ph_h_fast(const Ctx& c, int layer) {
    LAS unsigned char* lds = (LAS unsigned char*)c.smem;
    const int tpe = layer == 0 ? 9 : 8;
    pg8::StaticOrder S; S.init(NE * tpe, 2048 / 256, c.nb, c.bid);
    __syncthreads();
    const pg8::GeomExpert<true> G{(const char*)(c.ws + WS_H2), (const char*)(c.ws + WS_WGU), D, D, D, c.wsp<int>(WS_IDX), tpe, 2048};
    const pg8::EpiGU E{c.wsp<bf16_t>(WS_ACT)};
    pg8::gemm_phase(lds, G, S, E);
}
__device__ __forceinline__ void ph_i_fast(const Ctx& c, int layer) {
    LAS unsigned char* lds = (LAS unsigned char*)c.smem;
    const int tpe = layer == 0 ? 9 : 8;
    pg8::StaticOrder S; S.init(NE * tpe, D / 256, c.nb, c.bid);
    __syncthreads();
    const pg8::GeomExpert<false> G{(const char*)(c.ws + WS_ACT), (const char*)(c.ws + WS_WDN), DF, DF, DF, nullptr, tpe, D};
    const pg8::EpiBf16Plain E{c.wsp<bf16_t>(WS_YE), D, 0};
    pg8::gemm_phase(lds, G, S, E);
}

__global__ void __launch_bounds__(NTHREADS, 2) mega(KArgs a) {
    extern __shared__ __attribute__((aligned(16))) unsigned char smem[];
    Ctx c; c.in = a.in; c.out = a.out; c.ws = a.ws; c.bid = blockIdx.x; c.nb = gridDim.x; c.tid = threadIdx.x; c.lane = c.tid & 63;
    c.wave = __builtin_amdgcn_readfirstlane(c.tid >> 6); c.smem = smem;
    volatile LAS unsigned* st = (volatile LAS unsigned*)(LAS unsigned char*)(smem + LDS_BYTES - 16);
    if (c.tid == 0) { st[0] = 0u; st[1] = 0u; st[2] = 0u; st[3] = 0u; }
    __syncthreads();
    const int lo = a.ph_lo, hi = a.ph_hi;
    XcdBarrier bar; bar.bar = (unsigned*)(a.ws + WS_CTL); bar.x = 0; bar.st = st;
    if (hi - lo > 1) bar = xcd_barrier_post((unsigned*)(a.ws + WS_CTL), st);
#ifndef ONLY_PH
#define ONLY_PH -1
#endif
#define PSEL(j) (ONLY_PH < 0 || ONLY_PH == (j))
#define IN(k) (lo <= (k) && (k) < hi)
#define LAUNDER(cc) Ctx cc = c; asm volatile("" : "+v"(cc.tid), "+v"(cc.lane)); asm volatile("" : "+s"(cc.bid), "+s"(cc.nb), "+s"(cc.wave), "+s"(cc.ws), "+s"(cc.out))
#define SEAM(k) do { if (IN(k) && IN((k) + 1)) xcd_barrier(bar); } while (0)
    if (PSEL(0) && IN(0)) { LAUNDER(cc); ph_g0(cc); } SEAM(0);
#define LAYER_PROGRAM(layer) do { const int b = 1 + (layer) * PH_PER_LAYER; \
        if (PSEL(1) && IN(b + 0)) { LAUNDER(cc); constexpr int ly = (layer); ph_a(cc, ly); if (FAST_B || FAST_DE || FAST_HI) ph_conv(cc, ly); } SEAM(b + 0); \
        if (PSEL(2) && IN(b + 1)) { LAUNDER(cc); constexpr int ly = (layer); if (FAST_B) ph_b_fast(cc, ly); else ph_b(cc, ly); } SEAM(b + 1); \
        if (PSEL(3) && IN(b + 2)) { LAUNDER(cc); constexpr int ly = (layer); ph_b2(cc, ly); } SEAM(b + 2); \
        if (PSEL(4) && IN(b + 3)) { LAUNDER(cc); constexpr int ly = (layer); ph_c(cc, ly); } SEAM(b + 3); \
        if (PSEL(5) && IN(b + 4)) { LAUNDER(cc); constexpr int ly = (layer); ph_c2(cc); } SEAM(b + 4); \
        if (PSEL(6) && IN(b + 5)) { LAUNDER(cc); constexpr int ly = (layer); if (FAST_DE) ph_d_fast(cc, ly); else ph_d(cc, ly); } SEAM(b + 5); \
        if (PSEL(7) && IN(b + 6)) { LAUNDER(cc); constexpr int ly = (layer); if (FAST_DE) ph_e_fast(cc, ly); else ph_e(cc, ly); } SEAM(b + 6); \
        if (PSEL(8) && IN(b + 7)) { LAUNDER(cc); constexpr int ly = (layer); ph_f(cc, ly); } SEAM(b + 7); \
        if (PSEL(9) && IN(b + 8)) { LAUNDER(cc); constexpr int ly = (layer); ph_g(cc); } SEAM(b + 8); \
        if (PSEL(10) && IN(b + 9)) { LAUNDER(cc); constexpr int ly = (layer); if (FAST_HI) ph_h_fast(cc, ly); else ph_h(cc, ly); } SEAM(b + 9); \
        if (PSEL(11) && IN(b + 10)) { LAUNDER(cc); constexpr int ly = (layer); if (FAST_HI) ph_i_fast(cc, ly); else ph_i(cc, ly); } SEAM(b + 10); \
        if (PSEL(12) && IN(b + 11)) { LAUNDER(cc); constexpr int ly = (layer); ph_j(cc, ly); } SEAM(b + 11); \
    } while (0)
    LAYER_PROGRAM(0);
    LAYER_PROGRAM(1);
#undef LAYER_PROGRAM
#undef IN
#undef SEAM
}

extern "C" void kernel_launch(void* const* d_in, const int* in_sizes, int n_in, void* d_out, int out_size, void* d_ws, size_t ws_size, hipStream_t stream) {
    static int grid = 0;
    if (grid == 0) {
        if (n_in != 31 || out_size != L * D || ws_size < WS_END) { fprintf(stderr, "kernel_launch: unexpected shapes: n_in %d out %d ws %zu (need %zu)\n", n_in, out_size, ws_size, (size_t)WS_END); grid = -1; return; }
        int dev = 0, cus = 0, per_cu = 0;
        if (hipGetDevice(&dev) != hipSuccess || hipDeviceGetAttribute(&cus, hipDeviceAttributeMultiprocessorCount, dev) != hipSuccess) { grid = -1; return; }
        if (hipFuncSetAttribute((const void*)mega, hipFuncAttributeMaxDynamicSharedMemorySize, LDS_BYTES) != hipSuccess) { fprintf(stderr, "kernel_launch: hipFuncSetAttribute failed\n"); grid = -1; return; }
        if (hipOccupancyMaxActiveBlocksPerMultiprocessor(&per_cu, (const void*)mega, NTHREADS, LDS_BYTES) != hipSuccess || per_cu < 1) fprintf(stderr, "kernel_launch: occupancy query says %d\n", per_cu);
        (void)hipGetLastError();
        grid = cus;
    }
    if (grid < 0) return;
    if (hipMemsetAsync((char*)d_ws + WS_CTL, 0, CTL_BYTES, stream) != hipSuccess) return;
    KArgs a{};
    for (int i = 0; i < 31; ++i) a.in[i] = (const float*)d_in[i];
    a.out = (float*)d_out; a.ws = (unsigned char*)d_ws;
#if ONE_LAUNCH
    a.ph_lo = 0; a.ph_hi = NPH;
    hipLaunchKernelGGL(mega, dim3(grid), dim3(NTHREADS), LDS_BYTES, stream, a);
#else
    for (int p = 0; p < NPH; ++p) { a.ph_lo = p; a.ph_hi = p + 1; hipLaunchKernelGGL(mega, dim3(grid), dim3(NTHREADS), LDS_BYTES, stream, a); }
#endif
    const hipError_t le = hipPeekAtLastError();
    if (le != hipSuccess) fprintf(stderr, "kernel_launch: launch failed: %s\n", hipGetErrorName(le));
}
```

```cpp
#include <hip/hip_runtime.h>
#include <stdint.h>
#include <stdio.h>

#ifndef ONE_LAUNCH
#define ONE_LAUNCH 1
#endif

typedef unsigned short bf16_t;
#define LAS __attribute__((address_space(3)))

constexpr int L = 16384, LC = 256, MR = L + LC, D = 2048, NIN = 13824;
constexpr int HD = 128, GRIDW = 64;
constexpr int OFF_HY = 0, OFF_WAQ = 3072, OFF_WAKV = 4096, OFF_NAQ = 4608, OFF_NAKV = 5632, OFF_GATE = 7680;
constexpr int NE = 16, CAP = 2048, CAPC = 32, SLOTS = 2304, DF = 1024;
constexpr int NMOD = 6 * D;
constexpr float RMS_EPS = 1e-6f;
constexpr float QK_SCALE = 0.08838834764831845f;

constexpr size_t al256(size_t x) { return (x + 255) & ~(size_t)255; }
constexpr size_t WS_CTL = 0, CTL_BYTES = 1u << 20;
constexpr size_t WS_MOD = WS_CTL + CTL_BYTES;
constexpr size_t WS_H2B = WS_MOD + al256((size_t)2 * 2 * NMOD * 4);
constexpr size_t WS_FW3T = WS_H2B + al256((size_t)2 * MR * 256 * 2);
constexpr size_t WS_AFF = WS_FW3T + al256((size_t)2 * 4096 * 256 * 2);
constexpr size_t WS_IDX = WS_AFF + al256((size_t)MR * 16 * 4);
constexpr size_t WS_GSEL = WS_IDX + al256((size_t)NE * SLOTS * 4);
constexpr size_t WS_SLOT = WS_GSEL + al256((size_t)NE * SLOTS * 4);
constexpr size_t WS_KFC = WS_SLOT + al256((size_t)NE * MR * 4);
constexpr size_t WS_ZHYC = WS_KFC + al256((size_t)4096 * LC * 2);
constexpr size_t WS_XA = WS_ZHYC + al256((size_t)3072 * LC * 2);
constexpr size_t WS_XB = WS_XA + al256((size_t)MR * D * 4);
constexpr size_t WS_W = WS_XB + al256((size_t)MR * D * 4);
constexpr size_t W_BYTES = (size_t)2 * ((size_t)NIN * D + 3 * (size_t)D * 1024 + (size_t)D * D + (size_t)NE * 2048 * D + (size_t)NE * D * DF);
constexpr size_t WS_WIN = WS_W;
constexpr size_t WS_WBR = WS_WIN + (size_t)NIN * D * 2;
constexpr size_t WS_WOUT = WS_WBR + (size_t)3 * D * 1024 * 2;
constexpr size_t WS_WGU = WS_WOUT + (size_t)D * D * 2;
constexpr size_t WS_WDN = WS_WGU + (size_t)NE * 2048 * D * 2;
constexpr size_t WS_R3 = WS_W + al256(W_BYTES);
constexpr size_t R3_BYTES = (size_t)MR * D * 4 + (size_t)MR * D * 2;
constexpr size_t WS_KF = WS_R3;
constexpr size_t WS_KS = WS_R3 + al256((size_t)4096 * L * 2);
constexpr size_t WS_MPART = WS_R3;
constexpr size_t WS_MB = WS_R3 + (size_t)MR * D * 4;
constexpr size_t WS_TMP = WS_R3;
constexpr size_t WS_YE = WS_R3;
constexpr size_t WS_R4 = WS_R3 + al256(R3_BYTES);
constexpr size_t R4_BYTES = (size_t)MR * 6144 * 2;
constexpr size_t WS_GATE = WS_R4;
constexpr size_t WS_H2 = WS_R4;
constexpr size_t WS_ACT = WS_R4 + al256((size_t)MR * D * 2);
constexpr size_t WS_R5 = WS_R4 + al256(R4_BYTES);
constexpr size_t WS_HX = WS_R5;
constexpr size_t WS_YHYT = WS_R5;
constexpr size_t WS_YHY = WS_R5 + al256((size_t)1024 * L * 2);
constexpr size_t WS_ZHYT = WS_R5 + al256((size_t)MR * D * 2);
constexpr size_t WS_QWA = WS_ZHYT + al256((size_t)3072 * MR * 2);
constexpr size_t WS_KVWA = WS_QWA + al256((size_t)MR * 1024 * 2);
constexpr size_t WS_QNA = WS_KVWA + al256((size_t)MR * 512 * 2);
constexpr size_t WS_KVNA = WS_QNA + al256((size_t)MR * 1024 * 2);
constexpr size_t WS_YWA = WS_KVNA + al256((size_t)MR * 2048 * 2);
constexpr size_t WS_YNA = WS_YWA + al256((size_t)MR * 1024 * 2);
constexpr size_t WS_END = WS_YNA + al256((size_t)MR * 1024 * 2);
static_assert((size_t)1024 * L * 2 + (size_t)MR * 1024 * 2 <= (size_t)MR * D * 2 + 512, "YHYT+YHY overlay HX");
static_assert((size_t)4096 * L * 2 + 256 + (size_t)256 * 2 * 16384 * 8 <= R3_BYTES && (size_t)NE * SLOTS * D * 2 <= R3_BYTES && (size_t)NE * SLOTS * DF * 4 <= R3_BYTES, "R3");
static_assert((size_t)MR * D * 2 + 256 + (size_t)NE * SLOTS * DF * 2 <= R4_BYTES, "R4");

constexpr int LDS_BYTES = 160 * 1024;
constexpr int NTHREADS = 512;
constexpr int PH_PER_LAYER = 12, NPH = 1 + 2 * PH_PER_LAYER;

__device__ __forceinline__ float bf2f(bf16_t b) { return __uint_as_float(((unsigned)b) << 16); }
__device__ __forceinline__ bf16_t f2bf(float f) { unsigned u = __float_as_uint(f); u += 0x7fffu + ((u >> 16) & 1u); return (bf16_t)(u >> 16); }
__device__ __forceinline__ unsigned pk2(float lo, float hi) { return (unsigned)f2bf(lo) | ((unsigned)f2bf(hi) << 16); }
__device__ __forceinline__ float wave_sum(float v) {
#pragma unroll
    for (int o = 1; o < 64; o <<= 1) v += __shfl_xor(v, o);
    return v;
}
__device__ __forceinline__ float wave_max(float v) {
#pragma unroll
    for (int o = 1; o < 64; o <<= 1) v = fmaxf(v, __shfl_xor(v, o));
    return v;
}
__device__ __forceinline__ float silu_f(float x) { return x / (1.f + __expf(-x)); }
__device__ __forceinline__ float sigmoid_f(float x) { return 1.f / (1.f + __expf(-x)); }
#define LDS_FENCE() asm volatile("s_waitcnt lgkmcnt(0)" ::: "memory")

#define XB_TMO      128
#define XB_XCNT(j)  (256  + 64 * (j))
#define XB_XSUB(j)  (1280 + 64 * (j))
#define XB_XGEN(j)  (2304 + 64 * (j))
#define XB_TOP      3328
#define XB_TOPGEN   3392
#define XCD_BAR_WORDS 3456
#define XB_SPIN_CAP (1u << 22)

__device__ __forceinline__ unsigned xb_ld(unsigned* p)              { return __hip_atomic_load(p, __ATOMIC_RELAXED, __HIP_MEMORY_SCOPE_AGENT); }
__device__ __forceinline__ unsigned xb_add(unsigned* p, unsigned v) { return __hip_atomic_fetch_add(p, v, __ATOMIC_RELAXED, __HIP_MEMORY_SCOPE_AGENT); }
__device__ __forceinline__ unsigned xb_xcc_id() { return (unsigned)__builtin_amdgcn_s_getreg((3 << 11) | 20) & 0xFu; }
#define XB_SPIN(cond, bar) do { unsigned _sp = 0; while (cond) { __builtin_amdgcn_s_sleep(1); \
    if ((++_sp & 255u) == 0u) { if (xb_ld(&(bar)[XB_TMO])) break; if (_sp > XB_SPIN_CAP) { atomicAdd(&(bar)[XB_TMO], 1u); break; } } } } while (0)

struct XcdBarrier { unsigned* bar; unsigned x; volatile LAS unsigned* st; };

__device__ __forceinline__ XcdBarrier xcd_barrier_post(unsigned* bar, volatile LAS unsigned* st) {
    XcdBarrier b; b.bar = bar; b.x = xb_xcc_id(); b.st = st;
    if (threadIdx.x == 0) (void)xb_add(&bar[XB_XCNT(b.x)], 1u);
    return b;
}
__device__ __forceinline__ void xcd_barrier_complete(unsigned* bar, unsigned x, unsigned& nloc, unsigned& nx) {
    const unsigned G = gridDim.x * gridDim.y * gridDim.z;
    unsigned sum, cnt, mine, sp = 0u;
    for (;;) {
        sum = 0u; cnt = 0u; mine = 0u;
#pragma unroll
        for (unsigned j = 0; j < 16; ++j) { const unsigned c = xb_ld(&bar[XB_XCNT(j)]); sum += c; cnt += (c > 0u) ? 1u : 0u; mine = (j == x) ? c : mine; }
        if (sum == G) break;
        __builtin_amdgcn_s_sleep(1);
        if ((++sp & 255u) == 0u) { if (xb_ld(&bar[XB_TMO])) break; if (sp > XB_SPIN_CAP) { atomicAdd(&bar[XB_TMO], 1u); break; } }
    }
    nloc = mine > 0u ? mine : 1u; nx = cnt > 0u ? cnt : 1u;
}
__device__ __forceinline__ void xcd_barrier(const XcdBarrier& b) {
    asm volatile("s_waitcnt vmcnt(0)" ::: "memory");
    __syncthreads();
    if (threadIdx.x == 0) {
        unsigned* bar = b.bar;
        __builtin_amdgcn_s_waitcnt(0);
        unsigned nloc = b.st[0], nx = b.st[1];
        if (nloc == 0u) { xcd_barrier_complete(bar, b.x, nloc, nx); b.st[0] = nloc; b.st[1] = nx; }
        const unsigned old = xb_add(&bar[XB_XSUB(b.x)], 1u);
        const unsigned gen = old / nloc;
        if (old + 1u == (gen + 1u) * nloc) {
            __builtin_amdgcn_fence(__ATOMIC_RELEASE, "agent");
            asm volatile("s_waitcnt vmcnt(0)" ::: "memory");
            const unsigned og = xb_add(&bar[XB_TOP], 1u);
            const unsigned tg = og / nx;
            if (og + 1u == (tg + 1u) * nx) xb_add(&bar[XB_TOPGEN], 1u);
            else XB_SPIN(xb_ld(&bar[XB_TOPGEN]) == tg, bar);
            __builtin_amdgcn_fence(__ATOMIC_ACQUIRE, "agent");
            xb_add(&bar[XB_XGEN(b.x)], 1u);
            asm volatile("s_waitcnt vmcnt(0)" ::: "memory");
        } else {
            XB_SPIN(xb_ld(&bar[XB_XGEN(b.x)]) == gen, bar);
            __builtin_amdgcn_fence(__ATOMIC_ACQUIRE, "agent");
            asm volatile("s_waitcnt vmcnt(0)" ::: "memory");
        }
    }
    __syncthreads();
}

struct KArgs { const float* in[31]; float* out; unsigned char* ws; int ph_lo, ph_hi; };

struct Ctx {
    const float* const* in; float* out; unsigned char* ws;
    int bid, nb, tid, lane, wave;
    unsigned char* smem;
    template <class T> __device__ __forceinline__ T* wsp(size_t off) const { return (T*)(ws + off); }
    __device__ __forceinline__ const float* mod(int layer, int src, int chunk) const { return wsp<float>(WS_MOD) + ((size_t)(layer * 2 + src) * NMOD) + chunk * D; }
    __device__ __forceinline__ const float* xrow(int layer, int r) const {
        if (layer == 0) return r < L ? in[0] + (size_t)r * D : in[2] + (size_t)(r - L) * D;
        return wsp<float>(WS_XB) + (size_t)r * D;
    }
};

template <class RowPtr, class Epi>
__device__ __forceinline__ void sgemm_unit(const RowPtr& rp, const float* __restrict__ W, int ldw, int K, int m0, int n0, const Epi& ep, float* lds, int tid) {
    float* As = lds;
    float* Bs = lds + 16 * 132;
    const int ty = tid >> 4, tx = tid & 15;
    const int am = tid >> 2, kq = (tid & 3) * 4;
    const int bk = tid >> 5, n4 = (tid & 31) * 4;
    float acc[4][8];
#pragma unroll
    for (int i = 0; i < 4; ++i)
#pragma unroll
        for (int j = 0; j < 8; ++j) acc[i][j] = 0.f;
    const bf16_t* arow = rp(m0 + am);
    const float* wp = W + (size_t)bk * ldw + n0 + n4;
    for (int k0 = 0; k0 < K; k0 += 16) {
        const uint2 a4 = *(const uint2*)(arow + k0 + kq);
        const float4 b4 = *(const float4*)(wp + (size_t)k0 * ldw);
        __syncthreads();
        As[(kq + 0) * 132 + am] = __uint_as_float(a4.x << 16);
        As[(kq + 1) * 132 + am] = __uint_as_float(a4.x & 0xffff0000u);
        As[(kq + 2) * 132 + am] = __uint_as_float(a4.y << 16);
        As[(kq + 3) * 132 + am] = __uint_as_float(a4.y & 0xffff0000u);
        *(float4*)&Bs[bk * 128 + n4] = b4;
        __syncthreads();
#pragma unroll
        for (int kk = 0; kk < 16; ++kk) {
            const float4 a = *(const float4*)&As[kk * 132 + ty * 4];
            const float4 b0 = *(const float4*)&Bs[kk * 128 + tx * 8];
            const float4 b1 = *(const float4*)&Bs[kk * 128 + tx * 8 + 4];
            const float av[4] = {a.x, a.y, a.z, a.w};
            const float bv[8] = {b0.x, b0.y, b0.z, b0.w, b1.x, b1.y, b1.z, b1.w};
#pragma unroll
            for (int i = 0; i < 4; ++i)
#pragma unroll
                for (int j = 0; j < 8; ++j) acc[i][j] = fmaf(av[i], bv[j], acc[i][j]);
        }
    }
#pragma unroll
    for (int i = 0; i < 4; ++i) ep(m0 + ty * 4 + i, n0 + tx * 8, acc[i]);
}

struct RowLin { const bf16_t* base; int ld; __device__ __forceinline__ const bf16_t* operator()(int m) const { return base + (size_t)m * ld; } };
struct RowGather { const bf16_t* base; int ld; const int* idx; __device__ __forceinline__ const bf16_t* operator()(int m) const { return base + (size_t)idx[m] * ld; } };


namespace pg8 {
typedef short bf16x8 __attribute__((ext_vector_type(8)));
typedef float f32x4 __attribute__((ext_vector_type(4)));
typedef unsigned u32x4 __attribute__((ext_vector_type(4)));
typedef unsigned u32x2 __attribute__((ext_vector_type(2)));
constexpr int BM = 256, BK = 64, HALF = 128, HTB = HALF * BK * 2, STAGE_BYTES = 8 * HTB, NXCD = 8, WGM = 8;
__host__ __device__ __forceinline__ int lds_byte(int r, int c) { const int st = (r >> 4) * 2 + (c >> 5), rr = r & 15, cc = c & 31, ob = rr * 64 + cc * 2; return st * 1024 + (ob ^ (((ob >> 9) & 1) << 5)); }
__host__ __device__ __forceinline__ void stage_rc(int b, int& R, int& C) { const int st = b / 1024, sb = b % 1024, swz = sb ^ (((sb >> 9) & 1) << 5); R = (st >> 1) * 16 + swz / 64; C = (st & 1) * 32 + (swz % 64) / 2; }
__host__ __device__ __forceinline__ int perm32(int rho) { const int n = rho >> 4, i = rho & 15; return 8 * (i >> 2) + 4 * n + (i & 3); }
struct Unit { int pm, pn; };
struct StaticOrder {
    int nM, nN, nwg, G, c;
    __host__ __device__ void init(int nM_, int nN_, int G_, int c_) { nM = nM_; nN = nN_; nwg = nM * nN; G = G_; c = c_; }
    __host__ __device__ bool next(int i, Unit& u) const {
        const long Lq = (long)i * G + c; if (Lq >= nwg) return false;
        int wgid = (int)Lq; { const int q = nwg / NXCD, r = nwg % NXCD, xcd = wgid % NXCD, off = wgid / NXCD; wgid = (xcd < r ? xcd * (q + 1) : r * (q + 1) + (xcd - r) * q) + off; }
        const int nig = WGM * nN, gid = wgid / nig, fm = gid * WGM, gsz = (nM - fm) < WGM ? (nM - fm) : WGM;
        u.pm = fm + ((wgid % nig) % gsz); u.pn = (wgid % nig) / gsz; return true;
    }
};
__device__ __forceinline__ unsigned cvt_pk_bf16(float lo, float hi) { unsigned r; asm volatile("v_cvt_pk_bf16_f32 %0, %1, %2" : "=v"(r) : "v"(lo), "v"(hi)); return r; }

struct GeomLin {
    static constexpr bool GATHER = false;
    const char* A; const char* B; int K, lda, ldb; const int* idx;
    __device__ __forceinline__ const char* a_base(const Unit& u) const { return A + (size_t)u.pm * 256 * lda * 2; }
    __device__ __forceinline__ const char* b_base(const Unit& u) const { return B + (size_t)u.pn * 256 * ldb * 2; }
    __device__ __forceinline__ int row0(const Unit& u) const { return u.pm * 256; }
};
template <bool GATHER_> struct GeomExpert {
    static constexpr bool GATHER = GATHER_;
    const char* A; const char* B; int K, lda, ldb; const int* idx; int tpe, nb;
    __device__ __forceinline__ int row0(const Unit& u) const { const int e = u.pm / tpe, t = u.pm - e * tpe; return e * SLOTS + t * 256; }
    __device__ __forceinline__ const char* a_base(const Unit& u) const { return GATHER_ ? A : A + (size_t)row0(u) * lda * 2; }
    __device__ __forceinline__ const char* b_base(const Unit& u) const { const int e = u.pm / tpe; return B + ((size_t)e * nb + (size_t)u.pn * 256) * ldb * 2; }
};

template <class Epi, class Geom, class Sched>
__device__ __forceinline__ void gemm_phase(LAS unsigned char* lds, const Geom& G, const Sched& S, const Epi& E) {
    const int tid = threadIdx.x, wid = __builtin_amdgcn_readfirstlane(tid >> 6), lane = tid & 63, wr = wid >> 2, wc = wid & 3, fr = lane & 15, fq = lane >> 4;
    const int K = G.K, nt = K / BK;
    int Rs[2], Cs[2]; unsigned vB0[2], vA0[2], vAc[2][2], vAn[2][2];
#pragma unroll
    for (int i = 0; i < 2; ++i) { int R, C; stage_rc(tid * 16 + i * 8192, R, C); Rs[i] = R; Cs[i] = C; const int Rb = Epi::PERM ? ((R & ~31) + perm32(R & 31)) : R;
        vB0[i] = (unsigned)(Rb * G.ldb + C) * 2u; vA0[i] = (unsigned)(R * G.lda + C) * 2u;
#pragma unroll
        for (int h = 0; h < 2; ++h) { vAc[h][i] = 0u; vAn[h][i] = 0u; } }
    const size_t hstepA = (size_t)HALF * G.lda * 2, hstepB = (size_t)HALF * G.ldb * 2;
#define PG8_VOFF(dst, u) do { if constexpr (Geom::GATHER) { const int _r0 = G.row0(u); _Pragma("unroll") for (int _h = 0; _h < 2; ++_h) _Pragma("unroll") for (int _i = 0; _i < 2; ++_i) \
        dst[_h][_i] = ((unsigned)G.idx[_r0 + _h * HALF + Rs[_i]] * (unsigned)G.lda + (unsigned)Cs[_i]) * 2u; } } while (0)
    const size_t kstep = (size_t)(BK * 2);
    const unsigned ldsw = (unsigned)wid * 1024u;
    const int aoff = lds_byte(wr * 64 + fr, fq * 8), boff = lds_byte(wc * 32 + fr, fq * 8);
#define PG8_SA(b, h) (((b) * 2 + (h)) * HTB)
#define PG8_SB(b, h) ((4 + (b) * 2 + (h)) * HTB)
#define PG8_STAGE(bufoff, gbase, v) do { \
        __builtin_amdgcn_global_load_lds((const unsigned*)((const char*)(gbase) + (v)[0]), (LAS unsigned*)(lds + (bufoff) + ldsw), 16, 0, 0); \
        __builtin_amdgcn_global_load_lds((const unsigned*)((const char*)(gbase) + (v)[1]), (LAS unsigned*)(lds + (bufoff) + ldsw + 8192), 16, 0, 0); } while (0)
#define PG8_STA(bufoff, gbase, h, VX) do { if constexpr (Geom::GATHER) { PG8_STAGE(bufoff, gbase, VX[h]); } else { PG8_STAGE(bufoff, (gbase) + (h) * hstepA, vA0); } } while (0)
#define PG8_STB(bufoff, gbase, h) PG8_STAGE(bufoff, (gbase) + (h) * hstepB, vB0)
#define PG8_LDA(dst, b, h) do { _Pragma("unroll") for (int m = 0; m < 4; ++m) _Pragma("unroll") for (int k = 0; k < 2; ++k) dst[m][k] = *(const LAS bf16x8*)(lds + PG8_SA(b, h) + aoff + m * 2048 + k * 1024); } while (0)
#define PG8_LDB(dst, b, h) do { _Pragma("unroll") for (int n = 0; n < 2; ++n) _Pragma("unroll") for (int k = 0; k < 2; ++k) dst[n][k] = *(const LAS bf16x8*)(lds + PG8_SB(b, h) + boff + n * 2048 + k * 1024); } while (0)
#define PG8_MMA(ai, bj, At, Bt) do { __builtin_amdgcn_s_setprio(1); _Pragma("unroll") for (int m = 0; m < 4; ++m) _Pragma("unroll") for (int n = 0; n < 2; ++n) _Pragma("unroll") for (int k = 0; k < 2; ++k) \
        acc[ai][bj][m][n] = __builtin_amdgcn_mfma_f32_16x16x32_bf16(Bt[n][k], At[m][k], acc[ai][bj][m][n], 0, 0, 0); __builtin_amdgcn_s_setprio(0); } while (0)
#define PG8_WAIT_V(n) asm volatile("s_waitcnt vmcnt(" #n ")" ::: "memory")
#define PG8_WAIT_L(n) asm volatile("s_waitcnt lgkmcnt(" #n ")" ::: "memory")
#define PG8_BAR __builtin_amdgcn_s_barrier()
#define PG8_SCHED __builtin_amdgcn_sched_barrier(0)
    Unit cur, nxt; int ui = 0;
    if (!S.next(0, cur)) return;
    f32x4 acc[2][2][4][2];
#pragma unroll
    for (int a = 0; a < 2; ++a)
#pragma unroll
        for (int b = 0; b < 2; ++b)
#pragma unroll
            for (int m = 0; m < 4; ++m)
#pragma unroll
                for (int n = 0; n < 2; ++n) acc[a][b][m][n] = (f32x4){0.f, 0.f, 0.f, 0.f};
    bf16x8 At[4][2], B0[2][2], B1[2][2];
    const char* cA = G.a_base(cur); const char* cB = G.b_base(cur);
    PG8_VOFF(vAc, cur);
    PG8_STB(PG8_SB(0, 0), cB, 0); PG8_STA(PG8_SA(0, 0), cA, 0, vAc); PG8_STB(PG8_SB(0, 1), cB, 1); PG8_STA(PG8_SA(0, 1), cA, 1, vAc);
    if (wr == 1) PG8_BAR;
    PG8_WAIT_V(4); PG8_BAR;
    PG8_STB(PG8_SB(1, 0), cB + kstep, 0); PG8_STA(PG8_SA(1, 0), cA + kstep, 0, vAc); PG8_STB(PG8_SB(1, 1), cB + kstep, 1);
    PG8_WAIT_V(6); PG8_BAR;
    for (;;) {
        const bool has_next = S.next(ui + 1, nxt);
        const char* nA = has_next ? G.a_base(nxt) : cA; const char* nB = has_next ? G.b_base(nxt) : cB;
        if constexpr (Geom::GATHER) { if (has_next) PG8_VOFF(vAn, nxt); else {
#pragma unroll
            for (int h = 0; h < 2; ++h) { vAn[h][0] = vAc[h][0]; vAn[h][1] = vAc[h][1]; } } }
        for (int t = 0; t < nt; t += 2) {
            const bool last = (t == nt - 2);
            const char* a1 = cA + (size_t)(t + 1) * kstep;
            const char* a2 = last ? nA : cA + (size_t)(t + 2) * kstep; const char* b2 = last ? nB : cB + (size_t)(t + 2) * kstep;
            const char* a3 = a2 + kstep; const char* b3 = b2 + kstep;
            unsigned v2[2][2];
#pragma unroll
            for (int h = 0; h < 2; ++h) { v2[h][0] = (Geom::GATHER && last) ? vAn[h][0] : vAc[h][0]; v2[h][1] = (Geom::GATHER && last) ? vAn[h][1] : vAc[h][1]; }
            PG8_LDB(B0, 0, 0); PG8_SCHED; PG8_LDA(At, 0, 0); PG8_STA(PG8_SA(1, 1), a1, 1, vAc);
            PG8_WAIT_L(8); PG8_BAR; PG8_WAIT_L(0); PG8_MMA(0, 0, At, B0); PG8_BAR; PG8_SCHED;
            PG8_LDB(B1, 0, 1); PG8_STB(PG8_SB(0, 0), b2, 0);
            PG8_BAR; PG8_WAIT_L(0); PG8_MMA(0, 1, At, B1); PG8_BAR;
            PG8_LDA(At, 0, 1); PG8_STA(PG8_SA(0, 0), a2, 0, v2);
            PG8_BAR; PG8_WAIT_L(0); PG8_MMA(1, 0, At, B0); PG8_BAR; PG8_SCHED;
            PG8_STB(PG8_SB(0, 1), b2, 1);
            PG8_WAIT_V(6); PG8_BAR; PG8_MMA(1, 1, At, B1); PG8_BAR;
            PG8_LDB(B0, 1, 0); PG8_SCHED; PG8_LDA(At, 1, 0); PG8_STA(PG8_SA(0, 1), a2, 1, v2);
            PG8_WAIT_L(8); PG8_BAR; PG8_WAIT_L(0); PG8_MMA(0, 0, At, B0); PG8_BAR; PG8_SCHED;
            PG8_LDB(B1, 1, 1); PG8_STB(PG8_SB(1, 0), b3, 0);
            PG8_BAR; PG8_WAIT_L(0); PG8_MMA(0, 1, At, B1); PG8_BAR;
            PG8_LDA(At, 1, 1); PG8_STA(PG8_SA(1, 0), a3, 0, v2);
            PG8_BAR; PG8_WAIT_L(0); PG8_MMA(1, 0, At, B0); PG8_BAR; PG8_SCHED;
            PG8_STB(PG8_SB(1, 1), b3, 1);
            PG8_WAIT_V(6); PG8_BAR; PG8_MMA(1, 1, At, B1); PG8_BAR;
        }
        E(acc, cur, G.row0(cur), wr, wc, fr, fq);
        if (!has_next) break;
#pragma unroll
        for (int a = 0; a < 2; ++a)
#pragma unroll
            for (int b = 0; b < 2; ++b)
#pragma unroll
                for (int m = 0; m < 4; ++m)
#pragma unroll
                    for (int n = 0; n < 2; ++n) acc[a][b][m][n] = (f32x4){0.f, 0.f, 0.f, 0.f};
        cur = nxt; cA = nA; cB = nB; ++ui;
#pragma unroll
        for (int h = 0; h < 2; ++h) { vAc[h][0] = vAn[h][0]; vAc[h][1] = vAn[h][1]; }
    }
    PG8_WAIT_V(0);
    if (wr == 0) PG8_BAR;
    PG8_BAR;
#undef PG8_VOFF
#undef PG8_SA
#undef PG8_SB
#undef PG8_STAGE
#undef PG8_STA
#undef PG8_STB
#undef PG8_LDA
#undef PG8_LDB
#undef PG8_MMA
#undef PG8_WAIT_V
#undef PG8_WAIT_L
#undef PG8_BAR
#undef PG8_SCHED
}

struct EpiBf16Plain {
    static constexpr bool PERM = true;
    bf16_t* O; int ldc; int coloff;
    __device__ __forceinline__ void operator()(const f32x4 (&acc)[2][2][4][2], const Unit& u, int row0, int wr, int wc, int fr, int fq) const {
        const int r0 = row0 + wr * 64 + fr, col0 = coloff + u.pn * BM + wc * 32 + 8 * fq;
#pragma unroll
        for (int ai = 0; ai < 2; ++ai)
#pragma unroll
            for (int m = 0; m < 4; ++m) { bf16_t* rowp = O + (size_t)(r0 + ai * HALF + m * 16) * ldc + col0;
#pragma unroll
                for (int bj = 0; bj < 2; ++bj) { const f32x4 v0 = acc[ai][bj][m][0], v1 = acc[ai][bj][m][1];
                    u32x4 w; w.x = cvt_pk_bf16(v0[0], v0[1]); w.y = cvt_pk_bf16(v0[2], v0[3]); w.z = cvt_pk_bf16(v1[0], v1[1]); w.w = cvt_pk_bf16(v1[2], v1[3]);
                    *(u32x4*)(rowp + bj * HALF) = w; } }
    }
};
struct EpiInRest {
    static constexpr bool PERM = true;
    unsigned char* ws;
    __device__ __forceinline__ void operator()(const f32x4 (&acc)[2][2][4][2], const Unit& u, int row0, int wr, int wc, int fr, int fq) const {
        const int gcol = OFF_WAQ + u.pn * BM;
        bf16_t* base; int ldc, c0; bool sg = false;
        if (gcol < OFF_WAKV) { base = (bf16_t*)(ws + WS_QWA); ldc = 1024; c0 = gcol - OFF_WAQ; }
        else if (gcol < OFF_NAQ) { base = (bf16_t*)(ws + WS_KVWA); ldc = 512; c0 = gcol - OFF_WAKV; }
        else if (gcol < OFF_NAKV) { base = (bf16_t*)(ws + WS_QNA); ldc = 1024; c0 = gcol - OFF_NAQ; }
        else if (gcol < OFF_GATE) { base = (bf16_t*)(ws + WS_KVNA); ldc = 2048; c0 = gcol - OFF_NAKV; }
        else { base = (bf16_t*)(ws + WS_GATE); ldc = 6144; c0 = gcol - OFF_GATE; sg = true; }
        const int r0 = row0 + wr * 64 + fr, col0 = c0 + wc * 32 + 8 * fq;
#pragma unroll
        for (int ai = 0; ai < 2; ++ai)
#pragma unroll
            for (int m = 0; m < 4; ++m) { bf16_t* rowp = base + (size_t)(r0 + ai * HALF + m * 16) * ldc + col0;
#pragma unroll
                for (int bj = 0; bj < 2; ++bj) { f32x4 v0 = acc[ai][bj][m][0], v1 = acc[ai][bj][m][1];
                    if (sg) {
#pragma unroll
                        for (int j = 0; j < 4; ++j) { v0[j] = sigmoid_f(v0[j]); v1[j] = sigmoid_f(v1[j]); } }
                    u32x4 w; w.x = cvt_pk_bf16(v0[0], v0[1]); w.y = cvt_pk_bf16(v0[2], v0[3]); w.z = cvt_pk_bf16(v1[0], v1[1]); w.w = cvt_pk_bf16(v1[2], v1[3]);
                    *(u32x4*)(rowp + bj * HALF) = w; } }
    }
};
template <int BR> struct EpiMergeF {
    static constexpr bool PERM = false;
    unsigned char* ws;
    __device__ __forceinline__ void operator()(const f32x4 (&acc)[2][2][4][2], const Unit& u, int row0, int wr, int wc, int fr, int fq) const {
        const int r0 = row0 + wr * 64 + fr, col0 = u.pn * BM + wc * 32 + 4 * fq;
#pragma unroll
        for (int ai = 0; ai < 2; ++ai)
#pragma unroll
            for (int m = 0; m < 4; ++m) { const size_t row = (size_t)(r0 + ai * HALF + m * 16);
                const bf16_t* gp = (const bf16_t*)(ws + WS_GATE) + row * 6144 + BR * 2048 + col0;
                float* mp = (float*)(ws + WS_MPART) + row * D + col0; bf16_t* ob = (bf16_t*)(ws + WS_MB) + row * D + col0;
#pragma unroll
                for (int bj = 0; bj < 2; ++bj)
#pragma unroll
                    for (int n = 0; n < 2; ++n) { const int co = bj * HALF + n * 16;
                        const u32x2 gg = *(const u32x2*)(gp + co);
                        const f32x4 g = {__uint_as_float(gg.x << 16), __uint_as_float(gg.x & 0xffff0000u), __uint_as_float(gg.y << 16), __uint_as_float(gg.y & 0xffff0000u)};
                        f32x4 t = g * acc[ai][bj][m][n];
                        if (BR > 0) t += *(const f32x4*)(mp + co);
                        if (BR < 2) *(f32x4*)(mp + co) = t;
                        else { u32x2 w; w.x = cvt_pk_bf16(t[0], t[1]); w.y = cvt_pk_bf16(t[2], t[3]); *(u32x2*)(ob + co) = w; } } }
    }
};
struct EpiOutF {
    static constexpr bool PERM = false;
    const Ctx* c; int layer;
    __device__ __forceinline__ void operator()(const f32x4 (&acc)[2][2][4][2], const Unit& u, int row0, int wr, int wc, int fr, int fq) const {
        const int r0 = row0 + wr * 64 + fr, col0 = u.pn * BM + wc * 32 + 4 * fq;
#pragma unroll
        for (int ai = 0; ai < 2; ++ai)
#pragma unroll
            for (int m = 0; m < 4; ++m) { const int row = r0 + ai * HALF + m * 16;
                const float* xin = c->xrow(layer, row) + col0; const float* g = c->mod(layer, row < L ? 0 : 1, 2) + col0;
                float* o = (float*)(c->ws + WS_XA) + (size_t)row * D + col0;
#pragma unroll
                for (int bj = 0; bj < 2; ++bj)
#pragma unroll
                    for (int n = 0; n < 2; ++n) { const int co = bj * HALF + n * 16;
                        *(f32x4*)(o + co) = *(const f32x4*)(xin + co) + *(const f32x4*)(g + co) * acc[ai][bj][m][n]; } }
    }
};
struct EpiGU {
    static constexpr bool PERM = false;
    bf16_t* act;
    __device__ __forceinline__ void operator()(const f32x4 (&acc)[2][2][4][2], const Unit& u, int row0, int wr, int wc, int fr, int fq) const {
        const int r0 = row0 + wr * 64 + fr, f0 = u.pn * 128 + wc * 16 + 4 * fq;
#pragma unroll
        for (int ai = 0; ai < 2; ++ai)
#pragma unroll
            for (int m = 0; m < 4; ++m) { bf16_t* rowp = act + (size_t)(r0 + ai * HALF + m * 16) * DF + f0;
#pragma unroll
                for (int bj = 0; bj < 2; ++bj) { const f32x4 a = acc[ai][bj][m][0], uu = acc[ai][bj][m][1]; f32x4 t;
#pragma unroll
                    for (int j = 0; j < 4; ++j) t[j] = silu_f(a[j]) * uu[j];
                    u32x2 w; w.x = cvt_pk_bf16(t[0], t[1]); w.y = cvt_pk_bf16(t[2], t[3]); *(u32x2*)(rowp + bj * 64) = w; } }
    }
};
}

struct ConvDesc { const float* W; bf16_t* WT; int K, N, k0, n0, gu, off; };
__device__ __forceinline__ ConvDesc conv_desc(const Ctx& c, int layer, int it) {
    constexpr int I_IN = (D / 64) * (NIN / 256), I_BR = (1024 / 64) * (D / 256), I_OUT = (D / 64) * (D / 256), I_G = (D / 64) * (DF / 256), I_DN = (DF / 64) * (D / 256);
    ConvDesc d; int r = it; d.gu = 0; d.off = 0;
    if (r < I_IN) { d.W = c.in[7] + (size_t)layer * D * NIN; d.WT = c.wsp<bf16_t>(WS_WIN); d.K = D; d.N = NIN; }
    else if ((r -= I_IN) < 3 * I_BR) { const int b = r / I_BR; r -= b * I_BR; d.W = c.in[24] + ((size_t)layer * 3 + b) * 1024 * D; d.WT = c.wsp<bf16_t>(WS_WBR) + (size_t)b * D * 1024; d.K = 1024; d.N = D; }
    else if ((r -= 3 * I_BR) < I_OUT) { d.W = c.in[25] + (size_t)layer * D * D; d.WT = c.wsp<bf16_t>(WS_WOUT); d.K = D; d.N = D; }
    else { r -= I_OUT; const int e = r / (2 * I_G + I_DN); r -= e * (2 * I_G + I_DN);
        if (r < I_G) { d.W = c.in[28] + ((size_t)layer * NE + e) * D * DF; d.WT = c.wsp<bf16_t>(WS_WGU); d.K = D; d.N = DF; d.gu = 1; d.off = e * 2048; }
        else if ((r -= I_G) < I_G) { d.W = c.in[29] + ((size_t)layer * NE + e) * D * DF; d.WT = c.wsp<bf16_t>(WS_WGU); d.K = D; d.N = DF; d.gu = 1; d.off = e * 2048 + 16; }
        else { r -= I_G; d.W = c.in[30] + ((size_t)layer * NE + e) * DF * D; d.WT = c.wsp<bf16_t>(WS_WDN) + (size_t)e * D * DF; d.K = DF; d.N = D; } }
    const int nblk = d.N / 256; d.k0 = 64 * (r / nblk); d.n0 = 256 * (r % nblk);
    return d;
}
__device__ __forceinline__ void ph_conv(const Ctx& c, int layer) {
    constexpr int I_IN = (D / 64) * (NIN / 256), I_BR = (1024 / 64) * (D / 256), I_OUT = (D / 64) * (D / 256), I_G = (D / 64) * (DF / 256), I_DN = (DF / 64) * (D / 256);
    constexpr int NITEMS = I_IN + 3 * I_BR + I_OUT + NE * (2 * I_G + I_DN);
    __syncthreads();
    float* tile = (float*)c.smem;
    const int tid = c.tid;
    float4 rg[8];
    int it = c.bid; bool have = it < NITEMS; ConvDesc d;
    if (have) { d = conv_desc(c, layer, it);
#pragma unroll
        for (int q = 0; q < 8; ++q) { const int e = tid + 512 * q, row = e >> 6, c4 = e & 63; rg[q] = *(const float4*)(d.W + (size_t)(d.k0 + row) * d.N + d.n0 + 4 * c4); } }
    while (have) {
#pragma unroll
        for (int q = 0; q < 8; ++q) { const int e = tid + 512 * q, row = e >> 6, c4 = e & 63; float* tp = tile + row * 257 + 4 * c4; tp[0] = rg[q].x; tp[1] = rg[q].y; tp[2] = rg[q].z; tp[3] = rg[q].w; }
        __syncthreads();
        const ConvDesc cur = d;
        it += c.nb; have = it < NITEMS;
        if (have) { d = conv_desc(c, layer, it);
#pragma unroll
            for (int q = 0; q < 8; ++q) { const int e = tid + 512 * q, row = e >> 6, c4 = e & 63; rg[q] = *(const float4*)(d.W + (size_t)(d.k0 + row) * d.N + d.n0 + 4 * c4); } }
#pragma unroll
        for (int j = 0; j < 4; ++j) { const int p = tid + 512 * j, nn = p >> 3, kc = p & 7; const float* sp = tile + (8 * kc) * 257 + nn;
            uint4 o; o.x = pk2(sp[0 * 257], sp[1 * 257]); o.y = pk2(sp[2 * 257], sp[3 * 257]); o.z = pk2(sp[4 * 257], sp[5 * 257]); o.w = pk2(sp[6 * 257], sp[7 * 257]);
            const int f = cur.n0 + nn; const int orow = cur.gu ? cur.off + 32 * (f >> 4) + (f & 15) : f;
            *(uint4*)(cur.WT + (size_t)orow * cur.K + cur.k0 + 8 * kc) = o; }
        __syncthreads();
    }
}

struct EpiTaps {
    static constexpr bool PERM = true;
    bf16_t* KF; bf16_t* KFC; const float* dec;
    __device__ __forceinline__ void operator()(const pg8::f32x4 (&acc)[2][2][4][2], const pg8::Unit& u, int row0, int wr, int wc, int fr, int fq) const {
        const bool isc = u.pn == L / 256;
        const int ch0 = row0 + wr * 64 + fr, pos0 = (isc ? 0 : u.pn * 256) + wc * 32 + 8 * fq;
        const float inv = isc ? 1.0f / (float)(LC - 1) : 1.0f / (float)(L - 1);
        bf16_t* base = isc ? KFC : KF; const int ld = isc ? LC : L;
#pragma unroll
        for (int ai = 0; ai < 2; ++ai)
#pragma unroll
            for (int m = 0; m < 4; ++m) { const int ch = ch0 + ai * 128 + m * 16; const float rate = fabsf(dec[ch]); bf16_t* rowp = base + (size_t)ch * ld + pos0;
#pragma unroll
                for (int bj = 0; bj < 2; ++bj) { float t[8];
#pragma unroll
                    for (int j = 0; j < 8; ++j) { const float tt = (float)(pos0 + bj * 128 + j) * inv; const float a = j < 4 ? acc[ai][bj][m][0][j] : acc[ai][bj][m][1][j - 4]; t[j] = a * (__expf(-tt * rate) + 0.05f); }
                    pg8::u32x4 w; w.x = pg8::cvt_pk_bf16(t[0], t[1]); w.y = pg8::cvt_pk_bf16(t[2], t[3]); w.z = pg8::cvt_pk_bf16(t[4], t[5]); w.w = pg8::cvt_pk_bf16(t[6], t[7]);
                    *(pg8::u32x4*)(rowp + bj * 128) = w; } }
    }
};
__device__ __forceinline__ void ph_taps(const Ctx& c, int layer) {
    LAS unsigned char* lds = (LAS unsigned char*)c.smem;
    __syncthreads();
    const pg8::GeomLin G{(const char*)(c.wsp<bf16_t>(WS_FW3T) + (size_t)layer * 4096 * 256), (const char*)(c.wsp<bf16_t>(WS_H2B) + (size_t)layer * MR * 256), 256, 256, 256, nullptr};
    pg8::StaticOrder S; S.init(4096 / 256, MR / 256, c.nb, c.bid);
    const EpiTaps E{c.wsp<bf16_t>(WS_KF), c.wsp<bf16_t>(WS_KFC), c.in[16] + (size_t)layer * 4096};
    pg8::gemm_phase(lds, G, S, E);
}

__device__ __forceinline__ void ph_g0(const Ctx& c) {
    float* lds = (float*)c.smem;
    for (int u = c.bid; u < 2 * 256; u += c.nb) {
        const int layer = u >> 8, n0 = (u & 255) * 48;
        __syncthreads();
        for (int k = c.tid; k < D; k += NTHREADS) { lds[k] = silu_f(c.in[1][k]); lds[D + k] = silu_f(c.in[3][k]); }
        __syncthreads();
        const int col = c.tid % 48, kg = c.tid / 48;
        float a0 = 0.f, a1 = 0.f;
        if (kg < 10) {
            const float* w = c.in[4] + (size_t)layer * D * NMOD + n0 + col;
            for (int k = kg; k < D; k += 10) { const float wv = w[(size_t)k * NMOD]; a0 = fmaf(lds[k], wv, a0); a1 = fmaf(lds[D + k], wv, a1); }
        }
        float* red = lds + 2 * D;
        if (kg < 10) { red[(kg * 48 + col) * 2] = a0; red[(kg * 48 + col) * 2 + 1] = a1; }
        __syncthreads();
        if (c.tid < 96) {
            const int cc = c.tid >> 1, s = c.tid & 1; float t = 0.f;
            for (int g = 0; g < 10; ++g) t += red[(g * 48 + cc) * 2 + s];
            t += c.in[5][(size_t)layer * NMOD + n0 + cc];
            c.wsp<float>(WS_MOD)[(size_t)(layer * 2 + s) * NMOD + n0 + cc] = t;
        }
    }
    for (size_t e = (size_t)c.bid * NTHREADS + c.tid; e < (size_t)2 * 4096 * 256; e += (size_t)c.nb * NTHREADS) {
        const int k = (int)(e & 255), col = (int)((e >> 8) & 4095), layer = (int)(e >> 20);
        c.wsp<bf16_t>(WS_FW3T)[e] = k < 64 ? f2bf(c.in[14][((size_t)layer * 64 + k) * 4096 + col]) : (bf16_t)0;
    }
    const int gw = c.bid * 8 + c.wave, ngw = c.nb * 8;
    for (int task = gw; task < 2 * MR; task += ngw) {
        const int layer = task / MR, pos = task % MR;
        const bool isc = pos >= L; const int i = isc ? pos - L : pos; const int Lx = isc ? LC : L;
        const float tt = (float)i * (1.0f / (float)(Lx - 1));
        const float c0 = (float)(2.0 * 3.14159265358979323846 / (double)Lx);
        const int j = c.lane;
        float feat = 0.f;
        if (j == 0) feat = tt;
        else if (j < 33) { const int b = (j - 1) & 15; const float band = 1e-4f + (float)b * ((15.0f - 1e-4f) / 15.0f); const float ang = (c0 * band) * (float)i; feat = (j <= 16) ? cosf(ang) : -sinf(ang); }
        const float* fw1 = c.in[10] + (size_t)layer * 33 * 64; const float* fb1 = c.in[11] + layer * 64;
        const float* fw2 = c.in[12] + (size_t)layer * 64 * 64; const float* fb2 = c.in[13] + layer * 64;
        const float* fr = c.in[15] + layer * 128;
        float s = fb1[j];
        for (int f = 0; f < 33; ++f) s = fmaf(__shfl(feat, f), fw1[f * 64 + j], s);
        const float h1 = sinf(fr[j] * s);
        float s2 = fb2[j];
        for (int m = 0; m < 64; ++m) s2 = fmaf(__shfl(h1, m), fw2[m * 64 + j], s2);
        const float h2 = sinf(fr[64 + j] * s2);
        bf16_t* hb = c.wsp<bf16_t>(WS_H2B) + ((size_t)layer * MR + pos) * 256;
        hb[j] = f2bf(h2); hb[64 + j] = 0; hb[128 + j] = 0; hb[192 + j] = 0;
    }
}

__device__ __forceinline__ void ph_a(const Ctx& c, int layer) {
    const int gw = c.bid * 8 + c.wave, ngw = c.nb * 8;
    const float* g = c.in[6] + (size_t)layer * D;
    for (int r = gw; r < MR; r += ngw) {
        const float* x = c.xrow(layer, r);
        const int src = r < L ? 0 : 1;
        const float* sh = c.mod(layer, src, 0); const float* sc = c.mod(layer, src, 1);
        float4 v[8]; float ss = 0.f;
#pragma unroll
        for (int j = 0; j < 8; ++j) { v[j] = *(const float4*)(x + 4 * c.lane + 256 * j); ss += v[j].x * v[j].x + v[j].y * v[j].y + v[j].z * v[j].z + v[j].w * v[j].w; }
        ss = wave_sum(ss);
        const float inv = rsqrtf(ss * (1.0f / D) + RMS_EPS);
        bf16_t* o = c.wsp<bf16_t>(WS_HX) + (size_t)r * D;
#pragma unroll
        for (int j = 0; j < 8; ++j) {
            const int col = 4 * c.lane + 256 * j;
            const float4 gg = *(const float4*)(g + col), s4 = *(const float4*)(sh + col), c4 = *(const float4*)(sc + col);
            const float y0 = v[j].x * inv * gg.x * (1.f + c4.x) + s4.x, y1 = v[j].y * inv * gg.y * (1.f + c4.y) + s4.y;
            const float y2 = v[j].z * inv * gg.z * (1.f + c4.z) + s4.z, y3 = v[j].w * inv * gg.w * (1.f + c4.w) + s4.w;
            uint2 w; w.x = pk2(y0, y1); w.y = pk2(y2, y3);
            *(uint2*)(o + col) = w;
        }
    }
}

struct EpiIn {
    unsigned char* ws;
    __device__ __forceinline__ void operator()(int row, int col, const float (&v)[8]) const {
        if (col < OFF_WAQ) {
            bf16_t* d = (bf16_t*)(ws + WS_ZHYT);
#pragma unroll
            for (int j = 0; j < 8; ++j) d[(size_t)(col + j) * MR + row] = f2bf(v[j]);
            return;
        }
        bf16_t* dst; float t[8];
#pragma unroll
        for (int j = 0; j < 8; ++j) t[j] = v[j];
        if (col < OFF_WAKV) dst = (bf16_t*)(ws + WS_QWA) + (size_t)row * 1024 + (col - OFF_WAQ);
        else if (col < OFF_NAQ) dst = (bf16_t*)(ws + WS_KVWA) + (size_t)row * 512 + (col - OFF_WAKV);
        else if (col < OFF_NAKV) dst = (bf16_t*)(ws + WS_QNA) + (size_t)row * 1024 + (col - OFF_NAQ);
        else if (col < OFF_GATE) dst = (bf16_t*)(ws + WS_KVNA) + (size_t)row * 2048 + (col - OFF_NAKV);
        else { dst = (bf16_t*)(ws + WS_GATE) + (size_t)row * 6144 + (col - OFF_GATE);
#pragma unroll
            for (int j = 0; j < 8; ++j) t[j] = sigmoid_f(t[j]); }
        uint4 o; o.x = pk2(t[0], t[1]); o.y = pk2(t[2], t[3]); o.z = pk2(t[4], t[5]); o.w = pk2(t[6], t[7]);
        *(uint4*)dst = o;
    }
};
__device__ __forceinline__ void ph_b(const Ctx& c, int layer) {
    const RowLin rp{c.wsp<bf16_t>(WS_HX), D};
    const EpiIn ep{c.ws};
    const float* W = c.in[7] + (size_t)layer * D * NIN;
    const int nM = MR / 128, nN = NIN / 128;
    for (int u = c.bid; u < nM * nN; u += c.nb) {
        const int pm = u % nM, pn = u / nM;
        sgemm_unit(rp, W, NIN, D, pm * 128, pn * 128, ep, (float*)c.smem, c.tid);
    }
}

__device__ __forceinline__ void ph_b2(const Ctx& c, int layer) {
    const int gw = c.bid * 8 + c.wave, ngw = c.nb * 8;
    const int lane = c.lane;
    const int dlo = lane < 32 ? lane : lane + 32, dhi = dlo + 32;
    const int f = lane & 31, ax = lane >> 5;
    const float invf = powf(10000.0f, -(float)f / 32.0f);
    for (int task = gw; task < MR * 26; task += ngw) {
        const int r = task / 26, s = task % 26;
        bf16_t* p; const float* gain; bool rope;
        if (s < 8) { p = c.wsp<bf16_t>(WS_QWA) + (size_t)r * 1024 + s * 128; gain = c.in[18] + layer * 128; rope = true; }
        else if (s < 10) { p = c.wsp<bf16_t>(WS_KVWA) + (size_t)r * 512 + (s - 8) * 128; gain = c.in[19] + layer * 128; rope = true; }
        else if (s < 18) { p = c.wsp<bf16_t>(WS_QNA) + (size_t)r * 1024 + (s - 10) * 128; gain = c.in[21] + layer * 128; rope = false; }
        else { p = c.wsp<bf16_t>(WS_KVNA) + (size_t)r * 2048 + (s - 18) * 128; gain = c.in[22] + layer * 128; rope = false; }
        float a = bf2f(p[dlo]), b = bf2f(p[dhi]);
        const float ss = wave_sum(a * a + b * b);
        const float inv = rsqrtf(ss * (1.0f / 128.0f) + RMS_EPS);
        a = a * inv * gain[dlo]; b = b * inv * gain[dhi];
        if (rope && r < L) {
            const float pos = ax == 0 ? (float)(r / GRIDW) : (float)(r % GRIDW);
            const float ang = pos * invf; const float cs = cosf(ang), sn = sinf(ang);
            const float na = a * cs - b * sn, nb2 = b * cs + a * sn; a = na; b = nb2;
        }
        p[dlo] = f2bf(a); p[dhi] = f2bf(b);
    }
}

__device__ __forceinline__ float shortconv_at(const bf16_t* z, int t, int Lx, float w0, float w1, float w2, float b) {
    const float zm = t > 0 ? bf2f(z[t - 1]) : 0.f, z0 = bf2f(z[t]), zp = t + 1 < Lx ? bf2f(z[t + 1]) : 0.f;
    return zm * w0 + z0 * w1 + zp * w2 + b;
}
__device__ __forceinline__ float block_sum(float v, float* red, int tid) {
    v = wave_sum(v);
    __syncthreads();
    if ((tid & 63) == 0) red[tid >> 6] = v;
    __syncthreads();
    float t = 0.f;
#pragma unroll
    for (int w = 0; w < 8; ++w) t += red[w];
    return t;
}
__device__ __forceinline__ void hyena_direct_unit(const Ctx& c, int layer, int ch) {
    bf16_t* kc = (bf16_t*)c.smem;
    float* cv = (float*)c.smem;
    float* us = (float*)(c.smem + 4 * L);
    float* red = us + L;
    const int tid = c.tid;
    const float* cw = c.in[8] + (size_t)layer * 3 * 3072; const float* cb = c.in[9] + (size_t)layer * 3072;
    const bf16_t* zv = c.wsp<bf16_t>(WS_ZHYT) + (size_t)ch * MR;
    const bf16_t* z1 = c.wsp<bf16_t>(WS_ZHYT) + (size_t)(1024 + ch) * MR;
    const bf16_t* z2 = c.wsp<bf16_t>(WS_ZHYT) + (size_t)(2048 + ch) * MR;
    const bf16_t* KF = c.wsp<bf16_t>(WS_KF);
    __syncthreads();
    { const float w0 = cw[ch], w1 = cw[3072 + ch], w2 = cw[6144 + ch], b = cb[ch];
#pragma unroll 2
      for (int t = tid; t < L; t += NTHREADS) us[t] = shortconv_at(zv, t, L, w0, w1, w2, b); }
    for (int o = 0; o < 2; ++o) {
        const bf16_t* hf = KF + (size_t)(o * 1024 + ch) * L;
        const bf16_t* hb = KF + (size_t)(2048 + o * 1024 + ch) * L;
        float sabs = 0.f;
#pragma unroll 2
        for (int t = tid; t < L; t += NTHREADS) {
            bf16_t kf = hf[t], kb = hb[t];
            if (t == 0) { kf = f2bf(bf2f(kf) + bf2f(kb)); kb = 0; }
            kc[L + t] = kf; kc[L - t] = (t == 0) ? kf : kb;
            sabs += fabsf(bf2f(kf)) + fabsf(bf2f(kb));
        }
        if (tid == 0) kc[0] = 0;
        const float S = block_sum(sabs, red, tid);
        {
            float acc[32];
#pragma unroll
            for (int j = 0; j < 32; ++j) acc[j] = 0.f;
#pragma unroll 2
            for (int s = 0; s < L; ++s) {
                const float uv = us[s];
                const bf16_t* kp = kc + (L + tid - s);
#pragma unroll
                for (int j = 0; j < 32; ++j) acc[j] = fmaf(uv, bf2f(kp[512 * j]), acc[j]);
            }
            __syncthreads();
#pragma unroll
            for (int j = 0; j < 32; ++j) cv[tid + 512 * j] = acc[j];
        }
        LDS_FENCE();
        const float invS = 1.0f / S;
        const float dsk = c.in[17][(size_t)layer * 2048 + o * 1024 + ch];
        const int co = o == 0 ? 1024 : 2048;
        const bf16_t* zz = o == 0 ? z1 : z2;
        const float w0 = cw[co + ch], w1 = cw[3072 + co + ch], w2 = cw[6144 + co + ch], b = cb[co + ch];
        bf16_t* dst = c.wsp<bf16_t>(WS_YHYT) + (size_t)ch * L;
#pragma unroll 2
        for (int t = tid; t < L; t += NTHREADS) {
            const float r = shortconv_at(zz, t, L, w0, w1, w2, b) * (cv[t] * invS + us[t] * dsk);
            if (o == 0) us[t] = r; else dst[t] = f2bf(r);
        }
        __syncthreads();
    }
}
__device__ __forceinline__ void hyena_ctx_unit(const Ctx& c, int layer, int ch) {
    float* kc = (float*)c.smem;
    float* us = kc + 512;
    float* red = us + 256;
    const int tid = c.tid;
    const float* cw = c.in[8] + (size_t)layer * 3 * 3072; const float* cb = c.in[9] + (size_t)layer * 3072;
    const bf16_t* zv = c.wsp<bf16_t>(WS_ZHYT) + (size_t)ch * MR + L;
    const bf16_t* z1 = c.wsp<bf16_t>(WS_ZHYT) + (size_t)(1024 + ch) * MR + L;
    const bf16_t* z2 = c.wsp<bf16_t>(WS_ZHYT) + (size_t)(2048 + ch) * MR + L;
    const bf16_t* KF = c.wsp<bf16_t>(WS_KFC);
    __syncthreads();
    if (tid < LC) us[tid] = shortconv_at(zv, tid, LC, cw[ch], cw[3072 + ch], cw[6144 + ch], cb[ch]);
    for (int o = 0; o < 2; ++o) {
        const bf16_t* hf = KF + (size_t)(o * 1024 + ch) * LC;
        const bf16_t* hb = KF + (size_t)(2048 + o * 1024 + ch) * LC;
        float sabs = 0.f;
        {
            const int lag = tid - 256; float k;
            if (lag == 0) k = bf2f(hf[0]) + bf2f(hb[0]); else if (lag > 0) k = bf2f(hf[lag]); else if (lag > -256) k = bf2f(hb[-lag]); else k = 0.f;
            kc[tid] = k; sabs = fabsf(k);
        }
        const float S = block_sum(sabs, red, tid);
        float acc = 0.f;
        if (tid < LC) for (int s = 0; s < LC; ++s) acc = fmaf(us[s], kc[256 + tid - s], acc);
        const float dsk = c.in[17][(size_t)layer * 2048 + o * 1024 + ch];
        float res = 0.f;
        if (tid < LC) {
            const bf16_t* zz = o == 0 ? z1 : z2; const int co = o == 0 ? 1024 : 2048;
            res = shortconv_at(zz, tid, LC, cw[co + ch], cw[3072 + co + ch], cw[6144 + co + ch], cb[co + ch]) * (acc / S + us[tid] * dsk);
        }
        __syncthreads();
        if (tid < LC) { if (o == 0) us[tid] = res; else c.wsp<bf16_t>(WS_YHY)[(size_t)(L + tid) * 1024 + ch] = f2bf(res); }
        __syncthreads();
    }
}

template <class KeyFn>
__device__ __forceinline__ void wave_attn(const bf16_t* q, int nkeys, const KeyFn& key, bool has_sink, float sink, bf16_t* out, float* wl, int lane) {
    float* qf = wl;
    float* sc = wl + 128;
    qf[2 * lane] = bf2f(q[2 * lane]); qf[2 * lane + 1] = bf2f(q[2 * lane + 1]);
    LDS_FENCE();
    float mx = -3.0e38f;
    for (int j = lane; j < nkeys; j += 64) {
        const bf16_t* kp; const bf16_t* vp; float bias;
        float s = -1e30f;
        if (key(j, kp, vp, bias)) {
            float d = 0.f;
#pragma unroll
            for (int e = 0; e < 128; e += 8) {
                const uint4 kk = *(const uint4*)(kp + e);
                d = fmaf(qf[e + 0], __uint_as_float(kk.x << 16), d); d = fmaf(qf[e + 1], __uint_as_float(kk.x & 0xffff0000u), d);
                d = fmaf(qf[e + 2], __uint_as_float(kk.y << 16), d); d = fmaf(qf[e + 3], __uint_as_float(kk.y & 0xffff0000u), d);
                d = fmaf(qf[e + 4], __uint_as_float(kk.z << 16), d); d = fmaf(qf[e + 5], __uint_as_float(kk.z & 0xffff0000u), d);
                d = fmaf(qf[e + 6], __uint_as_float(kk.w << 16), d); d = fmaf(qf[e + 7], __uint_as_float(kk.w & 0xffff0000u), d);
            }
            s = d * QK_SCALE + bias;
        }
        sc[j] = s; mx = fmaxf(mx, s);
    }
    if (has_sink) mx = fmaxf(mx, sink);
    mx = wave_max(mx);
    float sum = 0.f;
    for (int j = lane; j < nkeys; j += 64) { const float p = __expf(sc[j] - mx); sc[j] = p; sum += p; }
    sum = wave_sum(sum);
    if (has_sink) sum += __expf(sink - mx);
    LDS_FENCE();
    float o0 = 0.f, o1 = 0.f;
    for (int j = 0; j < nkeys; ++j) {
        const float p = sc[j];
        if (p != 0.f) {
            const bf16_t* kp; const bf16_t* vp; float bias;
            key(j, kp, vp, bias);
            const unsigned vv = *(const unsigned*)(vp + 2 * lane);
            o0 = fmaf(p, __uint_as_float(vv << 16), o0); o1 = fmaf(p, __uint_as_float(vv & 0xffff0000u), o1);
        }
    }
    const float inv = 1.0f / sum;
    *(unsigned*)(out + 2 * lane) = pk2(o0 * inv, o1 * inv);
    LDS_FENCE();
}

struct KeyWA {
    const bf16_t* kv; int t, kvh;
    __device__ __forceinline__ bool operator()(int j, const bf16_t*& kp, const bf16_t*& vp, float& bias) const {
        bias = 0.f;
        int row; bool ok = true;
        if (j < 257) { const int kpos = t - 128 + j; ok = kpos >= 0 && kpos < L; row = ok ? kpos : 0; } else row = L + (j - 257);
        kp = kv + (size_t)row * 512 + kvh * 128; vp = kp + 256; return ok;
    }
};
struct KeyCtxWA { const bf16_t* kv; int kvh;
    __device__ __forceinline__ bool operator()(int j, const bf16_t*& kp, const bf16_t*& vp, float& bias) const { bias = 0.f; kp = kv + (size_t)(L + j) * 512 + kvh * 128; vp = kp + 256; return true; } };
struct KeyNA {
    const bf16_t* kv; const float* rpb; int r, qc, r0, cs, h;
    __device__ __forceinline__ bool operator()(int j, const bf16_t*& kp, const bf16_t*& vp, float& bias) const {
        int row;
        if (j < 128) { const int w = j >> 4, kc = cs + (j & 15); row = (r0 + w) * GRIDW + kc;
            const int dr = r0 + w - r + 7; int dc = kc - qc + 15; dc = dc < 0 ? 0 : (dc > 30 ? 30 : dc);
            bias = rpb[(h * 15 + dr) * 31 + dc]; }
        else { row = L + (j - 128); bias = 0.f; }
        kp = kv + (size_t)row * 2048 + h * 128; vp = kp + 1024; return true;
    }
};
struct KeyCtxNA { const bf16_t* kv; int h;
    __device__ __forceinline__ bool operator()(int j, const bf16_t*& kp, const bf16_t*& vp, float& bias) const { bias = 0.f; kp = kv + (size_t)(L + j) * 2048 + h * 128; vp = kp + 1024; return true; } };


#define HYF __device__ __forceinline__
#define HYF_OPAQUE(x) asm volatile("" : "+v"(x))
#define HYF_SB(i) do { if (((i) & 3) == 3) __builtin_amdgcn_sched_barrier(0); } while (0)
namespace hyf {
constexpr int FL = 16384;
constexpr int FPAD = FL + 32 * 16;
typedef float cpx __attribute__((ext_vector_type(2)));
HYF int phys(int p) { return ((p & ~15) | ((p & 15) ^ ((p >> 5) & 15))) + ((p >> 9) << 4); }

#define HYF_C32 {1.0f, 0.98078528040323043f, 0.92387953251128674f, 0.83146961230254524f, 0.70710678118654752f, 0.55557023301960218f, 0.38268343236508978f, 0.19509032201612825f, \
                 0.0f, -0.19509032201612825f, -0.38268343236508978f, -0.55557023301960218f, -0.70710678118654752f, -0.83146961230254524f, -0.92387953251128674f, -0.98078528040323043f}
#define HYF_S32 {0.0f, 0.19509032201612825f, 0.38268343236508978f, 0.55557023301960218f, 0.70710678118654752f, 0.83146961230254524f, 0.92387953251128674f, 0.98078528040323043f, \
                 1.0f, 0.98078528040323043f, 0.92387953251128674f, 0.83146961230254524f, 0.70710678118654752f, 0.55557023301960218f, 0.38268343236508978f, 0.19509032201612825f}

HYF int rev5(int x) { return (int)(__builtin_bitreverse32((unsigned)x) >> 27); }
HYF int rev4(int x) { return (int)(__builtin_bitreverse32((unsigned)x) >> 28); }
HYF cpx cmul(cpx a, cpx t) { return a.xx * t + (cpx){-a.y, a.y} * t.yx; }
HYF cpx cmulc(cpx a, cpx t) { return t.xx * a + t.yy * (cpx){a.y, -a.x}; }

template <int N, int SG, int BASE, int STRIDE32>
struct DifStage {
    static HYF void run(cpx (&v)[32], const float (&K)[9]) {
        constexpr int H = N / 2;
#pragma unroll
        for (int j = 0; j < H; ++j) {
            const cpx a = v[BASE + j], b = v[BASE + j + H];
            v[BASE + j] = a + b;
            const cpx d = a - b;
            const int tw = j * STRIDE32;
            if (tw == 0) v[BASE + j + H] = d;
            else if (tw == 8) v[BASE + j + H] = (SG < 0) ? (cpx){d.y, -d.x} : (cpx){-d.y, d.x};
            else {
                const float c = (tw < 8) ? K[tw] : -K[16 - tw];
                const float sa = (tw < 8) ? K[8 - tw] : K[tw - 8];
                const float s = (SG < 0) ? -sa : sa;
                v[BASE + j + H] = d * c + (cpx){-d.y, d.x} * s;
            }
        }
        if constexpr (N > 2) { DifStage<H, SG, BASE, STRIDE32 * 2>::run(v, K); DifStage<H, SG, BASE + H, STRIDE32 * 2>::run(v, K); }
    }
};
template <int SG> HYF void dft32(cpx (&v)[32], const float (&K0)[9]) { float K[9]; _Pragma("unroll") for (int m = 0; m < 9; ++m) { K[m] = K0[m]; HYF_OPAQUE(K[m]); } DifStage<32, SG, 0, 1>::run(v, K); }
template <int SG> HYF void dft16(cpx (&v)[32], const float (&K0)[9]) { float K[9]; _Pragma("unroll") for (int m = 0; m < 9; ++m) { K[m] = K0[m]; HYF_OPAQUE(K[m]); } DifStage<16, SG, 0, 2>::run(v, K); }

struct ThreadTw { cpx w1;
                  cpx w2;
                  cpx wo;
                  int b1;
                  int b2, n3;
                  int b3[2], sw;
                  float K[9]; };
HYF void tw_addr(int tid, ThreadTw& t) {
    t.b1 = (tid & ~15) | ((tid & 15) ^ ((tid >> 5) & 15));
    t.b2 = (tid >> 4) * 528; t.n3 = tid & 15; t.sw = (tid >> 1) & 15;
    for (int h = 0; h < 2; ++h) { const int g = tid + 512 * h; t.b3[h] = g * 16 + (g >> 5) * 16; }
    constexpr float KK[9] = {1.0f, 0.98078528040323043f, 0.92387953251128674f, 0.83146961230254524f, 0.70710678118654752f, 0.55557023301960218f, 0.38268343236508978f, 0.19509032201612825f, 0.0f};
    for (int m = 0; m < 9; ++m) { t.K[m] = KK[m]; HYF_OPAQUE(t.K[m]); }
}

HYF void fwd_p1(const ThreadTw& tw, cpx (&v)[32], cpx* lds) {
    int b1 = tw.b1; HYF_OPAQUE(b1);
    float wx = tw.w1.x, wy = tw.w1.y; HYF_OPAQUE(wx); HYF_OPAQUE(wy); const cpx w = {wx, wy};
    dft32<-1>(v, tw.K);
    cpx t = {1.f, 0.f};
#pragma unroll
    for (int k1 = 0; k1 < 32; ++k1) {
        lds[b1 + 528 * k1] = cmul(v[rev5(k1)], t);
        t = cmul(t, w);
        HYF_SB(k1);
    }
}
HYF void fwd_p2(const ThreadTw& tw, cpx* lds) {
    int b2 = tw.b2, n3 = tw.n3; HYF_OPAQUE(b2); HYF_OPAQUE(n3);
    float wx = tw.w2.x, wy = tw.w2.y; HYF_OPAQUE(wx); HYF_OPAQUE(wy); const cpx w = {wx, wy};
    cpx v[32];
#pragma unroll
    for (int n2 = 0; n2 < 32; ++n2) v[n2] = lds[b2 + 16 * n2 + (n3 ^ ((n2 >> 1) & 15))];
    dft32<-1>(v, tw.K);
    cpx t = {1.f, 0.f};
#pragma unroll
    for (int k2 = 0; k2 < 32; ++k2) {
        lds[b2 + 16 * k2 + (n3 ^ ((k2 >> 1) & 15))] = cmul(v[rev5(k2)], t);
        t = cmul(t, w);
        HYF_SB(k2);
    }
}
HYF void fwd_p3(int tid, const ThreadTw& tw, const cpx* lds, cpx* ks) {
    HYF_OPAQUE(tid);
#pragma unroll
    for (int h = 0; h < 2; ++h) {
        int b3 = tw.b3[h], sw = tw.sw; HYF_OPAQUE(b3); HYF_OPAQUE(sw);
        cpx v[32];
#pragma unroll
        for (int n3 = 0; n3 < 16; ++n3) v[n3] = lds[b3 + (n3 ^ sw)];
        dft16<-1>(v, tw.K);
#pragma unroll
        for (int k3 = 0; k3 < 16; ++k3) ks[(h * 16 + k3) * 512 + tid] = v[rev4(k3)];
    }
}
HYF void mid_p3(int tid, const ThreadTw& tw, cpx* lds, const cpx* ks) {
    HYF_OPAQUE(tid);
#pragma unroll
    for (int h = 0; h < 2; ++h) {
        int b3 = tw.b3[h], sw = tw.sw; HYF_OPAQUE(b3); HYF_OPAQUE(sw);
        cpx v[32], p[32];
#pragma unroll
        for (int n3 = 0; n3 < 16; ++n3) v[n3] = lds[b3 + (n3 ^ sw)];
        dft16<-1>(v, tw.K);
#pragma unroll
        for (int k3 = 0; k3 < 16; ++k3) p[k3] = cmul(v[rev4(k3)], ks[(h * 16 + k3) * 512 + tid]);
        dft16<1>(p, tw.K);
#pragma unroll
        for (int n3 = 0; n3 < 16; ++n3) lds[b3 + (n3 ^ sw)] = p[rev4(n3)];
    }
}
HYF void inv_p2(const ThreadTw& tw, cpx* lds) {
    int b2 = tw.b2, n3 = tw.n3; HYF_OPAQUE(b2); HYF_OPAQUE(n3);
    float wx = tw.w2.x, wy = tw.w2.y; HYF_OPAQUE(wx); HYF_OPAQUE(wy); const cpx w = {wx, wy};
    cpx v[32];
    cpx t = {1.f, 0.f};
#pragma unroll
    for (int k2 = 0; k2 < 32; ++k2) {
        v[k2] = cmulc(lds[b2 + 16 * k2 + (n3 ^ ((k2 >> 1) & 15))], t);
        t = cmul(t, w);
        HYF_SB(k2);
    }
    dft32<1>(v, tw.K);
#pragma unroll
    for (int n2 = 0; n2 < 32; ++n2) { lds[b2 + 16 * n2 + (n3 ^ ((n2 >> 1) & 15))] = v[rev5(n2)]; HYF_SB(n2); }
}
HYF void inv_p1(const ThreadTw& tw, const cpx* lds, cpx (&out)[32]) {
    int b1 = tw.b1; HYF_OPAQUE(b1);
    float wx = tw.w1.x, wy = tw.w1.y; HYF_OPAQUE(wx); HYF_OPAQUE(wy); const cpx w = {wx, wy};
    cpx v[32];
    cpx t = {1.f, 0.f};
#pragma unroll
    for (int k1 = 0; k1 < 32; ++k1) {
        v[k1] = cmulc(lds[b1 + 528 * k1], t);
        t = cmul(t, w);
        HYF_SB(k1);
    }
    dft32<1>(v, tw.K);
#pragma unroll
    for (int n1 = 0; n1 < 32; ++n1) out[n1] = v[rev5(n1)];
}
HYF cpx opaque_wo(const ThreadTw& tw) { float x = tw.wo.x, y = tw.wo.y; HYF_OPAQUE(x); HYF_OPAQUE(y); return (cpx){x, y}; }
HYF cpx modfac(cpx wo, int n1) {
    constexpr float C64[32] = {1.0f, 0.99518472667219693f, 0.98078528040323043f, 0.95694033573220882f, 0.92387953251128674f, 0.88192126434835505f, 0.83146961230254524f, 0.77301045336273699f,
        0.70710678118654752f, 0.63439328416364549f, 0.55557023301960218f, 0.47139673682599764f, 0.38268343236508978f, 0.29028467725446233f, 0.19509032201612825f, 0.098017140329560604f,
        0.0f, -0.098017140329560604f, -0.19509032201612825f, -0.29028467725446233f, -0.38268343236508978f, -0.47139673682599764f, -0.55557023301960218f, -0.63439328416364549f,
        -0.70710678118654752f, -0.77301045336273699f, -0.83146961230254524f, -0.88192126434835505f, -0.92387953251128674f, -0.95694033573220882f, -0.98078528040323043f, -0.99518472667219693f};
    constexpr float S64[32] = {0.0f, 0.098017140329560604f, 0.19509032201612825f, 0.29028467725446233f, 0.38268343236508978f, 0.47139673682599764f, 0.55557023301960218f, 0.63439328416364549f,
        0.70710678118654752f, 0.77301045336273699f, 0.83146961230254524f, 0.88192126434835505f, 0.92387953251128674f, 0.95694033573220882f, 0.98078528040323043f, 0.99518472667219693f,
        1.0f, 0.99518472667219693f, 0.98078528040323043f, 0.95694033573220882f, 0.92387953251128674f, 0.88192126434835505f, 0.83146961230254524f, 0.77301045336273699f,
        0.70710678118654752f, 0.63439328416364549f, 0.55557023301960218f, 0.47139673682599764f, 0.38268343236508978f, 0.29028467725446233f, 0.19509032201612825f, 0.098017140329560604f};
    return cmul(wo, (cpx){C64[n1], -S64[n1]});
}
}

#undef HYF
#ifndef FAST_HY
#define FAST_HY 1
#endif
__device__ __forceinline__ void hyena_fft_unit(const Ctx& c, int layer, int ch, const hyf::ThreadTw& tw) {
    using namespace hyf;
    cpx* lds = (cpx*)c.smem; float* red = (float*)(c.smem + (size_t)FPAD * 8);
    cpx* ks = c.wsp<cpx>(WS_KS) + (size_t)c.bid * (2 * FL);
    float* ub = (float*)(ks + FL); float* yb = ub + FL;
    const int tid = c.tid;
    const float* cw = c.in[8] + (size_t)layer * 3 * 3072; const float* cb = c.in[9] + (size_t)layer * 3072;
    const bf16_t* zv = c.wsp<bf16_t>(WS_ZHYT) + (size_t)ch * MR;
    const bf16_t* KF = c.wsp<bf16_t>(WS_KF);
    { const float w0 = cw[ch], w1 = cw[3072 + ch], w2 = cw[6144 + ch], b = cb[ch]; int tq = tid; HYF_OPAQUE(tq);
#pragma unroll 4
      for (int j = 0; j < 32; ++j) ub[tq + 512 * j] = shortconv_at(zv, tq + 512 * j, L, w0, w1, w2, b); }
#pragma unroll 1
    for (int o = 0; o < 2; ++o) {
        const bf16_t* hf = KF + (size_t)(o * 1024 + ch) * L;
        const bf16_t* hb = KF + (size_t)(2048 + o * 1024 + ch) * L;
        float S;
        {
            cpx v[32]; float sabs = 0.f; int tq = tid; HYF_OPAQUE(tq);
#pragma unroll
            for (int j = 0; j < 32; ++j) { const int n = tq + 512 * j; const float f = bf2f(hf[n]); const float bb = bf2f(hb[n == 0 ? 0 : L - n]);
                v[j] = (cpx){f + bb, 0.f}; sabs += (n == 0) ? fabsf(f + bb) : fabsf(f) + fabsf(bb); }
            S = block_sum(sabs, red, tid);
            fwd_p1(tw, v, lds); __syncthreads(); fwd_p2(tw, lds); __syncthreads(); fwd_p3(tid, tw, lds, ks); __syncthreads();
        }
        {
            cpx v[32]; int tq = tid; HYF_OPAQUE(tq);
#pragma unroll
            for (int j = 0; j < 32; ++j) v[j] = (cpx){ub[tq + 512 * j], 0.f};
            fwd_p1(tw, v, lds); __syncthreads(); fwd_p2(tw, lds); __syncthreads(); mid_p3(tid, tw, lds, ks); __syncthreads();
            inv_p2(tw, lds); __syncthreads();
            inv_p1(tw, lds, v); __syncthreads();
            HYF_OPAQUE(tq);
#pragma unroll
            for (int j = 0; j < 32; ++j) yb[tq + 512 * j] = v[j].x;
        }
        {
            cpx v[32]; const cpx wo = opaque_wo(tw); int tq = tid; HYF_OPAQUE(tq);
#pragma unroll
            for (int j = 0; j < 32; ++j) { const int n = tq + 512 * j; const float f = bf2f(hf[n]); const float bb = bf2f(hb[n == 0 ? 0 : L - n]);
                const float d = (n == 0) ? f + bb : f - bb; v[j] = modfac(wo, j) * d; }
            fwd_p1(tw, v, lds); __syncthreads(); fwd_p2(tw, lds); __syncthreads(); fwd_p3(tid, tw, lds, ks); __syncthreads();
        }
        {
            cpx v[32]; cpx wo = opaque_wo(tw); int tq = tid; HYF_OPAQUE(tq);
#pragma unroll
            for (int j = 0; j < 32; ++j) v[j] = modfac(wo, j) * ub[tq + 512 * j];
            fwd_p1(tw, v, lds); __syncthreads(); fwd_p2(tw, lds); __syncthreads(); mid_p3(tid, tw, lds, ks); __syncthreads();
            inv_p2(tw, lds); __syncthreads();
            inv_p1(tw, lds, v); __syncthreads();
            const float sc = (0.5f / (float)L) / S; wo = opaque_wo(tw); HYF_OPAQUE(tq);
            const float dsk = c.in[17][(size_t)layer * 2048 + o * 1024 + ch];
            const int co = o == 0 ? 1024 : 2048;
            const bf16_t* zz = c.wsp<bf16_t>(WS_ZHYT) + (size_t)(co + ch) * MR;
            const float w0 = cw[co + ch], w1 = cw[3072 + co + ch], w2 = cw[6144 + co + ch], b = cb[co + ch];
            bf16_t* dst = c.wsp<bf16_t>(WS_YHYT) + (size_t)ch * L;
#pragma unroll
            for (int j = 0; j < 32; ++j) { const int t = tq + 512 * j; const cpx m = modfac(wo, j);
                const float conv = (yb[t] + v[j].x * m.x + v[j].y * m.y) * sc;
                const float r = shortconv_at(zz, t, L, w0, w1, w2, b) * (conv + ub[t] * dsk);
                if (o == 0) ub[t] = r; else dst[t] = f2bf(r); }
        }
    }
}


#ifndef FAST_ATT
#define FAST_ATT 1
#endif
namespace fa {
using bf16x8 = __attribute__((ext_vector_type(8))) short;
using s16x4  = __attribute__((ext_vector_type(4))) short;
using f32x16 = __attribute__((ext_vector_type(16))) float;
using u32x4  = __attribute__((ext_vector_type(4))) unsigned;
constexpr int AD = 128, NW = 8, QBLK = 32, KVBLK = 64;
constexpr float SCALE = 0.088388347648318440f;
constexpr float THR = 8.f;
constexpr size_t SHM_V = KVBLK * AD * 2, SHM_K = KVBLK * AD * 2, SHM_ATTN = 2 * SHM_V + 2 * SHM_K + NW * 64 * 4;
constexpr float NEG = -1e30f;
#define KSWZ(row, colB) ((row) * 256 + ((colB) ^ (((row) & 7) << 4)))
#define SBAR() __builtin_amdgcn_sched_barrier(0)
__device__ __forceinline__ int crow(int r, int hi) { return (r & 3) + 8 * (r >> 2) + 4 * hi; }
__device__ __forceinline__ unsigned cvtpk(float lo, float hi) { unsigned r; asm volatile("v_cvt_pk_bf16_f32 %0, %1, %2" : "=v"(r) : "v"(lo), "v"(hi)); return r; }
__device__ __forceinline__ void partialSM(f32x16& p0, f32x16& p1, float& m_reg, float& mn, float& alpha) {
  constexpr float C = SCALE * 1.4426950408889634f;
  float pmax = p0[0];
#pragma unroll
  for (int r = 1; r < 16; ++r) pmax = fmaxf(pmax, p0[r]);
#pragma unroll
  for (int r = 0; r < 16; ++r) pmax = fmaxf(pmax, p1[r]);
  { auto rr = __builtin_amdgcn_permlane32_swap(__float_as_uint(pmax), __float_as_uint(pmax), false, false);
    pmax = fmaxf(__uint_as_float(rr[0]), __uint_as_float(rr[1])); }
  if (__builtin_expect(__all(pmax - m_reg <= THR / SCALE), 1)) { mn = m_reg; alpha = 1.f; }
  else { mn = fmaxf(m_reg, pmax); alpha = __builtin_amdgcn_exp2f((m_reg - mn) * C); m_reg = mn; }
  const float mnC = -mn * C;
#pragma unroll
  for (int r = 0; r < 16; ++r) p0[r] = fmaf(p0[r], C, mnC);
#pragma unroll
  for (int r = 0; r < 16; ++r) p1[r] = fmaf(p1[r], C, mnC);
#pragma unroll
  for (int r = 0; r < 16; ++r) p0[r] = __builtin_amdgcn_exp2f(p0[r]);
}
__device__ __forceinline__ void finishSM(f32x16& p0, f32x16& p1, float alpha, float& l_reg, bf16x8& pa0, bf16x8& pa1, bf16x8& pa2, bf16x8& pa3) {
#pragma unroll
  for (int r = 0; r < 16; ++r) p1[r] = __builtin_amdgcn_exp2f(p1[r]);
  float ps = 0;
#pragma unroll
  for (int r = 0; r < 16; ++r) ps += p0[r];
#pragma unroll
  for (int r = 0; r < 16; ++r) ps += p1[r];
  { auto rr = __builtin_amdgcn_permlane32_swap(__float_as_uint(ps), __float_as_uint(ps), false, false);
    ps = __uint_as_float(rr[0]) + __uint_as_float(rr[1]); }
  l_reg = l_reg * alpha + ps;
#define PK4(P, BASE, OUT) do { unsigned a0 = cvtpk(P[BASE + 0], P[BASE + 1]), a1 = cvtpk(P[BASE + 2], P[BASE + 3]);   \
    unsigned b0 = cvtpk(P[BASE + 4], P[BASE + 5]), b1 = cvtpk(P[BASE + 6], P[BASE + 7]);                              \
    auto r0 = __builtin_amdgcn_permlane32_swap(a0, b0, false, false); auto r1 = __builtin_amdgcn_permlane32_swap(a1, b1, false, false); \
    u32x4 w = {r0[0], r1[0], r0[1], r1[1]}; OUT = *reinterpret_cast<bf16x8*>(&w); } while (0)
  PK4(p0, 0, pa0); PK4(p0, 8, pa1); PK4(p1, 0, pa2); PK4(p1, 8, pa3);
#undef PK4
}
__device__ __forceinline__ void qkt(f32x16& p0, f32x16& p1, const char* Ks, const bf16x8* qr, int r32, int hi) {
  p0 = f32x16{}; p1 = f32x16{};
#pragma unroll
  for (int d0 = 0; d0 < 8; ++d0) { const int cb = (d0 * 16 + hi * 8) * 2;
    const bf16x8 b0 = *reinterpret_cast<const bf16x8*>(Ks + KSWZ(r32, cb));
    const bf16x8 b1 = *reinterpret_cast<const bf16x8*>(Ks + KSWZ(32 + r32, cb));
    p0 = __builtin_amdgcn_mfma_f32_32x32x16_bf16(b0, qr[d0], p0, 0, 0, 0);
    p1 = __builtin_amdgcn_mfma_f32_32x32x16_bf16(b1, qr[d0], p1, 0, 0, 0); }
}
__device__ __forceinline__ int v_st(int k, int c) { const int kk = (k & ~0xC) | ((k & 4) << 1) | ((k & 8) >> 1); return ((kk >> 3) * 4 + (c >> 5)) * 512 + ((kk & 7) * 32 + (c & 31)) * 2; }
__device__ __forceinline__ int v_rd_base(int lane) { return ((lane & 3) << 3) | (((lane >> 2) & 3) << 6) | (((lane >> 4) & 1) << 5) | (((lane >> 5) & 1) << 8); }
constexpr int v_rd_off(int d0, int ks, int half) { return d0 * 512 + ks * 4096 + half * 2048; }
template <int OFF> __device__ __forceinline__ s16x4 tr_read(int vb) { s16x4 r; asm volatile("ds_read_b64_tr_b16 %0, %1 offset:%2" : "=&v"(r) : "v"(vb), "i"(OFF) : "memory"); return r; }
template <int D0> __device__ __forceinline__ void pv_one(f32x16& od, int vb, bf16x8 pa0, bf16x8 pa1, bf16x8 pa2, bf16x8 pa3) {
  const s16x4 l0 = tr_read<v_rd_off(D0, 0, 0)>(vb), h0 = tr_read<v_rd_off(D0, 0, 1)>(vb), l1 = tr_read<v_rd_off(D0, 1, 0)>(vb), h1 = tr_read<v_rd_off(D0, 1, 1)>(vb);
  const s16x4 l2 = tr_read<v_rd_off(D0, 2, 0)>(vb), h2 = tr_read<v_rd_off(D0, 2, 1)>(vb), l3 = tr_read<v_rd_off(D0, 3, 0)>(vb), h3 = tr_read<v_rd_off(D0, 3, 1)>(vb);
  asm volatile("s_waitcnt lgkmcnt(0)" ::: "memory"); SBAR();
#define PK(Lo, Hi) (bf16x8){Lo[0], Lo[1], Lo[2], Lo[3], Hi[0], Hi[1], Hi[2], Hi[3]}
  od = __builtin_amdgcn_mfma_f32_32x32x16_bf16(pa0, PK(l0, h0), od, 0, 0, 0);
  od = __builtin_amdgcn_mfma_f32_32x32x16_bf16(pa1, PK(l1, h1), od, 0, 0, 0);
  od = __builtin_amdgcn_mfma_f32_32x32x16_bf16(pa2, PK(l2, h2), od, 0, 0, 0);
  od = __builtin_amdgcn_mfma_f32_32x32x16_bf16(pa3, PK(l3, h3), od, 0, 0, 0);
#undef PK
}
__device__ __forceinline__ void pv_d0(f32x16* o, int vb, bf16x8 pa0, bf16x8 pa1, bf16x8 pa2, bf16x8 pa3) {
  pv_one<0>(o[0], vb, pa0, pa1, pa2, pa3); pv_one<1>(o[1], vb, pa0, pa1, pa2, pa3); pv_one<2>(o[2], vb, pa0, pa1, pa2, pa3); pv_one<3>(o[3], vb, pa0, pa1, pa2, pa3);
}

template <class Tiles>
__device__ __forceinline__ void attn_unit(const bf16_t* __restrict__ Qb, int ldq, const bf16_t* __restrict__ Kb, const bf16_t* __restrict__ Vb, int ldk,
                                          bf16_t* __restrict__ Ob, int ldo, const Tiles& T, int NT, bool has_sink, float sink, char* lds) {
  int tid = threadIdx.x; asm volatile("" : "+v"(tid));
  const int wid = __builtin_amdgcn_readfirstlane(tid >> 6), lane = tid & 63, r32 = lane & 31, hi = lane >> 5;
  char* V_lds = lds; char* K_lds = lds + 2 * SHM_V;
  float* ws = (float*)(lds + 2 * SHM_V + 2 * SHM_K) + wid * 64; float* li_l = ws; float* al_l = ws + 32;
  float m_reg = -1e30f, l_reg = 0; f32x16 o[4] = {}; bf16x8 qr[8];
  const bf16_t* Qw = Qb + (long)(wid * QBLK + r32) * ldq + hi * 8;
#pragma unroll
  for (int d0 = 0; d0 < 8; ++d0) qr[d0] = *reinterpret_cast<const bf16x8*>(Qw + d0 * 16);
  const int sr = tid >> 4, sc = (tid & 15) * 8, vst0 = v_st(sr, sc), vst1 = v_st(32 + sr, sc);
  const int vb0 = (int)(uintptr_t)V_lds + v_rd_base(lane);
  bf16x8 vs0, vs1, ks0, ks1;
#define SLOAD(j) do { const long _k0 = T.row(j); vs0 = *reinterpret_cast<const bf16x8*>(&Vb[(_k0 + sr) * ldk + sc]); vs1 = *reinterpret_cast<const bf16x8*>(&Vb[(_k0 + 32 + sr) * ldk + sc]); \
    ks0 = *reinterpret_cast<const bf16x8*>(&Kb[(_k0 + sr) * ldk + sc]); ks1 = *reinterpret_cast<const bf16x8*>(&Kb[(_k0 + 32 + sr) * ldk + sc]); } while (0)
#define SWRITE(b) do { *(bf16x8*)(V_lds + (b) * SHM_V + vst0) = vs0; *(bf16x8*)(V_lds + (b) * SHM_V + vst1) = vs1; const int kc = sc * 2; \
    *(bf16x8*)(K_lds + (b) * SHM_K + KSWZ(sr, kc)) = ks0; *(bf16x8*)(K_lds + (b) * SHM_K + KSWZ(32 + sr, kc)) = ks1; } while (0)
  __syncthreads();
  SLOAD(0); asm volatile("s_waitcnt vmcnt(0)" ::: "memory"); SWRITE(0);
  if (1 < NT) SLOAD(1);
#pragma unroll 1
  for (int j = 0; j < NT; ++j) {
    const int b = j & 1;
    __syncthreads();
    if (j + 1 < NT) { asm volatile("s_waitcnt vmcnt(0)" ::: "memory"); SWRITE(b ^ 1); if (j + 2 < NT) SLOAD(j + 2); }
    if (T.active(j, wid)) {
      f32x16 p0, p1; float mn, alpha; bf16x8 pa0, pa1, pa2, pa3;
      qkt(p0, p1, K_lds + b * SHM_K, qr, r32, hi); T.mask(p0, p1, j, wid, r32, hi);
      partialSM(p0, p1, m_reg, mn, alpha);
      if (__any(alpha < 1.f)) { if (hi == 0) al_l[r32] = alpha; asm volatile("s_waitcnt lgkmcnt(0)" ::: "memory");
#pragma unroll
        for (int d = 0; d < 4; ++d)
#pragma unroll
          for (int r = 0; r < 16; ++r) o[d][r] *= al_l[crow(r, hi)]; }
      finishSM(p0, p1, alpha, l_reg, pa0, pa1, pa2, pa3); SBAR();
      pv_d0(o, vb0 + b * (int)SHM_V, pa0, pa1, pa2, pa3);
    }
  }
  if (has_sink) { constexpr float C = SCALE * 1.4426950408889634f; l_reg += __builtin_amdgcn_exp2f(fmaf(sink, 1.4426950408889634f, -m_reg * C)); }
  if (hi == 0) li_l[r32] = l_reg; asm volatile("s_waitcnt lgkmcnt(0)" ::: "memory");
  float rli[16];
#pragma unroll
  for (int r = 0; r < 16; ++r) rli[r] = __builtin_amdgcn_rcpf(li_l[crow(r, hi)]);
  bf16_t* Ow = Ob + (long)(wid * QBLK) * ldo;
#pragma unroll
  for (int r = 0; r < 16; ++r) { const int orow = crow(r, hi);
#pragma unroll
    for (int d0 = 0; d0 < 4; ++d0) Ow[(long)orow * ldo + d0 * 32 + r32] = f2bf(o[d0][r] * rli[r]); }
#undef SLOAD
#undef SWRITE
}
#undef KSWZ
#undef SBAR

struct TilesGen {
  int mode, i0, lo, R, glo, nloc; const float* bias;
  __device__ __forceinline__ long row(int j) const {
    if (j < 4) return L + 64 * j;
    if (mode == 0) return lo + 64 * (j - 4);
    return (long)(glo + (j - 4)) * 64;
  }
  __device__ __forceinline__ bool active(int j, int wid) const {
    if (j < 4 || mode == 2) return true;
    if (mode == 0) { const int Tr = lo + 64 * (j - 4), q0 = i0 + 32 * wid; return Tr + 63 >= q0 - 128 && Tr <= q0 + 31 + 128; }
    const int kr = glo + (j - 4), qr = R + (wid >> 1);
    int r0 = qr - 4; r0 = r0 < 0 ? 0 : (r0 > 248 ? 248 : r0);
    return kr >= r0 && kr <= r0 + 7;
  }
  __device__ __forceinline__ void mask(f32x16& p0, f32x16& p1, int j, int wid, int r32, int hi) const {
    if (j < 4 || mode == 2) return;
    if (mode == 0) {
      const int Tr = lo + 64 * (j - 4), q0 = i0 + 32 * wid;
      if (q0 + 31 - Tr <= 128 && Tr + 63 - q0 <= 128) return;
      const int dq = q0 + r32 - Tr;
#pragma unroll
      for (int r = 0; r < 16; ++r) { const int kk = crow(r, hi); p0[r] = (kk >= dq - 128 && kk <= dq + 128) ? p0[r] : NEG; p1[r] = (kk + 32 >= dq - 128 && kk + 32 <= dq + 128) ? p1[r] : NEG; }
      return;
    }
    const int kr = glo + (j - 4), qr = R + (wid >> 1), qc = (wid & 1) * 32 + r32;
    int cs = qc - 8; cs = cs < 0 ? 0 : (cs > 48 ? 48 : cs);
    const float* bt = bias + (kr - qr + 7) * 32 + (15 - qc);
#pragma unroll
    for (int r = 0; r < 16; ++r) { const int k0 = crow(r, hi), k1 = k0 + 32;
      const bool v0 = (unsigned)(k0 - cs) < 16u, v1 = (unsigned)(k1 - cs) < 16u;
      p0[r] = v0 ? p0[r] + bt[v0 ? k0 : cs] : NEG; p1[r] = v1 ? p1[r] + bt[v1 ? k1 : cs] : NEG; }
  }
};
}

__device__ __forceinline__ void ph_attn_fast(const Ctx& c, int layer) {
  char* lds = (char*)c.smem;
  float* btab = (float*)(c.smem + fa::SHM_ATTN);
  const bf16_t* QWA = c.wsp<bf16_t>(WS_QWA); const bf16_t* KVWA = c.wsp<bf16_t>(WS_KVWA); bf16_t* YWA = c.wsp<bf16_t>(WS_YWA);
  const bf16_t* QNA = c.wsp<bf16_t>(WS_QNA); const bf16_t* KVNA = c.wsp<bf16_t>(WS_KVNA); bf16_t* YNA = c.wsp<bf16_t>(WS_YNA);
  const float* sinkp = c.in[20] + layer * 8; const float* rpb = c.in[23] + (size_t)layer * 8 * 15 * 31;
  const int nq = L / 256;
  const int nunits = 2 * 8 * nq + (layer == 0 ? 16 : 0);
#pragma unroll 1
  for (int u = c.bid; u < nunits; u += c.nb) {
    fa::TilesGen T; T.mode = 2; T.i0 = 0; T.lo = 0; T.R = 0; T.glo = 0; T.nloc = 0; T.bias = btab;
    int h, i0, NT; bool wa;
    if (u < 8 * nq) {
      wa = true; h = u / nq; i0 = (u % nq) * 256;
      const int lo = i0 - 128 < 0 ? 0 : i0 - 128, hiR = i0 + 384 > L ? L : i0 + 384;
      T.mode = 0; T.i0 = i0; T.lo = lo; NT = 4 + (hiR - lo) / 64;
    } else if (u < 16 * nq) {
      const int v = u - 8 * nq; wa = false; h = v / nq; const int qb = v % nq; i0 = qb * 256; const int R = qb * 4;
      int glo = R - 4; glo = glo < 0 ? 0 : (glo > 248 ? 248 : glo);
      int gh = R + 3 - 4; gh = gh < 0 ? 0 : (gh > 248 ? 248 : gh); gh += 7;
      T.mode = 1; T.R = R; T.glo = glo; T.nloc = gh - glo + 1; NT = 4 + T.nloc;
      __syncthreads();
      for (int e = c.tid; e < 15 * 32; e += NTHREADS) { const int dr = e >> 5, dc = e & 31; btab[e] = dc < 31 ? rpb[(h * 15 + dr) * 31 + dc] * (1.0f / fa::SCALE) : 0.f; }
    } else {
      const int v = u - 16 * nq; wa = v < 8; h = v & 7; i0 = L; NT = 4;
    }
    const bf16_t* Q = (wa ? QWA : QNA) + (size_t)i0 * 1024 + h * 128;
    const bf16_t* Kb = wa ? KVWA + (h >> 2) * 128 : KVNA + h * 128;
    const bf16_t* Vb = wa ? KVWA + 256 + (h >> 2) * 128 : KVNA + 1024 + h * 128;
    bf16_t* O = (wa ? YWA : YNA) + (size_t)i0 * 1024 + h * 128;
    fa::attn_unit(Q, 1024, Kb, Vb, wa ? 512 : 2048, O, 1024, T, NT, wa, wa ? sinkp[h] : 0.f, lds);
  }
}

__device__ __forceinline__ void ph_c(const Ctx& c, int layer) {
#ifndef NO_HY
    if (FAST_HY) {
        hyf::ThreadTw tw; hyf::tw_addr(c.tid, tw);
        { float s_, c_; sincospif(-2.0f * (float)c.tid / (float)hyf::FL, &s_, &c_); tw.w1 = (hyf::cpx){c_, s_};
          sincospif(-2.0f * (float)(c.tid & 15) / 512.0f, &s_, &c_); tw.w2 = (hyf::cpx){c_, s_};
          sincospif(-(float)c.tid / (float)hyf::FL, &s_, &c_); tw.wo = (hyf::cpx){c_, s_}; }
        for (int u = c.bid; u < 1024; u += c.nb) hyena_fft_unit(c, layer, u, tw);
    } else
    for (int u = c.bid; u < 1024; u += c.nb) hyena_direct_unit(c, layer, u);
#endif
#ifndef NO_HYC
    if (layer == 0) for (int u = c.bid; u < 1024; u += c.nb) hyena_ctx_unit(c, layer, u);
#endif
    __syncthreads();
#ifndef NO_ATT
    if (FAST_ATT) { ph_attn_fast(c, layer); return; }
    const int gw = c.bid * 8 + c.wave, ngw = c.nb * 8;
    float* wl = (float*)c.smem + c.wave * 768;
    const int nrows = layer == 0 ? MR : L;
    const float* sinkp = c.in[20] + layer * 8;
    const float* rpb = c.in[23] + (size_t)layer * 8 * 15 * 31;
    const bf16_t* kvwa = c.wsp<bf16_t>(WS_KVWA); const bf16_t* kvna = c.wsp<bf16_t>(WS_KVNA);
    for (int task = gw; task < nrows * 16; task += ngw) {
        const int r = task >> 4, hh = task & 15;
        if (hh < 8) {
            const int h = hh; const bf16_t* q = c.wsp<bf16_t>(WS_QWA) + (size_t)r * 1024 + h * 128; bf16_t* o = c.wsp<bf16_t>(WS_YWA) + (size_t)r * 1024 + h * 128;
            if (r < L) { const KeyWA k{kvwa, r, h >> 2}; wave_attn(q, 513, k, true, sinkp[h], o, wl, c.lane); }
            else { const KeyCtxWA k{kvwa, h >> 2}; wave_attn(q, 256, k, true, sinkp[h], o, wl, c.lane); }
        } else {
            const int h = hh - 8; const bf16_t* q = c.wsp<bf16_t>(WS_QNA) + (size_t)r * 1024 + h * 128; bf16_t* o = c.wsp<bf16_t>(WS_YNA) + (size_t)r * 1024 + h * 128;
            if (r < L) { const int gr = r / GRIDW, qc = r % GRIDW; int r0 = gr - 4; r0 = r0 < 0 ? 0 : (r0 > 248 ? 248 : r0); int cs = qc - 8; cs = cs < 0 ? 0 : (cs > 48 ? 48 : cs);
                const KeyNA k{kvna, rpb, gr, qc, r0, cs, h}; wave_attn(q, 384, k, false, 0.f, o, wl, c.lane); }
            else { const KeyCtxNA k{kvna, h}; wave_attn(q, 256, k, false, 0.f, o, wl, c.lane); }
        }
    }
#endif
}

__device__ __forceinline__ void ph_c2(const Ctx& c) {
    bf16_t* tile = (bf16_t*)c.smem;
    const bf16_t* src = c.wsp<bf16_t>(WS_YHYT); bf16_t* dst = c.wsp<bf16_t>(WS_YHY);
    for (int u = c.bid; u < (1024 / 64) * (L / 64); u += c.nb) {
        const int c0 = (u % 16) * 64, t0 = (u / 16) * 64;
        __syncthreads();
        for (int e = c.tid; e < 4096; e += NTHREADS) { const int cc = e >> 6, tt = e & 63; tile[cc * 66 + tt] = src[(size_t)(c0 + cc) * L + t0 + tt]; }
        __syncthreads();
        for (int e = c.tid; e < 4096; e += NTHREADS) { const int tt = e >> 6, cc = e & 63; dst[(size_t)(t0 + tt) * 1024 + c0 + cc] = tile[cc * 66 + tt]; }
    }
}

struct EpiMerge { unsigned char* ws; int b;
    __device__ __forceinline__ void operator()(int row, int col, const float (&v)[8]) const {
        const bf16_t* g = (const bf16_t*)(ws + WS_GATE) + (size_t)row * 6144 + b * 2048 + col;
        float* mp = (float*)(ws + WS_MPART) + (size_t)row * D + col;
        const uint4 gg = *(const uint4*)g;
        const float gv[8] = {__uint_as_float(gg.x << 16), __uint_as_float(gg.x & 0xffff0000u), __uint_as_float(gg.y << 16), __uint_as_float(gg.y & 0xffff0000u),
                             __uint_as_float(gg.z << 16), __uint_as_float(gg.z & 0xffff0000u), __uint_as_float(gg.w << 16), __uint_as_float(gg.w & 0xffff0000u)};
        float t[8];
        if (b == 0) {
#pragma unroll
            for (int j = 0; j < 8; ++j) t[j] = gv[j] * v[j];
        } else {
            const float4 p0 = *(const float4*)mp, p1 = *(const float4*)(mp + 4);
            const float pv[8] = {p0.x, p0.y, p0.z, p0.w, p1.x, p1.y, p1.z, p1.w};
#pragma unroll
            for (int j = 0; j < 8; ++j) t[j] = fmaf(gv[j], v[j], pv[j]);
        }
        if (b < 2) { *(float4*)mp = make_float4(t[0], t[1], t[2], t[3]); *(float4*)(mp + 4) = make_float4(t[4], t[5], t[6], t[7]); }
        else { uint4 o; o.x = pk2(t[0], t[1]); o.y = pk2(t[2], t[3]); o.z = pk2(t[4], t[5]); o.w = pk2(t[6], t[7]); *(uint4*)((bf16_t*)(ws + WS_MB) + (size_t)row * D + col) = o; }
    }
};
__device__ __forceinline__ void ph_d(const Ctx& c, int layer) {
    const int nM = MR / 128, nN = D / 128;
    for (int b = 0; b < 3; ++b) {
        const bf16_t* A = b == 0 ? c.wsp<bf16_t>(WS_YHY) : (b == 1 ? c.wsp<bf16_t>(WS_YWA) : c.wsp<bf16_t>(WS_YNA));
        const RowLin rp{A, 1024}; const EpiMerge ep{c.ws, b};
        const float* W = c.in[24] + ((size_t)layer * 3 + b) * 1024 * D;
        for (int u = c.bid; u < nM * nN; u += c.nb) sgemm_unit(rp, W, D, 1024, (u % nM) * 128, (u / nM) * 128, ep, (float*)c.smem, c.tid);
    }
}
struct EpiOut { const Ctx* c; int layer;
    __device__ __forceinline__ void operator()(int row, int col, const float (&v)[8]) const {
        const float* xin = c->xrow(layer, row) + col; const float* g = c->mod(layer, row < L ? 0 : 1, 2) + col;
        float* o = (float*)(c->ws + WS_XA) + (size_t)row * D + col;
        const float4 x0 = *(const float4*)xin, x1 = *(const float4*)(xin + 4), g0 = *(const float4*)g, g1 = *(const float4*)(g + 4);
        *(float4*)o = make_float4(x0.x + g0.x * v[0], x0.y + g0.y * v[1], x0.z + g0.z * v[2], x0.w + g0.w * v[3]);
        *(float4*)(o + 4) = make_float4(x1.x + g1.x * v[4], x1.y + g1.y * v[5], x1.z + g1.z * v[6], x1.w + g1.w * v[7]);
    }
};
__device__ __forceinline__ void ph_e(const Ctx& c, int layer) {
    const int nM = MR / 128, nN = D / 128;
    const RowLin rp{c.wsp<bf16_t>(WS_MB), D}; const EpiOut ep{&c, layer};
    const float* W = c.in[25] + (size_t)layer * D * D;
    for (int u = c.bid; u < nM * nN; u += c.nb) sgemm_unit(rp, W, D, D, (u % nM) * 128, (u / nM) * 128, ep, (float*)c.smem, c.tid);
}

__device__ __forceinline__ void ph_f(const Ctx& c, int layer) {
    const int gw = c.bid * 8 + c.wave, ngw = c.nb * 8;
    const float* g = c.in[26] + (size_t)layer * D;
    const float* wr = c.in[27] + (size_t)layer * D * NE;
    for (int r = gw; r < MR; r += ngw) {
        const float* x = c.wsp<float>(WS_XA) + (size_t)r * D;
        const int src = r < L ? 0 : 1;
        const float* sh = c.mod(layer, src, 3); const float* sc = c.mod(layer, src, 4);
        float4 v[8]; float ss = 0.f;
#pragma unroll
        for (int j = 0; j < 8; ++j) { v[j] = *(const float4*)(x + 4 * c.lane + 256 * j); ss += v[j].x * v[j].x + v[j].y * v[j].y + v[j].z * v[j].z + v[j].w * v[j].w; }
        ss = wave_sum(ss);
        const float inv = rsqrtf(ss * (1.0f / D) + RMS_EPS);
        bf16_t* o = c.wsp<bf16_t>(WS_H2) + (size_t)r * D;
        float lg[NE];
#pragma unroll
        for (int e = 0; e < NE; ++e) lg[e] = 0.f;
#pragma unroll
        for (int j = 0; j < 8; ++j) {
            const int col = 4 * c.lane + 256 * j;
            const float4 gg = *(const float4*)(g + col), s4 = *(const float4*)(sh + col), c4 = *(const float4*)(sc + col);
            const float y[4] = {v[j].x * inv * gg.x * (1.f + c4.x) + s4.x, v[j].y * inv * gg.y * (1.f + c4.y) + s4.y,
                                v[j].z * inv * gg.z * (1.f + c4.z) + s4.z, v[j].w * inv * gg.w * (1.f + c4.w) + s4.w};
            uint2 w; w.x = pk2(y[0], y[1]); w.y = pk2(y[2], y[3]);
            *(uint2*)(o + col) = w;
#pragma unroll
            for (int q = 0; q < 4; ++q) {
                const float4* wp = (const float4*)(wr + (size_t)(col + q) * NE);
#pragma unroll
                for (int e4 = 0; e4 < 4; ++e4) { const float4 w4 = wp[e4]; lg[e4 * 4 + 0] = fmaf(y[q], w4.x, lg[e4 * 4 + 0]); lg[e4 * 4 + 1] = fmaf(y[q], w4.y, lg[e4 * 4 + 1]); lg[e4 * 4 + 2] = fmaf(y[q], w4.z, lg[e4 * 4 + 2]); lg[e4 * 4 + 3] = fmaf(y[q], w4.w, lg[e4 * 4 + 3]); }
            }
        }
        float mx = -3e38f;
#pragma unroll
        for (int e = 0; e < NE; ++e) { lg[e] = wave_sum(lg[e]); mx = fmaxf(mx, lg[e]); }
        float sum = 0.f;
#pragma unroll
        for (int e = 0; e < NE; ++e) { lg[e] = expf(lg[e] - mx); sum += lg[e]; }
        float mine = 0.f;
#pragma unroll
        for (int e = 0; e < NE; ++e) mine = (c.lane == e) ? lg[e] / sum : mine;
        if (c.lane < NE) c.wsp<float>(WS_AFF)[(size_t)r * NE + c.lane] = mine;
    }
}

__device__ __forceinline__ void topk_unit(const Ctx& c, int e, int row0, int n, int K, int slot0) {
    unsigned* keys = (unsigned*)c.smem;
    unsigned* hist = keys + L;
    unsigned* sh = hist + 256;
    const int tid = c.tid, lane = c.lane, wave = c.wave;
    const float* aff = c.wsp<float>(WS_AFF);
    __syncthreads();
#pragma unroll 4
    for (int t = tid; t < n; t += NTHREADS) keys[t] = __float_as_uint(aff[(size_t)(row0 + t) * NE + e]);
    unsigned prefix = 0u, mask = 0u, need = (unsigned)K;
#pragma unroll 1
    for (int pass = 0; pass < 4; ++pass) {
        const int shift = 24 - 8 * pass;
        __syncthreads();
        if (tid < 256) hist[tid] = 0u;
        __syncthreads();
#pragma unroll 4
        for (int t = tid; t < n; t += NTHREADS) { const unsigned k = keys[t]; if ((k & mask) == prefix) atomicAdd(&hist[(k >> shift) & 255u], 1u); }
        __syncthreads();
        if (tid == 0) {
            unsigned cum = 0u; int b = 255;
            for (; b > 0; --b) { if (cum + hist[b] >= need) break; cum += hist[b]; }
            sh[0] = prefix | ((unsigned)b << shift); sh[1] = need - cum;
        }
        __syncthreads();
        prefix = sh[0]; need = sh[1]; mask |= 255u << shift;
    }
    const unsigned T = prefix; const unsigned cnt_gt = (unsigned)K - need;
    int* IDX = c.wsp<int>(WS_IDX) + (size_t)e * SLOTS; float* GS = c.wsp<float>(WS_GSEL) + (size_t)e * SLOTS; int* SL = c.wsp<int>(WS_SLOT) + (size_t)e * MR;
    unsigned base_gt = 0u, base_eq = 0u;
    const int rounds = (n + NTHREADS - 1) / NTHREADS;
#pragma unroll 1
    for (int j = 0; j < rounds; ++j) {
        const int t = tid + NTHREADS * j;
        const bool valid = t < n; const unsigned kj = valid ? keys[t] : 0u;
        const bool gt = valid && kj > T, eq = valid && kj == T;
        const unsigned long long mg = __ballot(gt), me = __ballot(eq);
        const unsigned long long lower = (lane == 0) ? 0ull : (~0ull >> (64 - lane));
        const unsigned rg = (unsigned)__popcll(mg & lower), re = (unsigned)__popcll(me & lower);
        __syncthreads();
        if (lane == 0) { sh[8 + wave] = (unsigned)__popcll(mg); sh[16 + wave] = (unsigned)__popcll(me); }
        __syncthreads();
        unsigned og = 0u, oe = 0u, tg = 0u, te = 0u;
#pragma unroll
        for (int w = 0; w < 8; ++w) { const unsigned a = sh[8 + w], b2 = sh[16 + w]; if (w < wave) { og += a; oe += b2; } tg += a; te += b2; }
        int slot = -1;
        if (gt) slot = (int)(base_gt + og + rg);
        else if (eq) { const unsigned rk = base_eq + oe + re; if (rk < need) slot = (int)(cnt_gt + rk); }
        if (valid) { SL[row0 + t] = slot >= 0 ? slot0 + slot : -1; if (slot >= 0) { IDX[slot0 + slot] = row0 + t; GS[slot0 + slot] = __uint_as_float(kj); } }
        base_gt += tg; base_eq += te;
    }
}
__device__ __forceinline__ void ph_g(const Ctx& c) {
    for (int u = c.bid; u < 32; u += c.nb) {
        if (u < 16) topk_unit(c, u, 0, L, CAP, 0);
        else { const int e = u - 16; topk_unit(c, e, L, LC, CAPC, CAP);
            for (int s = CAP + CAPC + c.tid; s < SLOTS; s += NTHREADS) { c.wsp<int>(WS_IDX)[(size_t)e * SLOTS + s] = 0; c.wsp<float>(WS_GSEL)[(size_t)e * SLOTS + s] = 0.f; } }
    }
}

struct EpiGate { float* tmp; __device__ __forceinline__ void operator()(int row, int col, const float (&v)[8]) const {
    float* p = tmp + (size_t)row * DF + col; *(float4*)p = make_float4(v[0], v[1], v[2], v[3]); *(float4*)(p + 4) = make_float4(v[4], v[5], v[6], v[7]); } };
struct EpiUp { const float* tmp; bf16_t* act; __device__ __forceinline__ void operator()(int row, int col, const float (&v)[8]) const {
    const float* p = tmp + (size_t)row * DF + col; const float4 a0 = *(const float4*)p, a1 = *(const float4*)(p + 4);
    const float a[8] = {a0.x, a0.y, a0.z, a0.w, a1.x, a1.y, a1.z, a1.w}; float t[8];
#pragma unroll
    for (int j = 0; j < 8; ++j) t[j] = silu_f(a[j]) * v[j];
    uint4 o; o.x = pk2(t[0], t[1]); o.y = pk2(t[2], t[3]); o.z = pk2(t[4], t[5]); o.w = pk2(t[6], t[7]);
    *(uint4*)(act + (size_t)row * DF + col) = o; } };
struct EpiDown { bf16_t* ye; __device__ __forceinline__ void operator()(int row, int col, const float (&v)[8]) const {
    uint4 o; o.x = pk2(v[0], v[1]); o.y = pk2(v[2], v[3]); o.z = pk2(v[4], v[5]); o.w = pk2(v[6], v[7]);
    *(uint4*)(ye + (size_t)row * D + col) = o; } };
__device__ __forceinline__ void ph_h(const Ctx& c, int layer) {
    const int nM = SLOTS / 128, nN = DF / 128;
    for (int which = 0; which < 2; ++which)
        for (int u = c.bid; u < NE * nM * nN; u += c.nb) {
            const int e = u / (nM * nN), r = u % (nM * nN), pm = r % nM, pn = r / nM;
            const RowGather rp{c.wsp<bf16_t>(WS_H2), D, c.wsp<int>(WS_IDX) + (size_t)e * SLOTS};
            float* tmp = c.wsp<float>(WS_TMP) + (size_t)e * SLOTS * DF;
            const float* W = c.in[which == 0 ? 28 : 29] + ((size_t)layer * NE + e) * D * DF;
            if (which == 0) { const EpiGate ep{tmp}; sgemm_unit(rp, W, DF, D, pm * 128, pn * 128, ep, (float*)c.smem, c.tid); }
            else { const EpiUp ep{tmp, c.wsp<bf16_t>(WS_ACT) + (size_t)e * SLOTS * DF}; sgemm_unit(rp, W, DF, D, pm * 128, pn * 128, ep, (float*)c.smem, c.tid); }
        }
}
__device__ __forceinline__ void ph_i(const Ctx& c, int layer) {
    const int nM = SLOTS / 128, nN = D / 128;
    for (int u = c.bid; u < NE * nM * nN; u += c.nb) {
        const int e = u / (nM * nN), r = u % (nM * nN), pm = r % nM, pn = r / nM;
        const RowLin rp{c.wsp<bf16_t>(WS_ACT) + (size_t)e * SLOTS * DF, DF};
        const EpiDown ep{c.wsp<bf16_t>(WS_YE) + (size_t)e * SLOTS * D};
        const float* W = c.in[30] + ((size_t)layer * NE + e) * DF * D;
        sgemm_unit(rp, W, D, DF, pm * 128, pn * 128, ep, (float*)c.smem, c.tid);
    }
}

__device__ __forceinline__ void ph_j(const Ctx& c, int layer) {
    const int gw = c.bid * 8 + c.wave, ngw = c.nb * 8;
    const int nrows = layer == 0 ? MR : L;
    for (int r = gw; r < nrows; r += ngw) {
        const float* x1 = c.wsp<float>(WS_XA) + (size_t)r * D;
        const float* g5 = c.mod(layer, r < L ? 0 : 1, 5);
        float* o = layer == 0 ? c.wsp<float>(WS_XB) + (size_t)r * D : c.out + (size_t)r * D;
        float acc[32];
#pragma unroll
        for (int j = 0; j < 32; ++j) acc[j] = 0.f;
        for (int e = 0; e < NE; ++e) {
            const int s = c.wsp<int>(WS_SLOT)[(size_t)e * MR + r];
            if (s >= 0) {
                const float gs = c.wsp<float>(WS_GSEL)[(size_t)e * SLOTS + s];
                const bf16_t* y = c.wsp<bf16_t>(WS_YE) + ((size_t)e * SLOTS + s) * D;
#pragma unroll
                for (int j = 0; j < 8; ++j) { const uint2 w = *(const uint2*)(y + 4 * c.lane + 256 * j);
                    acc[4 * j + 0] = fmaf(gs, __uint_as_float(w.x << 16), acc[4 * j + 0]); acc[4 * j + 1] = fmaf(gs, __uint_as_float(w.x & 0xffff0000u), acc[4 * j + 1]);
                    acc[4 * j + 2] = fmaf(gs, __uint_as_float(w.y << 16), acc[4 * j + 2]); acc[4 * j + 3] = fmaf(gs, __uint_as_float(w.y & 0xffff0000u), acc[4 * j + 3]); }
            }
        }
#pragma unroll
        for (int j = 0; j < 8; ++j) { const int col = 4 * c.lane + 256 * j; const float4 xv = *(const float4*)(x1 + col), gv = *(const float4*)(g5 + col);
            *(float4*)(o + col) = make_float4(xv.x + gv.x * acc[4 * j], xv.y + gv.y * acc[4 * j + 1], xv.z + gv.z * acc[4 * j + 2], xv.w + gv.w * acc[4 * j + 3]); }
    }
}


#ifndef FAST_B
#define FAST_B 1
#endif
#ifndef FAST_DE
#define FAST_DE 1
#endif
#ifndef FAST_HI
#define FAST_HI 1
#endif
__device__ __forceinline__ void ph_b_fast(const Ctx& c, int layer) {
    LAS unsigned char* lds = (LAS unsigned char*)c.smem;
    const char* WIN = (const char*)(c.ws + WS_WIN); const char* HX = (const char*)(c.ws + WS_HX);
    __syncthreads();
    {
        const pg8::GeomLin G{WIN, HX, D, D, D, nullptr}; pg8::StaticOrder S; S.init(3072 / 256, MR / 256, c.nb, c.bid);
        const pg8::EpiBf16Plain E{c.wsp<bf16_t>(WS_ZHYT), MR, 0};
        pg8::gemm_phase(lds, G, S, E);
    }
    {
        const pg8::GeomLin G{HX, WIN + (size_t)OFF_WAQ * D * 2, D, D, D, nullptr}; pg8::StaticOrder S; S.init(MR / 256, (NIN - OFF_WAQ) / 256, c.nb, c.bid);
        const pg8::EpiInRest E{c.ws};
        pg8::gemm_phase(lds, G, S, E);
    }
}
__device__ __forceinline__ void ph_d_fast(const Ctx& c, int layer) {
    LAS unsigned char* lds = (LAS unsigned char*)c.smem;
    const int nM = layer == 0 ? MR / 256 : L / 256;
    pg8::StaticOrder S; S.init(nM, D / 256, c.nb, c.bid);
    __syncthreads();
    { const pg8::GeomLin G{(const char*)(c.ws + WS_YHY), (const char*)(c.ws + WS_WBR), 1024, 1024, 1024, nullptr}; const pg8::EpiMergeF<0> E{c.ws}; pg8::gemm_phase(lds, G, S, E); }
    { const pg8::GeomLin G{(const char*)(c.ws + WS_YWA), (const char*)(c.ws + WS_WBR) + (size_t)D * 1024 * 2, 1024, 1024, 1024, nullptr}; const pg8::EpiMergeF<1> E{c.ws}; pg8::gemm_phase(lds, G, S, E); }
    { const pg8::GeomLin G{(const char*)(c.ws + WS_YNA), (const char*)(c.ws + WS_WBR) + (size_t)2 * D * 1024 * 2, 1024, 1024, 1024, nullptr}; const pg8::EpiMergeF<2> E{c.ws}; pg8::gemm_phase(lds, G, S, E); }
}
__device__ __forceinline__ void ph_e_fast(const Ctx& c, int layer) {
    LAS unsigned char* lds = (LAS unsigned char*)c.smem;
    const int nM = layer == 0 ? MR / 256 : L / 256;
    pg8::StaticOrder S; S.init(nM, D / 256, c.nb, c.bid);
    __syncthreads();
    const pg8::GeomLin G{(const char*)(c.ws + WS_MB), (const char*)(c.ws + WS_WOUT), D, D, D, nullptr}; const pg8::EpiOutF E{&c, layer};
    pg8::gemm_phase(lds, G, S, E);
}
__device__ __forceinline__ void ph_h_fast(const Ctx& c, int layer) {
    LAS unsigned char* lds = (LAS unsigned char*)c.smem;
    const int tpe = layer == 0 ? 9 : 8;
    pg8::StaticOrder S; S.init(NE * tpe, 2048 / 256, c.nb, c.bid);
    __syncthreads();
    const pg8::GeomExpert<true> G{(const char*)(c.ws + WS_H2), (const char*)(c.ws + WS_WGU), D, D, D, c.wsp<int>(WS_IDX), tpe, 2048};
    const pg8::EpiGU E{c.wsp<bf16_t>(WS_ACT)};
    pg8::gemm_phase(lds, G, S, E);
}
__device__ __forceinline__ void ph_i_fast(const Ctx& c, int layer) {
    LAS unsigned char* lds = (LAS unsigned char*)c.smem;
    const int tpe = layer == 0 ? 9 : 8;
    pg8::StaticOrder S; S.init(NE * tpe, D / 256, c.nb, c.bid);
    __syncthreads();
    const pg8::GeomExpert<false> G{(const char*)(c.ws + WS_ACT), (const char*)(c.ws + WS_WDN), DF, DF, DF, nullptr, tpe, D};
    const pg8::EpiBf16Plain E{c.wsp<bf16_t>(WS_YE), D, 0};
    pg8::gemm_phase(lds, G, S, E);
}

__global__ void __launch_bounds__(NTHREADS, 2) mega(KArgs a) {
    extern __shared__ __attribute__((aligned(16))) unsigned char smem[];
    Ctx c; c.in = a.in; c.out = a.out; c.ws = a.ws; c.bid = blockIdx.x; c.nb = gridDim.x; c.tid = threadIdx.x; c.lane = c.tid & 63;
    c.wave = __builtin_amdgcn_readfirstlane(c.tid >> 6); c.smem = smem;
    volatile LAS unsigned* st = (volatile LAS unsigned*)(LAS unsigned char*)(smem + LDS_BYTES - 16);
    if (c.tid == 0) { st[0] = 0u; st[1] = 0u; st[2] = 0u; st[3] = 0u; }
    __syncthreads();
    const int lo = a.ph_lo, hi = a.ph_hi;
    XcdBarrier bar; bar.bar = (unsigned*)(a.ws + WS_CTL); bar.x = 0; bar.st = st;
    if (hi - lo > 1) bar = xcd_barrier_post((unsigned*)(a.ws + WS_CTL), st);
#ifndef ONLY_PH
#define ONLY_PH -1
#endif
#define PSEL(j) (ONLY_PH < 0 || ONLY_PH == (j))
#ifndef REP_MASK
#define REP_MASK 0
#endif
#define DOREP(j) ((((REP_MASK) >> (j)) & 1) != 0)
#define IN(k) (lo <= (k) && (k) < hi)
#define LAUNDER(cc) Ctx cc = c; asm volatile("" : "+v"(cc.tid), "+v"(cc.lane)); asm volatile("" : "+s"(cc.bid), "+s"(cc.nb), "+s"(cc.wave), "+s"(cc.ws), "+s"(cc.out))
#define SEAM(k) do { if (IN(k) && IN((k) + 1)) xcd_barrier(bar); } while (0)
    if (PSEL(0) && IN(0)) { LAUNDER(cc); ph_g0(cc); } SEAM(0);
#define LAYER_PROGRAM(layer) do { const int b = 1 + (layer) * PH_PER_LAYER; \
        if (PSEL(1) && IN(b + 0)) { LAUNDER(cc); constexpr int ly = (layer); { ph_a(cc, ly); ph_taps(cc, ly); if (FAST_B || FAST_DE || FAST_HI) ph_conv(cc, ly); __syncthreads(); } if constexpr (DOREP(1)) { LAUNDER(cd); { Ctx& cc = cd; (void)cc; ph_a(cd, ly); ph_taps(cd, ly); if (FAST_B || FAST_DE || FAST_HI) ph_conv(cd, ly); __syncthreads(); } } } SEAM(b + 0); \
        if (PSEL(2) && IN(b + 1)) { LAUNDER(cc); constexpr int ly = (layer); { if (FAST_B) ph_b_fast(cc, ly); else ph_b(cc, ly); __syncthreads(); } if constexpr (DOREP(2)) { LAUNDER(cd); { Ctx& cc = cd; (void)cc; if (FAST_B) ph_b_fast(cd, ly); else ph_b(cd, ly); __syncthreads(); } } } SEAM(b + 1); \
        if (PSEL(3) && IN(b + 2)) { LAUNDER(cc); constexpr int ly = (layer); ph_b2(cc, ly); } SEAM(b + 2); \
        if (PSEL(4) && IN(b + 3)) { LAUNDER(cc); constexpr int ly = (layer); { ph_c(cc, ly); __syncthreads(); } if constexpr (DOREP(4)) { LAUNDER(cd); { Ctx& cc = cd; (void)cc; ph_c(cd, ly); __syncthreads(); } } } SEAM(b + 3); \
        if (PSEL(5) && IN(b + 4)) { LAUNDER(cc); constexpr int ly = (layer); { ph_c2(cc); __syncthreads(); } if constexpr (DOREP(5)) { LAUNDER(cd); { Ctx& cc = cd; (void)cc; ph_c2(cd); __syncthreads(); } } } SEAM(b + 4); \
        if (PSEL(6) && IN(b + 5)) { LAUNDER(cc); constexpr int ly = (layer); { if (FAST_DE) ph_d_fast(cc, ly); else ph_d(cc, ly); __syncthreads(); } if constexpr (DOREP(6)) { LAUNDER(cd); { Ctx& cc = cd; (void)cc; if (FAST_DE) ph_d_fast(cd, ly); else ph_d(cd, ly); __syncthreads(); } } } SEAM(b + 5); \
        if (PSEL(7) && IN(b + 6)) { LAUNDER(cc); constexpr int ly = (layer); { if (FAST_DE) ph_e_fast(cc, ly); else ph_e(cc, ly); __syncthreads(); } if constexpr (DOREP(7)) { LAUNDER(cd); { Ctx& cc = cd; (void)cc; if (FAST_DE) ph_e_fast(cd, ly); else ph_e(cd, ly); __syncthreads(); } } } SEAM(b + 6); \
        if (PSEL(8) && IN(b + 7)) { LAUNDER(cc); constexpr int ly = (layer); { ph_f(cc, ly); __syncthreads(); } if constexpr (DOREP(8)) { LAUNDER(cd); { Ctx& cc = cd; (void)cc; ph_f(cd, ly); __syncthreads(); } } } SEAM(b + 7); \
        if (PSEL(9) && IN(b + 8)) { LAUNDER(cc); constexpr int ly = (layer); { ph_g(cc); __syncthreads(); } if constexpr (DOREP(9)) { LAUNDER(cd); { Ctx& cc = cd; (void)cc; ph_g(cd); __syncthreads(); } } } SEAM(b + 8); \
        if (PSEL(10) && IN(b + 9)) { LAUNDER(cc); constexpr int ly = (layer); { if (FAST_HI) ph_h_fast(cc, ly); else ph_h(cc, ly); __syncthreads(); } if constexpr (DOREP(10)) { LAUNDER(cd); { Ctx& cc = cd; (void)cc; if (FAST_HI) ph_h_fast(cd, ly); else ph_h(cd, ly); __syncthreads(); } } } SEAM(b + 9); \
        if (PSEL(11) && IN(b + 10)) { LAUNDER(cc); constexpr int ly = (layer); { if (FAST_HI) ph_i_fast(cc, ly); else ph_i(cc, ly); __syncthreads(); } if constexpr (DOREP(11)) { LAUNDER(cd); { Ctx& cc = cd; (void)cc; if (FAST_HI) ph_i_fast(cd, ly); else ph_i(cd, ly); __syncthreads(); } } } SEAM(b + 10); \
        if (PSEL(12) && IN(b + 11)) { LAUNDER(cc); constexpr int ly = (layer); { ph_j(cc, ly); __syncthreads(); } if constexpr (DOREP(12)) { LAUNDER(cd); { Ctx& cc = cd; (void)cc; ph_j(cd, ly); __syncthreads(); } } } SEAM(b + 11); \
    } while (0)
    LAYER_PROGRAM(0);
    LAYER_PROGRAM(1);
#undef LAYER_PROGRAM
#undef IN
#undef SEAM
}

extern "C" void kernel_launch(void* const* d_in, const int* in_sizes, int n_in, void* d_out, int out_size, void* d_ws, size_t ws_size, hipStream_t stream) {
    static int grid = 0;
    if (grid == 0) {
        if (n_in != 31 || out_size != L * D || ws_size < WS_END) { fprintf(stderr, "kernel_launch: unexpected shapes: n_in %d out %d ws %zu (need %zu)\n", n_in, out_size, ws_size, (size_t)WS_END); grid = -1; return; }
        int dev = 0, cus = 0, per_cu = 0;
        if (hipGetDevice(&dev) != hipSuccess || hipDeviceGetAttribute(&cus, hipDeviceAttributeMultiprocessorCount, dev) != hipSuccess) { grid = -1; return; }
        if (hipFuncSetAttribute((const void*)mega, hipFuncAttributeMaxDynamicSharedMemorySize, LDS_BYTES) != hipSuccess) { fprintf(stderr, "kernel_launch: hipFuncSetAttribute failed\n"); grid = -1; return; }
        if (hipOccupancyMaxActiveBlocksPerMultiprocessor(&per_cu, (const void*)mega, NTHREADS, LDS_BYTES) != hipSuccess || per_cu < 1) fprintf(stderr, "kernel_launch: occupancy query says %d\n", per_cu);
        (void)hipGetLastError();
        grid = cus;
    }
    if (grid < 0) return;
    if (hipMemsetAsync((char*)d_ws + WS_CTL, 0, CTL_BYTES, stream) != hipSuccess) return;
    KArgs a{};
    for (int i = 0; i < 31; ++i) a.in[i] = (const float*)d_in[i];
    a.out = (float*)d_out; a.ws = (unsigned char*)d_ws;
#if ONE_LAUNCH
    a.ph_lo = 0; a.ph_hi = NPH;
    hipLaunchKernelGGL(mega, dim3(grid), dim3(NTHREADS), LDS_BYTES, stream, a);
#else
    for (int p = 0; p < NPH; ++p) { a.ph_lo = p; a.ph_hi = p + 1; hipLaunchKernelGGL(mega, dim3(grid), dim3(NTHREADS), LDS_BYTES, stream, a); }
#endif
    const hipError_t le = hipPeekAtLastError();
    if (le != hipSuccess) fprintf(stderr, "kernel_launch: launch failed: %s\n", hipGetErrorName(le));
}
```

```cpp
#include <hip/hip_runtime.h>
#include <stdint.h>
#include <stdio.h>

#ifndef ONE_LAUNCH
#define ONE_LAUNCH 1
#endif

#ifndef REP_MASK
#define REP_MASK 0
#endif
#define DOREP(j) ((((REP_MASK) >> (j)) & 1) != 0)
typedef unsigned short bf16_t;
#define LAS __attribute__((address_space(3)))

constexpr int L = 16384, LC = 256, MR = L + LC, D = 2048, NIN = 13824;
constexpr int HD = 128, GRIDW = 64;
constexpr int OFF_HY = 0, OFF_WAQ = 3072, OFF_WAKV = 4096, OFF_NAQ = 4608, OFF_NAKV = 5632, OFF_GATE = 7680;
constexpr int NE = 16, CAP = 2048, CAPC = 32, SLOTS = 2304, DF = 1024;
constexpr int NMOD = 6 * D;
constexpr float RMS_EPS = 1e-6f;
constexpr float QK_SCALE = 0.08838834764831845f;

constexpr size_t al256(size_t x) { return (x + 255) & ~(size_t)255; }
constexpr size_t WS_CTL = 0, CTL_BYTES = 1u << 20;
constexpr size_t WS_MOD = WS_CTL + CTL_BYTES;
constexpr size_t WS_H2B = WS_MOD + al256((size_t)2 * 2 * NMOD * 4);
constexpr size_t WS_FW3T = WS_H2B + al256((size_t)2 * MR * 256 * 2);
constexpr size_t WS_AFF = WS_FW3T + al256((size_t)2 * 4096 * 256 * 2);
constexpr size_t WS_IDX = WS_AFF + al256((size_t)MR * 16 * 4);
constexpr size_t WS_GSEL = WS_IDX + al256((size_t)NE * SLOTS * 4);
constexpr size_t WS_SLOT = WS_GSEL + al256((size_t)NE * SLOTS * 4);
constexpr size_t WS_KFC = WS_SLOT + al256((size_t)NE * MR * 4);
constexpr size_t WS_ZHYC = WS_KFC + al256((size_t)4096 * LC * 2);
constexpr size_t WS_XA = WS_ZHYC + al256((size_t)3072 * LC * 2);
constexpr size_t WS_XB = WS_XA + al256((size_t)MR * D * 4);
constexpr size_t WS_W = WS_XB + al256((size_t)MR * D * 4);
constexpr size_t W_BYTES = (size_t)2 * ((size_t)NIN * D + 3 * (size_t)D * 1024 + (size_t)D * D + (size_t)NE * 2048 * D + (size_t)NE * D * DF);
constexpr size_t WS_WIN = WS_W;
constexpr size_t WS_WBR = WS_WIN + (size_t)NIN * D * 2;
constexpr size_t WS_WOUT = WS_WBR + (size_t)3 * D * 1024 * 2;
constexpr size_t WS_WGU = WS_WOUT + (size_t)D * D * 2;
constexpr size_t WS_WDN = WS_WGU + (size_t)NE * 2048 * D * 2;
constexpr size_t WS_R3 = WS_W + al256(W_BYTES);
constexpr size_t R3_BYTES = (size_t)MR * D * 4 + (size_t)MR * D * 2;
constexpr size_t WS_KF = WS_R3;
constexpr size_t WS_KS = WS_R3 + al256((size_t)4096 * L * 2);
constexpr size_t WS_MPART = WS_R3;
constexpr size_t WS_MB = WS_R3 + (size_t)MR * D * 4;
constexpr size_t WS_TMP = WS_R3;
constexpr size_t WS_YE = WS_R3;
constexpr size_t WS_R4 = WS_R3 + al256(R3_BYTES);
constexpr size_t R4_BYTES = (size_t)MR * 6144 * 2;
constexpr size_t WS_GATE = WS_R4;
constexpr size_t WS_H2 = WS_R4;
constexpr size_t WS_ACT = WS_R4 + al256((size_t)MR * D * 2);
constexpr size_t WS_R5 = WS_R4 + al256(R4_BYTES);
constexpr size_t WS_HX = WS_R5;
constexpr size_t WS_YHYT = WS_R5;
constexpr size_t WS_YHY = WS_R5 + al256((size_t)1024 * L * 2);
constexpr size_t WS_ZHYT = WS_R5 + al256((size_t)MR * D * 2);
constexpr size_t WS_QWA = WS_ZHYT + al256((size_t)3072 * MR * 2);
constexpr size_t WS_KVWA = WS_QWA + al256((size_t)MR * 1024 * 2);
constexpr size_t WS_QNA = WS_KVWA + al256((size_t)MR * 512 * 2);
constexpr size_t WS_KVNA = WS_QNA + al256((size_t)MR * 1024 * 2);
constexpr size_t WS_YWA = WS_KVNA + al256((size_t)MR * 2048 * 2);
constexpr size_t WS_YNA = WS_YWA + al256((size_t)MR * 1024 * 2);
constexpr size_t WS_END = WS_YNA + al256((size_t)MR * 1024 * 2);
static_assert((size_t)1024 * L * 2 + (size_t)MR * 1024 * 2 <= (size_t)MR * D * 2 + 512, "YHYT+YHY overlay HX");
static_assert((size_t)4096 * L * 2 + 256 + (size_t)256 * 2 * 16384 * 8 <= R3_BYTES && (size_t)NE * SLOTS * D * 2 <= R3_BYTES && (size_t)NE * SLOTS * DF * 4 <= R3_BYTES, "R3");
static_assert((size_t)MR * D * 2 + 256 + (size_t)NE * SLOTS * DF * 2 <= R4_BYTES, "R4");

constexpr int LDS_BYTES = 160 * 1024;
constexpr int NTHREADS = 512;
constexpr int PH_PER_LAYER = 12, NPH = 1 + 2 * PH_PER_LAYER;

__device__ __forceinline__ float bf2f(bf16_t b) { return __uint_as_float(((unsigned)b) << 16); }
__device__ __forceinline__ bf16_t f2bf(float f) { unsigned u = __float_as_uint(f); u += 0x7fffu + ((u >> 16) & 1u); return (bf16_t)(u >> 16); }
__device__ __forceinline__ unsigned pk2(float lo, float hi) { return (unsigned)f2bf(lo) | ((unsigned)f2bf(hi) << 16); }
__device__ __forceinline__ float wave_sum(float v) {
#pragma unroll
    for (int o = 1; o < 64; o <<= 1) v += __shfl_xor(v, o);
    return v;
}
__device__ __forceinline__ float wave_max(float v) {
#pragma unroll
    for (int o = 1; o < 64; o <<= 1) v = fmaxf(v, __shfl_xor(v, o));
    return v;
}
__device__ __forceinline__ float silu_f(float x) { return x / (1.f + __expf(-x)); }
__device__ __forceinline__ float sigmoid_f(float x) { return 1.f / (1.f + __expf(-x)); }
#define LDS_FENCE() asm volatile("s_waitcnt lgkmcnt(0)" ::: "memory")

#define XB_TMO      128
#define XB_XCNT(j)  (256  + 64 * (j))
#define XB_XSUB(j)  (1280 + 64 * (j))
#define XB_XGEN(j)  (2304 + 64 * (j))
#define XB_TOP      3328
#define XB_TOPGEN   3392
#define XCD_BAR_WORDS 3456
#define XB_SPIN_CAP (1u << 22)

__device__ __forceinline__ unsigned xb_ld(unsigned* p)              { return __hip_atomic_load(p, __ATOMIC_RELAXED, __HIP_MEMORY_SCOPE_AGENT); }
__device__ __forceinline__ unsigned xb_add(unsigned* p, unsigned v) { return __hip_atomic_fetch_add(p, v, __ATOMIC_RELAXED, __HIP_MEMORY_SCOPE_AGENT); }
__device__ __forceinline__ unsigned xb_xcc_id() { return (unsigned)__builtin_amdgcn_s_getreg((3 << 11) | 20) & 0xFu; }
#define XB_SPIN(cond, bar) do { unsigned _sp = 0; while (cond) { __builtin_amdgcn_s_sleep(1); \
    if ((++_sp & 255u) == 0u) { if (xb_ld(&(bar)[XB_TMO])) break; if (_sp > XB_SPIN_CAP) { atomicAdd(&(bar)[XB_TMO], 1u); break; } } } } while (0)

struct XcdBarrier { unsigned* bar; unsigned x; volatile LAS unsigned* st; };

__device__ __forceinline__ XcdBarrier xcd_barrier_post(unsigned* bar, volatile LAS unsigned* st) {
    XcdBarrier b; b.bar = bar; b.x = xb_xcc_id(); b.st = st;
    if (threadIdx.x == 0) (void)xb_add(&bar[XB_XCNT(b.x)], 1u);
    return b;
}
__device__ __forceinline__ void xcd_barrier_complete(unsigned* bar, unsigned x, unsigned& nloc, unsigned& nx) {
    const unsigned G = gridDim.x * gridDim.y * gridDim.z;
    unsigned sum, cnt, mine, sp = 0u;
    for (;;) {
        sum = 0u; cnt = 0u; mine = 0u;
#pragma unroll
        for (unsigned j = 0; j < 16; ++j) { const unsigned c = xb_ld(&bar[XB_XCNT(j)]); sum += c; cnt += (c > 0u) ? 1u : 0u; mine = (j == x) ? c : mine; }
        if (sum == G) break;
        __builtin_amdgcn_s_sleep(1);
        if ((++sp & 255u) == 0u) { if (xb_ld(&bar[XB_TMO])) break; if (sp > XB_SPIN_CAP) { atomicAdd(&bar[XB_TMO], 1u); break; } }
    }
    nloc = mine > 0u ? mine : 1u; nx = cnt > 0u ? cnt : 1u;
}
__device__ __forceinline__ void xcd_barrier(const XcdBarrier& b) {
    asm volatile("s_waitcnt vmcnt(0)" ::: "memory");
    __syncthreads();
    if (threadIdx.x == 0) {
        unsigned* bar = b.bar;
        __builtin_amdgcn_s_waitcnt(0);
        unsigned nloc = b.st[0], nx = b.st[1];
        if (nloc == 0u) { xcd_barrier_complete(bar, b.x, nloc, nx); b.st[0] = nloc; b.st[1] = nx; }
        const unsigned old = xb_add(&bar[XB_XSUB(b.x)], 1u);
        const unsigned gen = old / nloc;
        if (old + 1u == (gen + 1u) * nloc) {
            __builtin_amdgcn_fence(__ATOMIC_RELEASE, "agent");
            asm volatile("s_waitcnt vmcnt(0)" ::: "memory");
            const unsigned og = xb_add(&bar[XB_TOP], 1u);
            const unsigned tg = og / nx;
            if (og + 1u == (tg + 1u) * nx) xb_add(&bar[XB_TOPGEN], 1u);
            else XB_SPIN(xb_ld(&bar[XB_TOPGEN]) == tg, bar);
            __builtin_amdgcn_fence(__ATOMIC_ACQUIRE, "agent");
            xb_add(&bar[XB_XGEN(b.x)], 1u);
            asm volatile("s_waitcnt vmcnt(0)" ::: "memory");
        } else {
            XB_SPIN(xb_ld(&bar[XB_XGEN(b.x)]) == gen, bar);
            __builtin_amdgcn_fence(__ATOMIC_ACQUIRE, "agent");
            asm volatile("s_waitcnt vmcnt(0)" ::: "memory");
        }
    }
    __syncthreads();
}

struct KArgs { const float* in[31]; float* out; unsigned char* ws; int ph_lo, ph_hi; };

struct Ctx {
    const float* const* in; float* out; unsigned char* ws;
    int bid, nb, tid, lane, wave;
    unsigned char* smem;
    template <class T> __device__ __forceinline__ T* wsp(size_t off) const { return (T*)(ws + off); }
    __device__ __forceinline__ const float* mod(int layer, int src, int chunk) const { return wsp<float>(WS_MOD) + ((size_t)(layer * 2 + src) * NMOD) + chunk * D; }
    __device__ __forceinline__ const float* xrow(int layer, int r) const {
        if (layer == 0) return r < L ? in[0] + (size_t)r * D : in[2] + (size_t)(r - L) * D;
        return wsp<float>(WS_XB) + (size_t)r * D;
    }
};

template <class RowPtr, class Epi>
__device__ __forceinline__ void sgemm_unit(const RowPtr& rp, const float* __restrict__ W, int ldw, int K, int m0, int n0, const Epi& ep, float* lds, int tid) {
    float* As = lds;
    float* Bs = lds + 16 * 132;
    const int ty = tid >> 4, tx = tid & 15;
    const int am = tid >> 2, kq = (tid & 3) * 4;
    const int bk = tid >> 5, n4 = (tid & 31) * 4;
    float acc[4][8];
#pragma unroll
    for (int i = 0; i < 4; ++i)
#pragma unroll
        for (int j = 0; j < 8; ++j) acc[i][j] = 0.f;
    const bf16_t* arow = rp(m0 + am);
    const float* wp = W + (size_t)bk * ldw + n0 + n4;
    for (int k0 = 0; k0 < K; k0 += 16) {
        const uint2 a4 = *(const uint2*)(arow + k0 + kq);
        const float4 b4 = *(const float4*)(wp + (size_t)k0 * ldw);
        __syncthreads();
        As[(kq + 0) * 132 + am] = __uint_as_float(a4.x << 16);
        As[(kq + 1) * 132 + am] = __uint_as_float(a4.x & 0xffff0000u);
        As[(kq + 2) * 132 + am] = __uint_as_float(a4.y << 16);
        As[(kq + 3) * 132 + am] = __uint_as_float(a4.y & 0xffff0000u);
        *(float4*)&Bs[bk * 128 + n4] = b4;
        __syncthreads();
#pragma unroll
        for (int kk = 0; kk < 16; ++kk) {
            const float4 a = *(const float4*)&As[kk * 132 + ty * 4];
            const float4 b0 = *(const float4*)&Bs[kk * 128 + tx * 8];
            const float4 b1 = *(const float4*)&Bs[kk * 128 + tx * 8 + 4];
            const float av[4] = {a.x, a.y, a.z, a.w};
            const float bv[8] = {b0.x, b0.y, b0.z, b0.w, b1.x, b1.y, b1.z, b1.w};
#pragma unroll
            for (int i = 0; i < 4; ++i)
#pragma unroll
                for (int j = 0; j < 8; ++j) acc[i][j] = fmaf(av[i], bv[j], acc[i][j]);
        }
    }
#pragma unroll
    for (int i = 0; i < 4; ++i) ep(m0 + ty * 4 + i, n0 + tx * 8, acc[i]);
}

struct RowLin { const bf16_t* base; int ld; __device__ __forceinline__ const bf16_t* operator()(int m) const { return base + (size_t)m * ld; } };
struct RowGather { const bf16_t* base; int ld; const int* idx; __device__ __forceinline__ const bf16_t* operator()(int m) const { return base + (size_t)idx[m] * ld; } };


namespace pg8 {
typedef short bf16x8 __attribute__((ext_vector_type(8)));
typedef float f32x4 __attribute__((ext_vector_type(4)));
typedef unsigned u32x4 __attribute__((ext_vector_type(4)));
typedef unsigned u32x2 __attribute__((ext_vector_type(2)));
constexpr int BM = 256, BK = 64, HALF = 128, HTB = HALF * BK * 2, STAGE_BYTES = 8 * HTB, NXCD = 8, WGM = 8;
__host__ __device__ __forceinline__ int lds_byte(int r, int c) { const int st = (r >> 4) * 2 + (c >> 5), rr = r & 15, cc = c & 31, ob = rr * 64 + cc * 2; return st * 1024 + (ob ^ (((ob >> 9) & 1) << 5)); }
__host__ __device__ __forceinline__ void stage_rc(int b, int& R, int& C) { const int st = b / 1024, sb = b % 1024, swz = sb ^ (((sb >> 9) & 1) << 5); R = (st >> 1) * 16 + swz / 64; C = (st & 1) * 32 + (swz % 64) / 2; }
__host__ __device__ __forceinline__ int perm32(int rho) { const int n = rho >> 4, i = rho & 15; return 8 * (i >> 2) + 4 * n + (i & 3); }
struct Unit { int pm, pn; };
struct StaticOrder {
    int nM, nN, nwg, G, c;
    __host__ __device__ void init(int nM_, int nN_, int G_, int c_) { nM = nM_; nN = nN_; nwg = nM * nN; G = G_; c = c_; }
    __host__ __device__ bool next(int i, Unit& u) const {
        const long Lq = (long)i * G + c; if (Lq >= nwg) return false;
        int wgid = (int)Lq; { const int q = nwg / NXCD, r = nwg % NXCD, xcd = wgid % NXCD, off = wgid / NXCD; wgid = (xcd < r ? xcd * (q + 1) : r * (q + 1) + (xcd - r) * q) + off; }
        const int nig = WGM * nN, gid = wgid / nig, fm = gid * WGM, gsz = (nM - fm) < WGM ? (nM - fm) : WGM;
        u.pm = fm + ((wgid % nig) % gsz); u.pn = (wgid % nig) / gsz; return true;
    }
};
__device__ __forceinline__ unsigned cvt_pk_bf16(float lo, float hi) { unsigned r; asm volatile("v_cvt_pk_bf16_f32 %0, %1, %2" : "=v"(r) : "v"(lo), "v"(hi)); return r; }

struct GeomLin {
    static constexpr bool GATHER = false;
    const char* A; const char* B; int K, lda, ldb; const int* idx;
    __device__ __forceinline__ const char* a_base(const Unit& u) const { return A + (size_t)u.pm * 256 * lda * 2; }
    __device__ __forceinline__ const char* b_base(const Unit& u) const { return B + (size_t)u.pn * 256 * ldb * 2; }
    __device__ __forceinline__ int row0(const Unit& u) const { return u.pm * 256; }
};
template <bool GATHER_> struct GeomExpert {
    static constexpr bool GATHER = GATHER_;
    const char* A; const char* B; int K, lda, ldb; const int* idx; int tpe, nb;
    __device__ __forceinline__ int row0(const Unit& u) const { const int e = u.pm / tpe, t = u.pm - e * tpe; return e * SLOTS + t * 256; }
    __device__ __forceinline__ const char* a_base(const Unit& u) const { return GATHER_ ? A : A + (size_t)row0(u) * lda * 2; }
    __device__ __forceinline__ const char* b_base(const Unit& u) const { const int e = u.pm / tpe; return B + ((size_t)e * nb + (size_t)u.pn * 256) * ldb * 2; }
};

template <class Epi, class Geom, class Sched>
__device__ __forceinline__ void gemm_phase(LAS unsigned char* lds, const Geom& G, const Sched& S, const Epi& E) {
    const int tid = threadIdx.x, wid = __builtin_amdgcn_readfirstlane(tid >> 6), lane = tid & 63, wr = wid >> 2, wc = wid & 3, fr = lane & 15, fq = lane >> 4;
    const int K = G.K, nt = K / BK;
    int Rs[2], Cs[2]; unsigned vB0[2], vA0[2], vAc[2][2], vAn[2][2];
#pragma unroll
    for (int i = 0; i < 2; ++i) { int R, C; stage_rc(tid * 16 + i * 8192, R, C); Rs[i] = R; Cs[i] = C; const int Rb = Epi::PERM ? ((R & ~31) + perm32(R & 31)) : R;
        vB0[i] = (unsigned)(Rb * G.ldb + C) * 2u; vA0[i] = (unsigned)(R * G.lda + C) * 2u;
#pragma unroll
        for (int h = 0; h < 2; ++h) { vAc[h][i] = 0u; vAn[h][i] = 0u; } }
    const size_t hstepA = (size_t)HALF * G.lda * 2, hstepB = (size_t)HALF * G.ldb * 2;
#define PG8_VOFF(dst, u) do { if constexpr (Geom::GATHER) { const int _r0 = G.row0(u); _Pragma("unroll") for (int _h = 0; _h < 2; ++_h) _Pragma("unroll") for (int _i = 0; _i < 2; ++_i) \
        dst[_h][_i] = ((unsigned)G.idx[_r0 + _h * HALF + Rs[_i]] * (unsigned)G.lda + (unsigned)Cs[_i]) * 2u; } } while (0)
    const size_t kstep = (size_t)(BK * 2);
    const unsigned ldsw = (unsigned)wid * 1024u;
    const int aoff = lds_byte(wr * 64 + fr, fq * 8), boff = lds_byte(wc * 32 + fr, fq * 8);
#define PG8_SA(b, h) (((b) * 2 + (h)) * HTB)
#define PG8_SB(b, h) ((4 + (b) * 2 + (h)) * HTB)
#define PG8_STAGE(bufoff, gbase, v) do { \
        __builtin_amdgcn_global_load_lds((const unsigned*)((const char*)(gbase) + (v)[0]), (LAS unsigned*)(lds + (bufoff) + ldsw), 16, 0, 0); \
        __builtin_amdgcn_global_load_lds((const unsigned*)((const char*)(gbase) + (v)[1]), (LAS unsigned*)(lds + (bufoff) + ldsw + 8192), 16, 0, 0); } while (0)
#define PG8_STA(bufoff, gbase, h, VX) do { if constexpr (Geom::GATHER) { PG8_STAGE(bufoff, gbase, VX[h]); } else { PG8_STAGE(bufoff, (gbase) + (h) * hstepA, vA0); } } while (0)
#define PG8_STB(bufoff, gbase, h) PG8_STAGE(bufoff, (gbase) + (h) * hstepB, vB0)
#define PG8_LDA(dst, b, h) do { _Pragma("unroll") for (int m = 0; m < 4; ++m) _Pragma("unroll") for (int k = 0; k < 2; ++k) dst[m][k] = *(const LAS bf16x8*)(lds + PG8_SA(b, h) + aoff + m * 2048 + k * 1024); } while (0)
#define PG8_LDB(dst, b, h) do { _Pragma("unroll") for (int n = 0; n < 2; ++n) _Pragma("unroll") for (int k = 0; k < 2; ++k) dst[n][k] = *(const LAS bf16x8*)(lds + PG8_SB(b, h) + boff + n * 2048 + k * 1024); } while (0)
#define PG8_MMA(ai, bj, At, Bt) do { __builtin_amdgcn_s_setprio(1); _Pragma("unroll") for (int m = 0; m < 4; ++m) _Pragma("unroll") for (int n = 0; n < 2; ++n) _Pragma("unroll") for (int k = 0; k < 2; ++k) \
        acc[ai][bj][m][n] = __builtin_amdgcn_mfma_f32_16x16x32_bf16(Bt[n][k], At[m][k], acc[ai][bj][m][n], 0, 0, 0); __builtin_amdgcn_s_setprio(0); } while (0)
#define PG8_WAIT_V(n) asm volatile("s_waitcnt vmcnt(" #n ")" ::: "memory")
#define PG8_WAIT_L(n) asm volatile("s_waitcnt lgkmcnt(" #n ")" ::: "memory")
#define PG8_BAR __builtin_amdgcn_s_barrier()
#define PG8_SCHED __builtin_amdgcn_sched_barrier(0)
    Unit cur, nxt; int ui = 0;
    if (!S.next(0, cur)) return;
    f32x4 acc[2][2][4][2];
#pragma unroll
    for (int a = 0; a < 2; ++a)
#pragma unroll
        for (int b = 0; b < 2; ++b)
#pragma unroll
            for (int m = 0; m < 4; ++m)
#pragma unroll
                for (int n = 0; n < 2; ++n) acc[a][b][m][n] = (f32x4){0.f, 0.f, 0.f, 0.f};
    bf16x8 At[4][2], B0[2][2], B1[2][2];
    const char* cA = G.a_base(cur); const char* cB = G.b_base(cur);
    PG8_VOFF(vAc, cur);
    PG8_STB(PG8_SB(0, 0), cB, 0); PG8_STA(PG8_SA(0, 0), cA, 0, vAc); PG8_STB(PG8_SB(0, 1), cB, 1); PG8_STA(PG8_SA(0, 1), cA, 1, vAc);
    if (wr == 1) PG8_BAR;
    PG8_WAIT_V(4); PG8_BAR;
    PG8_STB(PG8_SB(1, 0), cB + kstep, 0); PG8_STA(PG8_SA(1, 0), cA + kstep, 0, vAc); PG8_STB(PG8_SB(1, 1), cB + kstep, 1);
    PG8_WAIT_V(6); PG8_BAR;
    for (;;) {
        const bool has_next = S.next(ui + 1, nxt);
        const char* nA = has_next ? G.a_base(nxt) : cA; const char* nB = has_next ? G.b_base(nxt) : cB;
        if constexpr (Geom::GATHER) { if (has_next) PG8_VOFF(vAn, nxt); else {
#pragma unroll
            for (int h = 0; h < 2; ++h) { vAn[h][0] = vAc[h][0]; vAn[h][1] = vAc[h][1]; } } }
        for (int t = 0; t < nt; t += 2) {
            const bool last = (t == nt - 2);
            const char* a1 = cA + (size_t)(t + 1) * kstep;
            const char* a2 = last ? nA : cA + (size_t)(t + 2) * kstep; const char* b2 = last ? nB : cB + (size_t)(t + 2) * kstep;
            const char* a3 = a2 + kstep; const char* b3 = b2 + kstep;
            unsigned v2[2][2];
#pragma unroll
            for (int h = 0; h < 2; ++h) { v2[h][0] = (Geom::GATHER && last) ? vAn[h][0] : vAc[h][0]; v2[h][1] = (Geom::GATHER && last) ? vAn[h][1] : vAc[h][1]; }
            PG8_LDB(B0, 0, 0); PG8_SCHED; PG8_LDA(At, 0, 0); PG8_STA(PG8_SA(1, 1), a1, 1, vAc);
            PG8_WAIT_L(8); PG8_BAR; PG8_WAIT_L(0); PG8_MMA(0, 0, At, B0); PG8_BAR; PG8_SCHED;
            PG8_LDB(B1, 0, 1); PG8_STB(PG8_SB(0, 0), b2, 0);
            PG8_BAR; PG8_WAIT_L(0); PG8_MMA(0, 1, At, B1); PG8_BAR;
            PG8_LDA(At, 0, 1); PG8_STA(PG8_SA(0, 0), a2, 0, v2);
            PG8_BAR; PG8_WAIT_L(0); PG8_MMA(1, 0, At, B0); PG8_BAR; PG8_SCHED;
            PG8_STB(PG8_SB(0, 1), b2, 1);
            PG8_WAIT_V(6); PG8_BAR; PG8_MMA(1, 1, At, B1); PG8_BAR;
            PG8_LDB(B0, 1, 0); PG8_SCHED; PG8_LDA(At, 1, 0); PG8_STA(PG8_SA(0, 1), a2, 1, v2);
            PG8_WAIT_L(8); PG8_BAR; PG8_WAIT_L(0); PG8_MMA(0, 0, At, B0); PG8_BAR; PG8_SCHED;
            PG8_LDB(B1, 1, 1); PG8_STB(PG8_SB(1, 0), b3, 0);
            PG8_BAR; PG8_WAIT_L(0); PG8_MMA(0, 1, At, B1); PG8_BAR;
            PG8_LDA(At, 1, 1); PG8_STA(PG8_SA(1, 0), a3, 0, v2);
            PG8_BAR; PG8_WAIT_L(0); PG8_MMA(1, 0, At, B0); PG8_BAR; PG8_SCHED;
            PG8_STB(PG8_SB(1, 1), b3, 1);
            PG8_WAIT_V(6); PG8_BAR; PG8_MMA(1, 1, At, B1); PG8_BAR;
        }
        E(acc, cur, G.row0(cur), wr, wc, fr, fq);
        if (!has_next) break;
#pragma unroll
        for (int a = 0; a < 2; ++a)
#pragma unroll
            for (int b = 0; b < 2; ++b)
#pragma unroll
                for (int m = 0; m < 4; ++m)
#pragma unroll
                    for (int n = 0; n < 2; ++n) acc[a][b][m][n] = (f32x4){0.f, 0.f, 0.f, 0.f};
        cur = nxt; cA = nA; cB = nB; ++ui;
#pragma unroll
        for (int h = 0; h < 2; ++h) { vAc[h][0] = vAn[h][0]; vAc[h][1] = vAn[h][1]; }
    }
    PG8_WAIT_V(0);
    if (wr == 0) PG8_BAR;
    PG8_BAR;
#undef PG8_VOFF
#undef PG8_SA
#undef PG8_SB
#undef PG8_STAGE
#undef PG8_STA
#undef PG8_STB
#undef PG8_LDA
#undef PG8_LDB
#undef PG8_MMA
#undef PG8_WAIT_V
#undef PG8_WAIT_L
#undef PG8_BAR
#undef PG8_SCHED
}

struct EpiBf16Plain {
    static constexpr bool PERM = true;
    bf16_t* O; int ldc; int coloff;
    __device__ __forceinline__ void operator()(const f32x4 (&acc)[2][2][4][2], const Unit& u, int row0, int wr, int wc, int fr, int fq) const {
        const int r0 = row0 + wr * 64 + fr, col0 = coloff + u.pn * BM + wc * 32 + 8 * fq;
#pragma unroll
        for (int ai = 0; ai < 2; ++ai)
#pragma unroll
            for (int m = 0; m < 4; ++m) { bf16_t* rowp = O + (size_t)(r0 + ai * HALF + m * 16) * ldc + col0;
#pragma unroll
                for (int bj = 0; bj < 2; ++bj) { const f32x4 v0 = acc[ai][bj][m][0], v1 = acc[ai][bj][m][1];
                    u32x4 w; w.x = cvt_pk_bf16(v0[0], v0[1]); w.y = cvt_pk_bf16(v0[2], v0[3]); w.z = cvt_pk_bf16(v1[0], v1[1]); w.w = cvt_pk_bf16(v1[2], v1[3]);
                    *(u32x4*)(rowp + bj * HALF) = w; } }
    }
};
struct EpiInRest {
    static constexpr bool PERM = true;
    unsigned char* ws;
    __device__ __forceinline__ void operator()(const f32x4 (&acc)[2][2][4][2], const Unit& u, int row0, int wr, int wc, int fr, int fq) const {
        const int gcol = OFF_WAQ + u.pn * BM;
        bf16_t* base; int ldc, c0; bool sg = false;
        if (gcol < OFF_WAKV) { base = (bf16_t*)(ws + WS_QWA); ldc = 1024; c0 = gcol - OFF_WAQ; }
        else if (gcol < OFF_NAQ) { base = (bf16_t*)(ws + WS_KVWA); ldc = 512; c0 = gcol - OFF_WAKV; }
        else if (gcol < OFF_NAKV) { base = (bf16_t*)(ws + WS_QNA); ldc = 1024; c0 = gcol - OFF_NAQ; }
        else if (gcol < OFF_GATE) { base = (bf16_t*)(ws + WS_KVNA); ldc = 2048; c0 = gcol - OFF_NAKV; }
        else { base = (bf16_t*)(ws + WS_GATE); ldc = 6144; c0 = gcol - OFF_GATE; sg = true; }
        const int r0 = row0 + wr * 64 + fr, col0 = c0 + wc * 32 + 8 * fq;
#pragma unroll
        for (int ai = 0; ai < 2; ++ai)
#pragma unroll
            for (int m = 0; m < 4; ++m) { bf16_t* rowp = base + (size_t)(r0 + ai * HALF + m * 16) * ldc + col0;
#pragma unroll
                for (int bj = 0; bj < 2; ++bj) { f32x4 v0 = acc[ai][bj][m][0], v1 = acc[ai][bj][m][1];
                    if (sg) {
#pragma unroll
                        for (int j = 0; j < 4; ++j) { v0[j] = sigmoid_f(v0[j]); v1[j] = sigmoid_f(v1[j]); } }
                    u32x4 w; w.x = cvt_pk_bf16(v0[0], v0[1]); w.y = cvt_pk_bf16(v0[2], v0[3]); w.z = cvt_pk_bf16(v1[0], v1[1]); w.w = cvt_pk_bf16(v1[2], v1[3]);
                    *(u32x4*)(rowp + bj * HALF) = w; } }
    }
};
template <int BR> struct EpiMergeF {
    static constexpr bool PERM = false;
    unsigned char* ws;
    __device__ __forceinline__ void operator()(const f32x4 (&acc)[2][2][4][2], const Unit& u, int row0, int wr, int wc, int fr, int fq) const {
        const int r0 = row0 + wr * 64 + fr, col0 = u.pn * BM + wc * 32 + 4 * fq;
#pragma unroll
        for (int ai = 0; ai < 2; ++ai)
#pragma unroll
            for (int m = 0; m < 4; ++m) { const size_t row = (size_t)(r0 + ai * HALF + m * 16);
                const bf16_t* gp = (const bf16_t*)(ws + WS_GATE) + row * 6144 + BR * 2048 + col0;
                float* mp = (float*)(ws + WS_MPART) + row * D + col0; bf16_t* ob = (bf16_t*)(ws + WS_MB) + row * D + col0;
#pragma unroll
                for (int bj = 0; bj < 2; ++bj)
#pragma unroll
                    for (int n = 0; n < 2; ++n) { const int co = bj * HALF + n * 16;
                        const u32x2 gg = *(const u32x2*)(gp + co);
                        const f32x4 g = {__uint_as_float(gg.x << 16), __uint_as_float(gg.x & 0xffff0000u), __uint_as_float(gg.y << 16), __uint_as_float(gg.y & 0xffff0000u)};
                        f32x4 t = g * acc[ai][bj][m][n];
                        if (BR > 0) t += *(const f32x4*)(mp + co);
                        if (BR < 2) *(f32x4*)(mp + co) = t;
                        else { u32x2 w; w.x = cvt_pk_bf16(t[0], t[1]); w.y = cvt_pk_bf16(t[2], t[3]); *(u32x2*)(ob + co) = w; } } }
    }
};
struct EpiOutF {
    static constexpr bool PERM = false;
    const Ctx* c; int layer;
    __device__ __forceinline__ void operator()(const f32x4 (&acc)[2][2][4][2], const Unit& u, int row0, int wr, int wc, int fr, int fq) const {
        const int r0 = row0 + wr * 64 + fr, col0 = u.pn * BM + wc * 32 + 4 * fq;
#pragma unroll
        for (int ai = 0; ai < 2; ++ai)
#pragma unroll
            for (int m = 0; m < 4; ++m) { const int row = r0 + ai * HALF + m * 16;
                const float* xin = c->xrow(layer, row) + col0; const float* g = c->mod(layer, row < L ? 0 : 1, 2) + col0;
                float* o = (float*)(c->ws + WS_XA) + (size_t)row * D + col0;
#pragma unroll
                for (int bj = 0; bj < 2; ++bj)
#pragma unroll
                    for (int n = 0; n < 2; ++n) { const int co = bj * HALF + n * 16;
                        *(f32x4*)(o + co) = *(const f32x4*)(xin + co) + *(const f32x4*)(g + co) * acc[ai][bj][m][n]; } }
    }
};
struct EpiGU {
    static constexpr bool PERM = false;
    bf16_t* act;
    __device__ __forceinline__ void operator()(const f32x4 (&acc)[2][2][4][2], const Unit& u, int row0, int wr, int wc, int fr, int fq) const {
        const int r0 = row0 + wr * 64 + fr, f0 = u.pn * 128 + wc * 16 + 4 * fq;
#pragma unroll
        for (int ai = 0; ai < 2; ++ai)
#pragma unroll
            for (int m = 0; m < 4; ++m) { bf16_t* rowp = act + (size_t)(r0 + ai * HALF + m * 16) * DF + f0;
#pragma unroll
                for (int bj = 0; bj < 2; ++bj) { const f32x4 a = acc[ai][bj][m][0], uu = acc[ai][bj][m][1]; f32x4 t;
#pragma unroll
                    for (int j = 0; j < 4; ++j) t[j] = silu_f(a[j]) * uu[j];
                    u32x2 w; w.x = cvt_pk_bf16(t[0], t[1]); w.y = cvt_pk_bf16(t[2], t[3]); *(u32x2*)(rowp + bj * 64) = w; } }
    }
};
}

struct ConvDesc { const float* W; bf16_t* WT; int K, N, k0, n0, gu, off; };
__device__ __forceinline__ ConvDesc conv_desc(const Ctx& c, int layer, int it) {
    constexpr int I_IN = (D / 64) * (NIN / 256), I_BR = (1024 / 64) * (D / 256), I_OUT = (D / 64) * (D / 256), I_G = (D / 64) * (DF / 256), I_DN = (DF / 64) * (D / 256);
    ConvDesc d; int r = it; d.gu = 0; d.off = 0;
    if (r < I_IN) { d.W = c.in[7] + (size_t)layer * D * NIN; d.WT = c.wsp<bf16_t>(WS_WIN); d.K = D; d.N = NIN; }
    else if ((r -= I_IN) < 3 * I_BR) { const int b = r / I_BR; r -= b * I_BR; d.W = c.in[24] + ((size_t)layer * 3 + b) * 1024 * D; d.WT = c.wsp<bf16_t>(WS_WBR) + (size_t)b * D * 1024; d.K = 1024; d.N = D; }
    else if ((r -= 3 * I_BR) < I_OUT) { d.W = c.in[25] + (size_t)layer * D * D; d.WT = c.wsp<bf16_t>(WS_WOUT); d.K = D; d.N = D; }
    else { r -= I_OUT; const int e = r / (2 * I_G + I_DN); r -= e * (2 * I_G + I_DN);
        if (r < I_G) { d.W = c.in[28] + ((size_t)layer * NE + e) * D * DF; d.WT = c.wsp<bf16_t>(WS_WGU); d.K = D; d.N = DF; d.gu = 1; d.off = e * 2048; }
        else if ((r -= I_G) < I_G) { d.W = c.in[29] + ((size_t)layer * NE + e) * D * DF; d.WT = c.wsp<bf16_t>(WS_WGU); d.K = D; d.N = DF; d.gu = 1; d.off = e * 2048 + 16; }
        else { r -= I_G; d.W = c.in[30] + ((size_t)layer * NE + e) * DF * D; d.WT = c.wsp<bf16_t>(WS_WDN) + (size_t)e * D * DF; d.K = DF; d.N = D; } }
    const int nblk = d.N / 256; d.k0 = 64 * (r / nblk); d.n0 = 256 * (r % nblk);
    return d;
}
__device__ __forceinline__ void ph_conv(const Ctx& c, int layer) {
    constexpr int I_IN = (D / 64) * (NIN / 256), I_BR = (1024 / 64) * (D / 256), I_OUT = (D / 64) * (D / 256), I_G = (D / 64) * (DF / 256), I_DN = (DF / 64) * (D / 256);
    constexpr int NITEMS = I_IN + 3 * I_BR + I_OUT + NE * (2 * I_G + I_DN);
    __syncthreads();
    float* tile = (float*)c.smem;
    const int tid = c.tid;
    float4 rg[8];
    int it = c.bid; bool have = it < NITEMS; ConvDesc d;
    if (have) { d = conv_desc(c, layer, it);
#pragma unroll
        for (int q = 0; q < 8; ++q) { const int e = tid + 512 * q, row = e >> 6, c4 = e & 63; rg[q] = *(const float4*)(d.W + (size_t)(d.k0 + row) * d.N + d.n0 + 4 * c4); } }
    while (have) {
#pragma unroll
        for (int q = 0; q < 8; ++q) { const int e = tid + 512 * q, row = e >> 6, c4 = e & 63; float* tp = tile + row * 257 + 4 * c4; tp[0] = rg[q].x; tp[1] = rg[q].y; tp[2] = rg[q].z; tp[3] = rg[q].w; }
        __syncthreads();
        const ConvDesc cur = d;
        it += c.nb; have = it < NITEMS;
        if (have) { d = conv_desc(c, layer, it);
#pragma unroll
            for (int q = 0; q < 8; ++q) { const int e = tid + 512 * q, row = e >> 6, c4 = e & 63; rg[q] = *(const float4*)(d.W + (size_t)(d.k0 + row) * d.N + d.n0 + 4 * c4); } }
#pragma unroll
        for (int j = 0; j < 4; ++j) { const int p = tid + 512 * j, nn = p >> 3, kc = p & 7; const float* sp = tile + (8 * kc) * 257 + nn;
            uint4 o; o.x = pk2(sp[0 * 257], sp[1 * 257]); o.y = pk2(sp[2 * 257], sp[3 * 257]); o.z = pk2(sp[4 * 257], sp[5 * 257]); o.w = pk2(sp[6 * 257], sp[7 * 257]);
            const int f = cur.n0 + nn; const int orow = cur.gu ? cur.off + 32 * (f >> 4) + (f & 15) : f;
            *(uint4*)(cur.WT + (size_t)orow * cur.K + cur.k0 + 8 * kc) = o; }
        __syncthreads();
    }
}

struct EpiTaps {
    static constexpr bool PERM = true;
    bf16_t* KF; bf16_t* KFC; const float* dec;
    __device__ __forceinline__ void operator()(const pg8::f32x4 (&acc)[2][2][4][2], const pg8::Unit& u, int row0, int wr, int wc, int fr, int fq) const {
        const bool isc = u.pn == L / 256;
        const int ch0 = row0 + wr * 64 + fr, pos0 = (isc ? 0 : u.pn * 256) + wc * 32 + 8 * fq;
        const float inv = isc ? 1.0f / (float)(LC - 1) : 1.0f / (float)(L - 1);
        bf16_t* base = isc ? KFC : KF; const int ld = isc ? LC : L;
#pragma unroll
        for (int ai = 0; ai < 2; ++ai)
#pragma unroll
            for (int m = 0; m < 4; ++m) { const int ch = ch0 + ai * 128 + m * 16; const float rate = fabsf(dec[ch]); bf16_t* rowp = base + (size_t)ch * ld + pos0;
#pragma unroll
                for (int bj = 0; bj < 2; ++bj) { float t[8];
#pragma unroll
                    for (int j = 0; j < 8; ++j) { const float tt = (float)(pos0 + bj * 128 + j) * inv; const float a = j < 4 ? acc[ai][bj][m][0][j] : acc[ai][bj][m][1][j - 4]; t[j] = a * (__expf(-tt * rate) + 0.05f); }
                    pg8::u32x4 w; w.x = pg8::cvt_pk_bf16(t[0], t[1]); w.y = pg8::cvt_pk_bf16(t[2], t[3]); w.z = pg8::cvt_pk_bf16(t[4], t[5]); w.w = pg8::cvt_pk_bf16(t[6], t[7]);
                    *(pg8::u32x4*)(rowp + bj * 128) = w; } }
    }
};
__device__ __forceinline__ void ph_taps(const Ctx& c, int layer) {
    LAS unsigned char* lds = (LAS unsigned char*)c.smem;
    __syncthreads();
    const pg8::GeomLin G{(const char*)(c.wsp<bf16_t>(WS_FW3T) + (size_t)layer * 4096 * 256), (const char*)(c.wsp<bf16_t>(WS_H2B) + (size_t)layer * MR * 256), 256, 256, 256, nullptr};
    pg8::StaticOrder S; S.init(4096 / 256, MR / 256, c.nb, c.bid);
    const EpiTaps E{c.wsp<bf16_t>(WS_KF), c.wsp<bf16_t>(WS_KFC), c.in[16] + (size_t)layer * 4096};
    pg8::gemm_phase(lds, G, S, E);
}

__device__ __forceinline__ void ph_g0(const Ctx& c) {
    float* lds = (float*)c.smem;
    for (int u = c.bid; u < 2 * 256; u += c.nb) {
        const int layer = u >> 8, n0 = (u & 255) * 48;
        __syncthreads();
        for (int k = c.tid; k < D; k += NTHREADS) { lds[k] = silu_f(c.in[1][k]); lds[D + k] = silu_f(c.in[3][k]); }
        __syncthreads();
        const int col = c.tid % 48, kg = c.tid / 48;
        float a0 = 0.f, a1 = 0.f;
        if (kg < 10) {
            const float* w = c.in[4] + (size_t)layer * D * NMOD + n0 + col;
            for (int k = kg; k < D; k += 10) { const float wv = w[(size_t)k * NMOD]; a0 = fmaf(lds[k], wv, a0); a1 = fmaf(lds[D + k], wv, a1); }
        }
        float* red = lds + 2 * D;
        if (kg < 10) { red[(kg * 48 + col) * 2] = a0; red[(kg * 48 + col) * 2 + 1] = a1; }
        __syncthreads();
        if (c.tid < 96) {
            const int cc = c.tid >> 1, s = c.tid & 1; float t = 0.f;
            for (int g = 0; g < 10; ++g) t += red[(g * 48 + cc) * 2 + s];
            t += c.in[5][(size_t)layer * NMOD + n0 + cc];
            c.wsp<float>(WS_MOD)[(size_t)(layer * 2 + s) * NMOD + n0 + cc] = t;
        }
    }
    for (size_t e = (size_t)c.bid * NTHREADS + c.tid; e < (size_t)2 * 4096 * 256; e += (size_t)c.nb * NTHREADS) {
        const int k = (int)(e & 255), col = (int)((e >> 8) & 4095), layer = (int)(e >> 20);
        c.wsp<bf16_t>(WS_FW3T)[e] = k < 64 ? f2bf(c.in[14][((size_t)layer * 64 + k) * 4096 + col]) : (bf16_t)0;
    }
    const int gw = c.bid * 8 + c.wave, ngw = c.nb * 8;
    for (int task = gw; task < 2 * MR; task += ngw) {
        const int layer = task / MR, pos = task % MR;
        const bool isc = pos >= L; const int i = isc ? pos - L : pos; const int Lx = isc ? LC : L;
        const float tt = (float)i * (1.0f / (float)(Lx - 1));
        const float c0 = (float)(2.0 * 3.14159265358979323846 / (double)Lx);
        const int j = c.lane;
        float feat = 0.f;
        if (j == 0) feat = tt;
        else if (j < 33) { const int b = (j - 1) & 15; const float band = 1e-4f + (float)b * ((15.0f - 1e-4f) / 15.0f); const float ang = (c0 * band) * (float)i; feat = (j <= 16) ? cosf(ang) : -sinf(ang); }
        const float* fw1 = c.in[10] + (size_t)layer * 33 * 64; const float* fb1 = c.in[11] + layer * 64;
        const float* fw2 = c.in[12] + (size_t)layer * 64 * 64; const float* fb2 = c.in[13] + layer * 64;
        const float* fr = c.in[15] + layer * 128;
        float s = fb1[j];
        for (int f = 0; f < 33; ++f) s = fmaf(__shfl(feat, f), fw1[f * 64 + j], s);
        const float h1 = sinf(fr[j] * s);
        float s2 = fb2[j];
        for (int m = 0; m < 64; ++m) s2 = fmaf(__shfl(h1, m), fw2[m * 64 + j], s2);
        const float h2 = sinf(fr[64 + j] * s2);
        bf16_t* hb = c.wsp<bf16_t>(WS_H2B) + ((size_t)layer * MR + pos) * 256;
        hb[j] = f2bf(h2); hb[64 + j] = 0; hb[128 + j] = 0; hb[192 + j] = 0;
    }
}

__device__ __forceinline__ void ph_a(const Ctx& c, int layer) {
    const int gw = c.bid * 8 + c.wave, ngw = c.nb * 8;
    const float* g = c.in[6] + (size_t)layer * D;
    for (int r = gw; r < MR; r += ngw) {
        const float* x = c.xrow(layer, r);
        const int src = r < L ? 0 : 1;
        const float* sh = c.mod(layer, src, 0); const float* sc = c.mod(layer, src, 1);
        float4 v[8]; float ss = 0.f;
#pragma unroll
        for (int j = 0; j < 8; ++j) { v[j] = *(const float4*)(x + 4 * c.lane + 256 * j); ss += v[j].x * v[j].x + v[j].y * v[j].y + v[j].z * v[j].z + v[j].w * v[j].w; }
        ss = wave_sum(ss);
        const float inv = rsqrtf(ss * (1.0f / D) + RMS_EPS);
        bf16_t* o = c.wsp<bf16_t>(WS_HX) + (size_t)r * D;
#pragma unroll
        for (int j = 0; j < 8; ++j) {
            const int col = 4 * c.lane + 256 * j;
            const float4 gg = *(const float4*)(g + col), s4 = *(const float4*)(sh + col), c4 = *(const float4*)(sc + col);
            const float y0 = v[j].x * inv * gg.x * (1.f + c4.x) + s4.x, y1 = v[j].y * inv * gg.y * (1.f + c4.y) + s4.y;
            const float y2 = v[j].z * inv * gg.z * (1.f + c4.z) + s4.z, y3 = v[j].w * inv * gg.w * (1.f + c4.w) + s4.w;
            uint2 w; w.x = pk2(y0, y1); w.y = pk2(y2, y3);
            *(uint2*)(o + col) = w;
        }
    }
}

struct EpiIn {
    unsigned char* ws;
    __device__ __forceinline__ void operator()(int row, int col, const float (&v)[8]) const {
        if (col < OFF_WAQ) {
            bf16_t* d = (bf16_t*)(ws + WS_ZHYT);
#pragma unroll
            for (int j = 0; j < 8; ++j) d[(size_t)(col + j) * MR + row] = f2bf(v[j]);
            return;
        }
        bf16_t* dst; float t[8];
#pragma unroll
        for (int j = 0; j < 8; ++j) t[j] = v[j];
        if (col < OFF_WAKV) dst = (bf16_t*)(ws + WS_QWA) + (size_t)row * 1024 + (col - OFF_WAQ);
        else if (col < OFF_NAQ) dst = (bf16_t*)(ws + WS_KVWA) + (size_t)row * 512 + (col - OFF_WAKV);
        else if (col < OFF_NAKV) dst = (bf16_t*)(ws + WS_QNA) + (size_t)row * 1024 + (col - OFF_NAQ);
        else if (col < OFF_GATE) dst = (bf16_t*)(ws + WS_KVNA) + (size_t)row * 2048 + (col - OFF_NAKV);
        else { dst = (bf16_t*)(ws + WS_GATE) + (size_t)row * 6144 + (col - OFF_GATE);
#pragma unroll
            for (int j = 0; j < 8; ++j) t[j] = sigmoid_f(t[j]); }
        uint4 o; o.x = pk2(t[0], t[1]); o.y = pk2(t[2], t[3]); o.z = pk2(t[4], t[5]); o.w = pk2(t[6], t[7]);
        *(uint4*)dst = o;
    }
};
__device__ __forceinline__ void ph_b(const Ctx& c, int layer) {
    const RowLin rp{c.wsp<bf16_t>(WS_HX), D};
    const EpiIn ep{c.ws};
    const float* W = c.in[7] + (size_t)layer * D * NIN;
    const int nM = MR / 128, nN = NIN / 128;
    for (int u = c.bid; u < nM * nN; u += c.nb) {
        const int pm = u % nM, pn = u / nM;
        sgemm_unit(rp, W, NIN, D, pm * 128, pn * 128, ep, (float*)c.smem, c.tid);
    }
}

__device__ __forceinline__ void b2_segment(bf16_t* p, const float* gain, bool rope, int r, int lane, bool active) {
    uint4 w = make_uint4(0u, 0u, 0u, 0u);
    if (active) w = *(const uint4*)(p + 8 * lane);
    float x[8] = {__uint_as_float(w.x << 16), __uint_as_float(w.x & 0xffff0000u), __uint_as_float(w.y << 16), __uint_as_float(w.y & 0xffff0000u),
                  __uint_as_float(w.z << 16), __uint_as_float(w.z & 0xffff0000u), __uint_as_float(w.w << 16), __uint_as_float(w.w & 0xffff0000u)};
    float ss = 0.f;
#pragma unroll
    for (int i = 0; i < 8; ++i) ss += x[i] * x[i];
    ss += __shfl_xor(ss, 1); ss += __shfl_xor(ss, 2); ss += __shfl_xor(ss, 4); ss += __shfl_xor(ss, 8);
    const float inv = rsqrtf(ss * (1.0f / 128.0f) + RMS_EPS);
    const int d0 = (lane & 15) * 8;
    const float4 g0 = *(const float4*)(gain + d0), g1 = *(const float4*)(gain + d0 + 4);
    const float gg[8] = {g0.x, g0.y, g0.z, g0.w, g1.x, g1.y, g1.z, g1.w};
#pragma unroll
    for (int i = 0; i < 8; ++i) x[i] = x[i] * inv * gg[i];
    if (rope) {
        const int axis = d0 >> 6, half = (d0 >> 5) & 1, f0 = d0 & 31;
        const float pos = axis == 0 ? (float)(r / GRIDW) : (float)(r % GRIDW);
#pragma unroll
        for (int i = 0; i < 8; ++i) {
            const float other = __shfl_xor(x[i], 4);
            const float ang = pos * powf(10000.0f, -(float)(f0 + i) / 32.0f);
            float sn, cs; sincosf(ang, &sn, &cs);
            x[i] = half == 0 ? x[i] * cs - other * sn : x[i] * cs + other * sn;
        }
    }
    if (active) { uint4 o; o.x = pk2(x[0], x[1]); o.y = pk2(x[2], x[3]); o.z = pk2(x[4], x[5]); o.w = pk2(x[6], x[7]); *(uint4*)(p + 8 * lane) = o; }
}
__device__ __forceinline__ void ph_b2(const Ctx& c, int layer) {
    const int gw = c.bid * 8 + c.wave, ngw = c.nb * 8;
    const int lane = c.lane;
    for (int r = gw; r < MR; r += ngw) {
        const bool lat = r < L;
        b2_segment(c.wsp<bf16_t>(WS_QWA) + (size_t)r * 1024, c.in[18] + layer * 128, lat, r, lane, true);
        b2_segment(c.wsp<bf16_t>(WS_QWA) + (size_t)r * 1024 + 512, c.in[18] + layer * 128, lat, r, lane, true);
        b2_segment(c.wsp<bf16_t>(WS_KVWA) + (size_t)r * 512, c.in[19] + layer * 128, lat, r, lane, lane < 32);
        b2_segment(c.wsp<bf16_t>(WS_QNA) + (size_t)r * 1024, c.in[21] + layer * 128, false, r, lane, true);
        b2_segment(c.wsp<bf16_t>(WS_QNA) + (size_t)r * 1024 + 512, c.in[21] + layer * 128, false, r, lane, true);
        b2_segment(c.wsp<bf16_t>(WS_KVNA) + (size_t)r * 2048, c.in[22] + layer * 128, false, r, lane, true);
        b2_segment(c.wsp<bf16_t>(WS_KVNA) + (size_t)r * 2048 + 512, c.in[22] + layer * 128, false, r, lane, true);
    }
}

__device__ __forceinline__ float shortconv_at(const bf16_t* z, int t, int Lx, float w0, float w1, float w2, float b) {
    const float zm = t > 0 ? bf2f(z[t - 1]) : 0.f, z0 = bf2f(z[t]), zp = t + 1 < Lx ? bf2f(z[t + 1]) : 0.f;
    return zm * w0 + z0 * w1 + zp * w2 + b;
}
__device__ __forceinline__ float block_sum(float v, float* red, int tid) {
    v = wave_sum(v);
    __syncthreads();
    if ((tid & 63) == 0) red[tid >> 6] = v;
    __syncthreads();
    float t = 0.f;
#pragma unroll
    for (int w = 0; w < 8; ++w) t += red[w];
    return t;
}
__device__ __forceinline__ void hyena_direct_unit(const Ctx& c, int layer, int ch) {
    bf16_t* kc = (bf16_t*)c.smem;
    float* cv = (float*)c.smem;
    float* us = (float*)(c.smem + 4 * L);
    float* red = us + L;
    const int tid = c.tid;
    const float* cw = c.in[8] + (size_t)layer * 3 * 3072; const float* cb = c.in[9] + (size_t)layer * 3072;
    const bf16_t* zv = c.wsp<bf16_t>(WS_ZHYT) + (size_t)ch * MR;
    const bf16_t* z1 = c.wsp<bf16_t>(WS_ZHYT) + (size_t)(1024 + ch) * MR;
    const bf16_t* z2 = c.wsp<bf16_t>(WS_ZHYT) + (size_t)(2048 + ch) * MR;
    const bf16_t* KF = c.wsp<bf16_t>(WS_KF);
    __syncthreads();
    { const float w0 = cw[ch], w1 = cw[3072 + ch], w2 = cw[6144 + ch], b = cb[ch];
#pragma unroll 2
      for (int t = tid; t < L; t += NTHREADS) us[t] = shortconv_at(zv, t, L, w0, w1, w2, b); }
    for (int o = 0; o < 2; ++o) {
        const bf16_t* hf = KF + (size_t)(o * 1024 + ch) * L;
        const bf16_t* hb = KF + (size_t)(2048 + o * 1024 + ch) * L;
        float sabs = 0.f;
#pragma unroll 2
        for (int t = tid; t < L; t += NTHREADS) {
            bf16_t kf = hf[t], kb = hb[t];
            if (t == 0) { kf = f2bf(bf2f(kf) + bf2f(kb)); kb = 0; }
            kc[L + t] = kf; kc[L - t] = (t == 0) ? kf : kb;
            sabs += fabsf(bf2f(kf)) + fabsf(bf2f(kb));
        }
        if (tid == 0) kc[0] = 0;
        const float S = block_sum(sabs, red, tid);
        {
            float acc[32];
#pragma unroll
            for (int j = 0; j < 32; ++j) acc[j] = 0.f;
#pragma unroll 2
            for (int s = 0; s < L; ++s) {
                const float uv = us[s];
                const bf16_t* kp = kc + (L + tid - s);
#pragma unroll
                for (int j = 0; j < 32; ++j) acc[j] = fmaf(uv, bf2f(kp[512 * j]), acc[j]);
            }
            __syncthreads();
#pragma unroll
            for (int j = 0; j < 32; ++j) cv[tid + 512 * j] = acc[j];
        }
        LDS_FENCE();
        const float invS = 1.0f / S;
        const float dsk = c.in[17][(size_t)layer * 2048 + o * 1024 + ch];
        const int co = o == 0 ? 1024 : 2048;
        const bf16_t* zz = o == 0 ? z1 : z2;
        const float w0 = cw[co + ch], w1 = cw[3072 + co + ch], w2 = cw[6144 + co + ch], b = cb[co + ch];
        bf16_t* dst = c.wsp<bf16_t>(WS_YHYT) + (size_t)ch * L;
#pragma unroll 2
        for (int t = tid; t < L; t += NTHREADS) {
            const float r = shortconv_at(zz, t, L, w0, w1, w2, b) * (cv[t] * invS + us[t] * dsk);
            if (o == 0) us[t] = r; else dst[t] = f2bf(r);
        }
        __syncthreads();
    }
}
__device__ __forceinline__ void hyena_ctx_unit(const Ctx& c, int layer, int ch) {
    float* kc = (float*)c.smem;
    float* us = kc + 512;
    float* red = us + 256;
    const int tid = c.tid;
    const float* cw = c.in[8] + (size_t)layer * 3 * 3072; const float* cb = c.in[9] + (size_t)layer * 3072;
    const bf16_t* zv = c.wsp<bf16_t>(WS_ZHYT) + (size_t)ch * MR + L;
    const bf16_t* z1 = c.wsp<bf16_t>(WS_ZHYT) + (size_t)(1024 + ch) * MR + L;
    const bf16_t* z2 = c.wsp<bf16_t>(WS_ZHYT) + (size_t)(2048 + ch) * MR + L;
    const bf16_t* KF = c.wsp<bf16_t>(WS_KFC);
    __syncthreads();
    if (tid < LC) us[tid] = shortconv_at(zv, tid, LC, cw[ch], cw[3072 + ch], cw[6144 + ch], cb[ch]);
    for (int o = 0; o < 2; ++o) {
        const bf16_t* hf = KF + (size_t)(o * 1024 + ch) * LC;
        const bf16_t* hb = KF + (size_t)(2048 + o * 1024 + ch) * LC;
        float sabs = 0.f;
        {
            const int lag = tid - 256; float k;
            if (lag == 0) k = bf2f(hf[0]) + bf2f(hb[0]); else if (lag > 0) k = bf2f(hf[lag]); else if (lag > -256) k = bf2f(hb[-lag]); else k = 0.f;
            kc[tid] = k; sabs = fabsf(k);
        }
        const float S = block_sum(sabs, red, tid);
        float acc = 0.f;
        if (tid < LC) for (int s = 0; s < LC; ++s) acc = fmaf(us[s], kc[256 + tid - s], acc);
        const float dsk = c.in[17][(size_t)layer * 2048 + o * 1024 + ch];
        float res = 0.f;
        if (tid < LC) {
            const bf16_t* zz = o == 0 ? z1 : z2; const int co = o == 0 ? 1024 : 2048;
            res = shortconv_at(zz, tid, LC, cw[co + ch], cw[3072 + co + ch], cw[6144 + co + ch], cb[co + ch]) * (acc / S + us[tid] * dsk);
        }
        __syncthreads();
        if (tid < LC) { if (o == 0) us[tid] = res; else c.wsp<bf16_t>(WS_YHY)[(size_t)(L + tid) * 1024 + ch] = f2bf(res); }
        __syncthreads();
    }
}

template <class KeyFn>
__device__ __forceinline__ void wave_attn(const bf16_t* q, int nkeys, const KeyFn& key, bool has_sink, float sink, bf16_t* out, float* wl, int lane) {
    float* qf = wl;
    float* sc = wl + 128;
    qf[2 * lane] = bf2f(q[2 * lane]); qf[2 * lane + 1] = bf2f(q[2 * lane + 1]);
    LDS_FENCE();
    float mx = -3.0e38f;
    for (int j = lane; j < nkeys; j += 64) {
        const bf16_t* kp; const bf16_t* vp; float bias;
        float s = -1e30f;
        if (key(j, kp, vp, bias)) {
            float d = 0.f;
#pragma unroll
            for (int e = 0; e < 128; e += 8) {
                const uint4 kk = *(const uint4*)(kp + e);
                d = fmaf(qf[e + 0], __uint_as_float(kk.x << 16), d); d = fmaf(qf[e + 1], __uint_as_float(kk.x & 0xffff0000u), d);
                d = fmaf(qf[e + 2], __uint_as_float(kk.y << 16), d); d = fmaf(qf[e + 3], __uint_as_float(kk.y & 0xffff0000u), d);
                d = fmaf(qf[e + 4], __uint_as_float(kk.z << 16), d); d = fmaf(qf[e + 5], __uint_as_float(kk.z & 0xffff0000u), d);
                d = fmaf(qf[e + 6], __uint_as_float(kk.w << 16), d); d = fmaf(qf[e + 7], __uint_as_float(kk.w & 0xffff0000u), d);
            }
            s = d * QK_SCALE + bias;
        }
        sc[j] = s; mx = fmaxf(mx, s);
    }
    if (has_sink) mx = fmaxf(mx, sink);
    mx = wave_max(mx);
    float sum = 0.f;
    for (int j = lane; j < nkeys; j += 64) { const float p = __expf(sc[j] - mx); sc[j] = p; sum += p; }
    sum = wave_sum(sum);
    if (has_sink) sum += __expf(sink - mx);
    LDS_FENCE();
    float o0 = 0.f, o1 = 0.f;
    for (int j = 0; j < nkeys; ++j) {
        const float p = sc[j];
        if (p != 0.f) {
            const bf16_t* kp; const bf16_t* vp; float bias;
            key(j, kp, vp, bias);
            const unsigned vv = *(const unsigned*)(vp + 2 * lane);
            o0 = fmaf(p, __uint_as_float(vv << 16), o0); o1 = fmaf(p, __uint_as_float(vv & 0xffff0000u), o1);
        }
    }
    const float inv = 1.0f / sum;
    *(unsigned*)(out + 2 * lane) = pk2(o0 * inv, o1 * inv);
    LDS_FENCE();
}

struct KeyWA {
    const bf16_t* kv; int t, kvh;
    __device__ __forceinline__ bool operator()(int j, const bf16_t*& kp, const bf16_t*& vp, float& bias) const {
        bias = 0.f;
        int row; bool ok = true;
        if (j < 257) { const int kpos = t - 128 + j; ok = kpos >= 0 && kpos < L; row = ok ? kpos : 0; } else row = L + (j - 257);
        kp = kv + (size_t)row * 512 + kvh * 128; vp = kp + 256; return ok;
    }
};
struct KeyCtxWA { const bf16_t* kv; int kvh;
    __device__ __forceinline__ bool operator()(int j, const bf16_t*& kp, const bf16_t*& vp, float& bias) const { bias = 0.f; kp = kv + (size_t)(L + j) * 512 + kvh * 128; vp = kp + 256; return true; } };
struct KeyNA {
    const bf16_t* kv; const float* rpb; int r, qc, r0, cs, h;
    __device__ __forceinline__ bool operator()(int j, const bf16_t*& kp, const bf16_t*& vp, float& bias) const {
        int row;
        if (j < 128) { const int w = j >> 4, kc = cs + (j & 15); row = (r0 + w) * GRIDW + kc;
            const int dr = r0 + w - r + 7; int dc = kc - qc + 15; dc = dc < 0 ? 0 : (dc > 30 ? 30 : dc);
            bias = rpb[(h * 15 + dr) * 31 + dc]; }
        else { row = L + (j - 128); bias = 0.f; }
        kp = kv + (size_t)row * 2048 + h * 128; vp = kp + 1024; return true;
    }
};
struct KeyCtxNA { const bf16_t* kv; int h;
    __device__ __forceinline__ bool operator()(int j, const bf16_t*& kp, const bf16_t*& vp, float& bias) const { bias = 0.f; kp = kv + (size_t)(L + j) * 2048 + h * 128; vp = kp + 1024; return true; } };


#define HYF __device__ __forceinline__
#define HYF_OPAQUE(x) asm volatile("" : "+v"(x))
#define HYF_SB(i) do { if (((i) & 3) == 3) __builtin_amdgcn_sched_barrier(0); } while (0)
namespace hyf {
constexpr int FL = 16384;
constexpr int FPAD = FL + 32 * 16;
typedef float cpx __attribute__((ext_vector_type(2)));
HYF int phys(int p) { return ((p & ~15) | ((p & 15) ^ ((p >> 5) & 15))) + ((p >> 9) << 4); }

#define HYF_C32 {1.0f, 0.98078528040323043f, 0.92387953251128674f, 0.83146961230254524f, 0.70710678118654752f, 0.55557023301960218f, 0.38268343236508978f, 0.19509032201612825f, \
                 0.0f, -0.19509032201612825f, -0.38268343236508978f, -0.55557023301960218f, -0.70710678118654752f, -0.83146961230254524f, -0.92387953251128674f, -0.98078528040323043f}
#define HYF_S32 {0.0f, 0.19509032201612825f, 0.38268343236508978f, 0.55557023301960218f, 0.70710678118654752f, 0.83146961230254524f, 0.92387953251128674f, 0.98078528040323043f, \
                 1.0f, 0.98078528040323043f, 0.92387953251128674f, 0.83146961230254524f, 0.70710678118654752f, 0.55557023301960218f, 0.38268343236508978f, 0.19509032201612825f}

HYF int rev5(int x) { return (int)(__builtin_bitreverse32((unsigned)x) >> 27); }
HYF int rev4(int x) { return (int)(__builtin_bitreverse32((unsigned)x) >> 28); }
HYF cpx cmul(cpx a, cpx t) { return a.xx * t + (cpx){-a.y, a.y} * t.yx; }
HYF cpx cmulc(cpx a, cpx t) { return t.xx * a + t.yy * (cpx){a.y, -a.x}; }

template <int N, int SG, int BASE, int STRIDE32>
struct DifStage {
    static HYF void run(cpx (&v)[32], const float (&K)[9]) {
        constexpr int H = N / 2;
#pragma unroll
        for (int j = 0; j < H; ++j) {
            const cpx a = v[BASE + j], b = v[BASE + j + H];
            v[BASE + j] = a + b;
            const cpx d = a - b;
            const int tw = j * STRIDE32;
            if (tw == 0) v[BASE + j + H] = d;
            else if (tw == 8) v[BASE + j + H] = (SG < 0) ? (cpx){d.y, -d.x} : (cpx){-d.y, d.x};
            else {
                const float c = (tw < 8) ? K[tw] : -K[16 - tw];
                const float sa = (tw < 8) ? K[8 - tw] : K[tw - 8];
                const float s = (SG < 0) ? -sa : sa;
                v[BASE + j + H] = d * c + (cpx){-d.y, d.x} * s;
            }
        }
        if constexpr (N > 2) { DifStage<H, SG, BASE, STRIDE32 * 2>::run(v, K); DifStage<H, SG, BASE + H, STRIDE32 * 2>::run(v, K); }
    }
};
template <int SG> HYF void dft32(cpx (&v)[32], const float (&K0)[9]) { float K[9]; _Pragma("unroll") for (int m = 0; m < 9; ++m) { K[m] = K0[m]; HYF_OPAQUE(K[m]); } DifStage<32, SG, 0, 1>::run(v, K); }
template <int SG> HYF void dft16(cpx (&v)[32], const float (&K0)[9]) { float K[9]; _Pragma("unroll") for (int m = 0; m < 9; ++m) { K[m] = K0[m]; HYF_OPAQUE(K[m]); } DifStage<16, SG, 0, 2>::run(v, K); }

struct ThreadTw { cpx w1;
                  cpx w2;
                  cpx wo;
                  int b1;
                  int b2, n3;
                  int b3[2], sw;
                  float K[9]; };
HYF void tw_addr(int tid, ThreadTw& t) {
    t.b1 = (tid & ~15) | ((tid & 15) ^ ((tid >> 5) & 15));
    t.b2 = (tid >> 4) * 528; t.n3 = tid & 15; t.sw = (tid >> 1) & 15;
    for (int h = 0; h < 2; ++h) { const int g = tid + 512 * h; t.b3[h] = g * 16 + (g >> 5) * 16; }
    constexpr float KK[9] = {1.0f, 0.98078528040323043f, 0.92387953251128674f, 0.83146961230254524f, 0.70710678118654752f, 0.55557023301960218f, 0.38268343236508978f, 0.19509032201612825f, 0.0f};
    for (int m = 0; m < 9; ++m) { t.K[m] = KK[m]; HYF_OPAQUE(t.K[m]); }
}

HYF void fwd_p1(const ThreadTw& tw, cpx (&v)[32], cpx* lds) {
    int b1 = tw.b1; HYF_OPAQUE(b1);
    float wx = tw.w1.x, wy = tw.w1.y; HYF_OPAQUE(wx); HYF_OPAQUE(wy); const cpx w = {wx, wy};
    dft32<-1>(v, tw.K);
    cpx t = {1.f, 0.f};
#pragma unroll
    for (int k1 = 0; k1 < 32; ++k1) {
        lds[b1 + 528 * k1] = cmul(v[rev5(k1)], t);
        t = cmul(t, w);
        HYF_SB(k1);
    }
}
HYF void fwd_p2(const ThreadTw& tw, cpx* lds) {
    int b2 = tw.b2, n3 = tw.n3; HYF_OPAQUE(b2); HYF_OPAQUE(n3);
    float wx = tw.w2.x, wy = tw.w2.y; HYF_OPAQUE(wx); HYF_OPAQUE(wy); const cpx w = {wx, wy};
    cpx v[32];
#pragma unroll
    for (int n2 = 0; n2 < 32; ++n2) v[n2] = lds[b2 + 16 * n2 + (n3 ^ ((n2 >> 1) & 15))];
    dft32<-1>(v, tw.K);
    cpx t = {1.f, 0.f};
#pragma unroll
    for (int k2 = 0; k2 < 32; ++k2) {
        lds[b2 + 16 * k2 + (n3 ^ ((k2 >> 1) & 15))] = cmul(v[rev5(k2)], t);
        t = cmul(t, w);
        HYF_SB(k2);
    }
}
HYF void fwd_p3(int tid, const ThreadTw& tw, const cpx* lds, cpx* ks) {
    HYF_OPAQUE(tid);
#pragma unroll
    for (int h = 0; h < 2; ++h) {
        int b3 = tw.b3[h], sw = tw.sw; HYF_OPAQUE(b3); HYF_OPAQUE(sw);
        cpx v[32];
#pragma unroll
        for (int n3 = 0; n3 < 16; ++n3) v[n3] = lds[b3 + (n3 ^ sw)];
        dft16<-1>(v, tw.K);
#pragma unroll
        for (int k3 = 0; k3 < 16; ++k3) ks[(h * 16 + k3) * 512 + tid] = v[rev4(k3)];
    }
}
HYF void mid_p3(int tid, const ThreadTw& tw, cpx* lds, const cpx* ks) {
    HYF_OPAQUE(tid);
#pragma unroll
    for (int h = 0; h < 2; ++h) {
        int b3 = tw.b3[h], sw = tw.sw; HYF_OPAQUE(b3); HYF_OPAQUE(sw);
        cpx v[32], p[32];
#pragma unroll
        for (int n3 = 0; n3 < 16; ++n3) v[n3] = lds[b3 + (n3 ^ sw)];
        dft16<-1>(v, tw.K);
#pragma unroll
        for (int k3 = 0; k3 < 16; ++k3) p[k3] = cmul(v[rev4(k3)], ks[(h * 16 + k3) * 512 + tid]);
        dft16<1>(p, tw.K);
#pragma unroll
        for (int n3 = 0; n3 < 16; ++n3) lds[b3 + (n3 ^ sw)] = p[rev4(n3)];
    }
}
HYF void inv_p2(const ThreadTw& tw, cpx* lds) {
    int b2 = tw.b2, n3 = tw.n3; HYF_OPAQUE(b2); HYF_OPAQUE(n3);
    float wx = tw.w2.x, wy = tw.w2.y; HYF_OPAQUE(wx); HYF_OPAQUE(wy); const cpx w = {wx, wy};
    cpx v[32];
    cpx t = {1.f, 0.f};
#pragma unroll
    for (int k2 = 0; k2 < 32; ++k2) {
        v[k2] = cmulc(lds[b2 + 16 * k2 + (n3 ^ ((k2 >> 1) & 15))], t);
        t = cmul(t, w);
        HYF_SB(k2);
    }
    dft32<1>(v, tw.K);
#pragma unroll
    for (int n2 = 0; n2 < 32; ++n2) { lds[b2 + 16 * n2 + (n3 ^ ((n2 >> 1) & 15))] = v[rev5(n2)]; HYF_SB(n2); }
}
HYF void inv_p1(const ThreadTw& tw, const cpx* lds, cpx (&out)[32]) {
    int b1 = tw.b1; HYF_OPAQUE(b1);
    float wx = tw.w1.x, wy = tw.w1.y; HYF_OPAQUE(wx); HYF_OPAQUE(wy); const cpx w = {wx, wy};
    cpx v[32];
    cpx t = {1.f, 0.f};
#pragma unroll
    for (int k1 = 0; k1 < 32; ++k1) {
        v[k1] = cmulc(lds[b1 + 528 * k1], t);
        t = cmul(t, w);
        HYF_SB(k1);
    }
    dft32<1>(v, tw.K);
#pragma unroll
    for (int n1 = 0; n1 < 32; ++n1) out[n1] = v[rev5(n1)];
}
HYF cpx opaque_wo(const ThreadTw& tw) { float x = tw.wo.x, y = tw.wo.y; HYF_OPAQUE(x); HYF_OPAQUE(y); return (cpx){x, y}; }
HYF cpx modfac(cpx wo, int n1) {
    constexpr float C64[32] = {1.0f, 0.99518472667219693f, 0.98078528040323043f, 0.95694033573220882f, 0.92387953251128674f, 0.88192126434835505f, 0.83146961230254524f, 0.77301045336273699f,
        0.70710678118654752f, 0.63439328416364549f, 0.55557023301960218f, 0.47139673682599764f, 0.38268343236508978f, 0.29028467725446233f, 0.19509032201612825f, 0.098017140329560604f,
        0.0f, -0.098017140329560604f, -0.19509032201612825f, -0.29028467725446233f, -0.38268343236508978f, -0.47139673682599764f, -0.55557023301960218f, -0.63439328416364549f,
        -0.70710678118654752f, -0.77301045336273699f, -0.83146961230254524f, -0.88192126434835505f, -0.92387953251128674f, -0.95694033573220882f, -0.98078528040323043f, -0.99518472667219693f};
    constexpr float S64[32] = {0.0f, 0.098017140329560604f, 0.19509032201612825f, 0.29028467725446233f, 0.38268343236508978f, 0.47139673682599764f, 0.55557023301960218f, 0.63439328416364549f,
        0.70710678118654752f, 0.77301045336273699f, 0.83146961230254524f, 0.88192126434835505f, 0.92387953251128674f, 0.95694033573220882f, 0.98078528040323043f, 0.99518472667219693f,
        1.0f, 0.99518472667219693f, 0.98078528040323043f, 0.95694033573220882f, 0.92387953251128674f, 0.88192126434835505f, 0.83146961230254524f, 0.77301045336273699f,
        0.70710678118654752f, 0.63439328416364549f, 0.55557023301960218f, 0.47139673682599764f, 0.38268343236508978f, 0.29028467725446233f, 0.19509032201612825f, 0.098017140329560604f};
    return cmul(wo, (cpx){C64[n1], -S64[n1]});
}
}

#undef HYF
#ifndef FAST_HY
#define FAST_HY 1
#endif
__device__ __forceinline__ void hyena_fft_unit(const Ctx& c, int layer, int ch, const hyf::ThreadTw& tw) {
    using namespace hyf;
    cpx* lds = (cpx*)c.smem; float* red = (float*)(c.smem + (size_t)FPAD * 8);
    cpx* ks = c.wsp<cpx>(WS_KS) + (size_t)c.bid * (2 * FL);
    float* ub = (float*)(ks + FL); float* yb = ub + FL;
    const int tid = c.tid;
    const float* cw = c.in[8] + (size_t)layer * 3 * 3072; const float* cb = c.in[9] + (size_t)layer * 3072;
    const bf16_t* zv = c.wsp<bf16_t>(WS_ZHYT) + (size_t)ch * MR;
    const bf16_t* KF = c.wsp<bf16_t>(WS_KF);
    { const float w0 = cw[ch], w1 = cw[3072 + ch], w2 = cw[6144 + ch], b = cb[ch]; int tq = tid; HYF_OPAQUE(tq);
#pragma unroll 4
      for (int j = 0; j < 32; ++j) ub[tq + 512 * j] = shortconv_at(zv, tq + 512 * j, L, w0, w1, w2, b); }
#pragma unroll 1
    for (int o = 0; o < 2; ++o) {
        const bf16_t* hf = KF + (size_t)(o * 1024 + ch) * L;
        const bf16_t* hb = KF + (size_t)(2048 + o * 1024 + ch) * L;
        float S;
        {
            cpx v[32]; float sabs = 0.f; int tq = tid; HYF_OPAQUE(tq);
#pragma unroll
            for (int j = 0; j < 32; ++j) { const int n = tq + 512 * j; const float f = bf2f(hf[n]); const float bb = bf2f(hb[n == 0 ? 0 : L - n]);
                v[j] = (cpx){f + bb, 0.f}; sabs += (n == 0) ? fabsf(f + bb) : fabsf(f) + fabsf(bb); }
            S = block_sum(sabs, red, tid);
            fwd_p1(tw, v, lds); __syncthreads(); fwd_p2(tw, lds); __syncthreads(); fwd_p3(tid, tw, lds, ks); __syncthreads();
        }
        {
            cpx v[32]; int tq = tid; HYF_OPAQUE(tq);
#pragma unroll
            for (int j = 0; j < 32; ++j) v[j] = (cpx){ub[tq + 512 * j], 0.f};
            fwd_p1(tw, v, lds); __syncthreads(); fwd_p2(tw, lds); __syncthreads(); mid_p3(tid, tw, lds, ks); __syncthreads();
            inv_p2(tw, lds); __syncthreads();
            inv_p1(tw, lds, v); __syncthreads();
            HYF_OPAQUE(tq);
#pragma unroll
            for (int j = 0; j < 32; ++j) yb[tq + 512 * j] = v[j].x;
        }
        {
            cpx v[32]; const cpx wo = opaque_wo(tw); int tq = tid; HYF_OPAQUE(tq);
#pragma unroll
            for (int j = 0; j < 32; ++j) { const int n = tq + 512 * j; const float f = bf2f(hf[n]); const float bb = bf2f(hb[n == 0 ? 0 : L - n]);
                const float d = (n == 0) ? f + bb : f - bb; v[j] = modfac(wo, j) * d; }
            fwd_p1(tw, v, lds); __syncthreads(); fwd_p2(tw, lds); __syncthreads(); fwd_p3(tid, tw, lds, ks); __syncthreads();
        }
        {
            cpx v[32]; cpx wo = opaque_wo(tw); int tq = tid; HYF_OPAQUE(tq);
#pragma unroll
            for (int j = 0; j < 32; ++j) v[j] = modfac(wo, j) * ub[tq + 512 * j];
            fwd_p1(tw, v, lds); __syncthreads(); fwd_p2(tw, lds); __syncthreads(); mid_p3(tid, tw, lds, ks); __syncthreads();
            inv_p2(tw, lds); __syncthreads();
            inv_p1(tw, lds, v); __syncthreads();
            const float sc = (0.5f / (float)L) / S; wo = opaque_wo(tw); HYF_OPAQUE(tq);
            const float dsk = c.in[17][(size_t)layer * 2048 + o * 1024 + ch];
            const int co = o == 0 ? 1024 : 2048;
            const bf16_t* zz = c.wsp<bf16_t>(WS_ZHYT) + (size_t)(co + ch) * MR;
            const float w0 = cw[co + ch], w1 = cw[3072 + co + ch], w2 = cw[6144 + co + ch], b = cb[co + ch];
            bf16_t* dst = c.wsp<bf16_t>(WS_YHYT) + (size_t)ch * L;
#pragma unroll
            for (int j = 0; j < 32; ++j) { const int t = tq + 512 * j; const cpx m = modfac(wo, j);
                const float conv = (yb[t] + v[j].x * m.x + v[j].y * m.y) * sc;
                const float r = shortconv_at(zz, t, L, w0, w1, w2, b) * (conv + ub[t] * dsk);
                if (o == 0) ub[t] = r; else dst[t] = f2bf(r); }
        }
    }
}


#ifndef FAST_ATT
#define FAST_ATT 1
#endif
namespace fa {
using bf16x8 = __attribute__((ext_vector_type(8))) short;
using s16x4  = __attribute__((ext_vector_type(4))) short;
using f32x16 = __attribute__((ext_vector_type(16))) float;
using u32x4  = __attribute__((ext_vector_type(4))) unsigned;
constexpr int AD = 128, NW = 8, QBLK = 32, KVBLK = 64;
constexpr float SCALE = 0.088388347648318440f;
constexpr float THR = 8.f;
constexpr size_t SHM_V = KVBLK * AD * 2, SHM_K = KVBLK * AD * 2, SHM_ATTN = 2 * SHM_V + 2 * SHM_K + NW * 64 * 4;
constexpr float NEG = -1e30f;
#define KSWZ(row, colB) ((row) * 256 + ((colB) ^ (((row) & 7) << 4)))
#define SBAR() __builtin_amdgcn_sched_barrier(0)
__device__ __forceinline__ int crow(int r, int hi) { return (r & 3) + 8 * (r >> 2) + 4 * hi; }
__device__ __forceinline__ unsigned cvtpk(float lo, float hi) { unsigned r; asm volatile("v_cvt_pk_bf16_f32 %0, %1, %2" : "=v"(r) : "v"(lo), "v"(hi)); return r; }
__device__ __forceinline__ void partialSM(f32x16& p0, f32x16& p1, float& m_reg, float& mn, float& alpha) {
  constexpr float C = SCALE * 1.4426950408889634f;
  float pmax = p0[0];
#pragma unroll
  for (int r = 1; r < 16; ++r) pmax = fmaxf(pmax, p0[r]);
#pragma unroll
  for (int r = 0; r < 16; ++r) pmax = fmaxf(pmax, p1[r]);
  { auto rr = __builtin_amdgcn_permlane32_swap(__float_as_uint(pmax), __float_as_uint(pmax), false, false);
    pmax = fmaxf(__uint_as_float(rr[0]), __uint_as_float(rr[1])); }
  if (__builtin_expect(__all(pmax - m_reg <= THR / SCALE), 1)) { mn = m_reg; alpha = 1.f; }
  else { mn = fmaxf(m_reg, pmax); alpha = __builtin_amdgcn_exp2f((m_reg - mn) * C); m_reg = mn; }
  const float mnC = -mn * C;
#pragma unroll
  for (int r = 0; r < 16; ++r) p0[r] = fmaf(p0[r], C, mnC);
#pragma unroll
  for (int r = 0; r < 16; ++r) p1[r] = fmaf(p1[r], C, mnC);
#pragma unroll
  for (int r = 0; r < 16; ++r) p0[r] = __builtin_amdgcn_exp2f(p0[r]);
}
__device__ __forceinline__ void finishSM(f32x16& p0, f32x16& p1, float alpha, float& l_reg, bf16x8& pa0, bf16x8& pa1, bf16x8& pa2, bf16x8& pa3) {
#pragma unroll
  for (int r = 0; r < 16; ++r) p1[r] = __builtin_amdgcn_exp2f(p1[r]);
  float ps = 0;
#pragma unroll
  for (int r = 0; r < 16; ++r) ps += p0[r];
#pragma unroll
  for (int r = 0; r < 16; ++r) ps += p1[r];
  { auto rr = __builtin_amdgcn_permlane32_swap(__float_as_uint(ps), __float_as_uint(ps), false, false);
    ps = __uint_as_float(rr[0]) + __uint_as_float(rr[1]); }
  l_reg = l_reg * alpha + ps;
#define PK4(P, BASE, OUT) do { unsigned a0 = cvtpk(P[BASE + 0], P[BASE + 1]), a1 = cvtpk(P[BASE + 2], P[BASE + 3]);   \
    unsigned b0 = cvtpk(P[BASE + 4], P[BASE + 5]), b1 = cvtpk(P[BASE + 6], P[BASE + 7]);                              \
    auto r0 = __builtin_amdgcn_permlane32_swap(a0, b0, false, false); auto r1 = __builtin_amdgcn_permlane32_swap(a1, b1, false, false); \
    u32x4 w = {r0[0], r1[0], r0[1], r1[1]}; OUT = *reinterpret_cast<bf16x8*>(&w); } while (0)
  PK4(p0, 0, pa0); PK4(p0, 8, pa1); PK4(p1, 0, pa2); PK4(p1, 8, pa3);
#undef PK4
}
__device__ __forceinline__ void qkt(f32x16& p0, f32x16& p1, const char* Ks, const bf16x8* qr, int r32, int hi) {
  p0 = f32x16{}; p1 = f32x16{};
#pragma unroll
  for (int d0 = 0; d0 < 8; ++d0) { const int cb = (d0 * 16 + hi * 8) * 2;
    const bf16x8 b0 = *reinterpret_cast<const bf16x8*>(Ks + KSWZ(r32, cb));
    const bf16x8 b1 = *reinterpret_cast<const bf16x8*>(Ks + KSWZ(32 + r32, cb));
    p0 = __builtin_amdgcn_mfma_f32_32x32x16_bf16(b0, qr[d0], p0, 0, 0, 0);
    p1 = __builtin_amdgcn_mfma_f32_32x32x16_bf16(b1, qr[d0], p1, 0, 0, 0); }
}
__device__ __forceinline__ int v_st(int k, int c) { const int kk = (k & ~0xC) | ((k & 4) << 1) | ((k & 8) >> 1); return ((kk >> 3) * 4 + (c >> 5)) * 512 + ((kk & 7) * 32 + (c & 31)) * 2; }
__device__ __forceinline__ int v_rd_base(int lane) { return ((lane & 3) << 3) | (((lane >> 2) & 3) << 6) | (((lane >> 4) & 1) << 5) | (((lane >> 5) & 1) << 8); }
constexpr int v_rd_off(int d0, int ks, int half) { return d0 * 512 + ks * 4096 + half * 2048; }
template <int OFF> __device__ __forceinline__ s16x4 tr_read(int vb) { s16x4 r; asm volatile("ds_read_b64_tr_b16 %0, %1 offset:%2" : "=&v"(r) : "v"(vb), "i"(OFF) : "memory"); return r; }
template <int D0> __device__ __forceinline__ void pv_one(f32x16& od, int vb, bf16x8 pa0, bf16x8 pa1, bf16x8 pa2, bf16x8 pa3) {
  const s16x4 l0 = tr_read<v_rd_off(D0, 0, 0)>(vb), h0 = tr_read<v_rd_off(D0, 0, 1)>(vb), l1 = tr_read<v_rd_off(D0, 1, 0)>(vb), h1 = tr_read<v_rd_off(D0, 1, 1)>(vb);
  const s16x4 l2 = tr_read<v_rd_off(D0, 2, 0)>(vb), h2 = tr_read<v_rd_off(D0, 2, 1)>(vb), l3 = tr_read<v_rd_off(D0, 3, 0)>(vb), h3 = tr_read<v_rd_off(D0, 3, 1)>(vb);
  asm volatile("s_waitcnt lgkmcnt(0)" ::: "memory"); SBAR();
#define PK(Lo, Hi) (bf16x8){Lo[0], Lo[1], Lo[2], Lo[3], Hi[0], Hi[1], Hi[2], Hi[3]}
  od = __builtin_amdgcn_mfma_f32_32x32x16_bf16(pa0, PK(l0, h0), od, 0, 0, 0);
  od = __builtin_amdgcn_mfma_f32_32x32x16_bf16(pa1, PK(l1, h1), od, 0, 0, 0);
  od = __builtin_amdgcn_mfma_f32_32x32x16_bf16(pa2, PK(l2, h2), od, 0, 0, 0);
  od = __builtin_amdgcn_mfma_f32_32x32x16_bf16(pa3, PK(l3, h3), od, 0, 0, 0);
#undef PK
}
__device__ __forceinline__ void pv_d0(f32x16* o, int vb, bf16x8 pa0, bf16x8 pa1, bf16x8 pa2, bf16x8 pa3) {
  pv_one<0>(o[0], vb, pa0, pa1, pa2, pa3); pv_one<1>(o[1], vb, pa0, pa1, pa2, pa3); pv_one<2>(o[2], vb, pa0, pa1, pa2, pa3); pv_one<3>(o[3], vb, pa0, pa1, pa2, pa3);
}

template <class Tiles>
__device__ __forceinline__ void attn_unit(const bf16_t* __restrict__ Qb, int ldq, const bf16_t* __restrict__ Kb, const bf16_t* __restrict__ Vb, int ldk,
                                          bf16_t* __restrict__ Ob, int ldo, const Tiles& T, int NT, bool has_sink, float sink, char* lds) {
  int tid = threadIdx.x; asm volatile("" : "+v"(tid));
  const int wid = __builtin_amdgcn_readfirstlane(tid >> 6), lane = tid & 63, r32 = lane & 31, hi = lane >> 5;
  char* V_lds = lds; char* K_lds = lds + 2 * SHM_V;
  float* ws = (float*)(lds + 2 * SHM_V + 2 * SHM_K) + wid * 64; float* li_l = ws; float* al_l = ws + 32;
  float m_reg = -1e30f, l_reg = 0; f32x16 o[4] = {}; bf16x8 qr[8];
  const bf16_t* Qw = Qb + (long)(wid * QBLK + r32) * ldq + hi * 8;
#pragma unroll
  for (int d0 = 0; d0 < 8; ++d0) qr[d0] = *reinterpret_cast<const bf16x8*>(Qw + d0 * 16);
  const int sr = tid >> 4, sc = (tid & 15) * 8, vst0 = v_st(sr, sc), vst1 = v_st(32 + sr, sc);
  const int vb0 = (int)(uintptr_t)V_lds + v_rd_base(lane);
  bf16x8 vs0, vs1, ks0, ks1;
#define SLOAD(j) do { const long _k0 = T.row(j); vs0 = *reinterpret_cast<const bf16x8*>(&Vb[(_k0 + sr) * ldk + sc]); vs1 = *reinterpret_cast<const bf16x8*>(&Vb[(_k0 + 32 + sr) * ldk + sc]); \
    ks0 = *reinterpret_cast<const bf16x8*>(&Kb[(_k0 + sr) * ldk + sc]); ks1 = *reinterpret_cast<const bf16x8*>(&Kb[(_k0 + 32 + sr) * ldk + sc]); } while (0)
#define SWRITE(b) do { *(bf16x8*)(V_lds + (b) * SHM_V + vst0) = vs0; *(bf16x8*)(V_lds + (b) * SHM_V + vst1) = vs1; const int kc = sc * 2; \
    *(bf16x8*)(K_lds + (b) * SHM_K + KSWZ(sr, kc)) = ks0; *(bf16x8*)(K_lds + (b) * SHM_K + KSWZ(32 + sr, kc)) = ks1; } while (0)
  __syncthreads();
  SLOAD(0); asm volatile("s_waitcnt vmcnt(0)" ::: "memory"); SWRITE(0);
  if (1 < NT) SLOAD(1);
#pragma unroll 1
  for (int j = 0; j < NT; ++j) {
    const int b = j & 1;
    __syncthreads();
    if (j + 1 < NT) { asm volatile("s_waitcnt vmcnt(0)" ::: "memory"); SWRITE(b ^ 1); if (j + 2 < NT) SLOAD(j + 2); }
    if (T.active(j, wid)) {
      f32x16 p0, p1; float mn, alpha; bf16x8 pa0, pa1, pa2, pa3;
      qkt(p0, p1, K_lds + b * SHM_K, qr, r32, hi); T.mask(p0, p1, j, wid, r32, hi);
      partialSM(p0, p1, m_reg, mn, alpha);
      if (__any(alpha < 1.f)) { if (hi == 0) al_l[r32] = alpha; asm volatile("s_waitcnt lgkmcnt(0)" ::: "memory");
#pragma unroll
        for (int d = 0; d < 4; ++d)
#pragma unroll
          for (int r = 0; r < 16; ++r) o[d][r] *= al_l[crow(r, hi)]; }
      finishSM(p0, p1, alpha, l_reg, pa0, pa1, pa2, pa3); SBAR();
      pv_d0(o, vb0 + b * (int)SHM_V, pa0, pa1, pa2, pa3);
    }
  }
  if (has_sink) { constexpr float C = SCALE * 1.4426950408889634f; l_reg += __builtin_amdgcn_exp2f(fmaf(sink, 1.4426950408889634f, -m_reg * C)); }
  if (hi == 0) li_l[r32] = l_reg; asm volatile("s_waitcnt lgkmcnt(0)" ::: "memory");
  float rli[16];
#pragma unroll
  for (int r = 0; r < 16; ++r) rli[r] = __builtin_amdgcn_rcpf(li_l[crow(r, hi)]);
  bf16_t* Ow = Ob + (long)(wid * QBLK) * ldo;
#pragma unroll
  for (int r = 0; r < 16; ++r) { const int orow = crow(r, hi);
#pragma unroll
    for (int d0 = 0; d0 < 4; ++d0) Ow[(long)orow * ldo + d0 * 32 + r32] = f2bf(o[d0][r] * rli[r]); }
#undef SLOAD
#undef SWRITE
}
#undef KSWZ
#undef SBAR

struct TilesGen {
  int mode, i0, lo, R, glo, nloc; const float* bias;
  __device__ __forceinline__ long row(int j) const {
    if (j < 4) return L + 64 * j;
    if (mode == 0) return lo + 64 * (j - 4);
    return (long)(glo + (j - 4)) * 64;
  }
  __device__ __forceinline__ bool active(int j, int wid) const {
    if (j < 4 || mode == 2) return true;
    if (mode == 0) { const int Tr = lo + 64 * (j - 4), q0 = i0 + 32 * wid; return Tr + 63 >= q0 - 128 && Tr <= q0 + 31 + 128; }
    const int kr = glo + (j - 4), qr = R + (wid >> 1);
    int r0 = qr - 4; r0 = r0 < 0 ? 0 : (r0 > 248 ? 248 : r0);
    return kr >= r0 && kr <= r0 + 7;
  }
  __device__ __forceinline__ void mask(f32x16& p0, f32x16& p1, int j, int wid, int r32, int hi) const {
    if (j < 4 || mode == 2) return;
    if (mode == 0) {
      const int Tr = lo + 64 * (j - 4), q0 = i0 + 32 * wid;
      if (q0 + 31 - Tr <= 128 && Tr + 63 - q0 <= 128) return;
      const int dq = q0 + r32 - Tr;
#pragma unroll
      for (int r = 0; r < 16; ++r) { const int kk = crow(r, hi); p0[r] = (kk >= dq - 128 && kk <= dq + 128) ? p0[r] : NEG; p1[r] = (kk + 32 >= dq - 128 && kk + 32 <= dq + 128) ? p1[r] : NEG; }
      return;
    }
    const int kr = glo + (j - 4), qr = R + (wid >> 1), qc = (wid & 1) * 32 + r32;
    int cs = qc - 8; cs = cs < 0 ? 0 : (cs > 48 ? 48 : cs);
    const float* bt = bias + (kr - qr + 7) * 32 + (15 - qc);
#pragma unroll
    for (int r = 0; r < 16; ++r) { const int k0 = crow(r, hi), k1 = k0 + 32;
      const bool v0 = (unsigned)(k0 - cs) < 16u, v1 = (unsigned)(k1 - cs) < 16u;
      p0[r] = v0 ? p0[r] + bt[v0 ? k0 : cs] : NEG; p1[r] = v1 ? p1[r] + bt[v1 ? k1 : cs] : NEG; }
  }
};
}

__device__ __forceinline__ void ph_attn_fast(const Ctx& c, int layer) {
  char* lds = (char*)c.smem;
  float* btab = (float*)(c.smem + fa::SHM_ATTN);
  const bf16_t* QWA = c.wsp<bf16_t>(WS_QWA); const bf16_t* KVWA = c.wsp<bf16_t>(WS_KVWA); bf16_t* YWA = c.wsp<bf16_t>(WS_YWA);
  const bf16_t* QNA = c.wsp<bf16_t>(WS_QNA); const bf16_t* KVNA = c.wsp<bf16_t>(WS_KVNA); bf16_t* YNA = c.wsp<bf16_t>(WS_YNA);
  const float* sinkp = c.in[20] + layer * 8; const float* rpb = c.in[23] + (size_t)layer * 8 * 15 * 31;
  const int nq = L / 256;
  const int nunits = 2 * 8 * nq + (layer == 0 ? 16 : 0);
#pragma unroll 1
  for (int u = c.bid; u < nunits; u += c.nb) {
    fa::TilesGen T; T.mode = 2; T.i0 = 0; T.lo = 0; T.R = 0; T.glo = 0; T.nloc = 0; T.bias = btab;
    int h, i0, NT; bool wa;
    if (u < 8 * nq) {
      wa = true; h = u / nq; i0 = (u % nq) * 256;
      const int lo = i0 - 128 < 0 ? 0 : i0 - 128, hiR = i0 + 384 > L ? L : i0 + 384;
      T.mode = 0; T.i0 = i0; T.lo = lo; NT = 4 + (hiR - lo) / 64;
    } else if (u < 16 * nq) {
      const int v = u - 8 * nq; wa = false; h = v / nq; const int qb = v % nq; i0 = qb * 256; const int R = qb * 4;
      int glo = R - 4; glo = glo < 0 ? 0 : (glo > 248 ? 248 : glo);
      int gh = R + 3 - 4; gh = gh < 0 ? 0 : (gh > 248 ? 248 : gh); gh += 7;
      T.mode = 1; T.R = R; T.glo = glo; T.nloc = gh - glo + 1; NT = 4 + T.nloc;
      __syncthreads();
      for (int e = c.tid; e < 15 * 32; e += NTHREADS) { const int dr = e >> 5, dc = e & 31; btab[e] = dc < 31 ? rpb[(h * 15 + dr) * 31 + dc] * (1.0f / fa::SCALE) : 0.f; }
    } else {
      const int v = u - 16 * nq; wa = v < 8; h = v & 7; i0 = L; NT = 4;
    }
    const bf16_t* Q = (wa ? QWA : QNA) + (size_t)i0 * 1024 + h * 128;
    const bf16_t* Kb = wa ? KVWA + (h >> 2) * 128 : KVNA + h * 128;
    const bf16_t* Vb = wa ? KVWA + 256 + (h >> 2) * 128 : KVNA + 1024 + h * 128;
    bf16_t* O = (wa ? YWA : YNA) + (size_t)i0 * 1024 + h * 128;
    fa::attn_unit(Q, 1024, Kb, Vb, wa ? 512 : 2048, O, 1024, T, NT, wa, wa ? sinkp[h] : 0.f, lds);
  }
}

__device__ __forceinline__ void ph_c(const Ctx& c, int layer) {
#ifndef NO_HY
    if (FAST_HY) {
        hyf::ThreadTw tw; hyf::tw_addr(c.tid, tw);
        { float s_, c_; sincospif(-2.0f * (float)c.tid / (float)hyf::FL, &s_, &c_); tw.w1 = (hyf::cpx){c_, s_};
          sincospif(-2.0f * (float)(c.tid & 15) / 512.0f, &s_, &c_); tw.w2 = (hyf::cpx){c_, s_};
          sincospif(-(float)c.tid / (float)hyf::FL, &s_, &c_); tw.wo = (hyf::cpx){c_, s_}; }
        for (int u = c.bid; u < 1024; u += c.nb) hyena_fft_unit(c, layer, u, tw);
        if constexpr (DOREP(16)) { for (int u = c.bid; u < 1024; u += c.nb) hyena_fft_unit(c, layer, u, tw); }
    } else
    for (int u = c.bid; u < 1024; u += c.nb) hyena_direct_unit(c, layer, u);
#endif
#ifndef NO_HYC
    if (layer == 0) for (int u = c.bid; u < 1024; u += c.nb) hyena_ctx_unit(c, layer, u);
#endif
    __syncthreads();
#ifndef NO_ATT
    if (FAST_ATT) { ph_attn_fast(c, layer); return; }
    const int gw = c.bid * 8 + c.wave, ngw = c.nb * 8;
    float* wl = (float*)c.smem + c.wave * 768;
    const int nrows = layer == 0 ? MR : L;
    const float* sinkp = c.in[20] + layer * 8;
    const float* rpb = c.in[23] + (size_t)layer * 8 * 15 * 31;
    const bf16_t* kvwa = c.wsp<bf16_t>(WS_KVWA); const bf16_t* kvna = c.wsp<bf16_t>(WS_KVNA);
    for (int task = gw; task < nrows * 16; task += ngw) {
        const int r = task >> 4, hh = task & 15;
        if (hh < 8) {
            const int h = hh; const bf16_t* q = c.wsp<bf16_t>(WS_QWA) + (size_t)r * 1024 + h * 128; bf16_t* o = c.wsp<bf16_t>(WS_YWA) + (size_t)r * 1024 + h * 128;
            if (r < L) { const KeyWA k{kvwa, r, h >> 2}; wave_attn(q, 513, k, true, sinkp[h], o, wl, c.lane); }
            else { const KeyCtxWA k{kvwa, h >> 2}; wave_attn(q, 256, k, true, sinkp[h], o, wl, c.lane); }
        } else {
            const int h = hh - 8; const bf16_t* q = c.wsp<bf16_t>(WS_QNA) + (size_t)r * 1024 + h * 128; bf16_t* o = c.wsp<bf16_t>(WS_YNA) + (size_t)r * 1024 + h * 128;
            if (r < L) { const int gr = r / GRIDW, qc = r % GRIDW; int r0 = gr - 4; r0 = r0 < 0 ? 0 : (r0 > 248 ? 248 : r0); int cs = qc - 8; cs = cs < 0 ? 0 : (cs > 48 ? 48 : cs);
                const KeyNA k{kvna, rpb, gr, qc, r0, cs, h}; wave_attn(q, 384, k, false, 0.f, o, wl, c.lane); }
            else { const KeyCtxNA k{kvna, h}; wave_attn(q, 256, k, false, 0.f, o, wl, c.lane); }
        }
    }
#endif
}

__device__ __forceinline__ void ph_c2(const Ctx& c) {
    bf16_t* tile = (bf16_t*)c.smem;
    const bf16_t* src = c.wsp<bf16_t>(WS_YHYT); bf16_t* dst = c.wsp<bf16_t>(WS_YHY);
    const int tid = c.tid, a = tid >> 3, b8 = (tid & 7) * 8;
    for (int u = c.bid; u < (1024 / 64) * (L / 64); u += c.nb) {
        const int c0 = (u % 16) * 64, t0 = (u / 16) * 64;
        const uint4 v = *(const uint4*)(src + (size_t)(c0 + a) * L + t0 + b8);
        __syncthreads();
        *(uint4*)(tile + a * 72 + b8) = v;
        __syncthreads();
        unsigned short e[8];
#pragma unroll
        for (int i = 0; i < 8; ++i) e[i] = tile[(b8 + i) * 72 + a];
        uint4 o; o.x = e[0] | ((unsigned)e[1] << 16); o.y = e[2] | ((unsigned)e[3] << 16); o.z = e[4] | ((unsigned)e[5] << 16); o.w = e[6] | ((unsigned)e[7] << 16);
        *(uint4*)(dst + (size_t)(t0 + a) * 1024 + c0 + b8) = o;
    }
}

struct EpiMerge { unsigned char* ws; int b;
    __device__ __forceinline__ void operator()(int row, int col, const float (&v)[8]) const {
        const bf16_t* g = (const bf16_t*)(ws + WS_GATE) + (size_t)row * 6144 + b * 2048 + col;
        float* mp = (float*)(ws + WS_MPART) + (size_t)row * D + col;
        const uint4 gg = *(const uint4*)g;
        const float gv[8] = {__uint_as_float(gg.x << 16), __uint_as_float(gg.x & 0xffff0000u), __uint_as_float(gg.y << 16), __uint_as_float(gg.y & 0xffff0000u),
                             __uint_as_float(gg.z << 16), __uint_as_float(gg.z & 0xffff0000u), __uint_as_float(gg.w << 16), __uint_as_float(gg.w & 0xffff0000u)};
        float t[8];
        if (b == 0) {
#pragma unroll
            for (int j = 0; j < 8; ++j) t[j] = gv[j] * v[j];
        } else {
            const float4 p0 = *(const float4*)mp, p1 = *(const float4*)(mp + 4);
            const float pv[8] = {p0.x, p0.y, p0.z, p0.w, p1.x, p1.y, p1.z, p1.w};
#pragma unroll
            for (int j = 0; j < 8; ++j) t[j] = fmaf(gv[j], v[j], pv[j]);
        }
        if (b < 2) { *(float4*)mp = make_float4(t[0], t[1], t[2], t[3]); *(float4*)(mp + 4) = make_float4(t[4], t[5], t[6], t[7]); }
        else { uint4 o; o.x = pk2(t[0], t[1]); o.y = pk2(t[2], t[3]); o.z = pk2(t[4], t[5]); o.w = pk2(t[6], t[7]); *(uint4*)((bf16_t*)(ws + WS_MB) + (size_t)row * D + col) = o; }
    }
};
__device__ __forceinline__ void ph_d(const Ctx& c, int layer) {
    const int nM = MR / 128, nN = D / 128;
    for (int b = 0; b < 3; ++b) {
        const bf16_t* A = b == 0 ? c.wsp<bf16_t>(WS_YHY) : (b == 1 ? c.wsp<bf16_t>(WS_YWA) : c.wsp<bf16_t>(WS_YNA));
        const RowLin rp{A, 1024}; const EpiMerge ep{c.ws, b};
        const float* W = c.in[24] + ((size_t)layer * 3 + b) * 1024 * D;
        for (int u = c.bid; u < nM * nN; u += c.nb) sgemm_unit(rp, W, D, 1024, (u % nM) * 128, (u / nM) * 128, ep, (float*)c.smem, c.tid);
    }
}
struct EpiOut { const Ctx* c; int layer;
    __device__ __forceinline__ void operator()(int row, int col, const float (&v)[8]) const {
        const float* xin = c->xrow(layer, row) + col; const float* g = c->mod(layer, row < L ? 0 : 1, 2) + col;
        float* o = (float*)(c->ws + WS_XA) + (size_t)row * D + col;
        const float4 x0 = *(const float4*)xin, x1 = *(const float4*)(xin + 4), g0 = *(const float4*)g, g1 = *(const float4*)(g + 4);
        *(float4*)o = make_float4(x0.x + g0.x * v[0], x0.y + g0.y * v[1], x0.z + g0.z * v[2], x0.w + g0.w * v[3]);
        *(float4*)(o + 4) = make_float4(x1.x + g1.x * v[4], x1.y + g1.y * v[5], x1.z + g1.z * v[6], x1.w + g1.w * v[7]);
    }
};
__device__ __forceinline__ void ph_e(const Ctx& c, int layer) {
    const int nM = MR / 128, nN = D / 128;
    const RowLin rp{c.wsp<bf16_t>(WS_MB), D}; const EpiOut ep{&c, layer};
    const float* W = c.in[25] + (size_t)layer * D * D;
    for (int u = c.bid; u < nM * nN; u += c.nb) sgemm_unit(rp, W, D, D, (u % nM) * 128, (u / nM) * 128, ep, (float*)c.smem, c.tid);
}

__device__ __forceinline__ void ph_f(const Ctx& c, int layer) {
    const int gw = c.bid * 8 + c.wave, ngw = c.nb * 8;
    const float* g = c.in[26] + (size_t)layer * D;
    const float* wr = c.in[27] + (size_t)layer * D * NE;
    for (int r = gw; r < MR; r += ngw) {
        const float* x = c.wsp<float>(WS_XA) + (size_t)r * D;
        const int src = r < L ? 0 : 1;
        const float* sh = c.mod(layer, src, 3); const float* sc = c.mod(layer, src, 4);
        float4 v[8]; float ss = 0.f;
#pragma unroll
        for (int j = 0; j < 8; ++j) { v[j] = *(const float4*)(x + 4 * c.lane + 256 * j); ss += v[j].x * v[j].x + v[j].y * v[j].y + v[j].z * v[j].z + v[j].w * v[j].w; }
        ss = wave_sum(ss);
        const float inv = rsqrtf(ss * (1.0f / D) + RMS_EPS);
        bf16_t* o = c.wsp<bf16_t>(WS_H2) + (size_t)r * D;
        float lg[NE];
#pragma unroll
        for (int e = 0; e < NE; ++e) lg[e] = 0.f;
#pragma unroll
        for (int j = 0; j < 8; ++j) {
            const int col = 4 * c.lane + 256 * j;
            const float4 gg = *(const float4*)(g + col), s4 = *(const float4*)(sh + col), c4 = *(const float4*)(sc + col);
            const float y[4] = {v[j].x * inv * gg.x * (1.f + c4.x) + s4.x, v[j].y * inv * gg.y * (1.f + c4.y) + s4.y,
                                v[j].z * inv * gg.z * (1.f + c4.z) + s4.z, v[j].w * inv * gg.w * (1.f + c4.w) + s4.w};
            uint2 w; w.x = pk2(y[0], y[1]); w.y = pk2(y[2], y[3]);
            *(uint2*)(o + col) = w;
#pragma unroll
            for (int q = 0; q < 4; ++q) {
                const float4* wp = (const float4*)(wr + (size_t)(col + q) * NE);
#pragma unroll
                for (int e4 = 0; e4 < 4; ++e4) { const float4 w4 = wp[e4]; lg[e4 * 4 + 0] = fmaf(y[q], w4.x, lg[e4 * 4 + 0]); lg[e4 * 4 + 1] = fmaf(y[q], w4.y, lg[e4 * 4 + 1]); lg[e4 * 4 + 2] = fmaf(y[q], w4.z, lg[e4 * 4 + 2]); lg[e4 * 4 + 3] = fmaf(y[q], w4.w, lg[e4 * 4 + 3]); }
            }
        }
        float mx = -3e38f;
#pragma unroll
        for (int e = 0; e < NE; ++e) { lg[e] = wave_sum(lg[e]); mx = fmaxf(mx, lg[e]); }
        float sum = 0.f;
#pragma unroll
        for (int e = 0; e < NE; ++e) { lg[e] = expf(lg[e] - mx); sum += lg[e]; }
        float mine = 0.f;
#pragma unroll
        for (int e = 0; e < NE; ++e) mine = (c.lane == e) ? lg[e] / sum : mine;
        if (c.lane < NE) c.wsp<float>(WS_AFF)[(size_t)r * NE + c.lane] = mine;
    }
}

__device__ __forceinline__ void topk_unit(const Ctx& c, int e, int row0, int n, int K, int slot0) {
    unsigned* sh = (unsigned*)c.smem;
    const int tid = c.tid, lane = c.lane, wave = c.wave;
    const float* aff = c.wsp<float>(WS_AFF);
    unsigned key[32];
#pragma unroll
    for (int j = 0; j < 32; ++j) { const int t = tid + NTHREADS * j; key[j] = t < n ? __float_as_uint(aff[(size_t)(row0 + t) * NE + e]) : 0u; }
    unsigned T = 0u;
#pragma unroll 1
    for (int bit = 30; bit >= 0; bit -= 2) {
        const unsigned t1 = T | (1u << bit), t2 = T | (2u << bit), t3 = T | (3u << bit);
        unsigned c1 = 0u, c2 = 0u, c3 = 0u;
#pragma unroll
        for (int j = 0; j < 32; ++j) { c1 += key[j] >= t1 ? 1u : 0u; c2 += key[j] >= t2 ? 1u : 0u; c3 += key[j] >= t3 ? 1u : 0u; }
#pragma unroll
        for (int o = 1; o < 64; o <<= 1) { c1 += __shfl_xor(c1, o); c2 += __shfl_xor(c2, o); c3 += __shfl_xor(c3, o); }
        __syncthreads();
        if (lane == 0) { sh[wave] = c1; sh[8 + wave] = c2; sh[16 + wave] = c3; }
        __syncthreads();
        unsigned s1 = 0u, s2 = 0u, s3 = 0u;
#pragma unroll
        for (int w = 0; w < 8; ++w) { s1 += sh[w]; s2 += sh[8 + w]; s3 += sh[16 + w]; }
        T = s3 >= (unsigned)K ? t3 : (s2 >= (unsigned)K ? t2 : (s1 >= (unsigned)K ? t1 : T));
    }
    unsigned ng = 0u, neq = 0u;
#pragma unroll
    for (int j = 0; j < 32; ++j) { ng += key[j] > T ? 1u : 0u; neq += (key[j] == T && tid + NTHREADS * j < n) ? 1u : 0u; }
    unsigned ig = ng, ie = neq;
#pragma unroll
    for (int o = 1; o < 64; o <<= 1) { const unsigned a = __shfl_up(ig, o), b = __shfl_up(ie, o); if (lane >= o) { ig += a; ie += b; } }
    __syncthreads();
    if (lane == 63) { sh[32 + wave] = ig; sh[40 + wave] = ie; }
    __syncthreads();
    unsigned og = 0u, oe = 0u, totg = 0u, tote = 0u;
#pragma unroll
    for (int w = 0; w < 8; ++w) { const unsigned a = sh[32 + w], b = sh[40 + w]; if (w < wave) { og += a; oe += b; } totg += a; tote += b; }
    const unsigned need = (unsigned)K - totg;
    unsigned pg = og + ig - ng;
    int* IDX = c.wsp<int>(WS_IDX) + (size_t)e * SLOTS; float* GS = c.wsp<float>(WS_GSEL) + (size_t)e * SLOTS; int* SL = c.wsp<int>(WS_SLOT) + (size_t)e * MR;
    if (tote == need) {
        unsigned pe = totg + oe + ie - neq;
#pragma unroll
        for (int j = 0; j < 32; ++j) { const int t = tid + NTHREADS * j;
            if (t < n) { int slot = -1; if (key[j] > T) slot = (int)pg++; else if (key[j] == T) slot = (int)pe++;
                SL[row0 + t] = slot >= 0 ? slot0 + slot : -1; if (slot >= 0) { IDX[slot0 + slot] = row0 + t; GS[slot0 + slot] = __uint_as_float(key[j]); } } }
    } else {
        unsigned base_eq = 0u;
#pragma unroll 1
        for (int j = 0; j < 32; ++j) { const int t = tid + NTHREADS * j;
            const unsigned kj = t < n ? __float_as_uint(aff[(size_t)(row0 + t) * NE + e]) : 0u;
            const bool eq = t < n && kj == T;
            const unsigned long long me = __ballot(eq);
            const unsigned long long lower = (lane == 0) ? 0ull : (~0ull >> (64 - lane));
            const unsigned re = (unsigned)__popcll(me & lower);
            __syncthreads();
            if (lane == 0) sh[48 + wave] = (unsigned)__popcll(me);
            __syncthreads();
            unsigned oq = 0u, tq = 0u;
#pragma unroll
            for (int w = 0; w < 8; ++w) { const unsigned a = sh[48 + w]; if (w < wave) oq += a; tq += a; }
            if (t < n) { int slot = -1; if (kj > T) slot = (int)pg++; else if (eq) { const unsigned rk = base_eq + oq + re; if (rk < need) slot = (int)(totg + rk); }
                SL[row0 + t] = slot >= 0 ? slot0 + slot : -1; if (slot >= 0) { IDX[slot0 + slot] = row0 + t; GS[slot0 + slot] = __uint_as_float(kj); } }
            base_eq += tq;
        }
    }
    __syncthreads();
}
__device__ __forceinline__ void ph_g(const Ctx& c) {
    for (int u = c.bid; u < 32; u += c.nb) {
        if (u < 16) topk_unit(c, u, 0, L, CAP, 0);
        else { const int e = u - 16; topk_unit(c, e, L, LC, CAPC, CAP);
            for (int s = CAP + CAPC + c.tid; s < SLOTS; s += NTHREADS) { c.wsp<int>(WS_IDX)[(size_t)e * SLOTS + s] = 0; c.wsp<float>(WS_GSEL)[(size_t)e * SLOTS + s] = 0.f; } }
    }
}

struct EpiGate { float* tmp; __device__ __forceinline__ void operator()(int row, int col, const float (&v)[8]) const {
    float* p = tmp + (size_t)row * DF + col; *(float4*)p = make_float4(v[0], v[1], v[2], v[3]); *(float4*)(p + 4) = make_float4(v[4], v[5], v[6], v[7]); } };
struct EpiUp { const float* tmp; bf16_t* act; __device__ __forceinline__ void operator()(int row, int col, const float (&v)[8]) const {
    const float* p = tmp + (size_t)row * DF + col; const float4 a0 = *(const float4*)p, a1 = *(const float4*)(p + 4);
    const float a[8] = {a0.x, a0.y, a0.z, a0.w, a1.x, a1.y, a1.z, a1.w}; float t[8];
#pragma unroll
    for (int j = 0; j < 8; ++j) t[j] = silu_f(a[j]) * v[j];
    uint4 o; o.x = pk2(t[0], t[1]); o.y = pk2(t[2], t[3]); o.z = pk2(t[4], t[5]); o.w = pk2(t[6], t[7]);
    *(uint4*)(act + (size_t)row * DF + col) = o; } };
struct EpiDown { bf16_t* ye; __device__ __forceinline__ void operator()(int row, int col, const float (&v)[8]) const {
    uint4 o; o.x = pk2(v[0], v[1]); o.y = pk2(v[2], v[3]); o.z = pk2(v[4], v[5]); o.w = pk2(v[6], v[7]);
    *(uint4*)(ye + (size_t)row * D + col) = o; } };
__device__ __forceinline__ void ph_h(const Ctx& c, int layer) {
    const int nM = SLOTS / 128, nN = DF / 128;
    for (int which = 0; which < 2; ++which)
        for (int u = c.bid; u < NE * nM * nN; u += c.nb) {
            const int e = u / (nM * nN), r = u % (nM * nN), pm = r % nM, pn = r / nM;
            const RowGather rp{c.wsp<bf16_t>(WS_H2), D, c.wsp<int>(WS_IDX) + (size_t)e * SLOTS};
            float* tmp = c.wsp<float>(WS_TMP) + (size_t)e * SLOTS * DF;
            const float* W = c.in[which == 0 ? 28 : 29] + ((size_t)layer * NE + e) * D * DF;
            if (which == 0) { const EpiGate ep{tmp}; sgemm_unit(rp, W, DF, D, pm * 128, pn * 128, ep, (float*)c.smem, c.tid); }
            else { const EpiUp ep{tmp, c.wsp<bf16_t>(WS_ACT) + (size_t)e * SLOTS * DF}; sgemm_unit(rp, W, DF, D, pm * 128, pn * 128, ep, (float*)c.smem, c.tid); }
        }
}
__device__ __forceinline__ void ph_i(const Ctx& c, int layer) {
    const int nM = SLOTS / 128, nN = D / 128;
    for (int u = c.bid; u < NE * nM * nN; u += c.nb) {
        const int e = u / (nM * nN), r = u % (nM * nN), pm = r % nM, pn = r / nM;
        const RowLin rp{c.wsp<bf16_t>(WS_ACT) + (size_t)e * SLOTS * DF, DF};
        const EpiDown ep{c.wsp<bf16_t>(WS_YE) + (size_t)e * SLOTS * D};
        const float* W = c.in[30] + ((size_t)layer * NE + e) * DF * D;
        sgemm_unit(rp, W, D, DF, pm * 128, pn * 128, ep, (float*)c.smem, c.tid);
    }
}

__device__ __forceinline__ void ph_j(const Ctx& c, int layer) {
    const int gw = c.bid * 8 + c.wave, ngw = c.nb * 8;
    const int nrows = layer == 0 ? MR : L;
    for (int r = gw; r < nrows; r += ngw) {
        const float* x1 = c.wsp<float>(WS_XA) + (size_t)r * D;
        const float* g5 = c.mod(layer, r < L ? 0 : 1, 5);
        float* o = layer == 0 ? c.wsp<float>(WS_XB) + (size_t)r * D : c.out + (size_t)r * D;
        float acc[32];
#pragma unroll
        for (int j = 0; j < 32; ++j) acc[j] = 0.f;
        for (int e = 0; e < NE; ++e) {
            const int s = c.wsp<int>(WS_SLOT)[(size_t)e * MR + r];
            if (s >= 0) {
                const float gs = c.wsp<float>(WS_GSEL)[(size_t)e * SLOTS + s];
                const bf16_t* y = c.wsp<bf16_t>(WS_YE) + ((size_t)e * SLOTS + s) * D;
#pragma unroll
                for (int j = 0; j < 8; ++j) { const uint2 w = *(const uint2*)(y + 4 * c.lane + 256 * j);
                    acc[4 * j + 0] = fmaf(gs, __uint_as_float(w.x << 16), acc[4 * j + 0]); acc[4 * j + 1] = fmaf(gs, __uint_as_float(w.x & 0xffff0000u), acc[4 * j + 1]);
                    acc[4 * j + 2] = fmaf(gs, __uint_as_float(w.y << 16), acc[4 * j + 2]); acc[4 * j + 3] = fmaf(gs, __uint_as_float(w.y & 0xffff0000u), acc[4 * j + 3]); }
            }
        }
#pragma unroll
        for (int j = 0; j < 8; ++j) { const int col = 4 * c.lane + 256 * j; const float4 xv = *(const float4*)(x1 + col), gv = *(const float4*)(g5 + col);
            *(float4*)(o + col) = make_float4(xv.x + gv.x * acc[4 * j], xv.y + gv.y * acc[4 * j + 1], xv.z + gv.z * acc[4 * j + 2], xv.w + gv.w * acc[4 * j + 3]); }
    }
}


#ifndef FAST_B
#define FAST_B 1
#endif
#ifndef FAST_DE
#define FAST_DE 1
#endif
#ifndef FAST_HI
#define FAST_HI 1
#endif
__device__ __forceinline__ void ph_b_fast(const Ctx& c, int layer) {
    LAS unsigned char* lds = (LAS unsigned char*)c.smem;
    const char* WIN = (const char*)(c.ws + WS_WIN); const char* HX = (const char*)(c.ws + WS_HX);
    __syncthreads();
    {
        const pg8::GeomLin G{WIN, HX, D, D, D, nullptr}; pg8::StaticOrder S; S.init(3072 / 256, MR / 256, c.nb, c.bid);
        const pg8::EpiBf16Plain E{c.wsp<bf16_t>(WS_ZHYT), MR, 0};
        pg8::gemm_phase(lds, G, S, E);
    }
    {
        const pg8::GeomLin G{HX, WIN + (size_t)OFF_WAQ * D * 2, D, D, D, nullptr}; pg8::StaticOrder S; S.init(MR / 256, (NIN - OFF_WAQ) / 256, c.nb, c.bid);
        const pg8::EpiInRest E{c.ws};
        pg8::gemm_phase(lds, G, S, E);
    }
}
__device__ __forceinline__ void ph_d_fast(const Ctx& c, int layer) {
    LAS unsigned char* lds = (LAS unsigned char*)c.smem;
    const int nM = layer == 0 ? MR / 256 : L / 256;
    pg8::StaticOrder S; S.init(nM, D / 256, c.nb, c.bid);
    __syncthreads();
    { const pg8::GeomLin G{(const char*)(c.ws + WS_YHY), (const char*)(c.ws + WS_WBR), 1024, 1024, 1024, nullptr}; const pg8::EpiMergeF<0> E{c.ws}; pg8::gemm_phase(lds, G, S, E); }
    { const pg8::GeomLin G{(const char*)(c.ws + WS_YWA), (const char*)(c.ws + WS_WBR) + (size_t)D * 1024 * 2, 1024, 1024, 1024, nullptr}; const pg8::EpiMergeF<1> E{c.ws}; pg8::gemm_phase(lds, G, S, E); }
    { const pg8::GeomLin G{(const char*)(c.ws + WS_YNA), (const char*)(c.ws + WS_WBR) + (size_t)2 * D * 1024 * 2, 1024, 1024, 1024, nullptr}; const pg8::EpiMergeF<2> E{c.ws}; pg8::gemm_phase(lds, G, S, E); }
}
__device__ __forceinline__ void ph_e_fast(const Ctx& c, int layer) {
    LAS unsigned char* lds = (LAS unsigned char*)c.smem;
    const int nM = layer == 0 ? MR / 256 : L / 256;
    pg8::StaticOrder S; S.init(nM, D / 256, c.nb, c.bid);
    __syncthreads();
    const pg8::GeomLin G{(const char*)(c.ws + WS_MB), (const char*)(c.ws + WS_WOUT), D, D, D, nullptr}; const pg8::EpiOutF E{&c, layer};
    pg8::gemm_phase(lds, G, S, E);
}
__device__ __forceinline__ void ph_h_fast(const Ctx& c, int layer) {
    LAS unsigned char* lds = (LAS unsigned char*)c.smem;
    const int tpe = layer == 0 ? 9 : 8;
    pg8::StaticOrder S; S.init(NE * tpe, 2048 / 256, c.nb, c.bid);
    __syncthreads();
    const pg8::GeomExpert<true> G{(const char*)(c.ws + WS_H2), (const char*)(c.ws + WS_WGU), D, D, D, c.wsp<int>(WS_IDX), tpe, 2048};
    const pg8::EpiGU E{c.wsp<bf16_t>(WS_ACT)};
    pg8::gemm_phase(lds, G, S, E);
}
__device__ __forceinline__ void ph_i_fast(const Ctx& c, int layer) {
    LAS unsigned char* lds = (LAS unsigned char*)c.smem;
    const int tpe = layer == 0 ? 9 : 8;
    pg8::StaticOrder S; S.init(NE * tpe, D / 256, c.nb, c.bid);
    __syncthreads();
    const pg8::GeomExpert<false> G{(const char*)(c.ws + WS_ACT), (const char*)(c.ws + WS_WDN), DF, DF, DF, nullptr, tpe, D};
    const pg8::EpiBf16Plain E{c.wsp<bf16_t>(WS_YE), D, 0};
    pg8::gemm_phase(lds, G, S, E);
}

__global__ void __launch_bounds__(NTHREADS, 2) mega(KArgs a) {
    extern __shared__ __attribute__((aligned(16))) unsigned char smem[];
    Ctx c; c.in = a.in; c.out = a.out; c.ws = a.ws; c.bid = blockIdx.x; c.nb = gridDim.x; c.tid = threadIdx.x; c.lane = c.tid & 63;
    c.wave = __builtin_amdgcn_readfirstlane(c.tid >> 6); c.smem = smem;
    volatile LAS unsigned* st = (volatile LAS unsigned*)(LAS unsigned char*)(smem + LDS_BYTES - 16);
    if (c.tid == 0) { st[0] = 0u; st[1] = 0u; st[2] = 0u; st[3] = 0u; }
    __syncthreads();
    const int lo = a.ph_lo, hi = a.ph_hi;
    XcdBarrier bar; bar.bar = (unsigned*)(a.ws + WS_CTL); bar.x = 0; bar.st = st;
    if (hi - lo > 1) bar = xcd_barrier_post((unsigned*)(a.ws + WS_CTL), st);
#ifndef ONLY_PH
#define ONLY_PH -1
#endif
#define PSEL(j) (ONLY_PH < 0 || ONLY_PH == (j))

#define IN(k) (lo <= (k) && (k) < hi)
#define GASP __attribute__((address_space(1)))
#define LAUNDER(cc) Ctx cc = c; asm volatile("" : "+v"(cc.tid), "+v"(cc.lane)); asm volatile("" : "+s"(cc.bid), "+s"(cc.nb), "+s"(cc.wave)); \
    { GASP unsigned char* wg_ = (GASP unsigned char*)cc.ws; GASP float* og_ = (GASP float*)cc.out; asm volatile("" : "+s"(wg_), "+s"(og_)); cc.ws = (unsigned char*)wg_; cc.out = (float*)og_; }
#define SEAM(k) do { if (IN(k) && IN((k) + 1)) xcd_barrier(bar); } while (0)
    if (PSEL(0) && IN(0)) { LAUNDER(cc); ph_g0(cc); } SEAM(0);
#define LAYER_PROGRAM(layer) do { const int b = 1 + (layer) * PH_PER_LAYER; \
        if (PSEL(1) && IN(b + 0)) { LAUNDER(cc); constexpr int ly = (layer); { ph_a(cc, ly); if constexpr (DOREP(15)) { LAUNDER(ce); ph_a(ce, ly); } ph_taps(cc, ly); if constexpr (DOREP(14)) { LAUNDER(ce); ph_taps(ce, ly); } if (FAST_B || FAST_DE || FAST_HI) ph_conv(cc, ly); if constexpr (DOREP(13)) { LAUNDER(ce); ph_conv(ce, ly); } __syncthreads(); } if constexpr (DOREP(1)) { LAUNDER(cd); { Ctx& cc = cd; (void)cc; ph_a(cd, ly); ph_taps(cd, ly); if (FAST_B || FAST_DE || FAST_HI) ph_conv(cd, ly); __syncthreads(); } } } SEAM(b + 0); \
        if (PSEL(2) && IN(b + 1)) { LAUNDER(cc); constexpr int ly = (layer); { if (FAST_B) ph_b_fast(cc, ly); else ph_b(cc, ly); __syncthreads(); } if constexpr (DOREP(2)) { LAUNDER(cd); { Ctx& cc = cd; (void)cc; if (FAST_B) ph_b_fast(cd, ly); else ph_b(cd, ly); __syncthreads(); } } } SEAM(b + 1); \
        if (PSEL(3) && IN(b + 2)) { LAUNDER(cc); constexpr int ly = (layer); ph_b2(cc, ly); } SEAM(b + 2); \
        if (PSEL(4) && IN(b + 3)) { LAUNDER(cc); constexpr int ly = (layer); { ph_c(cc, ly); __syncthreads(); } if constexpr (DOREP(4)) { LAUNDER(cd); { Ctx& cc = cd; (void)cc; ph_c(cd, ly); __syncthreads(); } } } SEAM(b + 3); \
        if (PSEL(5) && IN(b + 4)) { LAUNDER(cc); constexpr int ly = (layer); { ph_c2(cc); __syncthreads(); } if constexpr (DOREP(5)) { LAUNDER(cd); { Ctx& cc = cd; (void)cc; ph_c2(cd); __syncthreads(); } } } SEAM(b + 4); \
        if (PSEL(6) && IN(b + 5)) { LAUNDER(cc); constexpr int ly = (layer); { if (FAST_DE) ph_d_fast(cc, ly); else ph_d(cc, ly); __syncthreads(); } if constexpr (DOREP(6)) { LAUNDER(cd); { Ctx& cc = cd; (void)cc; if (FAST_DE) ph_d_fast(cd, ly); else ph_d(cd, ly); __syncthreads(); } } } SEAM(b + 5); \
        if (PSEL(7) && IN(b + 6)) { LAUNDER(cc); constexpr int ly = (layer); { if (FAST_DE) ph_e_fast(cc, ly); else ph_e(cc, ly); __syncthreads(); } if constexpr (DOREP(7)) { LAUNDER(cd); { Ctx& cc = cd; (void)cc; if (FAST_DE) ph_e_fast(cd, ly); else ph_e(cd, ly); __syncthreads(); } } } SEAM(b + 6); \
        if (PSEL(8) && IN(b + 7)) { LAUNDER(cc); constexpr int ly = (layer); { ph_f(cc, ly); __syncthreads(); } if constexpr (DOREP(8)) { LAUNDER(cd); { Ctx& cc = cd; (void)cc; ph_f(cd, ly); __syncthreads(); } } } SEAM(b + 7); \
        if (PSEL(9) && IN(b + 8)) { LAUNDER(cc); constexpr int ly = (layer); { ph_g(cc); __syncthreads(); } if constexpr (DOREP(9)) { LAUNDER(cd); { Ctx& cc = cd; (void)cc; ph_g(cd); __syncthreads(); } } } SEAM(b + 8); \
        if (PSEL(10) && IN(b + 9)) { LAUNDER(cc); constexpr int ly = (layer); { if (FAST_HI) ph_h_fast(cc, ly); else ph_h(cc, ly); __syncthreads(); } if constexpr (DOREP(10)) { LAUNDER(cd); { Ctx& cc = cd; (void)cc; if (FAST_HI) ph_h_fast(cd, ly); else ph_h(cd, ly); __syncthreads(); } } } SEAM(b + 9); \
        if (PSEL(11) && IN(b + 10)) { LAUNDER(cc); constexpr int ly = (layer); { if (FAST_HI) ph_i_fast(cc, ly); else ph_i(cc, ly); __syncthreads(); } if constexpr (DOREP(11)) { LAUNDER(cd); { Ctx& cc = cd; (void)cc; if (FAST_HI) ph_i_fast(cd, ly); else ph_i(cd, ly); __syncthreads(); } } } SEAM(b + 10); \
        if (PSEL(12) && IN(b + 11)) { LAUNDER(cc); constexpr int ly = (layer); { ph_j(cc, ly); __syncthreads(); } if constexpr (DOREP(12)) { LAUNDER(cd); { Ctx& cc = cd; (void)cc; ph_j(cd, ly); __syncthreads(); } } } SEAM(b + 11); \
    } while (0)
    LAYER_PROGRAM(0);
    LAYER_PROGRAM(1);
#undef LAYER_PROGRAM
#undef IN
#undef SEAM
}

extern "C" void kernel_launch(void* const* d_in, const int* in_sizes, int n_in, void* d_out, int out_size, void* d_ws, size_t ws_size, hipStream_t stream) {
    static int grid = 0;
    if (grid == 0) {
        if (n_in != 31 || out_size != L * D || ws_size < WS_END) { fprintf(stderr, "kernel_launch: unexpected shapes: n_in %d out %d ws %zu (need %zu)\n", n_in, out_size, ws_size, (size_t)WS_END); grid = -1; return; }
        int dev = 0, cus = 0, per_cu = 0;
        if (hipGetDevice(&dev) != hipSuccess || hipDeviceGetAttribute(&cus, hipDeviceAttributeMultiprocessorCount, dev) != hipSuccess) { grid = -1; return; }
        if (hipFuncSetAttribute((const void*)mega, hipFuncAttributeMaxDynamicSharedMemorySize, LDS_BYTES) != hipSuccess) { fprintf(stderr, "kernel_launch: hipFuncSetAttribute failed\n"); grid = -1; return; }
        if (hipOccupancyMaxActiveBlocksPerMultiprocessor(&per_cu, (const void*)mega, NTHREADS, LDS_BYTES) != hipSuccess || per_cu < 1) fprintf(stderr, "kernel_launch: occupancy query says %d\n", per_cu);
        (void)hipGetLastError();
        grid = cus;
    }
    if (grid < 0) return;
    if (hipMemsetAsync((char*)d_ws + WS_CTL, 0, CTL_BYTES, stream) != hipSuccess) return;
    KArgs a{};
    for (int i = 0; i < 31; ++i) a.in[i] = (const float*)d_in[i];
    a.out = (float*)d_out; a.ws = (unsigned char*)d_ws;
#if ONE_LAUNCH
    a.ph_lo = 0; a.ph_hi = NPH;
    hipLaunchKernelGGL(mega, dim3(grid), dim3(NTHREADS), LDS_BYTES, stream, a);
#else
    for (int p = 0; p < NPH; ++p) { a.ph_lo = p; a.ph_hi = p + 1; hipLaunchKernelGGL(mega, dim3(grid), dim3(NTHREADS), LDS_BYTES, stream, a); }
#endif
    const hipError_t le = hipPeekAtLastError();
    if (le != hipSuccess) fprintf(stderr, "kernel_launch: launch failed: %s\n", hipGetErrorName(le));
}
```

```cpp
#include <hip/hip_runtime.h>
#include <stdint.h>
#include <stdio.h>

#ifndef ONE_LAUNCH
#define ONE_LAUNCH 1
#endif

#ifndef REP_MASK
#define REP_MASK 0
#endif
#define DOREP(j) ((((REP_MASK) >> (j)) & 1) != 0)
typedef unsigned short bf16_t;
#define LAS __attribute__((address_space(3)))

constexpr int L = 16384, LC = 256, MR = L + LC, D = 2048, NIN = 13824;
constexpr int HD = 128, GRIDW = 64;
constexpr int OFF_HY = 0, OFF_WAQ = 3072, OFF_WAKV = 4096, OFF_NAQ = 4608, OFF_NAKV = 5632, OFF_GATE = 7680;
constexpr int NE = 16, CAP = 2048, CAPC = 32, SLOTS = 2304, DF = 1024;
constexpr int NMOD = 6 * D;
constexpr float RMS_EPS = 1e-6f;
constexpr float QK_SCALE = 0.08838834764831845f;

constexpr size_t al256(size_t x) { return (x + 255) & ~(size_t)255; }
constexpr size_t WS_CTL = 0, CTL_BYTES = 1u << 20;
constexpr size_t WS_MOD = WS_CTL + CTL_BYTES;
constexpr size_t WS_H2B = WS_MOD + al256((size_t)2 * 2 * NMOD * 4);
constexpr size_t WS_FW3T = WS_H2B + al256((size_t)2 * MR * 256 * 2);
constexpr size_t WS_AFF = WS_FW3T + al256((size_t)2 * 4096 * 256 * 2);
constexpr size_t WS_IDX = WS_AFF + al256((size_t)MR * 16 * 4);
constexpr size_t WS_GSEL = WS_IDX + al256((size_t)NE * SLOTS * 4);
constexpr size_t WS_SLOT = WS_GSEL + al256((size_t)NE * SLOTS * 4);
constexpr size_t WS_KFC = WS_SLOT + al256((size_t)NE * MR * 4);
constexpr size_t WS_ZHYC = WS_KFC + al256((size_t)4096 * LC * 2);
constexpr size_t WS_XA = WS_ZHYC + al256((size_t)3072 * LC * 2);
constexpr size_t WS_XB = WS_XA + al256((size_t)MR * D * 4);
constexpr size_t WS_W = WS_XB + al256((size_t)MR * D * 4);
constexpr size_t W_BYTES = (size_t)2 * ((size_t)NIN * D + 3 * (size_t)D * 1024 + (size_t)D * D + (size_t)NE * 2048 * D + (size_t)NE * D * DF);
constexpr size_t WS_WIN = WS_W;
constexpr size_t WS_WBR = WS_WIN + (size_t)NIN * D * 2;
constexpr size_t WS_WOUT = WS_WBR + (size_t)3 * D * 1024 * 2;
constexpr size_t WS_WGU = WS_WOUT + (size_t)D * D * 2;
constexpr size_t WS_WDN = WS_WGU + (size_t)NE * 2048 * D * 2;
constexpr size_t WS_R3 = WS_W + al256(W_BYTES);
constexpr size_t R3_BYTES = (size_t)MR * D * 4 + (size_t)MR * D * 2;
constexpr size_t WS_KF = WS_R3;
constexpr size_t WS_KS = WS_R3 + al256((size_t)4096 * L * 2);
constexpr size_t WS_MPART = WS_R3;
constexpr size_t WS_MB = WS_R3 + (size_t)MR * D * 4;
constexpr size_t WS_TMP = WS_R3;
constexpr size_t WS_YE = WS_R3;
constexpr size_t WS_R4 = WS_R3 + al256(R3_BYTES);
constexpr size_t R4_BYTES = (size_t)MR * 6144 * 2;
constexpr size_t WS_GATE = WS_R4;
constexpr size_t WS_H2 = WS_R4;
constexpr size_t WS_ACT = WS_R4 + al256((size_t)MR * D * 2);
constexpr size_t WS_R5 = WS_R4 + al256(R4_BYTES);
constexpr size_t WS_MODPART = WS_R5;
constexpr size_t WS_HX = WS_R5;
constexpr size_t WS_YHYT = WS_R5;
constexpr size_t WS_YHY = WS_R5 + al256((size_t)1024 * L * 2);
constexpr size_t WS_ZHYT = WS_R5 + al256((size_t)MR * D * 2);
constexpr size_t WS_QWA = WS_ZHYT + al256((size_t)3072 * MR * 2);
constexpr size_t WS_KVWA = WS_QWA + al256((size_t)MR * 1024 * 2);
constexpr size_t WS_QNA = WS_KVWA + al256((size_t)MR * 512 * 2);
constexpr size_t WS_KVNA = WS_QNA + al256((size_t)MR * 1024 * 2);
constexpr size_t WS_YWA = WS_KVNA + al256((size_t)MR * 2048 * 2);
constexpr size_t WS_YNA = WS_YWA + al256((size_t)MR * 1024 * 2);
constexpr size_t WS_END = WS_YNA + al256((size_t)MR * 1024 * 2);
static_assert((size_t)1024 * L * 2 + (size_t)MR * 1024 * 2 <= (size_t)MR * D * 2 + 512, "YHYT+YHY overlay HX");
static_assert((size_t)4096 * L * 2 + 256 + (size_t)256 * 2 * 16384 * 8 <= R3_BYTES && (size_t)NE * SLOTS * D * 2 <= R3_BYTES && (size_t)NE * SLOTS * DF * 4 <= R3_BYTES, "R3");
static_assert((size_t)MR * D * 2 + 256 + (size_t)NE * SLOTS * DF * 2 <= R4_BYTES, "R4");

constexpr int LDS_BYTES = 160 * 1024;
constexpr int NTHREADS = 512;
constexpr int PH_PER_LAYER = 12, NPH = 1 + 2 * PH_PER_LAYER;

__device__ __forceinline__ float bf2f(bf16_t b) { return __uint_as_float(((unsigned)b) << 16); }
__device__ __forceinline__ bf16_t f2bf(float f) { unsigned u = __float_as_uint(f); u += 0x7fffu + ((u >> 16) & 1u); return (bf16_t)(u >> 16); }
__device__ __forceinline__ unsigned pk2(float lo, float hi) { return (unsigned)f2bf(lo) | ((unsigned)f2bf(hi) << 16); }
__device__ __forceinline__ float wave_sum(float v) {
#pragma unroll
    for (int o = 1; o < 64; o <<= 1) v += __shfl_xor(v, o);
    return v;
}
__device__ __forceinline__ float wave_max(float v) {
#pragma unroll
    for (int o = 1; o < 64; o <<= 1) v = fmaxf(v, __shfl_xor(v, o));
    return v;
}
__device__ __forceinline__ float silu_f(float x) { return x / (1.f + __expf(-x)); }
__device__ __forceinline__ float sigmoid_f(float x) { return 1.f / (1.f + __expf(-x)); }
#define LDS_FENCE() asm volatile("s_waitcnt lgkmcnt(0)" ::: "memory")

#define XB_TMO      128
#define XB_XCNT(j)  (256  + 64 * (j))
#define XB_XSUB(j)  (1280 + 64 * (j))
#define XB_XGEN(j)  (2304 + 64 * (j))
#define XB_TOP      3328
#define XB_TOPGEN   3392
#define XCD_BAR_WORDS 3456
#define XB_SPIN_CAP (1u << 22)

__device__ __forceinline__ unsigned xb_ld(unsigned* p)              { return __hip_atomic_load(p, __ATOMIC_RELAXED, __HIP_MEMORY_SCOPE_AGENT); }
__device__ __forceinline__ unsigned xb_add(unsigned* p, unsigned v) { return __hip_atomic_fetch_add(p, v, __ATOMIC_RELAXED, __HIP_MEMORY_SCOPE_AGENT); }
__device__ __forceinline__ unsigned xb_xcc_id() { return (unsigned)__builtin_amdgcn_s_getreg((3 << 11) | 20) & 0xFu; }
#define XB_SPIN(cond, bar) do { unsigned _sp = 0; while (cond) { __builtin_amdgcn_s_sleep(1); \
    if ((++_sp & 255u) == 0u) { if (xb_ld(&(bar)[XB_TMO])) break; if (_sp > XB_SPIN_CAP) { atomicAdd(&(bar)[XB_TMO], 1u); break; } } } } while (0)

struct XcdBarrier { unsigned* bar; unsigned x; volatile LAS unsigned* st; };

__device__ __forceinline__ XcdBarrier xcd_barrier_post(unsigned* bar, volatile LAS unsigned* st) {
    XcdBarrier b; b.bar = bar; b.x = xb_xcc_id(); b.st = st;
    if (threadIdx.x == 0) (void)xb_add(&bar[XB_XCNT(b.x)], 1u);
    return b;
}
__device__ __forceinline__ void xcd_barrier_complete(unsigned* bar, unsigned x, unsigned& nloc, unsigned& nx) {
    const unsigned G = gridDim.x * gridDim.y * gridDim.z;
    unsigned sum, cnt, mine, sp = 0u;
    for (;;) {
        sum = 0u; cnt = 0u; mine = 0u;
#pragma unroll
        for (unsigned j = 0; j < 16; ++j) { const unsigned c = xb_ld(&bar[XB_XCNT(j)]); sum += c; cnt += (c > 0u) ? 1u : 0u; mine = (j == x) ? c : mine; }
        if (sum == G) break;
        __builtin_amdgcn_s_sleep(1);
        if ((++sp & 255u) == 0u) { if (xb_ld(&bar[XB_TMO])) break; if (sp > XB_SPIN_CAP) { atomicAdd(&bar[XB_TMO], 1u); break; } }
    }
    nloc = mine > 0u ? mine : 1u; nx = cnt > 0u ? cnt : 1u;
}
__device__ __forceinline__ void xcd_barrier(const XcdBarrier& b) {
    asm volatile("s_waitcnt vmcnt(0)" ::: "memory");
    __syncthreads();
    if (threadIdx.x == 0) {
        unsigned* bar = b.bar;
        __builtin_amdgcn_s_waitcnt(0);
        unsigned nloc = b.st[0], nx = b.st[1];
        if (nloc == 0u) { xcd_barrier_complete(bar, b.x, nloc, nx); b.st[0] = nloc; b.st[1] = nx; }
        const unsigned old = xb_add(&bar[XB_XSUB(b.x)], 1u);
        const unsigned gen = old / nloc;
        if (old + 1u == (gen + 1u) * nloc) {
            __builtin_amdgcn_fence(__ATOMIC_RELEASE, "agent");
            asm volatile("s_waitcnt vmcnt(0)" ::: "memory");
            const unsigned og = xb_add(&bar[XB_TOP], 1u);
            const unsigned tg = og / nx;
            if (og + 1u == (tg + 1u) * nx) xb_add(&bar[XB_TOPGEN], 1u);
            else XB_SPIN(xb_ld(&bar[XB_TOPGEN]) == tg, bar);
            __builtin_amdgcn_fence(__ATOMIC_ACQUIRE, "agent");
            xb_add(&bar[XB_XGEN(b.x)], 1u);
            asm volatile("s_waitcnt vmcnt(0)" ::: "memory");
        } else {
            XB_SPIN(xb_ld(&bar[XB_XGEN(b.x)]) == gen, bar);
            __builtin_amdgcn_fence(__ATOMIC_ACQUIRE, "agent");
            asm volatile("s_waitcnt vmcnt(0)" ::: "memory");
        }
    }
    __syncthreads();
}

struct KArgs { const float* in[31]; float* out; unsigned char* ws; int ph_lo, ph_hi; };

struct Ctx {
    const float* const* in; float* out; unsigned char* ws;
    int bid, nb, tid, lane, wave;
    unsigned char* smem;
    template <class T> __device__ __forceinline__ T* wsp(size_t off) const { return (T*)(ws + off); }
    __device__ __forceinline__ const float* mod(int layer, int src, int chunk) const { return wsp<float>(WS_MOD) + ((size_t)(layer * 2 + src) * NMOD) + chunk * D; }
    __device__ __forceinline__ const float* xrow(int layer, int r) const {
        if (layer == 0) return r < L ? in[0] + (size_t)r * D : in[2] + (size_t)(r - L) * D;
        return wsp<float>(WS_XB) + (size_t)r * D;
    }
};

template <class RowPtr, class Epi>
__device__ __forceinline__ void sgemm_unit(const RowPtr& rp, const float* __restrict__ W, int ldw, int K, int m0, int n0, const Epi& ep, float* lds, int tid) {
    float* As = lds;
    float* Bs = lds + 16 * 132;
    const int ty = tid >> 4, tx = tid & 15;
    const int am = tid >> 2, kq = (tid & 3) * 4;
    const int bk = tid >> 5, n4 = (tid & 31) * 4;
    float acc[4][8];
#pragma unroll
    for (int i = 0; i < 4; ++i)
#pragma unroll
        for (int j = 0; j < 8; ++j) acc[i][j] = 0.f;
    const bf16_t* arow = rp(m0 + am);
    const float* wp = W + (size_t)bk * ldw + n0 + n4;
    for (int k0 = 0; k0 < K; k0 += 16) {
        const uint2 a4 = *(const uint2*)(arow + k0 + kq);
        const float4 b4 = *(const float4*)(wp + (size_t)k0 * ldw);
        __syncthreads();
        As[(kq + 0) * 132 + am] = __uint_as_float(a4.x << 16);
        As[(kq + 1) * 132 + am] = __uint_as_float(a4.x & 0xffff0000u);
        As[(kq + 2) * 132 + am] = __uint_as_float(a4.y << 16);
        As[(kq + 3) * 132 + am] = __uint_as_float(a4.y & 0xffff0000u);
        *(float4*)&Bs[bk * 128 + n4] = b4;
        __syncthreads();
#pragma unroll
        for (int kk = 0; kk < 16; ++kk) {
            const float4 a = *(const float4*)&As[kk * 132 + ty * 4];
            const float4 b0 = *(const float4*)&Bs[kk * 128 + tx * 8];
            const float4 b1 = *(const float4*)&Bs[kk * 128 + tx * 8 + 4];
            const float av[4] = {a.x, a.y, a.z, a.w};
            const float bv[8] = {b0.x, b0.y, b0.z, b0.w, b1.x, b1.y, b1.z, b1.w};
#pragma unroll
            for (int i = 0; i < 4; ++i)
#pragma unroll
                for (int j = 0; j < 8; ++j) acc[i][j] = fmaf(av[i], bv[j], acc[i][j]);
        }
    }
#pragma unroll
    for (int i = 0; i < 4; ++i) ep(m0 + ty * 4 + i, n0 + tx * 8, acc[i]);
}

struct RowLin { const bf16_t* base; int ld; __device__ __forceinline__ const bf16_t* operator()(int m) const { return base + (size_t)m * ld; } };
struct RowGather { const bf16_t* base; int ld; const int* idx; __device__ __forceinline__ const bf16_t* operator()(int m) const { return base + (size_t)idx[m] * ld; } };


namespace pg8 {
typedef short bf16x8 __attribute__((ext_vector_type(8)));
typedef float f32x4 __attribute__((ext_vector_type(4)));
typedef unsigned u32x4 __attribute__((ext_vector_type(4)));
typedef unsigned u32x2 __attribute__((ext_vector_type(2)));
constexpr int BM = 256, BK = 64, HALF = 128, HTB = HALF * BK * 2, STAGE_BYTES = 8 * HTB, NXCD = 8, WGM = 8;
__host__ __device__ __forceinline__ int lds_byte(int r, int c) { const int st = (r >> 4) * 2 + (c >> 5), rr = r & 15, cc = c & 31, ob = rr * 64 + cc * 2; return st * 1024 + (ob ^ (((ob >> 9) & 1) << 5)); }
__host__ __device__ __forceinline__ void stage_rc(int b, int& R, int& C) { const int st = b / 1024, sb = b % 1024, swz = sb ^ (((sb >> 9) & 1) << 5); R = (st >> 1) * 16 + swz / 64; C = (st & 1) * 32 + (swz % 64) / 2; }
__host__ __device__ __forceinline__ int perm32(int rho) { const int n = rho >> 4, i = rho & 15; return 8 * (i >> 2) + 4 * n + (i & 3); }
struct Unit { int pm, pn; };
struct StaticOrder {
    int nM, nN, nwg, G, c;
    __host__ __device__ void init(int nM_, int nN_, int G_, int c_) { nM = nM_; nN = nN_; nwg = nM * nN; G = G_; c = c_; }
    __host__ __device__ bool next(int i, Unit& u) const {
        const long Lq = (long)i * G + c; if (Lq >= nwg) return false;
        int wgid = (int)Lq; { const int q = nwg / NXCD, r = nwg % NXCD, xcd = wgid % NXCD, off = wgid / NXCD; wgid = (xcd < r ? xcd * (q + 1) : r * (q + 1) + (xcd - r) * q) + off; }
        const int nig = WGM * nN, gid = wgid / nig, fm = gid * WGM, gsz = (nM - fm) < WGM ? (nM - fm) : WGM;
        u.pm = fm + ((wgid % nig) % gsz); u.pn = (wgid % nig) / gsz; return true;
    }
};
__device__ __forceinline__ unsigned cvt_pk_bf16(float lo, float hi) { unsigned r; asm volatile("v_cvt_pk_bf16_f32 %0, %1, %2" : "=v"(r) : "v"(lo), "v"(hi)); return r; }

struct GeomLin {
    static constexpr bool GATHER = false;
    const char* A; const char* B; int K, lda, ldb; const int* idx;
    __device__ __forceinline__ const char* a_base(const Unit& u) const { return A + (size_t)u.pm * 256 * lda * 2; }
    __device__ __forceinline__ const char* b_base(const Unit& u) const { return B + (size_t)u.pn * 256 * ldb * 2; }
    __device__ __forceinline__ int row0(const Unit& u) const { return u.pm * 256; }
};
template <bool GATHER_> struct GeomExpert {
    static constexpr bool GATHER = GATHER_;
    const char* A; const char* B; int K, lda, ldb; const int* idx; int tpe, nb;
    __device__ __forceinline__ int row0(const Unit& u) const { const int e = u.pm / tpe, t = u.pm - e * tpe; return e * SLOTS + t * 256; }
    __device__ __forceinline__ const char* a_base(const Unit& u) const { return GATHER_ ? A : A + (size_t)row0(u) * lda * 2; }
    __device__ __forceinline__ const char* b_base(const Unit& u) const { const int e = u.pm / tpe; return B + ((size_t)e * nb + (size_t)u.pn * 256) * ldb * 2; }
};

template <class Epi, class Geom, class Sched>
__device__ __forceinline__ void gemm_phase(LAS unsigned char* lds, const Geom& G, const Sched& S, const Epi& E) {
    const int tid = threadIdx.x, wid = __builtin_amdgcn_readfirstlane(tid >> 6), lane = tid & 63, wr = wid >> 2, wc = wid & 3, fr = lane & 15, fq = lane >> 4;
    const int K = G.K, nt = K / BK;
    int Rs[2], Cs[2]; unsigned vB0[2], vA0[2], vAc[2][2], vAn[2][2];
#pragma unroll
    for (int i = 0; i < 2; ++i) { int R, C; stage_rc(tid * 16 + i * 8192, R, C); Rs[i] = R; Cs[i] = C; const int Rb = Epi::PERM ? ((R & ~31) + perm32(R & 31)) : R;
        vB0[i] = (unsigned)(Rb * G.ldb + C) * 2u; vA0[i] = (unsigned)(R * G.lda + C) * 2u;
#pragma unroll
        for (int h = 0; h < 2; ++h) { vAc[h][i] = 0u; vAn[h][i] = 0u; } }
    const size_t hstepA = (size_t)HALF * G.lda * 2, hstepB = (size_t)HALF * G.ldb * 2;
#define PG8_VOFF(dst, u) do { if constexpr (Geom::GATHER) { const int _r0 = G.row0(u); _Pragma("unroll") for (int _h = 0; _h < 2; ++_h) _Pragma("unroll") for (int _i = 0; _i < 2; ++_i) \
        dst[_h][_i] = ((unsigned)G.idx[_r0 + _h * HALF + Rs[_i]] * (unsigned)G.lda + (unsigned)Cs[_i]) * 2u; } } while (0)
    const size_t kstep = (size_t)(BK * 2);
    const unsigned ldsw = (unsigned)wid * 1024u;
    const int aoff = lds_byte(wr * 64 + fr, fq * 8), boff = lds_byte(wc * 32 + fr, fq * 8);
#define PG8_SA(b, h) (((b) * 2 + (h)) * HTB)
#define PG8_SB(b, h) ((4 + (b) * 2 + (h)) * HTB)
#define PG8_STAGE(bufoff, gbase, v) do { \
        __builtin_amdgcn_global_load_lds((const unsigned*)((const char*)(gbase) + (v)[0]), (LAS unsigned*)(lds + (bufoff) + ldsw), 16, 0, 0); \
        __builtin_amdgcn_global_load_lds((const unsigned*)((const char*)(gbase) + (v)[1]), (LAS unsigned*)(lds + (bufoff) + ldsw + 8192), 16, 0, 0); } while (0)
#define PG8_STA(bufoff, gbase, h, VX) do { if constexpr (Geom::GATHER) { PG8_STAGE(bufoff, gbase, VX[h]); } else { PG8_STAGE(bufoff, (gbase) + (h) * hstepA, vA0); } } while (0)
#define PG8_STB(bufoff, gbase, h) PG8_STAGE(bufoff, (gbase) + (h) * hstepB, vB0)
#define PG8_LDA(dst, b, h) do { _Pragma("unroll") for (int m = 0; m < 4; ++m) _Pragma("unroll") for (int k = 0; k < 2; ++k) dst[m][k] = *(const LAS bf16x8*)(lds + PG8_SA(b, h) + aoff + m * 2048 + k * 1024); } while (0)
#define PG8_LDB(dst, b, h) do { _Pragma("unroll") for (int n = 0; n < 2; ++n) _Pragma("unroll") for (int k = 0; k < 2; ++k) dst[n][k] = *(const LAS bf16x8*)(lds + PG8_SB(b, h) + boff + n * 2048 + k * 1024); } while (0)
#define PG8_MMA(ai, bj, At, Bt) do { __builtin_amdgcn_s_setprio(1); _Pragma("unroll") for (int m = 0; m < 4; ++m) _Pragma("unroll") for (int n = 0; n < 2; ++n) _Pragma("unroll") for (int k = 0; k < 2; ++k) \
        acc[ai][bj][m][n] = __builtin_amdgcn_mfma_f32_16x16x32_bf16(Bt[n][k], At[m][k], acc[ai][bj][m][n], 0, 0, 0); __builtin_amdgcn_s_setprio(0); } while (0)
#define PG8_WAIT_V(n) asm volatile("s_waitcnt vmcnt(" #n ")" ::: "memory")
#define PG8_WAIT_L(n) asm volatile("s_waitcnt lgkmcnt(" #n ")" ::: "memory")
#define PG8_BAR __builtin_amdgcn_s_barrier()
#define PG8_SCHED __builtin_amdgcn_sched_barrier(0)
    Unit cur, nxt; int ui = 0;
    if (!S.next(0, cur)) return;
    f32x4 acc[2][2][4][2];
#pragma unroll
    for (int a = 0; a < 2; ++a)
#pragma unroll
        for (int b = 0; b < 2; ++b)
#pragma unroll
            for (int m = 0; m < 4; ++m)
#pragma unroll
                for (int n = 0; n < 2; ++n) acc[a][b][m][n] = (f32x4){0.f, 0.f, 0.f, 0.f};
    bf16x8 At[4][2], B0[2][2], B1[2][2];
    const char* cA = G.a_base(cur); const char* cB = G.b_base(cur);
    PG8_VOFF(vAc, cur);
    PG8_STB(PG8_SB(0, 0), cB, 0); PG8_STA(PG8_SA(0, 0), cA, 0, vAc); PG8_STB(PG8_SB(0, 1), cB, 1); PG8_STA(PG8_SA(0, 1), cA, 1, vAc);
    if (wr == 1) PG8_BAR;
    PG8_WAIT_V(4); PG8_BAR;
    PG8_STB(PG8_SB(1, 0), cB + kstep, 0); PG8_STA(PG8_SA(1, 0), cA + kstep, 0, vAc); PG8_STB(PG8_SB(1, 1), cB + kstep, 1);
    PG8_WAIT_V(6); PG8_BAR;
    for (;;) {
        const bool has_next = S.next(ui + 1, nxt);
        const char* nA = has_next ? G.a_base(nxt) : cA; const char* nB = has_next ? G.b_base(nxt) : cB;
        if constexpr (Geom::GATHER) { if (has_next) PG8_VOFF(vAn, nxt); else {
#pragma unroll
            for (int h = 0; h < 2; ++h) { vAn[h][0] = vAc[h][0]; vAn[h][1] = vAc[h][1]; } } }
        for (int t = 0; t < nt; t += 2) {
            const bool last = (t == nt - 2);
            const char* a1 = cA + (size_t)(t + 1) * kstep;
            const char* a2 = last ? nA : cA + (size_t)(t + 2) * kstep; const char* b2 = last ? nB : cB + (size_t)(t + 2) * kstep;
            const char* a3 = a2 + kstep; const char* b3 = b2 + kstep;
            unsigned v2[2][2];
#pragma unroll
            for (int h = 0; h < 2; ++h) { v2[h][0] = (Geom::GATHER && last) ? vAn[h][0] : vAc[h][0]; v2[h][1] = (Geom::GATHER && last) ? vAn[h][1] : vAc[h][1]; }
            PG8_LDB(B0, 0, 0); PG8_SCHED; PG8_LDA(At, 0, 0); PG8_STA(PG8_SA(1, 1), a1, 1, vAc);
            PG8_WAIT_L(8); PG8_BAR; PG8_WAIT_L(0); PG8_MMA(0, 0, At, B0); PG8_BAR; PG8_SCHED;
            PG8_LDB(B1, 0, 1); PG8_STB(PG8_SB(0, 0), b2, 0);
            PG8_BAR; PG8_WAIT_L(0); PG8_MMA(0, 1, At, B1); PG8_BAR;
            PG8_LDA(At, 0, 1); PG8_STA(PG8_SA(0, 0), a2, 0, v2);
            PG8_BAR; PG8_WAIT_L(0); PG8_MMA(1, 0, At, B0); PG8_BAR; PG8_SCHED;
            PG8_STB(PG8_SB(0, 1), b2, 1);
            PG8_WAIT_V(6); PG8_BAR; PG8_MMA(1, 1, At, B1); PG8_BAR;
            PG8_LDB(B0, 1, 0); PG8_SCHED; PG8_LDA(At, 1, 0); PG8_STA(PG8_SA(0, 1), a2, 1, v2);
            PG8_WAIT_L(8); PG8_BAR; PG8_WAIT_L(0); PG8_MMA(0, 0, At, B0); PG8_BAR; PG8_SCHED;
            PG8_LDB(B1, 1, 1); PG8_STB(PG8_SB(1, 0), b3, 0);
            PG8_BAR; PG8_WAIT_L(0); PG8_MMA(0, 1, At, B1); PG8_BAR;
            PG8_LDA(At, 1, 1); PG8_STA(PG8_SA(1, 0), a3, 0, v2);
            PG8_BAR; PG8_WAIT_L(0); PG8_MMA(1, 0, At, B0); PG8_BAR; PG8_SCHED;
            PG8_STB(PG8_SB(1, 1), b3, 1);
            PG8_WAIT_V(6); PG8_BAR; PG8_MMA(1, 1, At, B1); PG8_BAR;
        }
        E(acc, cur, G.row0(cur), wr, wc, fr, fq);
        if (!has_next) break;
#pragma unroll
        for (int a = 0; a < 2; ++a)
#pragma unroll
            for (int b = 0; b < 2; ++b)
#pragma unroll
                for (int m = 0; m < 4; ++m)
#pragma unroll
                    for (int n = 0; n < 2; ++n) acc[a][b][m][n] = (f32x4){0.f, 0.f, 0.f, 0.f};
        cur = nxt; cA = nA; cB = nB; ++ui;
#pragma unroll
        for (int h = 0; h < 2; ++h) { vAc[h][0] = vAn[h][0]; vAc[h][1] = vAn[h][1]; }
    }
    PG8_WAIT_V(0);
    if (wr == 0) PG8_BAR;
    PG8_BAR;
#undef PG8_VOFF
#undef PG8_SA
#undef PG8_SB
#undef PG8_STAGE
#undef PG8_STA
#undef PG8_STB
#undef PG8_LDA
#undef PG8_LDB
#undef PG8_MMA
#undef PG8_WAIT_V
#undef PG8_WAIT_L
#undef PG8_BAR
#undef PG8_SCHED
}

struct EpiBf16Plain {
    static constexpr bool PERM = true;
    bf16_t* O; int ldc; int coloff;
    __device__ __forceinline__ void operator()(const f32x4 (&acc)[2][2][4][2], const Unit& u, int row0, int wr, int wc, int fr, int fq) const {
        const int r0 = row0 + wr * 64 + fr, col0 = coloff + u.pn * BM + wc * 32 + 8 * fq;
#pragma unroll
        for (int ai = 0; ai < 2; ++ai)
#pragma unroll
            for (int m = 0; m < 4; ++m) { bf16_t* rowp = O + (size_t)(r0 + ai * HALF + m * 16) * ldc + col0;
#pragma unroll
                for (int bj = 0; bj < 2; ++bj) { const f32x4 v0 = acc[ai][bj][m][0], v1 = acc[ai][bj][m][1];
                    u32x4 w; w.x = cvt_pk_bf16(v0[0], v0[1]); w.y = cvt_pk_bf16(v0[2], v0[3]); w.z = cvt_pk_bf16(v1[0], v1[1]); w.w = cvt_pk_bf16(v1[2], v1[3]);
                    *(u32x4*)(rowp + bj * HALF) = w; } }
    }
};
struct EpiInRest {
    static constexpr bool PERM = true;
    unsigned char* ws;
    __device__ __forceinline__ void operator()(const f32x4 (&acc)[2][2][4][2], const Unit& u, int row0, int wr, int wc, int fr, int fq) const {
        const int gcol = OFF_WAQ + u.pn * BM;
        bf16_t* base; int ldc, c0; bool sg = false;
        if (gcol < OFF_WAKV) { base = (bf16_t*)(ws + WS_QWA); ldc = 1024; c0 = gcol - OFF_WAQ; }
        else if (gcol < OFF_NAQ) { base = (bf16_t*)(ws + WS_KVWA); ldc = 512; c0 = gcol - OFF_WAKV; }
        else if (gcol < OFF_NAKV) { base = (bf16_t*)(ws + WS_QNA); ldc = 1024; c0 = gcol - OFF_NAQ; }
        else if (gcol < OFF_GATE) { base = (bf16_t*)(ws + WS_KVNA); ldc = 2048; c0 = gcol - OFF_NAKV; }
        else { base = (bf16_t*)(ws + WS_GATE); ldc = 6144; c0 = gcol - OFF_GATE; sg = true; }
        const int r0 = row0 + wr * 64 + fr, col0 = c0 + wc * 32 + 8 * fq;
#pragma unroll
        for (int ai = 0; ai < 2; ++ai)
#pragma unroll
            for (int m = 0; m < 4; ++m) { bf16_t* rowp = base + (size_t)(r0 + ai * HALF + m * 16) * ldc + col0;
#pragma unroll
                for (int bj = 0; bj < 2; ++bj) { f32x4 v0 = acc[ai][bj][m][0], v1 = acc[ai][bj][m][1];
                    if (sg) {
#pragma unroll
                        for (int j = 0; j < 4; ++j) { v0[j] = sigmoid_f(v0[j]); v1[j] = sigmoid_f(v1[j]); } }
                    u32x4 w; w.x = cvt_pk_bf16(v0[0], v0[1]); w.y = cvt_pk_bf16(v0[2], v0[3]); w.z = cvt_pk_bf16(v1[0], v1[1]); w.w = cvt_pk_bf16(v1[2], v1[3]);
                    *(u32x4*)(rowp + bj * HALF) = w; } }
    }
};
template <int BR> struct EpiMergeF {
    static constexpr bool PERM = false;
    unsigned char* ws;
    __device__ __forceinline__ void operator()(const f32x4 (&acc)[2][2][4][2], const Unit& u, int row0, int wr, int wc, int fr, int fq) const {
        const int r0 = row0 + wr * 64 + fr, col0 = u.pn * BM + wc * 32 + 4 * fq;
#pragma unroll
        for (int ai = 0; ai < 2; ++ai)
#pragma unroll
            for (int m = 0; m < 4; ++m) { const size_t row = (size_t)(r0 + ai * HALF + m * 16);
                const bf16_t* gp = (const bf16_t*)(ws + WS_GATE) + row * 6144 + BR * 2048 + col0;
                float* mp = (float*)(ws + WS_MPART) + row * D + col0; bf16_t* ob = (bf16_t*)(ws + WS_MB) + row * D + col0;
#pragma unroll
                for (int bj = 0; bj < 2; ++bj)
#pragma unroll
                    for (int n = 0; n < 2; ++n) { const int co = bj * HALF + n * 16;
                        const u32x2 gg = *(const u32x2*)(gp + co);
                        const f32x4 g = {__uint_as_float(gg.x << 16), __uint_as_float(gg.x & 0xffff0000u), __uint_as_float(gg.y << 16), __uint_as_float(gg.y & 0xffff0000u)};
                        f32x4 t = g * acc[ai][bj][m][n];
                        if (BR > 0) t += *(const f32x4*)(mp + co);
                        if (BR < 2) *(f32x4*)(mp + co) = t;
                        else { u32x2 w; w.x = cvt_pk_bf16(t[0], t[1]); w.y = cvt_pk_bf16(t[2], t[3]); *(u32x2*)(ob + co) = w; } } }
    }
};
struct EpiOutF {
    static constexpr bool PERM = false;
    const Ctx* c; int layer;
    __device__ __forceinline__ void operator()(const f32x4 (&acc)[2][2][4][2], const Unit& u, int row0, int wr, int wc, int fr, int fq) const {
        const int r0 = row0 + wr * 64 + fr, col0 = u.pn * BM + wc * 32 + 4 * fq;
#pragma unroll
        for (int ai = 0; ai < 2; ++ai)
#pragma unroll
            for (int m = 0; m < 4; ++m) { const int row = r0 + ai * HALF + m * 16;
                const float* xin = c->xrow(layer, row) + col0; const float* g = c->mod(layer, row < L ? 0 : 1, 2) + col0;
                float* o = (float*)(c->ws + WS_XA) + (size_t)row * D + col0;
#pragma unroll
                for (int bj = 0; bj < 2; ++bj)
#pragma unroll
                    for (int n = 0; n < 2; ++n) { const int co = bj * HALF + n * 16;
                        *(f32x4*)(o + co) = *(const f32x4*)(xin + co) + *(const f32x4*)(g + co) * acc[ai][bj][m][n]; } }
    }
};
struct EpiGU {
    static constexpr bool PERM = false;
    bf16_t* act;
    __device__ __forceinline__ void operator()(const f32x4 (&acc)[2][2][4][2], const Unit& u, int row0, int wr, int wc, int fr, int fq) const {
        const int r0 = row0 + wr * 64 + fr, f0 = u.pn * 128 + wc * 16 + 4 * fq;
#pragma unroll
        for (int ai = 0; ai < 2; ++ai)
#pragma unroll
            for (int m = 0; m < 4; ++m) { bf16_t* rowp = act + (size_t)(r0 + ai * HALF + m * 16) * DF + f0;
#pragma unroll
                for (int bj = 0; bj < 2; ++bj) { const f32x4 a = acc[ai][bj][m][0], uu = acc[ai][bj][m][1]; f32x4 t;
#pragma unroll
                    for (int j = 0; j < 4; ++j) t[j] = silu_f(a[j]) * uu[j];
                    u32x2 w; w.x = cvt_pk_bf16(t[0], t[1]); w.y = cvt_pk_bf16(t[2], t[3]); *(u32x2*)(rowp + bj * 64) = w; } }
    }
};
}

struct ConvDesc { const float* W; bf16_t* WT; int K, N, k0, n0, gu, off; };
__device__ __forceinline__ ConvDesc conv_desc(const Ctx& c, int layer, int it) {
    constexpr int I_IN = (D / 64) * (NIN / 256), I_BR = (1024 / 64) * (D / 256), I_OUT = (D / 64) * (D / 256), I_G = (D / 64) * (DF / 256), I_DN = (DF / 64) * (D / 256);
    ConvDesc d; int r = it; d.gu = 0; d.off = 0;
    if (r < I_IN) { d.W = c.in[7] + (size_t)layer * D * NIN; d.WT = c.wsp<bf16_t>(WS_WIN); d.K = D; d.N = NIN; }
    else if ((r -= I_IN) < 3 * I_BR) { const int b = r / I_BR; r -= b * I_BR; d.W = c.in[24] + ((size_t)layer * 3 + b) * 1024 * D; d.WT = c.wsp<bf16_t>(WS_WBR) + (size_t)b * D * 1024; d.K = 1024; d.N = D; }
    else if ((r -= 3 * I_BR) < I_OUT) { d.W = c.in[25] + (size_t)layer * D * D; d.WT = c.wsp<bf16_t>(WS_WOUT); d.K = D; d.N = D; }
    else { r -= I_OUT; const int e = r / (2 * I_G + I_DN); r -= e * (2 * I_G + I_DN);
        if (r < I_G) { d.W = c.in[28] + ((size_t)layer * NE + e) * D * DF; d.WT = c.wsp<bf16_t>(WS_WGU); d.K = D; d.N = DF; d.gu = 1; d.off = e * 2048; }
        else if ((r -= I_G) < I_G) { d.W = c.in[29] + ((size_t)layer * NE + e) * D * DF; d.WT = c.wsp<bf16_t>(WS_WGU); d.K = D; d.N = DF; d.gu = 1; d.off = e * 2048 + 16; }
        else { r -= I_G; d.W = c.in[30] + ((size_t)layer * NE + e) * DF * D; d.WT = c.wsp<bf16_t>(WS_WDN) + (size_t)e * D * DF; d.K = DF; d.N = D; } }
    const int nblk = d.N / 256; d.k0 = 64 * (r / nblk); d.n0 = 256 * (r % nblk);
    return d;
}
__device__ __forceinline__ void ph_conv(const Ctx& c, int layer) {
    constexpr int I_IN = (D / 64) * (NIN / 256), I_BR = (1024 / 64) * (D / 256), I_OUT = (D / 64) * (D / 256), I_G = (D / 64) * (DF / 256), I_DN = (DF / 64) * (D / 256);
    constexpr int NITEMS = I_IN + 3 * I_BR + I_OUT + NE * (2 * I_G + I_DN);
    __syncthreads();
    float* tile = (float*)c.smem;
    const int tid = c.tid;
    float4 rg[8];
    int it = c.bid; bool have = it < NITEMS; ConvDesc d;
    if (have) { d = conv_desc(c, layer, it);
#pragma unroll
        for (int q = 0; q < 8; ++q) { const int e = tid + 512 * q, row = e >> 6, c4 = e & 63; rg[q] = *(const float4*)(d.W + (size_t)(d.k0 + row) * d.N + d.n0 + 4 * c4); } }
    while (have) {
#pragma unroll
        for (int q = 0; q < 8; ++q) { const int e = tid + 512 * q, row = e >> 6, c4 = e & 63; float* tp = tile + row * 257 + 4 * c4; tp[0] = rg[q].x; tp[1] = rg[q].y; tp[2] = rg[q].z; tp[3] = rg[q].w; }
        __syncthreads();
        const ConvDesc cur = d;
        it += c.nb; have = it < NITEMS;
        if (have) { d = conv_desc(c, layer, it);
#pragma unroll
            for (int q = 0; q < 8; ++q) { const int e = tid + 512 * q, row = e >> 6, c4 = e & 63; rg[q] = *(const float4*)(d.W + (size_t)(d.k0 + row) * d.N + d.n0 + 4 * c4); } }
#pragma unroll
        for (int j = 0; j < 4; ++j) { const int p = tid + 512 * j, nn = p >> 3, kc = p & 7; const float* sp = tile + (8 * kc) * 257 + nn;
            uint4 o; o.x = pk2(sp[0 * 257], sp[1 * 257]); o.y = pk2(sp[2 * 257], sp[3 * 257]); o.z = pk2(sp[4 * 257], sp[5 * 257]); o.w = pk2(sp[6 * 257], sp[7 * 257]);
            const int f = cur.n0 + nn; const int orow = cur.gu ? cur.off + 32 * (f >> 4) + (f & 15) : f;
            *(uint4*)(cur.WT + (size_t)orow * cur.K + cur.k0 + 8 * kc) = o; }
        __syncthreads();
    }
}

struct EpiTaps {
    static constexpr bool PERM = true;
    bf16_t* KF; bf16_t* KFC; const float* dec;
    __device__ __forceinline__ void operator()(const pg8::f32x4 (&acc)[2][2][4][2], const pg8::Unit& u, int row0, int wr, int wc, int fr, int fq) const {
        const bool isc = u.pn == L / 256;
        const int ch0 = row0 + wr * 64 + fr, pos0 = (isc ? 0 : u.pn * 256) + wc * 32 + 8 * fq;
        const float inv = isc ? 1.0f / (float)(LC - 1) : 1.0f / (float)(L - 1);
        bf16_t* base = isc ? KFC : KF; const int ld = isc ? LC : L;
#pragma unroll
        for (int ai = 0; ai < 2; ++ai)
#pragma unroll
            for (int m = 0; m < 4; ++m) { const int ch = ch0 + ai * 128 + m * 16; const float rate = fabsf(dec[ch]); bf16_t* rowp = base + (size_t)ch * ld + pos0;
#pragma unroll
                for (int bj = 0; bj < 2; ++bj) { float t[8];
#pragma unroll
                    for (int j = 0; j < 8; ++j) { const float tt = (float)(pos0 + bj * 128 + j) * inv; const float a = j < 4 ? acc[ai][bj][m][0][j] : acc[ai][bj][m][1][j - 4]; t[j] = a * (__expf(-tt * rate) + 0.05f); }
                    pg8::u32x4 w; w.x = pg8::cvt_pk_bf16(t[0], t[1]); w.y = pg8::cvt_pk_bf16(t[2], t[3]); w.z = pg8::cvt_pk_bf16(t[4], t[5]); w.w = pg8::cvt_pk_bf16(t[6], t[7]);
                    *(pg8::u32x4*)(rowp + bj * 128) = w; } }
    }
};
__device__ __forceinline__ void ph_taps(const Ctx& c, int layer) {
    LAS unsigned char* lds = (LAS unsigned char*)c.smem;
    __syncthreads();
    const pg8::GeomLin G{(const char*)(c.wsp<bf16_t>(WS_FW3T) + (size_t)layer * 4096 * 256), (const char*)(c.wsp<bf16_t>(WS_H2B) + (size_t)layer * MR * 256), 256, 256, 256, nullptr};
    pg8::StaticOrder S; S.init(4096 / 256, MR / 256, c.nb, c.bid);
    const EpiTaps E{c.wsp<bf16_t>(WS_KF), c.wsp<bf16_t>(WS_KFC), c.in[16] + (size_t)layer * 4096};
    pg8::gemm_phase(lds, G, S, E);
}

__device__ __forceinline__ void ph_g0(const Ctx& c) {
    float* lds = (float*)c.smem;
    {
        float* PART = c.wsp<float>(WS_MODPART);
        for (int u = c.bid; u < 2 * 128; u += c.nb) {
            const int layer = u >> 7, slab = u & 127, k0 = slab * 16;
            __syncthreads();
            if (c.tid < 32) { const int k = k0 + (c.tid & 15); lds[c.tid] = silu_f(c.tid < 16 ? c.in[1][k] : c.in[3][k]); }
            __syncthreads();
            const float4* w = (const float4*)(c.in[4] + ((size_t)layer * D + k0) * NMOD);
            float4 ac[6], ax[6];
#pragma unroll
            for (int q = 0; q < 6; ++q) { ac[q] = make_float4(0.f, 0.f, 0.f, 0.f); ax[q] = make_float4(0.f, 0.f, 0.f, 0.f); }
#pragma unroll 4
            for (int r = 0; r < 16; ++r) {
                const float sc = lds[r], sx = lds[16 + r];
#pragma unroll
                for (int q = 0; q < 6; ++q) { const float4 v = w[(size_t)r * (NMOD / 4) + c.tid + 512 * q];
                    ac[q].x = fmaf(sc, v.x, ac[q].x); ac[q].y = fmaf(sc, v.y, ac[q].y); ac[q].z = fmaf(sc, v.z, ac[q].z); ac[q].w = fmaf(sc, v.w, ac[q].w);
                    ax[q].x = fmaf(sx, v.x, ax[q].x); ax[q].y = fmaf(sx, v.y, ax[q].y); ax[q].z = fmaf(sx, v.z, ax[q].z); ax[q].w = fmaf(sx, v.w, ax[q].w); }
            }
            float4* pc = (float4*)(PART + ((size_t)(layer * 128 + slab) * 2 + 0) * NMOD), *px = (float4*)(PART + ((size_t)(layer * 128 + slab) * 2 + 1) * NMOD);
#pragma unroll
            for (int q = 0; q < 6; ++q) { pc[c.tid + 512 * q] = ac[q]; px[c.tid + 512 * q] = ax[q]; }
        }
    }
    for (size_t e = (size_t)c.bid * NTHREADS + c.tid; e < (size_t)2 * 4096 * 256; e += (size_t)c.nb * NTHREADS) {
        const int k = (int)(e & 255), col = (int)((e >> 8) & 4095), layer = (int)(e >> 20);
        c.wsp<bf16_t>(WS_FW3T)[e] = k < 64 ? f2bf(c.in[14][((size_t)layer * 64 + k) * 4096 + col]) : (bf16_t)0;
    }
    const int gw = c.bid * 8 + c.wave, ngw = c.nb * 8;
    for (int task = gw; task < 2 * MR; task += ngw) {
        const int layer = task / MR, pos = task % MR;
        const bool isc = pos >= L; const int i = isc ? pos - L : pos; const int Lx = isc ? LC : L;
        const float tt = (float)i * (1.0f / (float)(Lx - 1));
        const float c0 = (float)(2.0 * 3.14159265358979323846 / (double)Lx);
        const int j = c.lane;
        float feat = 0.f;
        if (j == 0) feat = tt;
        else if (j < 33) { const int b = (j - 1) & 15; const float band = 1e-4f + (float)b * ((15.0f - 1e-4f) / 15.0f); const float ang = (c0 * band) * (float)i; feat = (j <= 16) ? cosf(ang) : -sinf(ang); }
        const float* fw1 = c.in[10] + (size_t)layer * 33 * 64; const float* fb1 = c.in[11] + layer * 64;
        const float* fw2 = c.in[12] + (size_t)layer * 64 * 64; const float* fb2 = c.in[13] + layer * 64;
        const float* fr = c.in[15] + layer * 128;
        float s = fb1[j];
        for (int f = 0; f < 33; ++f) s = fmaf(__shfl(feat, f), fw1[f * 64 + j], s);
        const float h1 = sinf(fr[j] * s);
        float s2 = fb2[j];
        for (int m = 0; m < 64; ++m) s2 = fmaf(__shfl(h1, m), fw2[m * 64 + j], s2);
        const float h2 = sinf(fr[64 + j] * s2);
        bf16_t* hb = c.wsp<bf16_t>(WS_H2B) + ((size_t)layer * MR + pos) * 256;
        hb[j] = f2bf(h2); hb[64 + j] = 0; hb[128 + j] = 0; hb[192 + j] = 0;
    }
}

__device__ __forceinline__ void ph_g0b(const Ctx& c) {
    const float* PART = c.wsp<float>(WS_MODPART);
    for (int i = c.bid * NTHREADS + c.tid; i < 2 * 2 * (NMOD / 4); i += c.nb * NTHREADS) {
        const int n4 = i % (NMOD / 4), ls = i / (NMOD / 4), layer = ls >> 1, src = ls & 1;
        float4 a = *(const float4*)(c.in[5] + (size_t)layer * NMOD + 4 * n4);
#pragma unroll 8
        for (int sl = 0; sl < 128; ++sl) { const float4 v = *(const float4*)(PART + ((size_t)(layer * 128 + sl) * 2 + src) * NMOD + 4 * n4); a.x += v.x; a.y += v.y; a.z += v.z; a.w += v.w; }
        *(float4*)(c.wsp<float>(WS_MOD) + (size_t)(layer * 2 + src) * NMOD + 4 * n4) = a;
    }
}

__device__ __forceinline__ void ph_a(const Ctx& c, int layer) {
    const int gw = c.bid * 8 + c.wave, ngw = c.nb * 8;
    const float* g = c.in[6] + (size_t)layer * D;
    for (int r = gw; r < MR; r += ngw) {
        const float* x = c.xrow(layer, r);
        const int src = r < L ? 0 : 1;
        const float* sh = c.mod(layer, src, 0); const float* sc = c.mod(layer, src, 1);
        float4 v[8]; float ss = 0.f;
#pragma unroll
        for (int j = 0; j < 8; ++j) { v[j] = *(const float4*)(x + 4 * c.lane + 256 * j); ss += v[j].x * v[j].x + v[j].y * v[j].y + v[j].z * v[j].z + v[j].w * v[j].w; }
        ss = wave_sum(ss);
        const float inv = rsqrtf(ss * (1.0f / D) + RMS_EPS);
        bf16_t* o = c.wsp<bf16_t>(WS_HX) + (size_t)r * D;
#pragma unroll
        for (int j = 0; j < 8; ++j) {
            const int col = 4 * c.lane + 256 * j;
            const float4 gg = *(const float4*)(g + col), s4 = *(const float4*)(sh + col), c4 = *(const float4*)(sc + col);
            const float y0 = v[j].x * inv * gg.x * (1.f + c4.x) + s4.x, y1 = v[j].y * inv * gg.y * (1.f + c4.y) + s4.y;
            const float y2 = v[j].z * inv * gg.z * (1.f + c4.z) + s4.z, y3 = v[j].w * inv * gg.w * (1.f + c4.w) + s4.w;
            uint2 w; w.x = pk2(y0, y1); w.y = pk2(y2, y3);
            *(uint2*)(o + col) = w;
        }
    }
}

struct EpiIn {
    unsigned char* ws;
    __device__ __forceinline__ void operator()(int row, int col, const float (&v)[8]) const {
        if (col < OFF_WAQ) {
            bf16_t* d = (bf16_t*)(ws + WS_ZHYT);
#pragma unroll
            for (int j = 0; j < 8; ++j) d[(size_t)(col + j) * MR + row] = f2bf(v[j]);
            return;
        }
        bf16_t* dst; float t[8];
#pragma unroll
        for (int j = 0; j < 8; ++j) t[j] = v[j];
        if (col < OFF_WAKV) dst = (bf16_t*)(ws + WS_QWA) + (size_t)row * 1024 + (col - OFF_WAQ);
        else if (col < OFF_NAQ) dst = (bf16_t*)(ws + WS_KVWA) + (size_t)row * 512 + (col - OFF_WAKV);
        else if (col < OFF_NAKV) dst = (bf16_t*)(ws + WS_QNA) + (size_t)row * 1024 + (col - OFF_NAQ);
        else if (col < OFF_GATE) dst = (bf16_t*)(ws + WS_KVNA) + (size_t)row * 2048 + (col - OFF_NAKV);
        else { dst = (bf16_t*)(ws + WS_GATE) + (size_t)row * 6144 + (col - OFF_GATE);
#pragma unroll
            for (int j = 0; j < 8; ++j) t[j] = sigmoid_f(t[j]); }
        uint4 o; o.x = pk2(t[0], t[1]); o.y = pk2(t[2], t[3]); o.z = pk2(t[4], t[5]); o.w = pk2(t[6], t[7]);
        *(uint4*)dst = o;
    }
};
__device__ __forceinline__ void ph_b(const Ctx& c, int layer) {
    const RowLin rp{c.wsp<bf16_t>(WS_HX), D};
    const EpiIn ep{c.ws};
    const float* W = c.in[7] + (size_t)layer * D * NIN;
    const int nM = MR / 128, nN = NIN / 128;
    for (int u = c.bid; u < nM * nN; u += c.nb) {
        const int pm = u % nM, pn = u / nM;
        sgemm_unit(rp, W, NIN, D, pm * 128, pn * 128, ep, (float*)c.smem, c.tid);
    }
}

__device__ __forceinline__ void b2_segment(bf16_t* p, const float* gain, bool rope, int r, int lane, bool active) {
    uint4 w = make_uint4(0u, 0u, 0u, 0u);
    if (active) w = *(const uint4*)(p + 8 * lane);
    float x[8] = {__uint_as_float(w.x << 16), __uint_as_float(w.x & 0xffff0000u), __uint_as_float(w.y << 16), __uint_as_float(w.y & 0xffff0000u),
                  __uint_as_float(w.z << 16), __uint_as_float(w.z & 0xffff0000u), __uint_as_float(w.w << 16), __uint_as_float(w.w & 0xffff0000u)};
    float ss = 0.f;
#pragma unroll
    for (int i = 0; i < 8; ++i) ss += x[i] * x[i];
    ss += __shfl_xor(ss, 1); ss += __shfl_xor(ss, 2); ss += __shfl_xor(ss, 4); ss += __shfl_xor(ss, 8);
    const float inv = rsqrtf(ss * (1.0f / 128.0f) + RMS_EPS);
    const int d0 = (lane & 15) * 8;
    const float4 g0 = *(const float4*)(gain + d0), g1 = *(const float4*)(gain + d0 + 4);
    const float gg[8] = {g0.x, g0.y, g0.z, g0.w, g1.x, g1.y, g1.z, g1.w};
#pragma unroll
    for (int i = 0; i < 8; ++i) x[i] = x[i] * inv * gg[i];
    if (rope) {
        const int axis = d0 >> 6, half = (d0 >> 5) & 1, f0 = d0 & 31;
        const float pos = axis == 0 ? (float)(r / GRIDW) : (float)(r % GRIDW);
#pragma unroll
        for (int i = 0; i < 8; ++i) {
            const float other = __shfl_xor(x[i], 4);
            const float ang = pos * powf(10000.0f, -(float)(f0 + i) / 32.0f);
            float sn, cs; sincosf(ang, &sn, &cs);
            x[i] = half == 0 ? x[i] * cs - other * sn : x[i] * cs + other * sn;
        }
    }
    if (active) { uint4 o; o.x = pk2(x[0], x[1]); o.y = pk2(x[2], x[3]); o.z = pk2(x[4], x[5]); o.w = pk2(x[6], x[7]); *(uint4*)(p + 8 * lane) = o; }
}
__device__ __forceinline__ void ph_b2(const Ctx& c, int layer) {
    const int gw = c.bid * 8 + c.wave, ngw = c.nb * 8;
    const int lane = c.lane;
    for (int r = gw; r < MR; r += ngw) {
        const bool lat = r < L;
        b2_segment(c.wsp<bf16_t>(WS_QWA) + (size_t)r * 1024, c.in[18] + layer * 128, lat, r, lane, true);
        b2_segment(c.wsp<bf16_t>(WS_QWA) + (size_t)r * 1024 + 512, c.in[18] + layer * 128, lat, r, lane, true);
        b2_segment(c.wsp<bf16_t>(WS_KVWA) + (size_t)r * 512, c.in[19] + layer * 128, lat, r, lane, lane < 32);
        b2_segment(c.wsp<bf16_t>(WS_QNA) + (size_t)r * 1024, c.in[21] + layer * 128, false, r, lane, true);
        b2_segment(c.wsp<bf16_t>(WS_QNA) + (size_t)r * 1024 + 512, c.in[21] + layer * 128, false, r, lane, true);
        b2_segment(c.wsp<bf16_t>(WS_KVNA) + (size_t)r * 2048, c.in[22] + layer * 128, false, r, lane, true);
        b2_segment(c.wsp<bf16_t>(WS_KVNA) + (size_t)r * 2048 + 512, c.in[22] + layer * 128, false, r, lane, true);
    }
}

__device__ __forceinline__ float shortconv_at(const bf16_t* z, int t, int Lx, float w0, float w1, float w2, float b) {
    const float zm = t > 0 ? bf2f(z[t - 1]) : 0.f, z0 = bf2f(z[t]), zp = t + 1 < Lx ? bf2f(z[t + 1]) : 0.f;
    return zm * w0 + z0 * w1 + zp * w2 + b;
}
__device__ __forceinline__ float block_sum(float v, float* red, int tid) {
    v = wave_sum(v);
    __syncthreads();
    if ((tid & 63) == 0) red[tid >> 6] = v;
    __syncthreads();
    float t = 0.f;
#pragma unroll
    for (int w = 0; w < 8; ++w) t += red[w];
    return t;
}
__device__ __forceinline__ void hyena_direct_unit(const Ctx& c, int layer, int ch) {
    bf16_t* kc = (bf16_t*)c.smem;
    float* cv = (float*)c.smem;
    float* us = (float*)(c.smem + 4 * L);
    float* red = us + L;
    const int tid = c.tid;
    const float* cw = c.in[8] + (size_t)layer * 3 * 3072; const float* cb = c.in[9] + (size_t)layer * 3072;
    const bf16_t* zv = c.wsp<bf16_t>(WS_ZHYT) + (size_t)ch * MR;
    const bf16_t* z1 = c.wsp<bf16_t>(WS_ZHYT) + (size_t)(1024 + ch) * MR;
    const bf16_t* z2 = c.wsp<bf16_t>(WS_ZHYT) + (size_t)(2048 + ch) * MR;
    const bf16_t* KF = c.wsp<bf16_t>(WS_KF);
    __syncthreads();
    { const float w0 = cw[ch], w1 = cw[3072 + ch], w2 = cw[6144 + ch], b = cb[ch];
#pragma unroll 2
      for (int t = tid; t < L; t += NTHREADS) us[t] = shortconv_at(zv, t, L, w0, w1, w2, b); }
    for (int o = 0; o < 2; ++o) {
        const bf16_t* hf = KF + (size_t)(o * 1024 + ch) * L;
        const bf16_t* hb = KF + (size_t)(2048 + o * 1024 + ch) * L;
        float sabs = 0.f;
#pragma unroll 2
        for (int t = tid; t < L; t += NTHREADS) {
            bf16_t kf = hf[t], kb = hb[t];
            if (t == 0) { kf = f2bf(bf2f(kf) + bf2f(kb)); kb = 0; }
            kc[L + t] = kf; kc[L - t] = (t == 0) ? kf : kb;
            sabs += fabsf(bf2f(kf)) + fabsf(bf2f(kb));
        }
        if (tid == 0) kc[0] = 0;
        const float S = block_sum(sabs, red, tid);
        {
            float acc[32];
#pragma unroll
            for (int j = 0; j < 32; ++j) acc[j] = 0.f;
#pragma unroll 2
            for (int s = 0; s < L; ++s) {
                const float uv = us[s];
                const bf16_t* kp = kc + (L + tid - s);
#pragma unroll
                for (int j = 0; j < 32; ++j) acc[j] = fmaf(uv, bf2f(kp[512 * j]), acc[j]);
            }
            __syncthreads();
#pragma unroll
            for (int j = 0; j < 32; ++j) cv[tid + 512 * j] = acc[j];
        }
        LDS_FENCE();
        const float invS = 1.0f / S;
        const float dsk = c.in[17][(size_t)layer * 2048 + o * 1024 + ch];
        const int co = o == 0 ? 1024 : 2048;
        const bf16_t* zz = o == 0 ? z1 : z2;
        const float w0 = cw[co + ch], w1 = cw[3072 + co + ch], w2 = cw[6144 + co + ch], b = cb[co + ch];
        bf16_t* dst = c.wsp<bf16_t>(WS_YHYT) + (size_t)ch * L;
#pragma unroll 2
        for (int t = tid; t < L; t += NTHREADS) {
            const float r = shortconv_at(zz, t, L, w0, w1, w2, b) * (cv[t] * invS + us[t] * dsk);
            if (o == 0) us[t] = r; else dst[t] = f2bf(r);
        }
        __syncthreads();
    }
}
__device__ __forceinline__ void hyena_ctx_unit(const Ctx& c, int layer, int ch) {
    float* kc = (float*)c.smem;
    float* us = kc + 512;
    float* red = us + 256;
    const int tid = c.tid;
    const float* cw = c.in[8] + (size_t)layer * 3 * 3072; const float* cb = c.in[9] + (size_t)layer * 3072;
    const bf16_t* zv = c.wsp<bf16_t>(WS_ZHYT) + (size_t)ch * MR + L;
    const bf16_t* z1 = c.wsp<bf16_t>(WS_ZHYT) + (size_t)(1024 + ch) * MR + L;
    const bf16_t* z2 = c.wsp<bf16_t>(WS_ZHYT) + (size_t)(2048 + ch) * MR + L;
    const bf16_t* KF = c.wsp<bf16_t>(WS_KFC);
    __syncthreads();
    if (tid < LC) us[tid] = shortconv_at(zv, tid, LC, cw[ch], cw[3072 + ch], cw[6144 + ch], cb[ch]);
    for (int o = 0; o < 2; ++o) {
        const bf16_t* hf = KF + (size_t)(o * 1024 + ch) * LC;
        const bf16_t* hb = KF + (size_t)(2048 + o * 1024 + ch) * LC;
        float sabs = 0.f;
        {
            const int lag = tid - 256; float k;
            if (lag == 0) k = bf2f(hf[0]) + bf2f(hb[0]); else if (lag > 0) k = bf2f(hf[lag]); else if (lag > -256) k = bf2f(hb[-lag]); else k = 0.f;
            kc[tid] = k; sabs = fabsf(k);
        }
        const float S = block_sum(sabs, red, tid);
        float acc = 0.f;
        if (tid < LC) for (int s = 0; s < LC; ++s) acc = fmaf(us[s], kc[256 + tid - s], acc);
        const float dsk = c.in[17][(size_t)layer * 2048 + o * 1024 + ch];
        float res = 0.f;
        if (tid < LC) {
            const bf16_t* zz = o == 0 ? z1 : z2; const int co = o == 0 ? 1024 : 2048;
            res = shortconv_at(zz, tid, LC, cw[co + ch], cw[3072 + co + ch], cw[6144 + co + ch], cb[co + ch]) * (acc / S + us[tid] * dsk);
        }
        __syncthreads();
        if (tid < LC) { if (o == 0) us[tid] = res; else c.wsp<bf16_t>(WS_YHY)[(size_t)(L + tid) * 1024 + ch] = f2bf(res); }
        __syncthreads();
    }
}

template <class KeyFn>
__device__ __forceinline__ void wave_attn(const bf16_t* q, int nkeys, const KeyFn& key, bool has_sink, float sink, bf16_t* out, float* wl, int lane) {
    float* qf = wl;
    float* sc = wl + 128;
    qf[2 * lane] = bf2f(q[2 * lane]); qf[2 * lane + 1] = bf2f(q[2 * lane + 1]);
    LDS_FENCE();
    float mx = -3.0e38f;
    for (int j = lane; j < nkeys; j += 64) {
        const bf16_t* kp; const bf16_t* vp; float bias;
        float s = -1e30f;
        if (key(j, kp, vp, bias)) {
            float d = 0.f;
#pragma unroll
            for (int e = 0; e < 128; e += 8) {
                const uint4 kk = *(const uint4*)(kp + e);
                d = fmaf(qf[e + 0], __uint_as_float(kk.x << 16), d); d = fmaf(qf[e + 1], __uint_as_float(kk.x & 0xffff0000u), d);
                d = fmaf(qf[e + 2], __uint_as_float(kk.y << 16), d); d = fmaf(qf[e + 3], __uint_as_float(kk.y & 0xffff0000u), d);
                d = fmaf(qf[e + 4], __uint_as_float(kk.z << 16), d); d = fmaf(qf[e + 5], __uint_as_float(kk.z & 0xffff0000u), d);
                d = fmaf(qf[e + 6], __uint_as_float(kk.w << 16), d); d = fmaf(qf[e + 7], __uint_as_float(kk.w & 0xffff0000u), d);
            }
            s = d * QK_SCALE + bias;
        }
        sc[j] = s; mx = fmaxf(mx, s);
    }
    if (has_sink) mx = fmaxf(mx, sink);
    mx = wave_max(mx);
    float sum = 0.f;
    for (int j = lane; j < nkeys; j += 64) { const float p = __expf(sc[j] - mx); sc[j] = p; sum += p; }
    sum = wave_sum(sum);
    if (has_sink) sum += __expf(sink - mx);
    LDS_FENCE();
    float o0 = 0.f, o1 = 0.f;
    for (int j = 0; j < nkeys; ++j) {
        const float p = sc[j];
        if (p != 0.f) {
            const bf16_t* kp; const bf16_t* vp; float bias;
            key(j, kp, vp, bias);
            const unsigned vv = *(const unsigned*)(vp + 2 * lane);
            o0 = fmaf(p, __uint_as_float(vv << 16), o0); o1 = fmaf(p, __uint_as_float(vv & 0xffff0000u), o1);
        }
    }
    const float inv = 1.0f / sum;
    *(unsigned*)(out + 2 * lane) = pk2(o0 * inv, o1 * inv);
    LDS_FENCE();
}

struct KeyWA {
    const bf16_t* kv; int t, kvh;
    __device__ __forceinline__ bool operator()(int j, const bf16_t*& kp, const bf16_t*& vp, float& bias) const {
        bias = 0.f;
        int row; bool ok = true;
        if (j < 257) { const int kpos = t - 128 + j; ok = kpos >= 0 && kpos < L; row = ok ? kpos : 0; } else row = L + (j - 257);
        kp = kv + (size_t)row * 512 + kvh * 128; vp = kp + 256; return ok;
    }
};
struct KeyCtxWA { const bf16_t* kv; int kvh;
    __device__ __forceinline__ bool operator()(int j, const bf16_t*& kp, const bf16_t*& vp, float& bias) const { bias = 0.f; kp = kv + (size_t)(L + j) * 512 + kvh * 128; vp = kp + 256; return true; } };
struct KeyNA {
    const bf16_t* kv; const float* rpb; int r, qc, r0, cs, h;
    __device__ __forceinline__ bool operator()(int j, const bf16_t*& kp, const bf16_t*& vp, float& bias) const {
        int row;
        if (j < 128) { const int w = j >> 4, kc = cs + (j & 15); row = (r0 + w) * GRIDW + kc;
            const int dr = r0 + w - r + 7; int dc = kc - qc + 15; dc = dc < 0 ? 0 : (dc > 30 ? 30 : dc);
            bias = rpb[(h * 15 + dr) * 31 + dc]; }
        else { row = L + (j - 128); bias = 0.f; }
        kp = kv + (size_t)row * 2048 + h * 128; vp = kp + 1024; return true;
    }
};
struct KeyCtxNA { const bf16_t* kv; int h;
    __device__ __forceinline__ bool operator()(int j, const bf16_t*& kp, const bf16_t*& vp, float& bias) const { bias = 0.f; kp = kv + (size_t)(L + j) * 2048 + h * 128; vp = kp + 1024; return true; } };


#define HYF __device__ __forceinline__
#define HYF_OPAQUE(x) asm volatile("" : "+v"(x))
#define HYF_SB(i) do { if (((i) & 3) == 3) __builtin_amdgcn_sched_barrier(0); } while (0)
namespace hyf {
constexpr int FL = 16384;
constexpr int FPAD = FL + 32 * 16;
typedef float cpx __attribute__((ext_vector_type(2)));
HYF int phys(int p) { return ((p & ~15) | ((p & 15) ^ ((p >> 5) & 15))) + ((p >> 9) << 4); }

#define HYF_C32 {1.0f, 0.98078528040323043f, 0.92387953251128674f, 0.83146961230254524f, 0.70710678118654752f, 0.55557023301960218f, 0.38268343236508978f, 0.19509032201612825f, \
                 0.0f, -0.19509032201612825f, -0.38268343236508978f, -0.55557023301960218f, -0.70710678118654752f, -0.83146961230254524f, -0.92387953251128674f, -0.98078528040323043f}
#define HYF_S32 {0.0f, 0.19509032201612825f, 0.38268343236508978f, 0.55557023301960218f, 0.70710678118654752f, 0.83146961230254524f, 0.92387953251128674f, 0.98078528040323043f, \
                 1.0f, 0.98078528040323043f, 0.92387953251128674f, 0.83146961230254524f, 0.70710678118654752f, 0.55557023301960218f, 0.38268343236508978f, 0.19509032201612825f}

HYF int rev5(int x) { return (int)(__builtin_bitreverse32((unsigned)x) >> 27); }
HYF int rev4(int x) { return (int)(__builtin_bitreverse32((unsigned)x) >> 28); }
HYF cpx cmul(cpx a, cpx t) { return a.xx * t + (cpx){-a.y, a.y} * t.yx; }
HYF cpx cmulc(cpx a, cpx t) { return t.xx * a + t.yy * (cpx){a.y, -a.x}; }

template <int N, int SG, int BASE, int STRIDE32>
struct DifStage {
    static HYF void run(cpx (&v)[32], const float (&K)[9]) {
        constexpr int H = N / 2;
#pragma unroll
        for (int j = 0; j < H; ++j) {
            const cpx a = v[BASE + j], b = v[BASE + j + H];
            v[BASE + j] = a + b;
            const cpx d = a - b;
            const int tw = j * STRIDE32;
            if (tw == 0) v[BASE + j + H] = d;
            else if (tw == 8) v[BASE + j + H] = (SG < 0) ? (cpx){d.y, -d.x} : (cpx){-d.y, d.x};
            else {
                const float c = (tw < 8) ? K[tw] : -K[16 - tw];
                const float sa = (tw < 8) ? K[8 - tw] : K[tw - 8];
                const float s = (SG < 0) ? -sa : sa;
                v[BASE + j + H] = d * c + (cpx){-d.y, d.x} * s;
            }
        }
        if constexpr (N > 2) { DifStage<H, SG, BASE, STRIDE32 * 2>::run(v, K); DifStage<H, SG, BASE + H, STRIDE32 * 2>::run(v, K); }
    }
};
template <int SG> HYF void dft32(cpx (&v)[32], const float (&K0)[9]) { float K[9]; _Pragma("unroll") for (int m = 0; m < 9; ++m) { K[m] = K0[m]; HYF_OPAQUE(K[m]); } DifStage<32, SG, 0, 1>::run(v, K); }
template <int SG> HYF void dft16(cpx (&v)[32], const float (&K0)[9]) { float K[9]; _Pragma("unroll") for (int m = 0; m < 9; ++m) { K[m] = K0[m]; HYF_OPAQUE(K[m]); } DifStage<16, SG, 0, 2>::run(v, K); }

struct ThreadTw { cpx w1;
                  cpx w2;
                  cpx wo;
                  int b1;
                  int b2, n3;
                  int b3[2], sw;
                  float K[9]; };
HYF void tw_addr(int tid, ThreadTw& t) {
    t.b1 = (tid & ~15) | ((tid & 15) ^ ((tid >> 5) & 15));
    t.b2 = (tid >> 4) * 528; t.n3 = tid & 15; t.sw = (tid >> 1) & 15;
    for (int h = 0; h < 2; ++h) { const int g = tid + 512 * h; t.b3[h] = g * 16 + (g >> 5) * 16; }
    constexpr float KK[9] = {1.0f, 0.98078528040323043f, 0.92387953251128674f, 0.83146961230254524f, 0.70710678118654752f, 0.55557023301960218f, 0.38268343236508978f, 0.19509032201612825f, 0.0f};
    for (int m = 0; m < 9; ++m) { t.K[m] = KK[m]; HYF_OPAQUE(t.K[m]); }
}

HYF void fwd_p1(const ThreadTw& tw, cpx (&v)[32], cpx* lds) {
    int b1 = tw.b1; HYF_OPAQUE(b1);
    float wx = tw.w1.x, wy = tw.w1.y; HYF_OPAQUE(wx); HYF_OPAQUE(wy); const cpx w = {wx, wy};
    dft32<-1>(v, tw.K);
    cpx t = {1.f, 0.f};
#pragma unroll
    for (int k1 = 0; k1 < 32; ++k1) {
        lds[b1 + 528 * k1] = cmul(v[rev5(k1)], t);
        t = cmul(t, w);
        HYF_SB(k1);
    }
}
HYF void fwd_p2(const ThreadTw& tw, cpx* lds) {
    int b2 = tw.b2, n3 = tw.n3; HYF_OPAQUE(b2); HYF_OPAQUE(n3);
    float wx = tw.w2.x, wy = tw.w2.y; HYF_OPAQUE(wx); HYF_OPAQUE(wy); const cpx w = {wx, wy};
    cpx v[32];
#pragma unroll
    for (int n2 = 0; n2 < 32; ++n2) v[n2] = lds[b2 + 16 * n2 + (n3 ^ ((n2 >> 1) & 15))];
    dft32<-1>(v, tw.K);
    cpx t = {1.f, 0.f};
#pragma unroll
    for (int k2 = 0; k2 < 32; ++k2) {
        lds[b2 + 16 * k2 + (n3 ^ ((k2 >> 1) & 15))] = cmul(v[rev5(k2)], t);
        t = cmul(t, w);
        HYF_SB(k2);
    }
}
HYF void fwd_p3(int tid, const ThreadTw& tw, const cpx* lds, cpx* ks) {
    HYF_OPAQUE(tid);
#pragma unroll
    for (int h = 0; h < 2; ++h) {
        int b3 = tw.b3[h], sw = tw.sw; HYF_OPAQUE(b3); HYF_OPAQUE(sw);
        cpx v[32];
#pragma unroll
        for (int n3 = 0; n3 < 16; ++n3) v[n3] = lds[b3 + (n3 ^ sw)];
        dft16<-1>(v, tw.K);
#pragma unroll
        for (int k3 = 0; k3 < 16; ++k3) ks[(h * 16 + k3) * 512 + tid] = v[rev4(k3)];
    }
}
HYF void mid_p3(int tid, const ThreadTw& tw, cpx* lds, const cpx* ks) {
    HYF_OPAQUE(tid);
#pragma unroll
    for (int h = 0; h < 2; ++h) {
        int b3 = tw.b3[h], sw = tw.sw; HYF_OPAQUE(b3); HYF_OPAQUE(sw);
        cpx v[32], p[32];
#pragma unroll
        for (int n3 = 0; n3 < 16; ++n3) v[n3] = lds[b3 + (n3 ^ sw)];
        dft16<-1>(v, tw.K);
#pragma unroll
        for (int k3 = 0; k3 < 16; ++k3) p[k3] = cmul(v[rev4(k3)], ks[(h * 16 + k3) * 512 + tid]);
        dft16<1>(p, tw.K);
#pragma unroll
        for (int n3 = 0; n3 < 16; ++n3) lds[b3 + (n3 ^ sw)] = p[rev4(n3)];
    }
}
HYF void inv_p2(const ThreadTw& tw, cpx* lds) {
    int b2 = tw.b2, n3 = tw.n3; HYF_OPAQUE(b2); HYF_OPAQUE(n3);
    float wx = tw.w2.x, wy = tw.w2.y; HYF_OPAQUE(wx); HYF_OPAQUE(wy); const cpx w = {wx, wy};
    cpx v[32];
    cpx t = {1.f, 0.f};
#pragma unroll
    for (int k2 = 0; k2 < 32; ++k2) {
        v[k2] = cmulc(lds[b2 + 16 * k2 + (n3 ^ ((k2 >> 1) & 15))], t);
        t = cmul(t, w);
        HYF_SB(k2);
    }
    dft32<1>(v, tw.K);
#pragma unroll
    for (int n2 = 0; n2 < 32; ++n2) { lds[b2 + 16 * n2 + (n3 ^ ((n2 >> 1) & 15))] = v[rev5(n2)]; HYF_SB(n2); }
}
HYF void inv_p1(const ThreadTw& tw, const cpx* lds, cpx (&out)[32]) {
    int b1 = tw.b1; HYF_OPAQUE(b1);
    float wx = tw.w1.x, wy = tw.w1.y; HYF_OPAQUE(wx); HYF_OPAQUE(wy); const cpx w = {wx, wy};
    cpx v[32];
    cpx t = {1.f, 0.f};
#pragma unroll
    for (int k1 = 0; k1 < 32; ++k1) {
        v[k1] = cmulc(lds[b1 + 528 * k1], t);
        t = cmul(t, w);
        HYF_SB(k1);
    }
    dft32<1>(v, tw.K);
#pragma unroll
    for (int n1 = 0; n1 < 32; ++n1) out[n1] = v[rev5(n1)];
}
HYF cpx opaque_wo(const ThreadTw& tw) { float x = tw.wo.x, y = tw.wo.y; HYF_OPAQUE(x); HYF_OPAQUE(y); return (cpx){x, y}; }
HYF cpx modfac(cpx wo, int n1) {
    constexpr float C64[32] = {1.0f, 0.99518472667219693f, 0.98078528040323043f, 0.95694033573220882f, 0.92387953251128674f, 0.88192126434835505f, 0.83146961230254524f, 0.77301045336273699f,
        0.70710678118654752f, 0.63439328416364549f, 0.55557023301960218f, 0.47139673682599764f, 0.38268343236508978f, 0.29028467725446233f, 0.19509032201612825f, 0.098017140329560604f,
        0.0f, -0.098017140329560604f, -0.19509032201612825f, -0.29028467725446233f, -0.38268343236508978f, -0.47139673682599764f, -0.55557023301960218f, -0.63439328416364549f,
        -0.70710678118654752f, -0.77301045336273699f, -0.83146961230254524f, -0.88192126434835505f, -0.92387953251128674f, -0.95694033573220882f, -0.98078528040323043f, -0.99518472667219693f};
    constexpr float S64[32] = {0.0f, 0.098017140329560604f, 0.19509032201612825f, 0.29028467725446233f, 0.38268343236508978f, 0.47139673682599764f, 0.55557023301960218f, 0.63439328416364549f,
        0.70710678118654752f, 0.77301045336273699f, 0.83146961230254524f, 0.88192126434835505f, 0.92387953251128674f, 0.95694033573220882f, 0.98078528040323043f, 0.99518472667219693f,
        1.0f, 0.99518472667219693f, 0.98078528040323043f, 0.95694033573220882f, 0.92387953251128674f, 0.88192126434835505f, 0.83146961230254524f, 0.77301045336273699f,
        0.70710678118654752f, 0.63439328416364549f, 0.55557023301960218f, 0.47139673682599764f, 0.38268343236508978f, 0.29028467725446233f, 0.19509032201612825f, 0.098017140329560604f};
    return cmul(wo, (cpx){C64[n1], -S64[n1]});
}
}

#undef HYF
#ifndef FAST_HY
#define FAST_HY 1
#endif
__device__ __forceinline__ void hyena_fft_unit(const Ctx& c, int layer, int ch, const hyf::ThreadTw& tw) {
    using namespace hyf;
    cpx* lds = (cpx*)c.smem; float* red = (float*)(c.smem + (size_t)FPAD * 8);
    cpx* ks = c.wsp<cpx>(WS_KS) + (size_t)c.bid * (2 * FL);
    float* ub = (float*)(ks + FL); float* yb = ub + FL;
    const int tid = c.tid;
    const float* cw = c.in[8] + (size_t)layer * 3 * 3072; const float* cb = c.in[9] + (size_t)layer * 3072;
    const bf16_t* zv = c.wsp<bf16_t>(WS_ZHYT) + (size_t)ch * MR;
    const bf16_t* KF = c.wsp<bf16_t>(WS_KF);
    { const float w0 = cw[ch], w1 = cw[3072 + ch], w2 = cw[6144 + ch], b = cb[ch]; int tq = tid; HYF_OPAQUE(tq);
#pragma unroll 4
      for (int j = 0; j < 32; ++j) ub[tq + 512 * j] = shortconv_at(zv, tq + 512 * j, L, w0, w1, w2, b); }
#pragma unroll 1
    for (int o = 0; o < 2; ++o) {
        const bf16_t* hf = KF + (size_t)(o * 1024 + ch) * L;
        const bf16_t* hb = KF + (size_t)(2048 + o * 1024 + ch) * L;
        float S;
        {
            cpx v[32]; float sabs = 0.f; int tq = tid; HYF_OPAQUE(tq);
#pragma unroll
            for (int j = 0; j < 32; ++j) { const int n = tq + 512 * j; const float f = bf2f(hf[n]); const float bb = bf2f(hb[n == 0 ? 0 : L - n]);
                v[j] = (cpx){f + bb, 0.f}; sabs += (n == 0) ? fabsf(f + bb) : fabsf(f) + fabsf(bb); }
            S = block_sum(sabs, red, tid);
            fwd_p1(tw, v, lds); __syncthreads(); fwd_p2(tw, lds); __syncthreads(); fwd_p3(tid, tw, lds, ks); __syncthreads();
        }
        {
            cpx v[32]; int tq = tid; HYF_OPAQUE(tq);
#pragma unroll
            for (int j = 0; j < 32; ++j) v[j] = (cpx){ub[tq + 512 * j], 0.f};
            fwd_p1(tw, v, lds); __syncthreads(); fwd_p2(tw, lds); __syncthreads(); mid_p3(tid, tw, lds, ks); __syncthreads();
            inv_p2(tw, lds); __syncthreads();
            inv_p1(tw, lds, v); __syncthreads();
            HYF_OPAQUE(tq);
#pragma unroll
            for (int j = 0; j < 32; ++j) yb[tq + 512 * j] = v[j].x;
        }
        {
            cpx v[32]; const cpx wo = opaque_wo(tw); int tq = tid; HYF_OPAQUE(tq);
#pragma unroll
            for (int j = 0; j < 32; ++j) { const int n = tq + 512 * j; const float f = bf2f(hf[n]); const float bb = bf2f(hb[n == 0 ? 0 : L - n]);
                const float d = (n == 0) ? f + bb : f - bb; v[j] = modfac(wo, j) * d; }
            fwd_p1(tw, v, lds); __syncthreads(); fwd_p2(tw, lds); __syncthreads(); fwd_p3(tid, tw, lds, ks); __syncthreads();
        }
        {
            cpx v[32]; cpx wo = opaque_wo(tw); int tq = tid; HYF_OPAQUE(tq);
#pragma unroll
            for (int j = 0; j < 32; ++j) v[j] = modfac(wo, j) * ub[tq + 512 * j];
            fwd_p1(tw, v, lds); __syncthreads(); fwd_p2(tw, lds); __syncthreads(); mid_p3(tid, tw, lds, ks); __syncthreads();
            inv_p2(tw, lds); __syncthreads();
            inv_p1(tw, lds, v); __syncthreads();
            const float sc = (0.5f / (float)L) / S; wo = opaque_wo(tw); HYF_OPAQUE(tq);
            const float dsk = c.in[17][(size_t)layer * 2048 + o * 1024 + ch];
            const int co = o == 0 ? 1024 : 2048;
            const bf16_t* zz = c.wsp<bf16_t>(WS_ZHYT) + (size_t)(co + ch) * MR;
            const float w0 = cw[co + ch], w1 = cw[3072 + co + ch], w2 = cw[6144 + co + ch], b = cb[co + ch];
            bf16_t* dst = c.wsp<bf16_t>(WS_YHYT) + (size_t)ch * L;
#pragma unroll
            for (int j = 0; j < 32; ++j) { const int t = tq + 512 * j; const cpx m = modfac(wo, j);
                const float conv = (yb[t] + v[j].x * m.x + v[j].y * m.y) * sc;
                const float r = shortconv_at(zz, t, L, w0, w1, w2, b) * (conv + ub[t] * dsk);
                if (o == 0) ub[t] = r; else dst[t] = f2bf(r); }
        }
    }
}


#ifndef FAST_ATT
#define FAST_ATT 1
#endif
namespace fa {
using bf16x8 = __attribute__((ext_vector_type(8))) short;
using s16x4  = __attribute__((ext_vector_type(4))) short;
using f32x16 = __attribute__((ext_vector_type(16))) float;
using u32x4  = __attribute__((ext_vector_type(4))) unsigned;
constexpr int AD = 128, NW = 8, QBLK = 32, KVBLK = 64;
constexpr float SCALE = 0.088388347648318440f;
constexpr float THR = 8.f;
constexpr size_t SHM_V = KVBLK * AD * 2, SHM_K = KVBLK * AD * 2, SHM_ATTN = 2 * SHM_V + 2 * SHM_K + NW * 64 * 4;
constexpr float NEG = -1e30f;
#define KSWZ(row, colB) ((row) * 256 + ((colB) ^ (((row) & 7) << 4)))
#define SBAR() __builtin_amdgcn_sched_barrier(0)
__device__ __forceinline__ int crow(int r, int hi) { return (r & 3) + 8 * (r >> 2) + 4 * hi; }
__device__ __forceinline__ unsigned cvtpk(float lo, float hi) { unsigned r; asm volatile("v_cvt_pk_bf16_f32 %0, %1, %2" : "=v"(r) : "v"(lo), "v"(hi)); return r; }
__device__ __forceinline__ void partialSM(f32x16& p0, f32x16& p1, float& m_reg, float& mn, float& alpha) {
  constexpr float C = SCALE * 1.4426950408889634f;
  float pmax = p0[0];
#pragma unroll
  for (int r = 1; r < 16; ++r) pmax = fmaxf(pmax, p0[r]);
#pragma unroll
  for (int r = 0; r < 16; ++r) pmax = fmaxf(pmax, p1[r]);
  { auto rr = __builtin_amdgcn_permlane32_swap(__float_as_uint(pmax), __float_as_uint(pmax), false, false);
    pmax = fmaxf(__uint_as_float(rr[0]), __uint_as_float(rr[1])); }
  if (__builtin_expect(__all(pmax - m_reg <= THR / SCALE), 1)) { mn = m_reg; alpha = 1.f; }
  else { mn = fmaxf(m_reg, pmax); alpha = __builtin_amdgcn_exp2f((m_reg - mn) * C); m_reg = mn; }
  const float mnC = -mn * C;
#pragma unroll
  for (int r = 0; r < 16; ++r) p0[r] = fmaf(p0[r], C, mnC);
#pragma unroll
  for (int r = 0; r < 16; ++r) p1[r] = fmaf(p1[r], C, mnC);
#pragma unroll
  for (int r = 0; r < 16; ++r) p0[r] = __builtin_amdgcn_exp2f(p0[r]);
}
__device__ __forceinline__ void finishSM(f32x16& p0, f32x16& p1, float alpha, float& l_reg, bf16x8& pa0, bf16x8& pa1, bf16x8& pa2, bf16x8& pa3) {
#pragma unroll
  for (int r = 0; r < 16; ++r) p1[r] = __builtin_amdgcn_exp2f(p1[r]);
  float ps = 0;
#pragma unroll
  for (int r = 0; r < 16; ++r) ps += p0[r];
#pragma unroll
  for (int r = 0; r < 16; ++r) ps += p1[r];
  { auto rr = __builtin_amdgcn_permlane32_swap(__float_as_uint(ps), __float_as_uint(ps), false, false);
    ps = __uint_as_float(rr[0]) + __uint_as_float(rr[1]); }
  l_reg = l_reg * alpha + ps;
#define PK4(P, BASE, OUT) do { unsigned a0 = cvtpk(P[BASE + 0], P[BASE + 1]), a1 = cvtpk(P[BASE + 2], P[BASE + 3]);   \
    unsigned b0 = cvtpk(P[BASE + 4], P[BASE + 5]), b1 = cvtpk(P[BASE + 6], P[BASE + 7]);                              \
    auto r0 = __builtin_amdgcn_permlane32_swap(a0, b0, false, false); auto r1 = __builtin_amdgcn_permlane32_swap(a1, b1, false, false); \
    u32x4 w = {r0[0], r1[0], r0[1], r1[1]}; OUT = *reinterpret_cast<bf16x8*>(&w); } while (0)
  PK4(p0, 0, pa0); PK4(p0, 8, pa1); PK4(p1, 0, pa2); PK4(p1, 8, pa3);
#undef PK4
}
__device__ __forceinline__ void qkt(f32x16& p0, f32x16& p1, const char* Ks, const bf16x8* qr, int r32, int hi) {
  p0 = f32x16{}; p1 = f32x16{};
#pragma unroll
  for (int d0 = 0; d0 < 8; ++d0) { const int cb = (d0 * 16 + hi * 8) * 2;
    const bf16x8 b0 = *reinterpret_cast<const bf16x8*>(Ks + KSWZ(r32, cb));
    const bf16x8 b1 = *reinterpret_cast<const bf16x8*>(Ks + KSWZ(32 + r32, cb));
    p0 = __builtin_amdgcn_mfma_f32_32x32x16_bf16(b0, qr[d0], p0, 0, 0, 0);
    p1 = __builtin_amdgcn_mfma_f32_32x32x16_bf16(b1, qr[d0], p1, 0, 0, 0); }
}
__device__ __forceinline__ int v_st(int k, int c) { const int kk = (k & ~0xC) | ((k & 4) << 1) | ((k & 8) >> 1); return ((kk >> 3) * 4 + (c >> 5)) * 512 + ((kk & 7) * 32 + (c & 31)) * 2; }
__device__ __forceinline__ int v_rd_base(int lane) { return ((lane & 3) << 3) | (((lane >> 2) & 3) << 6) | (((lane >> 4) & 1) << 5) | (((lane >> 5) & 1) << 8); }
constexpr int v_rd_off(int d0, int ks, int half) { return d0 * 512 + ks * 4096 + half * 2048; }
template <int OFF> __device__ __forceinline__ s16x4 tr_read(int vb) { s16x4 r; asm volatile("ds_read_b64_tr_b16 %0, %1 offset:%2" : "=&v"(r) : "v"(vb), "i"(OFF) : "memory"); return r; }
template <int D0> __device__ __forceinline__ void pv_one(f32x16& od, int vb, bf16x8 pa0, bf16x8 pa1, bf16x8 pa2, bf16x8 pa3) {
  const s16x4 l0 = tr_read<v_rd_off(D0, 0, 0)>(vb), h0 = tr_read<v_rd_off(D0, 0, 1)>(vb), l1 = tr_read<v_rd_off(D0, 1, 0)>(vb), h1 = tr_read<v_rd_off(D0, 1, 1)>(vb);
  const s16x4 l2 = tr_read<v_rd_off(D0, 2, 0)>(vb), h2 = tr_read<v_rd_off(D0, 2, 1)>(vb), l3 = tr_read<v_rd_off(D0, 3, 0)>(vb), h3 = tr_read<v_rd_off(D0, 3, 1)>(vb);
  asm volatile("s_waitcnt lgkmcnt(0)" ::: "memory"); SBAR();
#define PK(Lo, Hi) (bf16x8){Lo[0], Lo[1], Lo[2], Lo[3], Hi[0], Hi[1], Hi[2], Hi[3]}
  od = __builtin_amdgcn_mfma_f32_32x32x16_bf16(pa0, PK(l0, h0), od, 0, 0, 0);
  od = __builtin_amdgcn_mfma_f32_32x32x16_bf16(pa1, PK(l1, h1), od, 0, 0, 0);
  od = __builtin_amdgcn_mfma_f32_32x32x16_bf16(pa2, PK(l2, h2), od, 0, 0, 0);
  od = __builtin_amdgcn_mfma_f32_32x32x16_bf16(pa3, PK(l3, h3), od, 0, 0, 0);
#undef PK
}
__device__ __forceinline__ void pv_d0(f32x16* o, int vb, bf16x8 pa0, bf16x8 pa1, bf16x8 pa2, bf16x8 pa3) {
  pv_one<0>(o[0], vb, pa0, pa1, pa2, pa3); pv_one<1>(o[1], vb, pa0, pa1, pa2, pa3); pv_one<2>(o[2], vb, pa0, pa1, pa2, pa3); pv_one<3>(o[3], vb, pa0, pa1, pa2, pa3);
}

template <class Tiles>
__device__ __forceinline__ void attn_unit(const bf16_t* __restrict__ Qb, int ldq, const bf16_t* __restrict__ Kb, const bf16_t* __restrict__ Vb, int ldk,
                                          bf16_t* __restrict__ Ob, int ldo, const Tiles& T, int NT, bool has_sink, float sink, char* lds) {
  int tid = threadIdx.x; asm volatile("" : "+v"(tid));
  const int wid = __builtin_amdgcn_readfirstlane(tid >> 6), lane = tid & 63, r32 = lane & 31, hi = lane >> 5;
  char* V_lds = lds; char* K_lds = lds + 2 * SHM_V;
  float* ws = (float*)(lds + 2 * SHM_V + 2 * SHM_K) + wid * 64; float* li_l = ws; float* al_l = ws + 32;
  float m_reg = -1e30f, l_reg = 0; f32x16 o[4] = {}; bf16x8 qr[8];
  const bf16_t* Qw = Qb + (long)(wid * QBLK + r32) * ldq + hi * 8;
#pragma unroll
  for (int d0 = 0; d0 < 8; ++d0) qr[d0] = *reinterpret_cast<const bf16x8*>(Qw + d0 * 16);
  const int sr = tid >> 4, sc = (tid & 15) * 8, vst0 = v_st(sr, sc), vst1 = v_st(32 + sr, sc);
  const int vb0 = (int)(uintptr_t)V_lds + v_rd_base(lane);
  bf16x8 vs0, vs1, ks0, ks1;
#define SLOAD(j) do { const long _k0 = T.row(j); vs0 = *reinterpret_cast<const bf16x8*>(&Vb[(_k0 + sr) * ldk + sc]); vs1 = *reinterpret_cast<const bf16x8*>(&Vb[(_k0 + 32 + sr) * ldk + sc]); \
    ks0 = *reinterpret_cast<const bf16x8*>(&Kb[(_k0 + sr) * ldk + sc]); ks1 = *reinterpret_cast<const bf16x8*>(&Kb[(_k0 + 32 + sr) * ldk + sc]); } while (0)
#define SWRITE(b) do { *(bf16x8*)(V_lds + (b) * SHM_V + vst0) = vs0; *(bf16x8*)(V_lds + (b) * SHM_V + vst1) = vs1; const int kc = sc * 2; \
    *(bf16x8*)(K_lds + (b) * SHM_K + KSWZ(sr, kc)) = ks0; *(bf16x8*)(K_lds + (b) * SHM_K + KSWZ(32 + sr, kc)) = ks1; } while (0)
  __syncthreads();
  SLOAD(0); asm volatile("s_waitcnt vmcnt(0)" ::: "memory"); SWRITE(0);
  if (1 < NT) SLOAD(1);
#pragma unroll 1
  for (int j = 0; j < NT; ++j) {
    const int b = j & 1;
    __syncthreads();
    if (j + 1 < NT) { asm volatile("s_waitcnt vmcnt(0)" ::: "memory"); SWRITE(b ^ 1); if (j + 2 < NT) SLOAD(j + 2); }
    if (T.active(j, wid)) {
      f32x16 p0, p1; float mn, alpha; bf16x8 pa0, pa1, pa2, pa3;
      qkt(p0, p1, K_lds + b * SHM_K, qr, r32, hi); T.mask(p0, p1, j, wid, r32, hi);
      partialSM(p0, p1, m_reg, mn, alpha);
      if (__any(alpha < 1.f)) { if (hi == 0) al_l[r32] = alpha; asm volatile("s_waitcnt lgkmcnt(0)" ::: "memory");
#pragma unroll
        for (int d = 0; d < 4; ++d)
#pragma unroll
          for (int r = 0; r < 16; ++r) o[d][r] *= al_l[crow(r, hi)]; }
      finishSM(p0, p1, alpha, l_reg, pa0, pa1, pa2, pa3); SBAR();
      pv_d0(o, vb0 + b * (int)SHM_V, pa0, pa1, pa2, pa3);
    }
  }
  if (has_sink) { constexpr float C = SCALE * 1.4426950408889634f; l_reg += __builtin_amdgcn_exp2f(fmaf(sink, 1.4426950408889634f, -m_reg * C)); }
  if (hi == 0) li_l[r32] = l_reg; asm volatile("s_waitcnt lgkmcnt(0)" ::: "memory");
  float rli[16];
#pragma unroll
  for (int r = 0; r < 16; ++r) rli[r] = __builtin_amdgcn_rcpf(li_l[crow(r, hi)]);
  bf16_t* Ow = Ob + (long)(wid * QBLK) * ldo;
#pragma unroll
  for (int r = 0; r < 16; ++r) { const int orow = crow(r, hi);
#pragma unroll
    for (int d0 = 0; d0 < 4; ++d0) Ow[(long)orow * ldo + d0 * 32 + r32] = f2bf(o[d0][r] * rli[r]); }
#undef SLOAD
#undef SWRITE
}
#undef KSWZ
#undef SBAR

struct TilesGen {
  int mode, i0, lo, R, glo, nloc; const float* bias;
  __device__ __forceinline__ long row(int j) const {
    if (j < 4) return L + 64 * j;
    if (mode == 0) return lo + 64 * (j - 4);
    return (long)(glo + (j - 4)) * 64;
  }
  __device__ __forceinline__ bool active(int j, int wid) const {
    if (j < 4 || mode == 2) return true;
    if (mode == 0) { const int Tr = lo + 64 * (j - 4), q0 = i0 + 32 * wid; return Tr + 63 >= q0 - 128 && Tr <= q0 + 31 + 128; }
    const int kr = glo + (j - 4), qr = R + (wid >> 1);
    int r0 = qr - 4; r0 = r0 < 0 ? 0 : (r0 > 248 ? 248 : r0);
    return kr >= r0 && kr <= r0 + 7;
  }
  __device__ __forceinline__ void mask(f32x16& p0, f32x16& p1, int j, int wid, int r32, int hi) const {
    if (j < 4 || mode == 2) return;
    if (mode == 0) {
      const int Tr = lo + 64 * (j - 4), q0 = i0 + 32 * wid;
      if (q0 + 31 - Tr <= 128 && Tr + 63 - q0 <= 128) return;
      const int dq = q0 + r32 - Tr;
#pragma unroll
      for (int r = 0; r < 16; ++r) { const int kk = crow(r, hi); p0[r] = (kk >= dq - 128 && kk <= dq + 128) ? p0[r] : NEG; p1[r] = (kk + 32 >= dq - 128 && kk + 32 <= dq + 128) ? p1[r] : NEG; }
      return;
    }
    const int kr = glo + (j - 4), qr = R + (wid >> 1), qc = (wid & 1) * 32 + r32;
    int cs = qc - 8; cs = cs < 0 ? 0 : (cs > 48 ? 48 : cs);
    const float* bt = bias + (kr - qr + 7) * 32 + (15 - qc);
#pragma unroll
    for (int r = 0; r < 16; ++r) { const int k0 = crow(r, hi), k1 = k0 + 32;
      const bool v0 = (unsigned)(k0 - cs) < 16u, v1 = (unsigned)(k1 - cs) < 16u;
      p0[r] = v0 ? p0[r] + bt[v0 ? k0 : cs] : NEG; p1[r] = v1 ? p1[r] + bt[v1 ? k1 : cs] : NEG; }
  }
};
}

__device__ __forceinline__ void ph_attn_fast(const Ctx& c, int layer) {
  char* lds = (char*)c.smem;
  float* btab = (float*)(c.smem + fa::SHM_ATTN);
  const bf16_t* QWA = c.wsp<bf16_t>(WS_QWA); const bf16_t* KVWA = c.wsp<bf16_t>(WS_KVWA); bf16_t* YWA = c.wsp<bf16_t>(WS_YWA);
  const bf16_t* QNA = c.wsp<bf16_t>(WS_QNA); const bf16_t* KVNA = c.wsp<bf16_t>(WS_KVNA); bf16_t* YNA = c.wsp<bf16_t>(WS_YNA);
  const float* sinkp = c.in[20] + layer * 8; const float* rpb = c.in[23] + (size_t)layer * 8 * 15 * 31;
  const int nq = L / 256;
  const int nunits = 2 * 8 * nq + (layer == 0 ? 16 : 0);
#pragma unroll 1
  for (int u = c.bid; u < nunits; u += c.nb) {
    fa::TilesGen T; T.mode = 2; T.i0 = 0; T.lo = 0; T.R = 0; T.glo = 0; T.nloc = 0; T.bias = btab;
    int h, i0, NT; bool wa;
    if (u < 8 * nq) {
      wa = true; h = u / nq; i0 = (u % nq) * 256;
      const int lo = i0 - 128 < 0 ? 0 : i0 - 128, hiR = i0 + 384 > L ? L : i0 + 384;
      T.mode = 0; T.i0 = i0; T.lo = lo; NT = 4 + (hiR - lo) / 64;
    } else if (u < 16 * nq) {
      const int v = u - 8 * nq; wa = false; h = v / nq; const int qb = v % nq; i0 = qb * 256; const int R = qb * 4;
      int glo = R - 4; glo = glo < 0 ? 0 : (glo > 248 ? 248 : glo);
      int gh = R + 3 - 4; gh = gh < 0 ? 0 : (gh > 248 ? 248 : gh); gh += 7;
      T.mode = 1; T.R = R; T.glo = glo; T.nloc = gh - glo + 1; NT = 4 + T.nloc;
      __syncthreads();
      for (int e = c.tid; e < 15 * 32; e += NTHREADS) { const int dr = e >> 5, dc = e & 31; btab[e] = dc < 31 ? rpb[(h * 15 + dr) * 31 + dc] * (1.0f / fa::SCALE) : 0.f; }
    } else {
      const int v = u - 16 * nq; wa = v < 8; h = v & 7; i0 = L; NT = 4;
    }
    const bf16_t* Q = (wa ? QWA : QNA) + (size_t)i0 * 1024 + h * 128;
    const bf16_t* Kb = wa ? KVWA + (h >> 2) * 128 : KVNA + h * 128;
    const bf16_t* Vb = wa ? KVWA + 256 + (h >> 2) * 128 : KVNA + 1024 + h * 128;
    bf16_t* O = (wa ? YWA : YNA) + (size_t)i0 * 1024 + h * 128;
    fa::attn_unit(Q, 1024, Kb, Vb, wa ? 512 : 2048, O, 1024, T, NT, wa, wa ? sinkp[h] : 0.f, lds);
  }
}

__device__ __forceinline__ void ph_c(const Ctx& c, int layer) {
#ifndef NO_HY
    if (FAST_HY) {
        hyf::ThreadTw tw; hyf::tw_addr(c.tid, tw);
        { float s_, c_; sincospif(-2.0f * (float)c.tid / (float)hyf::FL, &s_, &c_); tw.w1 = (hyf::cpx){c_, s_};
          sincospif(-2.0f * (float)(c.tid & 15) / 512.0f, &s_, &c_); tw.w2 = (hyf::cpx){c_, s_};
          sincospif(-(float)c.tid / (float)hyf::FL, &s_, &c_); tw.wo = (hyf::cpx){c_, s_}; }
        for (int u = c.bid; u < 1024; u += c.nb) hyena_fft_unit(c, layer, u, tw);
        if constexpr (DOREP(16)) { for (int u = c.bid; u < 1024; u += c.nb) hyena_fft_unit(c, layer, u, tw); }
    } else
    for (int u = c.bid; u < 1024; u += c.nb) hyena_direct_unit(c, layer, u);
#endif
#ifndef NO_HYC
    if (layer == 0) for (int u = c.bid; u < 1024; u += c.nb) hyena_ctx_unit(c, layer, u);
#endif
    __syncthreads();
#ifndef NO_ATT
    if (FAST_ATT) { ph_attn_fast(c, layer); return; }
    const int gw = c.bid * 8 + c.wave, ngw = c.nb * 8;
    float* wl = (float*)c.smem + c.wave * 768;
    const int nrows = layer == 0 ? MR : L;
    const float* sinkp = c.in[20] + layer * 8;
    const float* rpb = c.in[23] + (size_t)layer * 8 * 15 * 31;
    const bf16_t* kvwa = c.wsp<bf16_t>(WS_KVWA); const bf16_t* kvna = c.wsp<bf16_t>(WS_KVNA);
    for (int task = gw; task < nrows * 16; task += ngw) {
        const int r = task >> 4, hh = task & 15;
        if (hh < 8) {
            const int h = hh; const bf16_t* q = c.wsp<bf16_t>(WS_QWA) + (size_t)r * 1024 + h * 128; bf16_t* o = c.wsp<bf16_t>(WS_YWA) + (size_t)r * 1024 + h * 128;
            if (r < L) { const KeyWA k{kvwa, r, h >> 2}; wave_attn(q, 513, k, true, sinkp[h], o, wl, c.lane); }
            else { const KeyCtxWA k{kvwa, h >> 2}; wave_attn(q, 256, k, true, sinkp[h], o, wl, c.lane); }
        } else {
            const int h = hh - 8; const bf16_t* q = c.wsp<bf16_t>(WS_QNA) + (size_t)r * 1024 + h * 128; bf16_t* o = c.wsp<bf16_t>(WS_YNA) + (size_t)r * 1024 + h * 128;
            if (r < L) { const int gr = r / GRIDW, qc = r % GRIDW; int r0 = gr - 4; r0 = r0 < 0 ? 0 : (r0 > 248 ? 248 : r0); int cs = qc - 8; cs = cs < 0 ? 0 : (cs > 48 ? 48 : cs);
                const KeyNA k{kvna, rpb, gr, qc, r0, cs, h}; wave_attn(q, 384, k, false, 0.f, o, wl, c.lane); }
            else { const KeyCtxNA k{kvna, h}; wave_attn(q, 256, k, false, 0.f, o, wl, c.lane); }
        }
    }
#endif
}

__device__ __forceinline__ void ph_c2(const Ctx& c) {
    bf16_t* tile = (bf16_t*)c.smem;
    const bf16_t* src = c.wsp<bf16_t>(WS_YHYT); bf16_t* dst = c.wsp<bf16_t>(WS_YHY);
    const int tid = c.tid, a = tid >> 3, b8 = (tid & 7) * 8;
    for (int u = c.bid; u < (1024 / 64) * (L / 64); u += c.nb) {
        const int c0 = (u % 16) * 64, t0 = (u / 16) * 64;
        const uint4 v = *(const uint4*)(src + (size_t)(c0 + a) * L + t0 + b8);
        __syncthreads();
        *(uint4*)(tile + a * 72 + b8) = v;
        __syncthreads();
        unsigned short e[8];
#pragma unroll
        for (int i = 0; i < 8; ++i) e[i] = tile[(b8 + i) * 72 + a];
        uint4 o; o.x = e[0] | ((unsigned)e[1] << 16); o.y = e[2] | ((unsigned)e[3] << 16); o.z = e[4] | ((unsigned)e[5] << 16); o.w = e[6] | ((unsigned)e[7] << 16);
        *(uint4*)(dst + (size_t)(t0 + a) * 1024 + c0 + b8) = o;
    }
}

struct EpiMerge { unsigned char* ws; int b;
    __device__ __forceinline__ void operator()(int row, int col, const float (&v)[8]) const {
        const bf16_t* g = (const bf16_t*)(ws + WS_GATE) + (size_t)row * 6144 + b * 2048 + col;
        float* mp = (float*)(ws + WS_MPART) + (size_t)row * D + col;
        const uint4 gg = *(const uint4*)g;
        const float gv[8] = {__uint_as_float(gg.x << 16), __uint_as_float(gg.x & 0xffff0000u), __uint_as_float(gg.y << 16), __uint_as_float(gg.y & 0xffff0000u),
                             __uint_as_float(gg.z << 16), __uint_as_float(gg.z & 0xffff0000u), __uint_as_float(gg.w << 16), __uint_as_float(gg.w & 0xffff0000u)};
        float t[8];
        if (b == 0) {
#pragma unroll
            for (int j = 0; j < 8; ++j) t[j] = gv[j] * v[j];
        } else {
            const float4 p0 = *(const float4*)mp, p1 = *(const float4*)(mp + 4);
            const float pv[8] = {p0.x, p0.y, p0.z, p0.w, p1.x, p1.y, p1.z, p1.w};
#pragma unroll
            for (int j = 0; j < 8; ++j) t[j] = fmaf(gv[j], v[j], pv[j]);
        }
        if (b < 2) { *(float4*)mp = make_float4(t[0], t[1], t[2], t[3]); *(float4*)(mp + 4) = make_float4(t[4], t[5], t[6], t[7]); }
        else { uint4 o; o.x = pk2(t[0], t[1]); o.y = pk2(t[2], t[3]); o.z = pk2(t[4], t[5]); o.w = pk2(t[6], t[7]); *(uint4*)((bf16_t*)(ws + WS_MB) + (size_t)row * D + col) = o; }
    }
};
__device__ __forceinline__ void ph_d(const Ctx& c, int layer) {
    const int nM = MR / 128, nN = D / 128;
    for (int b = 0; b < 3; ++b) {
        const bf16_t* A = b == 0 ? c.wsp<bf16_t>(WS_YHY) : (b == 1 ? c.wsp<bf16_t>(WS_YWA) : c.wsp<bf16_t>(WS_YNA));
        const RowLin rp{A, 1024}; const EpiMerge ep{c.ws, b};
        const float* W = c.in[24] + ((size_t)layer * 3 + b) * 1024 * D;
        for (int u = c.bid; u < nM * nN; u += c.nb) sgemm_unit(rp, W, D, 1024, (u % nM) * 128, (u / nM) * 128, ep, (float*)c.smem, c.tid);
    }
}
struct EpiOut { const Ctx* c; int layer;
    __device__ __forceinline__ void operator()(int row, int col, const float (&v)[8]) const {
        const float* xin = c->xrow(layer, row) + col; const float* g = c->mod(layer, row < L ? 0 : 1, 2) + col;
        float* o = (float*)(c->ws + WS_XA) + (size_t)row * D + col;
        const float4 x0 = *(const float4*)xin, x1 = *(const float4*)(xin + 4), g0 = *(const float4*)g, g1 = *(const float4*)(g + 4);
        *(float4*)o = make_float4(x0.x + g0.x * v[0], x0.y + g0.y * v[1], x0.z + g0.z * v[2], x0.w + g0.w * v[3]);
        *(float4*)(o + 4) = make_float4(x1.x + g1.x * v[4], x1.y + g1.y * v[5], x1.z + g1.z * v[6], x1.w + g1.w * v[7]);
    }
};
__device__ __forceinline__ void ph_e(const Ctx& c, int layer) {
    const int nM = MR / 128, nN = D / 128;
    const RowLin rp{c.wsp<bf16_t>(WS_MB), D}; const EpiOut ep{&c, layer};
    const float* W = c.in[25] + (size_t)layer * D * D;
    for (int u = c.bid; u < nM * nN; u += c.nb) sgemm_unit(rp, W, D, D, (u % nM) * 128, (u / nM) * 128, ep, (float*)c.smem, c.tid);
}

__device__ __forceinline__ void ph_f(const Ctx& c, int layer) {
    const int gw = c.bid * 8 + c.wave, ngw = c.nb * 8;
    const float* g = c.in[26] + (size_t)layer * D;
    const float* wr = c.in[27] + (size_t)layer * D * NE;
    float* wl = (float*)c.smem; float* gl = wl + NE * D;
    __syncthreads();
    for (int i = c.tid; i < D * NE / 4; i += NTHREADS) { const float4 v = *(const float4*)(wr + 4 * i); const int col = i >> 2, e0 = (i & 3) * 4;
        wl[(e0 + 0) * D + col] = v.x; wl[(e0 + 1) * D + col] = v.y; wl[(e0 + 2) * D + col] = v.z; wl[(e0 + 3) * D + col] = v.w; }
    for (int i = c.tid; i < D; i += NTHREADS) { gl[i] = g[i]; gl[D + i] = c.mod(layer, 0, 3)[i]; gl[2 * D + i] = c.mod(layer, 0, 4)[i]; }
    __syncthreads();
    const int nrows = layer == 0 ? MR : L;
    for (int r = gw; r < nrows; r += ngw) {
        const float* x = c.wsp<float>(WS_XA) + (size_t)r * D;
        const bool lat = r < L;
        const float* shg = c.mod(layer, 1, 3); const float* scg = c.mod(layer, 1, 4);
        float4 v[8]; float ss = 0.f;
#pragma unroll
        for (int j = 0; j < 8; ++j) { v[j] = *(const float4*)(x + 4 * c.lane + 256 * j); ss += v[j].x * v[j].x + v[j].y * v[j].y + v[j].z * v[j].z + v[j].w * v[j].w; }
        ss = wave_sum(ss);
        const float inv = rsqrtf(ss * (1.0f / D) + RMS_EPS);
        bf16_t* o = c.wsp<bf16_t>(WS_H2) + (size_t)r * D;
        float lg[NE];
#pragma unroll
        for (int e = 0; e < NE; ++e) lg[e] = 0.f;
#pragma unroll
        for (int j = 0; j < 8; ++j) {
            const int col = 4 * c.lane + 256 * j;
            const float4 gg = *(const float4*)(gl + col);
            const float4 s4 = lat ? *(const float4*)(gl + D + col) : *(const float4*)(shg + col);
            const float4 c4 = lat ? *(const float4*)(gl + 2 * D + col) : *(const float4*)(scg + col);
            const float y0 = v[j].x * inv * gg.x * (1.f + c4.x) + s4.x, y1 = v[j].y * inv * gg.y * (1.f + c4.y) + s4.y;
            const float y2 = v[j].z * inv * gg.z * (1.f + c4.z) + s4.z, y3 = v[j].w * inv * gg.w * (1.f + c4.w) + s4.w;
            uint2 w; w.x = pk2(y0, y1); w.y = pk2(y2, y3);
            *(uint2*)(o + col) = w;
#pragma unroll
            for (int e = 0; e < NE; ++e) { const float4 w4 = *(const float4*)(wl + e * D + col); lg[e] = fmaf(y0, w4.x, fmaf(y1, w4.y, fmaf(y2, w4.z, fmaf(y3, w4.w, lg[e])))); }
            __builtin_amdgcn_sched_barrier(0);
        }
        float mx = -3e38f;
#pragma unroll
        for (int e = 0; e < NE; ++e) { lg[e] = wave_sum(lg[e]); mx = fmaxf(mx, lg[e]); }
        float sum = 0.f;
#pragma unroll
        for (int e = 0; e < NE; ++e) { lg[e] = expf(lg[e] - mx); sum += lg[e]; }
        float mine = 0.f;
#pragma unroll
        for (int e = 0; e < NE; ++e) mine = (c.lane == e) ? lg[e] / sum : mine;
        if (c.lane < NE) c.wsp<float>(WS_AFF)[(size_t)r * NE + c.lane] = mine;
    }
}

__device__ __forceinline__ void topk_unit(const Ctx& c, int e, int row0, int n, int K, int slot0) {
    unsigned* sh = (unsigned*)c.smem;
    const int tid = c.tid, lane = c.lane, wave = c.wave;
    const float* aff = c.wsp<float>(WS_AFF);
    unsigned key[32];
#pragma unroll
    for (int j = 0; j < 32; ++j) { const int t = tid + NTHREADS * j; key[j] = t < n ? __float_as_uint(aff[(size_t)(row0 + t) * NE + e]) : 0u; }
    unsigned T = 0u;
#pragma unroll 1
    for (int bit = 30; bit >= 0; bit -= 2) {
        const unsigned t1 = T | (1u << bit), t2 = T | (2u << bit), t3 = T | (3u << bit);
        unsigned c1 = 0u, c2 = 0u, c3 = 0u;
#pragma unroll
        for (int j = 0; j < 32; ++j) { c1 += key[j] >= t1 ? 1u : 0u; c2 += key[j] >= t2 ? 1u : 0u; c3 += key[j] >= t3 ? 1u : 0u; }
#pragma unroll
        for (int o = 1; o < 64; o <<= 1) { c1 += __shfl_xor(c1, o); c2 += __shfl_xor(c2, o); c3 += __shfl_xor(c3, o); }
        __syncthreads();
        if (lane == 0) { sh[wave] = c1; sh[8 + wave] = c2; sh[16 + wave] = c3; }
        __syncthreads();
        unsigned s1 = 0u, s2 = 0u, s3 = 0u;
#pragma unroll
        for (int w = 0; w < 8; ++w) { s1 += sh[w]; s2 += sh[8 + w]; s3 += sh[16 + w]; }
        T = s3 >= (unsigned)K ? t3 : (s2 >= (unsigned)K ? t2 : (s1 >= (unsigned)K ? t1 : T));
    }
    unsigned ng = 0u, neq = 0u;
#pragma unroll
    for (int j = 0; j < 32; ++j) { ng += key[j] > T ? 1u : 0u; neq += (key[j] == T && tid + NTHREADS * j < n) ? 1u : 0u; }
    unsigned ig = ng, ie = neq;
#pragma unroll
    for (int o = 1; o < 64; o <<= 1) { const unsigned a = __shfl_up(ig, o), b = __shfl_up(ie, o); if (lane >= o) { ig += a; ie += b; } }
    __syncthreads();
    if (lane == 63) { sh[32 + wave] = ig; sh[40 + wave] = ie; }
    __syncthreads();
    unsigned og = 0u, oe = 0u, totg = 0u, tote = 0u;
#pragma unroll
    for (int w = 0; w < 8; ++w) { const unsigned a = sh[32 + w], b = sh[40 + w]; if (w < wave) { og += a; oe += b; } totg += a; tote += b; }
    const unsigned need = (unsigned)K - totg;
    unsigned pg = og + ig - ng;
    int* IDX = c.wsp<int>(WS_IDX) + (size_t)e * SLOTS; float* GS = c.wsp<float>(WS_GSEL) + (size_t)e * SLOTS; int* SL = c.wsp<int>(WS_SLOT) + (size_t)e * MR;
    if (tote == need) {
        unsigned pe = totg + oe + ie - neq;
#pragma unroll
        for (int j = 0; j < 32; ++j) { const int t = tid + NTHREADS * j;
            if (t < n) { int slot = -1; if (key[j] > T) slot = (int)pg++; else if (key[j] == T) slot = (int)pe++;
                SL[row0 + t] = slot >= 0 ? slot0 + slot : -1; if (slot >= 0) { IDX[slot0 + slot] = row0 + t; GS[slot0 + slot] = __uint_as_float(key[j]); } } }
    } else {
        unsigned base_eq = 0u;
#pragma unroll 1
        for (int j = 0; j < 32; ++j) { const int t = tid + NTHREADS * j;
            const unsigned kj = t < n ? __float_as_uint(aff[(size_t)(row0 + t) * NE + e]) : 0u;
            const bool eq = t < n && kj == T;
            const unsigned long long me = __ballot(eq);
            const unsigned long long lower = (lane == 0) ? 0ull : (~0ull >> (64 - lane));
            const unsigned re = (unsigned)__popcll(me & lower);
            __syncthreads();
            if (lane == 0) sh[48 + wave] = (unsigned)__popcll(me);
            __syncthreads();
            unsigned oq = 0u, tq = 0u;
#pragma unroll
            for (int w = 0; w < 8; ++w) { const unsigned a = sh[48 + w]; if (w < wave) oq += a; tq += a; }
            if (t < n) { int slot = -1; if (kj > T) slot = (int)pg++; else if (eq) { const unsigned rk = base_eq + oq + re; if (rk < need) slot = (int)(totg + rk); }
                SL[row0 + t] = slot >= 0 ? slot0 + slot : -1; if (slot >= 0) { IDX[slot0 + slot] = row0 + t; GS[slot0 + slot] = __uint_as_float(kj); } }
            base_eq += tq;
        }
    }
    __syncthreads();
}
__device__ __forceinline__ void ph_g(const Ctx& c) {
    for (int u = c.bid; u < 32; u += c.nb) {
        if (u < 16) topk_unit(c, u, 0, L, CAP, 0);
        else { const int e = u - 16; topk_unit(c, e, L, LC, CAPC, CAP);
            for (int s = CAP + CAPC + c.tid; s < SLOTS; s += NTHREADS) { c.wsp<int>(WS_IDX)[(size_t)e * SLOTS + s] = 0; c.wsp<float>(WS_GSEL)[(size_t)e * SLOTS + s] = 0.f; } }
    }
}

struct EpiGate { float* tmp; __device__ __forceinline__ void operator()(int row, int col, const float (&v)[8]) const {
    float* p = tmp + (size_t)row * DF + col; *(float4*)p = make_float4(v[0], v[1], v[2], v[3]); *(float4*)(p + 4) = make_float4(v[4], v[5], v[6], v[7]); } };
struct EpiUp { const float* tmp; bf16_t* act; __device__ __forceinline__ void operator()(int row, int col, const float (&v)[8]) const {
    const float* p = tmp + (size_t)row * DF + col; const float4 a0 = *(const float4*)p, a1 = *(const float4*)(p + 4);
    const float a[8] = {a0.x, a0.y, a0.z, a0.w, a1.x, a1.y, a1.z, a1.w}; float t[8];
#pragma unroll
    for (int j = 0; j < 8; ++j) t[j] = silu_f(a[j]) * v[j];
    uint4 o; o.x = pk2(t[0], t[1]); o.y = pk2(t[2], t[3]); o.z = pk2(t[4], t[5]); o.w = pk2(t[6], t[7]);
    *(uint4*)(act + (size_t)row * DF + col) = o; } };
struct EpiDown { bf16_t* ye; __device__ __forceinline__ void operator()(int row, int col, const float (&v)[8]) const {
    uint4 o; o.x = pk2(v[0], v[1]); o.y = pk2(v[2], v[3]); o.z = pk2(v[4], v[5]); o.w = pk2(v[6], v[7]);
    *(uint4*)(ye + (size_t)row * D + col) = o; } };
__device__ __forceinline__ void ph_h(const Ctx& c, int layer) {
    const int nM = SLOTS / 128, nN = DF / 128;
    for (int which = 0; which < 2; ++which)
        for (int u = c.bid; u < NE * nM * nN; u += c.nb) {
            const int e = u / (nM * nN), r = u % (nM * nN), pm = r % nM, pn = r / nM;
            const RowGather rp{c.wsp<bf16_t>(WS_H2), D, c.wsp<int>(WS_IDX) + (size_t)e * SLOTS};
            float* tmp = c.wsp<float>(WS_TMP) + (size_t)e * SLOTS * DF;
            const float* W = c.in[which == 0 ? 28 : 29] + ((size_t)layer * NE + e) * D * DF;
            if (which == 0) { const EpiGate ep{tmp}; sgemm_unit(rp, W, DF, D, pm * 128, pn * 128, ep, (float*)c.smem, c.tid); }
            else { const EpiUp ep{tmp, c.wsp<bf16_t>(WS_ACT) + (size_t)e * SLOTS * DF}; sgemm_unit(rp, W, DF, D, pm * 128, pn * 128, ep, (float*)c.smem, c.tid); }
        }
}
__device__ __forceinline__ void ph_i(const Ctx& c, int layer) {
    const int nM = SLOTS / 128, nN = D / 128;
    for (int u = c.bid; u < NE * nM * nN; u += c.nb) {
        const int e = u / (nM * nN), r = u % (nM * nN), pm = r % nM, pn = r / nM;
        const RowLin rp{c.wsp<bf16_t>(WS_ACT) + (size_t)e * SLOTS * DF, DF};
        const EpiDown ep{c.wsp<bf16_t>(WS_YE) + (size_t)e * SLOTS * D};
        const float* W = c.in[30] + ((size_t)layer * NE + e) * DF * D;
        sgemm_unit(rp, W, D, DF, pm * 128, pn * 128, ep, (float*)c.smem, c.tid);
    }
}

__device__ __forceinline__ void ph_j(const Ctx& c, int layer) {
    const int gw = c.bid * 8 + c.wave, ngw = c.nb * 8;
    const int nrows = layer == 0 ? MR : L;
    for (int r = gw; r < nrows; r += ngw) {
        const float* x1 = c.wsp<float>(WS_XA) + (size_t)r * D;
        const float* g5 = c.mod(layer, r < L ? 0 : 1, 5);
        float* o = layer == 0 ? c.wsp<float>(WS_XB) + (size_t)r * D : c.out + (size_t)r * D;
        float acc[32];
#pragma unroll
        for (int j = 0; j < 32; ++j) acc[j] = 0.f;
        for (int e = 0; e < NE; ++e) {
            const int s = c.wsp<int>(WS_SLOT)[(size_t)e * MR + r];
            if (s >= 0) {
                const float gs = c.wsp<float>(WS_GSEL)[(size_t)e * SLOTS + s];
                const bf16_t* y = c.wsp<bf16_t>(WS_YE) + ((size_t)e * SLOTS + s) * D;
#pragma unroll
                for (int j = 0; j < 8; ++j) { const uint2 w = *(const uint2*)(y + 4 * c.lane + 256 * j);
                    acc[4 * j + 0] = fmaf(gs, __uint_as_float(w.x << 16), acc[4 * j + 0]); acc[4 * j + 1] = fmaf(gs, __uint_as_float(w.x & 0xffff0000u), acc[4 * j + 1]);
                    acc[4 * j + 2] = fmaf(gs, __uint_as_float(w.y << 16), acc[4 * j + 2]); acc[4 * j + 3] = fmaf(gs, __uint_as_float(w.y & 0xffff0000u), acc[4 * j + 3]); }
            }
        }
#pragma unroll
        for (int j = 0; j < 8; ++j) { const int col = 4 * c.lane + 256 * j; const float4 xv = *(const float4*)(x1 + col), gv = *(const float4*)(g5 + col);
            *(float4*)(o + col) = make_float4(xv.x + gv.x * acc[4 * j], xv.y + gv.y * acc[4 * j + 1], xv.z + gv.z * acc[4 * j + 2], xv.w + gv.w * acc[4 * j + 3]); }
    }
}


#ifndef FAST_B
#define FAST_B 1
#endif
#ifndef FAST_DE
#define FAST_DE 1
#endif
#ifndef FAST_HI
#define FAST_HI 1
#endif
__device__ __forceinline__ void ph_b_fast(const Ctx& c, int layer) {
    LAS unsigned char* lds = (LAS unsigned char*)c.smem;
    const char* WIN = (const char*)(c.ws + WS_WIN); const char* HX = (const char*)(c.ws + WS_HX);
    __syncthreads();
    {
        const pg8::GeomLin G{WIN, HX, D, D, D, nullptr}; pg8::StaticOrder S; S.init(3072 / 256, MR / 256, c.nb, c.bid);
        const pg8::EpiBf16Plain E{c.wsp<bf16_t>(WS_ZHYT), MR, 0};
        pg8::gemm_phase(lds, G, S, E);
    }
    {
        const pg8::GeomLin G{HX, WIN + (size_t)OFF_WAQ * D * 2, D, D, D, nullptr}; pg8::StaticOrder S; S.init(MR / 256, (NIN - OFF_WAQ) / 256, c.nb, c.bid);
        const pg8::EpiInRest E{c.ws};
        pg8::gemm_phase(lds, G, S, E);
    }
}
__device__ __forceinline__ void ph_d_fast(const Ctx& c, int layer) {
    LAS unsigned char* lds = (LAS unsigned char*)c.smem;
    const int nM = layer == 0 ? MR / 256 : L / 256;
    pg8::StaticOrder S; S.init(nM, D / 256, c.nb, c.bid);
    __syncthreads();
    { const pg8::GeomLin G{(const char*)(c.ws + WS_YHY), (const char*)(c.ws + WS_WBR), 1024, 1024, 1024, nullptr}; const pg8::EpiMergeF<0> E{c.ws}; pg8::gemm_phase(lds, G, S, E); }
    { const pg8::GeomLin G{(const char*)(c.ws + WS_YWA), (const char*)(c.ws + WS_WBR) + (size_t)D * 1024 * 2, 1024, 1024, 1024, nullptr}; const pg8::EpiMergeF<1> E{c.ws}; pg8::gemm_phase(lds, G, S, E); }
    { const pg8::GeomLin G{(const char*)(c.ws + WS_YNA), (const char*)(c.ws + WS_WBR) + (size_t)2 * D * 1024 * 2, 1024, 1024, 1024, nullptr}; const pg8::EpiMergeF<2> E{c.ws}; pg8::gemm_phase(lds, G, S, E); }
}
__device__ __forceinline__ void ph_e_fast(const Ctx& c, int layer) {
    LAS unsigned char* lds = (LAS unsigned char*)c.smem;
    const int nM = layer == 0 ? MR / 256 : L / 256;
    pg8::StaticOrder S; S.init(nM, D / 256, c.nb, c.bid);
    __syncthreads();
    const pg8::GeomLin G{(const char*)(c.ws + WS_MB), (const char*)(c.ws + WS_WOUT), D, D, D, nullptr}; const pg8::EpiOutF E{&c, layer};
    pg8::gemm_phase(lds, G, S, E);
}
__device__ __forceinline__ void ph_h_fast(const Ctx& c, int layer) {
    LAS unsigned char* lds = (LAS unsigned char*)c.smem;
    const int tpe = layer == 0 ? 9 : 8;
    pg8::StaticOrder S; S.init(NE * tpe, 2048 / 256, c.nb, c.bid);
    __syncthreads();
    const pg8::GeomExpert<true> G{(const char*)(c.ws + WS_H2), (const char*)(c.ws + WS_WGU), D, D, D, c.wsp<int>(WS_IDX), tpe, 2048};
    const pg8::EpiGU E{c.wsp<bf16_t>(WS_ACT)};
    pg8::gemm_phase(lds, G, S, E);
}
__device__ __forceinline__ void ph_i_fast(const Ctx& c, int layer) {
    LAS unsigned char* lds = (LAS unsigned char*)c.smem;
    const int tpe = layer == 0 ? 9 : 8;
    pg8::StaticOrder S; S.init(NE * tpe, D / 256, c.nb, c.bid);
    __syncthreads();
    const pg8::GeomExpert<false> G{(const char*)(c.ws + WS_ACT), (const char*)(c.ws + WS_WDN), DF, DF, DF, nullptr, tpe, D};
    const pg8::EpiBf16Plain E{c.wsp<bf16_t>(WS_YE), D, 0};
    pg8::gemm_phase(lds, G, S, E);
}

__global__ void __launch_bounds__(NTHREADS, 2) mega(KArgs a) {
    extern __shared__ __attribute__((aligned(16))) unsigned char smem[];
    Ctx c; c.in = a.in; c.out = a.out; c.ws = a.ws; c.bid = blockIdx.x; c.nb = gridDim.x; c.tid = threadIdx.x; c.lane = c.tid & 63;
    c.wave = __builtin_amdgcn_readfirstlane(c.tid >> 6); c.smem = smem;
    volatile LAS unsigned* st = (volatile LAS unsigned*)(LAS unsigned char*)(smem + LDS_BYTES - 16);
    if (c.tid == 0) { st[0] = 0u; st[1] = 0u; st[2] = 0u; st[3] = 0u; }
    __syncthreads();
    const int lo = a.ph_lo, hi = a.ph_hi;
    XcdBarrier bar; bar.bar = (unsigned*)(a.ws + WS_CTL); bar.x = 0; bar.st = st;
    if (hi - lo > 1) bar = xcd_barrier_post((unsigned*)(a.ws + WS_CTL), st);
#ifndef ONLY_PH
#define ONLY_PH -1
#endif
#define PSEL(j) (ONLY_PH < 0 || ONLY_PH == (j))

#define IN(k) (lo <= (k) && (k) < hi)
#define GASP __attribute__((address_space(1)))
#define LAUNDER(cc) Ctx cc = c; asm volatile("" : "+v"(cc.tid), "+v"(cc.lane)); asm volatile("" : "+s"(cc.bid), "+s"(cc.nb), "+s"(cc.wave)); \
    { GASP unsigned char* wg_ = (GASP unsigned char*)cc.ws; GASP float* og_ = (GASP float*)cc.out; asm volatile("" : "+s"(wg_), "+s"(og_)); cc.ws = (unsigned char*)wg_; cc.out = (float*)og_; }
#define SEAM(k) do { if (IN(k) && IN((k) + 1)) xcd_barrier(bar); } while (0)
    if (PSEL(0) && IN(0)) { LAUNDER(cc); ph_g0(cc); if (hi - lo > 1) xcd_barrier(bar); LAUNDER(cd); ph_g0b(cd); } SEAM(0);
#define LAYER_PROGRAM(layer) do { const int b = 1 + (layer) * PH_PER_LAYER; \
        if (PSEL(1) && IN(b + 0)) { LAUNDER(cc); constexpr int ly = (layer); { ph_a(cc, ly); if constexpr (DOREP(15)) { LAUNDER(ce); ph_a(ce, ly); } ph_taps(cc, ly); if constexpr (DOREP(14)) { LAUNDER(ce); ph_taps(ce, ly); } if (FAST_B || FAST_DE || FAST_HI) ph_conv(cc, ly); if constexpr (DOREP(13)) { LAUNDER(ce); ph_conv(ce, ly); } __syncthreads(); } if constexpr (DOREP(1)) { LAUNDER(cd); { Ctx& cc = cd; (void)cc; ph_a(cd, ly); ph_taps(cd, ly); if (FAST_B || FAST_DE || FAST_HI) ph_conv(cd, ly); __syncthreads(); } } } SEAM(b + 0); \
        if (PSEL(2) && IN(b + 1)) { LAUNDER(cc); constexpr int ly = (layer); { if (FAST_B) ph_b_fast(cc, ly); else ph_b(cc, ly); __syncthreads(); } if constexpr (DOREP(2)) { LAUNDER(cd); { Ctx& cc = cd; (void)cc; if (FAST_B) ph_b_fast(cd, ly); else ph_b(cd, ly); __syncthreads(); } } } SEAM(b + 1); \
        if (PSEL(3) && IN(b + 2)) { LAUNDER(cc); constexpr int ly = (layer); ph_b2(cc, ly); } SEAM(b + 2); \
        if (PSEL(4) && IN(b + 3)) { LAUNDER(cc); constexpr int ly = (layer); { ph_c(cc, ly); __syncthreads(); } if constexpr (DOREP(4)) { LAUNDER(cd); { Ctx& cc = cd; (void)cc; ph_c(cd, ly); __syncthreads(); } } } SEAM(b + 3); \
        if (PSEL(5) && IN(b + 4)) { LAUNDER(cc); constexpr int ly = (layer); { ph_c2(cc); __syncthreads(); } if constexpr (DOREP(5)) { LAUNDER(cd); { Ctx& cc = cd; (void)cc; ph_c2(cd); __syncthreads(); } } } SEAM(b + 4); \
        if (PSEL(6) && IN(b + 5)) { LAUNDER(cc); constexpr int ly = (layer); { if (FAST_DE) ph_d_fast(cc, ly); else ph_d(cc, ly); __syncthreads(); } if constexpr (DOREP(6)) { LAUNDER(cd); { Ctx& cc = cd; (void)cc; if (FAST_DE) ph_d_fast(cd, ly); else ph_d(cd, ly); __syncthreads(); } } } SEAM(b + 5); \
        if (PSEL(7) && IN(b + 6)) { LAUNDER(cc); constexpr int ly = (layer); { if (FAST_DE) ph_e_fast(cc, ly); else ph_e(cc, ly); __syncthreads(); } if constexpr (DOREP(7)) { LAUNDER(cd); { Ctx& cc = cd; (void)cc; if (FAST_DE) ph_e_fast(cd, ly); else ph_e(cd, ly); __syncthreads(); } } } SEAM(b + 6); \
        if (PSEL(8) && IN(b + 7)) { LAUNDER(cc); constexpr int ly = (layer); { ph_f(cc, ly); __syncthreads(); } if constexpr (DOREP(8)) { LAUNDER(cd); { Ctx& cc = cd; (void)cc; ph_f(cd, ly); __syncthreads(); } } } SEAM(b + 7); \
        if (PSEL(9) && IN(b + 8)) { LAUNDER(cc); constexpr int ly = (layer); { ph_g(cc); __syncthreads(); } if constexpr (DOREP(9)) { LAUNDER(cd); { Ctx& cc = cd; (void)cc; ph_g(cd); __syncthreads(); } } } SEAM(b + 8); \
        if (PSEL(10) && IN(b + 9)) { LAUNDER(cc); constexpr int ly = (layer); { if (FAST_HI) ph_h_fast(cc, ly); else ph_h(cc, ly); __syncthreads(); } if constexpr (DOREP(10)) { LAUNDER(cd); { Ctx& cc = cd; (void)cc; if (FAST_HI) ph_h_fast(cd, ly); else ph_h(cd, ly); __syncthreads(); } } } SEAM(b + 9); \
        if (PSEL(11) && IN(b + 10)) { LAUNDER(cc); constexpr int ly = (layer); { if (FAST_HI) ph_i_fast(cc, ly); else ph_i(cc, ly); __syncthreads(); } if constexpr (DOREP(11)) { LAUNDER(cd); { Ctx& cc = cd; (void)cc; if (FAST_HI) ph_i_fast(cd, ly); else ph_i(cd, ly); __syncthreads(); } } } SEAM(b + 10); \
        if (PSEL(12) && IN(b + 11)) { LAUNDER(cc); constexpr int ly = (layer); { ph_j(cc, ly); __syncthreads(); } if constexpr (DOREP(12)) { LAUNDER(cd); { Ctx& cc = cd; (void)cc; ph_j(cd, ly); __syncthreads(); } } } SEAM(b + 11); \
    } while (0)
    LAYER_PROGRAM(0);
    LAYER_PROGRAM(1);
#undef LAYER_PROGRAM
#undef IN
#undef SEAM
}

extern "C" void kernel_launch(void* const* d_in, const int* in_sizes, int n_in, void* d_out, int out_size, void* d_ws, size_t ws_size, hipStream_t stream) {
    static int grid = 0;
    if (grid == 0) {
        if (n_in != 31 || out_size != L * D || ws_size < WS_END) { fprintf(stderr, "kernel_launch: unexpected shapes: n_in %d out %d ws %zu (need %zu)\n", n_in, out_size, ws_size, (size_t)WS_END); grid = -1; return; }
        int dev = 0, cus = 0, per_cu = 0;
        if (hipGetDevice(&dev) != hipSuccess || hipDeviceGetAttribute(&cus, hipDeviceAttributeMultiprocessorCount, dev) != hipSuccess) { grid = -1; return; }
        if (hipFuncSetAttribute((const void*)mega, hipFuncAttributeMaxDynamicSharedMemorySize, LDS_BYTES) != hipSuccess) { fprintf(stderr, "kernel_launch: hipFuncSetAttribute failed\n"); grid = -1; return; }
        if (hipOccupancyMaxActiveBlocksPerMultiprocessor(&per_cu, (const void*)mega, NTHREADS, LDS_BYTES) != hipSuccess || per_cu < 1) fprintf(stderr, "kernel_launch: occupancy query says %d\n", per_cu);
        (void)hipGetLastError();
        grid = cus;
    }
    if (grid < 0) return;
    if (hipMemsetAsync((char*)d_ws + WS_CTL, 0, CTL_BYTES, stream) != hipSuccess) return;
    KArgs a{};
    for (int i = 0; i < 31; ++i) a.in[i] = (const float*)d_in[i];
    a.out = (float*)d_out; a.ws = (unsigned char*)d_ws;
#if ONE_LAUNCH
    a.ph_lo = 0; a.ph_hi = NPH;
    hipLaunchKernelGGL(mega, dim3(grid), dim3(NTHREADS), LDS_BYTES, stream, a);
#else
    for (int p = 0; p < NPH; ++p) { a.ph_lo = p; a.ph_hi = p + 1; hipLaunchKernelGGL(mega, dim3(grid), dim3(NTHREADS), LDS_BYTES, stream, a); }
#endif
    const hipError_t le = hipPeekAtLastError();
    if (le != hipSuccess) fprintf(stderr, "kernel_launch: launch failed: %s\n", hipGetErrorName(le));
}
```

```cpp
#include <hip/hip_runtime.h>
#include <stdint.h>
#include <stdio.h>

#ifndef ONE_LAUNCH
#define ONE_LAUNCH 1
#endif

#ifndef REP_MASK
#define REP_MASK 0
#endif
#define DOREP(j) ((((REP_MASK) >> (j)) & 1) != 0)
typedef unsigned short bf16_t;
#define LAS __attribute__((address_space(3)))

constexpr int L = 16384, LC = 256, MR = L + LC, D = 2048, NIN = 13824;
constexpr int HD = 128, GRIDW = 64;
constexpr int OFF_HY = 0, OFF_WAQ = 3072, OFF_WAKV = 4096, OFF_NAQ = 4608, OFF_NAKV = 5632, OFF_GATE = 7680;
constexpr int NE = 16, CAP = 2048, CAPC = 32, SLOTS = 2304, DF = 1024;
constexpr int NMOD = 6 * D;
constexpr float RMS_EPS = 1e-6f;
constexpr float QK_SCALE = 0.08838834764831845f;

constexpr size_t al256(size_t x) { return (x + 255) & ~(size_t)255; }
constexpr size_t WS_CTL = 0, CTL_BYTES = 1u << 20;
constexpr size_t WS_MOD = WS_CTL + CTL_BYTES;
constexpr size_t WS_H2B = WS_MOD + al256((size_t)2 * 2 * NMOD * 4);
constexpr size_t WS_FW3T = WS_H2B + al256((size_t)2 * MR * 256 * 2);
constexpr size_t WS_AFF = WS_FW3T + al256((size_t)2 * 4096 * 256 * 2);
constexpr size_t WS_IDX = WS_AFF + al256((size_t)MR * 16 * 4);
constexpr size_t WS_GSEL = WS_IDX + al256((size_t)NE * SLOTS * 4);
constexpr size_t WS_SLOT = WS_GSEL + al256((size_t)NE * SLOTS * 4);
constexpr size_t WS_KFC = WS_SLOT + al256((size_t)NE * MR * 4);
constexpr size_t WS_ZHYC = WS_KFC + al256((size_t)4096 * LC * 2);
constexpr size_t WS_XA = WS_ZHYC + al256((size_t)3072 * LC * 2);
constexpr size_t WS_XB = WS_XA + al256((size_t)MR * D * 4);
constexpr size_t WS_W = WS_XB + al256((size_t)MR * D * 4);
constexpr size_t W_BYTES = (size_t)2 * ((size_t)NIN * D + 3 * (size_t)D * 1024 + (size_t)D * D + (size_t)NE * 2048 * D + (size_t)NE * D * DF);
constexpr size_t WS_WIN = WS_W;
constexpr size_t WS_WBR = WS_WIN + (size_t)NIN * D * 2;
constexpr size_t WS_WOUT = WS_WBR + (size_t)3 * D * 1024 * 2;
constexpr size_t WS_WGU = WS_WOUT + (size_t)D * D * 2;
constexpr size_t WS_WDN = WS_WGU + (size_t)NE * 2048 * D * 2;
constexpr size_t WS_R3 = WS_W + al256(W_BYTES);
constexpr size_t R3_BYTES = (size_t)MR * D * 4 + (size_t)MR * D * 2;
constexpr size_t WS_KF = WS_R3;
constexpr size_t WS_KS = WS_R3 + al256((size_t)4096 * L * 2);
constexpr size_t WS_MPART = WS_R3;
constexpr size_t WS_MB = WS_R3 + (size_t)MR * D * 4;
constexpr size_t WS_TMP = WS_R3;
constexpr size_t WS_YE = WS_R3;
constexpr size_t WS_R4 = WS_R3 + al256(R3_BYTES);
constexpr size_t R4_BYTES = (size_t)MR * 6144 * 2;
constexpr size_t WS_GATE = WS_R4;
constexpr size_t WS_H2 = WS_R4;
constexpr size_t WS_ACT = WS_R4 + al256((size_t)MR * D * 2);
constexpr size_t WS_R5 = WS_R4 + al256(R4_BYTES);
constexpr size_t WS_MODPART = WS_R5;
constexpr size_t WS_HX = WS_R5;
constexpr size_t WS_YHYT = WS_R5;
constexpr size_t WS_YHY = WS_R5 + al256((size_t)1024 * L * 2);
constexpr size_t WS_ZHYT = WS_R5 + al256((size_t)MR * D * 2);
constexpr size_t WS_QWA = WS_ZHYT + al256((size_t)3072 * MR * 2);
constexpr size_t WS_KVWA = WS_QWA + al256((size_t)MR * 1024 * 2);
constexpr size_t WS_QNA = WS_KVWA + al256((size_t)MR * 512 * 2);
constexpr size_t WS_KVNA = WS_QNA + al256((size_t)MR * 1024 * 2);
constexpr size_t WS_YWA = WS_KVNA + al256((size_t)MR * 2048 * 2);
constexpr size_t WS_YNA = WS_YWA + al256((size_t)MR * 1024 * 2);
constexpr size_t WS_END = WS_YNA + al256((size_t)MR * 1024 * 2);
static_assert((size_t)1024 * L * 2 + (size_t)MR * 1024 * 2 <= (size_t)MR * D * 2 + 512, "YHYT+YHY overlay HX");
static_assert((size_t)4096 * L * 2 + 256 + (size_t)256 * 2 * 16384 * 8 <= R3_BYTES && (size_t)NE * SLOTS * D * 2 <= R3_BYTES && (size_t)NE * SLOTS * DF * 4 <= R3_BYTES, "R3");
static_assert((size_t)MR * D * 2 + 256 + (size_t)NE * SLOTS * DF * 2 <= R4_BYTES, "R4");

constexpr int LDS_BYTES = 160 * 1024;
constexpr int NTHREADS = 512;
constexpr int PH_PER_LAYER = 12, NPH = 1 + 2 * PH_PER_LAYER;

__device__ __forceinline__ float bf2f(bf16_t b) { return __uint_as_float(((unsigned)b) << 16); }
__device__ __forceinline__ bf16_t f2bf(float f) { unsigned u = __float_as_uint(f); u += 0x7fffu + ((u >> 16) & 1u); return (bf16_t)(u >> 16); }
__device__ __forceinline__ unsigned pk2(float lo, float hi) { return (unsigned)f2bf(lo) | ((unsigned)f2bf(hi) << 16); }
__device__ __forceinline__ float wave_sum(float v) {
#pragma unroll
    for (int o = 1; o < 64; o <<= 1) v += __shfl_xor(v, o);
    return v;
}
__device__ __forceinline__ float wave_max(float v) {
#pragma unroll
    for (int o = 1; o < 64; o <<= 1) v = fmaxf(v, __shfl_xor(v, o));
    return v;
}
__device__ __forceinline__ float silu_f(float x) { return x * __builtin_amdgcn_rcpf(1.f + __expf(-x)); }
__device__ __forceinline__ float sigmoid_f(float x) { return __builtin_amdgcn_rcpf(1.f + __expf(-x)); }
#define LDS_FENCE() asm volatile("s_waitcnt lgkmcnt(0)" ::: "memory")

#define XB_TMO      128
#define XB_XCNT(j)  (256  + 64 * (j))
#define XB_XSUB(j)  (1280 + 64 * (j))
#define XB_XGEN(j)  (2304 + 64 * (j))
#define XB_TOP      3328
#define XB_TOPGEN   3392
#define XCD_BAR_WORDS 3456
#define XB_SPIN_CAP (1u << 22)

__device__ __forceinline__ unsigned xb_ld(unsigned* p)              { return __hip_atomic_load(p, __ATOMIC_RELAXED, __HIP_MEMORY_SCOPE_AGENT); }
__device__ __forceinline__ unsigned xb_add(unsigned* p, unsigned v) { return __hip_atomic_fetch_add(p, v, __ATOMIC_RELAXED, __HIP_MEMORY_SCOPE_AGENT); }
__device__ __forceinline__ unsigned xb_xcc_id() { return (unsigned)__builtin_amdgcn_s_getreg((3 << 11) | 20) & 0xFu; }
#define XB_SPIN(cond, bar) do { unsigned _sp = 0; while (cond) { __builtin_amdgcn_s_sleep(1); \
    if ((++_sp & 255u) == 0u) { if (xb_ld(&(bar)[XB_TMO])) break; if (_sp > XB_SPIN_CAP) { atomicAdd(&(bar)[XB_TMO], 1u); break; } } } } while (0)

struct XcdBarrier { unsigned* bar; unsigned x; volatile LAS unsigned* st; };

__device__ __forceinline__ XcdBarrier xcd_barrier_post(unsigned* bar, volatile LAS unsigned* st) {
    XcdBarrier b; b.bar = bar; b.x = xb_xcc_id(); b.st = st;
    if (threadIdx.x == 0) (void)xb_add(&bar[XB_XCNT(b.x)], 1u);
    return b;
}
__device__ __forceinline__ void xcd_barrier_complete(unsigned* bar, unsigned x, unsigned& nloc, unsigned& nx) {
    const unsigned G = gridDim.x * gridDim.y * gridDim.z;
    unsigned sum, cnt, mine, sp = 0u;
    for (;;) {
        sum = 0u; cnt = 0u; mine = 0u;
#pragma unroll
        for (unsigned j = 0; j < 16; ++j) { const unsigned c = xb_ld(&bar[XB_XCNT(j)]); sum += c; cnt += (c > 0u) ? 1u : 0u; mine = (j == x) ? c : mine; }
        if (sum == G) break;
        __builtin_amdgcn_s_sleep(1);
        if ((++sp & 255u) == 0u) { if (xb_ld(&bar[XB_TMO])) break; if (sp > XB_SPIN_CAP) { atomicAdd(&bar[XB_TMO], 1u); break; } }
    }
    nloc = mine > 0u ? mine : 1u; nx = cnt > 0u ? cnt : 1u;
}
__device__ __forceinline__ void xcd_barrier(const XcdBarrier& b) {
    asm volatile("s_waitcnt vmcnt(0)" ::: "memory");
    __syncthreads();
    if (threadIdx.x == 0) {
        unsigned* bar = b.bar;
        __builtin_amdgcn_s_waitcnt(0);
        unsigned nloc = b.st[0], nx = b.st[1];
        if (nloc == 0u) { xcd_barrier_complete(bar, b.x, nloc, nx); b.st[0] = nloc; b.st[1] = nx; }
        const unsigned old = xb_add(&bar[XB_XSUB(b.x)], 1u);
        const unsigned gen = old / nloc;
        if (old + 1u == (gen + 1u) * nloc) {
            __builtin_amdgcn_fence(__ATOMIC_RELEASE, "agent");
            asm volatile("s_waitcnt vmcnt(0)" ::: "memory");
            const unsigned og = xb_add(&bar[XB_TOP], 1u);
            const unsigned tg = og / nx;
            if (og + 1u == (tg + 1u) * nx) xb_add(&bar[XB_TOPGEN], 1u);
            else XB_SPIN(xb_ld(&bar[XB_TOPGEN]) == tg, bar);
            __builtin_amdgcn_fence(__ATOMIC_ACQUIRE, "agent");
            xb_add(&bar[XB_XGEN(b.x)], 1u);
            asm volatile("s_waitcnt vmcnt(0)" ::: "memory");
        } else {
            XB_SPIN(xb_ld(&bar[XB_XGEN(b.x)]) == gen, bar);
            __builtin_amdgcn_fence(__ATOMIC_ACQUIRE, "agent");
            asm volatile("s_waitcnt vmcnt(0)" ::: "memory");
        }
    }
    __syncthreads();
}

struct KArgs { const float* in[31]; float* out; unsigned char* ws; int ph_lo, ph_hi; };

struct Ctx {
    const float* const* in; float* out; unsigned char* ws;
    int bid, nb, tid, lane, wave;
    unsigned char* smem;
    template <class T> __device__ __forceinline__ T* wsp(size_t off) const { return (T*)(ws + off); }
    __device__ __forceinline__ const float* mod(int layer, int src, int chunk) const { return wsp<float>(WS_MOD) + ((size_t)(layer * 2 + src) * NMOD) + chunk * D; }
    __device__ __forceinline__ const float* xrow(int layer, int r) const {
        if (layer == 0) return r < L ? in[0] + (size_t)r * D : in[2] + (size_t)(r - L) * D;
        return wsp<float>(WS_XB) + (size_t)r * D;
    }
};

template <class RowPtr, class Epi>
__device__ __forceinline__ void sgemm_unit(const RowPtr& rp, const float* __restrict__ W, int ldw, int K, int m0, int n0, const Epi& ep, float* lds, int tid) {
    float* As = lds;
    float* Bs = lds + 16 * 132;
    const int ty = tid >> 4, tx = tid & 15;
    const int am = tid >> 2, kq = (tid & 3) * 4;
    const int bk = tid >> 5, n4 = (tid & 31) * 4;
    float acc[4][8];
#pragma unroll
    for (int i = 0; i < 4; ++i)
#pragma unroll
        for (int j = 0; j < 8; ++j) acc[i][j] = 0.f;
    const bf16_t* arow = rp(m0 + am);
    const float* wp = W + (size_t)bk * ldw + n0 + n4;
    for (int k0 = 0; k0 < K; k0 += 16) {
        const uint2 a4 = *(const uint2*)(arow + k0 + kq);
        const float4 b4 = *(const float4*)(wp + (size_t)k0 * ldw);
        __syncthreads();
        As[(kq + 0) * 132 + am] = __uint_as_float(a4.x << 16);
        As[(kq + 1) * 132 + am] = __uint_as_float(a4.x & 0xffff0000u);
        As[(kq + 2) * 132 + am] = __uint_as_float(a4.y << 16);
        As[(kq + 3) * 132 + am] = __uint_as_float(a4.y & 0xffff0000u);
        *(float4*)&Bs[bk * 128 + n4] = b4;
        __syncthreads();
#pragma unroll
        for (int kk = 0; kk < 16; ++kk) {
            const float4 a = *(const float4*)&As[kk * 132 + ty * 4];
            const float4 b0 = *(const float4*)&Bs[kk * 128 + tx * 8];
            const float4 b1 = *(const float4*)&Bs[kk * 128 + tx * 8 + 4];
            const float av[4] = {a.x, a.y, a.z, a.w};
            const float bv[8] = {b0.x, b0.y, b0.z, b0.w, b1.x, b1.y, b1.z, b1.w};
#pragma unroll
            for (int i = 0; i < 4; ++i)
#pragma unroll
                for (int j = 0; j < 8; ++j) acc[i][j] = fmaf(av[i], bv[j], acc[i][j]);
        }
    }
#pragma unroll
    for (int i = 0; i < 4; ++i) ep(m0 + ty * 4 + i, n0 + tx * 8, acc[i]);
}

struct RowLin { const bf16_t* base; int ld; __device__ __forceinline__ const bf16_t* operator()(int m) const { return base + (size_t)m * ld; } };
struct RowGather { const bf16_t* base; int ld; const int* idx; __device__ __forceinline__ const bf16_t* operator()(int m) const { return base + (size_t)idx[m] * ld; } };


namespace pg8 {
typedef short bf16x8 __attribute__((ext_vector_type(8)));
typedef float f32x4 __attribute__((ext_vector_type(4)));
typedef unsigned u32x4 __attribute__((ext_vector_type(4)));
typedef unsigned u32x2 __attribute__((ext_vector_type(2)));
constexpr int BM = 256, BK = 64, HALF = 128, HTB = HALF * BK * 2, STAGE_BYTES = 8 * HTB, NXCD = 8, WGM = 8;
__host__ __device__ __forceinline__ int lds_byte(int r, int c) { const int st = (r >> 4) * 2 + (c >> 5), rr = r & 15, cc = c & 31, ob = rr * 64 + cc * 2; return st * 1024 + (ob ^ (((ob >> 9) & 1) << 5)); }
__host__ __device__ __forceinline__ void stage_rc(int b, int& R, int& C) { const int st = b / 1024, sb = b % 1024, swz = sb ^ (((sb >> 9) & 1) << 5); R = (st >> 1) * 16 + swz / 64; C = (st & 1) * 32 + (swz % 64) / 2; }
__host__ __device__ __forceinline__ int perm32(int rho) { const int n = rho >> 4, i = rho & 15; return 8 * (i >> 2) + 4 * n + (i & 3); }
struct Unit { int pm, pn; };
struct StaticOrder {
    int nM, nN, nwg, G, c;
    __host__ __device__ void init(int nM_, int nN_, int G_, int c_) { nM = nM_; nN = nN_; nwg = nM * nN; G = G_; c = c_; }
    __host__ __device__ bool next(int i, Unit& u) const {
        const long Lq = (long)i * G + c; if (Lq >= nwg) return false;
        int wgid = (int)Lq; { const int q = nwg / NXCD, r = nwg % NXCD, xcd = wgid % NXCD, off = wgid / NXCD; wgid = (xcd < r ? xcd * (q + 1) : r * (q + 1) + (xcd - r) * q) + off; }
        const int nig = WGM * nN, gid = wgid / nig, fm = gid * WGM, gsz = (nM - fm) < WGM ? (nM - fm) : WGM;
        u.pm = fm + ((wgid % nig) % gsz); u.pn = (wgid % nig) / gsz; return true;
    }
};
__device__ __forceinline__ unsigned cvt_pk_bf16(float lo, float hi) { unsigned r; asm volatile("v_cvt_pk_bf16_f32 %0, %1, %2" : "=v"(r) : "v"(lo), "v"(hi)); return r; }

struct GeomLin {
    static constexpr bool GATHER = false;
    const char* A; const char* B; int K, lda, ldb; const int* idx;
    __device__ __forceinline__ const char* a_base(const Unit& u) const { return A + (size_t)u.pm * 256 * lda * 2; }
    __device__ __forceinline__ const char* b_base(const Unit& u) const { return B + (size_t)u.pn * 256 * ldb * 2; }
    __device__ __forceinline__ int row0(const Unit& u) const { return u.pm * 256; }
};
template <bool GATHER_> struct GeomExpert {
    static constexpr bool GATHER = GATHER_;
    const char* A; const char* B; int K, lda, ldb; const int* idx; int tpe, nb;
    __device__ __forceinline__ int row0(const Unit& u) const { const int e = u.pm / tpe, t = u.pm - e * tpe; return e * SLOTS + t * 256; }
    __device__ __forceinline__ const char* a_base(const Unit& u) const { return GATHER_ ? A : A + (size_t)row0(u) * lda * 2; }
    __device__ __forceinline__ const char* b_base(const Unit& u) const { const int e = u.pm / tpe; return B + ((size_t)e * nb + (size_t)u.pn * 256) * ldb * 2; }
};

template <class Epi, class Geom, class Sched>
__device__ __forceinline__ void gemm_phase(LAS unsigned char* lds, const Geom& G, const Sched& S, const Epi& E) {
    const int tid = threadIdx.x, wid = __builtin_amdgcn_readfirstlane(tid >> 6), lane = tid & 63, wr = wid >> 2, wc = wid & 3, fr = lane & 15, fq = lane >> 4;
    const int K = G.K, nt = K / BK;
    int Rs[2], Cs[2]; unsigned vB0[2], vA0[2], vAc[2][2], vAn[2][2];
#pragma unroll
    for (int i = 0; i < 2; ++i) { int R, C; stage_rc(tid * 16 + i * 8192, R, C); Rs[i] = R; Cs[i] = C; const int Rb = Epi::PERM ? ((R & ~31) + perm32(R & 31)) : R;
        vB0[i] = (unsigned)(Rb * G.ldb + C) * 2u; vA0[i] = (unsigned)(R * G.lda + C) * 2u;
#pragma unroll
        for (int h = 0; h < 2; ++h) { vAc[h][i] = 0u; vAn[h][i] = 0u; } }
    const size_t hstepA = (size_t)HALF * G.lda * 2, hstepB = (size_t)HALF * G.ldb * 2;
#define PG8_VOFF(dst, u) do { if constexpr (Geom::GATHER) { const int _r0 = G.row0(u); _Pragma("unroll") for (int _h = 0; _h < 2; ++_h) _Pragma("unroll") for (int _i = 0; _i < 2; ++_i) \
        dst[_h][_i] = ((unsigned)G.idx[_r0 + _h * HALF + Rs[_i]] * (unsigned)G.lda + (unsigned)Cs[_i]) * 2u; } } while (0)
    const size_t kstep = (size_t)(BK * 2);
    const unsigned ldsw = (unsigned)wid * 1024u;
    const int aoff = lds_byte(wr * 64 + fr, fq * 8), boff = lds_byte(wc * 32 + fr, fq * 8);
#define PG8_SA(b, h) (((b) * 2 + (h)) * HTB)
#define PG8_SB(b, h) ((4 + (b) * 2 + (h)) * HTB)
#define PG8_STAGE(bufoff, gbase, v) do { \
        __builtin_amdgcn_global_load_lds((const unsigned*)((const char*)(gbase) + (v)[0]), (LAS unsigned*)(lds + (bufoff) + ldsw), 16, 0, 0); \
        __builtin_amdgcn_global_load_lds((const unsigned*)((const char*)(gbase) + (v)[1]), (LAS unsigned*)(lds + (bufoff) + ldsw + 8192), 16, 0, 0); } while (0)
#define PG8_STA(bufoff, gbase, h, VX) do { if constexpr (Geom::GATHER) { PG8_STAGE(bufoff, gbase, VX[h]); } else { PG8_STAGE(bufoff, (gbase) + (h) * hstepA, vA0); } } while (0)
#define PG8_STB(bufoff, gbase, h) PG8_STAGE(bufoff, (gbase) + (h) * hstepB, vB0)
#define PG8_LDA(dst, b, h) do { _Pragma("unroll") for (int m = 0; m < 4; ++m) _Pragma("unroll") for (int k = 0; k < 2; ++k) dst[m][k] = *(const LAS bf16x8*)(lds + PG8_SA(b, h) + aoff + m * 2048 + k * 1024); } while (0)
#define PG8_LDB(dst, b, h) do { _Pragma("unroll") for (int n = 0; n < 2; ++n) _Pragma("unroll") for (int k = 0; k < 2; ++k) dst[n][k] = *(const LAS bf16x8*)(lds + PG8_SB(b, h) + boff + n * 2048 + k * 1024); } while (0)
#define PG8_MMA(ai, bj, At, Bt) do { __builtin_amdgcn_s_setprio(1); _Pragma("unroll") for (int m = 0; m < 4; ++m) _Pragma("unroll") for (int n = 0; n < 2; ++n) _Pragma("unroll") for (int k = 0; k < 2; ++k) \
        acc[ai][bj][m][n] = __builtin_amdgcn_mfma_f32_16x16x32_bf16(Bt[n][k], At[m][k], acc[ai][bj][m][n], 0, 0, 0); __builtin_amdgcn_s_setprio(0); } while (0)
#define PG8_WAIT_V(n) asm volatile("s_waitcnt vmcnt(" #n ")" ::: "memory")
#define PG8_WAIT_L(n) asm volatile("s_waitcnt lgkmcnt(" #n ")" ::: "memory")
#define PG8_BAR __builtin_amdgcn_s_barrier()
#define PG8_SCHED __builtin_amdgcn_sched_barrier(0)
    Unit cur, nxt; int ui = 0;
    if (!S.next(0, cur)) return;
    f32x4 acc[2][2][4][2];
#pragma unroll
    for (int a = 0; a < 2; ++a)
#pragma unroll
        for (int b = 0; b < 2; ++b)
#pragma unroll
            for (int m = 0; m < 4; ++m)
#pragma unroll
                for (int n = 0; n < 2; ++n) acc[a][b][m][n] = (f32x4){0.f, 0.f, 0.f, 0.f};
    bf16x8 At[4][2], B0[2][2], B1[2][2];
    const char* cA = G.a_base(cur); const char* cB = G.b_base(cur);
    PG8_VOFF(vAc, cur);
    PG8_STB(PG8_SB(0, 0), cB, 0); PG8_STA(PG8_SA(0, 0), cA, 0, vAc); PG8_STB(PG8_SB(0, 1), cB, 1); PG8_STA(PG8_SA(0, 1), cA, 1, vAc);
    if (wr == 1) PG8_BAR;
    PG8_WAIT_V(4); PG8_BAR;
    PG8_STB(PG8_SB(1, 0), cB + kstep, 0); PG8_STA(PG8_SA(1, 0), cA + kstep, 0, vAc); PG8_STB(PG8_SB(1, 1), cB + kstep, 1);
    PG8_WAIT_V(6); PG8_BAR;
    for (;;) {
        const bool has_next = S.next(ui + 1, nxt);
        const char* nA = has_next ? G.a_base(nxt) : cA; const char* nB = has_next ? G.b_base(nxt) : cB;
        if constexpr (Geom::GATHER) { if (has_next) PG8_VOFF(vAn, nxt); else {
#pragma unroll
            for (int h = 0; h < 2; ++h) { vAn[h][0] = vAc[h][0]; vAn[h][1] = vAc[h][1]; } } }
        for (int t = 0; t < nt; t += 2) {
            const bool last = (t == nt - 2);
            const char* a1 = cA + (size_t)(t + 1) * kstep;
            const char* a2 = last ? nA : cA + (size_t)(t + 2) * kstep; const char* b2 = last ? nB : cB + (size_t)(t + 2) * kstep;
            const char* a3 = a2 + kstep; const char* b3 = b2 + kstep;
            unsigned v2[2][2];
#pragma unroll
            for (int h = 0; h < 2; ++h) { v2[h][0] = (Geom::GATHER && last) ? vAn[h][0] : vAc[h][0]; v2[h][1] = (Geom::GATHER && last) ? vAn[h][1] : vAc[h][1]; }
            PG8_LDB(B0, 0, 0); PG8_SCHED; PG8_LDA(At, 0, 0); PG8_STA(PG8_SA(1, 1), a1, 1, vAc);
            PG8_WAIT_L(8); PG8_BAR; PG8_WAIT_L(0); PG8_MMA(0, 0, At, B0); PG8_BAR; PG8_SCHED;
            PG8_LDB(B1, 0, 1); PG8_STB(PG8_SB(0, 0), b2, 0);
            PG8_BAR; PG8_WAIT_L(0); PG8_MMA(0, 1, At, B1); PG8_BAR;
            PG8_LDA(At, 0, 1); PG8_STA(PG8_SA(0, 0), a2, 0, v2);
            PG8_BAR; PG8_WAIT_L(0); PG8_MMA(1, 0, At, B0); PG8_BAR; PG8_SCHED;
            PG8_STB(PG8_SB(0, 1), b2, 1);
            PG8_WAIT_V(6); PG8_BAR; PG8_MMA(1, 1, At, B1); PG8_BAR;
            PG8_LDB(B0, 1, 0); PG8_SCHED; PG8_LDA(At, 1, 0); PG8_STA(PG8_SA(0, 1), a2, 1, v2);
            PG8_WAIT_L(8); PG8_BAR; PG8_WAIT_L(0); PG8_MMA(0, 0, At, B0); PG8_BAR; PG8_SCHED;
            PG8_LDB(B1, 1, 1); PG8_STB(PG8_SB(1, 0), b3, 0);
            PG8_BAR; PG8_WAIT_L(0); PG8_MMA(0, 1, At, B1); PG8_BAR;
            PG8_LDA(At, 1, 1); PG8_STA(PG8_SA(1, 0), a3, 0, v2);
            PG8_BAR; PG8_WAIT_L(0); PG8_MMA(1, 0, At, B0); PG8_BAR; PG8_SCHED;
            PG8_STB(PG8_SB(1, 1), b3, 1);
            PG8_WAIT_V(6); PG8_BAR; PG8_MMA(1, 1, At, B1); PG8_BAR;
        }
        E(acc, cur, G.row0(cur), wr, wc, fr, fq);
        if (!has_next) break;
#pragma unroll
        for (int a = 0; a < 2; ++a)
#pragma unroll
            for (int b = 0; b < 2; ++b)
#pragma unroll
                for (int m = 0; m < 4; ++m)
#pragma unroll
                    for (int n = 0; n < 2; ++n) acc[a][b][m][n] = (f32x4){0.f, 0.f, 0.f, 0.f};
        cur = nxt; cA = nA; cB = nB; ++ui;
#pragma unroll
        for (int h = 0; h < 2; ++h) { vAc[h][0] = vAn[h][0]; vAc[h][1] = vAn[h][1]; }
    }
    PG8_WAIT_V(0);
    if (wr == 0) PG8_BAR;
    PG8_BAR;
#undef PG8_VOFF
#undef PG8_SA
#undef PG8_SB
#undef PG8_STAGE
#undef PG8_STA
#undef PG8_STB
#undef PG8_LDA
#undef PG8_LDB
#undef PG8_MMA
#undef PG8_WAIT_V
#undef PG8_WAIT_L
#undef PG8_BAR
#undef PG8_SCHED
}

struct EpiBf16Plain {
    static constexpr bool PERM = true;
    bf16_t* O; int ldc; int coloff;
    __device__ __forceinline__ void operator()(const f32x4 (&acc)[2][2][4][2], const Unit& u, int row0, int wr, int wc, int fr, int fq) const {
        const int r0 = row0 + wr * 64 + fr, col0 = coloff + u.pn * BM + wc * 32 + 8 * fq;
#pragma unroll
        for (int ai = 0; ai < 2; ++ai)
#pragma unroll
            for (int m = 0; m < 4; ++m) { bf16_t* rowp = O + (size_t)(r0 + ai * HALF + m * 16) * ldc + col0;
#pragma unroll
                for (int bj = 0; bj < 2; ++bj) { const f32x4 v0 = acc[ai][bj][m][0], v1 = acc[ai][bj][m][1];
                    u32x4 w; w.x = cvt_pk_bf16(v0[0], v0[1]); w.y = cvt_pk_bf16(v0[2], v0[3]); w.z = cvt_pk_bf16(v1[0], v1[1]); w.w = cvt_pk_bf16(v1[2], v1[3]);
                    *(u32x4*)(rowp + bj * HALF) = w; } }
    }
};
struct EpiInRest {
    static constexpr bool PERM = true;
    unsigned char* ws;
    __device__ __forceinline__ void operator()(const f32x4 (&acc)[2][2][4][2], const Unit& u, int row0, int wr, int wc, int fr, int fq) const {
        const int gcol = OFF_WAQ + u.pn * BM;
        bf16_t* base; int ldc, c0; bool sg = false;
        if (gcol < OFF_WAKV) { base = (bf16_t*)(ws + WS_QWA); ldc = 1024; c0 = gcol - OFF_WAQ; }
        else if (gcol < OFF_NAQ) { base = (bf16_t*)(ws + WS_KVWA); ldc = 512; c0 = gcol - OFF_WAKV; }
        else if (gcol < OFF_NAKV) { base = (bf16_t*)(ws + WS_QNA); ldc = 1024; c0 = gcol - OFF_NAQ; }
        else if (gcol < OFF_GATE) { base = (bf16_t*)(ws + WS_KVNA); ldc = 2048; c0 = gcol - OFF_NAKV; }
        else { base = (bf16_t*)(ws + WS_GATE); ldc = 6144; c0 = gcol - OFF_GATE; sg = true; }
        const int r0 = row0 + wr * 64 + fr, col0 = c0 + wc * 32 + 8 * fq;
#pragma unroll
        for (int ai = 0; ai < 2; ++ai)
#pragma unroll
            for (int m = 0; m < 4; ++m) { bf16_t* rowp = base + (size_t)(r0 + ai * HALF + m * 16) * ldc + col0;
#pragma unroll
                for (int bj = 0; bj < 2; ++bj) { f32x4 v0 = acc[ai][bj][m][0], v1 = acc[ai][bj][m][1];
                    if (sg) {
#pragma unroll
                        for (int j = 0; j < 4; ++j) { v0[j] = sigmoid_f(v0[j]); v1[j] = sigmoid_f(v1[j]); } }
                    u32x4 w; w.x = cvt_pk_bf16(v0[0], v0[1]); w.y = cvt_pk_bf16(v0[2], v0[3]); w.z = cvt_pk_bf16(v1[0], v1[1]); w.w = cvt_pk_bf16(v1[2], v1[3]);
                    *(u32x4*)(rowp + bj * HALF) = w; } }
    }
};
template <int BR> struct EpiMergeF {
    static constexpr bool PERM = false;
    unsigned char* ws;
    __device__ __forceinline__ void operator()(const f32x4 (&acc)[2][2][4][2], const Unit& u, int row0, int wr, int wc, int fr, int fq) const {
        const int r0 = row0 + wr * 64 + fr, col0 = u.pn * BM + wc * 32 + 4 * fq;
#pragma unroll
        for (int ai = 0; ai < 2; ++ai)
#pragma unroll
            for (int m = 0; m < 4; ++m) { const size_t row = (size_t)(r0 + ai * HALF + m * 16);
                const bf16_t* gp = (const bf16_t*)(ws + WS_GATE) + row * 6144 + BR * 2048 + col0;
                bf16_t* ob = (bf16_t*)(ws + WS_MB) + row * D + col0;
#pragma unroll
                for (int bj = 0; bj < 2; ++bj)
#pragma unroll
                    for (int n = 0; n < 2; ++n) { const int co = bj * HALF + n * 16;
                        const u32x2 gg = *(const u32x2*)(gp + co);
                        const f32x4 g = {__uint_as_float(gg.x << 16), __uint_as_float(gg.x & 0xffff0000u), __uint_as_float(gg.y << 16), __uint_as_float(gg.y & 0xffff0000u)};
                        f32x4 t = g * acc[ai][bj][m][n];
                        if (BR > 0) { const u32x2 pp = *(const u32x2*)(ob + co);
                            t += (f32x4){__uint_as_float(pp.x << 16), __uint_as_float(pp.x & 0xffff0000u), __uint_as_float(pp.y << 16), __uint_as_float(pp.y & 0xffff0000u)}; }
                        u32x2 w; w.x = cvt_pk_bf16(t[0], t[1]); w.y = cvt_pk_bf16(t[2], t[3]); *(u32x2*)(ob + co) = w; } }
    }
};
struct EpiOutF {
    static constexpr bool PERM = false;
    const Ctx* c; int layer;
    __device__ __forceinline__ void operator()(const f32x4 (&acc)[2][2][4][2], const Unit& u, int row0, int wr, int wc, int fr, int fq) const {
        const int r0 = row0 + wr * 64 + fr, col0 = u.pn * BM + wc * 32 + 4 * fq;
#pragma unroll
        for (int ai = 0; ai < 2; ++ai)
#pragma unroll
            for (int m = 0; m < 4; ++m) { const int row = r0 + ai * HALF + m * 16;
                const float* xin = c->xrow(layer, row) + col0; const float* g = c->mod(layer, row < L ? 0 : 1, 2) + col0;
                float* o = (float*)(c->ws + WS_XA) + (size_t)row * D + col0;
#pragma unroll
                for (int bj = 0; bj < 2; ++bj)
#pragma unroll
                    for (int n = 0; n < 2; ++n) { const int co = bj * HALF + n * 16;
                        *(f32x4*)(o + co) = *(const f32x4*)(xin + co) + *(const f32x4*)(g + co) * acc[ai][bj][m][n]; } }
    }
};
struct EpiGU {
    static constexpr bool PERM = false;
    bf16_t* act;
    __device__ __forceinline__ void operator()(const f32x4 (&acc)[2][2][4][2], const Unit& u, int row0, int wr, int wc, int fr, int fq) const {
        const int r0 = row0 + wr * 64 + fr, f0 = u.pn * 128 + wc * 16 + 4 * fq;
#pragma unroll
        for (int ai = 0; ai < 2; ++ai)
#pragma unroll
            for (int m = 0; m < 4; ++m) { bf16_t* rowp = act + (size_t)(r0 + ai * HALF + m * 16) * DF + f0;
#pragma unroll
                for (int bj = 0; bj < 2; ++bj) { const f32x4 a = acc[ai][bj][m][0], uu = acc[ai][bj][m][1]; f32x4 t;
#pragma unroll
                    for (int j = 0; j < 4; ++j) t[j] = silu_f(a[j]) * uu[j];
                    u32x2 w; w.x = cvt_pk_bf16(t[0], t[1]); w.y = cvt_pk_bf16(t[2], t[3]); *(u32x2*)(rowp + bj * 64) = w; } }
    }
};
}

struct ConvDesc { const float* W; bf16_t* WT; int K, N, k0, n0, gu, off; };
__device__ __forceinline__ ConvDesc conv_desc(const Ctx& c, int layer, int it) {
    constexpr int I_IN = (D / 64) * (NIN / 256), I_BR = (1024 / 64) * (D / 256), I_OUT = (D / 64) * (D / 256), I_G = (D / 64) * (DF / 256), I_DN = (DF / 64) * (D / 256);
    ConvDesc d; int r = it; d.gu = 0; d.off = 0;
    if (r < I_IN) { d.W = c.in[7] + (size_t)layer * D * NIN; d.WT = c.wsp<bf16_t>(WS_WIN); d.K = D; d.N = NIN; }
    else if ((r -= I_IN) < 3 * I_BR) { const int b = r / I_BR; r -= b * I_BR; d.W = c.in[24] + ((size_t)layer * 3 + b) * 1024 * D; d.WT = c.wsp<bf16_t>(WS_WBR) + (size_t)b * D * 1024; d.K = 1024; d.N = D; }
    else if ((r -= 3 * I_BR) < I_OUT) { d.W = c.in[25] + (size_t)layer * D * D; d.WT = c.wsp<bf16_t>(WS_WOUT); d.K = D; d.N = D; }
    else { r -= I_OUT; const int e = r / (2 * I_G + I_DN); r -= e * (2 * I_G + I_DN);
        if (r < I_G) { d.W = c.in[28] + ((size_t)layer * NE + e) * D * DF; d.WT = c.wsp<bf16_t>(WS_WGU); d.K = D; d.N = DF; d.gu = 1; d.off = e * 2048; }
        else if ((r -= I_G) < I_G) { d.W = c.in[29] + ((size_t)layer * NE + e) * D * DF; d.WT = c.wsp<bf16_t>(WS_WGU); d.K = D; d.N = DF; d.gu = 1; d.off = e * 2048 + 16; }
        else { r -= I_G; d.W = c.in[30] + ((size_t)layer * NE + e) * DF * D; d.WT = c.wsp<bf16_t>(WS_WDN) + (size_t)e * D * DF; d.K = DF; d.N = D; } }
    const int nblk = d.N / 256; d.k0 = 64 * (r / nblk); d.n0 = 256 * (r % nblk);
    return d;
}
__device__ __forceinline__ void ph_conv(const Ctx& c, int layer) {
    constexpr int I_IN = (D / 64) * (NIN / 256), I_BR = (1024 / 64) * (D / 256), I_OUT = (D / 64) * (D / 256), I_G = (D / 64) * (DF / 256), I_DN = (DF / 64) * (D / 256);
    constexpr int NITEMS = I_IN + 3 * I_BR + I_OUT + NE * (2 * I_G + I_DN);
    __syncthreads();
    float* tile = (float*)c.smem;
    const int tid = c.tid;
    float4 rg[8];
    int it = c.bid; bool have = it < NITEMS; ConvDesc d;
    if (have) { d = conv_desc(c, layer, it);
#pragma unroll
        for (int q = 0; q < 8; ++q) { const int e = tid + 512 * q, row = e >> 6, c4 = e & 63; rg[q] = *(const float4*)(d.W + (size_t)(d.k0 + row) * d.N + d.n0 + 4 * c4); } }
    while (have) {
#pragma unroll
        for (int q = 0; q < 8; ++q) { const int e = tid + 512 * q, row = e >> 6, c4 = e & 63; float* tp = tile + row * 257 + 4 * c4; tp[0] = rg[q].x; tp[1] = rg[q].y; tp[2] = rg[q].z; tp[3] = rg[q].w; }
        __syncthreads();
        const ConvDesc cur = d;
        it += c.nb; have = it < NITEMS;
        if (have) { d = conv_desc(c, layer, it);
#pragma unroll
            for (int q = 0; q < 8; ++q) { const int e = tid + 512 * q, row = e >> 6, c4 = e & 63; rg[q] = *(const float4*)(d.W + (size_t)(d.k0 + row) * d.N + d.n0 + 4 * c4); } }
#pragma unroll
        for (int j = 0; j < 4; ++j) { const int p = tid + 512 * j, nn = p >> 3, kc = p & 7; const float* sp = tile + (8 * kc) * 257 + nn;
            uint4 o; o.x = pk2(sp[0 * 257], sp[1 * 257]); o.y = pk2(sp[2 * 257], sp[3 * 257]); o.z = pk2(sp[4 * 257], sp[5 * 257]); o.w = pk2(sp[6 * 257], sp[7 * 257]);
            const int f = cur.n0 + nn; const int orow = cur.gu ? cur.off + 32 * (f >> 4) + (f & 15) : f;
            *(uint4*)(cur.WT + (size_t)orow * cur.K + cur.k0 + 8 * kc) = o; }
        __syncthreads();
    }
}

struct EpiTaps {
    static constexpr bool PERM = true;
    bf16_t* KF; bf16_t* KFC; const float* dec;
    __device__ __forceinline__ void operator()(const pg8::f32x4 (&acc)[2][2][4][2], const pg8::Unit& u, int row0, int wr, int wc, int fr, int fq) const {
        const bool isc = u.pn == L / 256;
        const int ch0 = row0 + wr * 64 + fr, pos0 = (isc ? 0 : u.pn * 256) + wc * 32 + 8 * fq;
        const float inv = isc ? 1.0f / (float)(LC - 1) : 1.0f / (float)(L - 1);
        bf16_t* base = isc ? KFC : KF; const int ld = isc ? LC : L;
#pragma unroll
        for (int ai = 0; ai < 2; ++ai)
#pragma unroll
            for (int m = 0; m < 4; ++m) { const int ch = ch0 + ai * 128 + m * 16; const float rate = fabsf(dec[ch]); bf16_t* rowp = base + (size_t)ch * ld + pos0;
#pragma unroll
                for (int bj = 0; bj < 2; ++bj) { float t[8];
#pragma unroll
                    for (int j = 0; j < 8; ++j) { const float tt = (float)(pos0 + bj * 128 + j) * inv; const float a = j < 4 ? acc[ai][bj][m][0][j] : acc[ai][bj][m][1][j - 4]; t[j] = a * (__expf(-tt * rate) + 0.05f); }
                    pg8::u32x4 w; w.x = pg8::cvt_pk_bf16(t[0], t[1]); w.y = pg8::cvt_pk_bf16(t[2], t[3]); w.z = pg8::cvt_pk_bf16(t[4], t[5]); w.w = pg8::cvt_pk_bf16(t[6], t[7]);
                    *(pg8::u32x4*)(rowp + bj * 128) = w; } }
    }
};
__device__ __forceinline__ void ph_taps(const Ctx& c, int layer) {
    LAS unsigned char* lds = (LAS unsigned char*)c.smem;
    __syncthreads();
    const pg8::GeomLin G{(const char*)(c.wsp<bf16_t>(WS_FW3T) + (size_t)layer * 4096 * 256), (const char*)(c.wsp<bf16_t>(WS_H2B) + (size_t)layer * MR * 256), 256, 256, 256, nullptr};
    pg8::StaticOrder S; S.init(4096 / 256, MR / 256, c.nb, c.bid);
    const EpiTaps E{c.wsp<bf16_t>(WS_KF), c.wsp<bf16_t>(WS_KFC), c.in[16] + (size_t)layer * 4096};
    pg8::gemm_phase(lds, G, S, E);
}

__device__ __forceinline__ void ph_g0(const Ctx& c) {
    float* lds = (float*)c.smem;
    {
        float* PART = c.wsp<float>(WS_MODPART);
        for (int u = c.bid; u < 2 * 128; u += c.nb) {
            const int layer = u >> 7, slab = u & 127, k0 = slab * 16;
            __syncthreads();
            if (c.tid < 32) { const int k = k0 + (c.tid & 15); lds[c.tid] = silu_f(c.tid < 16 ? c.in[1][k] : c.in[3][k]); }
            __syncthreads();
            const float4* w = (const float4*)(c.in[4] + ((size_t)layer * D + k0) * NMOD);
            float4 ac[6], ax[6];
#pragma unroll
            for (int q = 0; q < 6; ++q) { ac[q] = make_float4(0.f, 0.f, 0.f, 0.f); ax[q] = make_float4(0.f, 0.f, 0.f, 0.f); }
#pragma unroll 4
            for (int r = 0; r < 16; ++r) {
                const float sc = lds[r], sx = lds[16 + r];
#pragma unroll
                for (int q = 0; q < 6; ++q) { const float4 v = w[(size_t)r * (NMOD / 4) + c.tid + 512 * q];
                    ac[q].x = fmaf(sc, v.x, ac[q].x); ac[q].y = fmaf(sc, v.y, ac[q].y); ac[q].z = fmaf(sc, v.z, ac[q].z); ac[q].w = fmaf(sc, v.w, ac[q].w);
                    ax[q].x = fmaf(sx, v.x, ax[q].x); ax[q].y = fmaf(sx, v.y, ax[q].y); ax[q].z = fmaf(sx, v.z, ax[q].z); ax[q].w = fmaf(sx, v.w, ax[q].w); }
            }
            float4* pc = (float4*)(PART + ((size_t)(layer * 128 + slab) * 2 + 0) * NMOD), *px = (float4*)(PART + ((size_t)(layer * 128 + slab) * 2 + 1) * NMOD);
#pragma unroll
            for (int q = 0; q < 6; ++q) { pc[c.tid + 512 * q] = ac[q]; px[c.tid + 512 * q] = ax[q]; }
        }
    }
    for (size_t e = (size_t)c.bid * NTHREADS + c.tid; e < (size_t)2 * 4096 * 256; e += (size_t)c.nb * NTHREADS) {
        const int k = (int)(e & 255), col = (int)((e >> 8) & 4095), layer = (int)(e >> 20);
        c.wsp<bf16_t>(WS_FW3T)[e] = k < 64 ? f2bf(c.in[14][((size_t)layer * 64 + k) * 4096 + col]) : (bf16_t)0;
    }
    const int gw = c.bid * 8 + c.wave, ngw = c.nb * 8;
    for (int task = gw; task < 2 * MR; task += ngw) {
        const int layer = task / MR, pos = task % MR;
        const bool isc = pos >= L; const int i = isc ? pos - L : pos; const int Lx = isc ? LC : L;
        const float tt = (float)i * (1.0f / (float)(Lx - 1));
        const float c0 = (float)(2.0 * 3.14159265358979323846 / (double)Lx);
        const int j = c.lane;
        float feat = 0.f;
        if (j == 0) feat = tt;
        else if (j < 33) { const int b = (j - 1) & 15; const float band = 1e-4f + (float)b * ((15.0f - 1e-4f) / 15.0f); const float ang = (c0 * band) * (float)i; feat = (j <= 16) ? cosf(ang) : -sinf(ang); }
        const float* fw1 = c.in[10] + (size_t)layer * 33 * 64; const float* fb1 = c.in[11] + layer * 64;
        const float* fw2 = c.in[12] + (size_t)layer * 64 * 64; const float* fb2 = c.in[13] + layer * 64;
        const float* fr = c.in[15] + layer * 128;
        float s = fb1[j];
        for (int f = 0; f < 33; ++f) s = fmaf(__shfl(feat, f), fw1[f * 64 + j], s);
        const float h1 = sinf(fr[j] * s);
        float s2 = fb2[j];
        for (int m = 0; m < 64; ++m) s2 = fmaf(__shfl(h1, m), fw2[m * 64 + j], s2);
        const float h2 = sinf(fr[64 + j] * s2);
        bf16_t* hb = c.wsp<bf16_t>(WS_H2B) + ((size_t)layer * MR + pos) * 256;
        hb[j] = f2bf(h2); hb[64 + j] = 0; hb[128 + j] = 0; hb[192 + j] = 0;
    }
}

__device__ __forceinline__ void ph_g0b(const Ctx& c) {
    const float* PART = c.wsp<float>(WS_MODPART);
    for (int i = c.bid * NTHREADS + c.tid; i < 2 * 2 * (NMOD / 4); i += c.nb * NTHREADS) {
        const int n4 = i % (NMOD / 4), ls = i / (NMOD / 4), layer = ls >> 1, src = ls & 1;
        float4 a = *(const float4*)(c.in[5] + (size_t)layer * NMOD + 4 * n4);
#pragma unroll 8
        for (int sl = 0; sl < 128; ++sl) { const float4 v = *(const float4*)(PART + ((size_t)(layer * 128 + sl) * 2 + src) * NMOD + 4 * n4); a.x += v.x; a.y += v.y; a.z += v.z; a.w += v.w; }
        *(float4*)(c.wsp<float>(WS_MOD) + (size_t)(layer * 2 + src) * NMOD + 4 * n4) = a;
    }
}

__device__ __forceinline__ void ph_a(const Ctx& c, int layer) {
    const int gw = c.bid * 8 + c.wave, ngw = c.nb * 8;
    const float* g = c.in[6] + (size_t)layer * D;
    float* gl = (float*)c.smem;
    __syncthreads();
    for (int i = c.tid; i < D; i += NTHREADS) { gl[i] = g[i]; gl[D + i] = c.mod(layer, 0, 0)[i]; gl[2 * D + i] = c.mod(layer, 0, 1)[i]; }
    __syncthreads();
    for (int r = gw; r < MR; r += ngw) {
        const float* x = c.xrow(layer, r);
        const bool lat = r < L;
        const float* shg = c.mod(layer, 1, 0); const float* scg = c.mod(layer, 1, 1);
        float4 v[8]; float ss = 0.f;
#pragma unroll
        for (int j = 0; j < 8; ++j) { v[j] = *(const float4*)(x + 4 * c.lane + 256 * j); ss += v[j].x * v[j].x + v[j].y * v[j].y + v[j].z * v[j].z + v[j].w * v[j].w; }
        ss = wave_sum(ss);
        const float inv = rsqrtf(ss * (1.0f / D) + RMS_EPS);
        bf16_t* o = c.wsp<bf16_t>(WS_HX) + (size_t)r * D;
#pragma unroll
        for (int j = 0; j < 8; ++j) {
            const int col = 4 * c.lane + 256 * j;
            const float4 gg = *(const float4*)(gl + col);
            const float4 s4 = lat ? *(const float4*)(gl + D + col) : *(const float4*)(shg + col);
            const float4 c4 = lat ? *(const float4*)(gl + 2 * D + col) : *(const float4*)(scg + col);
            const float y0 = v[j].x * inv * gg.x * (1.f + c4.x) + s4.x, y1 = v[j].y * inv * gg.y * (1.f + c4.y) + s4.y;
            const float y2 = v[j].z * inv * gg.z * (1.f + c4.z) + s4.z, y3 = v[j].w * inv * gg.w * (1.f + c4.w) + s4.w;
            uint2 w; w.x = pk2(y0, y1); w.y = pk2(y2, y3);
            *(uint2*)(o + col) = w;
        }
    }
}

struct EpiIn {
    unsigned char* ws;
    __device__ __forceinline__ void operator()(int row, int col, const float (&v)[8]) const {
        if (col < OFF_WAQ) {
            bf16_t* d = (bf16_t*)(ws + WS_ZHYT);
#pragma unroll
            for (int j = 0; j < 8; ++j) d[(size_t)(col + j) * MR + row] = f2bf(v[j]);
            return;
        }
        bf16_t* dst; float t[8];
#pragma unroll
        for (int j = 0; j < 8; ++j) t[j] = v[j];
        if (col < OFF_WAKV) dst = (bf16_t*)(ws + WS_QWA) + (size_t)row * 1024 + (col - OFF_WAQ);
        else if (col < OFF_NAQ) dst = (bf16_t*)(ws + WS_KVWA) + (size_t)row * 512 + (col - OFF_WAKV);
        else if (col < OFF_NAKV) dst = (bf16_t*)(ws + WS_QNA) + (size_t)row * 1024 + (col - OFF_NAQ);
        else if (col < OFF_GATE) dst = (bf16_t*)(ws + WS_KVNA) + (size_t)row * 2048 + (col - OFF_NAKV);
        else { dst = (bf16_t*)(ws + WS_GATE) + (size_t)row * 6144 + (col - OFF_GATE);
#pragma unroll
            for (int j = 0; j < 8; ++j) t[j] = sigmoid_f(t[j]); }
        uint4 o; o.x = pk2(t[0], t[1]); o.y = pk2(t[2], t[3]); o.z = pk2(t[4], t[5]); o.w = pk2(t[6], t[7]);
        *(uint4*)dst = o;
    }
};
__device__ __forceinline__ void ph_b(const Ctx& c, int layer) {
    const RowLin rp{c.wsp<bf16_t>(WS_HX), D};
    const EpiIn ep{c.ws};
    const float* W = c.in[7] + (size_t)layer * D * NIN;
    const int nM = MR / 128, nN = NIN / 128;
    for (int u = c.bid; u < nM * nN; u += c.nb) {
        const int pm = u % nM, pn = u / nM;
        sgemm_unit(rp, W, NIN, D, pm * 128, pn * 128, ep, (float*)c.smem, c.tid);
    }
}

__device__ __forceinline__ void b2_segment(bf16_t* p, const float* gain, bool rope, int r, int lane, bool active) {
    uint4 w = make_uint4(0u, 0u, 0u, 0u);
    if (active) w = *(const uint4*)(p + 8 * lane);
    float x[8] = {__uint_as_float(w.x << 16), __uint_as_float(w.x & 0xffff0000u), __uint_as_float(w.y << 16), __uint_as_float(w.y & 0xffff0000u),
                  __uint_as_float(w.z << 16), __uint_as_float(w.z & 0xffff0000u), __uint_as_float(w.w << 16), __uint_as_float(w.w & 0xffff0000u)};
    float ss = 0.f;
#pragma unroll
    for (int i = 0; i < 8; ++i) ss += x[i] * x[i];
    ss += __shfl_xor(ss, 1); ss += __shfl_xor(ss, 2); ss += __shfl_xor(ss, 4); ss += __shfl_xor(ss, 8);
    const float inv = rsqrtf(ss * (1.0f / 128.0f) + RMS_EPS);
    const int d0 = (lane & 15) * 8;
    const float4 g0 = *(const float4*)(gain + d0), g1 = *(const float4*)(gain + d0 + 4);
    const float gg[8] = {g0.x, g0.y, g0.z, g0.w, g1.x, g1.y, g1.z, g1.w};
#pragma unroll
    for (int i = 0; i < 8; ++i) x[i] = x[i] * inv * gg[i];
    if (rope) {
        const int axis = d0 >> 6, half = (d0 >> 5) & 1, f0 = d0 & 31;
        const float pos = axis == 0 ? (float)(r / GRIDW) : (float)(r % GRIDW);
#pragma unroll
        for (int i = 0; i < 8; ++i) {
            const float other = __shfl_xor(x[i], 4);
            const float ang = pos * powf(10000.0f, -(float)(f0 + i) / 32.0f);
            float sn, cs; sincosf(ang, &sn, &cs);
            x[i] = half == 0 ? x[i] * cs - other * sn : x[i] * cs + other * sn;
        }
    }
    if (active) { uint4 o; o.x = pk2(x[0], x[1]); o.y = pk2(x[2], x[3]); o.z = pk2(x[4], x[5]); o.w = pk2(x[6], x[7]); *(uint4*)(p + 8 * lane) = o; }
}
__device__ __forceinline__ void ph_b2(const Ctx& c, int layer) {
    const int gw = c.bid * 8 + c.wave, ngw = c.nb * 8;
    const int lane = c.lane;
    for (int r = gw; r < MR; r += ngw) {
        const bool lat = r < L;
        b2_segment(c.wsp<bf16_t>(WS_QWA) + (size_t)r * 1024, c.in[18] + layer * 128, lat, r, lane, true);
        b2_segment(c.wsp<bf16_t>(WS_QWA) + (size_t)r * 1024 + 512, c.in[18] + layer * 128, lat, r, lane, true);
        b2_segment(c.wsp<bf16_t>(WS_KVWA) + (size_t)r * 512, c.in[19] + layer * 128, lat, r, lane, lane < 32);
        b2_segment(c.wsp<bf16_t>(WS_QNA) + (size_t)r * 1024, c.in[21] + layer * 128, false, r, lane, true);
        b2_segment(c.wsp<bf16_t>(WS_QNA) + (size_t)r * 1024 + 512, c.in[21] + layer * 128, false, r, lane, true);
        b2_segment(c.wsp<bf16_t>(WS_KVNA) + (size_t)r * 2048, c.in[22] + layer * 128, false, r, lane, true);
        b2_segment(c.wsp<bf16_t>(WS_KVNA) + (size_t)r * 2048 + 512, c.in[22] + layer * 128, false, r, lane, true);
    }
}

__device__ __forceinline__ float shortconv_at(const bf16_t* z, int t, int Lx, float w0, float w1, float w2, float b) {
    const float zm = t > 0 ? bf2f(z[t - 1]) : 0.f, z0 = bf2f(z[t]), zp = t + 1 < Lx ? bf2f(z[t + 1]) : 0.f;
    return zm * w0 + z0 * w1 + zp * w2 + b;
}
__device__ __forceinline__ float block_sum(float v, float* red, int tid) {
    v = wave_sum(v);
    __syncthreads();
    if ((tid & 63) == 0) red[tid >> 6] = v;
    __syncthreads();
    float t = 0.f;
#pragma unroll
    for (int w = 0; w < 8; ++w) t += red[w];
    return t;
}
__device__ __forceinline__ void hyena_direct_unit(const Ctx& c, int layer, int ch) {
    bf16_t* kc = (bf16_t*)c.smem;
    float* cv = (float*)c.smem;
    float* us = (float*)(c.smem + 4 * L);
    float* red = us + L;
    const int tid = c.tid;
    const float* cw = c.in[8] + (size_t)layer * 3 * 3072; const float* cb = c.in[9] + (size_t)layer * 3072;
    const bf16_t* zv = c.wsp<bf16_t>(WS_ZHYT) + (size_t)ch * MR;
    const bf16_t* z1 = c.wsp<bf16_t>(WS_ZHYT) + (size_t)(1024 + ch) * MR;
    const bf16_t* z2 = c.wsp<bf16_t>(WS_ZHYT) + (size_t)(2048 + ch) * MR;
    const bf16_t* KF = c.wsp<bf16_t>(WS_KF);
    __syncthreads();
    { const float w0 = cw[ch], w1 = cw[3072 + ch], w2 = cw[6144 + ch], b = cb[ch];
#pragma unroll 2
      for (int t = tid; t < L; t += NTHREADS) us[t] = shortconv_at(zv, t, L, w0, w1, w2, b); }
    for (int o = 0; o < 2; ++o) {
        const bf16_t* hf = KF + (size_t)(o * 1024 + ch) * L;
        const bf16_t* hb = KF + (size_t)(2048 + o * 1024 + ch) * L;
        float sabs = 0.f;
#pragma unroll 2
        for (int t = tid; t < L; t += NTHREADS) {
            bf16_t kf = hf[t], kb = hb[t];
            if (t == 0) { kf = f2bf(bf2f(kf) + bf2f(kb)); kb = 0; }
            kc[L + t] = kf; kc[L - t] = (t == 0) ? kf : kb;
            sabs += fabsf(bf2f(kf)) + fabsf(bf2f(kb));
        }
        if (tid == 0) kc[0] = 0;
        const float S = block_sum(sabs, red, tid);
        {
            float acc[32];
#pragma unroll
            for (int j = 0; j < 32; ++j) acc[j] = 0.f;
#pragma unroll 2
            for (int s = 0; s < L; ++s) {
                const float uv = us[s];
                const bf16_t* kp = kc + (L + tid - s);
#pragma unroll
                for (int j = 0; j < 32; ++j) acc[j] = fmaf(uv, bf2f(kp[512 * j]), acc[j]);
            }
            __syncthreads();
#pragma unroll
            for (int j = 0; j < 32; ++j) cv[tid + 512 * j] = acc[j];
        }
        LDS_FENCE();
        const float invS = 1.0f / S;
        const float dsk = c.in[17][(size_t)layer * 2048 + o * 1024 + ch];
        const int co = o == 0 ? 1024 : 2048;
        const bf16_t* zz = o == 0 ? z1 : z2;
        const float w0 = cw[co + ch], w1 = cw[3072 + co + ch], w2 = cw[6144 + co + ch], b = cb[co + ch];
        bf16_t* dst = c.wsp<bf16_t>(WS_YHYT) + (size_t)ch * L;
#pragma unroll 2
        for (int t = tid; t < L; t += NTHREADS) {
            const float r = shortconv_at(zz, t, L, w0, w1, w2, b) * (cv[t] * invS + us[t] * dsk);
            if (o == 0) us[t] = r; else dst[t] = f2bf(r);
        }
        __syncthreads();
    }
}
__device__ __forceinline__ void hyena_ctx_unit(const Ctx& c, int layer, int ch) {
    float* kc = (float*)c.smem;
    float* us = kc + 512;
    float* red = us + 256;
    const int tid = c.tid;
    const float* cw = c.in[8] + (size_t)layer * 3 * 3072; const float* cb = c.in[9] + (size_t)layer * 3072;
    const bf16_t* zv = c.wsp<bf16_t>(WS_ZHYT) + (size_t)ch * MR + L;
    const bf16_t* z1 = c.wsp<bf16_t>(WS_ZHYT) + (size_t)(1024 + ch) * MR + L;
    const bf16_t* z2 = c.wsp<bf16_t>(WS_ZHYT) + (size_t)(2048 + ch) * MR + L;
    const bf16_t* KF = c.wsp<bf16_t>(WS_KFC);
    __syncthreads();
    if (tid < LC) us[tid] = shortconv_at(zv, tid, LC, cw[ch], cw[3072 + ch], cw[6144 + ch], cb[ch]);
    for (int o = 0; o < 2; ++o) {
        const bf16_t* hf = KF + (size_t)(o * 1024 + ch) * LC;
        const bf16_t* hb = KF + (size_t)(2048 + o * 1024 + ch) * LC;
        float sabs = 0.f;
        {
            const int lag = tid - 256; float k;
            if (lag == 0) k = bf2f(hf[0]) + bf2f(hb[0]); else if (lag > 0) k = bf2f(hf[lag]); else if (lag > -256) k = bf2f(hb[-lag]); else k = 0.f;
            kc[tid] = k; sabs = fabsf(k);
        }
        const float S = block_sum(sabs, red, tid);
        float acc = 0.f;
        if (tid < LC) for (int s = 0; s < LC; ++s) acc = fmaf(us[s], kc[256 + tid - s], acc);
        const float dsk = c.in[17][(size_t)layer * 2048 + o * 1024 + ch];
        float res = 0.f;
        if (tid < LC) {
            const bf16_t* zz = o == 0 ? z1 : z2; const int co = o == 0 ? 1024 : 2048;
            res = shortconv_at(zz, tid, LC, cw[co + ch], cw[3072 + co + ch], cw[6144 + co + ch], cb[co + ch]) * (acc / S + us[tid] * dsk);
        }
        __syncthreads();
        if (tid < LC) { if (o == 0) us[tid] = res; else c.wsp<bf16_t>(WS_YHY)[(size_t)(L + tid) * 1024 + ch] = f2bf(res); }
        __syncthreads();
    }
}

template <class KeyFn>
__device__ __forceinline__ void wave_attn(const bf16_t* q, int nkeys, const KeyFn& key, bool has_sink, float sink, bf16_t* out, float* wl, int lane) {
    float* qf = wl;
    float* sc = wl + 128;
    qf[2 * lane] = bf2f(q[2 * lane]); qf[2 * lane + 1] = bf2f(q[2 * lane + 1]);
    LDS_FENCE();
    float mx = -3.0e38f;
    for (int j = lane; j < nkeys; j += 64) {
        const bf16_t* kp; const bf16_t* vp; float bias;
        float s = -1e30f;
        if (key(j, kp, vp, bias)) {
            float d = 0.f;
#pragma unroll
            for (int e = 0; e < 128; e += 8) {
                const uint4 kk = *(const uint4*)(kp + e);
                d = fmaf(qf[e + 0], __uint_as_float(kk.x << 16), d); d = fmaf(qf[e + 1], __uint_as_float(kk.x & 0xffff0000u), d);
                d = fmaf(qf[e + 2], __uint_as_float(kk.y << 16), d); d = fmaf(qf[e + 3], __uint_as_float(kk.y & 0xffff0000u), d);
                d = fmaf(qf[e + 4], __uint_as_float(kk.z << 16), d); d = fmaf(qf[e + 5], __uint_as_float(kk.z & 0xffff0000u), d);
                d = fmaf(qf[e + 6], __uint_as_float(kk.w << 16), d); d = fmaf(qf[e + 7], __uint_as_float(kk.w & 0xffff0000u), d);
            }
            s = d * QK_SCALE + bias;
        }
        sc[j] = s; mx = fmaxf(mx, s);
    }
    if (has_sink) mx = fmaxf(mx, sink);
    mx = wave_max(mx);
    float sum = 0.f;
    for (int j = lane; j < nkeys; j += 64) { const float p = __expf(sc[j] - mx); sc[j] = p; sum += p; }
    sum = wave_sum(sum);
    if (has_sink) sum += __expf(sink - mx);
    LDS_FENCE();
    float o0 = 0.f, o1 = 0.f;
    for (int j = 0; j < nkeys; ++j) {
        const float p = sc[j];
        if (p != 0.f) {
            const bf16_t* kp; const bf16_t* vp; float bias;
            key(j, kp, vp, bias);
            const unsigned vv = *(const unsigned*)(vp + 2 * lane);
            o0 = fmaf(p, __uint_as_float(vv << 16), o0); o1 = fmaf(p, __uint_as_float(vv & 0xffff0000u), o1);
        }
    }
    const float inv = 1.0f / sum;
    *(unsigned*)(out + 2 * lane) = pk2(o0 * inv, o1 * inv);
    LDS_FENCE();
}

struct KeyWA {
    const bf16_t* kv; int t, kvh;
    __device__ __forceinline__ bool operator()(int j, const bf16_t*& kp, const bf16_t*& vp, float& bias) const {
        bias = 0.f;
        int row; bool ok = true;
        if (j < 257) { const int kpos = t - 128 + j; ok = kpos >= 0 && kpos < L; row = ok ? kpos : 0; } else row = L + (j - 257);
        kp = kv + (size_t)row * 512 + kvh * 128; vp = kp + 256; return ok;
    }
};
struct KeyCtxWA { const bf16_t* kv; int kvh;
    __device__ __forceinline__ bool operator()(int j, const bf16_t*& kp, const bf16_t*& vp, float& bias) const { bias = 0.f; kp = kv + (size_t)(L + j) * 512 + kvh * 128; vp = kp + 256; return true; } };
struct KeyNA {
    const bf16_t* kv; const float* rpb; int r, qc, r0, cs, h;
    __device__ __forceinline__ bool operator()(int j, const bf16_t*& kp, const bf16_t*& vp, float& bias) const {
        int row;
        if (j < 128) { const int w = j >> 4, kc = cs + (j & 15); row = (r0 + w) * GRIDW + kc;
            const int dr = r0 + w - r + 7; int dc = kc - qc + 15; dc = dc < 0 ? 0 : (dc > 30 ? 30 : dc);
            bias = rpb[(h * 15 + dr) * 31 + dc]; }
        else { row = L + (j - 128); bias = 0.f; }
        kp = kv + (size_t)row * 2048 + h * 128; vp = kp + 1024; return true;
    }
};
struct KeyCtxNA { const bf16_t* kv; int h;
    __device__ __forceinline__ bool operator()(int j, const bf16_t*& kp, const bf16_t*& vp, float& bias) const { bias = 0.f; kp = kv + (size_t)(L + j) * 2048 + h * 128; vp = kp + 1024; return true; } };


#define HYF __device__ __forceinline__
#define HYF_OPAQUE(x) asm volatile("" : "+v"(x))
#define HYF_SB(i) do { if (((i) & 3) == 3) __builtin_amdgcn_sched_barrier(0); } while (0)
namespace hyf {
constexpr int FL = 16384;
constexpr int FPAD = FL + 32 * 16;
typedef float cpx __attribute__((ext_vector_type(2)));
HYF int phys(int p) { return ((p & ~15) | ((p & 15) ^ ((p >> 5) & 15))) + ((p >> 9) << 4); }

#define HYF_C32 {1.0f, 0.98078528040323043f, 0.92387953251128674f, 0.83146961230254524f, 0.70710678118654752f, 0.55557023301960218f, 0.38268343236508978f, 0.19509032201612825f, \
                 0.0f, -0.19509032201612825f, -0.38268343236508978f, -0.55557023301960218f, -0.70710678118654752f, -0.83146961230254524f, -0.92387953251128674f, -0.98078528040323043f}
#define HYF_S32 {0.0f, 0.19509032201612825f, 0.38268343236508978f, 0.55557023301960218f, 0.70710678118654752f, 0.83146961230254524f, 0.92387953251128674f, 0.98078528040323043f, \
                 1.0f, 0.98078528040323043f, 0.92387953251128674f, 0.83146961230254524f, 0.70710678118654752f, 0.55557023301960218f, 0.38268343236508978f, 0.19509032201612825f}

HYF int rev5(int x) { return (int)(__builtin_bitreverse32((unsigned)x) >> 27); }
HYF int rev4(int x) { return (int)(__builtin_bitreverse32((unsigned)x) >> 28); }
HYF cpx cmul(cpx a, cpx t) { return a.xx * t + (cpx){-a.y, a.y} * t.yx; }
HYF cpx cmulc(cpx a, cpx t) { return t.xx * a + t.yy * (cpx){a.y, -a.x}; }

template <int N, int SG, int BASE, int STRIDE32>
struct DifStage {
    static HYF void run(cpx (&v)[32], const float (&K)[9]) {
        constexpr int H = N / 2;
#pragma unroll
        for (int j = 0; j < H; ++j) {
            const cpx a = v[BASE + j], b = v[BASE + j + H];
            v[BASE + j] = a + b;
            const cpx d = a - b;
            const int tw = j * STRIDE32;
            if (tw == 0) v[BASE + j + H] = d;
            else if (tw == 8) v[BASE + j + H] = (SG < 0) ? (cpx){d.y, -d.x} : (cpx){-d.y, d.x};
            else {
                const float c = (tw < 8) ? K[tw] : -K[16 - tw];
                const float sa = (tw < 8) ? K[8 - tw] : K[tw - 8];
                const float s = (SG < 0) ? -sa : sa;
                v[BASE + j + H] = d * c + (cpx){-d.y, d.x} * s;
            }
        }
        if constexpr (N > 2) { DifStage<H, SG, BASE, STRIDE32 * 2>::run(v, K); DifStage<H, SG, BASE + H, STRIDE32 * 2>::run(v, K); }
    }
};
template <int SG> HYF void dft32(cpx (&v)[32], const float (&K0)[9]) { float K[9]; _Pragma("unroll") for (int m = 0; m < 9; ++m) { K[m] = K0[m]; HYF_OPAQUE(K[m]); } DifStage<32, SG, 0, 1>::run(v, K); }
template <int SG> HYF void dft16(cpx (&v)[32], const float (&K0)[9]) { float K[9]; _Pragma("unroll") for (int m = 0; m < 9; ++m) { K[m] = K0[m]; HYF_OPAQUE(K[m]); } DifStage<16, SG, 0, 2>::run(v, K); }

struct ThreadTw { cpx w1;
                  cpx w2;
                  cpx wo;
                  int b1;
                  int b2, n3;
                  int b3[2], sw;
                  float K[9]; };
HYF void tw_addr(int tid, ThreadTw& t) {
    t.b1 = (tid & ~15) | ((tid & 15) ^ ((tid >> 5) & 15));
    t.b2 = (tid >> 4) * 528; t.n3 = tid & 15; t.sw = (tid >> 1) & 15;
    for (int h = 0; h < 2; ++h) { const int g = tid + 512 * h; t.b3[h] = g * 16 + (g >> 5) * 16; }
    constexpr float KK[9] = {1.0f, 0.98078528040323043f, 0.92387953251128674f, 0.83146961230254524f, 0.70710678118654752f, 0.55557023301960218f, 0.38268343236508978f, 0.19509032201612825f, 0.0f};
    for (int m = 0; m < 9; ++m) { t.K[m] = KK[m]; HYF_OPAQUE(t.K[m]); }
}

HYF void fwd_p1(const ThreadTw& tw, cpx (&v)[32], cpx* lds) {
    int b1 = tw.b1; HYF_OPAQUE(b1);
    float wx = tw.w1.x, wy = tw.w1.y; HYF_OPAQUE(wx); HYF_OPAQUE(wy); const cpx w = {wx, wy};
    dft32<-1>(v, tw.K);
    cpx t = {1.f, 0.f};
#pragma unroll
    for (int k1 = 0; k1 < 32; ++k1) {
        lds[b1 + 528 * k1] = cmul(v[rev5(k1)], t);
        t = cmul(t, w);
        HYF_SB(k1);
    }
}
HYF void fwd_p2(const ThreadTw& tw, cpx* lds) {
    int b2 = tw.b2, n3 = tw.n3; HYF_OPAQUE(b2); HYF_OPAQUE(n3);
    float wx = tw.w2.x, wy = tw.w2.y; HYF_OPAQUE(wx); HYF_OPAQUE(wy); const cpx w = {wx, wy};
    cpx v[32];
#pragma unroll
    for (int n2 = 0; n2 < 32; ++n2) v[n2] = lds[b2 + 16 * n2 + (n3 ^ ((n2 >> 1) & 15))];
    dft32<-1>(v, tw.K);
    cpx t = {1.f, 0.f};
#pragma unroll
    for (int k2 = 0; k2 < 32; ++k2) {
        lds[b2 + 16 * k2 + (n3 ^ ((k2 >> 1) & 15))] = cmul(v[rev5(k2)], t);
        t = cmul(t, w);
        HYF_SB(k2);
    }
}
HYF void fwd_p3(int tid, const ThreadTw& tw, const cpx* lds, cpx* ks) {
    HYF_OPAQUE(tid);
#pragma unroll
    for (int h = 0; h < 2; ++h) {
        int b3 = tw.b3[h], sw = tw.sw; HYF_OPAQUE(b3); HYF_OPAQUE(sw);
        cpx v[32];
#pragma unroll
        for (int n3 = 0; n3 < 16; ++n3) v[n3] = lds[b3 + (n3 ^ sw)];
        dft16<-1>(v, tw.K);
#pragma unroll
        for (int k3 = 0; k3 < 16; ++k3) ks[(h * 16 + k3) * 512 + tid] = v[rev4(k3)];
    }
}
HYF void mid_p3(int tid, const ThreadTw& tw, cpx* lds, const cpx* ks) {
    HYF_OPAQUE(tid);
#pragma unroll
    for (int h = 0; h < 2; ++h) {
        int b3 = tw.b3[h], sw = tw.sw; HYF_OPAQUE(b3); HYF_OPAQUE(sw);
        cpx v[32], p[32];
#pragma unroll
        for (int n3 = 0; n3 < 16; ++n3) v[n3] = lds[b3 + (n3 ^ sw)];
        dft16<-1>(v, tw.K);
#pragma unroll
        for (int k3 = 0; k3 < 16; ++k3) p[k3] = cmul(v[rev4(k3)], ks[(h * 16 + k3) * 512 + tid]);
        dft16<1>(p, tw.K);
#pragma unroll
        for (int n3 = 0; n3 < 16; ++n3) lds[b3 + (n3 ^ sw)] = p[rev4(n3)];
    }
}
HYF void inv_p2(const ThreadTw& tw, cpx* lds) {
    int b2 = tw.b2, n3 = tw.n3; HYF_OPAQUE(b2); HYF_OPAQUE(n3);
    float wx = tw.w2.x, wy = tw.w2.y; HYF_OPAQUE(wx); HYF_OPAQUE(wy); const cpx w = {wx, wy};
    cpx v[32];
    cpx t = {1.f, 0.f};
#pragma unroll
    for (int k2 = 0; k2 < 32; ++k2) {
        v[k2] = cmulc(lds[b2 + 16 * k2 + (n3 ^ ((k2 >> 1) & 15))], t);
        t = cmul(t, w);
        HYF_SB(k2);
    }
    dft32<1>(v, tw.K);
#pragma unroll
    for (int n2 = 0; n2 < 32; ++n2) { lds[b2 + 16 * n2 + (n3 ^ ((n2 >> 1) & 15))] = v[rev5(n2)]; HYF_SB(n2); }
}
HYF void inv_p1(const ThreadTw& tw, const cpx* lds, cpx (&out)[32]) {
    int b1 = tw.b1; HYF_OPAQUE(b1);
    float wx = tw.w1.x, wy = tw.w1.y; HYF_OPAQUE(wx); HYF_OPAQUE(wy); const cpx w = {wx, wy};
    cpx v[32];
    cpx t = {1.f, 0.f};
#pragma unroll
    for (int k1 = 0; k1 < 32; ++k1) {
        v[k1] = cmulc(lds[b1 + 528 * k1], t);
        t = cmul(t, w);
        HYF_SB(k1);
    }
    dft32<1>(v, tw.K);
#pragma unroll
    for (int n1 = 0; n1 < 32; ++n1) out[n1] = v[rev5(n1)];
}
HYF cpx opaque_wo(const ThreadTw& tw) { float x = tw.wo.x, y = tw.wo.y; HYF_OPAQUE(x); HYF_OPAQUE(y); return (cpx){x, y}; }
HYF cpx modfac(cpx wo, int n1) {
    constexpr float C64[32] = {1.0f, 0.99518472667219693f, 0.98078528040323043f, 0.95694033573220882f, 0.92387953251128674f, 0.88192126434835505f, 0.83146961230254524f, 0.77301045336273699f,
        0.70710678118654752f, 0.63439328416364549f, 0.55557023301960218f, 0.47139673682599764f, 0.38268343236508978f, 0.29028467725446233f, 0.19509032201612825f, 0.098017140329560604f,
        0.0f, -0.098017140329560604f, -0.19509032201612825f, -0.29028467725446233f, -0.38268343236508978f, -0.47139673682599764f, -0.55557023301960218f, -0.63439328416364549f,
        -0.70710678118654752f, -0.77301045336273699f, -0.83146961230254524f, -0.88192126434835505f, -0.92387953251128674f, -0.95694033573220882f, -0.98078528040323043f, -0.99518472667219693f};
    constexpr float S64[32] = {0.0f, 0.098017140329560604f, 0.19509032201612825f, 0.29028467725446233f, 0.38268343236508978f, 0.47139673682599764f, 0.55557023301960218f, 0.63439328416364549f,
        0.70710678118654752f, 0.77301045336273699f, 0.83146961230254524f, 0.88192126434835505f, 0.92387953251128674f, 0.95694033573220882f, 0.98078528040323043f, 0.99518472667219693f,
        1.0f, 0.99518472667219693f, 0.98078528040323043f, 0.95694033573220882f, 0.92387953251128674f, 0.88192126434835505f, 0.83146961230254524f, 0.77301045336273699f,
        0.70710678118654752f, 0.63439328416364549f, 0.55557023301960218f, 0.47139673682599764f, 0.38268343236508978f, 0.29028467725446233f, 0.19509032201612825f, 0.098017140329560604f};
    return cmul(wo, (cpx){C64[n1], -S64[n1]});
}
}

#undef HYF
#ifndef FAST_HY
#define FAST_HY 1
#endif
__device__ __forceinline__ void hyena_fft_unit(const Ctx& c, int layer, int ch, const hyf::ThreadTw& tw) {
    using namespace hyf;
    cpx* lds = (cpx*)c.smem; float* red = (float*)(c.smem + (size_t)FPAD * 8);
    cpx* ks = c.wsp<cpx>(WS_KS) + (size_t)c.bid * (2 * FL);
    float* ub = (float*)(ks + FL); float* yb = ub + FL;
    const int tid = c.tid;
    const float* cw = c.in[8] + (size_t)layer * 3 * 3072; const float* cb = c.in[9] + (size_t)layer * 3072;
    const bf16_t* zv = c.wsp<bf16_t>(WS_ZHYT) + (size_t)ch * MR;
    const bf16_t* KF = c.wsp<bf16_t>(WS_KF);
    { const float w0 = cw[ch], w1 = cw[3072 + ch], w2 = cw[6144 + ch], b = cb[ch]; int tq = tid; HYF_OPAQUE(tq);
#pragma unroll 4
      for (int j = 0; j < 32; ++j) ub[tq + 512 * j] = shortconv_at(zv, tq + 512 * j, L, w0, w1, w2, b); }
#pragma unroll 1
    for (int o = 0; o < 2; ++o) {
        const bf16_t* hf = KF + (size_t)(o * 1024 + ch) * L;
        const bf16_t* hb = KF + (size_t)(2048 + o * 1024 + ch) * L;
        float S;
        {
            cpx v[32]; float sabs = 0.f; int tq = tid; HYF_OPAQUE(tq);
#pragma unroll
            for (int j = 0; j < 32; ++j) { const int n = tq + 512 * j; const float f = bf2f(hf[n]); const float bb = bf2f(hb[n == 0 ? 0 : L - n]);
                v[j] = (cpx){f + bb, 0.f}; sabs += (n == 0) ? fabsf(f + bb) : fabsf(f) + fabsf(bb); }
            S = block_sum(sabs, red, tid);
            fwd_p1(tw, v, lds); __syncthreads(); fwd_p2(tw, lds); __syncthreads(); fwd_p3(tid, tw, lds, ks); __syncthreads();
        }
        {
            cpx v[32]; int tq = tid; HYF_OPAQUE(tq);
#pragma unroll
            for (int j = 0; j < 32; ++j) v[j] = (cpx){ub[tq + 512 * j], 0.f};
            fwd_p1(tw, v, lds); __syncthreads(); fwd_p2(tw, lds); __syncthreads(); mid_p3(tid, tw, lds, ks); __syncthreads();
            inv_p2(tw, lds); __syncthreads();
            inv_p1(tw, lds, v); __syncthreads();
            HYF_OPAQUE(tq);
#pragma unroll
            for (int j = 0; j < 32; ++j) yb[tq + 512 * j] = v[j].x;
        }
        {
            cpx v[32]; const cpx wo = opaque_wo(tw); int tq = tid; HYF_OPAQUE(tq);
#pragma unroll
            for (int j = 0; j < 32; ++j) { const int n = tq + 512 * j; const float f = bf2f(hf[n]); const float bb = bf2f(hb[n == 0 ? 0 : L - n]);
                const float d = (n == 0) ? f + bb : f - bb; v[j] = modfac(wo, j) * d; }
            fwd_p1(tw, v, lds); __syncthreads(); fwd_p2(tw, lds); __syncthreads(); fwd_p3(tid, tw, lds, ks); __syncthreads();
        }
        {
            cpx v[32]; cpx wo = opaque_wo(tw); int tq = tid; HYF_OPAQUE(tq);
#pragma unroll
            for (int j = 0; j < 32; ++j) v[j] = modfac(wo, j) * ub[tq + 512 * j];
            fwd_p1(tw, v, lds); __syncthreads(); fwd_p2(tw, lds); __syncthreads(); mid_p3(tid, tw, lds, ks); __syncthreads();
            inv_p2(tw, lds); __syncthreads();
            inv_p1(tw, lds, v); __syncthreads();
            const float sc = (0.5f / (float)L) / S; wo = opaque_wo(tw); HYF_OPAQUE(tq);
            const float dsk = c.in[17][(size_t)layer * 2048 + o * 1024 + ch];
            const int co = o == 0 ? 1024 : 2048;
            const bf16_t* zz = c.wsp<bf16_t>(WS_ZHYT) + (size_t)(co + ch) * MR;
            const float w0 = cw[co + ch], w1 = cw[3072 + co + ch], w2 = cw[6144 + co + ch], b = cb[co + ch];
            bf16_t* dst = c.wsp<bf16_t>(WS_YHYT) + (size_t)ch * L;
#pragma unroll
            for (int j = 0; j < 32; ++j) { const int t = tq + 512 * j; const cpx m = modfac(wo, j);
                const float conv = (yb[t] + v[j].x * m.x + v[j].y * m.y) * sc;
                const float r = shortconv_at(zz, t, L, w0, w1, w2, b) * (conv + ub[t] * dsk);
                if (o == 0) ub[t] = r; else dst[t] = f2bf(r); }
        }
    }
}


#ifndef FAST_ATT
#define FAST_ATT 1
#endif
namespace fa {
using bf16x8 = __attribute__((ext_vector_type(8))) short;
using s16x4  = __attribute__((ext_vector_type(4))) short;
using f32x16 = __attribute__((ext_vector_type(16))) float;
using u32x4  = __attribute__((ext_vector_type(4))) unsigned;
constexpr int AD = 128, NW = 8, QBLK = 32, KVBLK = 64;
constexpr float SCALE = 0.088388347648318440f;
constexpr float THR = 8.f;
constexpr size_t SHM_V = KVBLK * AD * 2, SHM_K = KVBLK * AD * 2, SHM_ATTN = 2 * SHM_V + 2 * SHM_K + NW * 64 * 4;
constexpr float NEG = -1e30f;
#define KSWZ(row, colB) ((row) * 256 + ((colB) ^ (((row) & 7) << 4)))
#define SBAR() __builtin_amdgcn_sched_barrier(0)
__device__ __forceinline__ int crow(int r, int hi) { return (r & 3) + 8 * (r >> 2) + 4 * hi; }
__device__ __forceinline__ unsigned cvtpk(float lo, float hi) { unsigned r; asm volatile("v_cvt_pk_bf16_f32 %0, %1, %2" : "=v"(r) : "v"(lo), "v"(hi)); return r; }
__device__ __forceinline__ void partialSM(f32x16& p0, f32x16& p1, float& m_reg, float& mn, float& alpha) {
  constexpr float C = SCALE * 1.4426950408889634f;
  float pmax = p0[0];
#pragma unroll
  for (int r = 1; r < 16; ++r) pmax = fmaxf(pmax, p0[r]);
#pragma unroll
  for (int r = 0; r < 16; ++r) pmax = fmaxf(pmax, p1[r]);
  { auto rr = __builtin_amdgcn_permlane32_swap(__float_as_uint(pmax), __float_as_uint(pmax), false, false);
    pmax = fmaxf(__uint_as_float(rr[0]), __uint_as_float(rr[1])); }
  if (__builtin_expect(__all(pmax - m_reg <= THR / SCALE), 1)) { mn = m_reg; alpha = 1.f; }
  else { mn = fmaxf(m_reg, pmax); alpha = __builtin_amdgcn_exp2f((m_reg - mn) * C); m_reg = mn; }
  const float mnC = -mn * C;
#pragma unroll
  for (int r = 0; r < 16; ++r) p0[r] = fmaf(p0[r], C, mnC);
#pragma unroll
  for (int r = 0; r < 16; ++r) p1[r] = fmaf(p1[r], C, mnC);
#pragma unroll
  for (int r = 0; r < 16; ++r) p0[r] = __builtin_amdgcn_exp2f(p0[r]);
}
__device__ __forceinline__ void finishSM(f32x16& p0, f32x16& p1, float alpha, float& l_reg, bf16x8& pa0, bf16x8& pa1, bf16x8& pa2, bf16x8& pa3) {
#pragma unroll
  for (int r = 0; r < 16; ++r) p1[r] = __builtin_amdgcn_exp2f(p1[r]);
  float ps = 0;
#pragma unroll
  for (int r = 0; r < 16; ++r) ps += p0[r];
#pragma unroll
  for (int r = 0; r < 16; ++r) ps += p1[r];
  { auto rr = __builtin_amdgcn_permlane32_swap(__float_as_uint(ps), __float_as_uint(ps), false, false);
    ps = __uint_as_float(rr[0]) + __uint_as_float(rr[1]); }
  l_reg = l_reg * alpha + ps;
#define PK4(P, BASE, OUT) do { unsigned a0 = cvtpk(P[BASE + 0], P[BASE + 1]), a1 = cvtpk(P[BASE + 2], P[BASE + 3]);   \
    unsigned b0 = cvtpk(P[BASE + 4], P[BASE + 5]), b1 = cvtpk(P[BASE + 6], P[BASE + 7]);                              \
    auto r0 = __builtin_amdgcn_permlane32_swap(a0, b0, false, false); auto r1 = __builtin_amdgcn_permlane32_swap(a1, b1, false, false); \
    u32x4 w = {r0[0], r1[0], r0[1], r1[1]}; OUT = *reinterpret_cast<bf16x8*>(&w); } while (0)
  PK4(p0, 0, pa0); PK4(p0, 8, pa1); PK4(p1, 0, pa2); PK4(p1, 8, pa3);
#undef PK4
}
__device__ __forceinline__ void qkt(f32x16& p0, f32x16& p1, const char* Ks, const bf16x8* qr, int r32, int hi) {
  p0 = f32x16{}; p1 = f32x16{};
#pragma unroll
  for (int d0 = 0; d0 < 8; ++d0) { const int cb = (d0 * 16 + hi * 8) * 2;
    const bf16x8 b0 = *reinterpret_cast<const bf16x8*>(Ks + KSWZ(r32, cb));
    const bf16x8 b1 = *reinterpret_cast<const bf16x8*>(Ks + KSWZ(32 + r32, cb));
    p0 = __builtin_amdgcn_mfma_f32_32x32x16_bf16(b0, qr[d0], p0, 0, 0, 0);
    p1 = __builtin_amdgcn_mfma_f32_32x32x16_bf16(b1, qr[d0], p1, 0, 0, 0); }
}
__device__ __forceinline__ int v_st(int k, int c) { const int kk = (k & ~0xC) | ((k & 4) << 1) | ((k & 8) >> 1); return ((kk >> 3) * 4 + (c >> 5)) * 512 + ((kk & 7) * 32 + (c & 31)) * 2; }
__device__ __forceinline__ int v_rd_base(int lane) { return ((lane & 3) << 3) | (((lane >> 2) & 3) << 6) | (((lane >> 4) & 1) << 5) | (((lane >> 5) & 1) << 8); }
constexpr int v_rd_off(int d0, int ks, int half) { return d0 * 512 + ks * 4096 + half * 2048; }
template <int OFF> __device__ __forceinline__ s16x4 tr_read(int vb) { s16x4 r; asm volatile("ds_read_b64_tr_b16 %0, %1 offset:%2" : "=&v"(r) : "v"(vb), "i"(OFF) : "memory"); return r; }
template <int D0> __device__ __forceinline__ void pv_one(f32x16& od, int vb, bf16x8 pa0, bf16x8 pa1, bf16x8 pa2, bf16x8 pa3) {
  const s16x4 l0 = tr_read<v_rd_off(D0, 0, 0)>(vb), h0 = tr_read<v_rd_off(D0, 0, 1)>(vb), l1 = tr_read<v_rd_off(D0, 1, 0)>(vb), h1 = tr_read<v_rd_off(D0, 1, 1)>(vb);
  const s16x4 l2 = tr_read<v_rd_off(D0, 2, 0)>(vb), h2 = tr_read<v_rd_off(D0, 2, 1)>(vb), l3 = tr_read<v_rd_off(D0, 3, 0)>(vb), h3 = tr_read<v_rd_off(D0, 3, 1)>(vb);
  asm volatile("s_waitcnt lgkmcnt(0)" ::: "memory"); SBAR();
#define PK(Lo, Hi) (bf16x8){Lo[0], Lo[1], Lo[2], Lo[3], Hi[0], Hi[1], Hi[2], Hi[3]}
  od = __builtin_amdgcn_mfma_f32_32x32x16_bf16(pa0, PK(l0, h0), od, 0, 0, 0);
  od = __builtin_amdgcn_mfma_f32_32x32x16_bf16(pa1, PK(l1, h1), od, 0, 0, 0);
  od = __builtin_amdgcn_mfma_f32_32x32x16_bf16(pa2, PK(l2, h2), od, 0, 0, 0);
  od = __builtin_amdgcn_mfma_f32_32x32x16_bf16(pa3, PK(l3, h3), od, 0, 0, 0);
#undef PK
}
__device__ __forceinline__ void pv_d0(f32x16* o, int vb, bf16x8 pa0, bf16x8 pa1, bf16x8 pa2, bf16x8 pa3) {
  pv_one<0>(o[0], vb, pa0, pa1, pa2, pa3); pv_one<1>(o[1], vb, pa0, pa1, pa2, pa3); pv_one<2>(o[2], vb, pa0, pa1, pa2, pa3); pv_one<3>(o[3], vb, pa0, pa1, pa2, pa3);
}

template <class Tiles>
__device__ __forceinline__ void attn_unit(const bf16_t* __restrict__ Qb, int ldq, const bf16_t* __restrict__ Kb, const bf16_t* __restrict__ Vb, int ldk,
                                          bf16_t* __restrict__ Ob, int ldo, const Tiles& T, int NT, bool has_sink, float sink, char* lds) {
  int tid = threadIdx.x; asm volatile("" : "+v"(tid));
  const int wid = __builtin_amdgcn_readfirstlane(tid >> 6), lane = tid & 63, r32 = lane & 31, hi = lane >> 5;
  char* V_lds = lds; char* K_lds = lds + 2 * SHM_V;
  float* ws = (float*)(lds + 2 * SHM_V + 2 * SHM_K) + wid * 64; float* li_l = ws; float* al_l = ws + 32;
  float m_reg = -1e30f, l_reg = 0; f32x16 o[4] = {}; bf16x8 qr[8];
  const bf16_t* Qw = Qb + (long)(wid * QBLK + r32) * ldq + hi * 8;
#pragma unroll
  for (int d0 = 0; d0 < 8; ++d0) qr[d0] = *reinterpret_cast<const bf16x8*>(Qw + d0 * 16);
  const int sr = tid >> 4, sc = (tid & 15) * 8, vst0 = v_st(sr, sc), vst1 = v_st(32 + sr, sc);
  const int vb0 = (int)(uintptr_t)V_lds + v_rd_base(lane);
  bf16x8 vs0, vs1, ks0, ks1;
#define SLOAD(j) do { const long _k0 = T.row(j); vs0 = *reinterpret_cast<const bf16x8*>(&Vb[(_k0 + sr) * ldk + sc]); vs1 = *reinterpret_cast<const bf16x8*>(&Vb[(_k0 + 32 + sr) * ldk + sc]); \
    ks0 = *reinterpret_cast<const bf16x8*>(&Kb[(_k0 + sr) * ldk + sc]); ks1 = *reinterpret_cast<const bf16x8*>(&Kb[(_k0 + 32 + sr) * ldk + sc]); } while (0)
#define SWRITE(b) do { *(bf16x8*)(V_lds + (b) * SHM_V + vst0) = vs0; *(bf16x8*)(V_lds + (b) * SHM_V + vst1) = vs1; const int kc = sc * 2; \
    *(bf16x8*)(K_lds + (b) * SHM_K + KSWZ(sr, kc)) = ks0; *(bf16x8*)(K_lds + (b) * SHM_K + KSWZ(32 + sr, kc)) = ks1; } while (0)
  __syncthreads();
  SLOAD(0); asm volatile("s_waitcnt vmcnt(0)" ::: "memory"); SWRITE(0);
  if (1 < NT) SLOAD(1);
#pragma unroll 1
  for (int j = 0; j < NT; ++j) {
    const int b = j & 1;
    __syncthreads();
    if (j + 1 < NT) { asm volatile("s_waitcnt vmcnt(0)" ::: "memory"); SWRITE(b ^ 1); if (j + 2 < NT) SLOAD(j + 2); }
    if (T.active(j, wid)) {
      f32x16 p0, p1; float mn, alpha; bf16x8 pa0, pa1, pa2, pa3;
      qkt(p0, p1, K_lds + b * SHM_K, qr, r32, hi); T.mask(p0, p1, j, wid, r32, hi);
      partialSM(p0, p1, m_reg, mn, alpha);
      if (__any(alpha < 1.f)) { if (hi == 0) al_l[r32] = alpha; asm volatile("s_waitcnt lgkmcnt(0)" ::: "memory");
#pragma unroll
        for (int d = 0; d < 4; ++d)
#pragma unroll
          for (int r = 0; r < 16; ++r) o[d][r] *= al_l[crow(r, hi)]; }
      finishSM(p0, p1, alpha, l_reg, pa0, pa1, pa2, pa3); SBAR();
      pv_d0(o, vb0 + b * (int)SHM_V, pa0, pa1, pa2, pa3);
    }
  }
  if (has_sink) { constexpr float C = SCALE * 1.4426950408889634f; l_reg += __builtin_amdgcn_exp2f(fmaf(sink, 1.4426950408889634f, -m_reg * C)); }
  if (hi == 0) li_l[r32] = l_reg; asm volatile("s_waitcnt lgkmcnt(0)" ::: "memory");
  float rli[16];
#pragma unroll
  for (int r = 0; r < 16; ++r) rli[r] = __builtin_amdgcn_rcpf(li_l[crow(r, hi)]);
  bf16_t* Ow = Ob + (long)(wid * QBLK) * ldo;
#pragma unroll
  for (int r = 0; r < 16; ++r) { const int orow = crow(r, hi);
#pragma unroll
    for (int d0 = 0; d0 < 4; ++d0) Ow[(long)orow * ldo + d0 * 32 + r32] = f2bf(o[d0][r] * rli[r]); }
#undef SLOAD
#undef SWRITE
}
#undef KSWZ
#undef SBAR

struct TilesGen {
  int mode, i0, lo, R, glo, nloc; const float* bias;
  __device__ __forceinline__ long row(int j) const {
    if (j < 4) return L + 64 * j;
    if (mode == 0) return lo + 64 * (j - 4);
    return (long)(glo + (j - 4)) * 64;
  }
  __device__ __forceinline__ bool active(int j, int wid) const {
    if (j < 4 || mode == 2) return true;
    if (mode == 0) { const int Tr = lo + 64 * (j - 4), q0 = i0 + 32 * wid; return Tr + 63 >= q0 - 128 && Tr <= q0 + 31 + 128; }
    const int kr = glo + (j - 4), qr = R + (wid >> 1);
    int r0 = qr - 4; r0 = r0 < 0 ? 0 : (r0 > 248 ? 248 : r0);
    return kr >= r0 && kr <= r0 + 7;
  }
  __device__ __forceinline__ void mask(f32x16& p0, f32x16& p1, int j, int wid, int r32, int hi) const {
    if (j < 4 || mode == 2) return;
    if (mode == 0) {
      const int Tr = lo + 64 * (j - 4), q0 = i0 + 32 * wid;
      if (q0 + 31 - Tr <= 128 && Tr + 63 - q0 <= 128) return;
      const int dq = q0 + r32 - Tr;
#pragma unroll
      for (int r = 0; r < 16; ++r) { const int kk = crow(r, hi); p0[r] = (kk >= dq - 128 && kk <= dq + 128) ? p0[r] : NEG; p1[r] = (kk + 32 >= dq - 128 && kk + 32 <= dq + 128) ? p1[r] : NEG; }
      return;
    }
    const int kr = glo + (j - 4), qr = R + (wid >> 1), qc = (wid & 1) * 32 + r32;
    int cs = qc - 8; cs = cs < 0 ? 0 : (cs > 48 ? 48 : cs);
    const float* bt = bias + (kr - qr + 7) * 32 + (15 - qc);
#pragma unroll
    for (int r = 0; r < 16; ++r) { const int k0 = crow(r, hi), k1 = k0 + 32;
      const bool v0 = (unsigned)(k0 - cs) < 16u, v1 = (unsigned)(k1 - cs) < 16u;
      p0[r] = v0 ? p0[r] + bt[v0 ? k0 : cs] : NEG; p1[r] = v1 ? p1[r] + bt[v1 ? k1 : cs] : NEG; }
  }
};
}

__device__ __forceinline__ void ph_attn_fast(const Ctx& c, int layer) {
  char* lds = (char*)c.smem;
  float* btab = (float*)(c.smem + fa::SHM_ATTN);
  const bf16_t* QWA = c.wsp<bf16_t>(WS_QWA); const bf16_t* KVWA = c.wsp<bf16_t>(WS_KVWA); bf16_t* YWA = c.wsp<bf16_t>(WS_YWA);
  const bf16_t* QNA = c.wsp<bf16_t>(WS_QNA); const bf16_t* KVNA = c.wsp<bf16_t>(WS_KVNA); bf16_t* YNA = c.wsp<bf16_t>(WS_YNA);
  const float* sinkp = c.in[20] + layer * 8; const float* rpb = c.in[23] + (size_t)layer * 8 * 15 * 31;
  const int nq = L / 256;
  const int nunits = 2 * 8 * nq + (layer == 0 ? 16 : 0);
#pragma unroll 1
  for (int u = c.bid; u < nunits; u += c.nb) {
    fa::TilesGen T; T.mode = 2; T.i0 = 0; T.lo = 0; T.R = 0; T.glo = 0; T.nloc = 0; T.bias = btab;
    int h, i0, NT; bool wa;
    if (u < 8 * nq) {
      wa = true; h = u / nq; i0 = (u % nq) * 256;
      const int lo = i0 - 128 < 0 ? 0 : i0 - 128, hiR = i0 + 384 > L ? L : i0 + 384;
      T.mode = 0; T.i0 = i0; T.lo = lo; NT = 4 + (hiR - lo) / 64;
    } else if (u < 16 * nq) {
      const int v = u - 8 * nq; wa = false; h = v / nq; const int qb = v % nq; i0 = qb * 256; const int R = qb * 4;
      int glo = R - 4; glo = glo < 0 ? 0 : (glo > 248 ? 248 : glo);
      int gh = R + 3 - 4; gh = gh < 0 ? 0 : (gh > 248 ? 248 : gh); gh += 7;
      T.mode = 1; T.R = R; T.glo = glo; T.nloc = gh - glo + 1; NT = 4 + T.nloc;
      __syncthreads();
      for (int e = c.tid; e < 15 * 32; e += NTHREADS) { const int dr = e >> 5, dc = e & 31; btab[e] = dc < 31 ? rpb[(h * 15 + dr) * 31 + dc] * (1.0f / fa::SCALE) : 0.f; }
    } else {
      const int v = u - 16 * nq; wa = v < 8; h = v & 7; i0 = L; NT = 4;
    }
    const bf16_t* Q = (wa ? QWA : QNA) + (size_t)i0 * 1024 + h * 128;
    const bf16_t* Kb = wa ? KVWA + (h >> 2) * 128 : KVNA + h * 128;
    const bf16_t* Vb = wa ? KVWA + 256 + (h >> 2) * 128 : KVNA + 1024 + h * 128;
    bf16_t* O = (wa ? YWA : YNA) + (size_t)i0 * 1024 + h * 128;
    fa::attn_unit(Q, 1024, Kb, Vb, wa ? 512 : 2048, O, 1024, T, NT, wa, wa ? sinkp[h] : 0.f, lds);
  }
}

__device__ __forceinline__ void ph_c(const Ctx& c, int layer) {
#ifndef NO_HY
    if (FAST_HY) {
        hyf::ThreadTw tw; hyf::tw_addr(c.tid, tw);
        { float s_, c_; sincospif(-2.0f * (float)c.tid / (float)hyf::FL, &s_, &c_); tw.w1 = (hyf::cpx){c_, s_};
          sincospif(-2.0f * (float)(c.tid & 15) / 512.0f, &s_, &c_); tw.w2 = (hyf::cpx){c_, s_};
          sincospif(-(float)c.tid / (float)hyf::FL, &s_, &c_); tw.wo = (hyf::cpx){c_, s_}; }
        for (int u = c.bid; u < 1024; u += c.nb) hyena_fft_unit(c, layer, u, tw);
        if constexpr (DOREP(16)) { for (int u = c.bid; u < 1024; u += c.nb) hyena_fft_unit(c, layer, u, tw); }
    } else
    for (int u = c.bid; u < 1024; u += c.nb) hyena_direct_unit(c, layer, u);
#endif
#ifndef NO_HYC
    if (layer == 0) for (int u = c.bid; u < 1024; u += c.nb) hyena_ctx_unit(c, layer, u);
#endif
    __syncthreads();
#ifndef NO_ATT
    if (FAST_ATT) { ph_attn_fast(c, layer); return; }
    const int gw = c.bid * 8 + c.wave, ngw = c.nb * 8;
    float* wl = (float*)c.smem + c.wave * 768;
    const int nrows = layer == 0 ? MR : L;
    const float* sinkp = c.in[20] + layer * 8;
    const float* rpb = c.in[23] + (size_t)layer * 8 * 15 * 31;
    const bf16_t* kvwa = c.wsp<bf16_t>(WS_KVWA); const bf16_t* kvna = c.wsp<bf16_t>(WS_KVNA);
    for (int task = gw; task < nrows * 16; task += ngw) {
        const int r = task >> 4, hh = task & 15;
        if (hh < 8) {
            const int h = hh; const bf16_t* q = c.wsp<bf16_t>(WS_QWA) + (size_t)r * 1024 + h * 128; bf16_t* o = c.wsp<bf16_t>(WS_YWA) + (size_t)r * 1024 + h * 128;
            if (r < L) { const KeyWA k{kvwa, r, h >> 2}; wave_attn(q, 513, k, true, sinkp[h], o, wl, c.lane); }
            else { const KeyCtxWA k{kvwa, h >> 2}; wave_attn(q, 256, k, true, sinkp[h], o, wl, c.lane); }
        } else {
            const int h = hh - 8; const bf16_t* q = c.wsp<bf16_t>(WS_QNA) + (size_t)r * 1024 + h * 128; bf16_t* o = c.wsp<bf16_t>(WS_YNA) + (size_t)r * 1024 + h * 128;
            if (r < L) { const int gr = r / GRIDW, qc = r % GRIDW; int r0 = gr - 4; r0 = r0 < 0 ? 0 : (r0 > 248 ? 248 : r0); int cs = qc - 8; cs = cs < 0 ? 0 : (cs > 48 ? 48 : cs);
                const KeyNA k{kvna, rpb, gr, qc, r0, cs, h}; wave_attn(q, 384, k, false, 0.f, o, wl, c.lane); }
            else { const KeyCtxNA k{kvna, h}; wave_attn(q, 256, k, false, 0.f, o, wl, c.lane); }
        }
    }
#endif
}

__device__ __forceinline__ void ph_c2(const Ctx& c) {
    bf16_t* tile = (bf16_t*)c.smem;
    const bf16_t* src = c.wsp<bf16_t>(WS_YHYT); bf16_t* dst = c.wsp<bf16_t>(WS_YHY);
    const int tid = c.tid, a = tid >> 3, b8 = (tid & 7) * 8;
    for (int u = c.bid; u < (1024 / 64) * (L / 64); u += c.nb) {
        const int c0 = (u % 16) * 64, t0 = (u / 16) * 64;
        const uint4 v = *(const uint4*)(src + (size_t)(c0 + a) * L + t0 + b8);
        __syncthreads();
        *(uint4*)(tile + a * 72 + b8) = v;
        __syncthreads();
        unsigned short e[8];
#pragma unroll
        for (int i = 0; i < 8; ++i) e[i] = tile[(b8 + i) * 72 + a];
        uint4 o; o.x = e[0] | ((unsigned)e[1] << 16); o.y = e[2] | ((unsigned)e[3] << 16); o.z = e[4] | ((unsigned)e[5] << 16); o.w = e[6] | ((unsigned)e[7] << 16);
        *(uint4*)(dst + (size_t)(t0 + a) * 1024 + c0 + b8) = o;
    }
}

struct EpiMerge { unsigned char* ws; int b;
    __device__ __forceinline__ void operator()(int row, int col, const float (&v)[8]) const {
        const bf16_t* g = (const bf16_t*)(ws + WS_GATE) + (size_t)row * 6144 + b * 2048 + col;
        float* mp = (float*)(ws + WS_MPART) + (size_t)row * D + col;
        const uint4 gg = *(const uint4*)g;
        const float gv[8] = {__uint_as_float(gg.x << 16), __uint_as_float(gg.x & 0xffff0000u), __uint_as_float(gg.y << 16), __uint_as_float(gg.y & 0xffff0000u),
                             __uint_as_float(gg.z << 16), __uint_as_float(gg.z & 0xffff0000u), __uint_as_float(gg.w << 16), __uint_as_float(gg.w & 0xffff0000u)};
        float t[8];
        if (b == 0) {
#pragma unroll
            for (int j = 0; j < 8; ++j) t[j] = gv[j] * v[j];
        } else {
            const float4 p0 = *(const float4*)mp, p1 = *(const float4*)(mp + 4);
            const float pv[8] = {p0.x, p0.y, p0.z, p0.w, p1.x, p1.y, p1.z, p1.w};
#pragma unroll
            for (int j = 0; j < 8; ++j) t[j] = fmaf(gv[j], v[j], pv[j]);
        }
        if (b < 2) { *(float4*)mp = make_float4(t[0], t[1], t[2], t[3]); *(float4*)(mp + 4) = make_float4(t[4], t[5], t[6], t[7]); }
        else { uint4 o; o.x = pk2(t[0], t[1]); o.y = pk2(t[2], t[3]); o.z = pk2(t[4], t[5]); o.w = pk2(t[6], t[7]); *(uint4*)((bf16_t*)(ws + WS_MB) + (size_t)row * D + col) = o; }
    }
};
__device__ __forceinline__ void ph_d(const Ctx& c, int layer) {
    const int nM = MR / 128, nN = D / 128;
    for (int b = 0; b < 3; ++b) {
        const bf16_t* A = b == 0 ? c.wsp<bf16_t>(WS_YHY) : (b == 1 ? c.wsp<bf16_t>(WS_YWA) : c.wsp<bf16_t>(WS_YNA));
        const RowLin rp{A, 1024}; const EpiMerge ep{c.ws, b};
        const float* W = c.in[24] + ((size_t)layer * 3 + b) * 1024 * D;
        for (int u = c.bid; u < nM * nN; u += c.nb) sgemm_unit(rp, W, D, 1024, (u % nM) * 128, (u / nM) * 128, ep, (float*)c.smem, c.tid);
    }
}
struct EpiOut { const Ctx* c; int layer;
    __device__ __forceinline__ void operator()(int row, int col, const float (&v)[8]) const {
        const float* xin = c->xrow(layer, row) + col; const float* g = c->mod(layer, row < L ? 0 : 1, 2) + col;
        float* o = (float*)(c->ws + WS_XA) + (size_t)row * D + col;
        const float4 x0 = *(const float4*)xin, x1 = *(const float4*)(xin + 4), g0 = *(const float4*)g, g1 = *(const float4*)(g + 4);
        *(float4*)o = make_float4(x0.x + g0.x * v[0], x0.y + g0.y * v[1], x0.z + g0.z * v[2], x0.w + g0.w * v[3]);
        *(float4*)(o + 4) = make_float4(x1.x + g1.x * v[4], x1.y + g1.y * v[5], x1.z + g1.z * v[6], x1.w + g1.w * v[7]);
    }
};
__device__ __forceinline__ void ph_e(const Ctx& c, int layer) {
    const int nM = MR / 128, nN = D / 128;
    const RowLin rp{c.wsp<bf16_t>(WS_MB), D}; const EpiOut ep{&c, layer};
    const float* W = c.in[25] + (size_t)layer * D * D;
    for (int u = c.bid; u < nM * nN; u += c.nb) sgemm_unit(rp, W, D, D, (u % nM) * 128, (u / nM) * 128, ep, (float*)c.smem, c.tid);
}

__device__ __forceinline__ void ph_f(const Ctx& c, int layer) {
    const int gw = c.bid * 8 + c.wave, ngw = c.nb * 8;
    const float* g = c.in[26] + (size_t)layer * D;
    const float* wr = c.in[27] + (size_t)layer * D * NE;
    float* wl = (float*)c.smem; float* gl = wl + NE * D;
    __syncthreads();
    for (int i = c.tid; i < D * NE / 4; i += NTHREADS) { const float4 v = *(const float4*)(wr + 4 * i); const int col = i >> 2, e0 = (i & 3) * 4;
        wl[(e0 + 0) * D + col] = v.x; wl[(e0 + 1) * D + col] = v.y; wl[(e0 + 2) * D + col] = v.z; wl[(e0 + 3) * D + col] = v.w; }
    for (int i = c.tid; i < D; i += NTHREADS) { gl[i] = g[i]; gl[D + i] = c.mod(layer, 0, 3)[i]; gl[2 * D + i] = c.mod(layer, 0, 4)[i]; }
    __syncthreads();
    const int nrows = layer == 0 ? MR : L;
    for (int r = gw; r < nrows; r += ngw) {
        const float* x = c.wsp<float>(WS_XA) + (size_t)r * D;
        const bool lat = r < L;
        const float* shg = c.mod(layer, 1, 3); const float* scg = c.mod(layer, 1, 4);
        float4 v[8]; float ss = 0.f;
#pragma unroll
        for (int j = 0; j < 8; ++j) { v[j] = *(const float4*)(x + 4 * c.lane + 256 * j); ss += v[j].x * v[j].x + v[j].y * v[j].y + v[j].z * v[j].z + v[j].w * v[j].w; }
        ss = wave_sum(ss);
        const float inv = rsqrtf(ss * (1.0f / D) + RMS_EPS);
        bf16_t* o = c.wsp<bf16_t>(WS_H2) + (size_t)r * D;
        float lg[NE];
#pragma unroll
        for (int e = 0; e < NE; ++e) lg[e] = 0.f;
#pragma unroll
        for (int j = 0; j < 8; ++j) {
            const int col = 4 * c.lane + 256 * j;
            const float4 gg = *(const float4*)(gl + col);
            const float4 s4 = lat ? *(const float4*)(gl + D + col) : *(const float4*)(shg + col);
            const float4 c4 = lat ? *(const float4*)(gl + 2 * D + col) : *(const float4*)(scg + col);
            const float y0 = v[j].x * inv * gg.x * (1.f + c4.x) + s4.x, y1 = v[j].y * inv * gg.y * (1.f + c4.y) + s4.y;
            const float y2 = v[j].z * inv * gg.z * (1.f + c4.z) + s4.z, y3 = v[j].w * inv * gg.w * (1.f + c4.w) + s4.w;
            uint2 w; w.x = pk2(y0, y1); w.y = pk2(y2, y3);
            *(uint2*)(o + col) = w;
#pragma unroll
            for (int e = 0; e < NE; ++e) { const float4 w4 = *(const float4*)(wl + e * D + col); lg[e] = fmaf(y0, w4.x, fmaf(y1, w4.y, fmaf(y2, w4.z, fmaf(y3, w4.w, lg[e])))); }
            __builtin_amdgcn_sched_barrier(0);
        }
        float mx = -3e38f;
#pragma unroll
        for (int e = 0; e < NE; ++e) { lg[e] = wave_sum(lg[e]); mx = fmaxf(mx, lg[e]); }
        float sum = 0.f;
#pragma unroll
        for (int e = 0; e < NE; ++e) { lg[e] = expf(lg[e] - mx); sum += lg[e]; }
        float mine = 0.f;
#pragma unroll
        for (int e = 0; e < NE; ++e) mine = (c.lane == e) ? lg[e] / sum : mine;
        if (c.lane < NE) c.wsp<float>(WS_AFF)[(size_t)r * NE + c.lane] = mine;
    }
}

__device__ __forceinline__ void topk_unit(const Ctx& c, int e, int row0, int n, int K, int slot0) {
    unsigned* sh = (unsigned*)c.smem;
    const int tid = c.tid, lane = c.lane, wave = c.wave;
    const float* aff = c.wsp<float>(WS_AFF);
    unsigned key[32];
#pragma unroll
    for (int j = 0; j < 32; ++j) { const int t = tid + NTHREADS * j; key[j] = t < n ? __float_as_uint(aff[(size_t)(row0 + t) * NE + e]) : 0u; }
    unsigned T = 0u;
#pragma unroll 1
    for (int bit = 30; bit >= 0; bit -= 2) {
        const unsigned t1 = T | (1u << bit), t2 = T | (2u << bit), t3 = T | (3u << bit);
        unsigned c1 = 0u, c2 = 0u, c3 = 0u;
#pragma unroll
        for (int j = 0; j < 32; ++j) { c1 += key[j] >= t1 ? 1u : 0u; c2 += key[j] >= t2 ? 1u : 0u; c3 += key[j] >= t3 ? 1u : 0u; }
#pragma unroll
        for (int o = 1; o < 64; o <<= 1) { c1 += __shfl_xor(c1, o); c2 += __shfl_xor(c2, o); c3 += __shfl_xor(c3, o); }
        __syncthreads();
        if (lane == 0) { sh[wave] = c1; sh[8 + wave] = c2; sh[16 + wave] = c3; }
        __syncthreads();
        unsigned s1 = 0u, s2 = 0u, s3 = 0u;
#pragma unroll
        for (int w = 0; w < 8; ++w) { s1 += sh[w]; s2 += sh[8 + w]; s3 += sh[16 + w]; }
        T = s3 >= (unsigned)K ? t3 : (s2 >= (unsigned)K ? t2 : (s1 >= (unsigned)K ? t1 : T));
    }
    unsigned ng = 0u, neq = 0u;
#pragma unroll
    for (int j = 0; j < 32; ++j) { ng += key[j] > T ? 1u : 0u; neq += (key[j] == T && tid + NTHREADS * j < n) ? 1u : 0u; }
    unsigned ig = ng, ie = neq;
#pragma unroll
    for (int o = 1; o < 64; o <<= 1) { const unsigned a = __shfl_up(ig, o), b = __shfl_up(ie, o); if (lane >= o) { ig += a; ie += b; } }
    __syncthreads();
    if (lane == 63) { sh[32 + wave] = ig; sh[40 + wave] = ie; }
    __syncthreads();
    unsigned og = 0u, oe = 0u, totg = 0u, tote = 0u;
#pragma unroll
    for (int w = 0; w < 8; ++w) { const unsigned a = sh[32 + w], b = sh[40 + w]; if (w < wave) { og += a; oe += b; } totg += a; tote += b; }
    const unsigned need = (unsigned)K - totg;
    unsigned pg = og + ig - ng;
    int* IDX = c.wsp<int>(WS_IDX) + (size_t)e * SLOTS; float* GS = c.wsp<float>(WS_GSEL) + (size_t)e * SLOTS; int* SL = c.wsp<int>(WS_SLOT) + (size_t)e * MR;
    if (tote == need) {
        unsigned pe = totg + oe + ie - neq;
#pragma unroll
        for (int j = 0; j < 32; ++j) { const int t = tid + NTHREADS * j;
            if (t < n) { int slot = -1; if (key[j] > T) slot = (int)pg++; else if (key[j] == T) slot = (int)pe++;
                SL[row0 + t] = slot >= 0 ? slot0 + slot : -1; if (slot >= 0) { IDX[slot0 + slot] = row0 + t; GS[slot0 + slot] = __uint_as_float(key[j]); } } }
    } else {
        unsigned base_eq = 0u;
#pragma unroll 1
        for (int j = 0; j < 32; ++j) { const int t = tid + NTHREADS * j;
            const unsigned kj = t < n ? __float_as_uint(aff[(size_t)(row0 + t) * NE + e]) : 0u;
            const bool eq = t < n && kj == T;
            const unsigned long long me = __ballot(eq);
            const unsigned long long lower = (lane == 0) ? 0ull : (~0ull >> (64 - lane));
            const unsigned re = (unsigned)__popcll(me & lower);
            __syncthreads();
            if (lane == 0) sh[48 + wave] = (unsigned)__popcll(me);
            __syncthreads();
            unsigned oq = 0u, tq = 0u;
#pragma unroll
            for (int w = 0; w < 8; ++w) { const unsigned a = sh[48 + w]; if (w < wave) oq += a; tq += a; }
            if (t < n) { int slot = -1; if (kj > T) slot = (int)pg++; else if (eq) { const unsigned rk = base_eq + oq + re; if (rk < need) slot = (int)(totg + rk); }
                SL[row0 + t] = slot >= 0 ? slot0 + slot : -1; if (slot >= 0) { IDX[slot0 + slot] = row0 + t; GS[slot0 + slot] = __uint_as_float(kj); } }
            base_eq += tq;
        }
    }
    __syncthreads();
}
__device__ __forceinline__ void ph_g(const Ctx& c) {
    for (int u = c.bid; u < 32; u += c.nb) {
        if (u < 16) topk_unit(c, u, 0, L, CAP, 0);
        else { const int e = u - 16; topk_unit(c, e, L, LC, CAPC, CAP);
            for (int s = CAP + CAPC + c.tid; s < SLOTS; s += NTHREADS) { c.wsp<int>(WS_IDX)[(size_t)e * SLOTS + s] = 0; c.wsp<float>(WS_GSEL)[(size_t)e * SLOTS + s] = 0.f; } }
    }
}

struct EpiGate { float* tmp; __device__ __forceinline__ void operator()(int row, int col, const float (&v)[8]) const {
    float* p = tmp + (size_t)row * DF + col; *(float4*)p = make_float4(v[0], v[1], v[2], v[3]); *(float4*)(p + 4) = make_float4(v[4], v[5], v[6], v[7]); } };
struct EpiUp { const float* tmp; bf16_t* act; __device__ __forceinline__ void operator()(int row, int col, const float (&v)[8]) const {
    const float* p = tmp + (size_t)row * DF + col; const float4 a0 = *(const float4*)p, a1 = *(const float4*)(p + 4);
    const float a[8] = {a0.x, a0.y, a0.z, a0.w, a1.x, a1.y, a1.z, a1.w}; float t[8];
#pragma unroll
    for (int j = 0; j < 8; ++j) t[j] = silu_f(a[j]) * v[j];
    uint4 o; o.x = pk2(t[0], t[1]); o.y = pk2(t[2], t[3]); o.z = pk2(t[4], t[5]); o.w = pk2(t[6], t[7]);
    *(uint4*)(act + (size_t)row * DF + col) = o; } };
struct EpiDown { bf16_t* ye; __device__ __forceinline__ void operator()(int row, int col, const float (&v)[8]) const {
    uint4 o; o.x = pk2(v[0], v[1]); o.y = pk2(v[2], v[3]); o.z = pk2(v[4], v[5]); o.w = pk2(v[6], v[7]);
    *(uint4*)(ye + (size_t)row * D + col) = o; } };
__device__ __forceinline__ void ph_h(const Ctx& c, int layer) {
    const int nM = SLOTS / 128, nN = DF / 128;
    for (int which = 0; which < 2; ++which)
        for (int u = c.bid; u < NE * nM * nN; u += c.nb) {
            const int e = u / (nM * nN), r = u % (nM * nN), pm = r % nM, pn = r / nM;
            const RowGather rp{c.wsp<bf16_t>(WS_H2), D, c.wsp<int>(WS_IDX) + (size_t)e * SLOTS};
            float* tmp = c.wsp<float>(WS_TMP) + (size_t)e * SLOTS * DF;
            const float* W = c.in[which == 0 ? 28 : 29] + ((size_t)layer * NE + e) * D * DF;
            if (which == 0) { const EpiGate ep{tmp}; sgemm_unit(rp, W, DF, D, pm * 128, pn * 128, ep, (float*)c.smem, c.tid); }
            else { const EpiUp ep{tmp, c.wsp<bf16_t>(WS_ACT) + (size_t)e * SLOTS * DF}; sgemm_unit(rp, W, DF, D, pm * 128, pn * 128, ep, (float*)c.smem, c.tid); }
        }
}
__device__ __forceinline__ void ph_i(const Ctx& c, int layer) {
    const int nM = SLOTS / 128, nN = D / 128;
    for (int u = c.bid; u < NE * nM * nN; u += c.nb) {
        const int e = u / (nM * nN), r = u % (nM * nN), pm = r % nM, pn = r / nM;
        const RowLin rp{c.wsp<bf16_t>(WS_ACT) + (size_t)e * SLOTS * DF, DF};
        const EpiDown ep{c.wsp<bf16_t>(WS_YE) + (size_t)e * SLOTS * D};
        const float* W = c.in[30] + ((size_t)layer * NE + e) * DF * D;
        sgemm_unit(rp, W, D, DF, pm * 128, pn * 128, ep, (float*)c.smem, c.tid);
    }
}

__device__ __forceinline__ void ph_j(const Ctx& c, int layer) {
    const int gw = c.bid * 8 + c.wave, ngw = c.nb * 8;
    const int nrows = layer == 0 ? MR : L;
    for (int r = gw; r < nrows; r += ngw) {
        const float* x1 = c.wsp<float>(WS_XA) + (size_t)r * D;
        const float* g5 = c.mod(layer, r < L ? 0 : 1, 5);
        float* o = layer == 0 ? c.wsp<float>(WS_XB) + (size_t)r * D : c.out + (size_t)r * D;
        float acc[32];
#pragma unroll
        for (int j = 0; j < 32; ++j) acc[j] = 0.f;
        for (int e = 0; e < NE; ++e) {
            const int s = c.wsp<int>(WS_SLOT)[(size_t)e * MR + r];
            if (s >= 0) {
                const float gs = c.wsp<float>(WS_GSEL)[(size_t)e * SLOTS + s];
                const bf16_t* y = c.wsp<bf16_t>(WS_YE) + ((size_t)e * SLOTS + s) * D;
#pragma unroll
                for (int j = 0; j < 8; ++j) { const uint2 w = *(const uint2*)(y + 4 * c.lane + 256 * j);
                    acc[4 * j + 0] = fmaf(gs, __uint_as_float(w.x << 16), acc[4 * j + 0]); acc[4 * j + 1] = fmaf(gs, __uint_as_float(w.x & 0xffff0000u), acc[4 * j + 1]);
                    acc[4 * j + 2] = fmaf(gs, __uint_as_float(w.y << 16), acc[4 * j + 2]); acc[4 * j + 3] = fmaf(gs, __uint_as_float(w.y & 0xffff0000u), acc[4 * j + 3]); }
            }
        }
#pragma unroll
        for (int j = 0; j < 8; ++j) { const int col = 4 * c.lane + 256 * j; const float4 xv = *(const float4*)(x1 + col), gv = *(const float4*)(g5 + col);
            *(float4*)(o + col) = make_float4(xv.x + gv.x * acc[4 * j], xv.y + gv.y * acc[4 * j + 1], xv.z + gv.z * acc[4 * j + 2], xv.w + gv.w * acc[4 * j + 3]); }
    }
}


#ifndef FAST_B
#define FAST_B 1
#endif
#ifndef FAST_DE
#define FAST_DE 1
#endif
#ifndef FAST_HI
#define FAST_HI 1
#endif
__device__ __forceinline__ void ph_b_fast(const Ctx& c, int layer) {
    LAS unsigned char* lds = (LAS unsigned char*)c.smem;
    const char* WIN = (const char*)(c.ws + WS_WIN); const char* HX = (const char*)(c.ws + WS_HX);
    __syncthreads();
    {
        const pg8::GeomLin G{WIN, HX, D, D, D, nullptr}; pg8::StaticOrder S; S.init(3072 / 256, MR / 256, c.nb, c.bid);
        const pg8::EpiBf16Plain E{c.wsp<bf16_t>(WS_ZHYT), MR, 0};
        pg8::gemm_phase(lds, G, S, E);
    }
    {
        const pg8::GeomLin G{HX, WIN + (size_t)OFF_WAQ * D * 2, D, D, D, nullptr}; pg8::StaticOrder S; S.init(MR / 256, (NIN - OFF_WAQ) / 256, c.nb, c.bid);
        const pg8::EpiInRest E{c.ws};
        pg8::gemm_phase(lds, G, S, E);
    }
}
__device__ __forceinline__ void ph_d_fast(const Ctx& c, int layer) {
    LAS unsigned char* lds = (LAS unsigned char*)c.smem;
    const int nM = layer == 0 ? MR / 256 : L / 256;
    pg8::StaticOrder S; S.init(nM, D / 256, c.nb, c.bid);
    __syncthreads();
    { const pg8::GeomLin G{(const char*)(c.ws + WS_YHY), (const char*)(c.ws + WS_WBR), 1024, 1024, 1024, nullptr}; const pg8::EpiMergeF<0> E{c.ws}; pg8::gemm_phase(lds, G, S, E); }
    { const pg8::GeomLin G{(const char*)(c.ws + WS_YWA), (const char*)(c.ws + WS_WBR) + (size_t)D * 1024 * 2, 1024, 1024, 1024, nullptr}; const pg8::EpiMergeF<1> E{c.ws}; pg8::gemm_phase(lds, G, S, E); }
    { const pg8::GeomLin G{(const char*)(c.ws + WS_YNA), (const char*)(c.ws + WS_WBR) + (size_t)2 * D * 1024 * 2, 1024, 1024, 1024, nullptr}; const pg8::EpiMergeF<2> E{c.ws}; pg8::gemm_phase(lds, G, S, E); }
}
__device__ __forceinline__ void ph_e_fast(const Ctx& c, int layer) {
    LAS unsigned char* lds = (LAS unsigned char*)c.smem;
    const int nM = layer == 0 ? MR / 256 : L / 256;
    pg8::StaticOrder S; S.init(nM, D / 256, c.nb, c.bid);
    __syncthreads();
    const pg8::GeomLin G{(const char*)(c.ws + WS_MB), (const char*)(c.ws + WS_WOUT), D, D, D, nullptr}; const pg8::EpiOutF E{&c, layer};
    pg8::gemm_phase(lds, G, S, E);
}
__device__ __forceinline__ void ph_h_fast(const Ctx& c, int layer) {
    LAS unsigned char* lds = (LAS unsigned char*)c.smem;
    const int tpe = layer == 0 ? 9 : 8;
    pg8::StaticOrder S; S.init(NE * tpe, 2048 / 256, c.nb, c.bid);
    __syncthreads();
    const pg8::GeomExpert<true> G{(const char*)(c.ws + WS_H2), (const char*)(c.ws + WS_WGU), D, D, D, c.wsp<int>(WS_IDX), tpe, 2048};
    const pg8::EpiGU E{c.wsp<bf16_t>(WS_ACT)};
    pg8::gemm_phase(lds, G, S, E);
}
__device__ __forceinline__ void ph_i_fast(const Ctx& c, int layer) {
    LAS unsigned char* lds = (LAS unsigned char*)c.smem;
    const int tpe = layer == 0 ? 9 : 8;
    pg8::StaticOrder S; S.init(NE * tpe, D / 256, c.nb, c.bid);
    __syncthreads();
    const pg8::GeomExpert<false> G{(const char*)(c.ws + WS_ACT), (const char*)(c.ws + WS_WDN), DF, DF, DF, nullptr, tpe, D};
    const pg8::EpiBf16Plain E{c.wsp<bf16_t>(WS_YE), D, 0};
    pg8::gemm_phase(lds, G, S, E);
}

__global__ void __launch_bounds__(NTHREADS, 2) mega(KArgs a) {
    extern __shared__ __attribute__((aligned(16))) unsigned char smem[];
    Ctx c; c.in = a.in; c.out = a.out; c.ws = a.ws; c.bid = blockIdx.x; c.nb = gridDim.x; c.tid = threadIdx.x; c.lane = c.tid & 63;
    c.wave = __builtin_amdgcn_readfirstlane(c.tid >> 6); c.smem = smem;
    volatile LAS unsigned* st = (volatile LAS unsigned*)(LAS unsigned char*)(smem + LDS_BYTES - 16);
    if (c.tid == 0) { st[0] = 0u; st[1] = 0u; st[2] = 0u; st[3] = 0u; }
    __syncthreads();
    const int lo = a.ph_lo, hi = a.ph_hi;
    XcdBarrier bar; bar.bar = (unsigned*)(a.ws + WS_CTL); bar.x = 0; bar.st = st;
    if (hi - lo > 1) bar = xcd_barrier_post((unsigned*)(a.ws + WS_CTL), st);
#ifndef ONLY_PH
#define ONLY_PH -1
#endif
#define PSEL(j) (ONLY_PH < 0 || ONLY_PH == (j))

#define IN(k) (lo <= (k) && (k) < hi)
#define GASP __attribute__((address_space(1)))
#define LAUNDER(cc) Ctx cc = c; asm volatile("" : "+v"(cc.tid), "+v"(cc.lane)); asm volatile("" : "+s"(cc.bid), "+s"(cc.nb), "+s"(cc.wave)); \
    { GASP unsigned char* wg_ = (GASP unsigned char*)cc.ws; GASP float* og_ = (GASP float*)cc.out; asm volatile("" : "+s"(wg_), "+s"(og_)); cc.ws = (unsigned char*)wg_; cc.out = (float*)og_; }
#define SEAM(k) do { if (IN(k) && IN((k) + 1)) xcd_barrier(bar); } while (0)
    if (PSEL(0) && IN(0)) { LAUNDER(cc); ph_g0(cc); if (hi - lo > 1) xcd_barrier(bar); LAUNDER(cd); ph_g0b(cd); } SEAM(0);
#define LAYER_PROGRAM(layer) do { const int b = 1 + (layer) * PH_PER_LAYER; \
        if (PSEL(1) && IN(b + 0)) { LAUNDER(cc); constexpr int ly = (layer); { ph_a(cc, ly); if constexpr (DOREP(15)) { LAUNDER(ce); ph_a(ce, ly); } ph_taps(cc, ly); if constexpr (DOREP(14)) { LAUNDER(ce); ph_taps(ce, ly); } if (FAST_B || FAST_DE || FAST_HI) ph_conv(cc, ly); if constexpr (DOREP(13)) { LAUNDER(ce); ph_conv(ce, ly); } __syncthreads(); } if constexpr (DOREP(1)) { LAUNDER(cd); { Ctx& cc = cd; (void)cc; ph_a(cd, ly); ph_taps(cd, ly); if (FAST_B || FAST_DE || FAST_HI) ph_conv(cd, ly); __syncthreads(); } } } SEAM(b + 0); \
        if (PSEL(2) && IN(b + 1)) { LAUNDER(cc); constexpr int ly = (layer); { if (FAST_B) ph_b_fast(cc, ly); else ph_b(cc, ly); __syncthreads(); } if constexpr (DOREP(2)) { LAUNDER(cd); { Ctx& cc = cd; (void)cc; if (FAST_B) ph_b_fast(cd, ly); else ph_b(cd, ly); __syncthreads(); } } } SEAM(b + 1); \
        if (PSEL(3) && IN(b + 2)) { LAUNDER(cc); constexpr int ly = (layer); ph_b2(cc, ly); } SEAM(b + 2); \
        if (PSEL(4) && IN(b + 3)) { LAUNDER(cc); constexpr int ly = (layer); { ph_c(cc, ly); __syncthreads(); } if constexpr (DOREP(4)) { LAUNDER(cd); { Ctx& cc = cd; (void)cc; ph_c(cd, ly); __syncthreads(); } } } SEAM(b + 3); \
        if (PSEL(5) && IN(b + 4)) { LAUNDER(cc); constexpr int ly = (layer); { ph_c2(cc); __syncthreads(); } if constexpr (DOREP(5)) { LAUNDER(cd); { Ctx& cc = cd; (void)cc; ph_c2(cd); __syncthreads(); } } } SEAM(b + 4); \
        if (PSEL(6) && IN(b + 5)) { LAUNDER(cc); constexpr int ly = (layer); { if (FAST_DE) ph_d_fast(cc, ly); else ph_d(cc, ly); __syncthreads(); } if constexpr (DOREP(6)) { LAUNDER(cd); { Ctx& cc = cd; (void)cc; if (FAST_DE) ph_d_fast(cd, ly); else ph_d(cd, ly); __syncthreads(); } } } SEAM(b + 5); \
        if (PSEL(7) && IN(b + 6)) { LAUNDER(cc); constexpr int ly = (layer); { if (FAST_DE) ph_e_fast(cc, ly); else ph_e(cc, ly); __syncthreads(); } if constexpr (DOREP(7)) { LAUNDER(cd); { Ctx& cc = cd; (void)cc; if (FAST_DE) ph_e_fast(cd, ly); else ph_e(cd, ly); __syncthreads(); } } } SEAM(b + 6); \
        if (PSEL(8) && IN(b + 7)) { LAUNDER(cc); constexpr int ly = (layer); { ph_f(cc, ly); __syncthreads(); } if constexpr (DOREP(8)) { LAUNDER(cd); { Ctx& cc = cd; (void)cc; ph_f(cd, ly); __syncthreads(); } } } SEAM(b + 7); \
        if (PSEL(9) && IN(b + 8)) { LAUNDER(cc); constexpr int ly = (layer); { ph_g(cc); __syncthreads(); } if constexpr (DOREP(9)) { LAUNDER(cd); { Ctx& cc = cd; (void)cc; ph_g(cd); __syncthreads(); } } } SEAM(b + 8); \
        if (PSEL(10) && IN(b + 9)) { LAUNDER(cc); constexpr int ly = (layer); { if (FAST_HI) ph_h_fast(cc, ly); else ph_h(cc, ly); __syncthreads(); } if constexpr (DOREP(10)) { LAUNDER(cd); { Ctx& cc = cd; (void)cc; if (FAST_HI) ph_h_fast(cd, ly); else ph_h(cd, ly); __syncthreads(); } } } SEAM(b + 9); \
        if (PSEL(11) && IN(b + 10)) { LAUNDER(cc); constexpr int ly = (layer); { if (FAST_HI) ph_i_fast(cc, ly); else ph_i(cc, ly); __syncthreads(); } if constexpr (DOREP(11)) { LAUNDER(cd); { Ctx& cc = cd; (void)cc; if (FAST_HI) ph_i_fast(cd, ly); else ph_i(cd, ly); __syncthreads(); } } } SEAM(b + 10); \
        if (PSEL(12) && IN(b + 11)) { LAUNDER(cc); constexpr int ly = (layer); { ph_j(cc, ly); __syncthreads(); } if constexpr (DOREP(12)) { LAUNDER(cd); { Ctx& cc = cd; (void)cc; ph_j(cd, ly); __syncthreads(); } } } SEAM(b + 11); \
    } while (0)
    LAYER_PROGRAM(0);
    LAYER_PROGRAM(1);
#undef LAYER_PROGRAM
#undef IN
#undef SEAM
}

extern "C" void kernel_launch(void* const* d_in, const int* in_sizes, int n_in, void* d_out, int out_size, void* d_ws, size_t ws_size, hipStream_t stream) {
    static int grid = 0;
    if (grid == 0) {
        if (n_in != 31 || out_size != L * D || ws_size < WS_END) { fprintf(stderr, "kernel_launch: unexpected shapes: n_in %d out %d ws %zu (need %zu)\n", n_in, out_size, ws_size, (size_t)WS_END); grid = -1; return; }
        int dev = 0, cus = 0, per_cu = 0;
        if (hipGetDevice(&dev) != hipSuccess || hipDeviceGetAttribute(&cus, hipDeviceAttributeMultiprocessorCount, dev) != hipSuccess) { grid = -1; return; }
        if (hipFuncSetAttribute((const void*)mega, hipFuncAttributeMaxDynamicSharedMemorySize, LDS_BYTES) != hipSuccess) { fprintf(stderr, "kernel_launch: hipFuncSetAttribute failed\n"); grid = -1; return; }
        if (hipOccupancyMaxActiveBlocksPerMultiprocessor(&per_cu, (const void*)mega, NTHREADS, LDS_BYTES) != hipSuccess || per_cu < 1) fprintf(stderr, "kernel_launch: occupancy query says %d\n", per_cu);
        (void)hipGetLastError();
        grid = cus;
    }
    if (grid < 0) return;
    if (hipMemsetAsync((char*)d_ws + WS_CTL, 0, CTL_BYTES, stream) != hipSuccess) return;
    KArgs a{};
    for (int i = 0; i < 31; ++i) a.in[i] = (const float*)d_in[i];
    a.out = (float*)d_out; a.ws = (unsigned char*)d_ws;
#if ONE_LAUNCH
    a.ph_lo = 0; a.ph_hi = NPH;
    hipLaunchKernelGGL(mega, dim3(grid), dim3(NTHREADS), LDS_BYTES, stream, a);
#else
    for (int p = 0; p < NPH; ++p) { a.ph_lo = p; a.ph_hi = p + 1; hipLaunchKernelGGL(mega, dim3(grid), dim3(NTHREADS), LDS_BYTES, stream, a); }
#endif
    const hipError_t le = hipPeekAtLastError();
    if (le != hipSuccess) fprintf(stderr, "kernel_launch: launch failed: %s\n", hipGetErrorName(le));
}
```

```cpp
#include <hip/hip_runtime.h>
#include <stdint.h>
#include <stdio.h>

#ifndef ONE_LAUNCH
#define ONE_LAUNCH 1
#endif

#ifndef REP_MASK
#define REP_MASK 0
#endif
#define DOREP(j) ((((REP_MASK) >> (j)) & 1) != 0)
typedef unsigned short bf16_t;
#define LAS __attribute__((address_space(3)))

constexpr int L = 16384, LC = 256, MR = L + LC, D = 2048, NIN = 13824;
constexpr int HD = 128, GRIDW = 64;
constexpr int OFF_HY = 0, OFF_WAQ = 3072, OFF_WAKV = 4096, OFF_NAQ = 4608, OFF_NAKV = 5632, OFF_GATE = 7680;
constexpr int NE = 16, CAP = 2048, CAPC = 32, SLOTS = 2304, DF = 1024;
constexpr int NMOD = 6 * D;
constexpr float RMS_EPS = 1e-6f;
constexpr float QK_SCALE = 0.08838834764831845f;

constexpr size_t al256(size_t x) { return (x + 255) & ~(size_t)255; }
constexpr size_t WS_CTL = 0, CTL_BYTES = 1u << 20;
constexpr size_t WS_MOD = WS_CTL + CTL_BYTES;
constexpr size_t WS_H2B = WS_MOD + al256((size_t)2 * 2 * NMOD * 4);
constexpr size_t WS_FW3T = WS_H2B + al256((size_t)2 * MR * 256 * 2);
constexpr size_t WS_AFF = WS_FW3T + al256((size_t)2 * 4096 * 256 * 2);
constexpr size_t WS_IDX = WS_AFF + al256((size_t)MR * 16 * 4);
constexpr size_t WS_GSEL = WS_IDX + al256((size_t)NE * SLOTS * 4);
constexpr size_t WS_SLOT = WS_GSEL + al256((size_t)NE * SLOTS * 4);
constexpr size_t WS_KFC = WS_SLOT + al256((size_t)NE * MR * 4);
constexpr size_t WS_ZHYC = WS_KFC + al256((size_t)4096 * LC * 2);
constexpr size_t WS_XA = WS_ZHYC + al256((size_t)3072 * LC * 2);
constexpr size_t WS_XB = WS_XA + al256((size_t)MR * D * 4);
constexpr size_t WS_W = WS_XB + al256((size_t)MR * D * 4);
constexpr size_t W_BYTES = (size_t)2 * ((size_t)NIN * D + 3 * (size_t)D * 1024 + (size_t)D * D + (size_t)NE * 2048 * D + (size_t)NE * D * DF);
constexpr size_t WS_WIN = WS_W;
constexpr size_t WS_WBR = WS_WIN + (size_t)NIN * D * 2;
constexpr size_t WS_WOUT = WS_WBR + (size_t)3 * D * 1024 * 2;
constexpr size_t WS_WGU = WS_WOUT + (size_t)D * D * 2;
constexpr size_t WS_WDN = WS_WGU + (size_t)NE * 2048 * D * 2;
constexpr size_t WS_R3 = WS_W + al256(W_BYTES);
constexpr size_t R3_BYTES = (size_t)MR * D * 4 + (size_t)MR * D * 2;
constexpr size_t WS_KF = WS_R3;
constexpr size_t WS_KS = WS_R3 + al256((size_t)4096 * L * 2);
constexpr size_t WS_MPART = WS_R3;
constexpr size_t WS_MB = WS_R3 + (size_t)MR * D * 4;
constexpr size_t WS_TMP = WS_R3;
constexpr size_t WS_YE = WS_R3;
constexpr size_t WS_R4 = WS_R3 + al256(R3_BYTES);
constexpr size_t R4_BYTES = (size_t)MR * 6144 * 2;
constexpr size_t WS_GATE = WS_R4;
constexpr size_t WS_H2 = WS_R4;
constexpr size_t WS_ACT = WS_R4 + al256((size_t)MR * D * 2);
constexpr size_t WS_R5 = WS_R4 + al256(R4_BYTES);
constexpr size_t WS_MODPART = WS_R5;
constexpr size_t WS_HX = WS_R5;
constexpr size_t WS_YHYT = WS_R5;
constexpr size_t WS_YHY = WS_R5 + al256((size_t)1024 * L * 2);
constexpr size_t WS_ZHYT = WS_R5 + al256((size_t)MR * D * 2);
constexpr size_t WS_QWA = WS_ZHYT + al256((size_t)3072 * MR * 2);
constexpr size_t WS_KVWA = WS_QWA + al256((size_t)MR * 1024 * 2);
constexpr size_t WS_QNA = WS_KVWA + al256((size_t)MR * 512 * 2);
constexpr size_t WS_KVNA = WS_QNA + al256((size_t)MR * 1024 * 2);
constexpr size_t WS_YWA = WS_KVNA + al256((size_t)MR * 2048 * 2);
constexpr size_t WS_YNA = WS_YWA + al256((size_t)MR * 1024 * 2);
constexpr size_t WS_END = WS_YNA + al256((size_t)MR * 1024 * 2);
static_assert((size_t)1024 * L * 2 + (size_t)MR * 1024 * 2 <= (size_t)MR * D * 2 + 512, "YHYT+YHY overlay HX");
static_assert((size_t)4096 * L * 2 + 256 + (size_t)256 * 2 * 16384 * 8 <= R3_BYTES && (size_t)NE * SLOTS * D * 2 <= R3_BYTES && (size_t)NE * SLOTS * DF * 4 <= R3_BYTES, "R3");
static_assert((size_t)MR * D * 2 + 256 + (size_t)NE * SLOTS * DF * 2 <= R4_BYTES, "R4");

constexpr int LDS_BYTES = 160 * 1024;
constexpr int NTHREADS = 512;
constexpr int PH_PER_LAYER = 12, NPH = 1 + 2 * PH_PER_LAYER;

__device__ __forceinline__ float bf2f(bf16_t b) { return __uint_as_float(((unsigned)b) << 16); }
__device__ __forceinline__ bf16_t f2bf(float f) { unsigned u = __float_as_uint(f); u += 0x7fffu + ((u >> 16) & 1u); return (bf16_t)(u >> 16); }
__device__ __forceinline__ unsigned pk2(float lo, float hi) { return (unsigned)f2bf(lo) | ((unsigned)f2bf(hi) << 16); }
__device__ __forceinline__ float wave_sum(float v) {
#pragma unroll
    for (int o = 1; o < 64; o <<= 1) v += __shfl_xor(v, o);
    return v;
}
__device__ __forceinline__ float wave_max(float v) {
#pragma unroll
    for (int o = 1; o < 64; o <<= 1) v = fmaxf(v, __shfl_xor(v, o));
    return v;
}
__device__ __forceinline__ float silu_f(float x) { return x * __builtin_amdgcn_rcpf(1.f + __expf(-x)); }
__device__ __forceinline__ float sigmoid_f(float x) { return __builtin_amdgcn_rcpf(1.f + __expf(-x)); }
#define LDS_FENCE() asm volatile("s_waitcnt lgkmcnt(0)" ::: "memory")

#define XB_TMO      128
#define XB_XCNT(j)  (256  + 64 * (j))
#define XB_XSUB(j)  (1280 + 64 * (j))
#define XB_XGEN(j)  (2304 + 64 * (j))
#define XB_TOP      3328
#define XB_TOPGEN   3392
#define XCD_BAR_WORDS 3456
#define XB_SPIN_CAP (1u << 22)

__device__ __forceinline__ unsigned xb_ld(unsigned* p)              { return __hip_atomic_load(p, __ATOMIC_RELAXED, __HIP_MEMORY_SCOPE_AGENT); }
__device__ __forceinline__ unsigned xb_add(unsigned* p, unsigned v) { return __hip_atomic_fetch_add(p, v, __ATOMIC_RELAXED, __HIP_MEMORY_SCOPE_AGENT); }
__device__ __forceinline__ unsigned xb_xcc_id() { return (unsigned)__builtin_amdgcn_s_getreg((3 << 11) | 20) & 0xFu; }
#define XB_SPIN(cond, bar) do { unsigned _sp = 0; while (cond) { __builtin_amdgcn_s_sleep(1); \
    if ((++_sp & 255u) == 0u) { if (xb_ld(&(bar)[XB_TMO])) break; if (_sp > XB_SPIN_CAP) { atomicAdd(&(bar)[XB_TMO], 1u); break; } } } } while (0)

struct XcdBarrier { unsigned* bar; unsigned x; volatile LAS unsigned* st; };

__device__ __forceinline__ XcdBarrier xcd_barrier_post(unsigned* bar, volatile LAS unsigned* st) {
    XcdBarrier b; b.bar = bar; b.x = xb_xcc_id(); b.st = st;
    if (threadIdx.x == 0) (void)xb_add(&bar[XB_XCNT(b.x)], 1u);
    return b;
}
__device__ __forceinline__ void xcd_barrier_complete(unsigned* bar, unsigned x, unsigned& nloc, unsigned& nx) {
    const unsigned G = gridDim.x * gridDim.y * gridDim.z;
    unsigned sum, cnt, mine, sp = 0u;
    for (;;) {
        sum = 0u; cnt = 0u; mine = 0u;
#pragma unroll
        for (unsigned j = 0; j < 16; ++j) { const unsigned c = xb_ld(&bar[XB_XCNT(j)]); sum += c; cnt += (c > 0u) ? 1u : 0u; mine = (j == x) ? c : mine; }
        if (sum == G) break;
        __builtin_amdgcn_s_sleep(1);
        if ((++sp & 255u) == 0u) { if (xb_ld(&bar[XB_TMO])) break; if (sp > XB_SPIN_CAP) { atomicAdd(&bar[XB_TMO], 1u); break; } }
    }
    nloc = mine > 0u ? mine : 1u; nx = cnt > 0u ? cnt : 1u;
}
__device__ __forceinline__ void xcd_barrier(const XcdBarrier& b) {
    asm volatile("s_waitcnt vmcnt(0)" ::: "memory");
    __syncthreads();
    if (threadIdx.x == 0) {
        unsigned* bar = b.bar;
        __builtin_amdgcn_s_waitcnt(0);
        unsigned nloc = b.st[0], nx = b.st[1];
        if (nloc == 0u) { xcd_barrier_complete(bar, b.x, nloc, nx); b.st[0] = nloc; b.st[1] = nx; }
        const unsigned old = xb_add(&bar[XB_XSUB(b.x)], 1u);
        const unsigned gen = old / nloc;
        if (old + 1u == (gen + 1u) * nloc) {
            __builtin_amdgcn_fence(__ATOMIC_RELEASE, "agent");
            asm volatile("s_waitcnt vmcnt(0)" ::: "memory");
            const unsigned og = xb_add(&bar[XB_TOP], 1u);
            const unsigned tg = og / nx;
            if (og + 1u == (tg + 1u) * nx) xb_add(&bar[XB_TOPGEN], 1u);
            else XB_SPIN(xb_ld(&bar[XB_TOPGEN]) == tg, bar);
            __builtin_amdgcn_fence(__ATOMIC_ACQUIRE, "agent");
            xb_add(&bar[XB_XGEN(b.x)], 1u);
            asm volatile("s_waitcnt vmcnt(0)" ::: "memory");
        } else {
            XB_SPIN(xb_ld(&bar[XB_XGEN(b.x)]) == gen, bar);
            __builtin_amdgcn_fence(__ATOMIC_ACQUIRE, "agent");
            asm volatile("s_waitcnt vmcnt(0)" ::: "memory");
        }
    }
    __syncthreads();
}

struct KArgs { const float* in[31]; float* out; unsigned char* ws; int ph_lo, ph_hi; };

struct Ctx {
    const float* const* in; float* out; unsigned char* ws;
    int bid, nb, tid, lane, wave;
    unsigned char* smem;
    template <class T> __device__ __forceinline__ T* wsp(size_t off) const { return (T*)(ws + off); }
    __device__ __forceinline__ const float* mod(int layer, int src, int chunk) const { return wsp<float>(WS_MOD) + ((size_t)(layer * 2 + src) * NMOD) + chunk * D; }
    __device__ __forceinline__ const float* xrow(int layer, int r) const {
        if (layer == 0) return r < L ? in[0] + (size_t)r * D : in[2] + (size_t)(r - L) * D;
        return wsp<float>(WS_XB) + (size_t)r * D;
    }
};

template <class RowPtr, class Epi>
__device__ __forceinline__ void sgemm_unit(const RowPtr& rp, const float* __restrict__ W, int ldw, int K, int m0, int n0, const Epi& ep, float* lds, int tid) {
    float* As = lds;
    float* Bs = lds + 16 * 132;
    const int ty = tid >> 4, tx = tid & 15;
    const int am = tid >> 2, kq = (tid & 3) * 4;
    const int bk = tid >> 5, n4 = (tid & 31) * 4;
    float acc[4][8];
#pragma unroll
    for (int i = 0; i < 4; ++i)
#pragma unroll
        for (int j = 0; j < 8; ++j) acc[i][j] = 0.f;
    const bf16_t* arow = rp(m0 + am);
    const float* wp = W + (size_t)bk * ldw + n0 + n4;
    for (int k0 = 0; k0 < K; k0 += 16) {
        const uint2 a4 = *(const uint2*)(arow + k0 + kq);
        const float4 b4 = *(const float4*)(wp + (size_t)k0 * ldw);
        __syncthreads();
        As[(kq + 0) * 132 + am] = __uint_as_float(a4.x << 16);
        As[(kq + 1) * 132 + am] = __uint_as_float(a4.x & 0xffff0000u);
        As[(kq + 2) * 132 + am] = __uint_as_float(a4.y << 16);
        As[(kq + 3) * 132 + am] = __uint_as_float(a4.y & 0xffff0000u);
        *(float4*)&Bs[bk * 128 + n4] = b4;
        __syncthreads();
#pragma unroll
        for (int kk = 0; kk < 16; ++kk) {
            const float4 a = *(const float4*)&As[kk * 132 + ty * 4];
            const float4 b0 = *(const float4*)&Bs[kk * 128 + tx * 8];
            const float4 b1 = *(const float4*)&Bs[kk * 128 + tx * 8 + 4];
            const float av[4] = {a.x, a.y, a.z, a.w};
            const float bv[8] = {b0.x, b0.y, b0.z, b0.w, b1.x, b1.y, b1.z, b1.w};
#pragma unroll
            for (int i = 0; i < 4; ++i)
#pragma unroll
                for (int j = 0; j < 8; ++j) acc[i][j] = fmaf(av[i], bv[j], acc[i][j]);
        }
    }
#pragma unroll
    for (int i = 0; i < 4; ++i) ep(m0 + ty * 4 + i, n0 + tx * 8, acc[i]);
}

struct RowLin { const bf16_t* base; int ld; __device__ __forceinline__ const bf16_t* operator()(int m) const { return base + (size_t)m * ld; } };
struct RowGather { const bf16_t* base; int ld; const int* idx; __device__ __forceinline__ const bf16_t* operator()(int m) const { return base + (size_t)idx[m] * ld; } };


namespace pg8 {
typedef short bf16x8 __attribute__((ext_vector_type(8)));
typedef float f32x4 __attribute__((ext_vector_type(4)));
typedef unsigned u32x4 __attribute__((ext_vector_type(4)));
typedef unsigned u32x2 __attribute__((ext_vector_type(2)));
constexpr int BM = 256, BK = 64, HALF = 128, HTB = HALF * BK * 2, STAGE_BYTES = 8 * HTB, NXCD = 8, WGM = 8;
__host__ __device__ __forceinline__ int lds_byte(int r, int c) { const int st = (r >> 4) * 2 + (c >> 5), rr = r & 15, cc = c & 31, ob = rr * 64 + cc * 2; return st * 1024 + (ob ^ (((ob >> 9) & 1) << 5)); }
__host__ __device__ __forceinline__ void stage_rc(int b, int& R, int& C) { const int st = b / 1024, sb = b % 1024, swz = sb ^ (((sb >> 9) & 1) << 5); R = (st >> 1) * 16 + swz / 64; C = (st & 1) * 32 + (swz % 64) / 2; }
__host__ __device__ __forceinline__ int perm32(int rho) { const int n = rho >> 4, i = rho & 15; return 8 * (i >> 2) + 4 * n + (i & 3); }
struct Unit { int pm, pn; };
struct StaticOrder {
    int nM, nN, nwg, G, c;
    __host__ __device__ void init(int nM_, int nN_, int G_, int c_) { nM = nM_; nN = nN_; nwg = nM * nN; G = G_; c = c_; }
    __host__ __device__ bool next(int i, Unit& u) const { return at((long)i * G + c, u); }
    __host__ __device__ bool at(long Lq, Unit& u) const {
        if (Lq >= nwg) return false;
        int wgid = (int)Lq; { const int q = nwg / NXCD, r = nwg % NXCD, xcd = wgid % NXCD, off = wgid / NXCD; wgid = (xcd < r ? xcd * (q + 1) : r * (q + 1) + (xcd - r) * q) + off; }
        const int nig = WGM * nN, gid = wgid / nig, fm = gid * WGM, gsz = (nM - fm) < WGM ? (nM - fm) : WGM;
        u.pm = fm + ((wgid % nig) % gsz); u.pn = (wgid % nig) / gsz; return true;
    }
};
__device__ __forceinline__ unsigned cvt_pk_bf16(float lo, float hi) { unsigned r; asm volatile("v_cvt_pk_bf16_f32 %0, %1, %2" : "=v"(r) : "v"(lo), "v"(hi)); return r; }

struct GeomLin {
    static constexpr bool GATHER = false;
    const char* A; const char* B; int K, lda, ldb; const int* idx;
    __device__ __forceinline__ const char* a_base(const Unit& u) const { return A + (size_t)u.pm * 256 * lda * 2; }
    __device__ __forceinline__ const char* b_base(const Unit& u) const { return B + (size_t)u.pn * 256 * ldb * 2; }
    __device__ __forceinline__ int row0(const Unit& u) const { return u.pm * 256; }
};
template <bool GATHER_> struct GeomExpert {
    static constexpr bool GATHER = GATHER_;
    const char* A; const char* B; int K, lda, ldb; const int* idx; int tpe, nb;
    __device__ __forceinline__ int row0(const Unit& u) const { const int e = u.pm / tpe, t = u.pm - e * tpe; return e * SLOTS + t * 256; }
    __device__ __forceinline__ const char* a_base(const Unit& u) const { return GATHER_ ? A : A + (size_t)row0(u) * lda * 2; }
    __device__ __forceinline__ const char* b_base(const Unit& u) const { const int e = u.pm / tpe; return B + ((size_t)e * nb + (size_t)u.pn * 256) * ldb * 2; }
};

template <class Epi, class Geom, class Sched>
__device__ __forceinline__ void gemm_phase(LAS unsigned char* lds, const Geom& G, const Sched& S, const Epi& E) {
    const int tid = threadIdx.x, wid = __builtin_amdgcn_readfirstlane(tid >> 6), lane = tid & 63, wr = wid >> 2, wc = wid & 3, fr = lane & 15, fq = lane >> 4;
    const int K = G.K, nt = K / BK;
    int Rs[2], Cs[2]; unsigned vB0[2], vA0[2], vAc[2][2], vAn[2][2];
#pragma unroll
    for (int i = 0; i < 2; ++i) { int R, C; stage_rc(tid * 16 + i * 8192, R, C); Rs[i] = R; Cs[i] = C; const int Rb = Epi::PERM ? ((R & ~31) + perm32(R & 31)) : R;
        vB0[i] = (unsigned)(Rb * G.ldb + C) * 2u; vA0[i] = (unsigned)(R * G.lda + C) * 2u;
#pragma unroll
        for (int h = 0; h < 2; ++h) { vAc[h][i] = 0u; vAn[h][i] = 0u; } }
    const size_t hstepA = (size_t)HALF * G.lda * 2, hstepB = (size_t)HALF * G.ldb * 2;
#define PG8_VOFF(dst, u) do { if constexpr (Geom::GATHER) { const int _r0 = G.row0(u); _Pragma("unroll") for (int _h = 0; _h < 2; ++_h) _Pragma("unroll") for (int _i = 0; _i < 2; ++_i) \
        dst[_h][_i] = ((unsigned)G.idx[_r0 + _h * HALF + Rs[_i]] * (unsigned)G.lda + (unsigned)Cs[_i]) * 2u; } } while (0)
    const size_t kstep = (size_t)(BK * 2);
    const unsigned ldsw = (unsigned)wid * 1024u;
    const int aoff = lds_byte(wr * 64 + fr, fq * 8), boff = lds_byte(wc * 32 + fr, fq * 8);
#define PG8_SA(b, h) (((b) * 2 + (h)) * HTB)
#define PG8_SB(b, h) ((4 + (b) * 2 + (h)) * HTB)
#define PG8_STAGE(bufoff, gbase, v) do { \
        __builtin_amdgcn_global_load_lds((const unsigned*)((const char*)(gbase) + (v)[0]), (LAS unsigned*)(lds + (bufoff) + ldsw), 16, 0, 0); \
        __builtin_amdgcn_global_load_lds((const unsigned*)((const char*)(gbase) + (v)[1]), (LAS unsigned*)(lds + (bufoff) + ldsw + 8192), 16, 0, 0); } while (0)
#define PG8_STA(bufoff, gbase, h, VX) do { if constexpr (Geom::GATHER) { PG8_STAGE(bufoff, gbase, VX[h]); } else { PG8_STAGE(bufoff, (gbase) + (h) * hstepA, vA0); } } while (0)
#define PG8_STB(bufoff, gbase, h) PG8_STAGE(bufoff, (gbase) + (h) * hstepB, vB0)
#define PG8_LDA(dst, b, h) do { _Pragma("unroll") for (int m = 0; m < 4; ++m) _Pragma("unroll") for (int k = 0; k < 2; ++k) dst[m][k] = *(const LAS bf16x8*)(lds + PG8_SA(b, h) + aoff + m * 2048 + k * 1024); } while (0)
#define PG8_LDB(dst, b, h) do { _Pragma("unroll") for (int n = 0; n < 2; ++n) _Pragma("unroll") for (int k = 0; k < 2; ++k) dst[n][k] = *(const LAS bf16x8*)(lds + PG8_SB(b, h) + boff + n * 2048 + k * 1024); } while (0)
#define PG8_MMA(ai, bj, At, Bt) do { __builtin_amdgcn_s_setprio(1); _Pragma("unroll") for (int m = 0; m < 4; ++m) _Pragma("unroll") for (int n = 0; n < 2; ++n) _Pragma("unroll") for (int k = 0; k < 2; ++k) \
        acc[ai][bj][m][n] = __builtin_amdgcn_mfma_f32_16x16x32_bf16(Bt[n][k], At[m][k], acc[ai][bj][m][n], 0, 0, 0); __builtin_amdgcn_s_setprio(0); } while (0)
#define PG8_WAIT_V(n) asm volatile("s_waitcnt vmcnt(" #n ")" ::: "memory")
#define PG8_WAIT_L(n) asm volatile("s_waitcnt lgkmcnt(" #n ")" ::: "memory")
#define PG8_BAR __builtin_amdgcn_s_barrier()
#define PG8_SCHED __builtin_amdgcn_sched_barrier(0)
    Unit cur, nxt; int ui = 0;
    if (!S.next(0, cur)) return;
    f32x4 acc[2][2][4][2];
#pragma unroll
    for (int a = 0; a < 2; ++a)
#pragma unroll
        for (int b = 0; b < 2; ++b)
#pragma unroll
            for (int m = 0; m < 4; ++m)
#pragma unroll
                for (int n = 0; n < 2; ++n) acc[a][b][m][n] = (f32x4){0.f, 0.f, 0.f, 0.f};
    bf16x8 At[4][2], B0[2][2], B1[2][2];
    const char* cA = G.a_base(cur); const char* cB = G.b_base(cur);
    PG8_VOFF(vAc, cur);
    PG8_STB(PG8_SB(0, 0), cB, 0); PG8_STA(PG8_SA(0, 0), cA, 0, vAc); PG8_STB(PG8_SB(0, 1), cB, 1); PG8_STA(PG8_SA(0, 1), cA, 1, vAc);
    if (wr == 1) PG8_BAR;
    PG8_WAIT_V(4); PG8_BAR;
    PG8_STB(PG8_SB(1, 0), cB + kstep, 0); PG8_STA(PG8_SA(1, 0), cA + kstep, 0, vAc); PG8_STB(PG8_SB(1, 1), cB + kstep, 1);
    PG8_WAIT_V(6); PG8_BAR;
    for (;;) {
        const bool has_next = S.next(ui + 1, nxt);
        const char* nA = has_next ? G.a_base(nxt) : cA; const char* nB = has_next ? G.b_base(nxt) : cB;
        if constexpr (Geom::GATHER) { if (has_next) PG8_VOFF(vAn, nxt); else {
#pragma unroll
            for (int h = 0; h < 2; ++h) { vAn[h][0] = vAc[h][0]; vAn[h][1] = vAc[h][1]; } } }
        for (int t = 0; t < nt; t += 2) {
            const bool last = (t == nt - 2);
            const char* a1 = cA + (size_t)(t + 1) * kstep;
            const char* a2 = last ? nA : cA + (size_t)(t + 2) * kstep; const char* b2 = last ? nB : cB + (size_t)(t + 2) * kstep;
            const char* a3 = a2 + kstep; const char* b3 = b2 + kstep;
            unsigned v2[2][2];
#pragma unroll
            for (int h = 0; h < 2; ++h) { v2[h][0] = (Geom::GATHER && last) ? vAn[h][0] : vAc[h][0]; v2[h][1] = (Geom::GATHER && last) ? vAn[h][1] : vAc[h][1]; }
            PG8_LDB(B0, 0, 0); PG8_SCHED; PG8_LDA(At, 0, 0); PG8_STA(PG8_SA(1, 1), a1, 1, vAc);
            PG8_WAIT_L(8); PG8_BAR; PG8_WAIT_L(0); PG8_MMA(0, 0, At, B0); PG8_BAR; PG8_SCHED;
            PG8_LDB(B1, 0, 1); PG8_STB(PG8_SB(0, 0), b2, 0);
            PG8_BAR; PG8_WAIT_L(0); PG8_MMA(0, 1, At, B1); PG8_BAR;
            PG8_LDA(At, 0, 1); PG8_STA(PG8_SA(0, 0), a2, 0, v2);
            PG8_BAR; PG8_WAIT_L(0); PG8_MMA(1, 0, At, B0); PG8_BAR; PG8_SCHED;
            PG8_STB(PG8_SB(0, 1), b2, 1);
            PG8_WAIT_V(6); PG8_BAR; PG8_MMA(1, 1, At, B1); PG8_BAR;
            PG8_LDB(B0, 1, 0); PG8_SCHED; PG8_LDA(At, 1, 0); PG8_STA(PG8_SA(0, 1), a2, 1, v2);
            PG8_WAIT_L(8); PG8_BAR; PG8_WAIT_L(0); PG8_MMA(0, 0, At, B0); PG8_BAR; PG8_SCHED;
            PG8_LDB(B1, 1, 1); PG8_STB(PG8_SB(1, 0), b3, 0);
            PG8_BAR; PG8_WAIT_L(0); PG8_MMA(0, 1, At, B1); PG8_BAR;
            PG8_LDA(At, 1, 1); PG8_STA(PG8_SA(1, 0), a3, 0, v2);
            PG8_BAR; PG8_WAIT_L(0); PG8_MMA(1, 0, At, B0); PG8_BAR; PG8_SCHED;
            PG8_STB(PG8_SB(1, 1), b3, 1);
            PG8_WAIT_V(6); PG8_BAR; PG8_MMA(1, 1, At, B1); PG8_BAR;
        }
        E(acc, cur, G.row0(cur), wr, wc, fr, fq);
        if (!has_next) break;
#pragma unroll
        for (int a = 0; a < 2; ++a)
#pragma unroll
            for (int b = 0; b < 2; ++b)
#pragma unroll
                for (int m = 0; m < 4; ++m)
#pragma unroll
                    for (int n = 0; n < 2; ++n) acc[a][b][m][n] = (f32x4){0.f, 0.f, 0.f, 0.f};
        cur = nxt; cA = nA; cB = nB; ++ui;
#pragma unroll
        for (int h = 0; h < 2; ++h) { vAc[h][0] = vAn[h][0]; vAc[h][1] = vAn[h][1]; }
    }
    PG8_WAIT_V(0);
    if (wr == 0) PG8_BAR;
    PG8_BAR;
#undef PG8_VOFF
#undef PG8_SA
#undef PG8_SB
#undef PG8_STAGE
#undef PG8_STA
#undef PG8_STB
#undef PG8_LDA
#undef PG8_LDB
#undef PG8_MMA
#undef PG8_WAIT_V
#undef PG8_WAIT_L
#undef PG8_BAR
#undef PG8_SCHED
}

struct EpiBf16Plain {
    static constexpr bool PERM = true;
    bf16_t* O; int ldc; int coloff;
    __device__ __forceinline__ void operator()(const f32x4 (&acc)[2][2][4][2], const Unit& u, int row0, int wr, int wc, int fr, int fq) const {
        const int r0 = row0 + wr * 64 + fr, col0 = coloff + u.pn * BM + wc * 32 + 8 * fq;
#pragma unroll
        for (int ai = 0; ai < 2; ++ai)
#pragma unroll
            for (int m = 0; m < 4; ++m) { bf16_t* rowp = O + (size_t)(r0 + ai * HALF + m * 16) * ldc + col0;
#pragma unroll
                for (int bj = 0; bj < 2; ++bj) { const f32x4 v0 = acc[ai][bj][m][0], v1 = acc[ai][bj][m][1];
                    u32x4 w; w.x = cvt_pk_bf16(v0[0], v0[1]); w.y = cvt_pk_bf16(v0[2], v0[3]); w.z = cvt_pk_bf16(v1[0], v1[1]); w.w = cvt_pk_bf16(v1[2], v1[3]);
                    *(u32x4*)(rowp + bj * HALF) = w; } }
    }
};
struct EpiInRest {
    static constexpr bool PERM = true;
    unsigned char* ws;
    __device__ __forceinline__ void operator()(const f32x4 (&acc)[2][2][4][2], const Unit& u, int row0, int wr, int wc, int fr, int fq) const {
        const int gcol = OFF_WAQ + u.pn * BM;
        bf16_t* base; int ldc, c0; bool sg = false;
        if (gcol < OFF_WAKV) { base = (bf16_t*)(ws + WS_QWA); ldc = 1024; c0 = gcol - OFF_WAQ; }
        else if (gcol < OFF_NAQ) { base = (bf16_t*)(ws + WS_KVWA); ldc = 512; c0 = gcol - OFF_WAKV; }
        else if (gcol < OFF_NAKV) { base = (bf16_t*)(ws + WS_QNA); ldc = 1024; c0 = gcol - OFF_NAQ; }
        else if (gcol < OFF_GATE) { base = (bf16_t*)(ws + WS_KVNA); ldc = 2048; c0 = gcol - OFF_NAKV; }
        else { base = (bf16_t*)(ws + WS_GATE); ldc = 6144; c0 = gcol - OFF_GATE; sg = true; }
        const int r0 = row0 + wr * 64 + fr, col0 = c0 + wc * 32 + 8 * fq;
#pragma unroll
        for (int ai = 0; ai < 2; ++ai)
#pragma unroll
            for (int m = 0; m < 4; ++m) { bf16_t* rowp = base + (size_t)(r0 + ai * HALF + m * 16) * ldc + col0;
#pragma unroll
                for (int bj = 0; bj < 2; ++bj) { f32x4 v0 = acc[ai][bj][m][0], v1 = acc[ai][bj][m][1];
                    if (sg) {
#pragma unroll
                        for (int j = 0; j < 4; ++j) { v0[j] = sigmoid_f(v0[j]); v1[j] = sigmoid_f(v1[j]); } }
                    u32x4 w; w.x = cvt_pk_bf16(v0[0], v0[1]); w.y = cvt_pk_bf16(v0[2], v0[3]); w.z = cvt_pk_bf16(v1[0], v1[1]); w.w = cvt_pk_bf16(v1[2], v1[3]);
                    *(u32x4*)(rowp + bj * HALF) = w; } }
    }
};
template <int BR> struct EpiMergeF {
    static constexpr bool PERM = false;
    unsigned char* ws;
    __device__ __forceinline__ void operator()(const f32x4 (&acc)[2][2][4][2], const Unit& u, int row0, int wr, int wc, int fr, int fq) const {
        const int r0 = row0 + wr * 64 + fr, col0 = u.pn * BM + wc * 32 + 4 * fq;
#pragma unroll
        for (int ai = 0; ai < 2; ++ai)
#pragma unroll
            for (int m = 0; m < 4; ++m) { const size_t row = (size_t)(r0 + ai * HALF + m * 16);
                const bf16_t* gp = (const bf16_t*)(ws + WS_GATE) + row * 6144 + BR * 2048 + col0;
                bf16_t* ob = (bf16_t*)(ws + WS_MB) + row * D + col0;
#pragma unroll
                for (int bj = 0; bj < 2; ++bj)
#pragma unroll
                    for (int n = 0; n < 2; ++n) { const int co = bj * HALF + n * 16;
                        const u32x2 gg = *(const u32x2*)(gp + co);
                        const f32x4 g = {__uint_as_float(gg.x << 16), __uint_as_float(gg.x & 0xffff0000u), __uint_as_float(gg.y << 16), __uint_as_float(gg.y & 0xffff0000u)};
                        f32x4 t = g * acc[ai][bj][m][n];
                        if (BR > 0) { const u32x2 pp = *(const u32x2*)(ob + co);
                            t += (f32x4){__uint_as_float(pp.x << 16), __uint_as_float(pp.x & 0xffff0000u), __uint_as_float(pp.y << 16), __uint_as_float(pp.y & 0xffff0000u)}; }
                        u32x2 w; w.x = cvt_pk_bf16(t[0], t[1]); w.y = cvt_pk_bf16(t[2], t[3]); *(u32x2*)(ob + co) = w; } }
    }
};
struct EpiOutF {
    static constexpr bool PERM = false;
    const Ctx* c; int layer;
    __device__ __forceinline__ void operator()(const f32x4 (&acc)[2][2][4][2], const Unit& u, int row0, int wr, int wc, int fr, int fq) const {
        const int r0 = row0 + wr * 64 + fr, col0 = u.pn * BM + wc * 32 + 4 * fq;
#pragma unroll
        for (int ai = 0; ai < 2; ++ai)
#pragma unroll
            for (int m = 0; m < 4; ++m) { const int row = r0 + ai * HALF + m * 16;
                const float* xin = c->xrow(layer, row) + col0; const float* g = c->mod(layer, row < L ? 0 : 1, 2) + col0;
                float* o = (float*)(c->ws + WS_XA) + (size_t)row * D + col0;
#pragma unroll
                for (int bj = 0; bj < 2; ++bj)
#pragma unroll
                    for (int n = 0; n < 2; ++n) { const int co = bj * HALF + n * 16;
                        *(f32x4*)(o + co) = *(const f32x4*)(xin + co) + *(const f32x4*)(g + co) * acc[ai][bj][m][n]; } }
    }
};
struct EpiGU {
    static constexpr bool PERM = false;
    bf16_t* act;
    __device__ __forceinline__ void operator()(const f32x4 (&acc)[2][2][4][2], const Unit& u, int row0, int wr, int wc, int fr, int fq) const {
        const int r0 = row0 + wr * 64 + fr, f0 = u.pn * 128 + wc * 16 + 4 * fq;
#pragma unroll
        for (int ai = 0; ai < 2; ++ai)
#pragma unroll
            for (int m = 0; m < 4; ++m) { bf16_t* rowp = act + (size_t)(r0 + ai * HALF + m * 16) * DF + f0;
#pragma unroll
                for (int bj = 0; bj < 2; ++bj) { const f32x4 a = acc[ai][bj][m][0], uu = acc[ai][bj][m][1]; f32x4 t;
#pragma unroll
                    for (int j = 0; j < 4; ++j) t[j] = silu_f(a[j]) * uu[j];
                    u32x2 w; w.x = cvt_pk_bf16(t[0], t[1]); w.y = cvt_pk_bf16(t[2], t[3]); *(u32x2*)(rowp + bj * 64) = w; } }
    }
};
}

struct ConvDesc { const float* W; bf16_t* WT; int K, N, k0, n0, gu, off; };
__device__ __forceinline__ ConvDesc conv_desc(const Ctx& c, int layer, int it) {
    constexpr int I_IN = (D / 64) * (NIN / 256), I_BR = (1024 / 64) * (D / 256), I_OUT = (D / 64) * (D / 256), I_G = (D / 64) * (DF / 256), I_DN = (DF / 64) * (D / 256);
    ConvDesc d; int r = it; d.gu = 0; d.off = 0;
    if (r < I_IN) { d.W = c.in[7] + (size_t)layer * D * NIN; d.WT = c.wsp<bf16_t>(WS_WIN); d.K = D; d.N = NIN; }
    else if ((r -= I_IN) < 3 * I_BR) { const int b = r / I_BR; r -= b * I_BR; d.W = c.in[24] + ((size_t)layer * 3 + b) * 1024 * D; d.WT = c.wsp<bf16_t>(WS_WBR) + (size_t)b * D * 1024; d.K = 1024; d.N = D; }
    else if ((r -= 3 * I_BR) < I_OUT) { d.W = c.in[25] + (size_t)layer * D * D; d.WT = c.wsp<bf16_t>(WS_WOUT); d.K = D; d.N = D; }
    else { r -= I_OUT; const int e = r / (2 * I_G + I_DN); r -= e * (2 * I_G + I_DN);
        if (r < I_G) { d.W = c.in[28] + ((size_t)layer * NE + e) * D * DF; d.WT = c.wsp<bf16_t>(WS_WGU); d.K = D; d.N = DF; d.gu = 1; d.off = e * 2048; }
        else if ((r -= I_G) < I_G) { d.W = c.in[29] + ((size_t)layer * NE + e) * D * DF; d.WT = c.wsp<bf16_t>(WS_WGU); d.K = D; d.N = DF; d.gu = 1; d.off = e * 2048 + 16; }
        else { r -= I_G; d.W = c.in[30] + ((size_t)layer * NE + e) * DF * D; d.WT = c.wsp<bf16_t>(WS_WDN) + (size_t)e * D * DF; d.K = DF; d.N = D; } }
    const int nblk = d.N / 256; d.k0 = 64 * (r / nblk); d.n0 = 256 * (r % nblk);
    return d;
}
__device__ __forceinline__ void ph_conv(const Ctx& c, int layer) {
    constexpr int I_IN = (D / 64) * (NIN / 256), I_BR = (1024 / 64) * (D / 256), I_OUT = (D / 64) * (D / 256), I_G = (D / 64) * (DF / 256), I_DN = (DF / 64) * (D / 256);
    constexpr int NITEMS = I_IN + 3 * I_BR + I_OUT + NE * (2 * I_G + I_DN);
    __syncthreads();
    float* tile = (float*)c.smem;
    const int tid = c.tid;
    float4 rg[8];
    int it = c.bid; bool have = it < NITEMS; ConvDesc d;
    if (have) { d = conv_desc(c, layer, it);
#pragma unroll
        for (int q = 0; q < 8; ++q) { const int e = tid + 512 * q, row = e >> 6, c4 = e & 63; rg[q] = *(const float4*)(d.W + (size_t)(d.k0 + row) * d.N + d.n0 + 4 * c4); } }
    while (have) {
#pragma unroll
        for (int q = 0; q < 8; ++q) { const int e = tid + 512 * q, row = e >> 6, c4 = e & 63; float* tp = tile + row * 257 + 4 * c4; tp[0] = rg[q].x; tp[1] = rg[q].y; tp[2] = rg[q].z; tp[3] = rg[q].w; }
        __syncthreads();
        const ConvDesc cur = d;
        it += c.nb; have = it < NITEMS;
        if (have) { d = conv_desc(c, layer, it);
#pragma unroll
            for (int q = 0; q < 8; ++q) { const int e = tid + 512 * q, row = e >> 6, c4 = e & 63; rg[q] = *(const float4*)(d.W + (size_t)(d.k0 + row) * d.N + d.n0 + 4 * c4); } }
#pragma unroll
        for (int j = 0; j < 4; ++j) { const int p = tid + 512 * j, nn = p >> 3, kc = p & 7; const float* sp = tile + (8 * kc) * 257 + nn;
            uint4 o; o.x = pk2(sp[0 * 257], sp[1 * 257]); o.y = pk2(sp[2 * 257], sp[3 * 257]); o.z = pk2(sp[4 * 257], sp[5 * 257]); o.w = pk2(sp[6 * 257], sp[7 * 257]);
            const int f = cur.n0 + nn; const int orow = cur.gu ? cur.off + 32 * (f >> 4) + (f & 15) : f;
            *(uint4*)(cur.WT + (size_t)orow * cur.K + cur.k0 + 8 * kc) = o; }
        __syncthreads();
    }
}

struct EpiTaps {
    static constexpr bool PERM = true;
    bf16_t* KF; bf16_t* KFC; const float* dec;
    __device__ __forceinline__ void operator()(const pg8::f32x4 (&acc)[2][2][4][2], const pg8::Unit& u, int row0, int wr, int wc, int fr, int fq) const {
        const bool isc = u.pn == L / 256;
        const int ch0 = row0 + wr * 64 + fr, pos0 = (isc ? 0 : u.pn * 256) + wc * 32 + 8 * fq;
        const float inv = isc ? 1.0f / (float)(LC - 1) : 1.0f / (float)(L - 1);
        bf16_t* base = isc ? KFC : KF; const int ld = isc ? LC : L;
#pragma unroll
        for (int ai = 0; ai < 2; ++ai)
#pragma unroll
            for (int m = 0; m < 4; ++m) { const int ch = ch0 + ai * 128 + m * 16; const float rate = fabsf(dec[ch]); bf16_t* rowp = base + (size_t)ch * ld + pos0;
#pragma unroll
                for (int bj = 0; bj < 2; ++bj) { float t[8];
#pragma unroll
                    for (int j = 0; j < 8; ++j) { const float tt = (float)(pos0 + bj * 128 + j) * inv; const float a = j < 4 ? acc[ai][bj][m][0][j] : acc[ai][bj][m][1][j - 4]; t[j] = a * (__expf(-tt * rate) + 0.05f); }
                    pg8::u32x4 w; w.x = pg8::cvt_pk_bf16(t[0], t[1]); w.y = pg8::cvt_pk_bf16(t[2], t[3]); w.z = pg8::cvt_pk_bf16(t[4], t[5]); w.w = pg8::cvt_pk_bf16(t[6], t[7]);
                    *(pg8::u32x4*)(rowp + bj * 128) = w; } }
    }
};
__device__ __forceinline__ void ph_taps(const Ctx& c, int layer) {
    LAS unsigned char* lds = (LAS unsigned char*)c.smem;
    __syncthreads();
    const pg8::GeomLin G{(const char*)(c.wsp<bf16_t>(WS_FW3T) + (size_t)layer * 4096 * 256), (const char*)(c.wsp<bf16_t>(WS_H2B) + (size_t)layer * MR * 256), 256, 256, 256, nullptr};
    pg8::StaticOrder S; S.init(4096 / 256, MR / 256, c.nb, c.bid);
    const EpiTaps E{c.wsp<bf16_t>(WS_KF), c.wsp<bf16_t>(WS_KFC), c.in[16] + (size_t)layer * 4096};
    pg8::gemm_phase(lds, G, S, E);
}

__device__ __forceinline__ void ph_g0(const Ctx& c) {
    float* lds = (float*)c.smem;
    {
        float* PART = c.wsp<float>(WS_MODPART);
        for (int u = c.bid; u < 2 * 128; u += c.nb) {
            const int layer = u >> 7, slab = u & 127, k0 = slab * 16;
            __syncthreads();
            if (c.tid < 32) { const int k = k0 + (c.tid & 15); lds[c.tid] = silu_f(c.tid < 16 ? c.in[1][k] : c.in[3][k]); }
            __syncthreads();
            const float4* w = (const float4*)(c.in[4] + ((size_t)layer * D + k0) * NMOD);
            float4 ac[6], ax[6];
#pragma unroll
            for (int q = 0; q < 6; ++q) { ac[q] = make_float4(0.f, 0.f, 0.f, 0.f); ax[q] = make_float4(0.f, 0.f, 0.f, 0.f); }
#pragma unroll 4
            for (int r = 0; r < 16; ++r) {
                const float sc = lds[r], sx = lds[16 + r];
#pragma unroll
                for (int q = 0; q < 6; ++q) { const float4 v = w[(size_t)r * (NMOD / 4) + c.tid + 512 * q];
                    ac[q].x = fmaf(sc, v.x, ac[q].x); ac[q].y = fmaf(sc, v.y, ac[q].y); ac[q].z = fmaf(sc, v.z, ac[q].z); ac[q].w = fmaf(sc, v.w, ac[q].w);
                    ax[q].x = fmaf(sx, v.x, ax[q].x); ax[q].y = fmaf(sx, v.y, ax[q].y); ax[q].z = fmaf(sx, v.z, ax[q].z); ax[q].w = fmaf(sx, v.w, ax[q].w); }
            }
            float4* pc = (float4*)(PART + ((size_t)(layer * 128 + slab) * 2 + 0) * NMOD), *px = (float4*)(PART + ((size_t)(layer * 128 + slab) * 2 + 1) * NMOD);
#pragma unroll
            for (int q = 0; q < 6; ++q) { pc[c.tid + 512 * q] = ac[q]; px[c.tid + 512 * q] = ax[q]; }
        }
    }
    for (size_t e = (size_t)c.bid * NTHREADS + c.tid; e < (size_t)2 * 4096 * 256; e += (size_t)c.nb * NTHREADS) {
        const int k = (int)(e & 255), col = (int)((e >> 8) & 4095), layer = (int)(e >> 20);
        c.wsp<bf16_t>(WS_FW3T)[e] = k < 64 ? f2bf(c.in[14][((size_t)layer * 64 + k) * 4096 + col]) : (bf16_t)0;
    }
    const int gw = c.bid * 8 + c.wave, ngw = c.nb * 8;
    for (int task = gw; task < 2 * MR; task += ngw) {
        const int layer = task / MR, pos = task % MR;
        const bool isc = pos >= L; const int i = isc ? pos - L : pos; const int Lx = isc ? LC : L;
        const float tt = (float)i * (1.0f / (float)(Lx - 1));
        const float c0 = (float)(2.0 * 3.14159265358979323846 / (double)Lx);
        const int j = c.lane;
        float feat = 0.f;
        if (j == 0) feat = tt;
        else if (j < 33) { const int b = (j - 1) & 15; const float band = 1e-4f + (float)b * ((15.0f - 1e-4f) / 15.0f); const float ang = (c0 * band) * (float)i; feat = (j <= 16) ? cosf(ang) : -sinf(ang); }
        const float* fw1 = c.in[10] + (size_t)layer * 33 * 64; const float* fb1 = c.in[11] + layer * 64;
        const float* fw2 = c.in[12] + (size_t)layer * 64 * 64; const float* fb2 = c.in[13] + layer * 64;
        const float* fr = c.in[15] + layer * 128;
        float s = fb1[j];
        for (int f = 0; f < 33; ++f) s = fmaf(__shfl(feat, f), fw1[f * 64 + j], s);
        const float h1 = sinf(fr[j] * s);
        float s2 = fb2[j];
        for (int m = 0; m < 64; ++m) s2 = fmaf(__shfl(h1, m), fw2[m * 64 + j], s2);
        const float h2 = sinf(fr[64 + j] * s2);
        bf16_t* hb = c.wsp<bf16_t>(WS_H2B) + ((size_t)layer * MR + pos) * 256;
        hb[j] = f2bf(h2); hb[64 + j] = 0; hb[128 + j] = 0; hb[192 + j] = 0;
    }
}

__device__ __forceinline__ void ph_g0b(const Ctx& c) {
    const float* PART = c.wsp<float>(WS_MODPART);
    for (int i = c.bid * NTHREADS + c.tid; i < 2 * 2 * (NMOD / 4); i += c.nb * NTHREADS) {
        const int n4 = i % (NMOD / 4), ls = i / (NMOD / 4), layer = ls >> 1, src = ls & 1;
        float4 a = *(const float4*)(c.in[5] + (size_t)layer * NMOD + 4 * n4);
#pragma unroll 8
        for (int sl = 0; sl < 128; ++sl) { const float4 v = *(const float4*)(PART + ((size_t)(layer * 128 + sl) * 2 + src) * NMOD + 4 * n4); a.x += v.x; a.y += v.y; a.z += v.z; a.w += v.w; }
        *(float4*)(c.wsp<float>(WS_MOD) + (size_t)(layer * 2 + src) * NMOD + 4 * n4) = a;
    }
}

__device__ __forceinline__ void ph_a(const Ctx& c, int layer) {
    const int gw = c.bid * 8 + c.wave, ngw = c.nb * 8;
    const float* g = c.in[6] + (size_t)layer * D;
    float* gl = (float*)c.smem;
    __syncthreads();
    for (int i = c.tid; i < D; i += NTHREADS) { gl[i] = g[i]; gl[D + i] = c.mod(layer, 0, 0)[i]; gl[2 * D + i] = c.mod(layer, 0, 1)[i]; }
    __syncthreads();
    for (int r = gw; r < MR; r += ngw) {
        const float* x = c.xrow(layer, r);
        const bool lat = r < L;
        const float* shg = c.mod(layer, 1, 0); const float* scg = c.mod(layer, 1, 1);
        float4 v[8]; float ss = 0.f;
#pragma unroll
        for (int j = 0; j < 8; ++j) { v[j] = *(const float4*)(x + 4 * c.lane + 256 * j); ss += v[j].x * v[j].x + v[j].y * v[j].y + v[j].z * v[j].z + v[j].w * v[j].w; }
        ss = wave_sum(ss);
        const float inv = rsqrtf(ss * (1.0f / D) + RMS_EPS);
        bf16_t* o = c.wsp<bf16_t>(WS_HX) + (size_t)r * D;
#pragma unroll
        for (int j = 0; j < 8; ++j) {
            const int col = 4 * c.lane + 256 * j;
            const float4 gg = *(const float4*)(gl + col);
            const float4 s4 = lat ? *(const float4*)(gl + D + col) : *(const float4*)(shg + col);
            const float4 c4 = lat ? *(const float4*)(gl + 2 * D + col) : *(const float4*)(scg + col);
            const float y0 = v[j].x * inv * gg.x * (1.f + c4.x) + s4.x, y1 = v[j].y * inv * gg.y * (1.f + c4.y) + s4.y;
            const float y2 = v[j].z * inv * gg.z * (1.f + c4.z) + s4.z, y3 = v[j].w * inv * gg.w * (1.f + c4.w) + s4.w;
            uint2 w; w.x = pk2(y0, y1); w.y = pk2(y2, y3);
            *(uint2*)(o + col) = w;
        }
    }
}

struct EpiIn {
    unsigned char* ws;
    __device__ __forceinline__ void operator()(int row, int col, const float (&v)[8]) const {
        if (col < OFF_WAQ) {
            bf16_t* d = (bf16_t*)(ws + WS_ZHYT);
#pragma unroll
            for (int j = 0; j < 8; ++j) d[(size_t)(col + j) * MR + row] = f2bf(v[j]);
            return;
        }
        bf16_t* dst; float t[8];
#pragma unroll
        for (int j = 0; j < 8; ++j) t[j] = v[j];
        if (col < OFF_WAKV) dst = (bf16_t*)(ws + WS_QWA) + (size_t)row * 1024 + (col - OFF_WAQ);
        else if (col < OFF_NAQ) dst = (bf16_t*)(ws + WS_KVWA) + (size_t)row * 512 + (col - OFF_WAKV);
        else if (col < OFF_NAKV) dst = (bf16_t*)(ws + WS_QNA) + (size_t)row * 1024 + (col - OFF_NAQ);
        else if (col < OFF_GATE) dst = (bf16_t*)(ws + WS_KVNA) + (size_t)row * 2048 + (col - OFF_NAKV);
        else { dst = (bf16_t*)(ws + WS_GATE) + (size_t)row * 6144 + (col - OFF_GATE);
#pragma unroll
            for (int j = 0; j < 8; ++j) t[j] = sigmoid_f(t[j]); }
        uint4 o; o.x = pk2(t[0], t[1]); o.y = pk2(t[2], t[3]); o.z = pk2(t[4], t[5]); o.w = pk2(t[6], t[7]);
        *(uint4*)dst = o;
    }
};
__device__ __forceinline__ void ph_b(const Ctx& c, int layer) {
    const RowLin rp{c.wsp<bf16_t>(WS_HX), D};
    const EpiIn ep{c.ws};
    const float* W = c.in[7] + (size_t)layer * D * NIN;
    const int nM = MR / 128, nN = NIN / 128;
    for (int u = c.bid; u < nM * nN; u += c.nb) {
        const int pm = u % nM, pn = u / nM;
        sgemm_unit(rp, W, NIN, D, pm * 128, pn * 128, ep, (float*)c.smem, c.tid);
    }
}

__device__ __forceinline__ void b2_segment(bf16_t* p, const float* gain, bool rope, int r, int lane, bool active) {
    uint4 w = make_uint4(0u, 0u, 0u, 0u);
    if (active) w = *(const uint4*)(p + 8 * lane);
    float x[8] = {__uint_as_float(w.x << 16), __uint_as_float(w.x & 0xffff0000u), __uint_as_float(w.y << 16), __uint_as_float(w.y & 0xffff0000u),
                  __uint_as_float(w.z << 16), __uint_as_float(w.z & 0xffff0000u), __uint_as_float(w.w << 16), __uint_as_float(w.w & 0xffff0000u)};
    float ss = 0.f;
#pragma unroll
    for (int i = 0; i < 8; ++i) ss += x[i] * x[i];
    ss += __shfl_xor(ss, 1); ss += __shfl_xor(ss, 2); ss += __shfl_xor(ss, 4); ss += __shfl_xor(ss, 8);
    const float inv = rsqrtf(ss * (1.0f / 128.0f) + RMS_EPS);
    const int d0 = (lane & 15) * 8;
    const float4 g0 = *(const float4*)(gain + d0), g1 = *(const float4*)(gain + d0 + 4);
    const float gg[8] = {g0.x, g0.y, g0.z, g0.w, g1.x, g1.y, g1.z, g1.w};
#pragma unroll
    for (int i = 0; i < 8; ++i) x[i] = x[i] * inv * gg[i];
    if (rope) {
        const int axis = d0 >> 6, half = (d0 >> 5) & 1, f0 = d0 & 31;
        const float pos = axis == 0 ? (float)(r / GRIDW) : (float)(r % GRIDW);
#pragma unroll
        for (int i = 0; i < 8; ++i) {
            const float other = __shfl_xor(x[i], 4);
            const float ang = pos * powf(10000.0f, -(float)(f0 + i) / 32.0f);
            float sn, cs; sincosf(ang, &sn, &cs);
            x[i] = half == 0 ? x[i] * cs - other * sn : x[i] * cs + other * sn;
        }
    }
    if (active) { uint4 o; o.x = pk2(x[0], x[1]); o.y = pk2(x[2], x[3]); o.z = pk2(x[4], x[5]); o.w = pk2(x[6], x[7]); *(uint4*)(p + 8 * lane) = o; }
}
__device__ __forceinline__ void ph_b2(const Ctx& c, int layer) {
    const int gw = c.bid * 8 + c.wave, ngw = c.nb * 8;
    const int lane = c.lane;
    for (int r = gw; r < MR; r += ngw) {
        const bool lat = r < L;
        b2_segment(c.wsp<bf16_t>(WS_QWA) + (size_t)r * 1024, c.in[18] + layer * 128, lat, r, lane, true);
        b2_segment(c.wsp<bf16_t>(WS_QWA) + (size_t)r * 1024 + 512, c.in[18] + layer * 128, lat, r, lane, true);
        b2_segment(c.wsp<bf16_t>(WS_KVWA) + (size_t)r * 512, c.in[19] + layer * 128, lat, r, lane, lane < 32);
        b2_segment(c.wsp<bf16_t>(WS_QNA) + (size_t)r * 1024, c.in[21] + layer * 128, false, r, lane, true);
        b2_segment(c.wsp<bf16_t>(WS_QNA) + (size_t)r * 1024 + 512, c.in[21] + layer * 128, false, r, lane, true);
        b2_segment(c.wsp<bf16_t>(WS_KVNA) + (size_t)r * 2048, c.in[22] + layer * 128, false, r, lane, true);
        b2_segment(c.wsp<bf16_t>(WS_KVNA) + (size_t)r * 2048 + 512, c.in[22] + layer * 128, false, r, lane, true);
    }
}

__device__ __forceinline__ float shortconv_at(const bf16_t* z, int t, int Lx, float w0, float w1, float w2, float b) {
    const float zm = t > 0 ? bf2f(z[t - 1]) : 0.f, z0 = bf2f(z[t]), zp = t + 1 < Lx ? bf2f(z[t + 1]) : 0.f;
    return zm * w0 + z0 * w1 + zp * w2 + b;
}
__device__ __forceinline__ float block_sum(float v, float* red, int tid) {
    v = wave_sum(v);
    __syncthreads();
    if ((tid & 63) == 0) red[tid >> 6] = v;
    __syncthreads();
    float t = 0.f;
#pragma unroll
    for (int w = 0; w < 8; ++w) t += red[w];
    return t;
}
__device__ __forceinline__ void hyena_direct_unit(const Ctx& c, int layer, int ch) {
    bf16_t* kc = (bf16_t*)c.smem;
    float* cv = (float*)c.smem;
    float* us = (float*)(c.smem + 4 * L);
    float* red = us + L;
    const int tid = c.tid;
    const float* cw = c.in[8] + (size_t)layer * 3 * 3072; const float* cb = c.in[9] + (size_t)layer * 3072;
    const bf16_t* zv = c.wsp<bf16_t>(WS_ZHYT) + (size_t)ch * MR;
    const bf16_t* z1 = c.wsp<bf16_t>(WS_ZHYT) + (size_t)(1024 + ch) * MR;
    const bf16_t* z2 = c.wsp<bf16_t>(WS_ZHYT) + (size_t)(2048 + ch) * MR;
    const bf16_t* KF = c.wsp<bf16_t>(WS_KF);
    __syncthreads();
    { const float w0 = cw[ch], w1 = cw[3072 + ch], w2 = cw[6144 + ch], b = cb[ch];
#pragma unroll 2
      for (int t = tid; t < L; t += NTHREADS) us[t] = shortconv_at(zv, t, L, w0, w1, w2, b); }
    for (int o = 0; o < 2; ++o) {
        const bf16_t* hf = KF + (size_t)(o * 1024 + ch) * L;
        const bf16_t* hb = KF + (size_t)(2048 + o * 1024 + ch) * L;
        float sabs = 0.f;
#pragma unroll 2
        for (int t = tid; t < L; t += NTHREADS) {
            bf16_t kf = hf[t], kb = hb[t];
            if (t == 0) { kf = f2bf(bf2f(kf) + bf2f(kb)); kb = 0; }
            kc[L + t] = kf; kc[L - t] = (t == 0) ? kf : kb;
            sabs += fabsf(bf2f(kf)) + fabsf(bf2f(kb));
        }
        if (tid == 0) kc[0] = 0;
        const float S = block_sum(sabs, red, tid);
        {
            float acc[32];
#pragma unroll
            for (int j = 0; j < 32; ++j) acc[j] = 0.f;
#pragma unroll 2
            for (int s = 0; s < L; ++s) {
                const float uv = us[s];
                const bf16_t* kp = kc + (L + tid - s);
#pragma unroll
                for (int j = 0; j < 32; ++j) acc[j] = fmaf(uv, bf2f(kp[512 * j]), acc[j]);
            }
            __syncthreads();
#pragma unroll
            for (int j = 0; j < 32; ++j) cv[tid + 512 * j] = acc[j];
        }
        LDS_FENCE();
        const float invS = 1.0f / S;
        const float dsk = c.in[17][(size_t)layer * 2048 + o * 1024 + ch];
        const int co = o == 0 ? 1024 : 2048;
        const bf16_t* zz = o == 0 ? z1 : z2;
        const float w0 = cw[co + ch], w1 = cw[3072 + co + ch], w2 = cw[6144 + co + ch], b = cb[co + ch];
        bf16_t* dst = c.wsp<bf16_t>(WS_YHYT) + (size_t)ch * L;
#pragma unroll 2
        for (int t = tid; t < L; t += NTHREADS) {
            const float r = shortconv_at(zz, t, L, w0, w1, w2, b) * (cv[t] * invS + us[t] * dsk);
            if (o == 0) us[t] = r; else dst[t] = f2bf(r);
        }
        __syncthreads();
    }
}
__device__ __forceinline__ void hyena_ctx_unit(const Ctx& c, int layer, int ch) {
    float* kc = (float*)c.smem;
    float* us = kc + 512;
    float* red = us + 256;
    const int tid = c.tid;
    const float* cw = c.in[8] + (size_t)layer * 3 * 3072; const float* cb = c.in[9] + (size_t)layer * 3072;
    const bf16_t* zv = c.wsp<bf16_t>(WS_ZHYT) + (size_t)ch * MR + L;
    const bf16_t* z1 = c.wsp<bf16_t>(WS_ZHYT) + (size_t)(1024 + ch) * MR + L;
    const bf16_t* z2 = c.wsp<bf16_t>(WS_ZHYT) + (size_t)(2048 + ch) * MR + L;
    const bf16_t* KF = c.wsp<bf16_t>(WS_KFC);
    __syncthreads();
    if (tid < LC) us[tid] = shortconv_at(zv, tid, LC, cw[ch], cw[3072 + ch], cw[6144 + ch], cb[ch]);
    for (int o = 0; o < 2; ++o) {
        const bf16_t* hf = KF + (size_t)(o * 1024 + ch) * LC;
        const bf16_t* hb = KF + (size_t)(2048 + o * 1024 + ch) * LC;
        float sabs = 0.f;
        {
            const int lag = tid - 256; float k;
            if (lag == 0) k = bf2f(hf[0]) + bf2f(hb[0]); else if (lag > 0) k = bf2f(hf[lag]); else if (lag > -256) k = bf2f(hb[-lag]); else k = 0.f;
            kc[tid] = k; sabs = fabsf(k);
        }
        const float S = block_sum(sabs, red, tid);
        float acc = 0.f;
        if (tid < LC) for (int s = 0; s < LC; ++s) acc = fmaf(us[s], kc[256 + tid - s], acc);
        const float dsk = c.in[17][(size_t)layer * 2048 + o * 1024 + ch];
        float res = 0.f;
        if (tid < LC) {
            const bf16_t* zz = o == 0 ? z1 : z2; const int co = o == 0 ? 1024 : 2048;
            res = shortconv_at(zz, tid, LC, cw[co + ch], cw[3072 + co + ch], cw[6144 + co + ch], cb[co + ch]) * (acc / S + us[tid] * dsk);
        }
        __syncthreads();
        if (tid < LC) { if (o == 0) us[tid] = res; else c.wsp<bf16_t>(WS_YHY)[(size_t)(L + tid) * 1024 + ch] = f2bf(res); }
        __syncthreads();
    }
}

template <class KeyFn>
__device__ __forceinline__ void wave_attn(const bf16_t* q, int nkeys, const KeyFn& key, bool has_sink, float sink, bf16_t* out, float* wl, int lane) {
    float* qf = wl;
    float* sc = wl + 128;
    qf[2 * lane] = bf2f(q[2 * lane]); qf[2 * lane + 1] = bf2f(q[2 * lane + 1]);
    LDS_FENCE();
    float mx = -3.0e38f;
    for (int j = lane; j < nkeys; j += 64) {
        const bf16_t* kp; const bf16_t* vp; float bias;
        float s = -1e30f;
        if (key(j, kp, vp, bias)) {
            float d = 0.f;
#pragma unroll
            for (int e = 0; e < 128; e += 8) {
                const uint4 kk = *(const uint4*)(kp + e);
                d = fmaf(qf[e + 0], __uint_as_float(kk.x << 16), d); d = fmaf(qf[e + 1], __uint_as_float(kk.x & 0xffff0000u), d);
                d = fmaf(qf[e + 2], __uint_as_float(kk.y << 16), d); d = fmaf(qf[e + 3], __uint_as_float(kk.y & 0xffff0000u), d);
                d = fmaf(qf[e + 4], __uint_as_float(kk.z << 16), d); d = fmaf(qf[e + 5], __uint_as_float(kk.z & 0xffff0000u), d);
                d = fmaf(qf[e + 6], __uint_as_float(kk.w << 16), d); d = fmaf(qf[e + 7], __uint_as_float(kk.w & 0xffff0000u), d);
            }
            s = d * QK_SCALE + bias;
        }
        sc[j] = s; mx = fmaxf(mx, s);
    }
    if (has_sink) mx = fmaxf(mx, sink);
    mx = wave_max(mx);
    float sum = 0.f;
    for (int j = lane; j < nkeys; j += 64) { const float p = __expf(sc[j] - mx); sc[j] = p; sum += p; }
    sum = wave_sum(sum);
    if (has_sink) sum += __expf(sink - mx);
    LDS_FENCE();
    float o0 = 0.f, o1 = 0.f;
    for (int j = 0; j < nkeys; ++j) {
        const float p = sc[j];
        if (p != 0.f) {
            const bf16_t* kp; const bf16_t* vp; float bias;
            key(j, kp, vp, bias);
            const unsigned vv = *(const unsigned*)(vp + 2 * lane);
            o0 = fmaf(p, __uint_as_float(vv << 16), o0); o1 = fmaf(p, __uint_as_float(vv & 0xffff0000u), o1);
        }
    }
    const float inv = 1.0f / sum;
    *(unsigned*)(out + 2 * lane) = pk2(o0 * inv, o1 * inv);
    LDS_FENCE();
}

struct KeyWA {
    const bf16_t* kv; int t, kvh;
    __device__ __forceinline__ bool operator()(int j, const bf16_t*& kp, const bf16_t*& vp, float& bias) const {
        bias = 0.f;
        int row; bool ok = true;
        if (j < 257) { const int kpos = t - 128 + j; ok = kpos >= 0 && kpos < L; row = ok ? kpos : 0; } else row = L + (j - 257);
        kp = kv + (size_t)row * 512 + kvh * 128; vp = kp + 256; return ok;
    }
};
struct KeyCtxWA { const bf16_t* kv; int kvh;
    __device__ __forceinline__ bool operator()(int j, const bf16_t*& kp, const bf16_t*& vp, float& bias) const { bias = 0.f; kp = kv + (size_t)(L + j) * 512 + kvh * 128; vp = kp + 256; return true; } };
struct KeyNA {
    const bf16_t* kv; const float* rpb; int r, qc, r0, cs, h;
    __device__ __forceinline__ bool operator()(int j, const bf16_t*& kp, const bf16_t*& vp, float& bias) const {
        int row;
        if (j < 128) { const int w = j >> 4, kc = cs + (j & 15); row = (r0 + w) * GRIDW + kc;
            const int dr = r0 + w - r + 7; int dc = kc - qc + 15; dc = dc < 0 ? 0 : (dc > 30 ? 30 : dc);
            bias = rpb[(h * 15 + dr) * 31 + dc]; }
        else { row = L + (j - 128); bias = 0.f; }
        kp = kv + (size_t)row * 2048 + h * 128; vp = kp + 1024; return true;
    }
};
struct KeyCtxNA { const bf16_t* kv; int h;
    __device__ __forceinline__ bool operator()(int j, const bf16_t*& kp, const bf16_t*& vp, float& bias) const { bias = 0.f; kp = kv + (size_t)(L + j) * 2048 + h * 128; vp = kp + 1024; return true; } };


#define HYF __device__ __forceinline__
#define HYF_OPAQUE(x) asm volatile("" : "+v"(x))
#define HYF_SB(i) do { if (((i) & 3) == 3) __builtin_amdgcn_sched_barrier(0); } while (0)
namespace hyf {
constexpr int FL = 16384;
constexpr int FPAD = FL + 32 * 16;
typedef float cpx __attribute__((ext_vector_type(2)));
HYF int phys(int p) { return ((p & ~15) | ((p & 15) ^ ((p >> 5) & 15))) + ((p >> 9) << 4); }

#define HYF_C32 {1.0f, 0.98078528040323043f, 0.92387953251128674f, 0.83146961230254524f, 0.70710678118654752f, 0.55557023301960218f, 0.38268343236508978f, 0.19509032201612825f, \
                 0.0f, -0.19509032201612825f, -0.38268343236508978f, -0.55557023301960218f, -0.70710678118654752f, -0.83146961230254524f, -0.92387953251128674f, -0.98078528040323043f}
#define HYF_S32 {0.0f, 0.19509032201612825f, 0.38268343236508978f, 0.55557023301960218f, 0.70710678118654752f, 0.83146961230254524f, 0.92387953251128674f, 0.98078528040323043f, \
                 1.0f, 0.98078528040323043f, 0.92387953251128674f, 0.83146961230254524f, 0.70710678118654752f, 0.55557023301960218f, 0.38268343236508978f, 0.19509032201612825f}

HYF int rev5(int x) { return (int)(__builtin_bitreverse32((unsigned)x) >> 27); }
HYF int rev4(int x) { return (int)(__builtin_bitreverse32((unsigned)x) >> 28); }
HYF cpx cmul(cpx a, cpx t) { return a.xx * t + (cpx){-a.y, a.y} * t.yx; }
HYF cpx cmulc(cpx a, cpx t) { return t.xx * a + t.yy * (cpx){a.y, -a.x}; }

template <int N, int SG, int BASE, int STRIDE32>
struct DifStage {
    static HYF void run(cpx (&v)[32], const float (&K)[9]) {
        constexpr int H = N / 2;
#pragma unroll
        for (int j = 0; j < H; ++j) {
            const cpx a = v[BASE + j], b = v[BASE + j + H];
            v[BASE + j] = a + b;
            const cpx d = a - b;
            const int tw = j * STRIDE32;
            if (tw == 0) v[BASE + j + H] = d;
            else if (tw == 8) v[BASE + j + H] = (SG < 0) ? (cpx){d.y, -d.x} : (cpx){-d.y, d.x};
            else {
                const float c = (tw < 8) ? K[tw] : -K[16 - tw];
                const float sa = (tw < 8) ? K[8 - tw] : K[tw - 8];
                const float s = (SG < 0) ? -sa : sa;
                v[BASE + j + H] = d * c + (cpx){-d.y, d.x} * s;
            }
        }
        if constexpr (N > 2) { DifStage<H, SG, BASE, STRIDE32 * 2>::run(v, K); DifStage<H, SG, BASE + H, STRIDE32 * 2>::run(v, K); }
    }
};
template <int SG> HYF void dft32(cpx (&v)[32], const float (&K0)[9]) { float K[9]; _Pragma("unroll") for (int m = 0; m < 9; ++m) { K[m] = K0[m]; HYF_OPAQUE(K[m]); } DifStage<32, SG, 0, 1>::run(v, K); }
template <int SG> HYF void dft16(cpx (&v)[32], const float (&K0)[9]) { float K[9]; _Pragma("unroll") for (int m = 0; m < 9; ++m) { K[m] = K0[m]; HYF_OPAQUE(K[m]); } DifStage<16, SG, 0, 2>::run(v, K); }

struct ThreadTw { cpx w1;
                  cpx w2;
                  cpx wo;
                  int b1;
                  int b2, n3;
                  int b3[2], sw;
                  float K[9]; };
HYF void tw_addr(int tid, ThreadTw& t) {
    t.b1 = (tid & ~15) | ((tid & 15) ^ ((tid >> 5) & 15));
    t.b2 = (tid >> 4) * 528; t.n3 = tid & 15; t.sw = (tid >> 1) & 15;
    for (int h = 0; h < 2; ++h) { const int g = tid + 512 * h; t.b3[h] = g * 16 + (g >> 5) * 16; }
    constexpr float KK[9] = {1.0f, 0.98078528040323043f, 0.92387953251128674f, 0.83146961230254524f, 0.70710678118654752f, 0.55557023301960218f, 0.38268343236508978f, 0.19509032201612825f, 0.0f};
    for (int m = 0; m < 9; ++m) { t.K[m] = KK[m]; HYF_OPAQUE(t.K[m]); }
}

HYF void fwd_p1(const ThreadTw& tw, cpx (&v)[32], cpx* lds) {
    int b1 = tw.b1; HYF_OPAQUE(b1);
    float wx = tw.w1.x, wy = tw.w1.y; HYF_OPAQUE(wx); HYF_OPAQUE(wy); const cpx w = {wx, wy};
    dft32<-1>(v, tw.K);
    cpx t = {1.f, 0.f};
#pragma unroll
    for (int k1 = 0; k1 < 32; ++k1) {
        lds[b1 + 528 * k1] = cmul(v[rev5(k1)], t);
        t = cmul(t, w);
        HYF_SB(k1);
    }
}
HYF void fwd_p2(const ThreadTw& tw, cpx* lds) {
    int b2 = tw.b2, n3 = tw.n3; HYF_OPAQUE(b2); HYF_OPAQUE(n3);
    float wx = tw.w2.x, wy = tw.w2.y; HYF_OPAQUE(wx); HYF_OPAQUE(wy); const cpx w = {wx, wy};
    cpx v[32];
#pragma unroll
    for (int n2 = 0; n2 < 32; ++n2) v[n2] = lds[b2 + 16 * n2 + (n3 ^ ((n2 >> 1) & 15))];
    dft32<-1>(v, tw.K);
    cpx t = {1.f, 0.f};
#pragma unroll
    for (int k2 = 0; k2 < 32; ++k2) {
        lds[b2 + 16 * k2 + (n3 ^ ((k2 >> 1) & 15))] = cmul(v[rev5(k2)], t);
        t = cmul(t, w);
        HYF_SB(k2);
    }
}
HYF void fwd_p3(int tid, const ThreadTw& tw, const cpx* lds, cpx* ks) {
    HYF_OPAQUE(tid);
#pragma unroll
    for (int h = 0; h < 2; ++h) {
        int b3 = tw.b3[h], sw = tw.sw; HYF_OPAQUE(b3); HYF_OPAQUE(sw);
        cpx v[32];
#pragma unroll
        for (int n3 = 0; n3 < 16; ++n3) v[n3] = lds[b3 + (n3 ^ sw)];
        dft16<-1>(v, tw.K);
#pragma unroll
        for (int k3 = 0; k3 < 16; ++k3) ks[(h * 16 + k3) * 512 + tid] = v[rev4(k3)];
    }
}
HYF void mid_p3(int tid, const ThreadTw& tw, cpx* lds, const cpx* ks) {
    HYF_OPAQUE(tid);
#pragma unroll
    for (int h = 0; h < 2; ++h) {
        int b3 = tw.b3[h], sw = tw.sw; HYF_OPAQUE(b3); HYF_OPAQUE(sw);
        cpx v[32], p[32];
#pragma unroll
        for (int n3 = 0; n3 < 16; ++n3) v[n3] = lds[b3 + (n3 ^ sw)];
        dft16<-1>(v, tw.K);
#pragma unroll
        for (int k3 = 0; k3 < 16; ++k3) p[k3] = cmul(v[rev4(k3)], ks[(h * 16 + k3) * 512 + tid]);
        dft16<1>(p, tw.K);
#pragma unroll
        for (int n3 = 0; n3 < 16; ++n3) lds[b3 + (n3 ^ sw)] = p[rev4(n3)];
    }
}
HYF void inv_p2(const ThreadTw& tw, cpx* lds) {
    int b2 = tw.b2, n3 = tw.n3; HYF_OPAQUE(b2); HYF_OPAQUE(n3);
    float wx = tw.w2.x, wy = tw.w2.y; HYF_OPAQUE(wx); HYF_OPAQUE(wy); const cpx w = {wx, wy};
    cpx v[32];
    cpx t = {1.f, 0.f};
#pragma unroll
    for (int k2 = 0; k2 < 32; ++k2) {
        v[k2] = cmulc(lds[b2 + 16 * k2 + (n3 ^ ((k2 >> 1) & 15))], t);
        t = cmul(t, w);
        HYF_SB(k2);
    }
    dft32<1>(v, tw.K);
#pragma unroll
    for (int n2 = 0; n2 < 32; ++n2) { lds[b2 + 16 * n2 + (n3 ^ ((n2 >> 1) & 15))] = v[rev5(n2)]; HYF_SB(n2); }
}
HYF void inv_p1(const ThreadTw& tw, const cpx* lds, cpx (&out)[32]) {
    int b1 = tw.b1; HYF_OPAQUE(b1);
    float wx = tw.w1.x, wy = tw.w1.y; HYF_OPAQUE(wx); HYF_OPAQUE(wy); const cpx w = {wx, wy};
    cpx v[32];
    cpx t = {1.f, 0.f};
#pragma unroll
    for (int k1 = 0; k1 < 32; ++k1) {
        v[k1] = cmulc(lds[b1 + 528 * k1], t);
        t = cmul(t, w);
        HYF_SB(k1);
    }
    dft32<1>(v, tw.K);
#pragma unroll
    for (int n1 = 0; n1 < 32; ++n1) out[n1] = v[rev5(n1)];
}
HYF cpx opaque_wo(const ThreadTw& tw) { float x = tw.wo.x, y = tw.wo.y; HYF_OPAQUE(x); HYF_OPAQUE(y); return (cpx){x, y}; }
HYF cpx modfac(cpx wo, int n1) {
    constexpr float C64[32] = {1.0f, 0.99518472667219693f, 0.98078528040323043f, 0.95694033573220882f, 0.92387953251128674f, 0.88192126434835505f, 0.83146961230254524f, 0.77301045336273699f,
        0.70710678118654752f, 0.63439328416364549f, 0.55557023301960218f, 0.47139673682599764f, 0.38268343236508978f, 0.29028467725446233f, 0.19509032201612825f, 0.098017140329560604f,
        0.0f, -0.098017140329560604f, -0.19509032201612825f, -0.29028467725446233f, -0.38268343236508978f, -0.47139673682599764f, -0.55557023301960218f, -0.63439328416364549f,
        -0.70710678118654752f, -0.77301045336273699f, -0.83146961230254524f, -0.88192126434835505f, -0.92387953251128674f, -0.95694033573220882f, -0.98078528040323043f, -0.99518472667219693f};
    constexpr float S64[32] = {0.0f, 0.098017140329560604f, 0.19509032201612825f, 0.29028467725446233f, 0.38268343236508978f, 0.47139673682599764f, 0.55557023301960218f, 0.63439328416364549f,
        0.70710678118654752f, 0.77301045336273699f, 0.83146961230254524f, 0.88192126434835505f, 0.92387953251128674f, 0.95694033573220882f, 0.98078528040323043f, 0.99518472667219693f,
        1.0f, 0.99518472667219693f, 0.98078528040323043f, 0.95694033573220882f, 0.92387953251128674f, 0.88192126434835505f, 0.83146961230254524f, 0.77301045336273699f,
        0.70710678118654752f, 0.63439328416364549f, 0.55557023301960218f, 0.47139673682599764f, 0.38268343236508978f, 0.29028467725446233f, 0.19509032201612825f, 0.098017140329560604f};
    return cmul(wo, (cpx){C64[n1], -S64[n1]});
}
}

#undef HYF
#ifndef FAST_HY
#define FAST_HY 1
#endif
__device__ __forceinline__ void hyena_fft_unit(const Ctx& c, int layer, int ch, const hyf::ThreadTw& tw) {
    using namespace hyf;
    cpx* lds = (cpx*)c.smem; float* red = (float*)(c.smem + (size_t)FPAD * 8);
    cpx* ks = c.wsp<cpx>(WS_KS) + (size_t)c.bid * (2 * FL);
    float* ub = (float*)(ks + FL); float* yb = ub + FL;
    const int tid = c.tid;
    const float* cw = c.in[8] + (size_t)layer * 3 * 3072; const float* cb = c.in[9] + (size_t)layer * 3072;
    const bf16_t* zv = c.wsp<bf16_t>(WS_ZHYT) + (size_t)ch * MR;
    const bf16_t* KF = c.wsp<bf16_t>(WS_KF);
    { const float w0 = cw[ch], w1 = cw[3072 + ch], w2 = cw[6144 + ch], b = cb[ch]; int tq = tid; HYF_OPAQUE(tq);
#pragma unroll 4
      for (int j = 0; j < 32; ++j) ub[tq + 512 * j] = shortconv_at(zv, tq + 512 * j, L, w0, w1, w2, b); }
#pragma unroll 1
    for (int o = 0; o < 2; ++o) {
        const bf16_t* hf = KF + (size_t)(o * 1024 + ch) * L;
        const bf16_t* hb = KF + (size_t)(2048 + o * 1024 + ch) * L;
        float S;
        {
            cpx v[32]; float sabs = 0.f; int tq = tid; HYF_OPAQUE(tq);
#pragma unroll
            for (int j = 0; j < 32; ++j) { const int n = tq + 512 * j; const float f = bf2f(hf[n]); const float bb = bf2f(hb[n == 0 ? 0 : L - n]);
                v[j] = (cpx){f + bb, 0.f}; sabs += (n == 0) ? fabsf(f + bb) : fabsf(f) + fabsf(bb); }
            S = block_sum(sabs, red, tid);
            fwd_p1(tw, v, lds); __syncthreads(); fwd_p2(tw, lds); __syncthreads(); fwd_p3(tid, tw, lds, ks); __syncthreads();
        }
        {
            cpx v[32]; int tq = tid; HYF_OPAQUE(tq);
#pragma unroll
            for (int j = 0; j < 32; ++j) v[j] = (cpx){ub[tq + 512 * j], 0.f};
            fwd_p1(tw, v, lds); __syncthreads(); fwd_p2(tw, lds); __syncthreads(); mid_p3(tid, tw, lds, ks); __syncthreads();
            inv_p2(tw, lds); __syncthreads();
            inv_p1(tw, lds, v); __syncthreads();
            HYF_OPAQUE(tq);
#pragma unroll
            for (int j = 0; j < 32; ++j) yb[tq + 512 * j] = v[j].x;
        }
        {
            cpx v[32]; const cpx wo = opaque_wo(tw); int tq = tid; HYF_OPAQUE(tq);
#pragma unroll
            for (int j = 0; j < 32; ++j) { const int n = tq + 512 * j; const float f = bf2f(hf[n]); const float bb = bf2f(hb[n == 0 ? 0 : L - n]);
                const float d = (n == 0) ? f + bb : f - bb; v[j] = modfac(wo, j) * d; }
            fwd_p1(tw, v, lds); __syncthreads(); fwd_p2(tw, lds); __syncthreads(); fwd_p3(tid, tw, lds, ks); __syncthreads();
        }
        {
            cpx v[32]; cpx wo = opaque_wo(tw); int tq = tid; HYF_OPAQUE(tq);
#pragma unroll
            for (int j = 0; j < 32; ++j) v[j] = modfac(wo, j) * ub[tq + 512 * j];
            fwd_p1(tw, v, lds); __syncthreads(); fwd_p2(tw, lds); __syncthreads(); mid_p3(tid, tw, lds, ks); __syncthreads();
            inv_p2(tw, lds); __syncthreads();
            inv_p1(tw, lds, v); __syncthreads();
            const float sc = (0.5f / (float)L) / S; wo = opaque_wo(tw); HYF_OPAQUE(tq);
            const float dsk = c.in[17][(size_t)layer * 2048 + o * 1024 + ch];
            const int co = o == 0 ? 1024 : 2048;
            const bf16_t* zz = c.wsp<bf16_t>(WS_ZHYT) + (size_t)(co + ch) * MR;
            const float w0 = cw[co + ch], w1 = cw[3072 + co + ch], w2 = cw[6144 + co + ch], b = cb[co + ch];
            bf16_t* dst = c.wsp<bf16_t>(WS_YHYT) + (size_t)ch * L;
#pragma unroll
            for (int j = 0; j < 32; ++j) { const int t = tq + 512 * j; const cpx m = modfac(wo, j);
                const float conv = (yb[t] + v[j].x * m.x + v[j].y * m.y) * sc;
                const float r = shortconv_at(zz, t, L, w0, w1, w2, b) * (conv + ub[t] * dsk);
                if (o == 0) ub[t] = r; else dst[t] = f2bf(r); }
        }
    }
}


#ifndef FAST_ATT
#define FAST_ATT 1
#endif
namespace fa {
using bf16x8 = __attribute__((ext_vector_type(8))) short;
using s16x4  = __attribute__((ext_vector_type(4))) short;
using f32x16 = __attribute__((ext_vector_type(16))) float;
using u32x4  = __attribute__((ext_vector_type(4))) unsigned;
constexpr int AD = 128, NW = 8, QBLK = 32, KVBLK = 64;
constexpr float SCALE = 0.088388347648318440f;
constexpr float THR = 8.f;
constexpr size_t SHM_V = KVBLK * AD * 2, SHM_K = KVBLK * AD * 2, SHM_ATTN = 2 * SHM_V + 2 * SHM_K + NW * 64 * 4;
constexpr float NEG = -1e30f;
#define KSWZ(row, colB) ((row) * 256 + ((colB) ^ (((row) & 7) << 4)))
#define SBAR() __builtin_amdgcn_sched_barrier(0)
__device__ __forceinline__ int crow(int r, int hi) { return (r & 3) + 8 * (r >> 2) + 4 * hi; }
__device__ __forceinline__ unsigned cvtpk(float lo, float hi) { unsigned r; asm volatile("v_cvt_pk_bf16_f32 %0, %1, %2" : "=v"(r) : "v"(lo), "v"(hi)); return r; }
__device__ __forceinline__ void partialSM(f32x16& p0, f32x16& p1, float& m_reg, float& mn, float& alpha) {
  constexpr float C = SCALE * 1.4426950408889634f;
  float pmax = p0[0];
#pragma unroll
  for (int r = 1; r < 16; ++r) pmax = fmaxf(pmax, p0[r]);
#pragma unroll
  for (int r = 0; r < 16; ++r) pmax = fmaxf(pmax, p1[r]);
  { auto rr = __builtin_amdgcn_permlane32_swap(__float_as_uint(pmax), __float_as_uint(pmax), false, false);
    pmax = fmaxf(__uint_as_float(rr[0]), __uint_as_float(rr[1])); }
  if (__builtin_expect(__all(pmax - m_reg <= THR / SCALE), 1)) { mn = m_reg; alpha = 1.f; }
  else { mn = fmaxf(m_reg, pmax); alpha = __builtin_amdgcn_exp2f((m_reg - mn) * C); m_reg = mn; }
  const float mnC = -mn * C;
#pragma unroll
  for (int r = 0; r < 16; ++r) p0[r] = fmaf(p0[r], C, mnC);
#pragma unroll
  for (int r = 0; r < 16; ++r) p1[r] = fmaf(p1[r], C, mnC);
#pragma unroll
  for (int r = 0; r < 16; ++r) p0[r] = __builtin_amdgcn_exp2f(p0[r]);
}
__device__ __forceinline__ void finishSM(f32x16& p0, f32x16& p1, float alpha, float& l_reg, bf16x8& pa0, bf16x8& pa1, bf16x8& pa2, bf16x8& pa3) {
#pragma unroll
  for (int r = 0; r < 16; ++r) p1[r] = __builtin_amdgcn_exp2f(p1[r]);
  float ps = 0;
#pragma unroll
  for (int r = 0; r < 16; ++r) ps += p0[r];
#pragma unroll
  for (int r = 0; r < 16; ++r) ps += p1[r];
  { auto rr = __builtin_amdgcn_permlane32_swap(__float_as_uint(ps), __float_as_uint(ps), false, false);
    ps = __uint_as_float(rr[0]) + __uint_as_float(rr[1]); }
  l_reg = l_reg * alpha + ps;
#define PK4(P, BASE, OUT) do { unsigned a0 = cvtpk(P[BASE + 0], P[BASE + 1]), a1 = cvtpk(P[BASE + 2], P[BASE + 3]);   \
    unsigned b0 = cvtpk(P[BASE + 4], P[BASE + 5]), b1 = cvtpk(P[BASE + 6], P[BASE + 7]);                              \
    auto r0 = __builtin_amdgcn_permlane32_swap(a0, b0, false, false); auto r1 = __builtin_amdgcn_permlane32_swap(a1, b1, false, false); \
    u32x4 w = {r0[0], r1[0], r0[1], r1[1]}; OUT = *reinterpret_cast<bf16x8*>(&w); } while (0)
  PK4(p0, 0, pa0); PK4(p0, 8, pa1); PK4(p1, 0, pa2); PK4(p1, 8, pa3);
#undef PK4
}
__device__ __forceinline__ void qkt(f32x16& p0, f32x16& p1, const char* Ks, const bf16x8* qr, int r32, int hi) {
  p0 = f32x16{}; p1 = f32x16{};
#pragma unroll
  for (int d0 = 0; d0 < 8; ++d0) { const int cb = (d0 * 16 + hi * 8) * 2;
    const bf16x8 b0 = *reinterpret_cast<const bf16x8*>(Ks + KSWZ(r32, cb));
    const bf16x8 b1 = *reinterpret_cast<const bf16x8*>(Ks + KSWZ(32 + r32, cb));
    p0 = __builtin_amdgcn_mfma_f32_32x32x16_bf16(b0, qr[d0], p0, 0, 0, 0);
    p1 = __builtin_amdgcn_mfma_f32_32x32x16_bf16(b1, qr[d0], p1, 0, 0, 0); }
}
__device__ __forceinline__ int v_st(int k, int c) { const int kk = (k & ~0xC) | ((k & 4) << 1) | ((k & 8) >> 1); return ((kk >> 3) * 4 + (c >> 5)) * 512 + ((kk & 7) * 32 + (c & 31)) * 2; }
__device__ __forceinline__ int v_rd_base(int lane) { return ((lane & 3) << 3) | (((lane >> 2) & 3) << 6) | (((lane >> 4) & 1) << 5) | (((lane >> 5) & 1) << 8); }
constexpr int v_rd_off(int d0, int ks, int half) { return d0 * 512 + ks * 4096 + half * 2048; }
template <int OFF> __device__ __forceinline__ s16x4 tr_read(int vb) { s16x4 r; asm volatile("ds_read_b64_tr_b16 %0, %1 offset:%2" : "=&v"(r) : "v"(vb), "i"(OFF) : "memory"); return r; }
template <int D0> __device__ __forceinline__ void pv_one(f32x16& od, int vb, bf16x8 pa0, bf16x8 pa1, bf16x8 pa2, bf16x8 pa3) {
  const s16x4 l0 = tr_read<v_rd_off(D0, 0, 0)>(vb), h0 = tr_read<v_rd_off(D0, 0, 1)>(vb), l1 = tr_read<v_rd_off(D0, 1, 0)>(vb), h1 = tr_read<v_rd_off(D0, 1, 1)>(vb);
  const s16x4 l2 = tr_read<v_rd_off(D0, 2, 0)>(vb), h2 = tr_read<v_rd_off(D0, 2, 1)>(vb), l3 = tr_read<v_rd_off(D0, 3, 0)>(vb), h3 = tr_read<v_rd_off(D0, 3, 1)>(vb);
  asm volatile("s_waitcnt lgkmcnt(0)" ::: "memory"); SBAR();
#define PK(Lo, Hi) (bf16x8){Lo[0], Lo[1], Lo[2], Lo[3], Hi[0], Hi[1], Hi[2], Hi[3]}
  od = __builtin_amdgcn_mfma_f32_32x32x16_bf16(pa0, PK(l0, h0), od, 0, 0, 0);
  od = __builtin_amdgcn_mfma_f32_32x32x16_bf16(pa1, PK(l1, h1), od, 0, 0, 0);
  od = __builtin_amdgcn_mfma_f32_32x32x16_bf16(pa2, PK(l2, h2), od, 0, 0, 0);
  od = __builtin_amdgcn_mfma_f32_32x32x16_bf16(pa3, PK(l3, h3), od, 0, 0, 0);
#undef PK
}
__device__ __forceinline__ void pv_d0(f32x16* o, int vb, bf16x8 pa0, bf16x8 pa1, bf16x8 pa2, bf16x8 pa3) {
  pv_one<0>(o[0], vb, pa0, pa1, pa2, pa3); pv_one<1>(o[1], vb, pa0, pa1, pa2, pa3); pv_one<2>(o[2], vb, pa0, pa1, pa2, pa3); pv_one<3>(o[3], vb, pa0, pa1, pa2, pa3);
}

template <class Tiles>
__device__ __forceinline__ void attn_unit(const bf16_t* __restrict__ Qb, int ldq, const bf16_t* __restrict__ Kb, const bf16_t* __restrict__ Vb, int ldk,
                                          bf16_t* __restrict__ Ob, int ldo, const Tiles& T, int NT, bool has_sink, float sink, char* lds) {
  int tid = threadIdx.x; asm volatile("" : "+v"(tid));
  const int wid = __builtin_amdgcn_readfirstlane(tid >> 6), lane = tid & 63, r32 = lane & 31, hi = lane >> 5;
  char* V_lds = lds; char* K_lds = lds + 2 * SHM_V;
  float* ws = (float*)(lds + 2 * SHM_V + 2 * SHM_K) + wid * 64; float* li_l = ws; float* al_l = ws + 32;
  float m_reg = -1e30f, l_reg = 0; f32x16 o[4] = {}; bf16x8 qr[8];
  const bf16_t* Qw = Qb + (long)(wid * QBLK + r32) * ldq + hi * 8;
#pragma unroll
  for (int d0 = 0; d0 < 8; ++d0) qr[d0] = *reinterpret_cast<const bf16x8*>(Qw + d0 * 16);
  const int sr = tid >> 4, sc = (tid & 15) * 8, vst0 = v_st(sr, sc), vst1 = v_st(32 + sr, sc);
  const int vb0 = (int)(uintptr_t)V_lds + v_rd_base(lane);
  bf16x8 vs0, vs1, ks0, ks1;
#define SLOAD(j) do { const long _k0 = T.row(j); vs0 = *reinterpret_cast<const bf16x8*>(&Vb[(_k0 + sr) * ldk + sc]); vs1 = *reinterpret_cast<const bf16x8*>(&Vb[(_k0 + 32 + sr) * ldk + sc]); \
    ks0 = *reinterpret_cast<const bf16x8*>(&Kb[(_k0 + sr) * ldk + sc]); ks1 = *reinterpret_cast<const bf16x8*>(&Kb[(_k0 + 32 + sr) * ldk + sc]); } while (0)
#define SWRITE(b) do { *(bf16x8*)(V_lds + (b) * SHM_V + vst0) = vs0; *(bf16x8*)(V_lds + (b) * SHM_V + vst1) = vs1; const int kc = sc * 2; \
    *(bf16x8*)(K_lds + (b) * SHM_K + KSWZ(sr, kc)) = ks0; *(bf16x8*)(K_lds + (b) * SHM_K + KSWZ(32 + sr, kc)) = ks1; } while (0)
  __syncthreads();
  SLOAD(0); asm volatile("s_waitcnt vmcnt(0)" ::: "memory"); SWRITE(0);
  if (1 < NT) SLOAD(1);
#pragma unroll 1
  for (int j = 0; j < NT; ++j) {
    const int b = j & 1;
    __syncthreads();
    if (j + 1 < NT) { asm volatile("s_waitcnt vmcnt(0)" ::: "memory"); SWRITE(b ^ 1); if (j + 2 < NT) SLOAD(j + 2); }
    if (T.active(j, wid)) {
      f32x16 p0, p1; float mn, alpha; bf16x8 pa0, pa1, pa2, pa3;
      qkt(p0, p1, K_lds + b * SHM_K, qr, r32, hi); T.mask(p0, p1, j, wid, r32, hi);
      partialSM(p0, p1, m_reg, mn, alpha);
      if (__any(alpha < 1.f)) { if (hi == 0) al_l[r32] = alpha; asm volatile("s_waitcnt lgkmcnt(0)" ::: "memory");
#pragma unroll
        for (int d = 0; d < 4; ++d)
#pragma unroll
          for (int r = 0; r < 16; ++r) o[d][r] *= al_l[crow(r, hi)]; }
      finishSM(p0, p1, alpha, l_reg, pa0, pa1, pa2, pa3); SBAR();
      pv_d0(o, vb0 + b * (int)SHM_V, pa0, pa1, pa2, pa3);
    }
  }
  if (has_sink) { constexpr float C = SCALE * 1.4426950408889634f; l_reg += __builtin_amdgcn_exp2f(fmaf(sink, 1.4426950408889634f, -m_reg * C)); }
  if (hi == 0) li_l[r32] = l_reg; asm volatile("s_waitcnt lgkmcnt(0)" ::: "memory");
  float rli[16];
#pragma unroll
  for (int r = 0; r < 16; ++r) rli[r] = __builtin_amdgcn_rcpf(li_l[crow(r, hi)]);
  bf16_t* Ow = Ob + (long)(wid * QBLK) * ldo;
#pragma unroll
  for (int r = 0; r < 16; ++r) { const int orow = crow(r, hi);
#pragma unroll
    for (int d0 = 0; d0 < 4; ++d0) Ow[(long)orow * ldo + d0 * 32 + r32] = f2bf(o[d0][r] * rli[r]); }
#undef SLOAD
#undef SWRITE
}
#undef KSWZ
#undef SBAR

struct TilesGen {
  int mode, i0, lo, R, glo, nloc; const float* bias;
  __device__ __forceinline__ long row(int j) const {
    if (j < 4) return L + 64 * j;
    if (mode == 0) return lo + 64 * (j - 4);
    return (long)(glo + (j - 4)) * 64;
  }
  __device__ __forceinline__ bool active(int j, int wid) const {
    if (j < 4 || mode == 2) return true;
    if (mode == 0) { const int Tr = lo + 64 * (j - 4), q0 = i0 + 32 * wid; return Tr + 63 >= q0 - 128 && Tr <= q0 + 31 + 128; }
    const int kr = glo + (j - 4), qr = R + (wid >> 1);
    int r0 = qr - 4; r0 = r0 < 0 ? 0 : (r0 > 248 ? 248 : r0);
    return kr >= r0 && kr <= r0 + 7;
  }
  __device__ __forceinline__ void mask(f32x16& p0, f32x16& p1, int j, int wid, int r32, int hi) const {
    if (j < 4 || mode == 2) return;
    if (mode == 0) {
      const int Tr = lo + 64 * (j - 4), q0 = i0 + 32 * wid;
      if (q0 + 31 - Tr <= 128 && Tr + 63 - q0 <= 128) return;
      const int dq = q0 + r32 - Tr;
#pragma unroll
      for (int r = 0; r < 16; ++r) { const int kk = crow(r, hi); p0[r] = (kk >= dq - 128 && kk <= dq + 128) ? p0[r] : NEG; p1[r] = (kk + 32 >= dq - 128 && kk + 32 <= dq + 128) ? p1[r] : NEG; }
      return;
    }
    const int kr = glo + (j - 4), qr = R + (wid >> 1), qc = (wid & 1) * 32 + r32;
    int cs = qc - 8; cs = cs < 0 ? 0 : (cs > 48 ? 48 : cs);
    const float* bt = bias + (kr - qr + 7) * 32 + (15 - qc);
#pragma unroll
    for (int r = 0; r < 16; ++r) { const int k0 = crow(r, hi), k1 = k0 + 32;
      const bool v0 = (unsigned)(k0 - cs) < 16u, v1 = (unsigned)(k1 - cs) < 16u;
      p0[r] = v0 ? p0[r] + bt[v0 ? k0 : cs] : NEG; p1[r] = v1 ? p1[r] + bt[v1 ? k1 : cs] : NEG; }
  }
};
}

__device__ __forceinline__ void ph_attn_fast(const Ctx& c, int layer) {
  char* lds = (char*)c.smem;
  float* btab = (float*)(c.smem + fa::SHM_ATTN);
  const bf16_t* QWA = c.wsp<bf16_t>(WS_QWA); const bf16_t* KVWA = c.wsp<bf16_t>(WS_KVWA); bf16_t* YWA = c.wsp<bf16_t>(WS_YWA);
  const bf16_t* QNA = c.wsp<bf16_t>(WS_QNA); const bf16_t* KVNA = c.wsp<bf16_t>(WS_KVNA); bf16_t* YNA = c.wsp<bf16_t>(WS_YNA);
  const float* sinkp = c.in[20] + layer * 8; const float* rpb = c.in[23] + (size_t)layer * 8 * 15 * 31;
  const int nq = L / 256;
  const int nunits = 2 * 8 * nq + (layer == 0 ? 16 : 0);
#pragma unroll 1
  for (int u = c.bid; u < nunits; u += c.nb) {
    fa::TilesGen T; T.mode = 2; T.i0 = 0; T.lo = 0; T.R = 0; T.glo = 0; T.nloc = 0; T.bias = btab;
    int h, i0, NT; bool wa;
    if (u < 8 * nq) {
      wa = true; h = u / nq; i0 = (u % nq) * 256;
      const int lo = i0 - 128 < 0 ? 0 : i0 - 128, hiR = i0 + 384 > L ? L : i0 + 384;
      T.mode = 0; T.i0 = i0; T.lo = lo; NT = 4 + (hiR - lo) / 64;
    } else if (u < 16 * nq) {
      const int v = u - 8 * nq; wa = false; h = v / nq; const int qb = v % nq; i0 = qb * 256; const int R = qb * 4;
      int glo = R - 4; glo = glo < 0 ? 0 : (glo > 248 ? 248 : glo);
      int gh = R + 3 - 4; gh = gh < 0 ? 0 : (gh > 248 ? 248 : gh); gh += 7;
      T.mode = 1; T.R = R; T.glo = glo; T.nloc = gh - glo + 1; NT = 4 + T.nloc;
      __syncthreads();
      for (int e = c.tid; e < 15 * 32; e += NTHREADS) { const int dr = e >> 5, dc = e & 31; btab[e] = dc < 31 ? rpb[(h * 15 + dr) * 31 + dc] * (1.0f / fa::SCALE) : 0.f; }
    } else {
      const int v = u - 16 * nq; wa = v < 8; h = v & 7; i0 = L; NT = 4;
    }
    const bf16_t* Q = (wa ? QWA : QNA) + (size_t)i0 * 1024 + h * 128;
    const bf16_t* Kb = wa ? KVWA + (h >> 2) * 128 : KVNA + h * 128;
    const bf16_t* Vb = wa ? KVWA + 256 + (h >> 2) * 128 : KVNA + 1024 + h * 128;
    bf16_t* O = (wa ? YWA : YNA) + (size_t)i0 * 1024 + h * 128;
    fa::attn_unit(Q, 1024, Kb, Vb, wa ? 512 : 2048, O, 1024, T, NT, wa, wa ? sinkp[h] : 0.f, lds);
  }
}

__device__ __forceinline__ void ph_c(const Ctx& c, int layer) {
#ifndef NO_HY
    if (FAST_HY) {
        hyf::ThreadTw tw; hyf::tw_addr(c.tid, tw);
        { float s_, c_; sincospif(-2.0f * (float)c.tid / (float)hyf::FL, &s_, &c_); tw.w1 = (hyf::cpx){c_, s_};
          sincospif(-2.0f * (float)(c.tid & 15) / 512.0f, &s_, &c_); tw.w2 = (hyf::cpx){c_, s_};
          sincospif(-(float)c.tid / (float)hyf::FL, &s_, &c_); tw.wo = (hyf::cpx){c_, s_}; }
        for (int u = c.bid; u < 1024; u += c.nb) hyena_fft_unit(c, layer, u, tw);
        if constexpr (DOREP(16)) { for (int u = c.bid; u < 1024; u += c.nb) hyena_fft_unit(c, layer, u, tw); }
    } else
    for (int u = c.bid; u < 1024; u += c.nb) hyena_direct_unit(c, layer, u);
#endif
#ifndef NO_HYC
    if (layer == 0) for (int u = c.bid; u < 1024; u += c.nb) hyena_ctx_unit(c, layer, u);
#endif
    __syncthreads();
#ifndef NO_ATT
    if (FAST_ATT) { ph_attn_fast(c, layer); return; }
    const int gw = c.bid * 8 + c.wave, ngw = c.nb * 8;
    float* wl = (float*)c.smem + c.wave * 768;
    const int nrows = layer == 0 ? MR : L;
    const float* sinkp = c.in[20] + layer * 8;
    const float* rpb = c.in[23] + (size_t)layer * 8 * 15 * 31;
    const bf16_t* kvwa = c.wsp<bf16_t>(WS_KVWA); const bf16_t* kvna = c.wsp<bf16_t>(WS_KVNA);
    for (int task = gw; task < nrows * 16; task += ngw) {
        const int r = task >> 4, hh = task & 15;
        if (hh < 8) {
            const int h = hh; const bf16_t* q = c.wsp<bf16_t>(WS_QWA) + (size_t)r * 1024 + h * 128; bf16_t* o = c.wsp<bf16_t>(WS_YWA) + (size_t)r * 1024 + h * 128;
            if (r < L) { const KeyWA k{kvwa, r, h >> 2}; wave_attn(q, 513, k, true, sinkp[h], o, wl, c.lane); }
            else { const KeyCtxWA k{kvwa, h >> 2}; wave_attn(q, 256, k, true, sinkp[h], o, wl, c.lane); }
        } else {
            const int h = hh - 8; const bf16_t* q = c.wsp<bf16_t>(WS_QNA) + (size_t)r * 1024 + h * 128; bf16_t* o = c.wsp<bf16_t>(WS_YNA) + (size_t)r * 1024 + h * 128;
            if (r < L) { const int gr = r / GRIDW, qc = r % GRIDW; int r0 = gr - 4; r0 = r0 < 0 ? 0 : (r0 > 248 ? 248 : r0); int cs = qc - 8; cs = cs < 0 ? 0 : (cs > 48 ? 48 : cs);
                const KeyNA k{kvna, rpb, gr, qc, r0, cs, h}; wave_attn(q, 384, k, false, 0.f, o, wl, c.lane); }
            else { const KeyCtxNA k{kvna, h}; wave_attn(q, 256, k, false, 0.f, o, wl, c.lane); }
        }
    }
#endif
}

__device__ __forceinline__ void ph_c2(const Ctx& c) {
    bf16_t* tile = (bf16_t*)c.smem;
    const bf16_t* src = c.wsp<bf16_t>(WS_YHYT); bf16_t* dst = c.wsp<bf16_t>(WS_YHY);
    const int tid = c.tid, a = tid >> 3, b8 = (tid & 7) * 8;
    for (int u = c.bid; u < (1024 / 64) * (L / 64); u += c.nb) {
        const int c0 = (u % 16) * 64, t0 = (u / 16) * 64;
        const uint4 v = *(const uint4*)(src + (size_t)(c0 + a) * L + t0 + b8);
        __syncthreads();
        *(uint4*)(tile + a * 72 + b8) = v;
        __syncthreads();
        unsigned short e[8];
#pragma unroll
        for (int i = 0; i < 8; ++i) e[i] = tile[(b8 + i) * 72 + a];
        uint4 o; o.x = e[0] | ((unsigned)e[1] << 16); o.y = e[2] | ((unsigned)e[3] << 16); o.z = e[4] | ((unsigned)e[5] << 16); o.w = e[6] | ((unsigned)e[7] << 16);
        *(uint4*)(dst + (size_t)(t0 + a) * 1024 + c0 + b8) = o;
    }
}

struct EpiMerge { unsigned char* ws; int b;
    __device__ __forceinline__ void operator()(int row, int col, const float (&v)[8]) const {
        const bf16_t* g = (const bf16_t*)(ws + WS_GATE) + (size_t)row * 6144 + b * 2048 + col;
        float* mp = (float*)(ws + WS_MPART) + (size_t)row * D + col;
        const uint4 gg = *(const uint4*)g;
        const float gv[8] = {__uint_as_float(gg.x << 16), __uint_as_float(gg.x & 0xffff0000u), __uint_as_float(gg.y << 16), __uint_as_float(gg.y & 0xffff0000u),
                             __uint_as_float(gg.z << 16), __uint_as_float(gg.z & 0xffff0000u), __uint_as_float(gg.w << 16), __uint_as_float(gg.w & 0xffff0000u)};
        float t[8];
        if (b == 0) {
#pragma unroll
            for (int j = 0; j < 8; ++j) t[j] = gv[j] * v[j];
        } else {
            const float4 p0 = *(const float4*)mp, p1 = *(const float4*)(mp + 4);
            const float pv[8] = {p0.x, p0.y, p0.z, p0.w, p1.x, p1.y, p1.z, p1.w};
#pragma unroll
            for (int j = 0; j < 8; ++j) t[j] = fmaf(gv[j], v[j], pv[j]);
        }
        if (b < 2) { *(float4*)mp = make_float4(t[0], t[1], t[2], t[3]); *(float4*)(mp + 4) = make_float4(t[4], t[5], t[6], t[7]); }
        else { uint4 o; o.x = pk2(t[0], t[1]); o.y = pk2(t[2], t[3]); o.z = pk2(t[4], t[5]); o.w = pk2(t[6], t[7]); *(uint4*)((bf16_t*)(ws + WS_MB) + (size_t)row * D + col) = o; }
    }
};
__device__ __forceinline__ void ph_d(const Ctx& c, int layer) {
    const int nM = MR / 128, nN = D / 128;
    for (int b = 0; b < 3; ++b) {
        const bf16_t* A = b == 0 ? c.wsp<bf16_t>(WS_YHY) : (b == 1 ? c.wsp<bf16_t>(WS_YWA) : c.wsp<bf16_t>(WS_YNA));
        const RowLin rp{A, 1024}; const EpiMerge ep{c.ws, b};
        const float* W = c.in[24] + ((size_t)layer * 3 + b) * 1024 * D;
        for (int u = c.bid; u < nM * nN; u += c.nb) sgemm_unit(rp, W, D, 1024, (u % nM) * 128, (u / nM) * 128, ep, (float*)c.smem, c.tid);
    }
}
struct EpiOut { const Ctx* c; int layer;
    __device__ __forceinline__ void operator()(int row, int col, const float (&v)[8]) const {
        const float* xin = c->xrow(layer, row) + col; const float* g = c->mod(layer, row < L ? 0 : 1, 2) + col;
        float* o = (float*)(c->ws + WS_XA) + (size_t)row * D + col;
        const float4 x0 = *(const float4*)xin, x1 = *(const float4*)(xin + 4), g0 = *(const float4*)g, g1 = *(const float4*)(g + 4);
        *(float4*)o = make_float4(x0.x + g0.x * v[0], x0.y + g0.y * v[1], x0.z + g0.z * v[2], x0.w + g0.w * v[3]);
        *(float4*)(o + 4) = make_float4(x1.x + g1.x * v[4], x1.y + g1.y * v[5], x1.z + g1.z * v[6], x1.w + g1.w * v[7]);
    }
};
__device__ __forceinline__ void ph_e(const Ctx& c, int layer) {
    const int nM = MR / 128, nN = D / 128;
    const RowLin rp{c.wsp<bf16_t>(WS_MB), D}; const EpiOut ep{&c, layer};
    const float* W = c.in[25] + (size_t)layer * D * D;
    for (int u = c.bid; u < nM * nN; u += c.nb) sgemm_unit(rp, W, D, D, (u % nM) * 128, (u / nM) * 128, ep, (float*)c.smem, c.tid);
}

__device__ __forceinline__ void ph_f(const Ctx& c, int layer) {
    const int gw = c.bid * 8 + c.wave, ngw = c.nb * 8;
    const float* g = c.in[26] + (size_t)layer * D;
    const float* wr = c.in[27] + (size_t)layer * D * NE;
    float* wl = (float*)c.smem; float* gl = wl + NE * D;
    __syncthreads();
    for (int i = c.tid; i < D * NE / 4; i += NTHREADS) { const float4 v = *(const float4*)(wr + 4 * i); const int col = i >> 2, e0 = (i & 3) * 4;
        wl[(e0 + 0) * D + col] = v.x; wl[(e0 + 1) * D + col] = v.y; wl[(e0 + 2) * D + col] = v.z; wl[(e0 + 3) * D + col] = v.w; }
    for (int i = c.tid; i < D; i += NTHREADS) { gl[i] = g[i]; gl[D + i] = c.mod(layer, 0, 3)[i]; gl[2 * D + i] = c.mod(layer, 0, 4)[i]; }
    __syncthreads();
    const int nrows = layer == 0 ? MR : L;
    for (int r = gw; r < nrows; r += ngw) {
        const float* x = c.wsp<float>(WS_XA) + (size_t)r * D;
        const bool lat = r < L;
        const float* shg = c.mod(layer, 1, 3); const float* scg = c.mod(layer, 1, 4);
        float4 v[8]; float ss = 0.f;
#pragma unroll
        for (int j = 0; j < 8; ++j) { v[j] = *(const float4*)(x + 4 * c.lane + 256 * j); ss += v[j].x * v[j].x + v[j].y * v[j].y + v[j].z * v[j].z + v[j].w * v[j].w; }
        ss = wave_sum(ss);
        const float inv = rsqrtf(ss * (1.0f / D) + RMS_EPS);
        bf16_t* o = c.wsp<bf16_t>(WS_H2) + (size_t)r * D;
        float lg[NE];
#pragma unroll
        for (int e = 0; e < NE; ++e) lg[e] = 0.f;
#pragma unroll
        for (int j = 0; j < 8; ++j) {
            const int col = 4 * c.lane + 256 * j;
            const float4 gg = *(const float4*)(gl + col);
            const float4 s4 = lat ? *(const float4*)(gl + D + col) : *(const float4*)(shg + col);
            const float4 c4 = lat ? *(const float4*)(gl + 2 * D + col) : *(const float4*)(scg + col);
            const float y0 = v[j].x * inv * gg.x * (1.f + c4.x) + s4.x, y1 = v[j].y * inv * gg.y * (1.f + c4.y) + s4.y;
            const float y2 = v[j].z * inv * gg.z * (1.f + c4.z) + s4.z, y3 = v[j].w * inv * gg.w * (1.f + c4.w) + s4.w;
            uint2 w; w.x = pk2(y0, y1); w.y = pk2(y2, y3);
            *(uint2*)(o + col) = w;
#pragma unroll
            for (int e = 0; e < NE; ++e) { const float4 w4 = *(const float4*)(wl + e * D + col); lg[e] = fmaf(y0, w4.x, fmaf(y1, w4.y, fmaf(y2, w4.z, fmaf(y3, w4.w, lg[e])))); }
            __builtin_amdgcn_sched_barrier(0);
        }
        float mx = -3e38f;
#pragma unroll
        for (int e = 0; e < NE; ++e) { lg[e] = wave_sum(lg[e]); mx = fmaxf(mx, lg[e]); }
        float sum = 0.f;
#pragma unroll
        for (int e = 0; e < NE; ++e) { lg[e] = expf(lg[e] - mx); sum += lg[e]; }
        float mine = 0.f;
#pragma unroll
        for (int e = 0; e < NE; ++e) mine = (c.lane == e) ? lg[e] / sum : mine;
        if (c.lane < NE) c.wsp<float>(WS_AFF)[(size_t)r * NE + c.lane] = mine;
    }
}

__device__ __forceinline__ void topk_unit(const Ctx& c, int e, int row0, int n, int K, int slot0) {
    unsigned* sh = (unsigned*)c.smem;
    const int tid = c.tid, lane = c.lane, wave = c.wave;
    const float* aff = c.wsp<float>(WS_AFF);
    unsigned key[32];
#pragma unroll
    for (int j = 0; j < 32; ++j) { const int t = tid + NTHREADS * j; key[j] = t < n ? __float_as_uint(aff[(size_t)(row0 + t) * NE + e]) : 0u; }
    unsigned T = 0u;
#pragma unroll 1
    for (int bit = 30; bit >= 0; bit -= 2) {
        const unsigned t1 = T | (1u << bit), t2 = T | (2u << bit), t3 = T | (3u << bit);
        unsigned c1 = 0u, c2 = 0u, c3 = 0u;
#pragma unroll
        for (int j = 0; j < 32; ++j) { c1 += key[j] >= t1 ? 1u : 0u; c2 += key[j] >= t2 ? 1u : 0u; c3 += key[j] >= t3 ? 1u : 0u; }
#pragma unroll
        for (int o = 1; o < 64; o <<= 1) { c1 += __shfl_xor(c1, o); c2 += __shfl_xor(c2, o); c3 += __shfl_xor(c3, o); }
        __syncthreads();
        if (lane == 0) { sh[wave] = c1; sh[8 + wave] = c2; sh[16 + wave] = c3; }
        __syncthreads();
        unsigned s1 = 0u, s2 = 0u, s3 = 0u;
#pragma unroll
        for (int w = 0; w < 8; ++w) { s1 += sh[w]; s2 += sh[8 + w]; s3 += sh[16 + w]; }
        T = s3 >= (unsigned)K ? t3 : (s2 >= (unsigned)K ? t2 : (s1 >= (unsigned)K ? t1 : T));
    }
    unsigned ng = 0u, neq = 0u;
#pragma unroll
    for (int j = 0; j < 32; ++j) { ng += key[j] > T ? 1u : 0u; neq += (key[j] == T && tid + NTHREADS * j < n) ? 1u : 0u; }
    unsigned ig = ng, ie = neq;
#pragma unroll
    for (int o = 1; o < 64; o <<= 1) { const unsigned a = __shfl_up(ig, o), b = __shfl_up(ie, o); if (lane >= o) { ig += a; ie += b; } }
    __syncthreads();
    if (lane == 63) { sh[32 + wave] = ig; sh[40 + wave] = ie; }
    __syncthreads();
    unsigned og = 0u, oe = 0u, totg = 0u, tote = 0u;
#pragma unroll
    for (int w = 0; w < 8; ++w) { const unsigned a = sh[32 + w], b = sh[40 + w]; if (w < wave) { og += a; oe += b; } totg += a; tote += b; }
    const unsigned need = (unsigned)K - totg;
    unsigned pg = og + ig - ng;
    int* IDX = c.wsp<int>(WS_IDX) + (size_t)e * SLOTS; float* GS = c.wsp<float>(WS_GSEL) + (size_t)e * SLOTS; int* SL = c.wsp<int>(WS_SLOT) + (size_t)e * MR;
    if (tote == need) {
        unsigned pe = totg + oe + ie - neq;
#pragma unroll
        for (int j = 0; j < 32; ++j) { const int t = tid + NTHREADS * j;
            if (t < n) { int slot = -1; if (key[j] > T) slot = (int)pg++; else if (key[j] == T) slot = (int)pe++;
                SL[row0 + t] = slot >= 0 ? slot0 + slot : -1; if (slot >= 0) { IDX[slot0 + slot] = row0 + t; GS[slot0 + slot] = __uint_as_float(key[j]); } } }
    } else {
        unsigned base_eq = 0u;
#pragma unroll 1
        for (int j = 0; j < 32; ++j) { const int t = tid + NTHREADS * j;
            const unsigned kj = t < n ? __float_as_uint(aff[(size_t)(row0 + t) * NE + e]) : 0u;
            const bool eq = t < n && kj == T;
            const unsigned long long me = __ballot(eq);
            const unsigned long long lower = (lane == 0) ? 0ull : (~0ull >> (64 - lane));
            const unsigned re = (unsigned)__popcll(me & lower);
            __syncthreads();
            if (lane == 0) sh[48 + wave] = (unsigned)__popcll(me);
            __syncthreads();
            unsigned oq = 0u, tq = 0u;
#pragma unroll
            for (int w = 0; w < 8; ++w) { const unsigned a = sh[48 + w]; if (w < wave) oq += a; tq += a; }
            if (t < n) { int slot = -1; if (kj > T) slot = (int)pg++; else if (eq) { const unsigned rk = base_eq + oq + re; if (rk < need) slot = (int)(totg + rk); }
                SL[row0 + t] = slot >= 0 ? slot0 + slot : -1; if (slot >= 0) { IDX[slot0 + slot] = row0 + t; GS[slot0 + slot] = __uint_as_float(kj); } }
            base_eq += tq;
        }
    }
    __syncthreads();
}
__device__ __forceinline__ void ph_g(const Ctx& c) {
    for (int u = c.bid; u < 32; u += c.nb) {
        if (u < 16) topk_unit(c, u, 0, L, CAP, 0);
        else { const int e = u - 16; topk_unit(c, e, L, LC, CAPC, CAP);
            for (int s = CAP + CAPC + c.tid; s < SLOTS; s += NTHREADS) { c.wsp<int>(WS_IDX)[(size_t)e * SLOTS + s] = 0; c.wsp<float>(WS_GSEL)[(size_t)e * SLOTS + s] = 0.f; } }
    }
}

struct EpiGate { float* tmp; __device__ __forceinline__ void operator()(int row, int col, const float (&v)[8]) const {
    float* p = tmp + (size_t)row * DF + col; *(float4*)p = make_float4(v[0], v[1], v[2], v[3]); *(float4*)(p + 4) = make_float4(v[4], v[5], v[6], v[7]); } };
struct EpiUp { const float* tmp; bf16_t* act; __device__ __forceinline__ void operator()(int row, int col, const float (&v)[8]) const {
    const float* p = tmp + (size_t)row * DF + col; const float4 a0 = *(const float4*)p, a1 = *(const float4*)(p + 4);
    const float a[8] = {a0.x, a0.y, a0.z, a0.w, a1.x, a1.y, a1.z, a1.w}; float t[8];
#pragma unroll
    for (int j = 0; j < 8; ++j) t[j] = silu_f(a[j]) * v[j];
    uint4 o; o.x = pk2(t[0], t[1]); o.y = pk2(t[2], t[3]); o.z = pk2(t[4], t[5]); o.w = pk2(t[6], t[7]);
    *(uint4*)(act + (size_t)row * DF + col) = o; } };
struct EpiDown { bf16_t* ye; __device__ __forceinline__ void operator()(int row, int col, const float (&v)[8]) const {
    uint4 o; o.x = pk2(v[0], v[1]); o.y = pk2(v[2], v[3]); o.z = pk2(v[4], v[5]); o.w = pk2(v[6], v[7]);
    *(uint4*)(ye + (size_t)row * D + col) = o; } };
__device__ __forceinline__ void ph_h(const Ctx& c, int layer) {
    const int nM = SLOTS / 128, nN = DF / 128;
    for (int which = 0; which < 2; ++which)
        for (int u = c.bid; u < NE * nM * nN; u += c.nb) {
            const int e = u / (nM * nN), r = u % (nM * nN), pm = r % nM, pn = r / nM;
            const RowGather rp{c.wsp<bf16_t>(WS_H2), D, c.wsp<int>(WS_IDX) + (size_t)e * SLOTS};
            float* tmp = c.wsp<float>(WS_TMP) + (size_t)e * SLOTS * DF;
            const float* W = c.in[which == 0 ? 28 : 29] + ((size_t)layer * NE + e) * D * DF;
            if (which == 0) { const EpiGate ep{tmp}; sgemm_unit(rp, W, DF, D, pm * 128, pn * 128, ep, (float*)c.smem, c.tid); }
            else { const EpiUp ep{tmp, c.wsp<bf16_t>(WS_ACT) + (size_t)e * SLOTS * DF}; sgemm_unit(rp, W, DF, D, pm * 128, pn * 128, ep, (float*)c.smem, c.tid); }
        }
}
__device__ __forceinline__ void ph_i(const Ctx& c, int layer) {
    const int nM = SLOTS / 128, nN = D / 128;
    for (int u = c.bid; u < NE * nM * nN; u += c.nb) {
        const int e = u / (nM * nN), r = u % (nM * nN), pm = r % nM, pn = r / nM;
        const RowLin rp{c.wsp<bf16_t>(WS_ACT) + (size_t)e * SLOTS * DF, DF};
        const EpiDown ep{c.wsp<bf16_t>(WS_YE) + (size_t)e * SLOTS * D};
        const float* W = c.in[30] + ((size_t)layer * NE + e) * DF * D;
        sgemm_unit(rp, W, D, DF, pm * 128, pn * 128, ep, (float*)c.smem, c.tid);
    }
}

__device__ __forceinline__ void ph_j(const Ctx& c, int layer) {
    const int gw = c.bid * 8 + c.wave, ngw = c.nb * 8;
    const int nrows = layer == 0 ? MR : L;
    for (int r = gw; r < nrows; r += ngw) {
        const float* x1 = c.wsp<float>(WS_XA) + (size_t)r * D;
        const float* g5 = c.mod(layer, r < L ? 0 : 1, 5);
        float* o = layer == 0 ? c.wsp<float>(WS_XB) + (size_t)r * D : c.out + (size_t)r * D;
        float acc[32];
#pragma unroll
        for (int j = 0; j < 32; ++j) acc[j] = 0.f;
        for (int e = 0; e < NE; ++e) {
            const int s = c.wsp<int>(WS_SLOT)[(size_t)e * MR + r];
            if (s >= 0) {
                const float gs = c.wsp<float>(WS_GSEL)[(size_t)e * SLOTS + s];
                const bf16_t* y = c.wsp<bf16_t>(WS_YE) + ((size_t)e * SLOTS + s) * D;
#pragma unroll
                for (int j = 0; j < 8; ++j) { const uint2 w = *(const uint2*)(y + 4 * c.lane + 256 * j);
                    acc[4 * j + 0] = fmaf(gs, __uint_as_float(w.x << 16), acc[4 * j + 0]); acc[4 * j + 1] = fmaf(gs, __uint_as_float(w.x & 0xffff0000u), acc[4 * j + 1]);
                    acc[4 * j + 2] = fmaf(gs, __uint_as_float(w.y << 16), acc[4 * j + 2]); acc[4 * j + 3] = fmaf(gs, __uint_as_float(w.y & 0xffff0000u), acc[4 * j + 3]); }
            }
        }
#pragma unroll
        for (int j = 0; j < 8; ++j) { const int col = 4 * c.lane + 256 * j; const float4 xv = *(const float4*)(x1 + col), gv = *(const float4*)(g5 + col);
            *(float4*)(o + col) = make_float4(xv.x + gv.x * acc[4 * j], xv.y + gv.y * acc[4 * j + 1], xv.z + gv.z * acc[4 * j + 2], xv.w + gv.w * acc[4 * j + 3]); }
    }
}


#ifndef FAST_B
#define FAST_B 1
#endif
#ifndef FAST_DE
#define FAST_DE 1
#endif
#ifndef FAST_HI
#define FAST_HI 1
#endif
struct GeomInProj {
    static constexpr bool GATHER = false;
    const char* WIN; const char* HX; int K, lda, ldb; const int* idx;
    __device__ __forceinline__ const char* a_base(const pg8::Unit& u) const { return u.pm >= 1000 ? WIN + (size_t)(u.pm - 1000) * 256 * D * 2 : HX + (size_t)u.pm * 256 * D * 2; }
    __device__ __forceinline__ const char* b_base(const pg8::Unit& u) const { return u.pm >= 1000 ? HX + (size_t)u.pn * 256 * D * 2 : WIN + ((size_t)OFF_WAQ + (size_t)u.pn * 256) * D * 2; }
    __device__ __forceinline__ int row0(const pg8::Unit& u) const { return (u.pm >= 1000 ? u.pm - 1000 : u.pm) * 256; }
};
struct SchedInProj {
    pg8::StaticOrder s0, s1; int G, c;
    __device__ __forceinline__ bool next(int i, pg8::Unit& u) const {
        const long Lq = (long)i * G + c;
        if (Lq < s0.nwg) { s0.at(Lq, u); u.pm += 1000; return true; }
        return s1.at(Lq - s0.nwg, u);
    }
};
struct EpiInProj {
    static constexpr bool PERM = true;
    pg8::EpiBf16Plain e0; pg8::EpiInRest e1;
    __device__ __forceinline__ void operator()(const pg8::f32x4 (&acc)[2][2][4][2], const pg8::Unit& u, int row0, int wr, int wc, int fr, int fq) const {
        if (u.pm >= 1000) { pg8::Unit v = u; v.pm -= 1000; e0(acc, v, row0, wr, wc, fr, fq); } else e1(acc, u, row0, wr, wc, fr, fq);
    }
};
__device__ __forceinline__ void ph_b_fast(const Ctx& c, int layer) {
    LAS unsigned char* lds = (LAS unsigned char*)c.smem;
    const char* WIN = (const char*)(c.ws + WS_WIN); const char* HX = (const char*)(c.ws + WS_HX);
    __syncthreads();
    const GeomInProj G{WIN, HX, D, D, D, nullptr};
    SchedInProj S; S.s0.init(3072 / 256, MR / 256, c.nb, c.bid); S.s1.init(MR / 256, (NIN - OFF_WAQ) / 256, c.nb, c.bid); S.G = c.nb; S.c = c.bid;
    const EpiInProj E{pg8::EpiBf16Plain{c.wsp<bf16_t>(WS_ZHYT), MR, 0}, pg8::EpiInRest{c.ws}};
    pg8::gemm_phase(lds, G, S, E);
}
__device__ __forceinline__ void ph_d_fast(const Ctx& c, int layer) {
    LAS unsigned char* lds = (LAS unsigned char*)c.smem;
    const int nM = layer == 0 ? MR / 256 : L / 256;
    pg8::StaticOrder S; S.init(nM, D / 256, c.nb, c.bid);
    __syncthreads();
    { const pg8::GeomLin G{(const char*)(c.ws + WS_YHY), (const char*)(c.ws + WS_WBR), 1024, 1024, 1024, nullptr}; const pg8::EpiMergeF<0> E{c.ws}; pg8::gemm_phase(lds, G, S, E); }
    { const pg8::GeomLin G{(const char*)(c.ws + WS_YWA), (const char*)(c.ws + WS_WBR) + (size_t)D * 1024 * 2, 1024, 1024, 1024, nullptr}; const pg8::EpiMergeF<1> E{c.ws}; pg8::gemm_phase(lds, G, S, E); }
    { const pg8::GeomLin G{(const char*)(c.ws + WS_YNA), (const char*)(c.ws + WS_WBR) + (size_t)2 * D * 1024 * 2, 1024, 1024, 1024, nullptr}; const pg8::EpiMergeF<2> E{c.ws}; pg8::gemm_phase(lds, G, S, E); }
}
__device__ __forceinline__ void ph_e_fast(const Ctx& c, int layer) {
    LAS unsigned char* lds = (LAS unsigned char*)c.smem;
    const int nM = layer == 0 ? MR / 256 : L / 256;
    pg8::StaticOrder S; S.init(nM, D / 256, c.nb, c.bid);
    __syncthreads();
    const pg8::GeomLin G{(const char*)(c.ws + WS_MB), (const char*)(c.ws + WS_WOUT), D, D, D, nullptr}; const pg8::EpiOutF E{&c, layer};
    pg8::gemm_phase(lds, G, S, E);
}
__device__ __forceinline__ void ph_h_fast(const Ctx& c, int layer) {
    LAS unsigned char* lds = (LAS unsigned char*)c.smem;
    const int tpe = layer == 0 ? 9 : 8;
    pg8::StaticOrder S; S.init(NE * tpe, 2048 / 256, c.nb, c.bid);
    __syncthreads();
    const pg8::GeomExpert<true> G{(const char*)(c.ws + WS_H2), (const char*)(c.ws + WS_WGU), D, D, D, c.wsp<int>(WS_IDX), tpe, 2048};
    const pg8::EpiGU E{c.wsp<bf16_t>(WS_ACT)};
    pg8::gemm_phase(lds, G, S, E);
}
__device__ __forceinline__ void ph_i_fast(const Ctx& c, int layer) {
    LAS unsigned char* lds = (LAS unsigned char*)c.smem;
    const int tpe = layer == 0 ? 9 : 8;
    pg8::StaticOrder S; S.init(NE * tpe, D / 256, c.nb, c.bid);
    __syncthreads();
    const pg8::GeomExpert<false> G{(const char*)(c.ws + WS_ACT), (const char*)(c.ws + WS_WDN), DF, DF, DF, nullptr, tpe, D};
    const pg8::EpiBf16Plain E{c.wsp<bf16_t>(WS_YE), D, 0};
    pg8::gemm_phase(lds, G, S, E);
}

__global__ void __launch_bounds__(NTHREADS, 2) mega(KArgs a) {
    extern __shared__ __attribute__((aligned(16))) unsigned char smem[];
    Ctx c; c.in = a.in; c.out = a.out; c.ws = a.ws; c.bid = blockIdx.x; c.nb = gridDim.x; c.tid = threadIdx.x; c.lane = c.tid & 63;
    c.wave = __builtin_amdgcn_readfirstlane(c.tid >> 6); c.smem = smem;
    volatile LAS unsigned* st = (volatile LAS unsigned*)(LAS unsigned char*)(smem + LDS_BYTES - 16);
    if (c.tid == 0) { st[0] = 0u; st[1] = 0u; st[2] = 0u; st[3] = 0u; }
    __syncthreads();
    const int lo = a.ph_lo, hi = a.ph_hi;
    XcdBarrier bar; bar.bar = (unsigned*)(a.ws + WS_CTL); bar.x = 0; bar.st = st;
    if (hi - lo > 1) bar = xcd_barrier_post((unsigned*)(a.ws + WS_CTL), st);
#ifndef ONLY_PH
#define ONLY_PH -1
#endif
#define PSEL(j) (ONLY_PH < 0 || ONLY_PH == (j))

#define IN(k) (lo <= (k) && (k) < hi)
#define GASP __attribute__((address_space(1)))
#define LAUNDER(cc) Ctx cc = c; asm volatile("" : "+v"(cc.tid), "+v"(cc.lane)); asm volatile("" : "+s"(cc.bid), "+s"(cc.nb), "+s"(cc.wave)); \
    { GASP unsigned char* wg_ = (GASP unsigned char*)cc.ws; GASP float* og_ = (GASP float*)cc.out; asm volatile("" : "+s"(wg_), "+s"(og_)); cc.ws = (unsigned char*)wg_; cc.out = (float*)og_; }
#define SEAM(k) do { if (IN(k) && IN((k) + 1)) xcd_barrier(bar); } while (0)
    if (PSEL(0) && IN(0)) { LAUNDER(cc); ph_g0(cc); if (hi - lo > 1) xcd_barrier(bar); LAUNDER(cd); ph_g0b(cd); } SEAM(0);
#define LAYER_PROGRAM(layer) do { const int b = 1 + (layer) * PH_PER_LAYER; \
        if (PSEL(1) && IN(b + 0)) { LAUNDER(cc); constexpr int ly = (layer); { ph_a(cc, ly); if constexpr (DOREP(15)) { LAUNDER(ce); ph_a(ce, ly); } ph_taps(cc, ly); if constexpr (DOREP(14)) { LAUNDER(ce); ph_taps(ce, ly); } if (FAST_B || FAST_DE || FAST_HI) ph_conv(cc, ly); if constexpr (DOREP(13)) { LAUNDER(ce); ph_conv(ce, ly); } __syncthreads(); } if constexpr (DOREP(1)) { LAUNDER(cd); { Ctx& cc = cd; (void)cc; ph_a(cd, ly); ph_taps(cd, ly); if (FAST_B || FAST_DE || FAST_HI) ph_conv(cd, ly); __syncthreads(); } } } SEAM(b + 0); \
        if (PSEL(2) && IN(b + 1)) { LAUNDER(cc); constexpr int ly = (layer); { if (FAST_B) ph_b_fast(cc, ly); else ph_b(cc, ly); __syncthreads(); } if constexpr (DOREP(2)) { LAUNDER(cd); { Ctx& cc = cd; (void)cc; if (FAST_B) ph_b_fast(cd, ly); else ph_b(cd, ly); __syncthreads(); } } } SEAM(b + 1); \
        if (PSEL(3) && IN(b + 2)) { LAUNDER(cc); constexpr int ly = (layer); ph_b2(cc, ly); } SEAM(b + 2); \
        if (PSEL(4) && IN(b + 3)) { LAUNDER(cc); constexpr int ly = (layer); { ph_c(cc, ly); __syncthreads(); } if constexpr (DOREP(4)) { LAUNDER(cd); { Ctx& cc = cd; (void)cc; ph_c(cd, ly); __syncthreads(); } } } SEAM(b + 3); \
        if (PSEL(5) && IN(b + 4)) { LAUNDER(cc); constexpr int ly = (layer); { ph_c2(cc); __syncthreads(); } if constexpr (DOREP(5)) { LAUNDER(cd); { Ctx& cc = cd; (void)cc; ph_c2(cd); __syncthreads(); } } } SEAM(b + 4); \
        if (PSEL(6) && IN(b + 5)) { LAUNDER(cc); constexpr int ly = (layer); { if (FAST_DE) ph_d_fast(cc, ly); else ph_d(cc, ly); __syncthreads(); } if constexpr (DOREP(6)) { LAUNDER(cd); { Ctx& cc = cd; (void)cc; if (FAST_DE) ph_d_fast(cd, ly); else ph_d(cd, ly); __syncthreads(); } } } SEAM(b + 5); \
        if (PSEL(7) && IN(b + 6)) { LAUNDER(cc); constexpr int ly = (layer); { if (FAST_DE) ph_e_fast(cc, ly); else ph_e(cc, ly); __syncthreads(); } if constexpr (DOREP(7)) { LAUNDER(cd); { Ctx& cc = cd; (void)cc; if (FAST_DE) ph_e_fast(cd, ly); else ph_e(cd, ly); __syncthreads(); } } } SEAM(b + 6); \
        if (PSEL(8) && IN(b + 7)) { LAUNDER(cc); constexpr int ly = (layer); { ph_f(cc, ly); __syncthreads(); } if constexpr (DOREP(8)) { LAUNDER(cd); { Ctx& cc = cd; (void)cc; ph_f(cd, ly); __syncthreads(); } } } SEAM(b + 7); \
        if (PSEL(9) && IN(b + 8)) { LAUNDER(cc); constexpr int ly = (layer); { ph_g(cc); __syncthreads(); } if constexpr (DOREP(9)) { LAUNDER(cd); { Ctx& cc = cd; (void)cc; ph_g(cd); __syncthreads(); } } } SEAM(b + 8); \
        if (PSEL(10) && IN(b + 9)) { LAUNDER(cc); constexpr int ly = (layer); { if (FAST_HI) ph_h_fast(cc, ly); else ph_h(cc, ly); __syncthreads(); } if constexpr (DOREP(10)) { LAUNDER(cd); { Ctx& cc = cd; (void)cc; if (FAST_HI) ph_h_fast(cd, ly); else ph_h(cd, ly); __syncthreads(); } } } SEAM(b + 9); \
        if (PSEL(11) && IN(b + 10)) { LAUNDER(cc); constexpr int ly = (layer); { if (FAST_HI) ph_i_fast(cc, ly); else ph_i(cc, ly); __syncthreads(); } if constexpr (DOREP(11)) { LAUNDER(cd); { Ctx& cc = cd; (void)cc; if (FAST_HI) ph_i_fast(cd, ly); else ph_i(cd, ly); __syncthreads(); } } } SEAM(b + 10); \
        if (PSEL(12) && IN(b + 11)) { LAUNDER(cc); constexpr int ly = (layer); { ph_j(cc, ly); __syncthreads(); } if constexpr (DOREP(12)) { LAUNDER(cd); { Ctx& cc = cd; (void)cc; ph_j(cd, ly); __syncthreads(); } } } SEAM(b + 11); \
    } while (0)
    LAYER_PROGRAM(0);
    LAYER_PROGRAM(1);
#undef LAYER_PROGRAM
#undef IN
#undef SEAM
}

extern "C" void kernel_launch(void* const* d_in, const int* in_sizes, int n_in, void* d_out, int out_size, void* d_ws, size_t ws_size, hipStream_t stream) {
    static int grid = 0;
    if (grid == 0) {
        if (n_in != 31 || out_size != L * D || ws_size < WS_END) { fprintf(stderr, "kernel_launch: unexpected shapes: n_in %d out %d ws %zu (need %zu)\n", n_in, out_size, ws_size, (size_t)WS_END); grid = -1; return; }
        int dev = 0, cus = 0, per_cu = 0;
        if (hipGetDevice(&dev) != hipSuccess || hipDeviceGetAttribute(&cus, hipDeviceAttributeMultiprocessorCount, dev) != hipSuccess) { grid = -1; return; }
        if (hipFuncSetAttribute((const void*)mega, hipFuncAttributeMaxDynamicSharedMemorySize, LDS_BYTES) != hipSuccess) { fprintf(stderr, "kernel_launch: hipFuncSetAttribute failed\n"); grid = -1; return; }
        if (hipOccupancyMaxActiveBlocksPerMultiprocessor(&per_cu, (const void*)mega, NTHREADS, LDS_BYTES) != hipSuccess || per_cu < 1) fprintf(stderr, "kernel_launch: occupancy query says %d\n", per_cu);
        (void)hipGetLastError();
        grid = cus;
    }
    if (grid < 0) return;
    if (hipMemsetAsync((char*)d_ws + WS_CTL, 0, CTL_BYTES, stream) != hipSuccess) return;
    KArgs a{};
    for (int i = 0; i < 31; ++i) a.in[i] = (const float*)d_in[i];
    a.out = (float*)d_out; a.ws = (unsigned char*)d_ws;
#if ONE_LAUNCH
    a.ph_lo = 0; a.ph_hi = NPH;
    hipLaunchKernelGGL(mega, dim3(grid), dim3(NTHREADS), LDS_BYTES, stream, a);
#else
    for (int p = 0; p < NPH; ++p) { a.ph_lo = p; a.ph_hi = p + 1; hipLaunchKernelGGL(mega, dim3(grid), dim3(NTHREADS), LDS_BYTES, stream, a); }
#endif
    const hipError_t le = hipPeekAtLastError();
    if (le != hipSuccess) fprintf(stderr, "kernel_launch: launch failed: %s\n", hipGetErrorName(le));
}
```

```cpp
#include <hip/hip_runtime.h>
#include <stdint.h>
#include <stdio.h>

#ifndef ONE_LAUNCH
#define ONE_LAUNCH 1
#endif

#ifndef REP_MASK
#define REP_MASK 0
#endif
#define DOREP(j) ((((REP_MASK) >> (j)) & 1) != 0)
typedef unsigned short bf16_t;
#define LAS __attribute__((address_space(3)))

constexpr int L = 16384, LC = 256, MR = L + LC, D = 2048, NIN = 13824;
constexpr int HD = 128, GRIDW = 64;
constexpr int OFF_HY = 0, OFF_WAQ = 3072, OFF_WAKV = 4096, OFF_NAQ = 4608, OFF_NAKV = 5632, OFF_GATE = 7680;
constexpr int NE = 16, CAP = 2048, CAPC = 32, SLOTS = 2304, DF = 1024;
constexpr int NMOD = 6 * D;
constexpr float RMS_EPS = 1e-6f;
constexpr float QK_SCALE = 0.08838834764831845f;

constexpr size_t al256(size_t x) { return (x + 255) & ~(size_t)255; }
constexpr size_t WS_CTL = 0, CTL_BYTES = 1u << 20;
constexpr size_t WS_MOD = WS_CTL + CTL_BYTES;
constexpr size_t WS_H2B = WS_MOD + al256((size_t)2 * 2 * NMOD * 4);
constexpr size_t WS_FW3T = WS_H2B + al256((size_t)2 * MR * 256 * 2);
constexpr size_t WS_AFF = WS_FW3T + al256((size_t)2 * 4096 * 256 * 2);
constexpr size_t WS_IDX = WS_AFF + al256((size_t)MR * 16 * 4);
constexpr size_t WS_GSEL = WS_IDX + al256((size_t)NE * SLOTS * 4);
constexpr size_t WS_SLOT = WS_GSEL + al256((size_t)NE * SLOTS * 4);
constexpr size_t WS_KFC = WS_SLOT + al256((size_t)NE * MR * 4);
constexpr size_t WS_ZHYC = WS_KFC + al256((size_t)4096 * LC * 2);
constexpr size_t WS_XA = WS_ZHYC + al256((size_t)3072 * LC * 2);
constexpr size_t WS_XB = WS_XA + al256((size_t)MR * D * 4);
constexpr size_t WS_W = WS_XB + al256((size_t)MR * D * 4);
constexpr size_t W_BYTES = (size_t)2 * ((size_t)NIN * D + 3 * (size_t)D * 1024 + (size_t)D * D + (size_t)NE * 2048 * D + (size_t)NE * D * DF);
constexpr size_t WS_WIN = WS_W;
constexpr size_t WS_WBR = WS_WIN + (size_t)NIN * D * 2;
constexpr size_t WS_WOUT = WS_WBR + (size_t)3 * D * 1024 * 2;
constexpr size_t WS_WGU = WS_WOUT + (size_t)D * D * 2;
constexpr size_t WS_WDN = WS_WGU + (size_t)NE * 2048 * D * 2;
constexpr size_t WS_R3 = WS_W + al256(W_BYTES);
constexpr size_t R3_BYTES = (size_t)MR * D * 4 + (size_t)MR * D * 2;
constexpr size_t WS_KF = WS_R3;
constexpr size_t WS_KS = WS_R3 + al256((size_t)4096 * L * 2);
constexpr size_t WS_MPART = WS_R3;
constexpr size_t WS_MB = WS_R3 + (size_t)MR * D * 4;
constexpr size_t WS_TMP = WS_R3;
constexpr size_t WS_YE = WS_R3;
constexpr size_t WS_R4 = WS_R3 + al256(R3_BYTES);
constexpr size_t R4_BYTES = (size_t)MR * 6144 * 2;
constexpr size_t WS_GATE = WS_R4;
constexpr size_t WS_H2 = WS_R4;
constexpr size_t WS_ACT = WS_R4 + al256((size_t)MR * D * 2);
constexpr size_t WS_R5 = WS_R4 + al256(R4_BYTES);
constexpr size_t WS_MODPART = WS_R5;
constexpr size_t WS_HX = WS_R5;
constexpr size_t WS_YHYT = WS_R5;
constexpr size_t WS_YHY = WS_R5 + al256((size_t)1024 * L * 2);
constexpr size_t WS_ZHYT = WS_R5 + al256((size_t)MR * D * 2);
constexpr size_t WS_QWA = WS_ZHYT + al256((size_t)3072 * MR * 2);
constexpr size_t WS_KVWA = WS_QWA + al256((size_t)MR * 1024 * 2);
constexpr size_t WS_QNA = WS_KVWA + al256((size_t)MR * 512 * 2);
constexpr size_t WS_KVNA = WS_QNA + al256((size_t)MR * 1024 * 2);
constexpr size_t WS_YWA = WS_KVNA + al256((size_t)MR * 2048 * 2);
constexpr size_t WS_YNA = WS_YWA + al256((size_t)MR * 1024 * 2);
constexpr size_t WS_END = WS_YNA + al256((size_t)MR * 1024 * 2);
static_assert((size_t)1024 * L * 2 + (size_t)MR * 1024 * 2 <= (size_t)MR * D * 2 + 512, "YHYT+YHY overlay HX");
static_assert((size_t)4096 * L * 2 + 256 + (size_t)256 * 2 * 16384 * 8 <= R3_BYTES && (size_t)NE * SLOTS * D * 2 <= R3_BYTES && (size_t)NE * SLOTS * DF * 4 <= R3_BYTES, "R3");
static_assert((size_t)MR * D * 2 + 256 + (size_t)NE * SLOTS * DF * 2 <= R4_BYTES, "R4");

constexpr int LDS_BYTES = 160 * 1024;
constexpr int NTHREADS = 512;
constexpr int PH_PER_LAYER = 12, NPH = 1 + 2 * PH_PER_LAYER;

__device__ __forceinline__ float bf2f(bf16_t b) { return __uint_as_float(((unsigned)b) << 16); }
__device__ __forceinline__ bf16_t f2bf(float f) { unsigned u = __float_as_uint(f); u += 0x7fffu + ((u >> 16) & 1u); return (bf16_t)(u >> 16); }
__device__ __forceinline__ unsigned pk2(float lo, float hi) { return (unsigned)f2bf(lo) | ((unsigned)f2bf(hi) << 16); }
__device__ __forceinline__ float wave_sum(float v) {
#pragma unroll
    for (int o = 1; o < 64; o <<= 1) v += __shfl_xor(v, o);
    return v;
}
__device__ __forceinline__ float wave_max(float v) {
#pragma unroll
    for (int o = 1; o < 64; o <<= 1) v = fmaxf(v, __shfl_xor(v, o));
    return v;
}
__device__ __forceinline__ float silu_f(float x) { return x * __builtin_amdgcn_rcpf(1.f + __expf(-x)); }
__device__ __forceinline__ float sigmoid_f(float x) { return __builtin_amdgcn_rcpf(1.f + __expf(-x)); }
#define LDS_FENCE() asm volatile("s_waitcnt lgkmcnt(0)" ::: "memory")

#define XB_TMO      128
#define XB_XCNT(j)  (256  + 64 * (j))
#define XB_XSUB(j)  (1280 + 64 * (j))
#define XB_XGEN(j)  (2304 + 64 * (j))
#define XB_TOP      3328
#define XB_TOPGEN   3392
#define XCD_BAR_WORDS 3456
#define XB_SPIN_CAP (1u << 22)

__device__ __forceinline__ unsigned xb_ld(unsigned* p)              { return __hip_atomic_load(p, __ATOMIC_RELAXED, __HIP_MEMORY_SCOPE_AGENT); }
__device__ __forceinline__ unsigned xb_add(unsigned* p, unsigned v) { return __hip_atomic_fetch_add(p, v, __ATOMIC_RELAXED, __HIP_MEMORY_SCOPE_AGENT); }
__device__ __forceinline__ unsigned xb_xcc_id() { return (unsigned)__builtin_amdgcn_s_getreg((3 << 11) | 20) & 0xFu; }
#define XB_SPIN(cond, bar) do { unsigned _sp = 0; while (cond) { __builtin_amdgcn_s_sleep(1); \
    if ((++_sp & 255u) == 0u) { if (xb_ld(&(bar)[XB_TMO])) break; if (_sp > XB_SPIN_CAP) { atomicAdd(&(bar)[XB_TMO], 1u); break; } } } } while (0)

struct XcdBarrier { unsigned* bar; unsigned x; volatile LAS unsigned* st; };

__device__ __forceinline__ XcdBarrier xcd_barrier_post(unsigned* bar, volatile LAS unsigned* st) {
    XcdBarrier b; b.bar = bar; b.x = xb_xcc_id(); b.st = st;
    if (threadIdx.x == 0) (void)xb_add(&bar[XB_XCNT(b.x)], 1u);
    return b;
}
__device__ __forceinline__ void xcd_barrier_complete(unsigned* bar, unsigned x, unsigned& nloc, unsigned& nx) {
    const unsigned G = gridDim.x * gridDim.y * gridDim.z;
    unsigned sum, cnt, mine, sp = 0u;
    for (;;) {
        sum = 0u; cnt = 0u; mine = 0u;
#pragma unroll
        for (unsigned j = 0; j < 16; ++j) { const unsigned c = xb_ld(&bar[XB_XCNT(j)]); sum += c; cnt += (c > 0u) ? 1u : 0u; mine = (j == x) ? c : mine; }
        if (sum == G) break;
        __builtin_amdgcn_s_sleep(1);
        if ((++sp & 255u) == 0u) { if (xb_ld(&bar[XB_TMO])) break; if (sp > XB_SPIN_CAP) { atomicAdd(&bar[XB_TMO], 1u); break; } }
    }
    nloc = mine > 0u ? mine : 1u; nx = cnt > 0u ? cnt : 1u;
}
__device__ __forceinline__ void xcd_barrier(const XcdBarrier& b) {
    asm volatile("s_waitcnt vmcnt(0)" ::: "memory");
    __syncthreads();
    if (threadIdx.x == 0) {
        unsigned* bar = b.bar;
        __builtin_amdgcn_s_waitcnt(0);
        unsigned nloc = b.st[0], nx = b.st[1];
        if (nloc == 0u) { xcd_barrier_complete(bar, b.x, nloc, nx); b.st[0] = nloc; b.st[1] = nx; }
        const unsigned old = xb_add(&bar[XB_XSUB(b.x)], 1u);
        const unsigned gen = old / nloc;
        if (old + 1u == (gen + 1u) * nloc) {
            __builtin_amdgcn_fence(__ATOMIC_RELEASE, "agent");
            asm volatile("s_waitcnt vmcnt(0)" ::: "memory");
            const unsigned og = xb_add(&bar[XB_TOP], 1u);
            const unsigned tg = og / nx;
            if (og + 1u == (tg + 1u) * nx) xb_add(&bar[XB_TOPGEN], 1u);
            else XB_SPIN(xb_ld(&bar[XB_TOPGEN]) == tg, bar);
            __builtin_amdgcn_fence(__ATOMIC_ACQUIRE, "agent");
            xb_add(&bar[XB_XGEN(b.x)], 1u);
            asm volatile("s_waitcnt vmcnt(0)" ::: "memory");
        } else {
            XB_SPIN(xb_ld(&bar[XB_XGEN(b.x)]) == gen, bar);
            __builtin_amdgcn_fence(__ATOMIC_ACQUIRE, "agent");
            asm volatile("s_waitcnt vmcnt(0)" ::: "memory");
        }
    }
    __syncthreads();
}

struct KArgs { const float* in[31]; float* out; unsigned char* ws; int ph_lo, ph_hi; };

struct Ctx {
    const float* const* in; float* out; unsigned char* ws;
    int bid, nb, tid, lane, wave;
    unsigned char* smem;
    template <class T> __device__ __forceinline__ T* wsp(size_t off) const { return (T*)(ws + off); }
    __device__ __forceinline__ const float* mod(int layer, int src, int chunk) const { return wsp<float>(WS_MOD) + ((size_t)(layer * 2 + src) * NMOD) + chunk * D; }
    __device__ __forceinline__ const float* xrow(int layer, int r) const {
        if (layer == 0) return r < L ? in[0] + (size_t)r * D : in[2] + (size_t)(r - L) * D;
        return wsp<float>(WS_XB) + (size_t)r * D;
    }
};

template <class RowPtr, class Epi>
__device__ __forceinline__ void sgemm_unit(const RowPtr& rp, const float* __restrict__ W, int ldw, int K, int m0, int n0, const Epi& ep, float* lds, int tid) {
    float* As = lds;
    float* Bs = lds + 16 * 132;
    const int ty = tid >> 4, tx = tid & 15;
    const int am = tid >> 2, kq = (tid & 3) * 4;
    const int bk = tid >> 5, n4 = (tid & 31) * 4;
    float acc[4][8];
#pragma unroll
    for (int i = 0; i < 4; ++i)
#pragma unroll
        for (int j = 0; j < 8; ++j) acc[i][j] = 0.f;
    const bf16_t* arow = rp(m0 + am);
    const float* wp = W + (size_t)bk * ldw + n0 + n4;
    for (int k0 = 0; k0 < K; k0 += 16) {
        const uint2 a4 = *(const uint2*)(arow + k0 + kq);
        const float4 b4 = *(const float4*)(wp + (size_t)k0 * ldw);
        __syncthreads();
        As[(kq + 0) * 132 + am] = __uint_as_float(a4.x << 16);
        As[(kq + 1) * 132 + am] = __uint_as_float(a4.x & 0xffff0000u);
        As[(kq + 2) * 132 + am] = __uint_as_float(a4.y << 16);
        As[(kq + 3) * 132 + am] = __uint_as_float(a4.y & 0xffff0000u);
        *(float4*)&Bs[bk * 128 + n4] = b4;
        __syncthreads();
#pragma unroll
        for (int kk = 0; kk < 16; ++kk) {
            const float4 a = *(const float4*)&As[kk * 132 + ty * 4];
            const float4 b0 = *(const float4*)&Bs[kk * 128 + tx * 8];
            const float4 b1 = *(const float4*)&Bs[kk * 128 + tx * 8 + 4];
            const float av[4] = {a.x, a.y, a.z, a.w};
            const float bv[8] = {b0.x, b0.y, b0.z, b0.w, b1.x, b1.y, b1.z, b1.w};
#pragma unroll
            for (int i = 0; i < 4; ++i)
#pragma unroll
                for (int j = 0; j < 8; ++j) acc[i][j] = fmaf(av[i], bv[j], acc[i][j]);
        }
    }
#pragma unroll
    for (int i = 0; i < 4; ++i) ep(m0 + ty * 4 + i, n0 + tx * 8, acc[i]);
}

struct RowLin { const bf16_t* base; int ld; __device__ __forceinline__ const bf16_t* operator()(int m) const { return base + (size_t)m * ld; } };
struct RowGather { const bf16_t* base; int ld; const int* idx; __device__ __forceinline__ const bf16_t* operator()(int m) const { return base + (size_t)idx[m] * ld; } };


namespace pg8 {
typedef short bf16x8 __attribute__((ext_vector_type(8)));
typedef float f32x4 __attribute__((ext_vector_type(4)));
typedef unsigned u32x4 __attribute__((ext_vector_type(4)));
typedef unsigned u32x2 __attribute__((ext_vector_type(2)));
constexpr int BM = 256, BK = 64, HALF = 128, HTB = HALF * BK * 2, STAGE_BYTES = 8 * HTB, NXCD = 8, WGM = 8;
__host__ __device__ __forceinline__ int lds_byte(int r, int c) { const int st = (r >> 4) * 2 + (c >> 5), rr = r & 15, cc = c & 31, ob = rr * 64 + cc * 2; return st * 1024 + (ob ^ (((ob >> 9) & 1) << 5)); }
__host__ __device__ __forceinline__ void stage_rc(int b, int& R, int& C) { const int st = b / 1024, sb = b % 1024, swz = sb ^ (((sb >> 9) & 1) << 5); R = (st >> 1) * 16 + swz / 64; C = (st & 1) * 32 + (swz % 64) / 2; }
__host__ __device__ __forceinline__ int perm32(int rho) { const int n = rho >> 4, i = rho & 15; return 8 * (i >> 2) + 4 * n + (i & 3); }
struct Unit { int pm, pn; };
struct StaticOrder {
    int nM, nN, nwg, G, c;
    __host__ __device__ void init(int nM_, int nN_, int G_, int c_) { nM = nM_; nN = nN_; nwg = nM * nN; G = G_; c = c_; }
    __host__ __device__ bool next(int i, Unit& u) const { return at((long)i * G + c, u); }
    __host__ __device__ bool at(long Lq, Unit& u) const {
        if (Lq >= nwg) return false;
        int wgid = (int)Lq; { const int q = nwg / NXCD, r = nwg % NXCD, xcd = wgid % NXCD, off = wgid / NXCD; wgid = (xcd < r ? xcd * (q + 1) : r * (q + 1) + (xcd - r) * q) + off; }
        const int nig = WGM * nN, gid = wgid / nig, fm = gid * WGM, gsz = (nM - fm) < WGM ? (nM - fm) : WGM;
        u.pm = fm + ((wgid % nig) % gsz); u.pn = (wgid % nig) / gsz; return true;
    }
};
__device__ __forceinline__ unsigned cvt_pk_bf16(float lo, float hi) { unsigned r; asm volatile("v_cvt_pk_bf16_f32 %0, %1, %2" : "=v"(r) : "v"(lo), "v"(hi)); return r; }

struct GeomLin {
    static constexpr bool GATHER = false;
    const char* A; const char* B; int K, lda, ldb; const int* idx;
    __device__ __forceinline__ const char* a_base(const Unit& u) const { return A + (size_t)u.pm * 256 * lda * 2; }
    __device__ __forceinline__ const char* b_base(const Unit& u) const { return B + (size_t)u.pn * 256 * ldb * 2; }
    __device__ __forceinline__ int row0(const Unit& u) const { return u.pm * 256; }
};
template <bool GATHER_> struct GeomExpert {
    static constexpr bool GATHER = GATHER_;
    const char* A; const char* B; int K, lda, ldb; const int* idx; int tpe, nb;
    __device__ __forceinline__ int row0(const Unit& u) const { const int e = u.pm / tpe, t = u.pm - e * tpe; return e * SLOTS + t * 256; }
    __device__ __forceinline__ const char* a_base(const Unit& u) const { return GATHER_ ? A : A + (size_t)row0(u) * lda * 2; }
    __device__ __forceinline__ const char* b_base(const Unit& u) const { const int e = u.pm / tpe; return B + ((size_t)e * nb + (size_t)u.pn * 256) * ldb * 2; }
};

template <class Epi, class Geom, class Sched>
__device__ __forceinline__ void gemm_phase(LAS unsigned char* lds, const Geom& G, const Sched& S, const Epi& E) {
    const int tid = threadIdx.x, wid = __builtin_amdgcn_readfirstlane(tid >> 6), lane = tid & 63, wr = wid >> 2, wc = wid & 3, fr = lane & 15, fq = lane >> 4;
    const int K = G.K, nt = K / BK;
    int Rs[2], Cs[2]; unsigned vB0[2], vA0[2], vAc[2][2], vAn[2][2];
#pragma unroll
    for (int i = 0; i < 2; ++i) { int R, C; stage_rc(tid * 16 + i * 8192, R, C); Rs[i] = R; Cs[i] = C; const int Rb = Epi::PERM ? ((R & ~31) + perm32(R & 31)) : R;
        vB0[i] = (unsigned)(Rb * G.ldb + C) * 2u; vA0[i] = (unsigned)(R * G.lda + C) * 2u;
#pragma unroll
        for (int h = 0; h < 2; ++h) { vAc[h][i] = 0u; vAn[h][i] = 0u; } }
    const size_t hstepA = (size_t)HALF * G.lda * 2, hstepB = (size_t)HALF * G.ldb * 2;
#define PG8_VOFF(dst, u) do { if constexpr (Geom::GATHER) { const int _r0 = G.row0(u); _Pragma("unroll") for (int _h = 0; _h < 2; ++_h) _Pragma("unroll") for (int _i = 0; _i < 2; ++_i) \
        dst[_h][_i] = ((unsigned)G.idx[_r0 + _h * HALF + Rs[_i]] * (unsigned)G.lda + (unsigned)Cs[_i]) * 2u; } } while (0)
    const size_t kstep = (size_t)(BK * 2);
    const unsigned ldsw = (unsigned)wid * 1024u;
    const int aoff = lds_byte(wr * 64 + fr, fq * 8), boff = lds_byte(wc * 32 + fr, fq * 8);
#define PG8_SA(b, h) (((b) * 2 + (h)) * HTB)
#define PG8_SB(b, h) ((4 + (b) * 2 + (h)) * HTB)
#define PG8_STAGE(bufoff, gbase, v) do { \
        __builtin_amdgcn_global_load_lds((const unsigned*)((const char*)(gbase) + (v)[0]), (LAS unsigned*)(lds + (bufoff) + ldsw), 16, 0, 0); \
        __builtin_amdgcn_global_load_lds((const unsigned*)((const char*)(gbase) + (v)[1]), (LAS unsigned*)(lds + (bufoff) + ldsw + 8192), 16, 0, 0); } while (0)
#define PG8_STA(bufoff, gbase, h, VX) do { if constexpr (Geom::GATHER) { PG8_STAGE(bufoff, gbase, VX[h]); } else { PG8_STAGE(bufoff, (gbase) + (h) * hstepA, vA0); } } while (0)
#define PG8_STB(bufoff, gbase, h) PG8_STAGE(bufoff, (gbase) + (h) * hstepB, vB0)
#define PG8_LDA(dst, b, h) do { _Pragma("unroll") for (int m = 0; m < 4; ++m) _Pragma("unroll") for (int k = 0; k < 2; ++k) dst[m][k] = *(const LAS bf16x8*)(lds + PG8_SA(b, h) + aoff + m * 2048 + k * 1024); } while (0)
#define PG8_LDB(dst, b, h) do { _Pragma("unroll") for (int n = 0; n < 2; ++n) _Pragma("unroll") for (int k = 0; k < 2; ++k) dst[n][k] = *(const LAS bf16x8*)(lds + PG8_SB(b, h) + boff + n * 2048 + k * 1024); } while (0)
#define PG8_MMA(ai, bj, At, Bt) do { __builtin_amdgcn_s_setprio(1); _Pragma("unroll") for (int m = 0; m < 4; ++m) _Pragma("unroll") for (int n = 0; n < 2; ++n) _Pragma("unroll") for (int k = 0; k < 2; ++k) \
        acc[ai][bj][m][n] = __builtin_amdgcn_mfma_f32_16x16x32_bf16(Bt[n][k], At[m][k], acc[ai][bj][m][n], 0, 0, 0); __builtin_amdgcn_s_setprio(0); } while (0)
#define PG8_WAIT_V(n) asm volatile("s_waitcnt vmcnt(" #n ")" ::: "memory")
#define PG8_WAIT_L(n) asm volatile("s_waitcnt lgkmcnt(" #n ")" ::: "memory")
#define PG8_BAR __builtin_amdgcn_s_barrier()
#define PG8_SCHED __builtin_amdgcn_sched_barrier(0)
    Unit cur, nxt; int ui = 0;
    if (!S.next(0, cur)) return;
    f32x4 acc[2][2][4][2];
#pragma unroll
    for (int a = 0; a < 2; ++a)
#pragma unroll
        for (int b = 0; b < 2; ++b)
#pragma unroll
            for (int m = 0; m < 4; ++m)
#pragma unroll
                for (int n = 0; n < 2; ++n) acc[a][b][m][n] = (f32x4){0.f, 0.f, 0.f, 0.f};
    bf16x8 At[4][2], B0[2][2], B1[2][2];
    const char* cA = G.a_base(cur); const char* cB = G.b_base(cur);
    PG8_VOFF(vAc, cur);
    PG8_STB(PG8_SB(0, 0), cB, 0); PG8_STA(PG8_SA(0, 0), cA, 0, vAc); PG8_STB(PG8_SB(0, 1), cB, 1); PG8_STA(PG8_SA(0, 1), cA, 1, vAc);
    if (wr == 1) PG8_BAR;
    PG8_WAIT_V(4); PG8_BAR;
    PG8_STB(PG8_SB(1, 0), cB + kstep, 0); PG8_STA(PG8_SA(1, 0), cA + kstep, 0, vAc); PG8_STB(PG8_SB(1, 1), cB + kstep, 1);
    PG8_WAIT_V(6); PG8_BAR;
    for (;;) {
        const bool has_next = S.next(ui + 1, nxt);
        const char* nA = has_next ? G.a_base(nxt) : cA; const char* nB = has_next ? G.b_base(nxt) : cB;
        if constexpr (Geom::GATHER) { if (has_next) PG8_VOFF(vAn, nxt); else {
#pragma unroll
            for (int h = 0; h < 2; ++h) { vAn[h][0] = vAc[h][0]; vAn[h][1] = vAc[h][1]; } } }
        for (int t = 0; t < nt; t += 2) {
            const bool last = (t == nt - 2);
            const char* a1 = cA + (size_t)(t + 1) * kstep;
            const char* a2 = last ? nA : cA + (size_t)(t + 2) * kstep; const char* b2 = last ? nB : cB + (size_t)(t + 2) * kstep;
            const char* a3 = a2 + kstep; const char* b3 = b2 + kstep;
            unsigned v2[2][2];
#pragma unroll
            for (int h = 0; h < 2; ++h) { v2[h][0] = (Geom::GATHER && last) ? vAn[h][0] : vAc[h][0]; v2[h][1] = (Geom::GATHER && last) ? vAn[h][1] : vAc[h][1]; }
            PG8_LDB(B0, 0, 0); PG8_SCHED; PG8_LDA(At, 0, 0); PG8_STA(PG8_SA(1, 1), a1, 1, vAc);
            PG8_WAIT_L(8); PG8_BAR; PG8_WAIT_L(0); PG8_MMA(0, 0, At, B0); PG8_BAR; PG8_SCHED;
            PG8_LDB(B1, 0, 1); PG8_STB(PG8_SB(0, 0), b2, 0);
            PG8_BAR; PG8_WAIT_L(0); PG8_MMA(0, 1, At, B1); PG8_BAR;
            PG8_LDA(At, 0, 1); PG8_STA(PG8_SA(0, 0), a2, 0, v2);
            PG8_BAR; PG8_WAIT_L(0); PG8_MMA(1, 0, At, B0); PG8_BAR; PG8_SCHED;
            PG8_STB(PG8_SB(0, 1), b2, 1);
            PG8_WAIT_V(6); PG8_BAR; PG8_MMA(1, 1, At, B1); PG8_BAR;
            PG8_LDB(B0, 1, 0); PG8_SCHED; PG8_LDA(At, 1, 0); PG8_STA(PG8_SA(0, 1), a2, 1, v2);
            PG8_WAIT_L(8); PG8_BAR; PG8_WAIT_L(0); PG8_MMA(0, 0, At, B0); PG8_BAR; PG8_SCHED;
            PG8_LDB(B1, 1, 1); PG8_STB(PG8_SB(1, 0), b3, 0);
            PG8_BAR; PG8_WAIT_L(0); PG8_MMA(0, 1, At, B1); PG8_BAR;
            PG8_LDA(At, 1, 1); PG8_STA(PG8_SA(1, 0), a3, 0, v2);
            PG8_BAR; PG8_WAIT_L(0); PG8_MMA(1, 0, At, B0); PG8_BAR; PG8_SCHED;
            PG8_STB(PG8_SB(1, 1), b3, 1);
            PG8_WAIT_V(6); PG8_BAR; PG8_MMA(1, 1, At, B1); PG8_BAR;
        }
        E(acc, cur, G.row0(cur), wr, wc, fr, fq);
        if (!has_next) break;
#pragma unroll
        for (int a = 0; a < 2; ++a)
#pragma unroll
            for (int b = 0; b < 2; ++b)
#pragma unroll
                for (int m = 0; m < 4; ++m)
#pragma unroll
                    for (int n = 0; n < 2; ++n) acc[a][b][m][n] = (f32x4){0.f, 0.f, 0.f, 0.f};
        cur = nxt; cA = nA; cB = nB; ++ui;
#pragma unroll
        for (int h = 0; h < 2; ++h) { vAc[h][0] = vAn[h][0]; vAc[h][1] = vAn[h][1]; }
    }
    PG8_WAIT_V(0);
    if (wr == 0) PG8_BAR;
    PG8_BAR;
#undef PG8_VOFF
#undef PG8_SA
#undef PG8_SB
#undef PG8_STAGE
#undef PG8_STA
#undef PG8_STB
#undef PG8_LDA
#undef PG8_LDB
#undef PG8_MMA
#undef PG8_WAIT_V
#undef PG8_WAIT_L
#undef PG8_BAR
#undef PG8_SCHED
}

struct EpiBf16Plain {
    static constexpr bool PERM = true;
    bf16_t* O; int ldc; int coloff;
    __device__ __forceinline__ void operator()(const f32x4 (&acc)[2][2][4][2], const Unit& u, int row0, int wr, int wc, int fr, int fq) const {
        const int r0 = row0 + wr * 64 + fr, col0 = coloff + u.pn * BM + wc * 32 + 8 * fq;
#pragma unroll
        for (int ai = 0; ai < 2; ++ai)
#pragma unroll
            for (int m = 0; m < 4; ++m) { bf16_t* rowp = O + (size_t)(r0 + ai * HALF + m * 16) * ldc + col0;
#pragma unroll
                for (int bj = 0; bj < 2; ++bj) { const f32x4 v0 = acc[ai][bj][m][0], v1 = acc[ai][bj][m][1];
                    u32x4 w; w.x = cvt_pk_bf16(v0[0], v0[1]); w.y = cvt_pk_bf16(v0[2], v0[3]); w.z = cvt_pk_bf16(v1[0], v1[1]); w.w = cvt_pk_bf16(v1[2], v1[3]);
                    *(u32x4*)(rowp + bj * HALF) = w; } }
    }
};
struct EpiInRest {
    static constexpr bool PERM = true;
    unsigned char* ws;
    __device__ __forceinline__ void operator()(const f32x4 (&acc)[2][2][4][2], const Unit& u, int row0, int wr, int wc, int fr, int fq) const {
        const int gcol = OFF_WAQ + u.pn * BM;
        bf16_t* base; int ldc, c0; bool sg = false;
        if (gcol < OFF_WAKV) { base = (bf16_t*)(ws + WS_QWA); ldc = 1024; c0 = gcol - OFF_WAQ; }
        else if (gcol < OFF_NAQ) { base = (bf16_t*)(ws + WS_KVWA); ldc = 512; c0 = gcol - OFF_WAKV; }
        else if (gcol < OFF_NAKV) { base = (bf16_t*)(ws + WS_QNA); ldc = 1024; c0 = gcol - OFF_NAQ; }
        else if (gcol < OFF_GATE) { base = (bf16_t*)(ws + WS_KVNA); ldc = 2048; c0 = gcol - OFF_NAKV; }
        else { base = (bf16_t*)(ws + WS_GATE); ldc = 6144; c0 = gcol - OFF_GATE; sg = true; }
        const int r0 = row0 + wr * 64 + fr, col0 = c0 + wc * 32 + 8 * fq;
#pragma unroll
        for (int ai = 0; ai < 2; ++ai)
#pragma unroll
            for (int m = 0; m < 4; ++m) { bf16_t* rowp = base + (size_t)(r0 + ai * HALF + m * 16) * ldc + col0;
#pragma unroll
                for (int bj = 0; bj < 2; ++bj) { f32x4 v0 = acc[ai][bj][m][0], v1 = acc[ai][bj][m][1];
                    if (sg) {
#pragma unroll
                        for (int j = 0; j < 4; ++j) { v0[j] = sigmoid_f(v0[j]); v1[j] = sigmoid_f(v1[j]); } }
                    u32x4 w; w.x = cvt_pk_bf16(v0[0], v0[1]); w.y = cvt_pk_bf16(v0[2], v0[3]); w.z = cvt_pk_bf16(v1[0], v1[1]); w.w = cvt_pk_bf16(v1[2], v1[3]);
                    *(u32x4*)(rowp + bj * HALF) = w; } }
    }
};
template <int BR> struct EpiMergeF {
    static constexpr bool PERM = false;
    unsigned char* ws;
    __device__ __forceinline__ void operator()(const f32x4 (&acc)[2][2][4][2], const Unit& u, int row0, int wr, int wc, int fr, int fq) const {
        const int r0 = row0 + wr * 64 + fr, col0 = u.pn * BM + wc * 32 + 4 * fq;
#pragma unroll
        for (int ai = 0; ai < 2; ++ai)
#pragma unroll
            for (int m = 0; m < 4; ++m) { const size_t row = (size_t)(r0 + ai * HALF + m * 16);
                const bf16_t* gp = (const bf16_t*)(ws + WS_GATE) + row * 6144 + BR * 2048 + col0;
                bf16_t* ob = (bf16_t*)(ws + WS_MB) + row * D + col0;
#pragma unroll
                for (int bj = 0; bj < 2; ++bj)
#pragma unroll
                    for (int n = 0; n < 2; ++n) { const int co = bj * HALF + n * 16;
                        const u32x2 gg = *(const u32x2*)(gp + co);
                        const f32x4 g = {__uint_as_float(gg.x << 16), __uint_as_float(gg.x & 0xffff0000u), __uint_as_float(gg.y << 16), __uint_as_float(gg.y & 0xffff0000u)};
                        f32x4 t = g * acc[ai][bj][m][n];
                        if (BR > 0) { const u32x2 pp = *(const u32x2*)(ob + co);
                            t += (f32x4){__uint_as_float(pp.x << 16), __uint_as_float(pp.x & 0xffff0000u), __uint_as_float(pp.y << 16), __uint_as_float(pp.y & 0xffff0000u)}; }
                        u32x2 w; w.x = cvt_pk_bf16(t[0], t[1]); w.y = cvt_pk_bf16(t[2], t[3]); *(u32x2*)(ob + co) = w; } }
    }
};
struct EpiOutF {
    static constexpr bool PERM = false;
    const Ctx* c; int layer;
    __device__ __forceinline__ void operator()(const f32x4 (&acc)[2][2][4][2], const Unit& u, int row0, int wr, int wc, int fr, int fq) const {
        const int r0 = row0 + wr * 64 + fr, col0 = u.pn * BM + wc * 32 + 4 * fq;
#pragma unroll
        for (int ai = 0; ai < 2; ++ai)
#pragma unroll
            for (int m = 0; m < 4; ++m) { const int row = r0 + ai * HALF + m * 16;
                const float* xin = c->xrow(layer, row) + col0; const float* g = c->mod(layer, row < L ? 0 : 1, 2) + col0;
                float* o = (float*)(c->ws + WS_XA) + (size_t)row * D + col0;
#pragma unroll
                for (int bj = 0; bj < 2; ++bj)
#pragma unroll
                    for (int n = 0; n < 2; ++n) { const int co = bj * HALF + n * 16;
                        *(f32x4*)(o + co) = *(const f32x4*)(xin + co) + *(const f32x4*)(g + co) * acc[ai][bj][m][n]; } }
    }
};
struct EpiGU {
    static constexpr bool PERM = false;
    bf16_t* act;
    __device__ __forceinline__ void operator()(const f32x4 (&acc)[2][2][4][2], const Unit& u, int row0, int wr, int wc, int fr, int fq) const {
        const int r0 = row0 + wr * 64 + fr, f0 = u.pn * 128 + wc * 16 + 4 * fq;
#pragma unroll
        for (int ai = 0; ai < 2; ++ai)
#pragma unroll
            for (int m = 0; m < 4; ++m) { bf16_t* rowp = act + (size_t)(r0 + ai * HALF + m * 16) * DF + f0;
#pragma unroll
                for (int bj = 0; bj < 2; ++bj) { const f32x4 a = acc[ai][bj][m][0], uu = acc[ai][bj][m][1]; f32x4 t;
#pragma unroll
                    for (int j = 0; j < 4; ++j) t[j] = silu_f(a[j]) * uu[j];
                    u32x2 w; w.x = cvt_pk_bf16(t[0], t[1]); w.y = cvt_pk_bf16(t[2], t[3]); *(u32x2*)(rowp + bj * 64) = w; } }
    }
};
}

struct ConvDesc { const float* W; bf16_t* WT; int K, N, k0, n0, gu, off; };
__device__ __forceinline__ ConvDesc conv_desc(const Ctx& c, int layer, int it) {
    constexpr int I_IN = (D / 64) * (NIN / 256), I_BR = (1024 / 64) * (D / 256), I_OUT = (D / 64) * (D / 256), I_G = (D / 64) * (DF / 256), I_DN = (DF / 64) * (D / 256);
    ConvDesc d; int r = it; d.gu = 0; d.off = 0;
    if (r < I_IN) { d.W = c.in[7] + (size_t)layer * D * NIN; d.WT = c.wsp<bf16_t>(WS_WIN); d.K = D; d.N = NIN; }
    else if ((r -= I_IN) < 3 * I_BR) { const int b = r / I_BR; r -= b * I_BR; d.W = c.in[24] + ((size_t)layer * 3 + b) * 1024 * D; d.WT = c.wsp<bf16_t>(WS_WBR) + (size_t)b * D * 1024; d.K = 1024; d.N = D; }
    else if ((r -= 3 * I_BR) < I_OUT) { d.W = c.in[25] + (size_t)layer * D * D; d.WT = c.wsp<bf16_t>(WS_WOUT); d.K = D; d.N = D; }
    else { r -= I_OUT; const int e = r / (2 * I_G + I_DN); r -= e * (2 * I_G + I_DN);
        if (r < I_G) { d.W = c.in[28] + ((size_t)layer * NE + e) * D * DF; d.WT = c.wsp<bf16_t>(WS_WGU); d.K = D; d.N = DF; d.gu = 1; d.off = e * 2048; }
        else if ((r -= I_G) < I_G) { d.W = c.in[29] + ((size_t)layer * NE + e) * D * DF; d.WT = c.wsp<bf16_t>(WS_WGU); d.K = D; d.N = DF; d.gu = 1; d.off = e * 2048 + 16; }
        else { r -= I_G; d.W = c.in[30] + ((size_t)layer * NE + e) * DF * D; d.WT = c.wsp<bf16_t>(WS_WDN) + (size_t)e * D * DF; d.K = DF; d.N = D; } }
    const int nblk = d.N / 256; d.k0 = 64 * (r / nblk); d.n0 = 256 * (r % nblk);
    return d;
}
constexpr int CONV_NA = (D / 64) * (NIN / 256) + 3 * (1024 / 64) * (D / 256) + (D / 64) * (D / 256);
constexpr int CONV_NX = NE * (2 * (D / 64) * (DF / 256) + (DF / 64) * (D / 256));
__device__ __forceinline__ void ph_conv(const Ctx& c, int layer, int first, int count, int stride) {
    __syncthreads();
    float* tile = (float*)c.smem;
    const int tid = c.tid;
    float4 rg[8];
    int it = first; int left = count; bool have = left > 0; ConvDesc d;
    if (have) { d = conv_desc(c, layer, it);
#pragma unroll
        for (int q = 0; q < 8; ++q) { const int e = tid + 512 * q, row = e >> 6, c4 = e & 63; rg[q] = *(const float4*)(d.W + (size_t)(d.k0 + row) * d.N + d.n0 + 4 * c4); } }
    while (have) {
#pragma unroll
        for (int q = 0; q < 8; ++q) { const int e = tid + 512 * q, row = e >> 6, c4 = e & 63; float* tp = tile + row * 257 + 4 * c4; tp[0] = rg[q].x; tp[1] = rg[q].y; tp[2] = rg[q].z; tp[3] = rg[q].w; }
        __syncthreads();
        const ConvDesc cur = d;
        it += stride; --left; have = left > 0;
        if (have) { d = conv_desc(c, layer, it);
#pragma unroll
            for (int q = 0; q < 8; ++q) { const int e = tid + 512 * q, row = e >> 6, c4 = e & 63; rg[q] = *(const float4*)(d.W + (size_t)(d.k0 + row) * d.N + d.n0 + 4 * c4); } }
#pragma unroll
        for (int j = 0; j < 4; ++j) { const int p = tid + 512 * j, nn = p >> 3, kc = p & 7; const float* sp = tile + (8 * kc) * 257 + nn;
            uint4 o; o.x = pk2(sp[0 * 257], sp[1 * 257]); o.y = pk2(sp[2 * 257], sp[3 * 257]); o.z = pk2(sp[4 * 257], sp[5 * 257]); o.w = pk2(sp[6 * 257], sp[7 * 257]);
            const int f = cur.n0 + nn; const int orow = cur.gu ? cur.off + 32 * (f >> 4) + (f & 15) : f;
            *(uint4*)(cur.WT + (size_t)orow * cur.K + cur.k0 + 8 * kc) = o; }
        __syncthreads();
    }
}

struct EpiTaps {
    static constexpr bool PERM = true;
    bf16_t* KF; bf16_t* KFC; const float* dec;
    __device__ __forceinline__ void operator()(const pg8::f32x4 (&acc)[2][2][4][2], const pg8::Unit& u, int row0, int wr, int wc, int fr, int fq) const {
        const bool isc = u.pn == L / 256;
        const int ch0 = row0 + wr * 64 + fr, pos0 = (isc ? 0 : u.pn * 256) + wc * 32 + 8 * fq;
        const float inv = isc ? 1.0f / (float)(LC - 1) : 1.0f / (float)(L - 1);
        bf16_t* base = isc ? KFC : KF; const int ld = isc ? LC : L;
#pragma unroll
        for (int ai = 0; ai < 2; ++ai)
#pragma unroll
            for (int m = 0; m < 4; ++m) { const int ch = ch0 + ai * 128 + m * 16; const float rate = fabsf(dec[ch]); bf16_t* rowp = base + (size_t)ch * ld + pos0;
#pragma unroll
                for (int bj = 0; bj < 2; ++bj) { float t[8];
#pragma unroll
                    for (int j = 0; j < 8; ++j) { const float tt = (float)(pos0 + bj * 128 + j) * inv; const float a = j < 4 ? acc[ai][bj][m][0][j] : acc[ai][bj][m][1][j - 4]; t[j] = a * (__expf(-tt * rate) + 0.05f); }
                    pg8::u32x4 w; w.x = pg8::cvt_pk_bf16(t[0], t[1]); w.y = pg8::cvt_pk_bf16(t[2], t[3]); w.z = pg8::cvt_pk_bf16(t[4], t[5]); w.w = pg8::cvt_pk_bf16(t[6], t[7]);
                    *(pg8::u32x4*)(rowp + bj * 128) = w; } }
    }
};
__device__ __forceinline__ void ph_taps(const Ctx& c, int layer) {
    LAS unsigned char* lds = (LAS unsigned char*)c.smem;
    __syncthreads();
    const pg8::GeomLin G{(const char*)(c.wsp<bf16_t>(WS_FW3T) + (size_t)layer * 4096 * 256), (const char*)(c.wsp<bf16_t>(WS_H2B) + (size_t)layer * MR * 256), 256, 256, 256, nullptr};
    pg8::StaticOrder S; S.init(4096 / 256, MR / 256, c.nb, c.bid);
    const EpiTaps E{c.wsp<bf16_t>(WS_KF), c.wsp<bf16_t>(WS_KFC), c.in[16] + (size_t)layer * 4096};
    pg8::gemm_phase(lds, G, S, E);
}

__device__ __forceinline__ void ph_g0(const Ctx& c) {
    float* lds = (float*)c.smem;
    {
        float* PART = c.wsp<float>(WS_MODPART);
        for (int u = c.bid; u < 2 * 128; u += c.nb) {
            const int layer = u >> 7, slab = u & 127, k0 = slab * 16;
            __syncthreads();
            if (c.tid < 32) { const int k = k0 + (c.tid & 15); lds[c.tid] = silu_f(c.tid < 16 ? c.in[1][k] : c.in[3][k]); }
            __syncthreads();
            const float4* w = (const float4*)(c.in[4] + ((size_t)layer * D + k0) * NMOD);
            float4 ac[6], ax[6];
#pragma unroll
            for (int q = 0; q < 6; ++q) { ac[q] = make_float4(0.f, 0.f, 0.f, 0.f); ax[q] = make_float4(0.f, 0.f, 0.f, 0.f); }
#pragma unroll 4
            for (int r = 0; r < 16; ++r) {
                const float sc = lds[r], sx = lds[16 + r];
#pragma unroll
                for (int q = 0; q < 6; ++q) { const float4 v = w[(size_t)r * (NMOD / 4) + c.tid + 512 * q];
                    ac[q].x = fmaf(sc, v.x, ac[q].x); ac[q].y = fmaf(sc, v.y, ac[q].y); ac[q].z = fmaf(sc, v.z, ac[q].z); ac[q].w = fmaf(sc, v.w, ac[q].w);
                    ax[q].x = fmaf(sx, v.x, ax[q].x); ax[q].y = fmaf(sx, v.y, ax[q].y); ax[q].z = fmaf(sx, v.z, ax[q].z); ax[q].w = fmaf(sx, v.w, ax[q].w); }
            }
            float4* pc = (float4*)(PART + ((size_t)(layer * 128 + slab) * 2 + 0) * NMOD), *px = (float4*)(PART + ((size_t)(layer * 128 + slab) * 2 + 1) * NMOD);
#pragma unroll
            for (int q = 0; q < 6; ++q) { pc[c.tid + 512 * q] = ac[q]; px[c.tid + 512 * q] = ax[q]; }
        }
    }
    for (size_t e = (size_t)c.bid * NTHREADS + c.tid; e < (size_t)2 * 4096 * 256; e += (size_t)c.nb * NTHREADS) {
        const int k = (int)(e & 255), col = (int)((e >> 8) & 4095), layer = (int)(e >> 20);
        c.wsp<bf16_t>(WS_FW3T)[e] = k < 64 ? f2bf(c.in[14][((size_t)layer * 64 + k) * 4096 + col]) : (bf16_t)0;
    }
    const int gw = c.bid * 8 + c.wave, ngw = c.nb * 8;
    for (int task = gw; task < 2 * MR; task += ngw) {
        const int layer = task / MR, pos = task % MR;
        const bool isc = pos >= L; const int i = isc ? pos - L : pos; const int Lx = isc ? LC : L;
        const float tt = (float)i * (1.0f / (float)(Lx - 1));
        const float c0 = (float)(2.0 * 3.14159265358979323846 / (double)Lx);
        const int j = c.lane;
        float feat = 0.f;
        if (j == 0) feat = tt;
        else if (j < 33) { const int b = (j - 1) & 15; const float band = 1e-4f + (float)b * ((15.0f - 1e-4f) / 15.0f); const float ang = (c0 * band) * (float)i; feat = (j <= 16) ? cosf(ang) : -sinf(ang); }
        const float* fw1 = c.in[10] + (size_t)layer * 33 * 64; const float* fb1 = c.in[11] + layer * 64;
        const float* fw2 = c.in[12] + (size_t)layer * 64 * 64; const float* fb2 = c.in[13] + layer * 64;
        const float* fr = c.in[15] + layer * 128;
        float s = fb1[j];
        for (int f = 0; f < 33; ++f) s = fmaf(__shfl(feat, f), fw1[f * 64 + j], s);
        const float h1 = sinf(fr[j] * s);
        float s2 = fb2[j];
        for (int m = 0; m < 64; ++m) s2 = fmaf(__shfl(h1, m), fw2[m * 64 + j], s2);
        const float h2 = sinf(fr[64 + j] * s2);
        bf16_t* hb = c.wsp<bf16_t>(WS_H2B) + ((size_t)layer * MR + pos) * 256;
        hb[j] = f2bf(h2); hb[64 + j] = 0; hb[128 + j] = 0; hb[192 + j] = 0;
    }
}

__device__ __forceinline__ void ph_g0b(const Ctx& c) {
    const float* PART = c.wsp<float>(WS_MODPART);
    for (int i = c.bid * NTHREADS + c.tid; i < 2 * 2 * (NMOD / 4); i += c.nb * NTHREADS) {
        const int n4 = i % (NMOD / 4), ls = i / (NMOD / 4), layer = ls >> 1, src = ls & 1;
        float4 a = *(const float4*)(c.in[5] + (size_t)layer * NMOD + 4 * n4);
#pragma unroll 8
        for (int sl = 0; sl < 128; ++sl) { const float4 v = *(const float4*)(PART + ((size_t)(layer * 128 + sl) * 2 + src) * NMOD + 4 * n4); a.x += v.x; a.y += v.y; a.z += v.z; a.w += v.w; }
        *(float4*)(c.wsp<float>(WS_MOD) + (size_t)(layer * 2 + src) * NMOD + 4 * n4) = a;
    }
}

__device__ __forceinline__ void ph_a(const Ctx& c, int layer) {
    const int gw = c.bid * 8 + c.wave, ngw = c.nb * 8;
    const float* g = c.in[6] + (size_t)layer * D;
    float* gl = (float*)c.smem;
    __syncthreads();
    for (int i = c.tid; i < D; i += NTHREADS) { gl[i] = g[i]; gl[D + i] = c.mod(layer, 0, 0)[i]; gl[2 * D + i] = c.mod(layer, 0, 1)[i]; }
    __syncthreads();
    for (int r = gw; r < MR; r += ngw) {
        const float* x = c.xrow(layer, r);
        const bool lat = r < L;
        const float* shg = c.mod(layer, 1, 0); const float* scg = c.mod(layer, 1, 1);
        float4 v[8]; float ss = 0.f;
#pragma unroll
        for (int j = 0; j < 8; ++j) { v[j] = *(const float4*)(x + 4 * c.lane + 256 * j); ss += v[j].x * v[j].x + v[j].y * v[j].y + v[j].z * v[j].z + v[j].w * v[j].w; }
        ss = wave_sum(ss);
        const float inv = rsqrtf(ss * (1.0f / D) + RMS_EPS);
        bf16_t* o = c.wsp<bf16_t>(WS_HX) + (size_t)r * D;
#pragma unroll
        for (int j = 0; j < 8; ++j) {
            const int col = 4 * c.lane + 256 * j;
            const float4 gg = *(const float4*)(gl + col);
            const float4 s4 = lat ? *(const float4*)(gl + D + col) : *(const float4*)(shg + col);
            const float4 c4 = lat ? *(const float4*)(gl + 2 * D + col) : *(const float4*)(scg + col);
            const float y0 = v[j].x * inv * gg.x * (1.f + c4.x) + s4.x, y1 = v[j].y * inv * gg.y * (1.f + c4.y) + s4.y;
            const float y2 = v[j].z * inv * gg.z * (1.f + c4.z) + s4.z, y3 = v[j].w * inv * gg.w * (1.f + c4.w) + s4.w;
            uint2 w; w.x = pk2(y0, y1); w.y = pk2(y2, y3);
            *(uint2*)(o + col) = w;
        }
    }
}

struct EpiIn {
    unsigned char* ws;
    __device__ __forceinline__ void operator()(int row, int col, const float (&v)[8]) const {
        if (col < OFF_WAQ) {
            bf16_t* d = (bf16_t*)(ws + WS_ZHYT);
#pragma unroll
            for (int j = 0; j < 8; ++j) d[(size_t)(col + j) * MR + row] = f2bf(v[j]);
            return;
        }
        bf16_t* dst; float t[8];
#pragma unroll
        for (int j = 0; j < 8; ++j) t[j] = v[j];
        if (col < OFF_WAKV) dst = (bf16_t*)(ws + WS_QWA) + (size_t)row * 1024 + (col - OFF_WAQ);
        else if (col < OFF_NAQ) dst = (bf16_t*)(ws + WS_KVWA) + (size_t)row * 512 + (col - OFF_WAKV);
        else if (col < OFF_NAKV) dst = (bf16_t*)(ws + WS_QNA) + (size_t)row * 1024 + (col - OFF_NAQ);
        else if (col < OFF_GATE) dst = (bf16_t*)(ws + WS_KVNA) + (size_t)row * 2048 + (col - OFF_NAKV);
        else { dst = (bf16_t*)(ws + WS_GATE) + (size_t)row * 6144 + (col - OFF_GATE);
#pragma unroll
            for (int j = 0; j < 8; ++j) t[j] = sigmoid_f(t[j]); }
        uint4 o; o.x = pk2(t[0], t[1]); o.y = pk2(t[2], t[3]); o.z = pk2(t[4], t[5]); o.w = pk2(t[6], t[7]);
        *(uint4*)dst = o;
    }
};
__device__ __forceinline__ void ph_b(const Ctx& c, int layer) {
    const RowLin rp{c.wsp<bf16_t>(WS_HX), D};
    const EpiIn ep{c.ws};
    const float* W = c.in[7] + (size_t)layer * D * NIN;
    const int nM = MR / 128, nN = NIN / 128;
    for (int u = c.bid; u < nM * nN; u += c.nb) {
        const int pm = u % nM, pn = u / nM;
        sgemm_unit(rp, W, NIN, D, pm * 128, pn * 128, ep, (float*)c.smem, c.tid);
    }
}

__device__ __forceinline__ void b2_segment(bf16_t* p, const float* gain, bool rope, int r, int lane, bool active) {
    uint4 w = make_uint4(0u, 0u, 0u, 0u);
    if (active) w = *(const uint4*)(p + 8 * lane);
    float x[8] = {__uint_as_float(w.x << 16), __uint_as_float(w.x & 0xffff0000u), __uint_as_float(w.y << 16), __uint_as_float(w.y & 0xffff0000u),
                  __uint_as_float(w.z << 16), __uint_as_float(w.z & 0xffff0000u), __uint_as_float(w.w << 16), __uint_as_float(w.w & 0xffff0000u)};
    float ss = 0.f;
#pragma unroll
    for (int i = 0; i < 8; ++i) ss += x[i] * x[i];
    ss += __shfl_xor(ss, 1); ss += __shfl_xor(ss, 2); ss += __shfl_xor(ss, 4); ss += __shfl_xor(ss, 8);
    const float inv = rsqrtf(ss * (1.0f / 128.0f) + RMS_EPS);
    const int d0 = (lane & 15) * 8;
    const float4 g0 = *(const float4*)(gain + d0), g1 = *(const float4*)(gain + d0 + 4);
    const float gg[8] = {g0.x, g0.y, g0.z, g0.w, g1.x, g1.y, g1.z, g1.w};
#pragma unroll
    for (int i = 0; i < 8; ++i) x[i] = x[i] * inv * gg[i];
    if (rope) {
        const int axis = d0 >> 6, half = (d0 >> 5) & 1, f0 = d0 & 31;
        const float pos = axis == 0 ? (float)(r / GRIDW) : (float)(r % GRIDW);
#pragma unroll
        for (int i = 0; i < 8; ++i) {
            const float other = __shfl_xor(x[i], 4);
            const float ang = pos * powf(10000.0f, -(float)(f0 + i) / 32.0f);
            float sn, cs; sincosf(ang, &sn, &cs);
            x[i] = half == 0 ? x[i] * cs - other * sn : x[i] * cs + other * sn;
        }
    }
    if (active) { uint4 o; o.x = pk2(x[0], x[1]); o.y = pk2(x[2], x[3]); o.z = pk2(x[4], x[5]); o.w = pk2(x[6], x[7]); *(uint4*)(p + 8 * lane) = o; }
}
__device__ __forceinline__ void ph_b2(const Ctx& c, int layer) {
    const int gw = c.bid * 8 + c.wave, ngw = c.nb * 8;
    const int lane = c.lane;
    for (int r = gw; r < MR; r += ngw) {
        const bool lat = r < L;
        b2_segment(c.wsp<bf16_t>(WS_QWA) + (size_t)r * 1024, c.in[18] + layer * 128, lat, r, lane, true);
        b2_segment(c.wsp<bf16_t>(WS_QWA) + (size_t)r * 1024 + 512, c.in[18] + layer * 128, lat, r, lane, true);
        b2_segment(c.wsp<bf16_t>(WS_KVWA) + (size_t)r * 512, c.in[19] + layer * 128, lat, r, lane, lane < 32);
        b2_segment(c.wsp<bf16_t>(WS_QNA) + (size_t)r * 1024, c.in[21] + layer * 128, false, r, lane, true);
        b2_segment(c.wsp<bf16_t>(WS_QNA) + (size_t)r * 1024 + 512, c.in[21] + layer * 128, false, r, lane, true);
        b2_segment(c.wsp<bf16_t>(WS_KVNA) + (size_t)r * 2048, c.in[22] + layer * 128, false, r, lane, true);
        b2_segment(c.wsp<bf16_t>(WS_KVNA) + (size_t)r * 2048 + 512, c.in[22] + layer * 128, false, r, lane, true);
    }
}

__device__ __forceinline__ float shortconv_at(const bf16_t* z, int t, int Lx, float w0, float w1, float w2, float b) {
    const float zm = t > 0 ? bf2f(z[t - 1]) : 0.f, z0 = bf2f(z[t]), zp = t + 1 < Lx ? bf2f(z[t + 1]) : 0.f;
    return zm * w0 + z0 * w1 + zp * w2 + b;
}
__device__ __forceinline__ float block_sum(float v, float* red, int tid) {
    v = wave_sum(v);
    __syncthreads();
    if ((tid & 63) == 0) red[tid >> 6] = v;
    __syncthreads();
    float t = 0.f;
#pragma unroll
    for (int w = 0; w < 8; ++w) t += red[w];
    return t;
}
__device__ __forceinline__ void hyena_direct_unit(const Ctx& c, int layer, int ch) {
    bf16_t* kc = (bf16_t*)c.smem;
    float* cv = (float*)c.smem;
    float* us = (float*)(c.smem + 4 * L);
    float* red = us + L;
    const int tid = c.tid;
    const float* cw = c.in[8] + (size_t)layer * 3 * 3072; const float* cb = c.in[9] + (size_t)layer * 3072;
    const bf16_t* zv = c.wsp<bf16_t>(WS_ZHYT) + (size_t)ch * MR;
    const bf16_t* z1 = c.wsp<bf16_t>(WS_ZHYT) + (size_t)(1024 + ch) * MR;
    const bf16_t* z2 = c.wsp<bf16_t>(WS_ZHYT) + (size_t)(2048 + ch) * MR;
    const bf16_t* KF = c.wsp<bf16_t>(WS_KF);
    __syncthreads();
    { const float w0 = cw[ch], w1 = cw[3072 + ch], w2 = cw[6144 + ch], b = cb[ch];
#pragma unroll 2
      for (int t = tid; t < L; t += NTHREADS) us[t] = shortconv_at(zv, t, L, w0, w1, w2, b); }
    for (int o = 0; o < 2; ++o) {
        const bf16_t* hf = KF + (size_t)(o * 1024 + ch) * L;
        const bf16_t* hb = KF + (size_t)(2048 + o * 1024 + ch) * L;
        float sabs = 0.f;
#pragma unroll 2
        for (int t = tid; t < L; t += NTHREADS) {
            bf16_t kf = hf[t], kb = hb[t];
            if (t == 0) { kf = f2bf(bf2f(kf) + bf2f(kb)); kb = 0; }
            kc[L + t] = kf; kc[L - t] = (t == 0) ? kf : kb;
            sabs += fabsf(bf2f(kf)) + fabsf(bf2f(kb));
        }
        if (tid == 0) kc[0] = 0;
        const float S = block_sum(sabs, red, tid);
        {
            float acc[32];
#pragma unroll
            for (int j = 0; j < 32; ++j) acc[j] = 0.f;
#pragma unroll 2
            for (int s = 0; s < L; ++s) {
                const float uv = us[s];
                const bf16_t* kp = kc + (L + tid - s);
#pragma unroll
                for (int j = 0; j < 32; ++j) acc[j] = fmaf(uv, bf2f(kp[512 * j]), acc[j]);
            }
            __syncthreads();
#pragma unroll
            for (int j = 0; j < 32; ++j) cv[tid + 512 * j] = acc[j];
        }
        LDS_FENCE();
        const float invS = 1.0f / S;
        const float dsk = c.in[17][(size_t)layer * 2048 + o * 1024 + ch];
        const int co = o == 0 ? 1024 : 2048;
        const bf16_t* zz = o == 0 ? z1 : z2;
        const float w0 = cw[co + ch], w1 = cw[3072 + co + ch], w2 = cw[6144 + co + ch], b = cb[co + ch];
        bf16_t* dst = c.wsp<bf16_t>(WS_YHYT) + (size_t)ch * L;
#pragma unroll 2
        for (int t = tid; t < L; t += NTHREADS) {
            const float r = shortconv_at(zz, t, L, w0, w1, w2, b) * (cv[t] * invS + us[t] * dsk);
            if (o == 0) us[t] = r; else dst[t] = f2bf(r);
        }
        __syncthreads();
    }
}
__device__ __forceinline__ void hyena_ctx_unit(const Ctx& c, int layer, int ch) {
    float* kc = (float*)c.smem;
    float* us = kc + 512;
    float* red = us + 256;
    const int tid = c.tid;
    const float* cw = c.in[8] + (size_t)layer * 3 * 3072; const float* cb = c.in[9] + (size_t)layer * 3072;
    const bf16_t* zv = c.wsp<bf16_t>(WS_ZHYT) + (size_t)ch * MR + L;
    const bf16_t* z1 = c.wsp<bf16_t>(WS_ZHYT) + (size_t)(1024 + ch) * MR + L;
    const bf16_t* z2 = c.wsp<bf16_t>(WS_ZHYT) + (size_t)(2048 + ch) * MR + L;
    const bf16_t* KF = c.wsp<bf16_t>(WS_KFC);
    __syncthreads();
    if (tid < LC) us[tid] = shortconv_at(zv, tid, LC, cw[ch], cw[3072 + ch], cw[6144 + ch], cb[ch]);
    for (int o = 0; o < 2; ++o) {
        const bf16_t* hf = KF + (size_t)(o * 1024 + ch) * LC;
        const bf16_t* hb = KF + (size_t)(2048 + o * 1024 + ch) * LC;
        float sabs = 0.f;
        {
            const int lag = tid - 256; float k;
            if (lag == 0) k = bf2f(hf[0]) + bf2f(hb[0]); else if (lag > 0) k = bf2f(hf[lag]); else if (lag > -256) k = bf2f(hb[-lag]); else k = 0.f;
            kc[tid] = k; sabs = fabsf(k);
        }
        const float S = block_sum(sabs, red, tid);
        float acc = 0.f;
        if (tid < LC) for (int s = 0; s < LC; ++s) acc = fmaf(us[s], kc[256 + tid - s], acc);
        const float dsk = c.in[17][(size_t)layer * 2048 + o * 1024 + ch];
        float res = 0.f;
        if (tid < LC) {
            const bf16_t* zz = o == 0 ? z1 : z2; const int co = o == 0 ? 1024 : 2048;
            res = shortconv_at(zz, tid, LC, cw[co + ch], cw[3072 + co + ch], cw[6144 + co + ch], cb[co + ch]) * (acc / S + us[tid] * dsk);
        }
        __syncthreads();
        if (tid < LC) { if (o == 0) us[tid] = res; else c.wsp<bf16_t>(WS_YHY)[(size_t)(L + tid) * 1024 + ch] = f2bf(res); }
        __syncthreads();
    }
}

template <class KeyFn>
__device__ __forceinline__ void wave_attn(const bf16_t* q, int nkeys, const KeyFn& key, bool has_sink, float sink, bf16_t* out, float* wl, int lane) {
    float* qf = wl;
    float* sc = wl + 128;
    qf[2 * lane] = bf2f(q[2 * lane]); qf[2 * lane + 1] = bf2f(q[2 * lane + 1]);
    LDS_FENCE();
    float mx = -3.0e38f;
    for (int j = lane; j < nkeys; j += 64) {
        const bf16_t* kp; const bf16_t* vp; float bias;
        float s = -1e30f;
        if (key(j, kp, vp, bias)) {
            float d = 0.f;
#pragma unroll
            for (int e = 0; e < 128; e += 8) {
                const uint4 kk = *(const uint4*)(kp + e);
                d = fmaf(qf[e + 0], __uint_as_float(kk.x << 16), d); d = fmaf(qf[e + 1], __uint_as_float(kk.x & 0xffff0000u), d);
                d = fmaf(qf[e + 2], __uint_as_float(kk.y << 16), d); d = fmaf(qf[e + 3], __uint_as_float(kk.y & 0xffff0000u), d);
                d = fmaf(qf[e + 4], __uint_as_float(kk.z << 16), d); d = fmaf(qf[e + 5], __uint_as_float(kk.z & 0xffff0000u), d);
                d = fmaf(qf[e + 6], __uint_as_float(kk.w << 16), d); d = fmaf(qf[e + 7], __uint_as_float(kk.w & 0xffff0000u), d);
            }
            s = d * QK_SCALE + bias;
        }
        sc[j] = s; mx = fmaxf(mx, s);
    }
    if (has_sink) mx = fmaxf(mx, sink);
    mx = wave_max(mx);
    float sum = 0.f;
    for (int j = lane; j < nkeys; j += 64) { const float p = __expf(sc[j] - mx); sc[j] = p; sum += p; }
    sum = wave_sum(sum);
    if (has_sink) sum += __expf(sink - mx);
    LDS_FENCE();
    float o0 = 0.f, o1 = 0.f;
    for (int j = 0; j < nkeys; ++j) {
        const float p = sc[j];
        if (p != 0.f) {
            const bf16_t* kp; const bf16_t* vp; float bias;
            key(j, kp, vp, bias);
            const unsigned vv = *(const unsigned*)(vp + 2 * lane);
            o0 = fmaf(p, __uint_as_float(vv << 16), o0); o1 = fmaf(p, __uint_as_float(vv & 0xffff0000u), o1);
        }
    }
    const float inv = 1.0f / sum;
    *(unsigned*)(out + 2 * lane) = pk2(o0 * inv, o1 * inv);
    LDS_FENCE();
}

struct KeyWA {
    const bf16_t* kv; int t, kvh;
    __device__ __forceinline__ bool operator()(int j, const bf16_t*& kp, const bf16_t*& vp, float& bias) const {
        bias = 0.f;
        int row; bool ok = true;
        if (j < 257) { const int kpos = t - 128 + j; ok = kpos >= 0 && kpos < L; row = ok ? kpos : 0; } else row = L + (j - 257);
        kp = kv + (size_t)row * 512 + kvh * 128; vp = kp + 256; return ok;
    }
};
struct KeyCtxWA { const bf16_t* kv; int kvh;
    __device__ __forceinline__ bool operator()(int j, const bf16_t*& kp, const bf16_t*& vp, float& bias) const { bias = 0.f; kp = kv + (size_t)(L + j) * 512 + kvh * 128; vp = kp + 256; return true; } };
struct KeyNA {
    const bf16_t* kv; const float* rpb; int r, qc, r0, cs, h;
    __device__ __forceinline__ bool operator()(int j, const bf16_t*& kp, const bf16_t*& vp, float& bias) const {
        int row;
        if (j < 128) { const int w = j >> 4, kc = cs + (j & 15); row = (r0 + w) * GRIDW + kc;
            const int dr = r0 + w - r + 7; int dc = kc - qc + 15; dc = dc < 0 ? 0 : (dc > 30 ? 30 : dc);
            bias = rpb[(h * 15 + dr) * 31 + dc]; }
        else { row = L + (j - 128); bias = 0.f; }
        kp = kv + (size_t)row * 2048 + h * 128; vp = kp + 1024; return true;
    }
};
struct KeyCtxNA { const bf16_t* kv; int h;
    __device__ __forceinline__ bool operator()(int j, const bf16_t*& kp, const bf16_t*& vp, float& bias) const { bias = 0.f; kp = kv + (size_t)(L + j) * 2048 + h * 128; vp = kp + 1024; return true; } };


#define HYF __device__ __forceinline__
#define HYF_OPAQUE(x) asm volatile("" : "+v"(x))
#define HYF_SB(i) do { if (((i) & 3) == 3) __builtin_amdgcn_sched_barrier(0); } while (0)
namespace hyf {
constexpr int FL = 16384;
constexpr int FPAD = FL + 32 * 16;
typedef float cpx __attribute__((ext_vector_type(2)));
HYF int phys(int p) { return ((p & ~15) | ((p & 15) ^ ((p >> 5) & 15))) + ((p >> 9) << 4); }

#define HYF_C32 {1.0f, 0.98078528040323043f, 0.92387953251128674f, 0.83146961230254524f, 0.70710678118654752f, 0.55557023301960218f, 0.38268343236508978f, 0.19509032201612825f, \
                 0.0f, -0.19509032201612825f, -0.38268343236508978f, -0.55557023301960218f, -0.70710678118654752f, -0.83146961230254524f, -0.92387953251128674f, -0.98078528040323043f}
#define HYF_S32 {0.0f, 0.19509032201612825f, 0.38268343236508978f, 0.55557023301960218f, 0.70710678118654752f, 0.83146961230254524f, 0.92387953251128674f, 0.98078528040323043f, \
                 1.0f, 0.98078528040323043f, 0.92387953251128674f, 0.83146961230254524f, 0.70710678118654752f, 0.55557023301960218f, 0.38268343236508978f, 0.19509032201612825f}

HYF int rev5(int x) { return (int)(__builtin_bitreverse32((unsigned)x) >> 27); }
HYF int rev4(int x) { return (int)(__builtin_bitreverse32((unsigned)x) >> 28); }
HYF cpx cmul(cpx a, cpx t) { return a.xx * t + (cpx){-a.y, a.y} * t.yx; }
HYF cpx cmulc(cpx a, cpx t) { return t.xx * a + t.yy * (cpx){a.y, -a.x}; }

template <int N, int SG, int BASE, int STRIDE32>
struct DifStage {
    static HYF void run(cpx (&v)[32], const float (&K)[9]) {
        constexpr int H = N / 2;
#pragma unroll
        for (int j = 0; j < H; ++j) {
            const cpx a = v[BASE + j], b = v[BASE + j + H];
            v[BASE + j] = a + b;
            const cpx d = a - b;
            const int tw = j * STRIDE32;
            if (tw == 0) v[BASE + j + H] = d;
            else if (tw == 8) v[BASE + j + H] = (SG < 0) ? (cpx){d.y, -d.x} : (cpx){-d.y, d.x};
            else {
                const float c = (tw < 8) ? K[tw] : -K[16 - tw];
                const float sa = (tw < 8) ? K[8 - tw] : K[tw - 8];
                const float s = (SG < 0) ? -sa : sa;
                v[BASE + j + H] = d * c + (cpx){-d.y, d.x} * s;
            }
        }
        if constexpr (N > 2) { DifStage<H, SG, BASE, STRIDE32 * 2>::run(v, K); DifStage<H, SG, BASE + H, STRIDE32 * 2>::run(v, K); }
    }
};
template <int SG> HYF void dft32(cpx (&v)[32], const float (&K0)[9]) { float K[9]; _Pragma("unroll") for (int m = 0; m < 9; ++m) { K[m] = K0[m]; HYF_OPAQUE(K[m]); } DifStage<32, SG, 0, 1>::run(v, K); }
template <int SG> HYF void dft16(cpx (&v)[32], const float (&K0)[9]) { float K[9]; _Pragma("unroll") for (int m = 0; m < 9; ++m) { K[m] = K0[m]; HYF_OPAQUE(K[m]); } DifStage<16, SG, 0, 2>::run(v, K); }

struct ThreadTw { cpx w1;
                  cpx w2;
                  cpx wo;
                  int b1;
                  int b2, n3;
                  int b3[2], sw;
                  float K[9]; };
HYF void tw_addr(int tid, ThreadTw& t) {
    t.b1 = (tid & ~15) | ((tid & 15) ^ ((tid >> 5) & 15));
    t.b2 = (tid >> 4) * 528; t.n3 = tid & 15; t.sw = (tid >> 1) & 15;
    for (int h = 0; h < 2; ++h) { const int g = tid + 512 * h; t.b3[h] = g * 16 + (g >> 5) * 16; }
    constexpr float KK[9] = {1.0f, 0.98078528040323043f, 0.92387953251128674f, 0.83146961230254524f, 0.70710678118654752f, 0.55557023301960218f, 0.38268343236508978f, 0.19509032201612825f, 0.0f};
    for (int m = 0; m < 9; ++m) { t.K[m] = KK[m]; HYF_OPAQUE(t.K[m]); }
}

HYF void fwd_p1(const ThreadTw& tw, cpx (&v)[32], cpx* lds) {
    int b1 = tw.b1; HYF_OPAQUE(b1);
    float wx = tw.w1.x, wy = tw.w1.y; HYF_OPAQUE(wx); HYF_OPAQUE(wy); const cpx w = {wx, wy};
    dft32<-1>(v, tw.K);
    cpx t = {1.f, 0.f};
#pragma unroll
    for (int k1 = 0; k1 < 32; ++k1) {
        lds[b1 + 528 * k1] = cmul(v[rev5(k1)], t);
        t = cmul(t, w);
        HYF_SB(k1);
    }
}
HYF void fwd_p2(const ThreadTw& tw, cpx* lds) {
    int b2 = tw.b2, n3 = tw.n3; HYF_OPAQUE(b2); HYF_OPAQUE(n3);
    float wx = tw.w2.x, wy = tw.w2.y; HYF_OPAQUE(wx); HYF_OPAQUE(wy); const cpx w = {wx, wy};
    cpx v[32];
#pragma unroll
    for (int n2 = 0; n2 < 32; ++n2) v[n2] = lds[b2 + 16 * n2 + (n3 ^ ((n2 >> 1) & 15))];
    dft32<-1>(v, tw.K);
    cpx t = {1.f, 0.f};
#pragma unroll
    for (int k2 = 0; k2 < 32; ++k2) {
        lds[b2 + 16 * k2 + (n3 ^ ((k2 >> 1) & 15))] = cmul(v[rev5(k2)], t);
        t = cmul(t, w);
        HYF_SB(k2);
    }
}
HYF void fwd_p3(int tid, const ThreadTw& tw, const cpx* lds, cpx* ks) {
    HYF_OPAQUE(tid);
#pragma unroll
    for (int h = 0; h < 2; ++h) {
        int b3 = tw.b3[h], sw = tw.sw; HYF_OPAQUE(b3); HYF_OPAQUE(sw);
        cpx v[32];
#pragma unroll
        for (int n3 = 0; n3 < 16; ++n3) v[n3] = lds[b3 + (n3 ^ sw)];
        dft16<-1>(v, tw.K);
#pragma unroll
        for (int k3 = 0; k3 < 16; ++k3) ks[(h * 16 + k3) * 512 + tid] = v[rev4(k3)];
    }
}
HYF void mid_p3(int tid, const ThreadTw& tw, cpx* lds, const cpx* ks) {
    HYF_OPAQUE(tid);
#pragma unroll
    for (int h = 0; h < 2; ++h) {
        int b3 = tw.b3[h], sw = tw.sw; HYF_OPAQUE(b3); HYF_OPAQUE(sw);
        cpx v[32], p[32];
#pragma unroll
        for (int n3 = 0; n3 < 16; ++n3) v[n3] = lds[b3 + (n3 ^ sw)];
        dft16<-1>(v, tw.K);
#pragma unroll
        for (int k3 = 0; k3 < 16; ++k3) p[k3] = cmul(v[rev4(k3)], ks[(h * 16 + k3) * 512 + tid]);
        dft16<1>(p, tw.K);
#pragma unroll
        for (int n3 = 0; n3 < 16; ++n3) lds[b3 + (n3 ^ sw)] = p[rev4(n3)];
    }
}
HYF void inv_p2(const ThreadTw& tw, cpx* lds) {
    int b2 = tw.b2, n3 = tw.n3; HYF_OPAQUE(b2); HYF_OPAQUE(n3);
    float wx = tw.w2.x, wy = tw.w2.y; HYF_OPAQUE(wx); HYF_OPAQUE(wy); const cpx w = {wx, wy};
    cpx v[32];
    cpx t = {1.f, 0.f};
#pragma unroll
    for (int k2 = 0; k2 < 32; ++k2) {
        v[k2] = cmulc(lds[b2 + 16 * k2 + (n3 ^ ((k2 >> 1) & 15))], t);
        t = cmul(t, w);
        HYF_SB(k2);
    }
    dft32<1>(v, tw.K);
#pragma unroll
    for (int n2 = 0; n2 < 32; ++n2) { lds[b2 + 16 * n2 + (n3 ^ ((n2 >> 1) & 15))] = v[rev5(n2)]; HYF_SB(n2); }
}
HYF void inv_p1(const ThreadTw& tw, const cpx* lds, cpx (&out)[32]) {
    int b1 = tw.b1; HYF_OPAQUE(b1);
    float wx = tw.w1.x, wy = tw.w1.y; HYF_OPAQUE(wx); HYF_OPAQUE(wy); const cpx w = {wx, wy};
    cpx v[32];
    cpx t = {1.f, 0.f};
#pragma unroll
    for (int k1 = 0; k1 < 32; ++k1) {
        v[k1] = cmulc(lds[b1 + 528 * k1], t);
        t = cmul(t, w);
        HYF_SB(k1);
    }
    dft32<1>(v, tw.K);
#pragma unroll
    for (int n1 = 0; n1 < 32; ++n1) out[n1] = v[rev5(n1)];
}
HYF cpx opaque_wo(const ThreadTw& tw) { float x = tw.wo.x, y = tw.wo.y; HYF_OPAQUE(x); HYF_OPAQUE(y); return (cpx){x, y}; }
HYF cpx modfac(cpx wo, int n1) {
    constexpr float C64[32] = {1.0f, 0.99518472667219693f, 0.98078528040323043f, 0.95694033573220882f, 0.92387953251128674f, 0.88192126434835505f, 0.83146961230254524f, 0.77301045336273699f,
        0.70710678118654752f, 0.63439328416364549f, 0.55557023301960218f, 0.47139673682599764f, 0.38268343236508978f, 0.29028467725446233f, 0.19509032201612825f, 0.098017140329560604f,
        0.0f, -0.098017140329560604f, -0.19509032201612825f, -0.29028467725446233f, -0.38268343236508978f, -0.47139673682599764f, -0.55557023301960218f, -0.63439328416364549f,
        -0.70710678118654752f, -0.77301045336273699f, -0.83146961230254524f, -0.88192126434835505f, -0.92387953251128674f, -0.95694033573220882f, -0.98078528040323043f, -0.99518472667219693f};
    constexpr float S64[32] = {0.0f, 0.098017140329560604f, 0.19509032201612825f, 0.29028467725446233f, 0.38268343236508978f, 0.47139673682599764f, 0.55557023301960218f, 0.63439328416364549f,
        0.70710678118654752f, 0.77301045336273699f, 0.83146961230254524f, 0.88192126434835505f, 0.92387953251128674f, 0.95694033573220882f, 0.98078528040323043f, 0.99518472667219693f,
        1.0f, 0.99518472667219693f, 0.98078528040323043f, 0.95694033573220882f, 0.92387953251128674f, 0.88192126434835505f, 0.83146961230254524f, 0.77301045336273699f,
        0.70710678118654752f, 0.63439328416364549f, 0.55557023301960218f, 0.47139673682599764f, 0.38268343236508978f, 0.29028467725446233f, 0.19509032201612825f, 0.098017140329560604f};
    return cmul(wo, (cpx){C64[n1], -S64[n1]});
}
}

#undef HYF
#ifndef FAST_HY
#define FAST_HY 1
#endif
__device__ __forceinline__ void hyena_fft_unit(const Ctx& c, int layer, int ch, const hyf::ThreadTw& tw) {
    using namespace hyf;
    cpx* lds = (cpx*)c.smem; float* red = (float*)(c.smem + (size_t)FPAD * 8);
    cpx* ks = c.wsp<cpx>(WS_KS) + (size_t)c.bid * (2 * FL);
    float* ub = (float*)(ks + FL); float* yb = ub + FL;
    const int tid = c.tid;
    const float* cw = c.in[8] + (size_t)layer * 3 * 3072; const float* cb = c.in[9] + (size_t)layer * 3072;
    const bf16_t* zv = c.wsp<bf16_t>(WS_ZHYT) + (size_t)ch * MR;
    const bf16_t* KF = c.wsp<bf16_t>(WS_KF);
    { const float w0 = cw[ch], w1 = cw[3072 + ch], w2 = cw[6144 + ch], b = cb[ch]; int tq = tid; HYF_OPAQUE(tq);
#pragma unroll 4
      for (int j = 0; j < 32; ++j) ub[tq + 512 * j] = shortconv_at(zv, tq + 512 * j, L, w0, w1, w2, b); }
#pragma unroll 1
    for (int o = 0; o < 2; ++o) {
        const bf16_t* hf = KF + (size_t)(o * 1024 + ch) * L;
        const bf16_t* hb = KF + (size_t)(2048 + o * 1024 + ch) * L;
        float S;
        {
            cpx v[32]; float sabs = 0.f; int tq = tid; HYF_OPAQUE(tq);
#pragma unroll
            for (int j = 0; j < 32; ++j) { const int n = tq + 512 * j; const float f = bf2f(hf[n]); const float bb = bf2f(hb[n == 0 ? 0 : L - n]);
                v[j] = (cpx){f + bb, 0.f}; sabs += (n == 0) ? fabsf(f + bb) : fabsf(f) + fabsf(bb); }
            S = block_sum(sabs, red, tid);
            fwd_p1(tw, v, lds); __syncthreads(); fwd_p2(tw, lds); __syncthreads(); fwd_p3(tid, tw, lds, ks); __syncthreads();
        }
        {
            cpx v[32]; int tq = tid; HYF_OPAQUE(tq);
#pragma unroll
            for (int j = 0; j < 32; ++j) v[j] = (cpx){ub[tq + 512 * j], 0.f};
            fwd_p1(tw, v, lds); __syncthreads(); fwd_p2(tw, lds); __syncthreads(); mid_p3(tid, tw, lds, ks); __syncthreads();
            inv_p2(tw, lds); __syncthreads();
            inv_p1(tw, lds, v); __syncthreads();
            HYF_OPAQUE(tq);
#pragma unroll
            for (int j = 0; j < 32; ++j) yb[tq + 512 * j] = v[j].x;
        }
        {
            cpx v[32]; const cpx wo = opaque_wo(tw); int tq = tid; HYF_OPAQUE(tq);
#pragma unroll
            for (int j = 0; j < 32; ++j) { const int n = tq + 512 * j; const float f = bf2f(hf[n]); const float bb = bf2f(hb[n == 0 ? 0 : L - n]);
                const float d = (n == 0) ? f + bb : f - bb; v[j] = modfac(wo, j) * d; }
            fwd_p1(tw, v, lds); __syncthreads(); fwd_p2(tw, lds); __syncthreads(); fwd_p3(tid, tw, lds, ks); __syncthreads();
        }
        {
            cpx v[32]; cpx wo = opaque_wo(tw); int tq = tid; HYF_OPAQUE(tq);
#pragma unroll
            for (int j = 0; j < 32; ++j) v[j] = modfac(wo, j) * ub[tq + 512 * j];
            fwd_p1(tw, v, lds); __syncthreads(); fwd_p2(tw, lds); __syncthreads(); mid_p3(tid, tw, lds, ks); __syncthreads();
            inv_p2(tw, lds); __syncthreads();
            inv_p1(tw, lds, v); __syncthreads();
            const float sc = (0.5f / (float)L) / S; wo = opaque_wo(tw); HYF_OPAQUE(tq);
            const float dsk = c.in[17][(size_t)layer * 2048 + o * 1024 + ch];
            const int co = o == 0 ? 1024 : 2048;
            const bf16_t* zz = c.wsp<bf16_t>(WS_ZHYT) + (size_t)(co + ch) * MR;
            const float w0 = cw[co + ch], w1 = cw[3072 + co + ch], w2 = cw[6144 + co + ch], b = cb[co + ch];
            bf16_t* dst = c.wsp<bf16_t>(WS_YHYT) + (size_t)ch * L;
#pragma unroll
            for (int j = 0; j < 32; ++j) { const int t = tq + 512 * j; const cpx m = modfac(wo, j);
                const float conv = (yb[t] + v[j].x * m.x + v[j].y * m.y) * sc;
                const float r = shortconv_at(zz, t, L, w0, w1, w2, b) * (conv + ub[t] * dsk);
                if (o == 0) ub[t] = r; else dst[t] = f2bf(r); }
        }
    }
}


#ifndef FAST_ATT
#define FAST_ATT 1
#endif
namespace fa {
using bf16x8 = __attribute__((ext_vector_type(8))) short;
using s16x4  = __attribute__((ext_vector_type(4))) short;
using f32x16 = __attribute__((ext_vector_type(16))) float;
using u32x4  = __attribute__((ext_vector_type(4))) unsigned;
constexpr int AD = 128, NW = 8, QBLK = 32, KVBLK = 64;
constexpr float SCALE = 0.088388347648318440f;
constexpr float THR = 8.f;
constexpr size_t SHM_V = KVBLK * AD * 2, SHM_K = KVBLK * AD * 2, SHM_ATTN = 2 * SHM_V + 2 * SHM_K + NW * 64 * 4;
constexpr float NEG = -1e30f;
#define KSWZ(row, colB) ((row) * 256 + ((colB) ^ (((row) & 7) << 4)))
#define SBAR() __builtin_amdgcn_sched_barrier(0)
__device__ __forceinline__ int crow(int r, int hi) { return (r & 3) + 8 * (r >> 2) + 4 * hi; }
__device__ __forceinline__ unsigned cvtpk(float lo, float hi) { unsigned r; asm volatile("v_cvt_pk_bf16_f32 %0, %1, %2" : "=v"(r) : "v"(lo), "v"(hi)); return r; }
__device__ __forceinline__ void partialSM(f32x16& p0, f32x16& p1, float& m_reg, float& mn, float& alpha) {
  constexpr float C = SCALE * 1.4426950408889634f;
  float pmax = p0[0];
#pragma unroll
  for (int r = 1; r < 16; ++r) pmax = fmaxf(pmax, p0[r]);
#pragma unroll
  for (int r = 0; r < 16; ++r) pmax = fmaxf(pmax, p1[r]);
  { auto rr = __builtin_amdgcn_permlane32_swap(__float_as_uint(pmax), __float_as_uint(pmax), false, false);
    pmax = fmaxf(__uint_as_float(rr[0]), __uint_as_float(rr[1])); }
  if (__builtin_expect(__all(pmax - m_reg <= THR / SCALE), 1)) { mn = m_reg; alpha = 1.f; }
  else { mn = fmaxf(m_reg, pmax); alpha = __builtin_amdgcn_exp2f((m_reg - mn) * C); m_reg = mn; }
  const float mnC = -mn * C;
#pragma unroll
  for (int r = 0; r < 16; ++r) p0[r] = fmaf(p0[r], C, mnC);
#pragma unroll
  for (int r = 0; r < 16; ++r) p1[r] = fmaf(p1[r], C, mnC);
#pragma unroll
  for (int r = 0; r < 16; ++r) p0[r] = __builtin_amdgcn_exp2f(p0[r]);
}
__device__ __forceinline__ void finishSM(f32x16& p0, f32x16& p1, float alpha, float& l_reg, bf16x8& pa0, bf16x8& pa1, bf16x8& pa2, bf16x8& pa3) {
#pragma unroll
  for (int r = 0; r < 16; ++r) p1[r] = __builtin_amdgcn_exp2f(p1[r]);
  float ps = 0;
#pragma unroll
  for (int r = 0; r < 16; ++r) ps += p0[r];
#pragma unroll
  for (int r = 0; r < 16; ++r) ps += p1[r];
  { auto rr = __builtin_amdgcn_permlane32_swap(__float_as_uint(ps), __float_as_uint(ps), false, false);
    ps = __uint_as_float(rr[0]) + __uint_as_float(rr[1]); }
  l_reg = l_reg * alpha + ps;
#define PK4(P, BASE, OUT) do { unsigned a0 = cvtpk(P[BASE + 0], P[BASE + 1]), a1 = cvtpk(P[BASE + 2], P[BASE + 3]);   \
    unsigned b0 = cvtpk(P[BASE + 4], P[BASE + 5]), b1 = cvtpk(P[BASE + 6], P[BASE + 7]);                              \
    auto r0 = __builtin_amdgcn_permlane32_swap(a0, b0, false, false); auto r1 = __builtin_amdgcn_permlane32_swap(a1, b1, false, false); \
    u32x4 w = {r0[0], r1[0], r0[1], r1[1]}; OUT = *reinterpret_cast<bf16x8*>(&w); } while (0)
  PK4(p0, 0, pa0); PK4(p0, 8, pa1); PK4(p1, 0, pa2); PK4(p1, 8, pa3);
#undef PK4
}
__device__ __forceinline__ void qkt(f32x16& p0, f32x16& p1, const char* Ks, const bf16x8* qr, int r32, int hi) {
  p0 = f32x16{}; p1 = f32x16{};
#pragma unroll
  for (int d0 = 0; d0 < 8; ++d0) { const int cb = (d0 * 16 + hi * 8) * 2;
    const bf16x8 b0 = *reinterpret_cast<const bf16x8*>(Ks + KSWZ(r32, cb));
    const bf16x8 b1 = *reinterpret_cast<const bf16x8*>(Ks + KSWZ(32 + r32, cb));
    p0 = __builtin_amdgcn_mfma_f32_32x32x16_bf16(b0, qr[d0], p0, 0, 0, 0);
    p1 = __builtin_amdgcn_mfma_f32_32x32x16_bf16(b1, qr[d0], p1, 0, 0, 0); }
}
__device__ __forceinline__ int v_st(int k, int c) { const int kk = (k & ~0xC) | ((k & 4) << 1) | ((k & 8) >> 1); return ((kk >> 3) * 4 + (c >> 5)) * 512 + ((kk & 7) * 32 + (c & 31)) * 2; }
__device__ __forceinline__ int v_rd_base(int lane) { return ((lane & 3) << 3) | (((lane >> 2) & 3) << 6) | (((lane >> 4) & 1) << 5) | (((lane >> 5) & 1) << 8); }
constexpr int v_rd_off(int d0, int ks, int half) { return d0 * 512 + ks * 4096 + half * 2048; }
template <int OFF> __device__ __forceinline__ s16x4 tr_read(int vb) { s16x4 r; asm volatile("ds_read_b64_tr_b16 %0, %1 offset:%2" : "=&v"(r) : "v"(vb), "i"(OFF) : "memory"); return r; }
template <int D0> __device__ __forceinline__ void pv_one(f32x16& od, int vb, bf16x8 pa0, bf16x8 pa1, bf16x8 pa2, bf16x8 pa3) {
  const s16x4 l0 = tr_read<v_rd_off(D0, 0, 0)>(vb), h0 = tr_read<v_rd_off(D0, 0, 1)>(vb), l1 = tr_read<v_rd_off(D0, 1, 0)>(vb), h1 = tr_read<v_rd_off(D0, 1, 1)>(vb);
  const s16x4 l2 = tr_read<v_rd_off(D0, 2, 0)>(vb), h2 = tr_read<v_rd_off(D0, 2, 1)>(vb), l3 = tr_read<v_rd_off(D0, 3, 0)>(vb), h3 = tr_read<v_rd_off(D0, 3, 1)>(vb);
  asm volatile("s_waitcnt lgkmcnt(0)" ::: "memory"); SBAR();
#define PK(Lo, Hi) (bf16x8){Lo[0], Lo[1], Lo[2], Lo[3], Hi[0], Hi[1], Hi[2], Hi[3]}
  od = __builtin_amdgcn_mfma_f32_32x32x16_bf16(pa0, PK(l0, h0), od, 0, 0, 0);
  od = __builtin_amdgcn_mfma_f32_32x32x16_bf16(pa1, PK(l1, h1), od, 0, 0, 0);
  od = __builtin_amdgcn_mfma_f32_32x32x16_bf16(pa2, PK(l2, h2), od, 0, 0, 0);
  od = __builtin_amdgcn_mfma_f32_32x32x16_bf16(pa3, PK(l3, h3), od, 0, 0, 0);
#undef PK
}
__device__ __forceinline__ void pv_d0(f32x16* o, int vb, bf16x8 pa0, bf16x8 pa1, bf16x8 pa2, bf16x8 pa3) {
  pv_one<0>(o[0], vb, pa0, pa1, pa2, pa3); pv_one<1>(o[1], vb, pa0, pa1, pa2, pa3); pv_one<2>(o[2], vb, pa0, pa1, pa2, pa3); pv_one<3>(o[3], vb, pa0, pa1, pa2, pa3);
}

template <class Tiles>
__device__ __forceinline__ void attn_unit(const bf16_t* __restrict__ Qb, int ldq, const bf16_t* __restrict__ Kb, const bf16_t* __restrict__ Vb, int ldk,
                                          bf16_t* __restrict__ Ob, int ldo, const Tiles& T, int NT, bool has_sink, float sink, char* lds) {
  int tid = threadIdx.x; asm volatile("" : "+v"(tid));
  const int wid = __builtin_amdgcn_readfirstlane(tid >> 6), lane = tid & 63, r32 = lane & 31, hi = lane >> 5;
  char* V_lds = lds; char* K_lds = lds + 2 * SHM_V;
  float* ws = (float*)(lds + 2 * SHM_V + 2 * SHM_K) + wid * 64; float* li_l = ws; float* al_l = ws + 32;
  float m_reg = -1e30f, l_reg = 0; f32x16 o[4] = {}; bf16x8 qr[8];
  const bf16_t* Qw = Qb + (long)(wid * QBLK + r32) * ldq + hi * 8;
#pragma unroll
  for (int d0 = 0; d0 < 8; ++d0) qr[d0] = *reinterpret_cast<const bf16x8*>(Qw + d0 * 16);
  const int sr = tid >> 4, sc = (tid & 15) * 8, vst0 = v_st(sr, sc), vst1 = v_st(32 + sr, sc);
  const int vb0 = (int)(uintptr_t)V_lds + v_rd_base(lane);
  bf16x8 vs0, vs1, ks0, ks1;
#define SLOAD(j) do { const long _k0 = T.row(j); vs0 = *reinterpret_cast<const bf16x8*>(&Vb[(_k0 + sr) * ldk + sc]); vs1 = *reinterpret_cast<const bf16x8*>(&Vb[(_k0 + 32 + sr) * ldk + sc]); \
    ks0 = *reinterpret_cast<const bf16x8*>(&Kb[(_k0 + sr) * ldk + sc]); ks1 = *reinterpret_cast<const bf16x8*>(&Kb[(_k0 + 32 + sr) * ldk + sc]); } while (0)
#define SWRITE(b) do { *(bf16x8*)(V_lds + (b) * SHM_V + vst0) = vs0; *(bf16x8*)(V_lds + (b) * SHM_V + vst1) = vs1; const int kc = sc * 2; \
    *(bf16x8*)(K_lds + (b) * SHM_K + KSWZ(sr, kc)) = ks0; *(bf16x8*)(K_lds + (b) * SHM_K + KSWZ(32 + sr, kc)) = ks1; } while (0)
  __syncthreads();
  SLOAD(0); asm volatile("s_waitcnt vmcnt(0)" ::: "memory"); SWRITE(0);
  if (1 < NT) SLOAD(1);
#pragma unroll 1
  for (int j = 0; j < NT; ++j) {
    const int b = j & 1;
    __syncthreads();
    if (j + 1 < NT) { asm volatile("s_waitcnt vmcnt(0)" ::: "memory"); SWRITE(b ^ 1); if (j + 2 < NT) SLOAD(j + 2); }
    if (T.active(j, wid)) {
      f32x16 p0, p1; float mn, alpha; bf16x8 pa0, pa1, pa2, pa3;
      qkt(p0, p1, K_lds + b * SHM_K, qr, r32, hi); T.mask(p0, p1, j, wid, r32, hi);
      partialSM(p0, p1, m_reg, mn, alpha);
      if (__any(alpha < 1.f)) { if (hi == 0) al_l[r32] = alpha; asm volatile("s_waitcnt lgkmcnt(0)" ::: "memory");
#pragma unroll
        for (int d = 0; d < 4; ++d)
#pragma unroll
          for (int r = 0; r < 16; ++r) o[d][r] *= al_l[crow(r, hi)]; }
      finishSM(p0, p1, alpha, l_reg, pa0, pa1, pa2, pa3); SBAR();
      pv_d0(o, vb0 + b * (int)SHM_V, pa0, pa1, pa2, pa3);
    }
  }
  if (has_sink) { constexpr float C = SCALE * 1.4426950408889634f; l_reg += __builtin_amdgcn_exp2f(fmaf(sink, 1.4426950408889634f, -m_reg * C)); }
  if (hi == 0) li_l[r32] = l_reg; asm volatile("s_waitcnt lgkmcnt(0)" ::: "memory");
  float rli[16];
#pragma unroll
  for (int r = 0; r < 16; ++r) rli[r] = __builtin_amdgcn_rcpf(li_l[crow(r, hi)]);
  bf16_t* Ow = Ob + (long)(wid * QBLK) * ldo;
#pragma unroll
  for (int r = 0; r < 16; ++r) { const int orow = crow(r, hi);
#pragma unroll
    for (int d0 = 0; d0 < 4; ++d0) Ow[(long)orow * ldo + d0 * 32 + r32] = f2bf(o[d0][r] * rli[r]); }
#undef SLOAD
#undef SWRITE
}
#undef KSWZ
#undef SBAR

struct TilesGen {
  int mode, i0, lo, R, glo, nloc; const float* bias;
  __device__ __forceinline__ long row(int j) const {
    if (j < 4) return L + 64 * j;
    if (mode == 0) return lo + 64 * (j - 4);
    return (long)(glo + (j - 4)) * 64;
  }
  __device__ __forceinline__ bool active(int j, int wid) const {
    if (j < 4 || mode == 2) return true;
    if (mode == 0) { const int Tr = lo + 64 * (j - 4), q0 = i0 + 32 * wid; return Tr + 63 >= q0 - 128 && Tr <= q0 + 31 + 128; }
    const int kr = glo + (j - 4), qr = R + (wid >> 1);
    int r0 = qr - 4; r0 = r0 < 0 ? 0 : (r0 > 248 ? 248 : r0);
    return kr >= r0 && kr <= r0 + 7;
  }
  __device__ __forceinline__ void mask(f32x16& p0, f32x16& p1, int j, int wid, int r32, int hi) const {
    if (j < 4 || mode == 2) return;
    if (mode == 0) {
      const int Tr = lo + 64 * (j - 4), q0 = i0 + 32 * wid;
      if (q0 + 31 - Tr <= 128 && Tr + 63 - q0 <= 128) return;
      const int dq = q0 + r32 - Tr;
#pragma unroll
      for (int r = 0; r < 16; ++r) { const int kk = crow(r, hi); p0[r] = (kk >= dq - 128 && kk <= dq + 128) ? p0[r] : NEG; p1[r] = (kk + 32 >= dq - 128 && kk + 32 <= dq + 128) ? p1[r] : NEG; }
      return;
    }
    const int kr = glo + (j - 4), qr = R + (wid >> 1), qc = (wid & 1) * 32 + r32;
    int cs = qc - 8; cs = cs < 0 ? 0 : (cs > 48 ? 48 : cs);
    const float* bt = bias + (kr - qr + 7) * 32 + (15 - qc);
#pragma unroll
    for (int r = 0; r < 16; ++r) { const int k0 = crow(r, hi), k1 = k0 + 32;
      const bool v0 = (unsigned)(k0 - cs) < 16u, v1 = (unsigned)(k1 - cs) < 16u;
      p0[r] = v0 ? p0[r] + bt[v0 ? k0 : cs] : NEG; p1[r] = v1 ? p1[r] + bt[v1 ? k1 : cs] : NEG; }
  }
};
}

__device__ __forceinline__ void ph_attn_fast(const Ctx& c, int layer) {
  char* lds = (char*)c.smem;
  float* btab = (float*)(c.smem + fa::SHM_ATTN);
  const bf16_t* QWA = c.wsp<bf16_t>(WS_QWA); const bf16_t* KVWA = c.wsp<bf16_t>(WS_KVWA); bf16_t* YWA = c.wsp<bf16_t>(WS_YWA);
  const bf16_t* QNA = c.wsp<bf16_t>(WS_QNA); const bf16_t* KVNA = c.wsp<bf16_t>(WS_KVNA); bf16_t* YNA = c.wsp<bf16_t>(WS_YNA);
  const float* sinkp = c.in[20] + layer * 8; const float* rpb = c.in[23] + (size_t)layer * 8 * 15 * 31;
  const int nq = L / 256;
  const int nunits = 2 * 8 * nq + (layer == 0 ? 16 : 0);
#pragma unroll 1
  for (int u = c.bid; u < nunits; u += c.nb) {
    fa::TilesGen T; T.mode = 2; T.i0 = 0; T.lo = 0; T.R = 0; T.glo = 0; T.nloc = 0; T.bias = btab;
    int h, i0, NT; bool wa;
    if (u < 8 * nq) {
      wa = true; h = u / nq; i0 = (u % nq) * 256;
      const int lo = i0 - 128 < 0 ? 0 : i0 - 128, hiR = i0 + 384 > L ? L : i0 + 384;
      T.mode = 0; T.i0 = i0; T.lo = lo; NT = 4 + (hiR - lo) / 64;
    } else if (u < 16 * nq) {
      const int v = u - 8 * nq; wa = false; h = v / nq; const int qb = v % nq; i0 = qb * 256; const int R = qb * 4;
      int glo = R - 4; glo = glo < 0 ? 0 : (glo > 248 ? 248 : glo);
      int gh = R + 3 - 4; gh = gh < 0 ? 0 : (gh > 248 ? 248 : gh); gh += 7;
      T.mode = 1; T.R = R; T.glo = glo; T.nloc = gh - glo + 1; NT = 4 + T.nloc;
      __syncthreads();
      for (int e = c.tid; e < 15 * 32; e += NTHREADS) { const int dr = e >> 5, dc = e & 31; btab[e] = dc < 31 ? rpb[(h * 15 + dr) * 31 + dc] * (1.0f / fa::SCALE) : 0.f; }
    } else {
      const int v = u - 16 * nq; wa = v < 8; h = v & 7; i0 = L; NT = 4;
    }
    const bf16_t* Q = (wa ? QWA : QNA) + (size_t)i0 * 1024 + h * 128;
    const bf16_t* Kb = wa ? KVWA + (h >> 2) * 128 : KVNA + h * 128;
    const bf16_t* Vb = wa ? KVWA + 256 + (h >> 2) * 128 : KVNA + 1024 + h * 128;
    bf16_t* O = (wa ? YWA : YNA) + (size_t)i0 * 1024 + h * 128;
    fa::attn_unit(Q, 1024, Kb, Vb, wa ? 512 : 2048, O, 1024, T, NT, wa, wa ? sinkp[h] : 0.f, lds);
  }
}

__device__ __forceinline__ void ph_c(const Ctx& c, int layer) {
#ifndef NO_HY
    if (FAST_HY) {
        hyf::ThreadTw tw; hyf::tw_addr(c.tid, tw);
        { float s_, c_; sincospif(-2.0f * (float)c.tid / (float)hyf::FL, &s_, &c_); tw.w1 = (hyf::cpx){c_, s_};
          sincospif(-2.0f * (float)(c.tid & 15) / 512.0f, &s_, &c_); tw.w2 = (hyf::cpx){c_, s_};
          sincospif(-(float)c.tid / (float)hyf::FL, &s_, &c_); tw.wo = (hyf::cpx){c_, s_}; }
        for (int u = c.bid; u < 1024; u += c.nb) hyena_fft_unit(c, layer, u, tw);
        if constexpr (DOREP(16)) { for (int u = c.bid; u < 1024; u += c.nb) hyena_fft_unit(c, layer, u, tw); }
    } else
    for (int u = c.bid; u < 1024; u += c.nb) hyena_direct_unit(c, layer, u);
#endif
#ifndef NO_HYC
    if (layer == 0) for (int u = c.bid; u < 1024; u += c.nb) hyena_ctx_unit(c, layer, u);
#endif
    __syncthreads();
#ifndef NO_ATT
    if (FAST_ATT) { ph_attn_fast(c, layer); return; }
    const int gw = c.bid * 8 + c.wave, ngw = c.nb * 8;
    float* wl = (float*)c.smem + c.wave * 768;
    const int nrows = layer == 0 ? MR : L;
    const float* sinkp = c.in[20] + layer * 8;
    const float* rpb = c.in[23] + (size_t)layer * 8 * 15 * 31;
    const bf16_t* kvwa = c.wsp<bf16_t>(WS_KVWA); const bf16_t* kvna = c.wsp<bf16_t>(WS_KVNA);
    for (int task = gw; task < nrows * 16; task += ngw) {
        const int r = task >> 4, hh = task & 15;
        if (hh < 8) {
            const int h = hh; const bf16_t* q = c.wsp<bf16_t>(WS_QWA) + (size_t)r * 1024 + h * 128; bf16_t* o = c.wsp<bf16_t>(WS_YWA) + (size_t)r * 1024 + h * 128;
            if (r < L) { const KeyWA k{kvwa, r, h >> 2}; wave_attn(q, 513, k, true, sinkp[h], o, wl, c.lane); }
            else { const KeyCtxWA k{kvwa, h >> 2}; wave_attn(q, 256, k, true, sinkp[h], o, wl, c.lane); }
        } else {
            const int h = hh - 8; const bf16_t* q = c.wsp<bf16_t>(WS_QNA) + (size_t)r * 1024 + h * 128; bf16_t* o = c.wsp<bf16_t>(WS_YNA) + (size_t)r * 1024 + h * 128;
            if (r < L) { const int gr = r / GRIDW, qc = r % GRIDW; int r0 = gr - 4; r0 = r0 < 0 ? 0 : (r0 > 248 ? 248 : r0); int cs = qc - 8; cs = cs < 0 ? 0 : (cs > 48 ? 48 : cs);
                const KeyNA k{kvna, rpb, gr, qc, r0, cs, h}; wave_attn(q, 384, k, false, 0.f, o, wl, c.lane); }
            else { const KeyCtxNA k{kvna, h}; wave_attn(q, 256, k, false, 0.f, o, wl, c.lane); }
        }
    }
#endif
}

__device__ __forceinline__ void ph_c2(const Ctx& c) {
    bf16_t* tile = (bf16_t*)c.smem;
    const bf16_t* src = c.wsp<bf16_t>(WS_YHYT); bf16_t* dst = c.wsp<bf16_t>(WS_YHY);
    const int tid = c.tid, a = tid >> 3, b8 = (tid & 7) * 8;
    for (int u = c.bid; u < (1024 / 64) * (L / 64); u += c.nb) {
        const int c0 = (u % 16) * 64, t0 = (u / 16) * 64;
        const uint4 v = *(const uint4*)(src + (size_t)(c0 + a) * L + t0 + b8);
        __syncthreads();
        *(uint4*)(tile + a * 72 + b8) = v;
        __syncthreads();
        unsigned short e[8];
#pragma unroll
        for (int i = 0; i < 8; ++i) e[i] = tile[(b8 + i) * 72 + a];
        uint4 o; o.x = e[0] | ((unsigned)e[1] << 16); o.y = e[2] | ((unsigned)e[3] << 16); o.z = e[4] | ((unsigned)e[5] << 16); o.w = e[6] | ((unsigned)e[7] << 16);
        *(uint4*)(dst + (size_t)(t0 + a) * 1024 + c0 + b8) = o;
    }
}

struct EpiMerge { unsigned char* ws; int b;
    __device__ __forceinline__ void operator()(int row, int col, const float (&v)[8]) const {
        const bf16_t* g = (const bf16_t*)(ws + WS_GATE) + (size_t)row * 6144 + b * 2048 + col;
        float* mp = (float*)(ws + WS_MPART) + (size_t)row * D + col;
        const uint4 gg = *(const uint4*)g;
        const float gv[8] = {__uint_as_float(gg.x << 16), __uint_as_float(gg.x & 0xffff0000u), __uint_as_float(gg.y << 16), __uint_as_float(gg.y & 0xffff0000u),
                             __uint_as_float(gg.z << 16), __uint_as_float(gg.z & 0xffff0000u), __uint_as_float(gg.w << 16), __uint_as_float(gg.w & 0xffff0000u)};
        float t[8];
        if (b == 0) {
#pragma unroll
            for (int j = 0; j < 8; ++j) t[j] = gv[j] * v[j];
        } else {
            const float4 p0 = *(const float4*)mp, p1 = *(const float4*)(mp + 4);
            const float pv[8] = {p0.x, p0.y, p0.z, p0.w, p1.x, p1.y, p1.z, p1.w};
#pragma unroll
            for (int j = 0; j < 8; ++j) t[j] = fmaf(gv[j], v[j], pv[j]);
        }
        if (b < 2) { *(float4*)mp = make_float4(t[0], t[1], t[2], t[3]); *(float4*)(mp + 4) = make_float4(t[4], t[5], t[6], t[7]); }
        else { uint4 o; o.x = pk2(t[0], t[1]); o.y = pk2(t[2], t[3]); o.z = pk2(t[4], t[5]); o.w = pk2(t[6], t[7]); *(uint4*)((bf16_t*)(ws + WS_MB) + (size_t)row * D + col) = o; }
    }
};
__device__ __forceinline__ void ph_d(const Ctx& c, int layer) {
    const int nM = MR / 128, nN = D / 128;
    for (int b = 0; b < 3; ++b) {
        const bf16_t* A = b == 0 ? c.wsp<bf16_t>(WS_YHY) : (b == 1 ? c.wsp<bf16_t>(WS_YWA) : c.wsp<bf16_t>(WS_YNA));
        const RowLin rp{A, 1024}; const EpiMerge ep{c.ws, b};
        const float* W = c.in[24] + ((size_t)layer * 3 + b) * 1024 * D;
        for (int u = c.bid; u < nM * nN; u += c.nb) sgemm_unit(rp, W, D, 1024, (u % nM) * 128, (u / nM) * 128, ep, (float*)c.smem, c.tid);
    }
}
struct EpiOut { const Ctx* c; int layer;
    __device__ __forceinline__ void operator()(int row, int col, const float (&v)[8]) const {
        const float* xin = c->xrow(layer, row) + col; const float* g = c->mod(layer, row < L ? 0 : 1, 2) + col;
        float* o = (float*)(c->ws + WS_XA) + (size_t)row * D + col;
        const float4 x0 = *(const float4*)xin, x1 = *(const float4*)(xin + 4), g0 = *(const float4*)g, g1 = *(const float4*)(g + 4);
        *(float4*)o = make_float4(x0.x + g0.x * v[0], x0.y + g0.y * v[1], x0.z + g0.z * v[2], x0.w + g0.w * v[3]);
        *(float4*)(o + 4) = make_float4(x1.x + g1.x * v[4], x1.y + g1.y * v[5], x1.z + g1.z * v[6], x1.w + g1.w * v[7]);
    }
};
__device__ __forceinline__ void ph_e(const Ctx& c, int layer) {
    const int nM = MR / 128, nN = D / 128;
    const RowLin rp{c.wsp<bf16_t>(WS_MB), D}; const EpiOut ep{&c, layer};
    const float* W = c.in[25] + (size_t)layer * D * D;
    for (int u = c.bid; u < nM * nN; u += c.nb) sgemm_unit(rp, W, D, D, (u % nM) * 128, (u / nM) * 128, ep, (float*)c.smem, c.tid);
}

__device__ __forceinline__ void ph_f(const Ctx& c, int layer) {
    const int gw = c.bid * 8 + c.wave, ngw = c.nb * 8;
    const float* g = c.in[26] + (size_t)layer * D;
    const float* wr = c.in[27] + (size_t)layer * D * NE;
    float* wl = (float*)c.smem; float* gl = wl + NE * D;
    __syncthreads();
    for (int i = c.tid; i < D * NE / 4; i += NTHREADS) { const float4 v = *(const float4*)(wr + 4 * i); const int col = i >> 2, e0 = (i & 3) * 4;
        wl[(e0 + 0) * D + col] = v.x; wl[(e0 + 1) * D + col] = v.y; wl[(e0 + 2) * D + col] = v.z; wl[(e0 + 3) * D + col] = v.w; }
    for (int i = c.tid; i < D; i += NTHREADS) { gl[i] = g[i]; gl[D + i] = c.mod(layer, 0, 3)[i]; gl[2 * D + i] = c.mod(layer, 0, 4)[i]; }
    __syncthreads();
    const int nrows = layer == 0 ? MR : L;
    for (int r = gw; r < nrows; r += ngw) {
        const float* x = c.wsp<float>(WS_XA) + (size_t)r * D;
        const bool lat = r < L;
        const float* shg = c.mod(layer, 1, 3); const float* scg = c.mod(layer, 1, 4);
        float4 v[8]; float ss = 0.f;
#pragma unroll
        for (int j = 0; j < 8; ++j) { v[j] = *(const float4*)(x + 4 * c.lane + 256 * j); ss += v[j].x * v[j].x + v[j].y * v[j].y + v[j].z * v[j].z + v[j].w * v[j].w; }
        ss = wave_sum(ss);
        const float inv = rsqrtf(ss * (1.0f / D) + RMS_EPS);
        bf16_t* o = c.wsp<bf16_t>(WS_H2) + (size_t)r * D;
        float lg[NE];
#pragma unroll
        for (int e = 0; e < NE; ++e) lg[e] = 0.f;
#pragma unroll
        for (int j = 0; j < 8; ++j) {
            const int col = 4 * c.lane + 256 * j;
            const float4 gg = *(const float4*)(gl + col);
            const float4 s4 = lat ? *(const float4*)(gl + D + col) : *(const float4*)(shg + col);
            const float4 c4 = lat ? *(const float4*)(gl + 2 * D + col) : *(const float4*)(scg + col);
            const float y0 = v[j].x * inv * gg.x * (1.f + c4.x) + s4.x, y1 = v[j].y * inv * gg.y * (1.f + c4.y) + s4.y;
            const float y2 = v[j].z * inv * gg.z * (1.f + c4.z) + s4.z, y3 = v[j].w * inv * gg.w * (1.f + c4.w) + s4.w;
            uint2 w; w.x = pk2(y0, y1); w.y = pk2(y2, y3);
            *(uint2*)(o + col) = w;
#pragma unroll
            for (int e = 0; e < NE; ++e) { const float4 w4 = *(const float4*)(wl + e * D + col); lg[e] = fmaf(y0, w4.x, fmaf(y1, w4.y, fmaf(y2, w4.z, fmaf(y3, w4.w, lg[e])))); }
            __builtin_amdgcn_sched_barrier(0);
        }
        float mx = -3e38f;
#pragma unroll
        for (int e = 0; e < NE; ++e) { lg[e] = wave_sum(lg[e]); mx = fmaxf(mx, lg[e]); }
        float sum = 0.f;
#pragma unroll
        for (int e = 0; e < NE; ++e) { lg[e] = expf(lg[e] - mx); sum += lg[e]; }
        float mine = 0.f;
#pragma unroll
        for (int e = 0; e < NE; ++e) mine = (c.lane == e) ? lg[e] / sum : mine;
        if (c.lane < NE) c.wsp<float>(WS_AFF)[(size_t)r * NE + c.lane] = mine;
    }
}

__device__ __forceinline__ void topk_unit(const Ctx& c, int e, int row0, int n, int K, int slot0) {
    unsigned* sh = (unsigned*)c.smem;
    const int tid = c.tid, lane = c.lane, wave = c.wave;
    const float* aff = c.wsp<float>(WS_AFF);
    unsigned key[32];
#pragma unroll
    for (int j = 0; j < 32; ++j) { const int t = tid + NTHREADS * j; key[j] = t < n ? __float_as_uint(aff[(size_t)(row0 + t) * NE + e]) : 0u; }
    unsigned T = 0u;
#pragma unroll 1
    for (int bit = 30; bit >= 0; bit -= 2) {
        const unsigned t1 = T | (1u << bit), t2 = T | (2u << bit), t3 = T | (3u << bit);
        unsigned c1 = 0u, c2 = 0u, c3 = 0u;
#pragma unroll
        for (int j = 0; j < 32; ++j) { c1 += key[j] >= t1 ? 1u : 0u; c2 += key[j] >= t2 ? 1u : 0u; c3 += key[j] >= t3 ? 1u : 0u; }
#pragma unroll
        for (int o = 1; o < 64; o <<= 1) { c1 += __shfl_xor(c1, o); c2 += __shfl_xor(c2, o); c3 += __shfl_xor(c3, o); }
        __syncthreads();
        if (lane == 0) { sh[wave] = c1; sh[8 + wave] = c2; sh[16 + wave] = c3; }
        __syncthreads();
        unsigned s1 = 0u, s2 = 0u, s3 = 0u;
#pragma unroll
        for (int w = 0; w < 8; ++w) { s1 += sh[w]; s2 += sh[8 + w]; s3 += sh[16 + w]; }
        T = s3 >= (unsigned)K ? t3 : (s2 >= (unsigned)K ? t2 : (s1 >= (unsigned)K ? t1 : T));
    }
    unsigned ng = 0u, neq = 0u;
#pragma unroll
    for (int j = 0; j < 32; ++j) { ng += key[j] > T ? 1u : 0u; neq += (key[j] == T && tid + NTHREADS * j < n) ? 1u : 0u; }
    unsigned ig = ng, ie = neq;
#pragma unroll
    for (int o = 1; o < 64; o <<= 1) { const unsigned a = __shfl_up(ig, o), b = __shfl_up(ie, o); if (lane >= o) { ig += a; ie += b; } }
    __syncthreads();
    if (lane == 63) { sh[32 + wave] = ig; sh[40 + wave] = ie; }
    __syncthreads();
    unsigned og = 0u, oe = 0u, totg = 0u, tote = 0u;
#pragma unroll
    for (int w = 0; w < 8; ++w) { const unsigned a = sh[32 + w], b = sh[40 + w]; if (w < wave) { og += a; oe += b; } totg += a; tote += b; }
    const unsigned need = (unsigned)K - totg;
    unsigned pg = og + ig - ng;
    int* IDX = c.wsp<int>(WS_IDX) + (size_t)e * SLOTS; float* GS = c.wsp<float>(WS_GSEL) + (size_t)e * SLOTS; int* SL = c.wsp<int>(WS_SLOT) + (size_t)e * MR;
    if (tote == need) {
        unsigned pe = totg + oe + ie - neq;
#pragma unroll
        for (int j = 0; j < 32; ++j) { const int t = tid + NTHREADS * j;
            if (t < n) { int slot = -1; if (key[j] > T) slot = (int)pg++; else if (key[j] == T) slot = (int)pe++;
                SL[row0 + t] = slot >= 0 ? slot0 + slot : -1; if (slot >= 0) { IDX[slot0 + slot] = row0 + t; GS[slot0 + slot] = __uint_as_float(key[j]); } } }
    } else {
        unsigned base_eq = 0u;
#pragma unroll 1
        for (int j = 0; j < 32; ++j) { const int t = tid + NTHREADS * j;
            const unsigned kj = t < n ? __float_as_uint(aff[(size_t)(row0 + t) * NE + e]) : 0u;
            const bool eq = t < n && kj == T;
            const unsigned long long me = __ballot(eq);
            const unsigned long long lower = (lane == 0) ? 0ull : (~0ull >> (64 - lane));
            const unsigned re = (unsigned)__popcll(me & lower);
            __syncthreads();
            if (lane == 0) sh[48 + wave] = (unsigned)__popcll(me);
            __syncthreads();
            unsigned oq = 0u, tq = 0u;
#pragma unroll
            for (int w = 0; w < 8; ++w) { const unsigned a = sh[48 + w]; if (w < wave) oq += a; tq += a; }
            if (t < n) { int slot = -1; if (kj > T) slot = (int)pg++; else if (eq) { const unsigned rk = base_eq + oq + re; if (rk < need) slot = (int)(totg + rk); }
                SL[row0 + t] = slot >= 0 ? slot0 + slot : -1; if (slot >= 0) { IDX[slot0 + slot] = row0 + t; GS[slot0 + slot] = __uint_as_float(kj); } }
            base_eq += tq;
        }
    }
    __syncthreads();
}
__device__ __forceinline__ void ph_g(const Ctx& c, int layer) {
    const int ntop = layer == 0 ? 32 : 16;
    for (int u = c.bid; u < ntop; u += c.nb) {
        if (u < 16) topk_unit(c, u, 0, L, CAP, 0);
        else { const int e = u - 16; topk_unit(c, e, L, LC, CAPC, CAP);
            for (int s = CAP + CAPC + c.tid; s < SLOTS; s += NTHREADS) { c.wsp<int>(WS_IDX)[(size_t)e * SLOTS + s] = 0; c.wsp<float>(WS_GSEL)[(size_t)e * SLOTS + s] = 0.f; } }
    }
    if (c.nb == 256) {
        constexpr int BIG = 25, SMALL = (CONV_NX - 224 * BIG) / 32;
        static_assert(224 * BIG + 32 * SMALL == CONV_NX, "expert conversion split");
        if (c.bid >= 32) ph_conv(c, layer, CONV_NA + (c.bid - 32) * BIG, BIG, 1);
        else ph_conv(c, layer, CONV_NA + 224 * BIG + c.bid * SMALL, SMALL, 1);
    } else ph_conv(c, layer, CONV_NA + c.bid, (CONV_NX - c.bid + c.nb - 1) / c.nb, c.nb);
}

struct EpiGate { float* tmp; __device__ __forceinline__ void operator()(int row, int col, const float (&v)[8]) const {
    float* p = tmp + (size_t)row * DF + col; *(float4*)p = make_float4(v[0], v[1], v[2], v[3]); *(float4*)(p + 4) = make_float4(v[4], v[5], v[6], v[7]); } };
struct EpiUp { const float* tmp; bf16_t* act; __device__ __forceinline__ void operator()(int row, int col, const float (&v)[8]) const {
    const float* p = tmp + (size_t)row * DF + col; const float4 a0 = *(const float4*)p, a1 = *(const float4*)(p + 4);
    const float a[8] = {a0.x, a0.y, a0.z, a0.w, a1.x, a1.y, a1.z, a1.w}; float t[8];
#pragma unroll
    for (int j = 0; j < 8; ++j) t[j] = silu_f(a[j]) * v[j];
    uint4 o; o.x = pk2(t[0], t[1]); o.y = pk2(t[2], t[3]); o.z = pk2(t[4], t[5]); o.w = pk2(t[6], t[7]);
    *(uint4*)(act + (size_t)row * DF + col) = o; } };
struct EpiDown { bf16_t* ye; __device__ __forceinline__ void operator()(int row, int col, const float (&v)[8]) const {
    uint4 o; o.x = pk2(v[0], v[1]); o.y = pk2(v[2], v[3]); o.z = pk2(v[4], v[5]); o.w = pk2(v[6], v[7]);
    *(uint4*)(ye + (size_t)row * D + col) = o; } };
__device__ __forceinline__ void ph_h(const Ctx& c, int layer) {
    const int nM = SLOTS / 128, nN = DF / 128;
    for (int which = 0; which < 2; ++which)
        for (int u = c.bid; u < NE * nM * nN; u += c.nb) {
            const int e = u / (nM * nN), r = u % (nM * nN), pm = r % nM, pn = r / nM;
            const RowGather rp{c.wsp<bf16_t>(WS_H2), D, c.wsp<int>(WS_IDX) + (size_t)e * SLOTS};
            float* tmp = c.wsp<float>(WS_TMP) + (size_t)e * SLOTS * DF;
            const float* W = c.in[which == 0 ? 28 : 29] + ((size_t)layer * NE + e) * D * DF;
            if (which == 0) { const EpiGate ep{tmp}; sgemm_unit(rp, W, DF, D, pm * 128, pn * 128, ep, (float*)c.smem, c.tid); }
            else { const EpiUp ep{tmp, c.wsp<bf16_t>(WS_ACT) + (size_t)e * SLOTS * DF}; sgemm_unit(rp, W, DF, D, pm * 128, pn * 128, ep, (float*)c.smem, c.tid); }
        }
}
__device__ __forceinline__ void ph_i(const Ctx& c, int layer) {
    const int nM = SLOTS / 128, nN = D / 128;
    for (int u = c.bid; u < NE * nM * nN; u += c.nb) {
        const int e = u / (nM * nN), r = u % (nM * nN), pm = r % nM, pn = r / nM;
        const RowLin rp{c.wsp<bf16_t>(WS_ACT) + (size_t)e * SLOTS * DF, DF};
        const EpiDown ep{c.wsp<bf16_t>(WS_YE) + (size_t)e * SLOTS * D};
        const float* W = c.in[30] + ((size_t)layer * NE + e) * DF * D;
        sgemm_unit(rp, W, D, DF, pm * 128, pn * 128, ep, (float*)c.smem, c.tid);
    }
}

__device__ __forceinline__ void ph_j(const Ctx& c, int layer) {
    const int gw = c.bid * 8 + c.wave, ngw = c.nb * 8;
    const int nrows = layer == 0 ? MR : L;
    for (int r = gw; r < nrows; r += ngw) {
        const float* x1 = c.wsp<float>(WS_XA) + (size_t)r * D;
        const float* g5 = c.mod(layer, r < L ? 0 : 1, 5);
        float* o = layer == 0 ? c.wsp<float>(WS_XB) + (size_t)r * D : c.out + (size_t)r * D;
        float acc[32];
#pragma unroll
        for (int j = 0; j < 32; ++j) acc[j] = 0.f;
        for (int e = 0; e < NE; ++e) {
            const int s = c.wsp<int>(WS_SLOT)[(size_t)e * MR + r];
            if (s >= 0) {
                const float gs = c.wsp<float>(WS_GSEL)[(size_t)e * SLOTS + s];
                const bf16_t* y = c.wsp<bf16_t>(WS_YE) + ((size_t)e * SLOTS + s) * D;
#pragma unroll
                for (int j = 0; j < 8; ++j) { const uint2 w = *(const uint2*)(y + 4 * c.lane + 256 * j);
                    acc[4 * j + 0] = fmaf(gs, __uint_as_float(w.x << 16), acc[4 * j + 0]); acc[4 * j + 1] = fmaf(gs, __uint_as_float(w.x & 0xffff0000u), acc[4 * j + 1]);
                    acc[4 * j + 2] = fmaf(gs, __uint_as_float(w.y << 16), acc[4 * j + 2]); acc[4 * j + 3] = fmaf(gs, __uint_as_float(w.y & 0xffff0000u), acc[4 * j + 3]); }
            }
        }
#pragma unroll
        for (int j = 0; j < 8; ++j) { const int col = 4 * c.lane + 256 * j; const float4 xv = *(const float4*)(x1 + col), gv = *(const float4*)(g5 + col);
            *(float4*)(o + col) = make_float4(xv.x + gv.x * acc[4 * j], xv.y + gv.y * acc[4 * j + 1], xv.z + gv.z * acc[4 * j + 2], xv.w + gv.w * acc[4 * j + 3]); }
    }
}


#ifndef FAST_B
#define FAST_B 1
#endif
#ifndef FAST_DE
#define FAST_DE 1
#endif
#ifndef FAST_HI
#define FAST_HI 1
#endif
struct GeomInProj {
    static constexpr bool GATHER = false;
    const char* WIN; const char* HX; int K, lda, ldb; const int* idx;
    __device__ __forceinline__ const char* a_base(const pg8::Unit& u) const { return u.pm >= 1000 ? WIN + (size_t)(u.pm - 1000) * 256 * D * 2 : HX + (size_t)u.pm * 256 * D * 2; }
    __device__ __forceinline__ const char* b_base(const pg8::Unit& u) const { return u.pm >= 1000 ? HX + (size_t)u.pn * 256 * D * 2 : WIN + ((size_t)OFF_WAQ + (size_t)u.pn * 256) * D * 2; }
    __device__ __forceinline__ int row0(const pg8::Unit& u) const { return (u.pm >= 1000 ? u.pm - 1000 : u.pm) * 256; }
};
struct SchedInProj {
    pg8::StaticOrder s0, s1; int G, c;
    __device__ __forceinline__ bool next(int i, pg8::Unit& u) const {
        const long Lq = (long)i * G + c;
        if (Lq < s0.nwg) { s0.at(Lq, u); u.pm += 1000; return true; }
        return s1.at(Lq - s0.nwg, u);
    }
};
struct EpiInProj {
    static constexpr bool PERM = true;
    pg8::EpiBf16Plain e0; pg8::EpiInRest e1;
    __device__ __forceinline__ void operator()(const pg8::f32x4 (&acc)[2][2][4][2], const pg8::Unit& u, int row0, int wr, int wc, int fr, int fq) const {
        if (u.pm >= 1000) { pg8::Unit v = u; v.pm -= 1000; e0(acc, v, row0, wr, wc, fr, fq); } else e1(acc, u, row0, wr, wc, fr, fq);
    }
};
__device__ __forceinline__ void ph_b_fast(const Ctx& c, int layer) {
    LAS unsigned char* lds = (LAS unsigned char*)c.smem;
    const char* WIN = (const char*)(c.ws + WS_WIN); const char* HX = (const char*)(c.ws + WS_HX);
    __syncthreads();
    const GeomInProj G{WIN, HX, D, D, D, nullptr};
    SchedInProj S; S.s0.init(3072 / 256, MR / 256, c.nb, c.bid); S.s1.init(MR / 256, (NIN - OFF_WAQ) / 256, c.nb, c.bid); S.G = c.nb; S.c = c.bid;
    const EpiInProj E{pg8::EpiBf16Plain{c.wsp<bf16_t>(WS_ZHYT), MR, 0}, pg8::EpiInRest{c.ws}};
    pg8::gemm_phase(lds, G, S, E);
}
__device__ __forceinline__ void ph_d_fast(const Ctx& c, int layer) {
    LAS unsigned char* lds = (LAS unsigned char*)c.smem;
    const int nM = layer == 0 ? MR / 256 : L / 256;
    pg8::StaticOrder S; S.init(nM, D / 256, c.nb, c.bid);
    __syncthreads();
    { const pg8::GeomLin G{(const char*)(c.ws + WS_YHY), (const char*)(c.ws + WS_WBR), 1024, 1024, 1024, nullptr}; const pg8::EpiMergeF<0> E{c.ws}; pg8::gemm_phase(lds, G, S, E); }
    { const pg8::GeomLin G{(const char*)(c.ws + WS_YWA), (const char*)(c.ws + WS_WBR) + (size_t)D * 1024 * 2, 1024, 1024, 1024, nullptr}; const pg8::EpiMergeF<1> E{c.ws}; pg8::gemm_phase(lds, G, S, E); }
    { const pg8::GeomLin G{(const char*)(c.ws + WS_YNA), (const char*)(c.ws + WS_WBR) + (size_t)2 * D * 1024 * 2, 1024, 1024, 1024, nullptr}; const pg8::EpiMergeF<2> E{c.ws}; pg8::gemm_phase(lds, G, S, E); }
}
__device__ __forceinline__ void ph_e_fast(const Ctx& c, int layer) {
    LAS unsigned char* lds = (LAS unsigned char*)c.smem;
    const int nM = layer == 0 ? MR / 256 : L / 256;
    pg8::StaticOrder S; S.init(nM, D / 256, c.nb, c.bid);
    __syncthreads();
    const pg8::GeomLin G{(const char*)(c.ws + WS_MB), (const char*)(c.ws + WS_WOUT), D, D, D, nullptr}; const pg8::EpiOutF E{&c, layer};
    pg8::gemm_phase(lds, G, S, E);
}
__device__ __forceinline__ void ph_h_fast(const Ctx& c, int layer) {
    LAS unsigned char* lds = (LAS unsigned char*)c.smem;
    const int tpe = layer == 0 ? 9 : 8;
    pg8::StaticOrder S; S.init(NE * tpe, 2048 / 256, c.nb, c.bid);
    __syncthreads();
    const pg8::GeomExpert<true> G{(const char*)(c.ws + WS_H2), (const char*)(c.ws + WS_WGU), D, D, D, c.wsp<int>(WS_IDX), tpe, 2048};
    const pg8::EpiGU E{c.wsp<bf16_t>(WS_ACT)};
    pg8::gemm_phase(lds, G, S, E);
}
__device__ __forceinline__ void ph_i_fast(const Ctx& c, int layer) {
    LAS unsigned char* lds = (LAS unsigned char*)c.smem;
    const int tpe = layer == 0 ? 9 : 8;
    pg8::StaticOrder S; S.init(NE * tpe, D / 256, c.nb, c.bid);
    __syncthreads();
    const pg8::GeomExpert<false> G{(const char*)(c.ws + WS_ACT), (const char*)(c.ws + WS_WDN), DF, DF, DF, nullptr, tpe, D};
    const pg8::EpiBf16Plain E{c.wsp<bf16_t>(WS_YE), D, 0};
    pg8::gemm_phase(lds, G, S, E);
}

__global__ void __launch_bounds__(NTHREADS, 2) mega(KArgs a) {
    extern __shared__ __attribute__((aligned(16))) unsigned char smem[];
    Ctx c; c.in = a.in; c.out = a.out; c.ws = a.ws; c.bid = blockIdx.x; c.nb = gridDim.x; c.tid = threadIdx.x; c.lane = c.tid & 63;
    c.wave = __builtin_amdgcn_readfirstlane(c.tid >> 6); c.smem = smem;
    volatile LAS unsigned* st = (volatile LAS unsigned*)(LAS unsigned char*)(smem + LDS_BYTES - 16);
    if (c.tid == 0) { st[0] = 0u; st[1] = 0u; st[2] = 0u; st[3] = 0u; }
    __syncthreads();
    const int lo = a.ph_lo, hi = a.ph_hi;
    XcdBarrier bar; bar.bar = (unsigned*)(a.ws + WS_CTL); bar.x = 0; bar.st = st;
    if (hi - lo > 1) bar = xcd_barrier_post((unsigned*)(a.ws + WS_CTL), st);
#ifndef ONLY_PH
#define ONLY_PH -1
#endif
#define PSEL(j) (ONLY_PH < 0 || ONLY_PH == (j))

#define IN(k) (lo <= (k) && (k) < hi)
#define GASP __attribute__((address_space(1)))
#define LAUNDER(cc) Ctx cc = c; asm volatile("" : "+v"(cc.tid), "+v"(cc.lane)); asm volatile("" : "+s"(cc.bid), "+s"(cc.nb), "+s"(cc.wave)); \
    { GASP unsigned char* wg_ = (GASP unsigned char*)cc.ws; GASP float* og_ = (GASP float*)cc.out; asm volatile("" : "+s"(wg_), "+s"(og_)); cc.ws = (unsigned char*)wg_; cc.out = (float*)og_; }
#define SEAM(k) do { if (IN(k) && IN((k) + 1)) xcd_barrier(bar); } while (0)
    if (PSEL(0) && IN(0)) { LAUNDER(cc); ph_g0(cc); if (hi - lo > 1) xcd_barrier(bar); LAUNDER(cd); ph_g0b(cd); } SEAM(0);
#define LAYER_PROGRAM(layer) do { const int b = 1 + (layer) * PH_PER_LAYER; \
        if (PSEL(1) && IN(b + 0)) { LAUNDER(cc); constexpr int ly = (layer); { ph_a(cc, ly); if constexpr (DOREP(15)) { LAUNDER(ce); ph_a(ce, ly); } ph_taps(cc, ly); if constexpr (DOREP(14)) { LAUNDER(ce); ph_taps(ce, ly); } if (FAST_B || FAST_DE || FAST_HI) ph_conv(cc, ly, cc.bid, (CONV_NA - cc.bid + cc.nb - 1) / cc.nb, cc.nb); if constexpr (DOREP(13)) { LAUNDER(ce); ph_conv(ce, ly, ce.bid, (CONV_NA - ce.bid + ce.nb - 1) / ce.nb, ce.nb); } __syncthreads(); } if constexpr (DOREP(1)) { LAUNDER(cd); { Ctx& cc = cd; (void)cc; ph_a(cd, ly); ph_taps(cd, ly); if (FAST_B || FAST_DE || FAST_HI) ph_conv(cd, ly, cd.bid, (CONV_NA - cd.bid + cd.nb - 1) / cd.nb, cd.nb); __syncthreads(); } } } SEAM(b + 0); \
        if (PSEL(2) && IN(b + 1)) { LAUNDER(cc); constexpr int ly = (layer); { if (FAST_B) ph_b_fast(cc, ly); else ph_b(cc, ly); __syncthreads(); } if constexpr (DOREP(2)) { LAUNDER(cd); { Ctx& cc = cd; (void)cc; if (FAST_B) ph_b_fast(cd, ly); else ph_b(cd, ly); __syncthreads(); } } } SEAM(b + 1); \
        if (PSEL(3) && IN(b + 2)) { LAUNDER(cc); constexpr int ly = (layer); ph_b2(cc, ly); } SEAM(b + 2); \
        if (PSEL(4) && IN(b + 3)) { LAUNDER(cc); constexpr int ly = (layer); { ph_c(cc, ly); __syncthreads(); } if constexpr (DOREP(4)) { LAUNDER(cd); { Ctx& cc = cd; (void)cc; ph_c(cd, ly); __syncthreads(); } } } SEAM(b + 3); \
        if (PSEL(5) && IN(b + 4)) { LAUNDER(cc); constexpr int ly = (layer); { ph_c2(cc); __syncthreads(); } if constexpr (DOREP(5)) { LAUNDER(cd); { Ctx& cc = cd; (void)cc; ph_c2(cd); __syncthreads(); } } } SEAM(b + 4); \
        if (PSEL(6) && IN(b + 5)) { LAUNDER(cc); constexpr int ly = (layer); { if (FAST_DE) ph_d_fast(cc, ly); else ph_d(cc, ly); __syncthreads(); } if constexpr (DOREP(6)) { LAUNDER(cd); { Ctx& cc = cd; (void)cc; if (FAST_DE) ph_d_fast(cd, ly); else ph_d(cd, ly); __syncthreads(); } } } SEAM(b + 5); \
        if (PSEL(7) && IN(b + 6)) { LAUNDER(cc); constexpr int ly = (layer); { if (FAST_DE) ph_e_fast(cc, ly); else ph_e(cc, ly); __syncthreads(); } if constexpr (DOREP(7)) { LAUNDER(cd); { Ctx& cc = cd; (void)cc; if (FAST_DE) ph_e_fast(cd, ly); else ph_e(cd, ly); __syncthreads(); } } } SEAM(b + 6); \
        if (PSEL(8) && IN(b + 7)) { LAUNDER(cc); constexpr int ly = (layer); { ph_f(cc, ly); __syncthreads(); } if constexpr (DOREP(8)) { LAUNDER(cd); { Ctx& cc = cd; (void)cc; ph_f(cd, ly); __syncthreads(); } } } SEAM(b + 7); \
        if (PSEL(9) && IN(b + 8)) { LAUNDER(cc); constexpr int ly = (layer); { ph_g(cc, ly); __syncthreads(); } if constexpr (DOREP(9)) { LAUNDER(cd); { Ctx& cc = cd; (void)cc; ph_g(cd, ly); __syncthreads(); } } } SEAM(b + 8); \
        if (PSEL(10) && IN(b + 9)) { LAUNDER(cc); constexpr int ly = (layer); { if (FAST_HI) ph_h_fast(cc, ly); else ph_h(cc, ly); __syncthreads(); } if constexpr (DOREP(10)) { LAUNDER(cd); { Ctx& cc = cd; (void)cc; if (FAST_HI) ph_h_fast(cd, ly); else ph_h(cd, ly); __syncthreads(); } } } SEAM(b + 9); \
        if (PSEL(11) && IN(b + 10)) { LAUNDER(cc); constexpr int ly = (layer); { if (FAST_HI) ph_i_fast(cc, ly); else ph_i(cc, ly); __syncthreads(); } if constexpr (DOREP(11)) { LAUNDER(cd); { Ctx& cc = cd; (void)cc; if (FAST_HI) ph_i_fast(cd, ly); else ph_i(cd, ly); __syncthreads(); } } } SEAM(b + 10); \
        if (PSEL(12) && IN(b + 11)) { LAUNDER(cc); constexpr int ly = (layer); { ph_j(cc, ly); __syncthreads(); } if constexpr (DOREP(12)) { LAUNDER(cd); { Ctx& cc = cd; (void)cc; ph_j(cd, ly); __syncthreads(); } } } SEAM(b + 11); \
    } while (0)
    LAYER_PROGRAM(0);
    LAYER_PROGRAM(1);
#undef LAYER_PROGRAM
#undef IN
#undef SEAM
}

extern "C" void kernel_launch(void* const* d_in, const int* in_sizes, int n_in, void* d_out, int out_size, void* d_ws, size_t ws_size, hipStream_t stream) {
    static int grid = 0;
    if (grid == 0) {
        if (n_in != 31 || out_size != L * D || ws_size < WS_END) { fprintf(stderr, "kernel_launch: unexpected shapes: n_in %d out %d ws %zu (need %zu)\n", n_in, out_size, ws_size, (size_t)WS_END); grid = -1; return; }
        int dev = 0, cus = 0, per_cu = 0;
        if (hipGetDevice(&dev) != hipSuccess || hipDeviceGetAttribute(&cus, hipDeviceAttributeMultiprocessorCount, dev) != hipSuccess) { grid = -1; return; }
        if (hipFuncSetAttribute((const void*)mega, hipFuncAttributeMaxDynamicSharedMemorySize, LDS_BYTES) != hipSuccess) { fprintf(stderr, "kernel_launch: hipFuncSetAttribute failed\n"); grid = -1; return; }
        if (hipOccupancyMaxActiveBlocksPerMultiprocessor(&per_cu, (const void*)mega, NTHREADS, LDS_BYTES) != hipSuccess || per_cu < 1) fprintf(stderr, "kernel_launch: occupancy query says %d\n", per_cu);
        (void)hipGetLastError();
        grid = cus;
    }
    if (grid < 0) return;
    if (hipMemsetAsync((char*)d_ws + WS_CTL, 0, CTL_BYTES, stream) != hipSuccess) return;
    KArgs a{};
    for (int i = 0; i < 31; ++i) a.in[i] = (const float*)d_in[i];
    a.out = (float*)d_out; a.ws = (unsigned char*)d_ws;
#if ONE_LAUNCH
    a.ph_lo = 0; a.ph_hi = NPH;
    hipLaunchKernelGGL(mega, dim3(grid), dim3(NTHREADS), LDS_BYTES, stream, a);
#else
    for (int p = 0; p < NPH; ++p) { a.ph_lo = p; a.ph_hi = p + 1; hipLaunchKernelGGL(mega, dim3(grid), dim3(NTHREADS), LDS_BYTES, stream, a); }
#endif
    const hipError_t le = hipPeekAtLastError();
    if (le != hipSuccess) fprintf(stderr, "kernel_launch: launch failed: %s\n", hipGetErrorName(le));
}
```

```cpp
#include <hip/hip_runtime.h>
#include <stdint.h>
#include <stdio.h>

#ifndef ONE_LAUNCH
#define ONE_LAUNCH 1
#endif

#ifndef REP_MASK
#define REP_MASK 0
#endif
#define DOREP(j) ((((REP_MASK) >> (j)) & 1) != 0)
typedef unsigned short bf16_t;
#define LAS __attribute__((address_space(3)))

constexpr int L = 16384, LC = 256, MR = L + LC, D = 2048, NIN = 13824;
constexpr int HD = 128, GRIDW = 64;
constexpr int OFF_HY = 0, OFF_WAQ = 3072, OFF_WAKV = 4096, OFF_NAQ = 4608, OFF_NAKV = 5632, OFF_GATE = 7680;
constexpr int NE = 16, CAP = 2048, CAPC = 32, SLOTS = 2304, DF = 1024;
constexpr int NMOD = 6 * D;
constexpr float RMS_EPS = 1e-6f;
constexpr float QK_SCALE = 0.08838834764831845f;

constexpr size_t al256(size_t x) { return (x + 255) & ~(size_t)255; }
constexpr size_t WS_CTL = 0, CTL_BYTES = 1u << 20;
constexpr size_t WS_MOD = WS_CTL + CTL_BYTES;
constexpr size_t WS_H2B = WS_MOD + al256((size_t)2 * 2 * NMOD * 4);
constexpr size_t WS_FW3T = WS_H2B + al256((size_t)2 * MR * 256 * 2);
constexpr size_t WS_AFF = WS_FW3T + al256((size_t)2 * 4096 * 256 * 2);
constexpr size_t WS_IDX = WS_AFF + al256((size_t)MR * 16 * 4);
constexpr size_t WS_GSEL = WS_IDX + al256((size_t)NE * SLOTS * 4);
constexpr size_t WS_SLOT = WS_GSEL + al256((size_t)NE * SLOTS * 4);
constexpr size_t WS_KFC = WS_SLOT + al256((size_t)NE * MR * 4);
constexpr size_t WS_ZHYC = WS_KFC + al256((size_t)4096 * LC * 2);
constexpr size_t WS_XA = WS_ZHYC + al256((size_t)3072 * LC * 2);
constexpr size_t WS_XB = WS_XA + al256((size_t)MR * D * 4);
constexpr size_t WS_W = WS_XB + al256((size_t)MR * D * 4);
constexpr size_t W_BYTES = (size_t)2 * ((size_t)NIN * D + 3 * (size_t)D * 1024 + (size_t)D * D + (size_t)NE * 2048 * D + (size_t)NE * D * DF);
constexpr size_t WS_WIN = WS_W;
constexpr size_t WS_WBR = WS_WIN + (size_t)NIN * D * 2;
constexpr size_t WS_WOUT = WS_WBR + (size_t)3 * D * 1024 * 2;
constexpr size_t WS_WGU = WS_WOUT + (size_t)D * D * 2;
constexpr size_t WS_WDN = WS_WGU + (size_t)NE * 2048 * D * 2;
constexpr size_t WS_R3 = WS_W + al256(W_BYTES);
constexpr size_t R3_BYTES = (size_t)MR * D * 4 + (size_t)MR * D * 2;
constexpr size_t WS_KF = WS_R3;
constexpr size_t WS_KS = WS_R3 + al256((size_t)4096 * L * 2);
constexpr size_t WS_MPART = WS_R3;
constexpr size_t WS_MB = WS_R3 + (size_t)MR * D * 4;
constexpr size_t WS_TMP = WS_R3;
constexpr size_t WS_YE = WS_R3;
constexpr size_t WS_R4 = WS_R3 + al256(R3_BYTES);
constexpr size_t R4_BYTES = (size_t)MR * 6144 * 2;
constexpr size_t WS_GATE = WS_R4;
constexpr size_t WS_H2 = WS_R4;
constexpr size_t WS_ACT = WS_R4 + al256((size_t)MR * D * 2);
constexpr size_t WS_R5 = WS_R4 + al256(R4_BYTES);
constexpr size_t WS_MODPART = WS_R5;
constexpr size_t WS_HX = WS_R5;
constexpr size_t WS_YHYT = WS_R5;
constexpr size_t WS_YHY = WS_R5 + al256((size_t)1024 * L * 2);
constexpr size_t WS_ZHYT = WS_R5 + al256((size_t)MR * D * 2);
constexpr size_t WS_QWA = WS_ZHYT + al256((size_t)3072 * MR * 2);
constexpr size_t WS_KVWA = WS_QWA + al256((size_t)MR * 1024 * 2);
constexpr size_t WS_QNA = WS_KVWA + al256((size_t)MR * 512 * 2);
constexpr size_t WS_KVNA = WS_QNA + al256((size_t)MR * 1024 * 2);
constexpr size_t WS_YWA = WS_KVNA + al256((size_t)MR * 2048 * 2);
constexpr size_t WS_YNA = WS_YWA + al256((size_t)MR * 1024 * 2);
constexpr size_t WS_END = WS_YNA + al256((size_t)MR * 1024 * 2);
static_assert((size_t)1024 * L * 2 + (size_t)MR * 1024 * 2 <= (size_t)MR * D * 2 + 512, "YHYT+YHY overlay HX");
static_assert((size_t)4096 * L * 2 + 256 + (size_t)256 * 2 * 16384 * 8 <= R3_BYTES && (size_t)NE * SLOTS * D * 2 <= R3_BYTES && (size_t)NE * SLOTS * DF * 4 <= R3_BYTES, "R3");
static_assert((size_t)MR * D * 2 + 256 + (size_t)NE * SLOTS * DF * 2 <= R4_BYTES, "R4");

constexpr int LDS_BYTES = 160 * 1024;
constexpr int NTHREADS = 512;
constexpr int PH_PER_LAYER = 12, NPH = 1 + 2 * PH_PER_LAYER;

__device__ __forceinline__ float bf2f(bf16_t b) { return __uint_as_float(((unsigned)b) << 16); }
__device__ __forceinline__ bf16_t f2bf(float f) { unsigned u = __float_as_uint(f); u += 0x7fffu + ((u >> 16) & 1u); return (bf16_t)(u >> 16); }
__device__ __forceinline__ unsigned pk2(float lo, float hi) { return (unsigned)f2bf(lo) | ((unsigned)f2bf(hi) << 16); }
__device__ __forceinline__ float wave_sum(float v) {
#pragma unroll
    for (int o = 1; o < 64; o <<= 1) v += __shfl_xor(v, o);
    return v;
}
__device__ __forceinline__ float wave_max(float v) {
#pragma unroll
    for (int o = 1; o < 64; o <<= 1) v = fmaxf(v, __shfl_xor(v, o));
    return v;
}
__device__ __forceinline__ float silu_f(float x) { return x * __builtin_amdgcn_rcpf(1.f + __expf(-x)); }
__device__ __forceinline__ float sigmoid_f(float x) { return __builtin_amdgcn_rcpf(1.f + __expf(-x)); }
#define LDS_FENCE() asm volatile("s_waitcnt lgkmcnt(0)" ::: "memory")

#define XB_TMO      128
#define XB_XCNT(j)  (256  + 64 * (j))
#define XB_XSUB(j)  (1280 + 64 * (j))
#define XB_XGEN(j)  (2304 + 64 * (j))
#define XB_TOP      3328
#define XB_TOPGEN   3392
#define XCD_BAR_WORDS 3456
#define XB_SPIN_CAP (1u << 22)

__device__ __forceinline__ unsigned xb_ld(unsigned* p)              { return __hip_atomic_load(p, __ATOMIC_RELAXED, __HIP_MEMORY_SCOPE_AGENT); }
__device__ __forceinline__ unsigned xb_add(unsigned* p, unsigned v) { return __hip_atomic_fetch_add(p, v, __ATOMIC_RELAXED, __HIP_MEMORY_SCOPE_AGENT); }
__device__ __forceinline__ unsigned xb_xcc_id() { return (unsigned)__builtin_amdgcn_s_getreg((3 << 11) | 20) & 0xFu; }
#define XB_SPIN(cond, bar) do { unsigned _sp = 0; while (cond) { __builtin_amdgcn_s_sleep(1); \
    if ((++_sp & 255u) == 0u) { if (xb_ld(&(bar)[XB_TMO])) break; if (_sp > XB_SPIN_CAP) { atomicAdd(&(bar)[XB_TMO], 1u); break; } } } } while (0)

struct XcdBarrier { unsigned* bar; unsigned x; volatile LAS unsigned* st; };

__device__ __forceinline__ XcdBarrier xcd_barrier_post(unsigned* bar, volatile LAS unsigned* st) {
    XcdBarrier b; b.bar = bar; b.x = xb_xcc_id(); b.st = st;
    if (threadIdx.x == 0) (void)xb_add(&bar[XB_XCNT(b.x)], 1u);
    return b;
}
__device__ __forceinline__ void xcd_barrier_complete(unsigned* bar, unsigned x, unsigned& nloc, unsigned& nx) {
    const unsigned G = gridDim.x * gridDim.y * gridDim.z;
    unsigned sum, cnt, mine, sp = 0u;
    for (;;) {
        sum = 0u; cnt = 0u; mine = 0u;
#pragma unroll
        for (unsigned j = 0; j < 16; ++j) { const unsigned c = xb_ld(&bar[XB_XCNT(j)]); sum += c; cnt += (c > 0u) ? 1u : 0u; mine = (j == x) ? c : mine; }
        if (sum == G) break;
        __builtin_amdgcn_s_sleep(1);
        if ((++sp & 255u) == 0u) { if (xb_ld(&bar[XB_TMO])) break; if (sp > XB_SPIN_CAP) { atomicAdd(&bar[XB_TMO], 1u); break; } }
    }
    nloc = mine > 0u ? mine : 1u; nx = cnt > 0u ? cnt : 1u;
}
__device__ __forceinline__ void xcd_barrier(const XcdBarrier& b) {
    asm volatile("s_waitcnt vmcnt(0)" ::: "memory");
    __syncthreads();
    if (threadIdx.x == 0) {
        unsigned* bar = b.bar;
        __builtin_amdgcn_s_waitcnt(0);
        unsigned nloc = b.st[0], nx = b.st[1];
        if (nloc == 0u) { xcd_barrier_complete(bar, b.x, nloc, nx); b.st[0] = nloc; b.st[1] = nx; }
        const unsigned old = xb_add(&bar[XB_XSUB(b.x)], 1u);
        const unsigned gen = old / nloc;
        if (old + 1u == (gen + 1u) * nloc) {
            __builtin_amdgcn_fence(__ATOMIC_RELEASE, "agent");
            asm volatile("s_waitcnt vmcnt(0)" ::: "memory");
            const unsigned og = xb_add(&bar[XB_TOP], 1u);
            const unsigned tg = og / nx;
            if (og + 1u == (tg + 1u) * nx) xb_add(&bar[XB_TOPGEN], 1u);
            else XB_SPIN(xb_ld(&bar[XB_TOPGEN]) == tg, bar);
            __builtin_amdgcn_fence(__ATOMIC_ACQUIRE, "agent");
            xb_add(&bar[XB_XGEN(b.x)], 1u);
            asm volatile("s_waitcnt vmcnt(0)" ::: "memory");
        } else {
            XB_SPIN(xb_ld(&bar[XB_XGEN(b.x)]) == gen, bar);
            __builtin_amdgcn_fence(__ATOMIC_ACQUIRE, "agent");
            asm volatile("s_waitcnt vmcnt(0)" ::: "memory");
        }
    }
    __syncthreads();
}

struct KArgs { const float* in[31]; float* out; unsigned char* ws; int ph_lo, ph_hi; };

struct Ctx {
    const float* const* in; float* out; unsigned char* ws;
    int bid, nb, tid, lane, wave;
    unsigned char* smem;
    template <class T> __device__ __forceinline__ T* wsp(size_t off) const { return (T*)(ws + off); }
    __device__ __forceinline__ const float* mod(int layer, int src, int chunk) const { return wsp<float>(WS_MOD) + ((size_t)(layer * 2 + src) * NMOD) + chunk * D; }
    __device__ __forceinline__ const float* xrow(int layer, int r) const {
        if (layer == 0) return r < L ? in[0] + (size_t)r * D : in[2] + (size_t)(r - L) * D;
        return wsp<float>(WS_XB) + (size_t)r * D;
    }
};

template <class RowPtr, class Epi>
__device__ __forceinline__ void sgemm_unit(const RowPtr& rp, const float* __restrict__ W, int ldw, int K, int m0, int n0, const Epi& ep, float* lds, int tid) {
    float* As = lds;
    float* Bs = lds + 16 * 132;
    const int ty = tid >> 4, tx = tid & 15;
    const int am = tid >> 2, kq = (tid & 3) * 4;
    const int bk = tid >> 5, n4 = (tid & 31) * 4;
    float acc[4][8];
#pragma unroll
    for (int i = 0; i < 4; ++i)
#pragma unroll
        for (int j = 0; j < 8; ++j) acc[i][j] = 0.f;
    const bf16_t* arow = rp(m0 + am);
    const float* wp = W + (size_t)bk * ldw + n0 + n4;
    for (int k0 = 0; k0 < K; k0 += 16) {
        const uint2 a4 = *(const uint2*)(arow + k0 + kq);
        const float4 b4 = *(const float4*)(wp + (size_t)k0 * ldw);
        __syncthreads();
        As[(kq + 0) * 132 + am] = __uint_as_float(a4.x << 16);
        As[(kq + 1) * 132 + am] = __uint_as_float(a4.x & 0xffff0000u);
        As[(kq + 2) * 132 + am] = __uint_as_float(a4.y << 16);
        As[(kq + 3) * 132 + am] = __uint_as_float(a4.y & 0xffff0000u);
        *(float4*)&Bs[bk * 128 + n4] = b4;
        __syncthreads();
#pragma unroll
        for (int kk = 0; kk < 16; ++kk) {
            const float4 a = *(const float4*)&As[kk * 132 + ty * 4];
            const float4 b0 = *(const float4*)&Bs[kk * 128 + tx * 8];
            const float4 b1 = *(const float4*)&Bs[kk * 128 + tx * 8 + 4];
            const float av[4] = {a.x, a.y, a.z, a.w};
            const float bv[8] = {b0.x, b0.y, b0.z, b0.w, b1.x, b1.y, b1.z, b1.w};
#pragma unroll
            for (int i = 0; i < 4; ++i)
#pragma unroll
                for (int j = 0; j < 8; ++j) acc[i][j] = fmaf(av[i], bv[j], acc[i][j]);
        }
    }
#pragma unroll
    for (int i = 0; i < 4; ++i) ep(m0 + ty * 4 + i, n0 + tx * 8, acc[i]);
}

struct RowLin { const bf16_t* base; int ld; __device__ __forceinline__ const bf16_t* operator()(int m) const { return base + (size_t)m * ld; } };
struct RowGather { const bf16_t* base; int ld; const int* idx; __device__ __forceinline__ const bf16_t* operator()(int m) const { return base + (size_t)idx[m] * ld; } };


namespace pg8 {
typedef short bf16x8 __attribute__((ext_vector_type(8)));
typedef float f32x4 __attribute__((ext_vector_type(4)));
typedef unsigned u32x4 __attribute__((ext_vector_type(4)));
typedef unsigned u32x2 __attribute__((ext_vector_type(2)));
constexpr int BM = 256, BK = 64, HALF = 128, HTB = HALF * BK * 2, STAGE_BYTES = 8 * HTB, NXCD = 8, WGM = 8;
__host__ __device__ __forceinline__ int lds_byte(int r, int c) { const int st = (r >> 4) * 2 + (c >> 5), rr = r & 15, cc = c & 31, ob = rr * 64 + cc * 2; return st * 1024 + (ob ^ (((ob >> 9) & 1) << 5)); }
__host__ __device__ __forceinline__ void stage_rc(int b, int& R, int& C) { const int st = b / 1024, sb = b % 1024, swz = sb ^ (((sb >> 9) & 1) << 5); R = (st >> 1) * 16 + swz / 64; C = (st & 1) * 32 + (swz % 64) / 2; }
__host__ __device__ __forceinline__ int perm32(int rho) { const int n = rho >> 4, i = rho & 15; return 8 * (i >> 2) + 4 * n + (i & 3); }
struct Unit { int pm, pn; };
struct StaticOrder {
    int nM, nN, nwg, G, c;
    __host__ __device__ void init(int nM_, int nN_, int G_, int c_) { nM = nM_; nN = nN_; nwg = nM * nN; G = G_; c = c_; }
    __host__ __device__ bool next(int i, Unit& u) const { return at((long)i * G + c, u); }
    __host__ __device__ bool at(long Lq, Unit& u) const {
        if (Lq >= nwg) return false;
        int wgid = (int)Lq; { const int q = nwg / NXCD, r = nwg % NXCD, xcd = wgid % NXCD, off = wgid / NXCD; wgid = (xcd < r ? xcd * (q + 1) : r * (q + 1) + (xcd - r) * q) + off; }
        const int nig = WGM * nN, gid = wgid / nig, fm = gid * WGM, gsz = (nM - fm) < WGM ? (nM - fm) : WGM;
        u.pm = fm + ((wgid % nig) % gsz); u.pn = (wgid % nig) / gsz; return true;
    }
};
__device__ __forceinline__ unsigned cvt_pk_bf16(float lo, float hi) { unsigned r; asm volatile("v_cvt_pk_bf16_f32 %0, %1, %2" : "=v"(r) : "v"(lo), "v"(hi)); return r; }

struct GeomLin {
    static constexpr bool GATHER = false;
    const char* A; const char* B; int K, lda, ldb; const int* idx;
    __device__ __forceinline__ const char* a_base(const Unit& u) const { return A + (size_t)u.pm * 256 * lda * 2; }
    __device__ __forceinline__ const char* b_base(const Unit& u) const { return B + (size_t)u.pn * 256 * ldb * 2; }
    __device__ __forceinline__ int row0(const Unit& u) const { return u.pm * 256; }
};
template <bool GATHER_> struct GeomExpert {
    static constexpr bool GATHER = GATHER_;
    const char* A; const char* B; int K, lda, ldb; const int* idx; int tpe, nb;
    __device__ __forceinline__ int row0(const Unit& u) const { const int e = u.pm / tpe, t = u.pm - e * tpe; return e * SLOTS + t * 256; }
    __device__ __forceinline__ const char* a_base(const Unit& u) const { return GATHER_ ? A : A + (size_t)row0(u) * lda * 2; }
    __device__ __forceinline__ const char* b_base(const Unit& u) const { const int e = u.pm / tpe; return B + ((size_t)e * nb + (size_t)u.pn * 256) * ldb * 2; }
};

template <class Epi, class Geom, class Sched>
__device__ __forceinline__ void gemm_phase(LAS unsigned char* lds, const Geom& G, const Sched& S, const Epi& E) {
    const int tid = threadIdx.x, wid = __builtin_amdgcn_readfirstlane(tid >> 6), lane = tid & 63, wr = wid >> 2, wc = wid & 3, fr = lane & 15, fq = lane >> 4;
    const int K = G.K, nt = K / BK;
    int Rs[2], Cs[2]; unsigned vB0[2], vA0[2], vAc[2][2], vAn[2][2];
#pragma unroll
    for (int i = 0; i < 2; ++i) { int R, C; stage_rc(tid * 16 + i * 8192, R, C); Rs[i] = R; Cs[i] = C; const int Rb = Epi::PERM ? ((R & ~31) + perm32(R & 31)) : R;
        vB0[i] = (unsigned)(Rb * G.ldb + C) * 2u; vA0[i] = (unsigned)(R * G.lda + C) * 2u;
#pragma unroll
        for (int h = 0; h < 2; ++h) { vAc[h][i] = 0u; vAn[h][i] = 0u; } }
    const size_t hstepA = (size_t)HALF * G.lda * 2, hstepB = (size_t)HALF * G.ldb * 2;
#define PG8_VOFF(dst, u) do { if constexpr (Geom::GATHER) { const int _r0 = G.row0(u); _Pragma("unroll") for (int _h = 0; _h < 2; ++_h) _Pragma("unroll") for (int _i = 0; _i < 2; ++_i) \
        dst[_h][_i] = ((unsigned)G.idx[_r0 + _h * HALF + Rs[_i]] * (unsigned)G.lda + (unsigned)Cs[_i]) * 2u; } } while (0)
    const size_t kstep = (size_t)(BK * 2);
    const unsigned ldsw = (unsigned)wid * 1024u;
    const int aoff = lds_byte(wr * 64 + fr, fq * 8), boff = lds_byte(wc * 32 + fr, fq * 8);
#define PG8_SA(b, h) (((b) * 2 + (h)) * HTB)
#define PG8_SB(b, h) ((4 + (b) * 2 + (h)) * HTB)
#define PG8_STAGE(bufoff, gbase, v) do { \
        __builtin_amdgcn_global_load_lds((const unsigned*)((const char*)(gbase) + (v)[0]), (LAS unsigned*)(lds + (bufoff) + ldsw), 16, 0, 0); \
        __builtin_amdgcn_global_load_lds((const unsigned*)((const char*)(gbase) + (v)[1]), (LAS unsigned*)(lds + (bufoff) + ldsw + 8192), 16, 0, 0); } while (0)
#define PG8_STA(bufoff, gbase, h, VX) do { if constexpr (Geom::GATHER) { PG8_STAGE(bufoff, gbase, VX[h]); } else { PG8_STAGE(bufoff, (gbase) + (h) * hstepA, vA0); } } while (0)
#define PG8_STB(bufoff, gbase, h) PG8_STAGE(bufoff, (gbase) + (h) * hstepB, vB0)
#define PG8_LDA(dst, b, h) do { _Pragma("unroll") for (int m = 0; m < 4; ++m) _Pragma("unroll") for (int k = 0; k < 2; ++k) dst[m][k] = *(const LAS bf16x8*)(lds + PG8_SA(b, h) + aoff + m * 2048 + k * 1024); } while (0)
#define PG8_LDB(dst, b, h) do { _Pragma("unroll") for (int n = 0; n < 2; ++n) _Pragma("unroll") for (int k = 0; k < 2; ++k) dst[n][k] = *(const LAS bf16x8*)(lds + PG8_SB(b, h) + boff + n * 2048 + k * 1024); } while (0)
#define PG8_MMA(ai, bj, At, Bt) do { __builtin_amdgcn_s_setprio(1); _Pragma("unroll") for (int m = 0; m < 4; ++m) _Pragma("unroll") for (int n = 0; n < 2; ++n) _Pragma("unroll") for (int k = 0; k < 2; ++k) \
        acc[ai][bj][m][n] = __builtin_amdgcn_mfma_f32_16x16x32_bf16(Bt[n][k], At[m][k], acc[ai][bj][m][n], 0, 0, 0); __builtin_amdgcn_s_setprio(0); } while (0)
#define PG8_WAIT_V(n) asm volatile("s_waitcnt vmcnt(" #n ")" ::: "memory")
#define PG8_WAIT_L(n) asm volatile("s_waitcnt lgkmcnt(" #n ")" ::: "memory")
#define PG8_BAR __builtin_amdgcn_s_barrier()
#define PG8_SCHED __builtin_amdgcn_sched_barrier(0)
    Unit cur, nxt; int ui = 0;
    if (!S.next(0, cur)) return;
    f32x4 acc[2][2][4][2];
#pragma unroll
    for (int a = 0; a < 2; ++a)
#pragma unroll
        for (int b = 0; b < 2; ++b)
#pragma unroll
            for (int m = 0; m < 4; ++m)
#pragma unroll
                for (int n = 0; n < 2; ++n) acc[a][b][m][n] = (f32x4){0.f, 0.f, 0.f, 0.f};
    bf16x8 At[4][2], B0[2][2], B1[2][2];
    const char* cA = G.a_base(cur); const char* cB = G.b_base(cur);
    PG8_VOFF(vAc, cur);
    PG8_STB(PG8_SB(0, 0), cB, 0); PG8_STA(PG8_SA(0, 0), cA, 0, vAc); PG8_STB(PG8_SB(0, 1), cB, 1); PG8_STA(PG8_SA(0, 1), cA, 1, vAc);
    if (wr == 1) PG8_BAR;
    PG8_WAIT_V(4); PG8_BAR;
    PG8_STB(PG8_SB(1, 0), cB + kstep, 0); PG8_STA(PG8_SA(1, 0), cA + kstep, 0, vAc); PG8_STB(PG8_SB(1, 1), cB + kstep, 1);
    PG8_WAIT_V(6); PG8_BAR;
    for (;;) {
        const bool has_next = S.next(ui + 1, nxt);
        const char* nA = has_next ? G.a_base(nxt) : cA; const char* nB = has_next ? G.b_base(nxt) : cB;
        if constexpr (Geom::GATHER) { if (has_next) PG8_VOFF(vAn, nxt); else {
#pragma unroll
            for (int h = 0; h < 2; ++h) { vAn[h][0] = vAc[h][0]; vAn[h][1] = vAc[h][1]; } } }
        for (int t = 0; t < nt; t += 2) {
            const bool last = (t == nt - 2);
            const char* a1 = cA + (size_t)(t + 1) * kstep;
            const char* a2 = last ? nA : cA + (size_t)(t + 2) * kstep; const char* b2 = last ? nB : cB + (size_t)(t + 2) * kstep;
            const char* a3 = a2 + kstep; const char* b3 = b2 + kstep;
            unsigned v2[2][2];
#pragma unroll
            for (int h = 0; h < 2; ++h) { v2[h][0] = (Geom::GATHER && last) ? vAn[h][0] : vAc[h][0]; v2[h][1] = (Geom::GATHER && last) ? vAn[h][1] : vAc[h][1]; }
            PG8_LDB(B0, 0, 0); PG8_SCHED; PG8_LDA(At, 0, 0); PG8_STA(PG8_SA(1, 1), a1, 1, vAc);
            PG8_WAIT_L(8); PG8_BAR; PG8_WAIT_L(0); PG8_MMA(0, 0, At, B0); PG8_BAR; PG8_SCHED;
            PG8_LDB(B1, 0, 1); PG8_STB(PG8_SB(0, 0), b2, 0);
            PG8_BAR; PG8_WAIT_L(0); PG8_MMA(0, 1, At, B1); PG8_BAR;
            PG8_LDA(At, 0, 1); PG8_STA(PG8_SA(0, 0), a2, 0, v2);
            PG8_BAR; PG8_WAIT_L(0); PG8_MMA(1, 0, At, B0); PG8_BAR; PG8_SCHED;
            PG8_STB(PG8_SB(0, 1), b2, 1);
            PG8_WAIT_V(6); PG8_BAR; PG8_MMA(1, 1, At, B1); PG8_BAR;
            PG8_LDB(B0, 1, 0); PG8_SCHED; PG8_LDA(At, 1, 0); PG8_STA(PG8_SA(0, 1), a2, 1, v2);
            PG8_WAIT_L(8); PG8_BAR; PG8_WAIT_L(0); PG8_MMA(0, 0, At, B0); PG8_BAR; PG8_SCHED;
            PG8_LDB(B1, 1, 1); PG8_STB(PG8_SB(1, 0), b3, 0);
            PG8_BAR; PG8_WAIT_L(0); PG8_MMA(0, 1, At, B1); PG8_BAR;
            PG8_LDA(At, 1, 1); PG8_STA(PG8_SA(1, 0), a3, 0, v2);
            PG8_BAR; PG8_WAIT_L(0); PG8_MMA(1, 0, At, B0); PG8_BAR; PG8_SCHED;
            PG8_STB(PG8_SB(1, 1), b3, 1);
            PG8_WAIT_V(6); PG8_BAR; PG8_MMA(1, 1, At, B1); PG8_BAR;
        }
        E(acc, cur, G.row0(cur), wr, wc, fr, fq);
        if (!has_next) break;
#pragma unroll
        for (int a = 0; a < 2; ++a)
#pragma unroll
            for (int b = 0; b < 2; ++b)
#pragma unroll
                for (int m = 0; m < 4; ++m)
#pragma unroll
                    for (int n = 0; n < 2; ++n) acc[a][b][m][n] = (f32x4){0.f, 0.f, 0.f, 0.f};
        cur = nxt; cA = nA; cB = nB; ++ui;
#pragma unroll
        for (int h = 0; h < 2; ++h) { vAc[h][0] = vAn[h][0]; vAc[h][1] = vAn[h][1]; }
    }
    PG8_WAIT_V(0);
    if (wr == 0) PG8_BAR;
    PG8_BAR;
#undef PG8_VOFF
#undef PG8_SA
#undef PG8_SB
#undef PG8_STAGE
#undef PG8_STA
#undef PG8_STB
#undef PG8_LDA
#undef PG8_LDB
#undef PG8_MMA
#undef PG8_WAIT_V
#undef PG8_WAIT_L
#undef PG8_BAR
#undef PG8_SCHED
}

struct EpiBf16Plain {
    static constexpr bool PERM = true;
    bf16_t* O; int ldc; int coloff;
    __device__ __forceinline__ void operator()(const f32x4 (&acc)[2][2][4][2], const Unit& u, int row0, int wr, int wc, int fr, int fq) const {
        const int r0 = row0 + wr * 64 + fr, col0 = coloff + u.pn * BM + wc * 32 + 8 * fq;
#pragma unroll
        for (int ai = 0; ai < 2; ++ai)
#pragma unroll
            for (int m = 0; m < 4; ++m) { bf16_t* rowp = O + (size_t)(r0 + ai * HALF + m * 16) * ldc + col0;
#pragma unroll
                for (int bj = 0; bj < 2; ++bj) { const f32x4 v0 = acc[ai][bj][m][0], v1 = acc[ai][bj][m][1];
                    u32x4 w; w.x = cvt_pk_bf16(v0[0], v0[1]); w.y = cvt_pk_bf16(v0[2], v0[3]); w.z = cvt_pk_bf16(v1[0], v1[1]); w.w = cvt_pk_bf16(v1[2], v1[3]);
                    *(u32x4*)(rowp + bj * HALF) = w; } }
    }
};
struct EpiInRest {
    static constexpr bool PERM = true;
    unsigned char* ws;
    __device__ __forceinline__ void operator()(const f32x4 (&acc)[2][2][4][2], const Unit& u, int row0, int wr, int wc, int fr, int fq) const {
        const int gcol = OFF_WAQ + u.pn * BM;
        bf16_t* base; int ldc, c0; bool sg = false;
        if (gcol < OFF_WAKV) { base = (bf16_t*)(ws + WS_QWA); ldc = 1024; c0 = gcol - OFF_WAQ; }
        else if (gcol < OFF_NAQ) { base = (bf16_t*)(ws + WS_KVWA); ldc = 512; c0 = gcol - OFF_WAKV; }
        else if (gcol < OFF_NAKV) { base = (bf16_t*)(ws + WS_QNA); ldc = 1024; c0 = gcol - OFF_NAQ; }
        else if (gcol < OFF_GATE) { base = (bf16_t*)(ws + WS_KVNA); ldc = 2048; c0 = gcol - OFF_NAKV; }
        else { base = (bf16_t*)(ws + WS_GATE); ldc = 6144; c0 = gcol - OFF_GATE; sg = true; }
        const int r0 = row0 + wr * 64 + fr, col0 = c0 + wc * 32 + 8 * fq;
#pragma unroll
        for (int ai = 0; ai < 2; ++ai)
#pragma unroll
            for (int m = 0; m < 4; ++m) { bf16_t* rowp = base + (size_t)(r0 + ai * HALF + m * 16) * ldc + col0;
#pragma unroll
                for (int bj = 0; bj < 2; ++bj) { f32x4 v0 = acc[ai][bj][m][0], v1 = acc[ai][bj][m][1];
                    if (sg) {
#pragma unroll
                        for (int j = 0; j < 4; ++j) { v0[j] = sigmoid_f(v0[j]); v1[j] = sigmoid_f(v1[j]); } }
                    u32x4 w; w.x = cvt_pk_bf16(v0[0], v0[1]); w.y = cvt_pk_bf16(v0[2], v0[3]); w.z = cvt_pk_bf16(v1[0], v1[1]); w.w = cvt_pk_bf16(v1[2], v1[3]);
                    *(u32x4*)(rowp + bj * HALF) = w; } }
    }
};
template <int BR> struct EpiMergeF {
    static constexpr bool PERM = false;
    unsigned char* ws;
    __device__ __forceinline__ void operator()(const f32x4 (&acc)[2][2][4][2], const Unit& u, int row0, int wr, int wc, int fr, int fq) const {
        const int r0 = row0 + wr * 64 + fr, col0 = u.pn * BM + wc * 32 + 4 * fq;
#pragma unroll
        for (int ai = 0; ai < 2; ++ai)
#pragma unroll
            for (int m = 0; m < 4; ++m) { const size_t row = (size_t)(r0 + ai * HALF + m * 16);
                const bf16_t* gp = (const bf16_t*)(ws + WS_GATE) + row * 6144 + BR * 2048 + col0;
                bf16_t* ob = (bf16_t*)(ws + WS_MB) + row * D + col0;
#pragma unroll
                for (int bj = 0; bj < 2; ++bj)
#pragma unroll
                    for (int n = 0; n < 2; ++n) { const int co = bj * HALF + n * 16;
                        const u32x2 gg = *(const u32x2*)(gp + co);
                        const f32x4 g = {__uint_as_float(gg.x << 16), __uint_as_float(gg.x & 0xffff0000u), __uint_as_float(gg.y << 16), __uint_as_float(gg.y & 0xffff0000u)};
                        f32x4 t = g * acc[ai][bj][m][n];
                        if (BR > 0) { const u32x2 pp = *(const u32x2*)(ob + co);
                            t += (f32x4){__uint_as_float(pp.x << 16), __uint_as_float(pp.x & 0xffff0000u), __uint_as_float(pp.y << 16), __uint_as_float(pp.y & 0xffff0000u)}; }
                        u32x2 w; w.x = cvt_pk_bf16(t[0], t[1]); w.y = cvt_pk_bf16(t[2], t[3]); *(u32x2*)(ob + co) = w; } }
    }
};
struct EpiOutF {
    static constexpr bool PERM = false;
    const Ctx* c; int layer;
    __device__ __forceinline__ void operator()(const f32x4 (&acc)[2][2][4][2], const Unit& u, int row0, int wr, int wc, int fr, int fq) const {
        const int r0 = row0 + wr * 64 + fr, col0 = u.pn * BM + wc * 32 + 4 * fq;
#pragma unroll
        for (int ai = 0; ai < 2; ++ai)
#pragma unroll
            for (int m = 0; m < 4; ++m) { const int row = r0 + ai * HALF + m * 16;
                const float* xin = c->xrow(layer, row) + col0; const float* g = c->mod(layer, row < L ? 0 : 1, 2) + col0;
                float* o = (float*)(c->ws + WS_XA) + (size_t)row * D + col0;
#pragma unroll
                for (int bj = 0; bj < 2; ++bj)
#pragma unroll
                    for (int n = 0; n < 2; ++n) { const int co = bj * HALF + n * 16;
                        *(f32x4*)(o + co) = *(const f32x4*)(xin + co) + *(const f32x4*)(g + co) * acc[ai][bj][m][n]; } }
    }
};
struct EpiGU {
    static constexpr bool PERM = false;
    bf16_t* act;
    __device__ __forceinline__ void operator()(const f32x4 (&acc)[2][2][4][2], const Unit& u, int row0, int wr, int wc, int fr, int fq) const {
        const int r0 = row0 + wr * 64 + fr, f0 = u.pn * 128 + wc * 16 + 4 * fq;
#pragma unroll
        for (int ai = 0; ai < 2; ++ai)
#pragma unroll
            for (int m = 0; m < 4; ++m) { bf16_t* rowp = act + (size_t)(r0 + ai * HALF + m * 16) * DF + f0;
#pragma unroll
                for (int bj = 0; bj < 2; ++bj) { const f32x4 a = acc[ai][bj][m][0], uu = acc[ai][bj][m][1]; f32x4 t;
#pragma unroll
                    for (int j = 0; j < 4; ++j) t[j] = silu_f(a[j]) * uu[j];
                    u32x2 w; w.x = cvt_pk_bf16(t[0], t[1]); w.y = cvt_pk_bf16(t[2], t[3]); *(u32x2*)(rowp + bj * 64) = w; } }
    }
};
}

struct ConvDesc { const float* W; bf16_t* WT; int K, N, k0, n0, gu, off; };
__device__ __forceinline__ ConvDesc conv_desc(const Ctx& c, int layer, int it) {
    constexpr int I_IN = (D / 64) * (NIN / 256), I_BR = (1024 / 64) * (D / 256), I_OUT = (D / 64) * (D / 256), I_G = (D / 64) * (DF / 256), I_DN = (DF / 64) * (D / 256);
    ConvDesc d; int r = it; d.gu = 0; d.off = 0;
    if (r < I_IN) { d.W = c.in[7] + (size_t)layer * D * NIN; d.WT = c.wsp<bf16_t>(WS_WIN); d.K = D; d.N = NIN; }
    else if ((r -= I_IN) < 3 * I_BR) { const int b = r / I_BR; r -= b * I_BR; d.W = c.in[24] + ((size_t)layer * 3 + b) * 1024 * D; d.WT = c.wsp<bf16_t>(WS_WBR) + (size_t)b * D * 1024; d.K = 1024; d.N = D; }
    else if ((r -= 3 * I_BR) < I_OUT) { d.W = c.in[25] + (size_t)layer * D * D; d.WT = c.wsp<bf16_t>(WS_WOUT); d.K = D; d.N = D; }
    else { r -= I_OUT; const int e = r / (2 * I_G + I_DN); r -= e * (2 * I_G + I_DN);
        if (r < I_G) { d.W = c.in[28] + ((size_t)layer * NE + e) * D * DF; d.WT = c.wsp<bf16_t>(WS_WGU); d.K = D; d.N = DF; d.gu = 1; d.off = e * 2048; }
        else if ((r -= I_G) < I_G) { d.W = c.in[29] + ((size_t)layer * NE + e) * D * DF; d.WT = c.wsp<bf16_t>(WS_WGU); d.K = D; d.N = DF; d.gu = 1; d.off = e * 2048 + 16; }
        else { r -= I_G; d.W = c.in[30] + ((size_t)layer * NE + e) * DF * D; d.WT = c.wsp<bf16_t>(WS_WDN) + (size_t)e * D * DF; d.K = DF; d.N = D; } }
    const int nblk = d.N / 256; d.k0 = 64 * (r / nblk); d.n0 = 256 * (r % nblk);
    return d;
}
constexpr int CONV_NA = (D / 64) * (NIN / 256) + 3 * (1024 / 64) * (D / 256) + (D / 64) * (D / 256);
constexpr int CONV_NX = NE * (2 * (D / 64) * (DF / 256) + (DF / 64) * (D / 256));
__device__ __forceinline__ void ph_conv(const Ctx& c, int layer, int first, int count, int stride) {
    __syncthreads();
    float* tile = (float*)c.smem;
    const int tid = c.tid;
    float4 rg[8];
    int it = first; int left = count; bool have = left > 0; ConvDesc d;
    if (have) { d = conv_desc(c, layer, it);
#pragma unroll
        for (int q = 0; q < 8; ++q) { const int e = tid + 512 * q, row = e >> 6, c4 = e & 63; rg[q] = *(const float4*)(d.W + (size_t)(d.k0 + row) * d.N + d.n0 + 4 * c4); } }
    while (have) {
#pragma unroll
        for (int q = 0; q < 8; ++q) { const int e = tid + 512 * q, row = e >> 6, c4 = e & 63; float* tp = tile + row * 257 + 4 * c4; tp[0] = rg[q].x; tp[1] = rg[q].y; tp[2] = rg[q].z; tp[3] = rg[q].w; }
        __syncthreads();
        const ConvDesc cur = d;
        it += stride; --left; have = left > 0;
        if (have) { d = conv_desc(c, layer, it);
#pragma unroll
            for (int q = 0; q < 8; ++q) { const int e = tid + 512 * q, row = e >> 6, c4 = e & 63; rg[q] = *(const float4*)(d.W + (size_t)(d.k0 + row) * d.N + d.n0 + 4 * c4); } }
#pragma unroll
        for (int j = 0; j < 4; ++j) { const int p = tid + 512 * j, nn = p >> 3, kc = p & 7; const float* sp = tile + (8 * kc) * 257 + nn;
            uint4 o; o.x = pk2(sp[0 * 257], sp[1 * 257]); o.y = pk2(sp[2 * 257], sp[3 * 257]); o.z = pk2(sp[4 * 257], sp[5 * 257]); o.w = pk2(sp[6 * 257], sp[7 * 257]);
            const int f = cur.n0 + nn; const int orow = cur.gu ? cur.off + 32 * (f >> 4) + (f & 15) : f;
            *(uint4*)(cur.WT + (size_t)orow * cur.K + cur.k0 + 8 * kc) = o; }
        __syncthreads();
    }
}

struct EpiTaps {
    static constexpr bool PERM = true;
    bf16_t* KF; bf16_t* KFC; const float* dec;
    __device__ __forceinline__ void operator()(const pg8::f32x4 (&acc)[2][2][4][2], const pg8::Unit& u, int row0, int wr, int wc, int fr, int fq) const {
        const bool isc = u.pn == L / 256;
        const int ch0 = row0 + wr * 64 + fr, pos0 = (isc ? 0 : u.pn * 256) + wc * 32 + 8 * fq;
        const float inv = isc ? 1.0f / (float)(LC - 1) : 1.0f / (float)(L - 1);
        bf16_t* base = isc ? KFC : KF; const int ld = isc ? LC : L;
#pragma unroll
        for (int ai = 0; ai < 2; ++ai)
#pragma unroll
            for (int m = 0; m < 4; ++m) { const int ch = ch0 + ai * 128 + m * 16; const float rate = fabsf(dec[ch]); bf16_t* rowp = base + (size_t)ch * ld + pos0;
#pragma unroll
                for (int bj = 0; bj < 2; ++bj) { float t[8];
#pragma unroll
                    for (int j = 0; j < 8; ++j) { const float tt = (float)(pos0 + bj * 128 + j) * inv; const float a = j < 4 ? acc[ai][bj][m][0][j] : acc[ai][bj][m][1][j - 4]; t[j] = a * (__expf(-tt * rate) + 0.05f); }
                    pg8::u32x4 w; w.x = pg8::cvt_pk_bf16(t[0], t[1]); w.y = pg8::cvt_pk_bf16(t[2], t[3]); w.z = pg8::cvt_pk_bf16(t[4], t[5]); w.w = pg8::cvt_pk_bf16(t[6], t[7]);
                    *(pg8::u32x4*)(rowp + bj * 128) = w; } }
    }
};
__device__ __forceinline__ void ph_taps(const Ctx& c, int layer) {
    LAS unsigned char* lds = (LAS unsigned char*)c.smem;
    __syncthreads();
    const pg8::GeomLin G{(const char*)(c.wsp<bf16_t>(WS_FW3T) + (size_t)layer * 4096 * 256), (const char*)(c.wsp<bf16_t>(WS_H2B) + (size_t)layer * MR * 256), 256, 256, 256, nullptr};
    pg8::StaticOrder S; S.init(4096 / 256, MR / 256, c.nb, c.bid);
    const EpiTaps E{c.wsp<bf16_t>(WS_KF), c.wsp<bf16_t>(WS_KFC), c.in[16] + (size_t)layer * 4096};
    pg8::gemm_phase(lds, G, S, E);
}

__device__ __forceinline__ void ph_g0(const Ctx& c) {
    float* lds = (float*)c.smem;
    {
        float* PART = c.wsp<float>(WS_MODPART);
        for (int u = c.bid; u < 2 * 128; u += c.nb) {
            const int layer = u >> 7, slab = u & 127, k0 = slab * 16;
            __syncthreads();
            if (c.tid < 32) { const int k = k0 + (c.tid & 15); lds[c.tid] = silu_f(c.tid < 16 ? c.in[1][k] : c.in[3][k]); }
            __syncthreads();
            const float4* w = (const float4*)(c.in[4] + ((size_t)layer * D + k0) * NMOD);
            float4 ac[6], ax[6];
#pragma unroll
            for (int q = 0; q < 6; ++q) { ac[q] = make_float4(0.f, 0.f, 0.f, 0.f); ax[q] = make_float4(0.f, 0.f, 0.f, 0.f); }
#pragma unroll 4
            for (int r = 0; r < 16; ++r) {
                const float sc = lds[r], sx = lds[16 + r];
#pragma unroll
                for (int q = 0; q < 6; ++q) { const float4 v = w[(size_t)r * (NMOD / 4) + c.tid + 512 * q];
                    ac[q].x = fmaf(sc, v.x, ac[q].x); ac[q].y = fmaf(sc, v.y, ac[q].y); ac[q].z = fmaf(sc, v.z, ac[q].z); ac[q].w = fmaf(sc, v.w, ac[q].w);
                    ax[q].x = fmaf(sx, v.x, ax[q].x); ax[q].y = fmaf(sx, v.y, ax[q].y); ax[q].z = fmaf(sx, v.z, ax[q].z); ax[q].w = fmaf(sx, v.w, ax[q].w); }
            }
            float4* pc = (float4*)(PART + ((size_t)(layer * 128 + slab) * 2 + 0) * NMOD), *px = (float4*)(PART + ((size_t)(layer * 128 + slab) * 2 + 1) * NMOD);
#pragma unroll
            for (int q = 0; q < 6; ++q) { pc[c.tid + 512 * q] = ac[q]; px[c.tid + 512 * q] = ax[q]; }
        }
    }
    for (size_t e = (size_t)c.bid * NTHREADS + c.tid; e < (size_t)2 * 4096 * 256; e += (size_t)c.nb * NTHREADS) {
        const int k = (int)(e & 255), col = (int)((e >> 8) & 4095), layer = (int)(e >> 20);
        c.wsp<bf16_t>(WS_FW3T)[e] = k < 64 ? f2bf(c.in[14][((size_t)layer * 64 + k) * 4096 + col]) : (bf16_t)0;
    }
    const int gw = c.bid * 8 + c.wave, ngw = c.nb * 8;
    for (int task = gw; task < 2 * MR; task += ngw) {
        const int layer = task / MR, pos = task % MR;
        const bool isc = pos >= L; const int i = isc ? pos - L : pos; const int Lx = isc ? LC : L;
        const float tt = (float)i * (1.0f / (float)(Lx - 1));
        const float c0 = (float)(2.0 * 3.14159265358979323846 / (double)Lx);
        const int j = c.lane;
        float feat = 0.f;
        if (j == 0) feat = tt;
        else if (j < 33) { const int b = (j - 1) & 15; const float band = 1e-4f + (float)b * ((15.0f - 1e-4f) / 15.0f); const float ang = (c0 * band) * (float)i; feat = (j <= 16) ? cosf(ang) : -sinf(ang); }
        const float* fw1 = c.in[10] + (size_t)layer * 33 * 64; const float* fb1 = c.in[11] + layer * 64;
        const float* fw2 = c.in[12] + (size_t)layer * 64 * 64; const float* fb2 = c.in[13] + layer * 64;
        const float* fr = c.in[15] + layer * 128;
        float s = fb1[j];
        for (int f = 0; f < 33; ++f) s = fmaf(__shfl(feat, f), fw1[f * 64 + j], s);
        const float h1 = sinf(fr[j] * s);
        float s2 = fb2[j];
        for (int m = 0; m < 64; ++m) s2 = fmaf(__shfl(h1, m), fw2[m * 64 + j], s2);
        const float h2 = sinf(fr[64 + j] * s2);
        bf16_t* hb = c.wsp<bf16_t>(WS_H2B) + ((size_t)layer * MR + pos) * 256;
        hb[j] = f2bf(h2); hb[64 + j] = 0; hb[128 + j] = 0; hb[192 + j] = 0;
    }
}

__device__ __forceinline__ void ph_g0b(const Ctx& c) {
    const float* PART = c.wsp<float>(WS_MODPART);
    for (int i = c.bid * NTHREADS + c.tid; i < 2 * 2 * (NMOD / 4); i += c.nb * NTHREADS) {
        const int n4 = i % (NMOD / 4), ls = i / (NMOD / 4), layer = ls >> 1, src = ls & 1;
        float4 a = *(const float4*)(c.in[5] + (size_t)layer * NMOD + 4 * n4);
#pragma unroll 8
        for (int sl = 0; sl < 128; ++sl) { const float4 v = *(const float4*)(PART + ((size_t)(layer * 128 + sl) * 2 + src) * NMOD + 4 * n4); a.x += v.x; a.y += v.y; a.z += v.z; a.w += v.w; }
        *(float4*)(c.wsp<float>(WS_MOD) + (size_t)(layer * 2 + src) * NMOD + 4 * n4) = a;
    }
}

__device__ __forceinline__ void ph_a(const Ctx& c, int layer) {
    const int gw = c.bid * 8 + c.wave, ngw = c.nb * 8;
    const float* g = c.in[6] + (size_t)layer * D;
    float* gl = (float*)c.smem;
    __syncthreads();
    for (int i = c.tid; i < D; i += NTHREADS) { gl[i] = g[i]; gl[D + i] = c.mod(layer, 0, 0)[i]; gl[2 * D + i] = c.mod(layer, 0, 1)[i]; }
    __syncthreads();
    if (layer == 0)
    for (int r = gw; r < MR; r += ngw) {
        const float* x = c.xrow(layer, r);
        const bool lat = r < L;
        const float* shg = c.mod(layer, 1, 0); const float* scg = c.mod(layer, 1, 1);
        float4 v[8]; float ss = 0.f;
#pragma unroll
        for (int j = 0; j < 8; ++j) { v[j] = *(const float4*)(x + 4 * c.lane + 256 * j); ss += v[j].x * v[j].x + v[j].y * v[j].y + v[j].z * v[j].z + v[j].w * v[j].w; }
        ss = wave_sum(ss);
        const float inv = rsqrtf(ss * (1.0f / D) + RMS_EPS);
        bf16_t* o = c.wsp<bf16_t>(WS_HX) + (size_t)r * D;
#pragma unroll
        for (int j = 0; j < 8; ++j) {
            const int col = 4 * c.lane + 256 * j;
            const float4 gg = *(const float4*)(gl + col);
            const float4 s4 = lat ? *(const float4*)(gl + D + col) : *(const float4*)(shg + col);
            const float4 c4 = lat ? *(const float4*)(gl + 2 * D + col) : *(const float4*)(scg + col);
            const float y0 = v[j].x * inv * gg.x * (1.f + c4.x) + s4.x, y1 = v[j].y * inv * gg.y * (1.f + c4.y) + s4.y;
            const float y2 = v[j].z * inv * gg.z * (1.f + c4.z) + s4.z, y3 = v[j].w * inv * gg.w * (1.f + c4.w) + s4.w;
            uint2 w; w.x = pk2(y0, y1); w.y = pk2(y2, y3);
            *(uint2*)(o + col) = w;
        }
    }
}

struct EpiIn {
    unsigned char* ws;
    __device__ __forceinline__ void operator()(int row, int col, const float (&v)[8]) const {
        if (col < OFF_WAQ) {
            bf16_t* d = (bf16_t*)(ws + WS_ZHYT);
#pragma unroll
            for (int j = 0; j < 8; ++j) d[(size_t)(col + j) * MR + row] = f2bf(v[j]);
            return;
        }
        bf16_t* dst; float t[8];
#pragma unroll
        for (int j = 0; j < 8; ++j) t[j] = v[j];
        if (col < OFF_WAKV) dst = (bf16_t*)(ws + WS_QWA) + (size_t)row * 1024 + (col - OFF_WAQ);
        else if (col < OFF_NAQ) dst = (bf16_t*)(ws + WS_KVWA) + (size_t)row * 512 + (col - OFF_WAKV);
        else if (col < OFF_NAKV) dst = (bf16_t*)(ws + WS_QNA) + (size_t)row * 1024 + (col - OFF_NAQ);
        else if (col < OFF_GATE) dst = (bf16_t*)(ws + WS_KVNA) + (size_t)row * 2048 + (col - OFF_NAKV);
        else { dst = (bf16_t*)(ws + WS_GATE) + (size_t)row * 6144 + (col - OFF_GATE);
#pragma unroll
            for (int j = 0; j < 8; ++j) t[j] = sigmoid_f(t[j]); }
        uint4 o; o.x = pk2(t[0], t[1]); o.y = pk2(t[2], t[3]); o.z = pk2(t[4], t[5]); o.w = pk2(t[6], t[7]);
        *(uint4*)dst = o;
    }
};
__device__ __forceinline__ void ph_b(const Ctx& c, int layer) {
    const RowLin rp{c.wsp<bf16_t>(WS_HX), D};
    const EpiIn ep{c.ws};
    const float* W = c.in[7] + (size_t)layer * D * NIN;
    const int nM = MR / 128, nN = NIN / 128;
    for (int u = c.bid; u < nM * nN; u += c.nb) {
        const int pm = u % nM, pn = u / nM;
        sgemm_unit(rp, W, NIN, D, pm * 128, pn * 128, ep, (float*)c.smem, c.tid);
    }
}

__device__ __forceinline__ void b2_segment(bf16_t* p, const float* gain, bool rope, int r, int lane, bool active) {
    uint4 w = make_uint4(0u, 0u, 0u, 0u);
    if (active) w = *(const uint4*)(p + 8 * lane);
    float x[8] = {__uint_as_float(w.x << 16), __uint_as_float(w.x & 0xffff0000u), __uint_as_float(w.y << 16), __uint_as_float(w.y & 0xffff0000u),
                  __uint_as_float(w.z << 16), __uint_as_float(w.z & 0xffff0000u), __uint_as_float(w.w << 16), __uint_as_float(w.w & 0xffff0000u)};
    float ss = 0.f;
#pragma unroll
    for (int i = 0; i < 8; ++i) ss += x[i] * x[i];
    ss += __shfl_xor(ss, 1); ss += __shfl_xor(ss, 2); ss += __shfl_xor(ss, 4); ss += __shfl_xor(ss, 8);
    const float inv = rsqrtf(ss * (1.0f / 128.0f) + RMS_EPS);
    const int d0 = (lane & 15) * 8;
    const float4 g0 = *(const float4*)(gain + d0), g1 = *(const float4*)(gain + d0 + 4);
    const float gg[8] = {g0.x, g0.y, g0.z, g0.w, g1.x, g1.y, g1.z, g1.w};
#pragma unroll
    for (int i = 0; i < 8; ++i) x[i] = x[i] * inv * gg[i];
    if (rope) {
        const int axis = d0 >> 6, half = (d0 >> 5) & 1, f0 = d0 & 31;
        const float pos = axis == 0 ? (float)(r / GRIDW) : (float)(r % GRIDW);
#pragma unroll
        for (int i = 0; i < 8; ++i) {
            const float other = __shfl_xor(x[i], 4);
            const float ang = pos * powf(10000.0f, -(float)(f0 + i) / 32.0f);
            float sn, cs; sincosf(ang, &sn, &cs);
            x[i] = half == 0 ? x[i] * cs - other * sn : x[i] * cs + other * sn;
        }
    }
    if (active) { uint4 o; o.x = pk2(x[0], x[1]); o.y = pk2(x[2], x[3]); o.z = pk2(x[4], x[5]); o.w = pk2(x[6], x[7]); *(uint4*)(p + 8 * lane) = o; }
}
__device__ __forceinline__ void ph_b2(const Ctx& c, int layer) {
    const int gw = c.bid * 8 + c.wave, ngw = c.nb * 8;
    const int lane = c.lane;
    for (int r = gw; r < MR; r += ngw) {
        const bool lat = r < L;
        b2_segment(c.wsp<bf16_t>(WS_QWA) + (size_t)r * 1024, c.in[18] + layer * 128, lat, r, lane, true);
        b2_segment(c.wsp<bf16_t>(WS_QWA) + (size_t)r * 1024 + 512, c.in[18] + layer * 128, lat, r, lane, true);
        b2_segment(c.wsp<bf16_t>(WS_KVWA) + (size_t)r * 512, c.in[19] + layer * 128, lat, r, lane, lane < 32);
        b2_segment(c.wsp<bf16_t>(WS_QNA) + (size_t)r * 1024, c.in[21] + layer * 128, false, r, lane, true);
        b2_segment(c.wsp<bf16_t>(WS_QNA) + (size_t)r * 1024 + 512, c.in[21] + layer * 128, false, r, lane, true);
        b2_segment(c.wsp<bf16_t>(WS_KVNA) + (size_t)r * 2048, c.in[22] + layer * 128, false, r, lane, true);
        b2_segment(c.wsp<bf16_t>(WS_KVNA) + (size_t)r * 2048 + 512, c.in[22] + layer * 128, false, r, lane, true);
    }
}

__device__ __forceinline__ float shortconv_at(const bf16_t* z, int t, int Lx, float w0, float w1, float w2, float b) {
    const float zm = t > 0 ? bf2f(z[t - 1]) : 0.f, z0 = bf2f(z[t]), zp = t + 1 < Lx ? bf2f(z[t + 1]) : 0.f;
    return zm * w0 + z0 * w1 + zp * w2 + b;
}
__device__ __forceinline__ float block_sum(float v, float* red, int tid) {
    v = wave_sum(v);
    __syncthreads();
    if ((tid & 63) == 0) red[tid >> 6] = v;
    __syncthreads();
    float t = 0.f;
#pragma unroll
    for (int w = 0; w < 8; ++w) t += red[w];
    return t;
}
__device__ __forceinline__ void hyena_direct_unit(const Ctx& c, int layer, int ch) {
    bf16_t* kc = (bf16_t*)c.smem;
    float* cv = (float*)c.smem;
    float* us = (float*)(c.smem + 4 * L);
    float* red = us + L;
    const int tid = c.tid;
    const float* cw = c.in[8] + (size_t)layer * 3 * 3072; const float* cb = c.in[9] + (size_t)layer * 3072;
    const bf16_t* zv = c.wsp<bf16_t>(WS_ZHYT) + (size_t)ch * MR;
    const bf16_t* z1 = c.wsp<bf16_t>(WS_ZHYT) + (size_t)(1024 + ch) * MR;
    const bf16_t* z2 = c.wsp<bf16_t>(WS_ZHYT) + (size_t)(2048 + ch) * MR;
    const bf16_t* KF = c.wsp<bf16_t>(WS_KF);
    __syncthreads();
    { const float w0 = cw[ch], w1 = cw[3072 + ch], w2 = cw[6144 + ch], b = cb[ch];
#pragma unroll 2
      for (int t = tid; t < L; t += NTHREADS) us[t] = shortconv_at(zv, t, L, w0, w1, w2, b); }
    for (int o = 0; o < 2; ++o) {
        const bf16_t* hf = KF + (size_t)(o * 1024 + ch) * L;
        const bf16_t* hb = KF + (size_t)(2048 + o * 1024 + ch) * L;
        float sabs = 0.f;
#pragma unroll 2
        for (int t = tid; t < L; t += NTHREADS) {
            bf16_t kf = hf[t], kb = hb[t];
            if (t == 0) { kf = f2bf(bf2f(kf) + bf2f(kb)); kb = 0; }
            kc[L + t] = kf; kc[L - t] = (t == 0) ? kf : kb;
            sabs += fabsf(bf2f(kf)) + fabsf(bf2f(kb));
        }
        if (tid == 0) kc[0] = 0;
        const float S = block_sum(sabs, red, tid);
        {
            float acc[32];
#pragma unroll
            for (int j = 0; j < 32; ++j) acc[j] = 0.f;
#pragma unroll 2
            for (int s = 0; s < L; ++s) {
                const float uv = us[s];
                const bf16_t* kp = kc + (L + tid - s);
#pragma unroll
                for (int j = 0; j < 32; ++j) acc[j] = fmaf(uv, bf2f(kp[512 * j]), acc[j]);
            }
            __syncthreads();
#pragma unroll
            for (int j = 0; j < 32; ++j) cv[tid + 512 * j] = acc[j];
        }
        LDS_FENCE();
        const float invS = 1.0f / S;
        const float dsk = c.in[17][(size_t)layer * 2048 + o * 1024 + ch];
        const int co = o == 0 ? 1024 : 2048;
        const bf16_t* zz = o == 0 ? z1 : z2;
        const float w0 = cw[co + ch], w1 = cw[3072 + co + ch], w2 = cw[6144 + co + ch], b = cb[co + ch];
        bf16_t* dst = c.wsp<bf16_t>(WS_YHYT) + (size_t)ch * L;
#pragma unroll 2
        for (int t = tid; t < L; t += NTHREADS) {
            const float r = shortconv_at(zz, t, L, w0, w1, w2, b) * (cv[t] * invS + us[t] * dsk);
            if (o == 0) us[t] = r; else dst[t] = f2bf(r);
        }
        __syncthreads();
    }
}
__device__ __forceinline__ void hyena_ctx_unit(const Ctx& c, int layer, int ch) {
    float* kc = (float*)c.smem;
    float* us = kc + 512;
    float* red = us + 256;
    const int tid = c.tid;
    const float* cw = c.in[8] + (size_t)layer * 3 * 3072; const float* cb = c.in[9] + (size_t)layer * 3072;
    const bf16_t* zv = c.wsp<bf16_t>(WS_ZHYT) + (size_t)ch * MR + L;
    const bf16_t* z1 = c.wsp<bf16_t>(WS_ZHYT) + (size_t)(1024 + ch) * MR + L;
    const bf16_t* z2 = c.wsp<bf16_t>(WS_ZHYT) + (size_t)(2048 + ch) * MR + L;
    const bf16_t* KF = c.wsp<bf16_t>(WS_KFC);
    __syncthreads();
    if (tid < LC) us[tid] = shortconv_at(zv, tid, LC, cw[ch], cw[3072 + ch], cw[6144 + ch], cb[ch]);
    for (int o = 0; o < 2; ++o) {
        const bf16_t* hf = KF + (size_t)(o * 1024 + ch) * LC;
        const bf16_t* hb = KF + (size_t)(2048 + o * 1024 + ch) * LC;
        float sabs = 0.f;
        {
            const int lag = tid - 256; float k;
            if (lag == 0) k = bf2f(hf[0]) + bf2f(hb[0]); else if (lag > 0) k = bf2f(hf[lag]); else if (lag > -256) k = bf2f(hb[-lag]); else k = 0.f;
            kc[tid] = k; sabs = fabsf(k);
        }
        const float S = block_sum(sabs, red, tid);
        float acc = 0.f;
        if (tid < LC) for (int s = 0; s < LC; ++s) acc = fmaf(us[s], kc[256 + tid - s], acc);
        const float dsk = c.in[17][(size_t)layer * 2048 + o * 1024 + ch];
        float res = 0.f;
        if (tid < LC) {
            const bf16_t* zz = o == 0 ? z1 : z2; const int co = o == 0 ? 1024 : 2048;
            res = shortconv_at(zz, tid, LC, cw[co + ch], cw[3072 + co + ch], cw[6144 + co + ch], cb[co + ch]) * (acc / S + us[tid] * dsk);
        }
        __syncthreads();
        if (tid < LC) { if (o == 0) us[tid] = res; else c.wsp<bf16_t>(WS_YHY)[(size_t)(L + tid) * 1024 + ch] = f2bf(res); }
        __syncthreads();
    }
}

template <class KeyFn>
__device__ __forceinline__ void wave_attn(const bf16_t* q, int nkeys, const KeyFn& key, bool has_sink, float sink, bf16_t* out, float* wl, int lane) {
    float* qf = wl;
    float* sc = wl + 128;
    qf[2 * lane] = bf2f(q[2 * lane]); qf[2 * lane + 1] = bf2f(q[2 * lane + 1]);
    LDS_FENCE();
    float mx = -3.0e38f;
    for (int j = lane; j < nkeys; j += 64) {
        const bf16_t* kp; const bf16_t* vp; float bias;
        float s = -1e30f;
        if (key(j, kp, vp, bias)) {
            float d = 0.f;
#pragma unroll
            for (int e = 0; e < 128; e += 8) {
                const uint4 kk = *(const uint4*)(kp + e);
                d = fmaf(qf[e + 0], __uint_as_float(kk.x << 16), d); d = fmaf(qf[e + 1], __uint_as_float(kk.x & 0xffff0000u), d);
                d = fmaf(qf[e + 2], __uint_as_float(kk.y << 16), d); d = fmaf(qf[e + 3], __uint_as_float(kk.y & 0xffff0000u), d);
                d = fmaf(qf[e + 4], __uint_as_float(kk.z << 16), d); d = fmaf(qf[e + 5], __uint_as_float(kk.z & 0xffff0000u), d);
                d = fmaf(qf[e + 6], __uint_as_float(kk.w << 16), d); d = fmaf(qf[e + 7], __uint_as_float(kk.w & 0xffff0000u), d);
            }
            s = d * QK_SCALE + bias;
        }
        sc[j] = s; mx = fmaxf(mx, s);
    }
    if (has_sink) mx = fmaxf(mx, sink);
    mx = wave_max(mx);
    float sum = 0.f;
    for (int j = lane; j < nkeys; j += 64) { const float p = __expf(sc[j] - mx); sc[j] = p; sum += p; }
    sum = wave_sum(sum);
    if (has_sink) sum += __expf(sink - mx);
    LDS_FENCE();
    float o0 = 0.f, o1 = 0.f;
    for (int j = 0; j < nkeys; ++j) {
        const float p = sc[j];
        if (p != 0.f) {
            const bf16_t* kp; const bf16_t* vp; float bias;
            key(j, kp, vp, bias);
            const unsigned vv = *(const unsigned*)(vp + 2 * lane);
            o0 = fmaf(p, __uint_as_float(vv << 16), o0); o1 = fmaf(p, __uint_as_float(vv & 0xffff0000u), o1);
        }
    }
    const float inv = 1.0f / sum;
    *(unsigned*)(out + 2 * lane) = pk2(o0 * inv, o1 * inv);
    LDS_FENCE();
}

struct KeyWA {
    const bf16_t* kv; int t, kvh;
    __device__ __forceinline__ bool operator()(int j, const bf16_t*& kp, const bf16_t*& vp, float& bias) const {
        bias = 0.f;
        int row; bool ok = true;
        if (j < 257) { const int kpos = t - 128 + j; ok = kpos >= 0 && kpos < L; row = ok ? kpos : 0; } else row = L + (j - 257);
        kp = kv + (size_t)row * 512 + kvh * 128; vp = kp + 256; return ok;
    }
};
struct KeyCtxWA { const bf16_t* kv; int kvh;
    __device__ __forceinline__ bool operator()(int j, const bf16_t*& kp, const bf16_t*& vp, float& bias) const { bias = 0.f; kp = kv + (size_t)(L + j) * 512 + kvh * 128; vp = kp + 256; return true; } };
struct KeyNA {
    const bf16_t* kv; const float* rpb; int r, qc, r0, cs, h;
    __device__ __forceinline__ bool operator()(int j, const bf16_t*& kp, const bf16_t*& vp, float& bias) const {
        int row;
        if (j < 128) { const int w = j >> 4, kc = cs + (j & 15); row = (r0 + w) * GRIDW + kc;
            const int dr = r0 + w - r + 7; int dc = kc - qc + 15; dc = dc < 0 ? 0 : (dc > 30 ? 30 : dc);
            bias = rpb[(h * 15 + dr) * 31 + dc]; }
        else { row = L + (j - 128); bias = 0.f; }
        kp = kv + (size_t)row * 2048 + h * 128; vp = kp + 1024; return true;
    }
};
struct KeyCtxNA { const bf16_t* kv; int h;
    __device__ __forceinline__ bool operator()(int j, const bf16_t*& kp, const bf16_t*& vp, float& bias) const { bias = 0.f; kp = kv + (size_t)(L + j) * 2048 + h * 128; vp = kp + 1024; return true; } };


#define HYF __device__ __forceinline__
#define HYF_OPAQUE(x) asm volatile("" : "+v"(x))
#define HYF_SB(i) do { if (((i) & 3) == 3) __builtin_amdgcn_sched_barrier(0); } while (0)
namespace hyf {
constexpr int FL = 16384;
constexpr int FPAD = FL + 32 * 16;
typedef float cpx __attribute__((ext_vector_type(2)));
HYF int phys(int p) { return ((p & ~15) | ((p & 15) ^ ((p >> 5) & 15))) + ((p >> 9) << 4); }

#define HYF_C32 {1.0f, 0.98078528040323043f, 0.92387953251128674f, 0.83146961230254524f, 0.70710678118654752f, 0.55557023301960218f, 0.38268343236508978f, 0.19509032201612825f, \
                 0.0f, -0.19509032201612825f, -0.38268343236508978f, -0.55557023301960218f, -0.70710678118654752f, -0.83146961230254524f, -0.92387953251128674f, -0.98078528040323043f}
#define HYF_S32 {0.0f, 0.19509032201612825f, 0.38268343236508978f, 0.55557023301960218f, 0.70710678118654752f, 0.83146961230254524f, 0.92387953251128674f, 0.98078528040323043f, \
                 1.0f, 0.98078528040323043f, 0.92387953251128674f, 0.83146961230254524f, 0.70710678118654752f, 0.55557023301960218f, 0.38268343236508978f, 0.19509032201612825f}

HYF int rev5(int x) { return (int)(__builtin_bitreverse32((unsigned)x) >> 27); }
HYF int rev4(int x) { return (int)(__builtin_bitreverse32((unsigned)x) >> 28); }
HYF cpx cmul(cpx a, cpx t) { return a.xx * t + (cpx){-a.y, a.y} * t.yx; }
HYF cpx cmulc(cpx a, cpx t) { return t.xx * a + t.yy * (cpx){a.y, -a.x}; }

template <int N, int SG, int BASE, int STRIDE32>
struct DifStage {
    static HYF void run(cpx (&v)[32], const float (&K)[9]) {
        constexpr int H = N / 2;
#pragma unroll
        for (int j = 0; j < H; ++j) {
            const cpx a = v[BASE + j], b = v[BASE + j + H];
            v[BASE + j] = a + b;
            const cpx d = a - b;
            const int tw = j * STRIDE32;
            if (tw == 0) v[BASE + j + H] = d;
            else if (tw == 8) v[BASE + j + H] = (SG < 0) ? (cpx){d.y, -d.x} : (cpx){-d.y, d.x};
            else {
                const float c = (tw < 8) ? K[tw] : -K[16 - tw];
                const float sa = (tw < 8) ? K[8 - tw] : K[tw - 8];
                const float s = (SG < 0) ? -sa : sa;
                v[BASE + j + H] = d * c + (cpx){-d.y, d.x} * s;
            }
        }
        if constexpr (N > 2) { DifStage<H, SG, BASE, STRIDE32 * 2>::run(v, K); DifStage<H, SG, BASE + H, STRIDE32 * 2>::run(v, K); }
    }
};
template <int SG> HYF void dft32(cpx (&v)[32], const float (&K0)[9]) { float K[9]; _Pragma("unroll") for (int m = 0; m < 9; ++m) { K[m] = K0[m]; HYF_OPAQUE(K[m]); } DifStage<32, SG, 0, 1>::run(v, K); }
template <int SG> HYF void dft16(cpx (&v)[32], const float (&K0)[9]) { float K[9]; _Pragma("unroll") for (int m = 0; m < 9; ++m) { K[m] = K0[m]; HYF_OPAQUE(K[m]); } DifStage<16, SG, 0, 2>::run(v, K); }

struct ThreadTw { cpx w1;
                  cpx w2;
                  cpx wo;
                  int b1;
                  int b2, n3;
                  int b3[2], sw;
                  float K[9]; };
HYF void tw_addr(int tid, ThreadTw& t) {
    t.b1 = (tid & ~15) | ((tid & 15) ^ ((tid >> 5) & 15));
    t.b2 = (tid >> 4) * 528; t.n3 = tid & 15; t.sw = (tid >> 1) & 15;
    for (int h = 0; h < 2; ++h) { const int g = tid + 512 * h; t.b3[h] = g * 16 + (g >> 5) * 16; }
    constexpr float KK[9] = {1.0f, 0.98078528040323043f, 0.92387953251128674f, 0.83146961230254524f, 0.70710678118654752f, 0.55557023301960218f, 0.38268343236508978f, 0.19509032201612825f, 0.0f};
    for (int m = 0; m < 9; ++m) { t.K[m] = KK[m]; HYF_OPAQUE(t.K[m]); }
}

HYF void fwd_p1(const ThreadTw& tw, cpx (&v)[32], cpx* lds) {
    int b1 = tw.b1; HYF_OPAQUE(b1);
    float wx = tw.w1.x, wy = tw.w1.y; HYF_OPAQUE(wx); HYF_OPAQUE(wy); const cpx w = {wx, wy};
    dft32<-1>(v, tw.K);
    cpx t = {1.f, 0.f};
#pragma unroll
    for (int k1 = 0; k1 < 32; ++k1) {
        lds[b1 + 528 * k1] = cmul(v[rev5(k1)], t);
        t = cmul(t, w);
        HYF_SB(k1);
    }
}
HYF void fwd_p2(const ThreadTw& tw, cpx* lds) {
    int b2 = tw.b2, n3 = tw.n3; HYF_OPAQUE(b2); HYF_OPAQUE(n3);
    float wx = tw.w2.x, wy = tw.w2.y; HYF_OPAQUE(wx); HYF_OPAQUE(wy); const cpx w = {wx, wy};
    cpx v[32];
#pragma unroll
    for (int n2 = 0; n2 < 32; ++n2) v[n2] = lds[b2 + 16 * n2 + (n3 ^ ((n2 >> 1) & 15))];
    dft32<-1>(v, tw.K);
    cpx t = {1.f, 0.f};
#pragma unroll
    for (int k2 = 0; k2 < 32; ++k2) {
        lds[b2 + 16 * k2 + (n3 ^ ((k2 >> 1) & 15))] = cmul(v[rev5(k2)], t);
        t = cmul(t, w);
        HYF_SB(k2);
    }
}
HYF void fwd_p3(int tid, const ThreadTw& tw, const cpx* lds, cpx* ks) {
    HYF_OPAQUE(tid);
#pragma unroll
    for (int h = 0; h < 2; ++h) {
        int b3 = tw.b3[h], sw = tw.sw; HYF_OPAQUE(b3); HYF_OPAQUE(sw);
        cpx v[32];
#pragma unroll
        for (int n3 = 0; n3 < 16; ++n3) v[n3] = lds[b3 + (n3 ^ sw)];
        dft16<-1>(v, tw.K);
#pragma unroll
        for (int k3 = 0; k3 < 16; ++k3) ks[(h * 16 + k3) * 512 + tid] = v[rev4(k3)];
    }
}
HYF void mid_p3(int tid, const ThreadTw& tw, cpx* lds, const cpx* ks) {
    HYF_OPAQUE(tid);
#pragma unroll
    for (int h = 0; h < 2; ++h) {
        int b3 = tw.b3[h], sw = tw.sw; HYF_OPAQUE(b3); HYF_OPAQUE(sw);
        cpx v[32], p[32];
#pragma unroll
        for (int n3 = 0; n3 < 16; ++n3) v[n3] = lds[b3 + (n3 ^ sw)];
        dft16<-1>(v, tw.K);
#pragma unroll
        for (int k3 = 0; k3 < 16; ++k3) p[k3] = cmul(v[rev4(k3)], ks[(h * 16 + k3) * 512 + tid]);
        dft16<1>(p, tw.K);
#pragma unroll
        for (int n3 = 0; n3 < 16; ++n3) lds[b3 + (n3 ^ sw)] = p[rev4(n3)];
    }
}
HYF void inv_p2(const ThreadTw& tw, cpx* lds) {
    int b2 = tw.b2, n3 = tw.n3; HYF_OPAQUE(b2); HYF_OPAQUE(n3);
    float wx = tw.w2.x, wy = tw.w2.y; HYF_OPAQUE(wx); HYF_OPAQUE(wy); const cpx w = {wx, wy};
    cpx v[32];
    cpx t = {1.f, 0.f};
#pragma unroll
    for (int k2 = 0; k2 < 32; ++k2) {
        v[k2] = cmulc(lds[b2 + 16 * k2 + (n3 ^ ((k2 >> 1) & 15))], t);
        t = cmul(t, w);
        HYF_SB(k2);
    }
    dft32<1>(v, tw.K);
#pragma unroll
    for (int n2 = 0; n2 < 32; ++n2) { lds[b2 + 16 * n2 + (n3 ^ ((n2 >> 1) & 15))] = v[rev5(n2)]; HYF_SB(n2); }
}
HYF void inv_p1(const ThreadTw& tw, const cpx* lds, cpx (&out)[32]) {
    int b1 = tw.b1; HYF_OPAQUE(b1);
    float wx = tw.w1.x, wy = tw.w1.y; HYF_OPAQUE(wx); HYF_OPAQUE(wy); const cpx w = {wx, wy};
    cpx v[32];
    cpx t = {1.f, 0.f};
#pragma unroll
    for (int k1 = 0; k1 < 32; ++k1) {
        v[k1] = cmulc(lds[b1 + 528 * k1], t);
        t = cmul(t, w);
        HYF_SB(k1);
    }
    dft32<1>(v, tw.K);
#pragma unroll
    for (int n1 = 0; n1 < 32; ++n1) out[n1] = v[rev5(n1)];
}
HYF cpx opaque_wo(const ThreadTw& tw) { float x = tw.wo.x, y = tw.wo.y; HYF_OPAQUE(x); HYF_OPAQUE(y); return (cpx){x, y}; }
HYF cpx modfac(cpx wo, int n1) {
    constexpr float C64[32] = {1.0f, 0.99518472667219693f, 0.98078528040323043f, 0.95694033573220882f, 0.92387953251128674f, 0.88192126434835505f, 0.83146961230254524f, 0.77301045336273699f,
        0.70710678118654752f, 0.63439328416364549f, 0.55557023301960218f, 0.47139673682599764f, 0.38268343236508978f, 0.29028467725446233f, 0.19509032201612825f, 0.098017140329560604f,
        0.0f, -0.098017140329560604f, -0.19509032201612825f, -0.29028467725446233f, -0.38268343236508978f, -0.47139673682599764f, -0.55557023301960218f, -0.63439328416364549f,
        -0.70710678118654752f, -0.77301045336273699f, -0.83146961230254524f, -0.88192126434835505f, -0.92387953251128674f, -0.95694033573220882f, -0.98078528040323043f, -0.99518472667219693f};
    constexpr float S64[32] = {0.0f, 0.098017140329560604f, 0.19509032201612825f, 0.29028467725446233f, 0.38268343236508978f, 0.47139673682599764f, 0.55557023301960218f, 0.63439328416364549f,
        0.70710678118654752f, 0.77301045336273699f, 0.83146961230254524f, 0.88192126434835505f, 0.92387953251128674f, 0.95694033573220882f, 0.98078528040323043f, 0.99518472667219693f,
        1.0f, 0.99518472667219693f, 0.98078528040323043f, 0.95694033573220882f, 0.92387953251128674f, 0.88192126434835505f, 0.83146961230254524f, 0.77301045336273699f,
        0.70710678118654752f, 0.63439328416364549f, 0.55557023301960218f, 0.47139673682599764f, 0.38268343236508978f, 0.29028467725446233f, 0.19509032201612825f, 0.098017140329560604f};
    return cmul(wo, (cpx){C64[n1], -S64[n1]});
}
}

#undef HYF
#ifndef FAST_HY
#define FAST_HY 1
#endif
__device__ __forceinline__ void hyena_fft_unit(const Ctx& c, int layer, int ch, const hyf::ThreadTw& tw) {
    using namespace hyf;
    cpx* lds = (cpx*)c.smem; float* red = (float*)(c.smem + (size_t)FPAD * 8);
    cpx* ks = c.wsp<cpx>(WS_KS) + (size_t)c.bid * (2 * FL);
    float* ub = (float*)(ks + FL); float* yb = ub + FL;
    const int tid = c.tid;
    const float* cw = c.in[8] + (size_t)layer * 3 * 3072; const float* cb = c.in[9] + (size_t)layer * 3072;
    const bf16_t* zv = c.wsp<bf16_t>(WS_ZHYT) + (size_t)ch * MR;
    const bf16_t* KF = c.wsp<bf16_t>(WS_KF);
    { const float w0 = cw[ch], w1 = cw[3072 + ch], w2 = cw[6144 + ch], b = cb[ch]; int tq = tid; HYF_OPAQUE(tq);
#pragma unroll 4
      for (int j = 0; j < 32; ++j) ub[tq + 512 * j] = shortconv_at(zv, tq + 512 * j, L, w0, w1, w2, b); }
#pragma unroll 1
    for (int o = 0; o < 2; ++o) {
        const bf16_t* hf = KF + (size_t)(o * 1024 + ch) * L;
        const bf16_t* hb = KF + (size_t)(2048 + o * 1024 + ch) * L;
        float S;
        {
            cpx v[32]; float sabs = 0.f; int tq = tid; HYF_OPAQUE(tq);
#pragma unroll
            for (int j = 0; j < 32; ++j) { const int n = tq + 512 * j; const float f = bf2f(hf[n]); const float bb = bf2f(hb[n == 0 ? 0 : L - n]);
                v[j] = (cpx){f + bb, 0.f}; sabs += (n == 0) ? fabsf(f + bb) : fabsf(f) + fabsf(bb); }
            S = block_sum(sabs, red, tid);
            fwd_p1(tw, v, lds); __syncthreads(); fwd_p2(tw, lds); __syncthreads(); fwd_p3(tid, tw, lds, ks); __syncthreads();
        }
        {
            cpx v[32]; int tq = tid; HYF_OPAQUE(tq);
#pragma unroll
            for (int j = 0; j < 32; ++j) v[j] = (cpx){ub[tq + 512 * j], 0.f};
            fwd_p1(tw, v, lds); __syncthreads(); fwd_p2(tw, lds); __syncthreads(); mid_p3(tid, tw, lds, ks); __syncthreads();
            inv_p2(tw, lds); __syncthreads();
            inv_p1(tw, lds, v); __syncthreads();
            HYF_OPAQUE(tq);
#pragma unroll
            for (int j = 0; j < 32; ++j) yb[tq + 512 * j] = v[j].x;
        }
        {
            cpx v[32]; const cpx wo = opaque_wo(tw); int tq = tid; HYF_OPAQUE(tq);
#pragma unroll
            for (int j = 0; j < 32; ++j) { const int n = tq + 512 * j; const float f = bf2f(hf[n]); const float bb = bf2f(hb[n == 0 ? 0 : L - n]);
                const float d = (n == 0) ? f + bb : f - bb; v[j] = modfac(wo, j) * d; }
            fwd_p1(tw, v, lds); __syncthreads(); fwd_p2(tw, lds); __syncthreads(); fwd_p3(tid, tw, lds, ks); __syncthreads();
        }
        {
            cpx v[32]; cpx wo = opaque_wo(tw); int tq = tid; HYF_OPAQUE(tq);
#pragma unroll
            for (int j = 0; j < 32; ++j) v[j] = modfac(wo, j) * ub[tq + 512 * j];
            fwd_p1(tw, v, lds); __syncthreads(); fwd_p2(tw, lds); __syncthreads(); mid_p3(tid, tw, lds, ks); __syncthreads();
            inv_p2(tw, lds); __syncthreads();
            inv_p1(tw, lds, v); __syncthreads();
            const float sc = (0.5f / (float)L) / S; wo = opaque_wo(tw); HYF_OPAQUE(tq);
            const float dsk = c.in[17][(size_t)layer * 2048 + o * 1024 + ch];
            const int co = o == 0 ? 1024 : 2048;
            const bf16_t* zz = c.wsp<bf16_t>(WS_ZHYT) + (size_t)(co + ch) * MR;
            const float w0 = cw[co + ch], w1 = cw[3072 + co + ch], w2 = cw[6144 + co + ch], b = cb[co + ch];
            bf16_t* dst = c.wsp<bf16_t>(WS_YHYT) + (size_t)ch * L;
#pragma unroll
            for (int j = 0; j < 32; ++j) { const int t = tq + 512 * j; const cpx m = modfac(wo, j);
                const float conv = (yb[t] + v[j].x * m.x + v[j].y * m.y) * sc;
                const float r = shortconv_at(zz, t, L, w0, w1, w2, b) * (conv + ub[t] * dsk);
                if (o == 0) ub[t] = r; else dst[t] = f2bf(r); }
        }
    }
}


#ifndef FAST_ATT
#define FAST_ATT 1
#endif
namespace fa {
using bf16x8 = __attribute__((ext_vector_type(8))) short;
using s16x4  = __attribute__((ext_vector_type(4))) short;
using f32x16 = __attribute__((ext_vector_type(16))) float;
using u32x4  = __attribute__((ext_vector_type(4))) unsigned;
constexpr int AD = 128, NW = 8, QBLK = 32, KVBLK = 64;
constexpr float SCALE = 0.088388347648318440f;
constexpr float THR = 8.f;
constexpr size_t SHM_V = KVBLK * AD * 2, SHM_K = KVBLK * AD * 2, SHM_ATTN = 2 * SHM_V + 2 * SHM_K + NW * 64 * 4;
constexpr float NEG = -1e30f;
#define KSWZ(row, colB) ((row) * 256 + ((colB) ^ (((row) & 7) << 4)))
#define SBAR() __builtin_amdgcn_sched_barrier(0)
__device__ __forceinline__ int crow(int r, int hi) { return (r & 3) + 8 * (r >> 2) + 4 * hi; }
__device__ __forceinline__ unsigned cvtpk(float lo, float hi) { unsigned r; asm volatile("v_cvt_pk_bf16_f32 %0, %1, %2" : "=v"(r) : "v"(lo), "v"(hi)); return r; }
__device__ __forceinline__ void partialSM(f32x16& p0, f32x16& p1, float& m_reg, float& mn, float& alpha) {
  constexpr float C = SCALE * 1.4426950408889634f;
  float pmax = p0[0];
#pragma unroll
  for (int r = 1; r < 16; ++r) pmax = fmaxf(pmax, p0[r]);
#pragma unroll
  for (int r = 0; r < 16; ++r) pmax = fmaxf(pmax, p1[r]);
  { auto rr = __builtin_amdgcn_permlane32_swap(__float_as_uint(pmax), __float_as_uint(pmax), false, false);
    pmax = fmaxf(__uint_as_float(rr[0]), __uint_as_float(rr[1])); }
  if (__builtin_expect(__all(pmax - m_reg <= THR / SCALE), 1)) { mn = m_reg; alpha = 1.f; }
  else { mn = fmaxf(m_reg, pmax); alpha = __builtin_amdgcn_exp2f((m_reg - mn) * C); m_reg = mn; }
  const float mnC = -mn * C;
#pragma unroll
  for (int r = 0; r < 16; ++r) p0[r] = fmaf(p0[r], C, mnC);
#pragma unroll
  for (int r = 0; r < 16; ++r) p1[r] = fmaf(p1[r], C, mnC);
#pragma unroll
  for (int r = 0; r < 16; ++r) p0[r] = __builtin_amdgcn_exp2f(p0[r]);
}
__device__ __forceinline__ void finishSM(f32x16& p0, f32x16& p1, float alpha, float& l_reg, bf16x8& pa0, bf16x8& pa1, bf16x8& pa2, bf16x8& pa3) {
#pragma unroll
  for (int r = 0; r < 16; ++r) p1[r] = __builtin_amdgcn_exp2f(p1[r]);
  float ps = 0;
#pragma unroll
  for (int r = 0; r < 16; ++r) ps += p0[r];
#pragma unroll
  for (int r = 0; r < 16; ++r) ps += p1[r];
  { auto rr = __builtin_amdgcn_permlane32_swap(__float_as_uint(ps), __float_as_uint(ps), false, false);
    ps = __uint_as_float(rr[0]) + __uint_as_float(rr[1]); }
  l_reg = l_reg * alpha + ps;
#define PK4(P, BASE, OUT) do { unsigned a0 = cvtpk(P[BASE + 0], P[BASE + 1]), a1 = cvtpk(P[BASE + 2], P[BASE + 3]);   \
    unsigned b0 = cvtpk(P[BASE + 4], P[BASE + 5]), b1 = cvtpk(P[BASE + 6], P[BASE + 7]);                              \
    auto r0 = __builtin_amdgcn_permlane32_swap(a0, b0, false, false); auto r1 = __builtin_amdgcn_permlane32_swap(a1, b1, false, false); \
    u32x4 w = {r0[0], r1[0], r0[1], r1[1]}; OUT = *reinterpret_cast<bf16x8*>(&w); } while (0)
  PK4(p0, 0, pa0); PK4(p0, 8, pa1); PK4(p1, 0, pa2); PK4(p1, 8, pa3);
#undef PK4
}
__device__ __forceinline__ void qkt(f32x16& p0, f32x16& p1, const char* Ks, const bf16x8* qr, int r32, int hi) {
  p0 = f32x16{}; p1 = f32x16{};
#pragma unroll
  for (int d0 = 0; d0 < 8; ++d0) { const int cb = (d0 * 16 + hi * 8) * 2;
    const bf16x8 b0 = *reinterpret_cast<const bf16x8*>(Ks + KSWZ(r32, cb));
    const bf16x8 b1 = *reinterpret_cast<const bf16x8*>(Ks + KSWZ(32 + r32, cb));
    p0 = __builtin_amdgcn_mfma_f32_32x32x16_bf16(b0, qr[d0], p0, 0, 0, 0);
    p1 = __builtin_amdgcn_mfma_f32_32x32x16_bf16(b1, qr[d0], p1, 0, 0, 0); }
}
__device__ __forceinline__ int v_st(int k, int c) { const int kk = (k & ~0xC) | ((k & 4) << 1) | ((k & 8) >> 1); return ((kk >> 3) * 4 + (c >> 5)) * 512 + ((kk & 7) * 32 + (c & 31)) * 2; }
__device__ __forceinline__ int v_rd_base(int lane) { return ((lane & 3) << 3) | (((lane >> 2) & 3) << 6) | (((lane >> 4) & 1) << 5) | (((lane >> 5) & 1) << 8); }
constexpr int v_rd_off(int d0, int ks, int half) { return d0 * 512 + ks * 4096 + half * 2048; }
template <int OFF> __device__ __forceinline__ s16x4 tr_read(int vb) { s16x4 r; asm volatile("ds_read_b64_tr_b16 %0, %1 offset:%2" : "=&v"(r) : "v"(vb), "i"(OFF) : "memory"); return r; }
template <int D0> __device__ __forceinline__ void pv_one(f32x16& od, int vb, bf16x8 pa0, bf16x8 pa1, bf16x8 pa2, bf16x8 pa3) {
  const s16x4 l0 = tr_read<v_rd_off(D0, 0, 0)>(vb), h0 = tr_read<v_rd_off(D0, 0, 1)>(vb), l1 = tr_read<v_rd_off(D0, 1, 0)>(vb), h1 = tr_read<v_rd_off(D0, 1, 1)>(vb);
  const s16x4 l2 = tr_read<v_rd_off(D0, 2, 0)>(vb), h2 = tr_read<v_rd_off(D0, 2, 1)>(vb), l3 = tr_read<v_rd_off(D0, 3, 0)>(vb), h3 = tr_read<v_rd_off(D0, 3, 1)>(vb);
  asm volatile("s_waitcnt lgkmcnt(0)" ::: "memory"); SBAR();
#define PK(Lo, Hi) (bf16x8){Lo[0], Lo[1], Lo[2], Lo[3], Hi[0], Hi[1], Hi[2], Hi[3]}
  od = __builtin_amdgcn_mfma_f32_32x32x16_bf16(pa0, PK(l0, h0), od, 0, 0, 0);
  od = __builtin_amdgcn_mfma_f32_32x32x16_bf16(pa1, PK(l1, h1), od, 0, 0, 0);
  od = __builtin_amdgcn_mfma_f32_32x32x16_bf16(pa2, PK(l2, h2), od, 0, 0, 0);
  od = __builtin_amdgcn_mfma_f32_32x32x16_bf16(pa3, PK(l3, h3), od, 0, 0, 0);
#undef PK
}
__device__ __forceinline__ void pv_d0(f32x16* o, int vb, bf16x8 pa0, bf16x8 pa1, bf16x8 pa2, bf16x8 pa3) {
  pv_one<0>(o[0], vb, pa0, pa1, pa2, pa3); pv_one<1>(o[1], vb, pa0, pa1, pa2, pa3); pv_one<2>(o[2], vb, pa0, pa1, pa2, pa3); pv_one<3>(o[3], vb, pa0, pa1, pa2, pa3);
}

template <class Tiles>
__device__ __forceinline__ void attn_unit(const bf16_t* __restrict__ Qb, int ldq, const bf16_t* __restrict__ Kb, const bf16_t* __restrict__ Vb, int ldk,
                                          bf16_t* __restrict__ Ob, int ldo, const Tiles& T, int NT, bool has_sink, float sink, char* lds) {
  int tid = threadIdx.x; asm volatile("" : "+v"(tid));
  const int wid = __builtin_amdgcn_readfirstlane(tid >> 6), lane = tid & 63, r32 = lane & 31, hi = lane >> 5;
  char* V_lds = lds; char* K_lds = lds + 2 * SHM_V;
  float* ws = (float*)(lds + 2 * SHM_V + 2 * SHM_K) + wid * 64; float* li_l = ws; float* al_l = ws + 32;
  float m_reg = -1e30f, l_reg = 0; f32x16 o[4] = {}; bf16x8 qr[8];
  const bf16_t* Qw = Qb + (long)(wid * QBLK + r32) * ldq + hi * 8;
#pragma unroll
  for (int d0 = 0; d0 < 8; ++d0) qr[d0] = *reinterpret_cast<const bf16x8*>(Qw + d0 * 16);
  const int sr = tid >> 4, sc = (tid & 15) * 8, vst0 = v_st(sr, sc), vst1 = v_st(32 + sr, sc);
  const int vb0 = (int)(uintptr_t)V_lds + v_rd_base(lane);
  bf16x8 vs0, vs1, ks0, ks1;
#define SLOAD(j) do { const long _k0 = T.row(j); vs0 = *reinterpret_cast<const bf16x8*>(&Vb[(_k0 + sr) * ldk + sc]); vs1 = *reinterpret_cast<const bf16x8*>(&Vb[(_k0 + 32 + sr) * ldk + sc]); \
    ks0 = *reinterpret_cast<const bf16x8*>(&Kb[(_k0 + sr) * ldk + sc]); ks1 = *reinterpret_cast<const bf16x8*>(&Kb[(_k0 + 32 + sr) * ldk + sc]); } while (0)
#define SWRITE(b) do { *(bf16x8*)(V_lds + (b) * SHM_V + vst0) = vs0; *(bf16x8*)(V_lds + (b) * SHM_V + vst1) = vs1; const int kc = sc * 2; \
    *(bf16x8*)(K_lds + (b) * SHM_K + KSWZ(sr, kc)) = ks0; *(bf16x8*)(K_lds + (b) * SHM_K + KSWZ(32 + sr, kc)) = ks1; } while (0)
  __syncthreads();
  SLOAD(0); asm volatile("s_waitcnt vmcnt(0)" ::: "memory"); SWRITE(0);
  if (1 < NT) SLOAD(1);
#pragma unroll 1
  for (int j = 0; j < NT; ++j) {
    const int b = j & 1;
    __syncthreads();
    if (j + 1 < NT) { asm volatile("s_waitcnt vmcnt(0)" ::: "memory"); SWRITE(b ^ 1); if (j + 2 < NT) SLOAD(j + 2); }
    if (T.active(j, wid)) {
      f32x16 p0, p1; float mn, alpha; bf16x8 pa0, pa1, pa2, pa3;
      qkt(p0, p1, K_lds + b * SHM_K, qr, r32, hi); T.mask(p0, p1, j, wid, r32, hi);
      partialSM(p0, p1, m_reg, mn, alpha);
      if (__any(alpha < 1.f)) { if (hi == 0) al_l[r32] = alpha; asm volatile("s_waitcnt lgkmcnt(0)" ::: "memory");
#pragma unroll
        for (int d = 0; d < 4; ++d)
#pragma unroll
          for (int r = 0; r < 16; ++r) o[d][r] *= al_l[crow(r, hi)]; }
      finishSM(p0, p1, alpha, l_reg, pa0, pa1, pa2, pa3); SBAR();
      pv_d0(o, vb0 + b * (int)SHM_V, pa0, pa1, pa2, pa3);
    }
  }
  if (has_sink) { constexpr float C = SCALE * 1.4426950408889634f; l_reg += __builtin_amdgcn_exp2f(fmaf(sink, 1.4426950408889634f, -m_reg * C)); }
  if (hi == 0) li_l[r32] = l_reg; asm volatile("s_waitcnt lgkmcnt(0)" ::: "memory");
  float rli[16];
#pragma unroll
  for (int r = 0; r < 16; ++r) rli[r] = __builtin_amdgcn_rcpf(li_l[crow(r, hi)]);
  bf16_t* Ow = Ob + (long)(wid * QBLK) * ldo;
#pragma unroll
  for (int r = 0; r < 16; ++r) { const int orow = crow(r, hi);
#pragma unroll
    for (int d0 = 0; d0 < 4; ++d0) Ow[(long)orow * ldo + d0 * 32 + r32] = f2bf(o[d0][r] * rli[r]); }
#undef SLOAD
#undef SWRITE
}
#undef KSWZ
#undef SBAR

struct TilesGen {
  int mode, i0, lo, R, glo, nloc; const float* bias;
  __device__ __forceinline__ long row(int j) const {
    if (j < 4) return L + 64 * j;
    if (mode == 0) return lo + 64 * (j - 4);
    return (long)(glo + (j - 4)) * 64;
  }
  __device__ __forceinline__ bool active(int j, int wid) const {
    if (j < 4 || mode == 2) return true;
    if (mode == 0) { const int Tr = lo + 64 * (j - 4), q0 = i0 + 32 * wid; return Tr + 63 >= q0 - 128 && Tr <= q0 + 31 + 128; }
    const int kr = glo + (j - 4), qr = R + (wid >> 1);
    int r0 = qr - 4; r0 = r0 < 0 ? 0 : (r0 > 248 ? 248 : r0);
    return kr >= r0 && kr <= r0 + 7;
  }
  __device__ __forceinline__ void mask(f32x16& p0, f32x16& p1, int j, int wid, int r32, int hi) const {
    if (j < 4 || mode == 2) return;
    if (mode == 0) {
      const int Tr = lo + 64 * (j - 4), q0 = i0 + 32 * wid;
      if (q0 + 31 - Tr <= 128 && Tr + 63 - q0 <= 128) return;
      const int dq = q0 + r32 - Tr;
#pragma unroll
      for (int r = 0; r < 16; ++r) { const int kk = crow(r, hi); p0[r] = (kk >= dq - 128 && kk <= dq + 128) ? p0[r] : NEG; p1[r] = (kk + 32 >= dq - 128 && kk + 32 <= dq + 128) ? p1[r] : NEG; }
      return;
    }
    const int kr = glo + (j - 4), qr = R + (wid >> 1), qc = (wid & 1) * 32 + r32;
    int cs = qc - 8; cs = cs < 0 ? 0 : (cs > 48 ? 48 : cs);
    const float* bt = bias + (kr - qr + 7) * 32 + (15 - qc);
#pragma unroll
    for (int r = 0; r < 16; ++r) { const int k0 = crow(r, hi), k1 = k0 + 32;
      const bool v0 = (unsigned)(k0 - cs) < 16u, v1 = (unsigned)(k1 - cs) < 16u;
      p0[r] = v0 ? p0[r] + bt[v0 ? k0 : cs] : NEG; p1[r] = v1 ? p1[r] + bt[v1 ? k1 : cs] : NEG; }
  }
};
}

__device__ __forceinline__ void ph_attn_fast(const Ctx& c, int layer) {
  char* lds = (char*)c.smem;
  float* btab = (float*)(c.smem + fa::SHM_ATTN);
  const bf16_t* QWA = c.wsp<bf16_t>(WS_QWA); const bf16_t* KVWA = c.wsp<bf16_t>(WS_KVWA); bf16_t* YWA = c.wsp<bf16_t>(WS_YWA);
  const bf16_t* QNA = c.wsp<bf16_t>(WS_QNA); const bf16_t* KVNA = c.wsp<bf16_t>(WS_KVNA); bf16_t* YNA = c.wsp<bf16_t>(WS_YNA);
  const float* sinkp = c.in[20] + layer * 8; const float* rpb = c.in[23] + (size_t)layer * 8 * 15 * 31;
  const int nq = L / 256;
  const int nunits = 2 * 8 * nq + (layer == 0 ? 16 : 0);
#pragma unroll 1
  for (int u = c.bid; u < nunits; u += c.nb) {
    fa::TilesGen T; T.mode = 2; T.i0 = 0; T.lo = 0; T.R = 0; T.glo = 0; T.nloc = 0; T.bias = btab;
    int h, i0, NT; bool wa;
    if (u < 8 * nq) {
      wa = true; h = u / nq; i0 = (u % nq) * 256;
      const int lo = i0 - 128 < 0 ? 0 : i0 - 128, hiR = i0 + 384 > L ? L : i0 + 384;
      T.mode = 0; T.i0 = i0; T.lo = lo; NT = 4 + (hiR - lo) / 64;
    } else if (u < 16 * nq) {
      const int v = u - 8 * nq; wa = false; h = v / nq; const int qb = v % nq; i0 = qb * 256; const int R = qb * 4;
      int glo = R - 4; glo = glo < 0 ? 0 : (glo > 248 ? 248 : glo);
      int gh = R + 3 - 4; gh = gh < 0 ? 0 : (gh > 248 ? 248 : gh); gh += 7;
      T.mode = 1; T.R = R; T.glo = glo; T.nloc = gh - glo + 1; NT = 4 + T.nloc;
      __syncthreads();
      for (int e = c.tid; e < 15 * 32; e += NTHREADS) { const int dr = e >> 5, dc = e & 31; btab[e] = dc < 31 ? rpb[(h * 15 + dr) * 31 + dc] * (1.0f / fa::SCALE) : 0.f; }
    } else {
      const int v = u - 16 * nq; wa = v < 8; h = v & 7; i0 = L; NT = 4;
    }
    const bf16_t* Q = (wa ? QWA : QNA) + (size_t)i0 * 1024 + h * 128;
    const bf16_t* Kb = wa ? KVWA + (h >> 2) * 128 : KVNA + h * 128;
    const bf16_t* Vb = wa ? KVWA + 256 + (h >> 2) * 128 : KVNA + 1024 + h * 128;
    bf16_t* O = (wa ? YWA : YNA) + (size_t)i0 * 1024 + h * 128;
    fa::attn_unit(Q, 1024, Kb, Vb, wa ? 512 : 2048, O, 1024, T, NT, wa, wa ? sinkp[h] : 0.f, lds);
  }
}

__device__ __forceinline__ void ph_c(const Ctx& c, int layer) {
#ifndef NO_HY
    if (FAST_HY) {
        hyf::ThreadTw tw; hyf::tw_addr(c.tid, tw);
        { float s_, c_; sincospif(-2.0f * (float)c.tid / (float)hyf::FL, &s_, &c_); tw.w1 = (hyf::cpx){c_, s_};
          sincospif(-2.0f * (float)(c.tid & 15) / 512.0f, &s_, &c_); tw.w2 = (hyf::cpx){c_, s_};
          sincospif(-(float)c.tid / (float)hyf::FL, &s_, &c_); tw.wo = (hyf::cpx){c_, s_}; }
        for (int u = c.bid; u < 1024; u += c.nb) hyena_fft_unit(c, layer, u, tw);
        if constexpr (DOREP(16)) { for (int u = c.bid; u < 1024; u += c.nb) hyena_fft_unit(c, layer, u, tw); }
    } else
    for (int u = c.bid; u < 1024; u += c.nb) hyena_direct_unit(c, layer, u);
#endif
#ifndef NO_HYC
    if (layer == 0) for (int u = c.bid; u < 1024; u += c.nb) hyena_ctx_unit(c, layer, u);
#endif
    __syncthreads();
#ifndef NO_ATT
    if (FAST_ATT) { ph_attn_fast(c, layer); return; }
    const int gw = c.bid * 8 + c.wave, ngw = c.nb * 8;
    float* wl = (float*)c.smem + c.wave * 768;
    const int nrows = layer == 0 ? MR : L;
    const float* sinkp = c.in[20] + layer * 8;
    const float* rpb = c.in[23] + (size_t)layer * 8 * 15 * 31;
    const bf16_t* kvwa = c.wsp<bf16_t>(WS_KVWA); const bf16_t* kvna = c.wsp<bf16_t>(WS_KVNA);
    for (int task = gw; task < nrows * 16; task += ngw) {
        const int r = task >> 4, hh = task & 15;
        if (hh < 8) {
            const int h = hh; const bf16_t* q = c.wsp<bf16_t>(WS_QWA) + (size_t)r * 1024 + h * 128; bf16_t* o = c.wsp<bf16_t>(WS_YWA) + (size_t)r * 1024 + h * 128;
            if (r < L) { const KeyWA k{kvwa, r, h >> 2}; wave_attn(q, 513, k, true, sinkp[h], o, wl, c.lane); }
            else { const KeyCtxWA k{kvwa, h >> 2}; wave_attn(q, 256, k, true, sinkp[h], o, wl, c.lane); }
        } else {
            const int h = hh - 8; const bf16_t* q = c.wsp<bf16_t>(WS_QNA) + (size_t)r * 1024 + h * 128; bf16_t* o = c.wsp<bf16_t>(WS_YNA) + (size_t)r * 1024 + h * 128;
            if (r < L) { const int gr = r / GRIDW, qc = r % GRIDW; int r0 = gr - 4; r0 = r0 < 0 ? 0 : (r0 > 248 ? 248 : r0); int cs = qc - 8; cs = cs < 0 ? 0 : (cs > 48 ? 48 : cs);
                const KeyNA k{kvna, rpb, gr, qc, r0, cs, h}; wave_attn(q, 384, k, false, 0.f, o, wl, c.lane); }
            else { const KeyCtxNA k{kvna, h}; wave_attn(q, 256, k, false, 0.f, o, wl, c.lane); }
        }
    }
#endif
}

__device__ __forceinline__ void ph_c2(const Ctx& c) {
    bf16_t* tile = (bf16_t*)c.smem;
    const bf16_t* src = c.wsp<bf16_t>(WS_YHYT); bf16_t* dst = c.wsp<bf16_t>(WS_YHY);
    const int tid = c.tid, a = tid >> 3, b8 = (tid & 7) * 8;
    for (int u = c.bid; u < (1024 / 64) * (L / 64); u += c.nb) {
        const int c0 = (u % 16) * 64, t0 = (u / 16) * 64;
        const uint4 v = *(const uint4*)(src + (size_t)(c0 + a) * L + t0 + b8);
        __syncthreads();
        *(uint4*)(tile + a * 72 + b8) = v;
        __syncthreads();
        unsigned short e[8];
#pragma unroll
        for (int i = 0; i < 8; ++i) e[i] = tile[(b8 + i) * 72 + a];
        uint4 o; o.x = e[0] | ((unsigned)e[1] << 16); o.y = e[2] | ((unsigned)e[3] << 16); o.z = e[4] | ((unsigned)e[5] << 16); o.w = e[6] | ((unsigned)e[7] << 16);
        *(uint4*)(dst + (size_t)(t0 + a) * 1024 + c0 + b8) = o;
    }
}

struct EpiMerge { unsigned char* ws; int b;
    __device__ __forceinline__ void operator()(int row, int col, const float (&v)[8]) const {
        const bf16_t* g = (const bf16_t*)(ws + WS_GATE) + (size_t)row * 6144 + b * 2048 + col;
        float* mp = (float*)(ws + WS_MPART) + (size_t)row * D + col;
        const uint4 gg = *(const uint4*)g;
        const float gv[8] = {__uint_as_float(gg.x << 16), __uint_as_float(gg.x & 0xffff0000u), __uint_as_float(gg.y << 16), __uint_as_float(gg.y & 0xffff0000u),
                             __uint_as_float(gg.z << 16), __uint_as_float(gg.z & 0xffff0000u), __uint_as_float(gg.w << 16), __uint_as_float(gg.w & 0xffff0000u)};
        float t[8];
        if (b == 0) {
#pragma unroll
            for (int j = 0; j < 8; ++j) t[j] = gv[j] * v[j];
        } else {
            const float4 p0 = *(const float4*)mp, p1 = *(const float4*)(mp + 4);
            const float pv[8] = {p0.x, p0.y, p0.z, p0.w, p1.x, p1.y, p1.z, p1.w};
#pragma unroll
            for (int j = 0; j < 8; ++j) t[j] = fmaf(gv[j], v[j], pv[j]);
        }
        if (b < 2) { *(float4*)mp = make_float4(t[0], t[1], t[2], t[3]); *(float4*)(mp + 4) = make_float4(t[4], t[5], t[6], t[7]); }
        else { uint4 o; o.x = pk2(t[0], t[1]); o.y = pk2(t[2], t[3]); o.z = pk2(t[4], t[5]); o.w = pk2(t[6], t[7]); *(uint4*)((bf16_t*)(ws + WS_MB) + (size_t)row * D + col) = o; }
    }
};
__device__ __forceinline__ void ph_d(const Ctx& c, int layer) {
    const int nM = MR / 128, nN = D / 128;
    for (int b = 0; b < 3; ++b) {
        const bf16_t* A = b == 0 ? c.wsp<bf16_t>(WS_YHY) : (b == 1 ? c.wsp<bf16_t>(WS_YWA) : c.wsp<bf16_t>(WS_YNA));
        const RowLin rp{A, 1024}; const EpiMerge ep{c.ws, b};
        const float* W = c.in[24] + ((size_t)layer * 3 + b) * 1024 * D;
        for (int u = c.bid; u < nM * nN; u += c.nb) sgemm_unit(rp, W, D, 1024, (u % nM) * 128, (u / nM) * 128, ep, (float*)c.smem, c.tid);
    }
}
struct EpiOut { const Ctx* c; int layer;
    __device__ __forceinline__ void operator()(int row, int col, const float (&v)[8]) const {
        const float* xin = c->xrow(layer, row) + col; const float* g = c->mod(layer, row < L ? 0 : 1, 2) + col;
        float* o = (float*)(c->ws + WS_XA) + (size_t)row * D + col;
        const float4 x0 = *(const float4*)xin, x1 = *(const float4*)(xin + 4), g0 = *(const float4*)g, g1 = *(const float4*)(g + 4);
        *(float4*)o = make_float4(x0.x + g0.x * v[0], x0.y + g0.y * v[1], x0.z + g0.z * v[2], x0.w + g0.w * v[3]);
        *(float4*)(o + 4) = make_float4(x1.x + g1.x * v[4], x1.y + g1.y * v[5], x1.z + g1.z * v[6], x1.w + g1.w * v[7]);
    }
};
__device__ __forceinline__ void ph_e(const Ctx& c, int layer) {
    const int nM = MR / 128, nN = D / 128;
    const RowLin rp{c.wsp<bf16_t>(WS_MB), D}; const EpiOut ep{&c, layer};
    const float* W = c.in[25] + (size_t)layer * D * D;
    for (int u = c.bid; u < nM * nN; u += c.nb) sgemm_unit(rp, W, D, D, (u % nM) * 128, (u / nM) * 128, ep, (float*)c.smem, c.tid);
}

__device__ __forceinline__ void ph_f(const Ctx& c, int layer) {
    const int gw = c.bid * 8 + c.wave, ngw = c.nb * 8;
    const float* g = c.in[26] + (size_t)layer * D;
    const float* wr = c.in[27] + (size_t)layer * D * NE;
    float* wl = (float*)c.smem; float* gl = wl + NE * D;
    __syncthreads();
    for (int i = c.tid; i < D * NE / 4; i += NTHREADS) { const float4 v = *(const float4*)(wr + 4 * i); const int col = i >> 2, e0 = (i & 3) * 4;
        wl[(e0 + 0) * D + col] = v.x; wl[(e0 + 1) * D + col] = v.y; wl[(e0 + 2) * D + col] = v.z; wl[(e0 + 3) * D + col] = v.w; }
    for (int i = c.tid; i < D; i += NTHREADS) { gl[i] = g[i]; gl[D + i] = c.mod(layer, 0, 3)[i]; gl[2 * D + i] = c.mod(layer, 0, 4)[i]; }
    __syncthreads();
    const int nrows = layer == 0 ? MR : L;
    for (int r = gw; r < nrows; r += ngw) {
        const float* x = c.wsp<float>(WS_XA) + (size_t)r * D;
        const bool lat = r < L;
        const float* shg = c.mod(layer, 1, 3); const float* scg = c.mod(layer, 1, 4);
        float4 v[8]; float ss = 0.f;
#pragma unroll
        for (int j = 0; j < 8; ++j) { v[j] = *(const float4*)(x + 4 * c.lane + 256 * j); ss += v[j].x * v[j].x + v[j].y * v[j].y + v[j].z * v[j].z + v[j].w * v[j].w; }
        ss = wave_sum(ss);
        const float inv = rsqrtf(ss * (1.0f / D) + RMS_EPS);
        bf16_t* o = c.wsp<bf16_t>(WS_H2) + (size_t)r * D;
        float lg[NE];
#pragma unroll
        for (int e = 0; e < NE; ++e) lg[e] = 0.f;
#pragma unroll
        for (int j = 0; j < 8; ++j) {
            const int col = 4 * c.lane + 256 * j;
            const float4 gg = *(const float4*)(gl + col);
            const float4 s4 = lat ? *(const float4*)(gl + D + col) : *(const float4*)(shg + col);
            const float4 c4 = lat ? *(const float4*)(gl + 2 * D + col) : *(const float4*)(scg + col);
            const float y0 = v[j].x * inv * gg.x * (1.f + c4.x) + s4.x, y1 = v[j].y * inv * gg.y * (1.f + c4.y) + s4.y;
            const float y2 = v[j].z * inv * gg.z * (1.f + c4.z) + s4.z, y3 = v[j].w * inv * gg.w * (1.f + c4.w) + s4.w;
            uint2 w; w.x = pk2(y0, y1); w.y = pk2(y2, y3);
            *(uint2*)(o + col) = w;
#pragma unroll
            for (int e = 0; e < NE; ++e) { const float4 w4 = *(const float4*)(wl + e * D + col); lg[e] = fmaf(y0, w4.x, fmaf(y1, w4.y, fmaf(y2, w4.z, fmaf(y3, w4.w, lg[e])))); }
            __builtin_amdgcn_sched_barrier(0);
        }
        float mx = -3e38f;
#pragma unroll
        for (int e = 0; e < NE; ++e) { lg[e] = wave_sum(lg[e]); mx = fmaxf(mx, lg[e]); }
        float sum = 0.f;
#pragma unroll
        for (int e = 0; e < NE; ++e) { lg[e] = expf(lg[e] - mx); sum += lg[e]; }
        float mine = 0.f;
#pragma unroll
        for (int e = 0; e < NE; ++e) mine = (c.lane == e) ? lg[e] / sum : mine;
        if (c.lane < NE) c.wsp<float>(WS_AFF)[(size_t)r * NE + c.lane] = mine;
    }
}

__device__ __forceinline__ void topk_unit(const Ctx& c, int e, int row0, int n, int K, int slot0) {
    unsigned* sh = (unsigned*)c.smem;
    const int tid = c.tid, lane = c.lane, wave = c.wave;
    const float* aff = c.wsp<float>(WS_AFF);
    unsigned key[32];
#pragma unroll
    for (int j = 0; j < 32; ++j) { const int t = tid + NTHREADS * j; key[j] = t < n ? __float_as_uint(aff[(size_t)(row0 + t) * NE + e]) : 0u; }
    unsigned T = 0u;
#pragma unroll 1
    for (int bit = 30; bit >= 0; bit -= 2) {
        const unsigned t1 = T | (1u << bit), t2 = T | (2u << bit), t3 = T | (3u << bit);
        unsigned c1 = 0u, c2 = 0u, c3 = 0u;
#pragma unroll
        for (int j = 0; j < 32; ++j) { c1 += key[j] >= t1 ? 1u : 0u; c2 += key[j] >= t2 ? 1u : 0u; c3 += key[j] >= t3 ? 1u : 0u; }
#pragma unroll
        for (int o = 1; o < 64; o <<= 1) { c1 += __shfl_xor(c1, o); c2 += __shfl_xor(c2, o); c3 += __shfl_xor(c3, o); }
        __syncthreads();
        if (lane == 0) { sh[wave] = c1; sh[8 + wave] = c2; sh[16 + wave] = c3; }
        __syncthreads();
        unsigned s1 = 0u, s2 = 0u, s3 = 0u;
#pragma unroll
        for (int w = 0; w < 8; ++w) { s1 += sh[w]; s2 += sh[8 + w]; s3 += sh[16 + w]; }
        T = s3 >= (unsigned)K ? t3 : (s2 >= (unsigned)K ? t2 : (s1 >= (unsigned)K ? t1 : T));
    }
    unsigned ng = 0u, neq = 0u;
#pragma unroll
    for (int j = 0; j < 32; ++j) { ng += key[j] > T ? 1u : 0u; neq += (key[j] == T && tid + NTHREADS * j < n) ? 1u : 0u; }
    unsigned ig = ng, ie = neq;
#pragma unroll
    for (int o = 1; o < 64; o <<= 1) { const unsigned a = __shfl_up(ig, o), b = __shfl_up(ie, o); if (lane >= o) { ig += a; ie += b; } }
    __syncthreads();
    if (lane == 63) { sh[32 + wave] = ig; sh[40 + wave] = ie; }
    __syncthreads();
    unsigned og = 0u, oe = 0u, totg = 0u, tote = 0u;
#pragma unroll
    for (int w = 0; w < 8; ++w) { const unsigned a = sh[32 + w], b = sh[40 + w]; if (w < wave) { og += a; oe += b; } totg += a; tote += b; }
    const unsigned need = (unsigned)K - totg;
    unsigned pg = og + ig - ng;
    int* IDX = c.wsp<int>(WS_IDX) + (size_t)e * SLOTS; float* GS = c.wsp<float>(WS_GSEL) + (size_t)e * SLOTS; int* SL = c.wsp<int>(WS_SLOT) + (size_t)e * MR;
    if (tote == need) {
        unsigned pe = totg + oe + ie - neq;
#pragma unroll
        for (int j = 0; j < 32; ++j) { const int t = tid + NTHREADS * j;
            if (t < n) { int slot = -1; if (key[j] > T) slot = (int)pg++; else if (key[j] == T) slot = (int)pe++;
                SL[row0 + t] = slot >= 0 ? slot0 + slot : -1; if (slot >= 0) { IDX[slot0 + slot] = row0 + t; GS[slot0 + slot] = __uint_as_float(key[j]); } } }
    } else {
        unsigned base_eq = 0u;
#pragma unroll 1
        for (int j = 0; j < 32; ++j) { const int t = tid + NTHREADS * j;
            const unsigned kj = t < n ? __float_as_uint(aff[(size_t)(row0 + t) * NE + e]) : 0u;
            const bool eq = t < n && kj == T;
            const unsigned long long me = __ballot(eq);
            const unsigned long long lower = (lane == 0) ? 0ull : (~0ull >> (64 - lane));
            const unsigned re = (unsigned)__popcll(me & lower);
            __syncthreads();
            if (lane == 0) sh[48 + wave] = (unsigned)__popcll(me);
            __syncthreads();
            unsigned oq = 0u, tq = 0u;
#pragma unroll
            for (int w = 0; w < 8; ++w) { const unsigned a = sh[48 + w]; if (w < wave) oq += a; tq += a; }
            if (t < n) { int slot = -1; if (kj > T) slot = (int)pg++; else if (eq) { const unsigned rk = base_eq + oq + re; if (rk < need) slot = (int)(totg + rk); }
                SL[row0 + t] = slot >= 0 ? slot0 + slot : -1; if (slot >= 0) { IDX[slot0 + slot] = row0 + t; GS[slot0 + slot] = __uint_as_float(kj); } }
            base_eq += tq;
        }
    }
    __syncthreads();
}
__device__ __forceinline__ void ph_g(const Ctx& c, int layer) {
    const int ntop = layer == 0 ? 32 : 16;
    for (int u = c.bid; u < ntop; u += c.nb) {
        if (u < 16) topk_unit(c, u, 0, L, CAP, 0);
        else { const int e = u - 16; topk_unit(c, e, L, LC, CAPC, CAP);
            for (int s = CAP + CAPC + c.tid; s < SLOTS; s += NTHREADS) { c.wsp<int>(WS_IDX)[(size_t)e * SLOTS + s] = 0; c.wsp<float>(WS_GSEL)[(size_t)e * SLOTS + s] = 0.f; } }
    }
    if (c.nb == 256) {
        constexpr int BIG = 25, SMALL = (CONV_NX - 224 * BIG) / 32;
        static_assert(224 * BIG + 32 * SMALL == CONV_NX, "expert conversion split");
        if (c.bid >= 32) ph_conv(c, layer, CONV_NA + (c.bid - 32) * BIG, BIG, 1);
        else ph_conv(c, layer, CONV_NA + 224 * BIG + c.bid * SMALL, SMALL, 1);
    } else ph_conv(c, layer, CONV_NA + c.bid, (CONV_NX - c.bid + c.nb - 1) / c.nb, c.nb);
}

struct EpiGate { float* tmp; __device__ __forceinline__ void operator()(int row, int col, const float (&v)[8]) const {
    float* p = tmp + (size_t)row * DF + col; *(float4*)p = make_float4(v[0], v[1], v[2], v[3]); *(float4*)(p + 4) = make_float4(v[4], v[5], v[6], v[7]); } };
struct EpiUp { const float* tmp; bf16_t* act; __device__ __forceinline__ void operator()(int row, int col, const float (&v)[8]) const {
    const float* p = tmp + (size_t)row * DF + col; const float4 a0 = *(const float4*)p, a1 = *(const float4*)(p + 4);
    const float a[8] = {a0.x, a0.y, a0.z, a0.w, a1.x, a1.y, a1.z, a1.w}; float t[8];
#pragma unroll
    for (int j = 0; j < 8; ++j) t[j] = silu_f(a[j]) * v[j];
    uint4 o; o.x = pk2(t[0], t[1]); o.y = pk2(t[2], t[3]); o.z = pk2(t[4], t[5]); o.w = pk2(t[6], t[7]);
    *(uint4*)(act + (size_t)row * DF + col) = o; } };
struct EpiDown { bf16_t* ye; __device__ __forceinline__ void operator()(int row, int col, const float (&v)[8]) const {
    uint4 o; o.x = pk2(v[0], v[1]); o.y = pk2(v[2], v[3]); o.z = pk2(v[4], v[5]); o.w = pk2(v[6], v[7]);
    *(uint4*)(ye + (size_t)row * D + col) = o; } };
__device__ __forceinline__ void ph_h(const Ctx& c, int layer) {
    const int nM = SLOTS / 128, nN = DF / 128;
    for (int which = 0; which < 2; ++which)
        for (int u = c.bid; u < NE * nM * nN; u += c.nb) {
            const int e = u / (nM * nN), r = u % (nM * nN), pm = r % nM, pn = r / nM;
            const RowGather rp{c.wsp<bf16_t>(WS_H2), D, c.wsp<int>(WS_IDX) + (size_t)e * SLOTS};
            float* tmp = c.wsp<float>(WS_TMP) + (size_t)e * SLOTS * DF;
            const float* W = c.in[which == 0 ? 28 : 29] + ((size_t)layer * NE + e) * D * DF;
            if (which == 0) { const EpiGate ep{tmp}; sgemm_unit(rp, W, DF, D, pm * 128, pn * 128, ep, (float*)c.smem, c.tid); }
            else { const EpiUp ep{tmp, c.wsp<bf16_t>(WS_ACT) + (size_t)e * SLOTS * DF}; sgemm_unit(rp, W, DF, D, pm * 128, pn * 128, ep, (float*)c.smem, c.tid); }
        }
}
__device__ __forceinline__ void ph_i(const Ctx& c, int layer) {
    const int nM = SLOTS / 128, nN = D / 128;
    for (int u = c.bid; u < NE * nM * nN; u += c.nb) {
        const int e = u / (nM * nN), r = u % (nM * nN), pm = r % nM, pn = r / nM;
        const RowLin rp{c.wsp<bf16_t>(WS_ACT) + (size_t)e * SLOTS * DF, DF};
        const EpiDown ep{c.wsp<bf16_t>(WS_YE) + (size_t)e * SLOTS * D};
        const float* W = c.in[30] + ((size_t)layer * NE + e) * DF * D;
        sgemm_unit(rp, W, D, DF, pm * 128, pn * 128, ep, (float*)c.smem, c.tid);
    }
}

__device__ __forceinline__ void ph_j(const Ctx& c, int layer) {
    const int gw = c.bid * 8 + c.wave, ngw = c.nb * 8;
    const int nrows = layer == 0 ? MR : L;
    for (int r = gw; r < nrows; r += ngw) {
        const float* x1 = c.wsp<float>(WS_XA) + (size_t)r * D;
        const float* g5 = c.mod(layer, r < L ? 0 : 1, 5);
        float* o = layer == 0 ? c.wsp<float>(WS_XB) + (size_t)r * D : c.out + (size_t)r * D;
        float acc[32];
#pragma unroll
        for (int j = 0; j < 32; ++j) acc[j] = 0.f;
        for (int e = 0; e < NE; ++e) {
            const int s = c.wsp<int>(WS_SLOT)[(size_t)e * MR + r];
            if (s >= 0) {
                const float gs = c.wsp<float>(WS_GSEL)[(size_t)e * SLOTS + s];
                const bf16_t* y = c.wsp<bf16_t>(WS_YE) + ((size_t)e * SLOTS + s) * D;
#pragma unroll
                for (int j = 0; j < 8; ++j) { const uint2 w = *(const uint2*)(y + 4 * c.lane + 256 * j);
                    acc[4 * j + 0] = fmaf(gs, __uint_as_float(w.x << 16), acc[4 * j + 0]); acc[4 * j + 1] = fmaf(gs, __uint_as_float(w.x & 0xffff0000u), acc[4 * j + 1]);
                    acc[4 * j + 2] = fmaf(gs, __uint_as_float(w.y << 16), acc[4 * j + 2]); acc[4 * j + 3] = fmaf(gs, __uint_as_float(w.y & 0xffff0000u), acc[4 * j + 3]); }
            }
        }
        float4 ov[8]; float ss = 0.f;
#pragma unroll
        for (int j = 0; j < 8; ++j) { const int col = 4 * c.lane + 256 * j; const float4 xv = *(const float4*)(x1 + col), gv = *(const float4*)(g5 + col);
            ov[j] = make_float4(xv.x + gv.x * acc[4 * j], xv.y + gv.y * acc[4 * j + 1], xv.z + gv.z * acc[4 * j + 2], xv.w + gv.w * acc[4 * j + 3]);
            *(float4*)(o + col) = ov[j]; ss += ov[j].x * ov[j].x + ov[j].y * ov[j].y + ov[j].z * ov[j].z + ov[j].w * ov[j].w; }
        if (layer == 0) {
            ss = wave_sum(ss);
            const float inv = rsqrtf(ss * (1.0f / D) + RMS_EPS);
            const float* g1 = c.in[6] + (size_t)1 * D; const float* sh = c.mod(1, r < L ? 0 : 1, 0); const float* sc = c.mod(1, r < L ? 0 : 1, 1);
            bf16_t* hx = c.wsp<bf16_t>(WS_HX) + (size_t)r * D;
#pragma unroll
            for (int j = 0; j < 8; ++j) { const int col = 4 * c.lane + 256 * j;
                const float4 gg = *(const float4*)(g1 + col), s4 = *(const float4*)(sh + col), c4 = *(const float4*)(sc + col);
                const float y0 = ov[j].x * inv * gg.x * (1.f + c4.x) + s4.x, y1 = ov[j].y * inv * gg.y * (1.f + c4.y) + s4.y;
                const float y2 = ov[j].z * inv * gg.z * (1.f + c4.z) + s4.z, y3 = ov[j].w * inv * gg.w * (1.f + c4.w) + s4.w;
                uint2 w; w.x = pk2(y0, y1); w.y = pk2(y2, y3);
                *(uint2*)(hx + col) = w; }
        }
    }
}


#ifndef FAST_B
#define FAST_B 1
#endif
#ifndef FAST_DE
#define FAST_DE 1
#endif
#ifndef FAST_HI
#define FAST_HI 1
#endif
struct GeomInProj {
    static constexpr bool GATHER = false;
    const char* WIN; const char* HX; int K, lda, ldb; const int* idx;
    __device__ __forceinline__ const char* a_base(const pg8::Unit& u) const { return u.pm >= 1000 ? WIN + (size_t)(u.pm - 1000) * 256 * D * 2 : HX + (size_t)u.pm * 256 * D * 2; }
    __device__ __forceinline__ const char* b_base(const pg8::Unit& u) const { return u.pm >= 1000 ? HX + (size_t)u.pn * 256 * D * 2 : WIN + ((size_t)OFF_WAQ + (size_t)u.pn * 256) * D * 2; }
    __device__ __forceinline__ int row0(const pg8::Unit& u) const { return (u.pm >= 1000 ? u.pm - 1000 : u.pm) * 256; }
};
struct SchedInProj {
    pg8::StaticOrder s0, s1; int G, c;
    __device__ __forceinline__ bool next(int i, pg8::Unit& u) const {
        const long Lq = (long)i * G + c;
        if (Lq < s0.nwg) { s0.at(Lq, u); u.pm += 1000; return true; }
        return s1.at(Lq - s0.nwg, u);
    }
};
struct EpiInProj {
    static constexpr bool PERM = true;
    pg8::EpiBf16Plain e0; pg8::EpiInRest e1;
    __device__ __forceinline__ void operator()(const pg8::f32x4 (&acc)[2][2][4][2], const pg8::Unit& u, int row0, int wr, int wc, int fr, int fq) const {
        if (u.pm >= 1000) { pg8::Unit v = u; v.pm -= 1000; e0(acc, v, row0, wr, wc, fr, fq); } else e1(acc, u, row0, wr, wc, fr, fq);
    }
};
__device__ __forceinline__ void ph_b_fast(const Ctx& c, int layer) {
    LAS unsigned char* lds = (LAS unsigned char*)c.smem;
    const char* WIN = (const char*)(c.ws + WS_WIN); const char* HX = (const char*)(c.ws + WS_HX);
    __syncthreads();
    const GeomInProj G{WIN, HX, D, D, D, nullptr};
    SchedInProj S; S.s0.init(3072 / 256, MR / 256, c.nb, c.bid); S.s1.init(MR / 256, (NIN - OFF_WAQ) / 256, c.nb, c.bid); S.G = c.nb; S.c = c.bid;
    const EpiInProj E{pg8::EpiBf16Plain{c.wsp<bf16_t>(WS_ZHYT), MR, 0}, pg8::EpiInRest{c.ws}};
    pg8::gemm_phase(lds, G, S, E);
}
__device__ __forceinline__ void ph_d_fast(const Ctx& c, int layer) {
    LAS unsigned char* lds = (LAS unsigned char*)c.smem;
    const int nM = layer == 0 ? MR / 256 : L / 256;
    pg8::StaticOrder S; S.init(nM, D / 256, c.nb, c.bid);
    __syncthreads();
    { const pg8::GeomLin G{(const char*)(c.ws + WS_YHY), (const char*)(c.ws + WS_WBR), 1024, 1024, 1024, nullptr}; const pg8::EpiMergeF<0> E{c.ws}; pg8::gemm_phase(lds, G, S, E); }
    { const pg8::GeomLin G{(const char*)(c.ws + WS_YWA), (const char*)(c.ws + WS_WBR) + (size_t)D * 1024 * 2, 1024, 1024, 1024, nullptr}; const pg8::EpiMergeF<1> E{c.ws}; pg8::gemm_phase(lds, G, S, E); }
    { const pg8::GeomLin G{(const char*)(c.ws + WS_YNA), (const char*)(c.ws + WS_WBR) + (size_t)2 * D * 1024 * 2, 1024, 1024, 1024, nullptr}; const pg8::EpiMergeF<2> E{c.ws}; pg8::gemm_phase(lds, G, S, E); }
}
__device__ __forceinline__ void ph_e_fast(const Ctx& c, int layer) {
    LAS unsigned char* lds = (LAS unsigned char*)c.smem;
    const int nM = layer == 0 ? MR / 256 : L / 256;
    pg8::StaticOrder S; S.init(nM, D / 256, c.nb, c.bid);
    __syncthreads();
    const pg8::GeomLin G{(const char*)(c.ws + WS_MB), (const char*)(c.ws + WS_WOUT), D, D, D, nullptr}; const pg8::EpiOutF E{&c, layer};
    pg8::gemm_phase(lds, G, S, E);
}
__device__ __forceinline__ void ph_h_fast(const Ctx& c, int layer) {
    LAS unsigned char* lds = (LAS unsigned char*)c.smem;
    const int tpe = layer == 0 ? 9 : 8;
    pg8::StaticOrder S; S.init(NE * tpe, 2048 / 256, c.nb, c.bid);
    __syncthreads();
    const pg8::GeomExpert<true> G{(const char*)(c.ws + WS_H2), (const char*)(c.ws + WS_WGU), D, D, D, c.wsp<int>(WS_IDX), tpe, 2048};
    const pg8::EpiGU E{c.wsp<bf16_t>(WS_ACT)};
    pg8::gemm_phase(lds, G, S, E);
}
__device__ __forceinline__ void ph_i_fast(const Ctx& c, int layer) {
    LAS unsigned char* lds = (LAS unsigned char*)c.smem;
    const int tpe = layer == 0 ? 9 : 8;
    pg8::StaticOrder S; S.init(NE * tpe, D / 256, c.nb, c.bid);
    __syncthreads();
    const pg8::GeomExpert<false> G{(const char*)(c.ws + WS_ACT), (const char*)(c.ws + WS_WDN), DF, DF, DF, nullptr, tpe, D};
    const pg8::EpiBf16Plain E{c.wsp<bf16_t>(WS_YE), D, 0};
    pg8::gemm_phase(lds, G, S, E);
}

__global__ void __launch_bounds__(NTHREADS, 2) mega(KArgs a) {
    extern __shared__ __attribute__((aligned(16))) unsigned char smem[];
    Ctx c; c.in = a.in; c.out = a.out; c.ws = a.ws; c.bid = blockIdx.x; c.nb = gridDim.x; c.tid = threadIdx.x; c.lane = c.tid & 63;
    c.wave = __builtin_amdgcn_readfirstlane(c.tid >> 6); c.smem = smem;
    volatile LAS unsigned* st = (volatile LAS unsigned*)(LAS unsigned char*)(smem + LDS_BYTES - 16);
    if (c.tid == 0) { st[0] = 0u; st[1] = 0u; st[2] = 0u; st[3] = 0u; }
    __syncthreads();
    const int lo = a.ph_lo, hi = a.ph_hi;
    XcdBarrier bar; bar.bar = (unsigned*)(a.ws + WS_CTL); bar.x = 0; bar.st = st;
    if (hi - lo > 1) bar = xcd_barrier_post((unsigned*)(a.ws + WS_CTL), st);
#ifndef ONLY_PH
#define ONLY_PH -1
#endif
#define PSEL(j) (ONLY_PH < 0 || ONLY_PH == (j))

#define IN(k) (lo <= (k) && (k) < hi)
#define GASP __attribute__((address_space(1)))
#define LAUNDER(cc) Ctx cc = c; asm volatile("" : "+v"(cc.tid), "+v"(cc.lane)); asm volatile("" : "+s"(cc.bid), "+s"(cc.nb), "+s"(cc.wave)); \
    { GASP unsigned char* wg_ = (GASP unsigned char*)cc.ws; GASP float* og_ = (GASP float*)cc.out; asm volatile("" : "+s"(wg_), "+s"(og_)); cc.ws = (unsigned char*)wg_; cc.out = (float*)og_; }
#define SEAM(k) do { if (IN(k) && IN((k) + 1)) xcd_barrier(bar); } while (0)
    if (PSEL(0) && IN(0)) { LAUNDER(cc); ph_g0(cc); if (hi - lo > 1) xcd_barrier(bar); LAUNDER(cd); ph_g0b(cd); } SEAM(0);
#define LAYER_PROGRAM(layer) do { const int b = 1 + (layer) * PH_PER_LAYER; \
        if (PSEL(1) && IN(b + 0)) { LAUNDER(cc); constexpr int ly = (layer); { ph_a(cc, ly); if constexpr (DOREP(15)) { LAUNDER(ce); ph_a(ce, ly); } ph_taps(cc, ly); if constexpr (DOREP(14)) { LAUNDER(ce); ph_taps(ce, ly); } if (FAST_B || FAST_DE || FAST_HI) ph_conv(cc, ly, cc.bid, (CONV_NA - cc.bid + cc.nb - 1) / cc.nb, cc.nb); if constexpr (DOREP(13)) { LAUNDER(ce); ph_conv(ce, ly, ce.bid, (CONV_NA - ce.bid + ce.nb - 1) / ce.nb, ce.nb); } __syncthreads(); } if constexpr (DOREP(1)) { LAUNDER(cd); { Ctx& cc = cd; (void)cc; ph_a(cd, ly); ph_taps(cd, ly); if (FAST_B || FAST_DE || FAST_HI) ph_conv(cd, ly, cd.bid, (CONV_NA - cd.bid + cd.nb - 1) / cd.nb, cd.nb); __syncthreads(); } } } SEAM(b + 0); \
        if (PSEL(2) && IN(b + 1)) { LAUNDER(cc); constexpr int ly = (layer); { if (FAST_B) ph_b_fast(cc, ly); else ph_b(cc, ly); __syncthreads(); } if constexpr (DOREP(2)) { LAUNDER(cd); { Ctx& cc = cd; (void)cc; if (FAST_B) ph_b_fast(cd, ly); else ph_b(cd, ly); __syncthreads(); } } } SEAM(b + 1); \
        if (PSEL(3) && IN(b + 2)) { LAUNDER(cc); constexpr int ly = (layer); ph_b2(cc, ly); } SEAM(b + 2); \
        if (PSEL(4) && IN(b + 3)) { LAUNDER(cc); constexpr int ly = (layer); { ph_c(cc, ly); __syncthreads(); } if constexpr (DOREP(4)) { LAUNDER(cd); { Ctx& cc = cd; (void)cc; ph_c(cd, ly); __syncthreads(); } } } SEAM(b + 3); \
        if (PSEL(5) && IN(b + 4)) { LAUNDER(cc); constexpr int ly = (layer); { ph_c2(cc); __syncthreads(); } if constexpr (DOREP(5)) { LAUNDER(cd); { Ctx& cc = cd; (void)cc; ph_c2(cd); __syncthreads(); } } } SEAM(b + 4); \
        if (PSEL(6) && IN(b + 5)) { LAUNDER(cc); constexpr int ly = (layer); { if (FAST_DE) ph_d_fast(cc, ly); else ph_d(cc, ly); __syncthreads(); } if constexpr (DOREP(6)) { LAUNDER(cd); { Ctx& cc = cd; (void)cc; if (FAST_DE) ph_d_fast(cd, ly); else ph_d(cd, ly); __syncthreads(); } } } SEAM(b + 5); \
        if (PSEL(7) && IN(b + 6)) { LAUNDER(cc); constexpr int ly = (layer); { if (FAST_DE) ph_e_fast(cc, ly); else ph_e(cc, ly); __syncthreads(); } if constexpr (DOREP(7)) { LAUNDER(cd); { Ctx& cc = cd; (void)cc; if (FAST_DE) ph_e_fast(cd, ly); else ph_e(cd, ly); __syncthreads(); } } } SEAM(b + 6); \
        if (PSEL(8) && IN(b + 7)) { LAUNDER(cc); constexpr int ly = (layer); { ph_f(cc, ly); __syncthreads(); } if constexpr (DOREP(8)) { LAUNDER(cd); { Ctx& cc = cd; (void)cc; ph_f(cd, ly); __syncthreads(); } } } SEAM(b + 7); \
        if (PSEL(9) && IN(b + 8)) { LAUNDER(cc); constexpr int ly = (layer); { ph_g(cc, ly); __syncthreads(); } if constexpr (DOREP(9)) { LAUNDER(cd); { Ctx& cc = cd; (void)cc; ph_g(cd, ly); __syncthreads(); } } } SEAM(b + 8); \
        if (PSEL(10) && IN(b + 9)) { LAUNDER(cc); constexpr int ly = (layer); { if (FAST_HI) ph_h_fast(cc, ly); else ph_h(cc, ly); __syncthreads(); } if constexpr (DOREP(10)) { LAUNDER(cd); { Ctx& cc = cd; (void)cc; if (FAST_HI) ph_h_fast(cd, ly); else ph_h(cd, ly); __syncthreads(); } } } SEAM(b + 9); \
        if (PSEL(11) && IN(b + 10)) { LAUNDER(cc); constexpr int ly = (layer); { if (FAST_HI) ph_i_fast(cc, ly); else ph_i(cc, ly); __syncthreads(); } if constexpr (DOREP(11)) { LAUNDER(cd); { Ctx& cc = cd; (void)cc; if (FAST_HI) ph_i_fast(cd, ly); else ph_i(cd, ly); __syncthreads(); } } } SEAM(b + 10); \
        if (PSEL(12) && IN(b + 11)) { LAUNDER(cc); constexpr int ly = (layer); { ph_j(cc, ly); __syncthreads(); } if constexpr (DOREP(12)) { LAUNDER(cd); { Ctx& cc = cd; (void)cc; ph_j(cd, ly); __syncthreads(); } } } SEAM(b + 11); \
    } while (0)
    LAYER_PROGRAM(0);
    LAYER_PROGRAM(1);
#undef LAYER_PROGRAM
#undef IN
#undef SEAM
}

extern "C" void kernel_launch(void* const* d_in, const int* in_sizes, int n_in, void* d_out, int out_size, void* d_ws, size_t ws_size, hipStream_t stream) {
    static int grid = 0;
    if (grid == 0) {
        if (n_in != 31 || out_size != L * D || ws_size < WS_END) { fprintf(stderr, "kernel_launch: unexpected shapes: n_in %d out %d ws %zu (need %zu)\n", n_in, out_size, ws_size, (size_t)WS_END); grid = -1; return; }
        int dev = 0, cus = 0, per_cu = 0;
        if (hipGetDevice(&dev) != hipSuccess || hipDeviceGetAttribute(&cus, hipDeviceAttributeMultiprocessorCount, dev) != hipSuccess) { grid = -1; return; }
        if (hipFuncSetAttribute((const void*)mega, hipFuncAttributeMaxDynamicSharedMemorySize, LDS_BYTES) != hipSuccess) { fprintf(stderr, "kernel_launch: hipFuncSetAttribute failed\n"); grid = -1; return; }
        if (hipOccupancyMaxActiveBlocksPerMultiprocessor(&per_cu, (const void*)mega, NTHREADS, LDS_BYTES) != hipSuccess || per_cu < 1) fprintf(stderr, "kernel_launch: occupancy query says %d\n", per_cu);
        (void)hipGetLastError();
        grid = cus;
    }
    if (grid < 0) return;
    if (hipMemsetAsync((char*)d_ws + WS_CTL, 0, CTL_BYTES, stream) != hipSuccess) return;
    KArgs a{};
    for (int i = 0; i < 31; ++i) a.in[i] = (const float*)d_in[i];
    a.out = (float*)d_out; a.ws = (unsigned char*)d_ws;
#if ONE_LAUNCH
    a.ph_lo = 0; a.ph_hi = NPH;
    hipLaunchKernelGGL(mega, dim3(grid), dim3(NTHREADS), LDS_BYTES, stream, a);
#else
    for (int p = 0; p < NPH; ++p) { a.ph_lo = p; a.ph_hi = p + 1; hipLaunchKernelGGL(mega, dim3(grid), dim3(NTHREADS), LDS_BYTES, stream, a); }
#endif
    const hipError_t le = hipPeekAtLastError();
    if (le != hipSuccess) fprintf(stderr, "kernel_launch: launch failed: %s\n", hipGetErrorName(le));
}
```
